# Optimizing an MI355X kernel written in HIP

```python
import math
import jax, jax.numpy as jnp
from jax import lax
import numpy as np

D_MODEL = 1024
BATCH = 4
SEQ = 8192
DEPTH = 2

N_MIXERS = 2
N_POOL_LAYERS = (DEPTH + 1) // 2
N_MOBA_LAYERS = DEPTH // 2
POOL_WINDOWS = (2, 4, 8, 16)
N_POOL_GROUPS = len(POOL_WINDOWS)
POOL_GROUP = D_MODEL // N_POOL_GROUPS
HEAD_DIM = 64
N_HEADS = D_MODEL // HEAD_DIM
MOBA_BLOCK = 256
MOBA_TOPK = 3
Q_CHUNK = 128
NUM_BUCKETS = 32
MAX_DISTANCE = 1024
D_FF = 4 * D_MODEL
EPS = 1e-6

kernel_name = "hybrid_pool_moba_adaln_block"


def rmsnorm(x, g):
    xf = x.astype(jnp.float32)
    y = xf * lax.rsqrt(jnp.mean(xf * xf, axis=-1, keepdims=True) + EPS)
    return (y * g.astype(jnp.float32)).astype(x.dtype)


def modulate(h, shift, scale):
    return h * (1 + scale[:, None, :]) + shift[:, None, :]


def t5_bucket(dist):
    max_exact = NUM_BUCKETS // 2
    nf = jnp.maximum(dist, 1).astype(jnp.float32)
    large = max_exact + (jnp.log(nf / max_exact) / math.log(MAX_DISTANCE / max_exact)
                         * (NUM_BUCKETS - max_exact)).astype(jnp.int32)
    large = jnp.minimum(large, NUM_BUCKETS - 1)
    return jnp.where(dist < max_exact, dist, large)


def pool_mixer(h, w_pool, pool_scale):
    B, S, D = h.shape
    hf = h.astype(jnp.float32)
    cs = jnp.concatenate([jnp.zeros((B, 1, D), jnp.float32), jnp.cumsum(hf, axis=1)], axis=1)
    t = jnp.arange(S)
    groups = []
    for g, w in enumerate(POOL_WINDOWS):
        sl = slice(g * POOL_GROUP, (g + 1) * POOL_GROUP)
        cs_g = cs[:, :, sl]
        lo = jnp.maximum(t + 1 - w, 0)
        win_sum = cs_g[:, 1:] - jnp.take(cs_g, lo, axis=1)
        cnt = jnp.minimum(t + 1, w).astype(jnp.float32)[None, :, None]
        groups.append(win_sum / cnt - hf[:, :, sl])
    pooled = jnp.stack(groups, axis=2)
    y = jnp.einsum('bsgi,gio->bsgo', pooled, w_pool.astype(jnp.float32)).reshape(B, S, D)
    return (y * pool_scale.astype(jnp.float32)).astype(h.dtype)


def moba_attention(h, w_qkv, w_o, rel_bias):
    B, S, D = h.shape
    H, Dh, BL = N_HEADS, HEAD_DIM, MOBA_BLOCK
    qkv = h @ w_qkv
    q, k, v = jnp.split(qkv, 3, axis=-1)
    q = q.reshape(B, S, H, Dh).transpose(0, 2, 1, 3)
    k = k.reshape(B, S, H, Dh).transpose(0, 2, 1, 3)
    v = v.reshape(B, S, H, Dh).transpose(0, 2, 1, 3)
    nb = -(-S // BL)
    pad = nb * BL - S
    kb = jnp.pad(k, ((0, 0), (0, 0), (0, pad), (0, 0))).reshape(B, H, nb, BL, Dh)
    vb = jnp.pad(v, ((0, 0), (0, 0), (0, pad), (0, 0))).reshape(B, H, nb, BL, Dh)
    kmean = jnp.mean(kb.astype(jnp.float32), axis=3)
    top = min(MOBA_TOPK, nb - 1)
    scale = HEAD_DIM ** -0.5
    rb = rel_bias.astype(jnp.float32)
    rbT = rb.T
    bi = jnp.arange(B)[:, None, None]
    hi = jnp.arange(H)[None, :, None]
    hi4 = jnp.arange(H)[None, :, None, None]
    n_chunks = S // Q_CHUNK

    def chunk_fn(ci):
        s0 = ci * Q_CHUNK
        qf = lax.dynamic_slice_in_dim(q, s0, Q_CHUNK, axis=2).astype(jnp.float32)
        tq = s0 + jnp.arange(Q_CHUNK)
        own = s0 // BL
        k_own = lax.dynamic_index_in_dim(kb, own, axis=2, keepdims=False)
        v_own = lax.dynamic_index_in_dim(vb, own, axis=2, keepdims=False)
        dist_own = tq[:, None] - (own * BL + jnp.arange(BL))[None, :]
        bias_own = rb[t5_bucket(jnp.maximum(dist_own, 0))].transpose(2, 0, 1)[None]
        logit_own = jnp.einsum('bhqd,bhkd->bhqk', qf, k_own.astype(jnp.float32)) * scale + bias_own
        logit_own = jnp.where((dist_own >= 0)[None, None], logit_own, -jnp.inf)
        logits = []
        sel = []
        if top > 0:
            gate = jnp.einsum('bhqd,bhnd->bhqn', qf, kmean)
            past = jnp.arange(nb) < own
            gate = jnp.where(past[None, None, None], gate, -jnp.inf)
            _, idx = lax.top_k(gate, top)
            for r in range(top):
                idx_r = idx[..., r]
                k_sel = kb[bi, hi, idx_r]
                kpos = idx_r[..., None] * BL + jnp.arange(BL)
                dist = tq[None, None, :, None] - kpos
                bias_r = rbT[hi4, t5_bucket(jnp.maximum(dist, 0))]
                lg = jnp.einsum('bhqd,bhqkd->bhqk', qf, k_sel.astype(jnp.float32)) * scale + bias_r
                lg = jnp.where((idx_r < own)[..., None], lg, -jnp.inf)
                logits.append(lg)
                sel.append(idx_r)
        logits.append(logit_own)
        p = jax.nn.softmax(jnp.concatenate(logits, axis=-1), axis=-1)
        out = jnp.einsum('bhqk,bhkd->bhqd', p[..., top * BL:], v_own.astype(jnp.float32))
        for r in range(top):
            v_sel = vb[bi, hi, sel[r]]
            out = out + jnp.einsum('bhqk,bhqkd->bhqd', p[..., r * BL:(r + 1) * BL],
                                   v_sel.astype(jnp.float32))
        return out.astype(h.dtype)

    o = lax.map(chunk_fn, jnp.arange(n_chunks))
    o = o.transpose(1, 0, 3, 2, 4).reshape(B, S, D)
    return o @ w_o


def squared_relu_mlp(h, w_up, w_down):
    a = jax.nn.relu(h @ w_up)
    return (a * a) @ w_down


def setup_inputs(seed: int = 0) -> dict:
    key = jax.random.key(seed)
    ks = jax.random.split(key, 16)
    f32 = jnp.float32
    D = D_MODEL
    nrm = lambda k, shape, s: jax.random.normal(k, shape, f32) * s
    return {
        "x": nrm(ks[0], (BATCH, SEQ, D), 1.0),
        "c": nrm(ks[1], (BATCH, D), 1.0),
        "rel_bias": nrm(ks[2], (NUM_BUCKETS, N_HEADS), 0.5),
        "w_mod": nrm(ks[3], (DEPTH, D, 6 * D), 0.5 * D ** -0.5),
        "b_mod": nrm(ks[4], (DEPTH, 6 * D), 0.02),
        "norm_mix": 1.0 + nrm(ks[5], (DEPTH, D), 0.02),
        "norm_mlp": 1.0 + nrm(ks[6], (DEPTH, D), 0.02),
        "w_pool": nrm(ks[7], (N_POOL_LAYERS, N_POOL_GROUPS, POOL_GROUP, POOL_GROUP), POOL_GROUP ** -0.5),
        "pool_scale": 1.0 + nrm(ks[8], (N_POOL_LAYERS, D), 0.05),
        "w_qkv": nrm(ks[9], (N_MOBA_LAYERS, D, 3 * D), D ** -0.5),
        "w_o": nrm(ks[10], (N_MOBA_LAYERS, D, D), D ** -0.5),
        "w_up": nrm(ks[11], (DEPTH, D, D_FF), D ** -0.5),
        "w_down": nrm(ks[12], (DEPTH, D_FF, D), D_FF ** -0.5),
        "norm_final": 1.0 + nrm(ks[13], (D,), 0.02),
    }


def reference(x, c, rel_bias, w_mod, b_mod, norm_mix, norm_mlp, w_pool, pool_scale,
              w_qkv, w_o, w_up, w_down, norm_final):
    c_act = jax.nn.silu(c)
    for i in range(DEPTH):
        mod = c_act @ w_mod[i] + b_mod[i]
        sh1, sc1, g1, sh2, sc2, g2 = jnp.split(mod, 6, axis=-1)
        h = modulate(rmsnorm(x, norm_mix[i]), sh1, sc1)
        if i % N_MIXERS == 0:
            y = pool_mixer(h, w_pool[i // N_MIXERS], pool_scale[i // N_MIXERS])
        else:
            y = moba_attention(h, w_qkv[i // N_MIXERS], w_o[i // N_MIXERS], rel_bias)
        x = x + g1[:, None, :] * y
        h = modulate(rmsnorm(x, norm_mlp[i]), sh2, sc2)
        x = x + g2[:, None, :] * squared_relu_mlp(h, w_up[i], w_down[i])
    return rmsnorm(x, norm_final)
```

```cpp
#include <hip/hip_runtime.h>
#include <cstdio>
#include <cstdint>

namespace v1 {
constexpr int B = 4, S = 8192, D = 1024, T = B * S, H = 16, HD = 64, FF = 4096, NBLK = 32, BL = 256;
constexpr float EPS = 1e-6f;

__device__ __forceinline__ float wave_sum(float v) {
#pragma unroll
    for (int o = 1; o < 64; o <<= 1) v += __shfl_xor(v, o);
    return v;
}

__global__ void __launch_bounds__(256) k_mod(const float* __restrict__ c, const float* __restrict__ w_mod, const float* __restrict__ b_mod, float* __restrict__ mod) {
    __shared__ float ca[4][1024];
    const int tid = threadIdx.x, l = blockIdx.y, j = blockIdx.x * 256 + tid;
    for (int i = tid; i < 4096; i += 256) { const float v = c[i]; ca[i >> 10][i & 1023] = v / (1.f + expf(-v)); }
    __syncthreads();
    float a0 = 0.f, a1 = 0.f, a2 = 0.f, a3 = 0.f;
    const float* w = w_mod + (size_t)l * 1024 * 6144 + j;
    for (int k = 0; k < 1024; ++k) { const float wv = w[(size_t)k * 6144]; a0 += ca[0][k] * wv; a1 += ca[1][k] * wv; a2 += ca[2][k] * wv; a3 += ca[3][k] * wv; }
    const float bb = b_mod[l * 6144 + j];
    mod[(l * 4 + 0) * 6144 + j] = a0 + bb; mod[(l * 4 + 1) * 6144 + j] = a1 + bb; mod[(l * 4 + 2) * 6144 + j] = a2 + bb; mod[(l * 4 + 3) * 6144 + j] = a3 + bb;
}

__global__ void __launch_bounds__(256) k_normmod(const float* x, const float* __restrict__ g, const float* __restrict__ modl, int sh_off, int sc_off, float* out) {
    const int lane = threadIdx.x & 63, row = blockIdx.x * 4 + (threadIdx.x >> 6), b = row / S;
    const float4* xr = (const float4*)(x + (size_t)row * D);
    float4 v[4]; float ss = 0.f;
#pragma unroll
    for (int j = 0; j < 4; ++j) { v[j] = xr[lane + 64 * j]; ss += v[j].x * v[j].x + v[j].y * v[j].y + v[j].z * v[j].z + v[j].w * v[j].w; }
    ss = wave_sum(ss);
    const float rstd = rsqrtf(ss * (1.f / D) + EPS);
    float4* o = (float4*)(out + (size_t)row * D);
#pragma unroll
    for (int j = 0; j < 4; ++j) {
        const int c4 = lane + 64 * j; const float4 gg = ((const float4*)g)[c4];
        float4 r; r.x = v[j].x * rstd * gg.x; r.y = v[j].y * rstd * gg.y; r.z = v[j].z * rstd * gg.z; r.w = v[j].w * rstd * gg.w;
        if (modl) { const float4 sh = ((const float4*)(modl + b * 6144 + sh_off))[c4], sc = ((const float4*)(modl + b * 6144 + sc_off))[c4];
            r.x = r.x * (1.f + sc.x) + sh.x; r.y = r.y * (1.f + sc.y) + sh.y; r.z = r.z * (1.f + sc.z) + sh.z; r.w = r.w * (1.f + sc.w) + sh.w; }
        o[c4] = r;
    }
}

__global__ void __launch_bounds__(256) k_pool(const float* __restrict__ h, float* __restrict__ p) {
    const size_t idx = (size_t)blockIdx.x * 256 + threadIdx.x; const int t = (int)(idx >> 8), c4 = (int)(idx & 255);
    const int gi = c4 >> 6, w = 2 << gi, s = t % S, cnt = (s + 1 < w) ? s + 1 : w;
    const float4* hp = (const float4*)h + (size_t)t * 256 + c4;
    const float4 h0 = hp[0]; float4 sum = h0;
    for (int i = 1; i < cnt; ++i) { const float4 v = hp[-(ptrdiff_t)i * 256]; sum.x += v.x; sum.y += v.y; sum.z += v.z; sum.w += v.w; }
    const float inv = 1.f / (float)cnt;
    float4 r; r.x = sum.x * inv - h0.x; r.y = sum.y * inv - h0.y; r.z = sum.z * inv - h0.z; r.w = sum.w * inv - h0.w;
    ((float4*)p)[(size_t)t * 256 + c4] = r;
}

struct GemmP { const float* A; int lda; const float* Bm; int ldb; float* C; int ldc; int K; const float* R; int ldr; const float* gate; const float* cscale; };
template <int EPI>
__global__ void __launch_bounds__(256) k_gemm(GemmP p) {
    __shared__ float As[16][128 + 4];
    __shared__ float Bs[16][128 + 4];
    const int tid = threadIdx.x, tx = tid & 15, ty = tid >> 4;
    const int m0 = blockIdx.y * 128, n0 = blockIdx.x * 128;
    float acc[8][8];
#pragma unroll
    for (int i = 0; i < 8; ++i)
#pragma unroll
        for (int j = 0; j < 8; ++j) acc[i][j] = 0.f;
    for (int k0 = 0; k0 < p.K; k0 += 16) {
#pragma unroll
        for (int i = 0; i < 2; ++i) { const int idx = tid + i * 256, row = idx >> 2, k4 = idx & 3;
            const float4 v = *(const float4*)(p.A + (size_t)(m0 + row) * p.lda + k0 + k4 * 4);
            As[k4 * 4 + 0][row] = v.x; As[k4 * 4 + 1][row] = v.y; As[k4 * 4 + 2][row] = v.z; As[k4 * 4 + 3][row] = v.w; }
#pragma unroll
        for (int i = 0; i < 2; ++i) { const int idx = tid + i * 256, kr = idx >> 5, n4 = idx & 31;
            *(float4*)&Bs[kr][n4 * 4] = *(const float4*)(p.Bm + (size_t)(k0 + kr) * p.ldb + n0 + n4 * 4); }
        __syncthreads();
#pragma unroll
        for (int k = 0; k < 16; ++k) {
            const float4 a0 = *(const float4*)&As[k][ty * 4], a1 = *(const float4*)&As[k][64 + ty * 4];
            const float4 b0 = *(const float4*)&Bs[k][tx * 4], b1 = *(const float4*)&Bs[k][64 + tx * 4];
            const float a[8] = {a0.x, a0.y, a0.z, a0.w, a1.x, a1.y, a1.z, a1.w}, bb[8] = {b0.x, b0.y, b0.z, b0.w, b1.x, b1.y, b1.z, b1.w};
#pragma unroll
            for (int i = 0; i < 8; ++i)
#pragma unroll
                for (int j = 0; j < 8; ++j) acc[i][j] += a[i] * bb[j];
        }
        __syncthreads();
    }
#pragma unroll
    for (int i = 0; i < 8; ++i) {
        const int m = m0 + (i >> 2) * 64 + ty * 4 + (i & 3);
#pragma unroll
        for (int jh = 0; jh < 2; ++jh) {
            const int n = n0 + jh * 64 + tx * 4;
            float4 v = {acc[i][jh * 4 + 0], acc[i][jh * 4 + 1], acc[i][jh * 4 + 2], acc[i][jh * 4 + 3]};
            if (EPI == 1) { v.x = fmaxf(v.x, 0.f); v.y = fmaxf(v.y, 0.f); v.z = fmaxf(v.z, 0.f); v.w = fmaxf(v.w, 0.f); v.x *= v.x; v.y *= v.y; v.z *= v.z; v.w *= v.w; }
            if (EPI == 2) {
                const float4 r = *(const float4*)(p.R + (size_t)m * p.ldr + n), gt = *(const float4*)(p.gate + n);
                float4 cs = {1.f, 1.f, 1.f, 1.f}; if (p.cscale) cs = *(const float4*)(p.cscale + n);
                v.x = r.x + gt.x * (v.x * cs.x); v.y = r.y + gt.y * (v.y * cs.y); v.z = r.z + gt.z * (v.z * cs.z); v.w = r.w + gt.w * (v.w * cs.w);
            }
            *(float4*)(p.C + (size_t)m * p.ldc + n) = v;
        }
    }
}

__device__ __forceinline__ int t5_bucket(int dist) {
    if (dist < 16) return dist;
    const int thr[15] = {21, 27, 35, 46, 59, 77, 99, 128, 166, 216, 280, 363, 470, 609, 790};
    int b = 16;
#pragma unroll
    for (int i = 0; i < 15; ++i) b += (dist >= thr[i]) ? 1 : 0;
    return b;
}

__global__ void __launch_bounds__(64) k_kmean(const float* __restrict__ qkv, float* __restrict__ km) {
    const int n = blockIdx.x, h = blockIdx.y, d = threadIdx.x;
    float s = 0.f;
    for (int r = 0; r < BL; ++r) s += qkv[(size_t)(n * BL + r) * 3072 + 1024 + h * 64 + d];
    km[(h * NBLK + n) * 64 + d] = s * (1.f / BL);
}

__global__ void __launch_bounds__(256) k_attn(const float* __restrict__ qkv, const float* __restrict__ km, const float* __restrict__ rel_bias, float* __restrict__ O) {
    __shared__ float kms[NBLK * 64];
    __shared__ float Ks[64 * 64];
    __shared__ float Vs[64 * 64];
    __shared__ float lut[1024];
    const int own = blockIdx.x, h = blockIdx.y, tid = threadIdx.x, t = own * BL + tid;
    for (int i = tid; i < NBLK * 64; i += 256) kms[i] = km[h * NBLK * 64 + i];
    for (int i = tid; i < 1024; i += 256) lut[i] = rel_bias[t5_bucket(i) * H + h];
    float q[64];
    { const float4* qp = (const float4*)(qkv + (size_t)t * 3072 + h * 64);
#pragma unroll
      for (int i = 0; i < 16; ++i) { const float4 v = qp[i]; q[4 * i] = v.x; q[4 * i + 1] = v.y; q[4 * i + 2] = v.z; q[4 * i + 3] = v.w; } }
    __syncthreads();
    float g1 = -INFINITY, g2 = -INFINITY, g3 = -INFINITY; int i1 = -1, i2 = -1, i3 = -1;
    for (int n = 0; n < own; ++n) {
        float g = 0.f;
#pragma unroll
        for (int d = 0; d < 64; ++d) g += q[d] * kms[n * 64 + d];
        if (g > g1) { g3 = g2; i3 = i2; g2 = g1; i2 = i1; g1 = g; i1 = n; }
        else if (g > g2) { g3 = g2; i3 = i2; g2 = g; i2 = n; }
        else if (g > g3) { g3 = g; i3 = n; }
    }
    unsigned mask = 1u << own;
    if (i1 >= 0) mask |= 1u << i1; if (i2 >= 0) mask |= 1u << i2; if (i3 >= 0) mask |= 1u << i3;
    float o[64];
#pragma unroll
    for (int d = 0; d < 64; ++d) o[d] = 0.f;
    float m = -INFINITY, l = 0.f;
    for (int n = 0; n <= own; ++n) {
        const bool act = (mask >> n) & 1u;
        for (int cc = 0; cc < 4; ++cc) {
            __syncthreads();
            const int k0 = n * BL + cc * 64;
#pragma unroll
            for (int i = 0; i < 4; ++i) { const int idx = tid + i * 256, r = idx >> 4, c4 = idx & 15;
                ((float4*)Ks)[idx] = *(const float4*)(qkv + (size_t)(k0 + r) * 3072 + 1024 + h * 64 + c4 * 4);
                ((float4*)Vs)[idx] = *(const float4*)(qkv + (size_t)(k0 + r) * 3072 + 2048 + h * 64 + c4 * 4); }
            __syncthreads();
            if (act) {
                for (int j = 0; j < 64; ++j) {
                    const int tk = k0 + j;
                    if (tk <= t) {
                        float s = 0.f;
#pragma unroll
                        for (int d4 = 0; d4 < 16; ++d4) { const float4 kv = ((const float4*)Ks)[j * 16 + d4]; s += q[4 * d4] * kv.x + q[4 * d4 + 1] * kv.y + q[4 * d4 + 2] * kv.z + q[4 * d4 + 3] * kv.w; }
                        int dist = t - tk; dist = dist > 1023 ? 1023 : dist;
                        s = s * 0.125f + lut[dist];
                        if (s > m) { const float f = __expf(m - s);
#pragma unroll
                            for (int d = 0; d < 64; ++d) o[d] *= f;
                            l *= f; m = s; }
                        const float pz = __expf(s - m); l += pz;
#pragma unroll
                        for (int d4 = 0; d4 < 16; ++d4) { const float4 vv = ((const float4*)Vs)[j * 16 + d4]; o[4 * d4] += pz * vv.x; o[4 * d4 + 1] += pz * vv.y; o[4 * d4 + 2] += pz * vv.z; o[4 * d4 + 3] += pz * vv.w; }
                    }
                }
            }
        }
    }
    const float inv = 1.f / l;
    float4* op = (float4*)(O + (size_t)t * D + h * 64);
#pragma unroll
    for (int i = 0; i < 16; ++i) { float4 v = {o[4 * i] * inv, o[4 * i + 1] * inv, o[4 * i + 2] * inv, o[4 * i + 3] * inv}; op[i] = v; }
}

template <int EPI> static void gemm(hipStream_t st, int M, int N, const GemmP& p) { hipLaunchKernelGGL(k_gemm<EPI>, dim3(N / 128, M / 128), dim3(256), 0, st, p); }
}

extern "C" void kernel_launch(void* const* d_in, const int* in_sizes, int n_in, void* d_out, int out_size, void* d_ws, size_t ws_size, hipStream_t stream) {
    using namespace v1;
    const float* x = (const float*)d_in[0]; const float* c = (const float*)d_in[1]; const float* rel_bias = (const float*)d_in[2];
    const float* w_mod = (const float*)d_in[3]; const float* b_mod = (const float*)d_in[4]; const float* norm_mix = (const float*)d_in[5];
    const float* norm_mlp = (const float*)d_in[6]; const float* w_pool = (const float*)d_in[7]; const float* pool_scale = (const float*)d_in[8];
    const float* w_qkv = (const float*)d_in[9]; const float* w_o = (const float*)d_in[10]; const float* w_up = (const float*)d_in[11];
    const float* w_down = (const float*)d_in[12]; const float* norm_final = (const float*)d_in[13];
    float* X = (float*)d_out;
    char* ws = (char*)d_ws; const size_t MiB = 1u << 20;
    if (ws_size < 310 * MiB) { fprintf(stderr, "kernel_launch: workspace too small (%zu)\n", ws_size); return; }
    float* MOD = (float*)(ws); float* KM = (float*)(ws + 1 * MiB); float* Hb = (float*)(ws + 16 * MiB); float* P = (float*)(ws + 144 * MiB); float* OB = (float*)(ws + 272 * MiB);

    hipLaunchKernelGGL(k_mod, dim3(24, 2), dim3(256), 0, stream, c, w_mod, b_mod, MOD);
    for (int layer = 0; layer < 2; ++layer) {
        const float* modl = MOD + layer * 4 * 6144;
        hipLaunchKernelGGL(k_normmod, dim3(T / 4), dim3(256), 0, stream, layer == 0 ? x : (const float*)X, norm_mix + layer * D, modl, 0, 1024, Hb);
        if (layer == 0) {
            hipLaunchKernelGGL(k_pool, dim3(T), dim3(256), 0, stream, (const float*)Hb, P);
            for (int b = 0; b < B; ++b)
                for (int g = 0; g < 4; ++g) {
                    GemmP p{P + (size_t)b * S * D + g * 256, D, w_pool + (size_t)g * 256 * 256, 256, X + (size_t)b * S * D + g * 256, D, 256,
                            x + (size_t)b * S * D + g * 256, D, modl + b * 6144 + 2048 + g * 256, pool_scale + g * 256};
                    gemm<2>(stream, S, 256, p);
                }
        } else {
            for (int b = 0; b < B; ++b) {
                GemmP p{Hb + (size_t)b * S * D, D, w_qkv, 3072, P, 3072, D, nullptr, 0, nullptr, nullptr};
                gemm<0>(stream, S, 3072, p);
                hipLaunchKernelGGL(k_kmean, dim3(NBLK, H), dim3(64), 0, stream, (const float*)P, KM);
                hipLaunchKernelGGL(k_attn, dim3(NBLK, H), dim3(256), 0, stream, (const float*)P, (const float*)KM, rel_bias, OB);
                GemmP p2{OB, D, w_o, D, X + (size_t)b * S * D, D, D, X + (size_t)b * S * D, D, modl + b * 6144 + 2048, nullptr};
                gemm<2>(stream, S, D, p2);
            }
        }
        hipLaunchKernelGGL(k_normmod, dim3(T / 4), dim3(256), 0, stream, (const float*)X, norm_mlp + layer * D, modl, 3072, 4096, Hb);
        for (int b = 0; b < B; ++b) {
            GemmP p{Hb + (size_t)b * S * D, D, w_up + (size_t)layer * D * FF, FF, P, FF, D, nullptr, 0, nullptr, nullptr};
            gemm<1>(stream, S, FF, p);
            GemmP p2{P, FF, w_down + (size_t)layer * FF * D, D, X + (size_t)b * S * D, D, FF, X + (size_t)b * S * D, D, modl + b * 6144 + 5120, nullptr};
            gemm<2>(stream, S, D, p2);
        }
    }
    hipLaunchKernelGGL(k_normmod, dim3(T / 4), dim3(256), 0, stream, (const float*)X, norm_final, (const float*)nullptr, 0, 0, X);
}
```

```cpp
#include <hip/hip_runtime.h>
#include <cstdio>
#include <cstdint>

namespace pg8 {
#define PG8_LAS __attribute__((address_space(3)))
#define PG8_GAS __attribute__((address_space(1)))
typedef unsigned short bf16_t;
typedef short bf16x8 __attribute__((ext_vector_type(8)));
typedef float f32x4 __attribute__((ext_vector_type(4)));
typedef unsigned u32x4 __attribute__((ext_vector_type(4)));
constexpr int BM = 256, BK = 64, HALF = 128, HTB = HALF * BK * 2, STAGE_BYTES = 8 * HTB, NXCD = 8, WGM = 8;

__host__ __device__ __forceinline__ int lds_byte(int r, int c) { const int st = (r >> 4) * 2 + (c >> 5), rr = r & 15, cc = c & 31, ob = rr * 64 + cc * 2; return st * 1024 + (ob ^ (((ob >> 9) & 1) << 5)); }
__host__ __device__ __forceinline__ void stage_rc(int b, int& R, int& C) { const int st = b / 1024, sb = b % 1024, swz = sb ^ (((sb >> 9) & 1) << 5); R = (st >> 1) * 16 + swz / 64; C = (st & 1) * 32 + (swz % 64) / 2; }
__host__ __device__ __forceinline__ int perm32(int rho) { const int n = rho >> 4, i = rho & 15; return 8 * (i >> 2) + 4 * n + (i & 3); }

struct Unit { int pm, pn; };
struct Gemm { const PG8_GAS bf16_t* A; const PG8_GAS bf16_t* Bt; int M, N, K, lda, a_pn_off; };

struct StaticOrder {
    int nM, nN, nwg, G, c;
    __host__ __device__ void init(int M, int N, int G_, int c_) { nM = M / BM; nN = N / BM; nwg = nM * nN; G = G_; c = c_; }
    __host__ __device__ bool next(int i, Unit& u) const {
        const long L = (long)i * G + c; if (L >= nwg) return false;
        int wgid = (int)L; { const int q = nwg / NXCD, r = nwg % NXCD, xcd = wgid % NXCD, off = wgid / NXCD; wgid = (xcd < r ? xcd * (q + 1) : r * (q + 1) + (xcd - r) * q) + off; }
        const int nig = WGM * nN, gid = wgid / nig, fm = gid * WGM, gsz = (nM - fm) < WGM ? (nM - fm) : WGM;
        u.pm = fm + ((wgid % nig) % gsz); u.pn = (wgid % nig) / gsz; return true;
    }
};

__device__ __forceinline__ unsigned cvt_pk_bf16(float lo, float hi) { unsigned r; asm volatile("v_cvt_pk_bf16_f32 %0, %1, %2" : "=v"(r) : "v"(lo), "v"(hi)); return r; }

constexpr int SEQ_ = 8192;
constexpr float EPS_ = 1e-6f;
constexpr float C2_ = 0.125f * 1.4426950408889634f;


__device__ __forceinline__ float row_rstd(const PG8_GAS float* SS, int row, int fq) {
    const f32x4 s4 = *(const PG8_GAS f32x4*)(SS + (size_t)row * 16 + 4 * fq);
    float s = (s4[0] + s4[1]) + (s4[2] + s4[3]);
    s += __shfl_xor(s, 16); s += __shfl_xor(s, 32);
    return rsqrtf(s * (1.0f / 1024.0f) + EPS_);
}

struct EpiRes {
    static constexpr bool PERM = true;
    const PG8_GAS float* R; PG8_GAS float* X; const PG8_GAS float* gate; const PG8_GAS float* cscale; const PG8_GAS float* gnext; const PG8_GAS float* scn; PG8_GAS bf16_t* XN; PG8_GAS float* SS;
    __device__ __forceinline__ void operator()(const f32x4 (&acc)[2][2][4][2], const Unit& u, int wr, int wc, int fr, int fq) const {
        const int b = u.pm >> 5, colb = u.pn * BM + wc * 32 + 8 * fq, row0 = u.pm * BM + wr * 64 + fr;
        float ssq[2][4];
#pragma unroll
        for (int bj = 0; bj < 2; ++bj) {
            f32x4 gt[2], cs[2];
#pragma unroll
            for (int n = 0; n < 2; ++n) { const int col = colb + bj * HALF + 4 * n;
                f32x4 gv = *(const PG8_GAS f32x4*)(gate + b * 6144 + col); if (cscale) gv = gv * *(const PG8_GAS f32x4*)(cscale + col); gt[n] = gv;
                if (XN) { const f32x4 sc = *(const PG8_GAS f32x4*)(scn + b * 6144 + col); cs[n] = *(const PG8_GAS f32x4*)(gnext + col) * (sc + 1.0f); } else cs[n] = (f32x4){0.f, 0.f, 0.f, 0.f}; }
#pragma unroll
            for (int ai = 0; ai < 2; ++ai)
#pragma unroll
                for (int m = 0; m < 4; ++m) { const size_t off = (size_t)(row0 + ai * HALF + m * 16) * 1024 + colb + bj * HALF;
                    const f32x4 r0 = *(const PG8_GAS f32x4*)(R + off), r1 = *(const PG8_GAS f32x4*)(R + off + 4);
                    const f32x4 x0 = r0 + gt[0] * acc[ai][bj][m][0], x1 = r1 + gt[1] * acc[ai][bj][m][1];
                    *(PG8_GAS f32x4*)(X + off) = x0; *(PG8_GAS f32x4*)(X + off + 4) = x1;
                    const float q = (x0[0] * x0[0] + x0[1] * x0[1]) + (x0[2] * x0[2] + x0[3] * x0[3]) + (x1[0] * x1[0] + x1[1] * x1[1]) + (x1[2] * x1[2] + x1[3] * x1[3]);
                    ssq[ai][m] = (bj == 0) ? q : ssq[ai][m] + q;
                    if (XN) { const f32x4 a0 = x0 * cs[0], a1 = x1 * cs[1]; u32x4 w; w.x = cvt_pk_bf16(a0[0], a0[1]); w.y = cvt_pk_bf16(a0[2], a0[3]); w.z = cvt_pk_bf16(a1[0], a1[1]); w.w = cvt_pk_bf16(a1[2], a1[3]);
                        *(PG8_GAS u32x4*)(XN + off) = w; }
                }
        }
        if (SS) {
#pragma unroll
            for (int ai = 0; ai < 2; ++ai)
#pragma unroll
                for (int m = 0; m < 4; ++m) { float q = ssq[ai][m]; q += __shfl_xor(q, 16); q += __shfl_xor(q, 32); if (fq == 0) SS[(size_t)(row0 + ai * HALF + m * 16) * 16 + u.pn * 4 + wc] = q; }
        }
    }
};

struct EpiUp {
    static constexpr bool PERM = true;
    const PG8_GAS float* SS; const PG8_GAS float* bias; PG8_GAS bf16_t* O; int ldc;
    __device__ __forceinline__ void operator()(const f32x4 (&acc)[2][2][4][2], const Unit& u, int wr, int wc, int fr, int fq) const {
        const int b = u.pm >> 5, colb = u.pn * BM + wc * 32 + 8 * fq, row0 = u.pm * BM + wr * 64 + fr;
        float rs[2][4];
#pragma unroll
        for (int ai = 0; ai < 2; ++ai)
#pragma unroll
            for (int m = 0; m < 4; ++m) rs[ai][m] = row_rstd(SS, row0 + ai * HALF + m * 16, fq);
#pragma unroll
        for (int bj = 0; bj < 2; ++bj) {
            const f32x4 bv0 = *(const PG8_GAS f32x4*)(bias + (size_t)b * ldc + colb + bj * HALF), bv1 = *(const PG8_GAS f32x4*)(bias + (size_t)b * ldc + colb + bj * HALF + 4);
#pragma unroll
            for (int ai = 0; ai < 2; ++ai)
#pragma unroll
                for (int m = 0; m < 4; ++m) { f32x4 v0 = acc[ai][bj][m][0] * rs[ai][m] + bv0, v1 = acc[ai][bj][m][1] * rs[ai][m] + bv1;
#pragma unroll
                    for (int j = 0; j < 4; ++j) { v0[j] = fmaxf(v0[j], 0.f); v1[j] = fmaxf(v1[j], 0.f); }
                    v0 = v0 * v0; v1 = v1 * v1;
                    u32x4 w; w.x = cvt_pk_bf16(v0[0], v0[1]); w.y = cvt_pk_bf16(v0[2], v0[3]); w.z = cvt_pk_bf16(v1[0], v1[1]); w.w = cvt_pk_bf16(v1[2], v1[3]);
                    *(PG8_GAS u32x4*)(O + (size_t)(row0 + ai * HALF + m * 16) * ldc + colb + bj * HALF) = w; }
        }
    }
};

struct EpiQKV {
    static constexpr bool PERM = true;
    const PG8_GAS float* SS; const PG8_GAS float* bias; PG8_GAS bf16_t* Q; size_t split_stride; PG8_GAS float* KMP;
    __device__ __forceinline__ void operator()(const f32x4 (&acc)[2][2][4][2], const Unit& u, int wr, int wc, int fr, int fq) const {
        const int b = u.pm >> 5, t = u.pn >> 2, colt = (u.pn & 3) * BM + wc * 32 + 8 * fq, colb = u.pn * BM + wc * 32 + 8 * fq, row0 = u.pm * BM + wr * 64 + fr;
        PG8_GAS bf16_t* base = Q + (size_t)t * split_stride; const float sc = (t == 0) ? C2_ : 1.0f;
        float rs[2][4];
#pragma unroll
        for (int ai = 0; ai < 2; ++ai)
#pragma unroll
            for (int m = 0; m < 4; ++m) rs[ai][m] = row_rstd(SS, row0 + ai * HALF + m * 16, fq);
#pragma unroll
        for (int bj = 0; bj < 2; ++bj) {
            const f32x4 bv0 = *(const PG8_GAS f32x4*)(bias + (size_t)b * 3072 + colb + bj * HALF), bv1 = *(const PG8_GAS f32x4*)(bias + (size_t)b * 3072 + colb + bj * HALF + 4);
            f32x4 cs0 = {0.f, 0.f, 0.f, 0.f}, cs1 = cs0;
#pragma unroll
            for (int ai = 0; ai < 2; ++ai)
#pragma unroll
                for (int m = 0; m < 4; ++m) { f32x4 v0 = acc[ai][bj][m][0] * rs[ai][m] + bv0, v1 = acc[ai][bj][m][1] * rs[ai][m] + bv1;
                    cs0 += v0; cs1 += v1; v0 = v0 * sc; v1 = v1 * sc;
                    u32x4 w; w.x = cvt_pk_bf16(v0[0], v0[1]); w.y = cvt_pk_bf16(v0[2], v0[3]); w.z = cvt_pk_bf16(v1[0], v1[1]); w.w = cvt_pk_bf16(v1[2], v1[3]);
                    *(PG8_GAS u32x4*)(base + (size_t)(row0 + ai * HALF + m * 16) * 1024 + colt + bj * HALF) = w; }
            if (t == 1) {
#pragma unroll
                for (int o = 1; o < 16; o <<= 1) {
#pragma unroll
                    for (int j = 0; j < 4; ++j) { cs0[j] += __shfl_xor(cs0[j], o); cs1[j] += __shfl_xor(cs1[j], o); } }
                if (fr == 0) { PG8_GAS float* kp = KMP + ((size_t)u.pm * 2 + wr) * 1024 + colt + bj * HALF; *(f32x4*)kp = cs0; *(PG8_GAS f32x4*)(kp + 4) = cs1; }
            }
        }
    }
};

template <class Epi, class Sched, bool ALIGN_EPI>
__device__ __forceinline__ void gemm_phase(PG8_LAS unsigned char* lds, const Gemm g, const Sched& S, const Epi& E) {
    int tid = threadIdx.x; asm volatile("" : "+v"(tid));
    const int wid = __builtin_amdgcn_readfirstlane(tid >> 6), lane = tid & 63, wr = wid >> 2, wc = wid & 3, fr = lane & 15, fq = lane >> 4;
    const int K = g.K, nt = K / BK, lda = g.lda;
    unsigned voffA[2], voffB[2];
#pragma unroll
    for (int i = 0; i < 2; ++i) { int R, C; stage_rc(tid * 16 + i * 8192, R, C); const int Rb = Epi::PERM ? ((R & ~31) + perm32(R & 31)) : R;
        voffA[i] = (unsigned)(R * lda + C) * 2u; voffB[i] = (unsigned)(Rb * K + C) * 2u; }
    const size_t kstep = (size_t)(BK * 2);
    const size_t hstepA = (size_t)HALF * lda * 2, tstepA = 2 * hstepA, hstepB = (size_t)HALF * K * 2, tstepB = 2 * hstepB;
    const unsigned ldsw = (unsigned)wid * 1024u;
    const int aoff = lds_byte(wr * 64 + fr, fq * 8), boff = lds_byte(wc * 32 + fr, fq * 8);
#define PG8_SA(b, h) (((b) * 2 + (h)) * HTB)
#define PG8_SB(b, h) ((4 + (b) * 2 + (h)) * HTB)
#define PG8_STAGE(bufoff, gbase, voff) do { _Pragma("unroll") for (int _i = 0; _i < 2; ++_i) \
        __builtin_amdgcn_global_load_lds((const PG8_GAS unsigned*)((const PG8_GAS char*)(gbase) + (voff)[_i]), (PG8_LAS unsigned*)(lds + (bufoff) + ldsw + _i * 8192), 16, 0, 0); } while (0)
#define PG8_LDA(dst, b, h) do { _Pragma("unroll") for (int m = 0; m < 4; ++m) _Pragma("unroll") for (int k = 0; k < 2; ++k) dst[m][k] = *(const PG8_LAS bf16x8*)(lds + PG8_SA(b, h) + aoff + m * 2048 + k * 1024); } while (0)
#define PG8_LDB(dst, b, h) do { _Pragma("unroll") for (int n = 0; n < 2; ++n) _Pragma("unroll") for (int k = 0; k < 2; ++k) dst[n][k] = *(const PG8_LAS bf16x8*)(lds + PG8_SB(b, h) + boff + n * 2048 + k * 1024); } while (0)
#define PG8_MMA(ai, bj, At, Bt) do { __builtin_amdgcn_s_setprio(1); _Pragma("unroll") for (int m = 0; m < 4; ++m) _Pragma("unroll") for (int n = 0; n < 2; ++n) _Pragma("unroll") for (int k = 0; k < 2; ++k) \
        acc[ai][bj][m][n] = __builtin_amdgcn_mfma_f32_16x16x32_bf16(Bt[n][k], At[m][k], acc[ai][bj][m][n], 0, 0, 0); __builtin_amdgcn_s_setprio(0); } while (0)
#define PG8_WAIT_V(n) asm volatile("s_waitcnt vmcnt(" #n ")" ::: "memory")
#define PG8_WAIT_L(n) asm volatile("s_waitcnt lgkmcnt(" #n ")" ::: "memory")
#define PG8_BAR __builtin_amdgcn_s_barrier()
#define PG8_SCHED __builtin_amdgcn_sched_barrier(0)
    Unit cur, nxt; int ui = 0;
    if (!S.next(0, cur)) return;
    f32x4 acc[2][2][4][2];
#pragma unroll
    for (int a = 0; a < 2; ++a)
#pragma unroll
        for (int b = 0; b < 2; ++b)
#pragma unroll
            for (int m = 0; m < 4; ++m)
#pragma unroll
                for (int n = 0; n < 2; ++n) acc[a][b][m][n] = (f32x4){0.f, 0.f, 0.f, 0.f};
    bf16x8 At[4][2], B0[2][2], B1[2][2];
    const PG8_GAS char* cA = (const PG8_GAS char*)g.A + (size_t)cur.pm * tstepA + (size_t)cur.pn * g.a_pn_off * 2; const PG8_GAS char* cB = (const PG8_GAS char*)g.Bt + (size_t)cur.pn * tstepB;
    PG8_STAGE(PG8_SB(0, 0), cB, voffB); PG8_STAGE(PG8_SB(0, 1), cB + hstepB, voffB); PG8_STAGE(PG8_SA(0, 0), cA, voffA); PG8_STAGE(PG8_SA(0, 1), cA + hstepA, voffA);
    if (wr == 1) PG8_BAR;
    PG8_WAIT_V(2); PG8_BAR;
    PG8_STAGE(PG8_SB(1, 0), cB + kstep, voffB); PG8_STAGE(PG8_SA(1, 0), cA + kstep, voffA); PG8_STAGE(PG8_SB(1, 1), cB + hstepB + kstep, voffB);
    PG8_WAIT_V(6); PG8_BAR;
    for (;;) {
        const bool has_next = S.next(ui + 1, nxt);
        const PG8_GAS char* nA = has_next ? (const PG8_GAS char*)g.A + (size_t)nxt.pm * tstepA + (size_t)nxt.pn * g.a_pn_off * 2 : cA; const PG8_GAS char* nB = has_next ? (const PG8_GAS char*)g.Bt + (size_t)nxt.pn * tstepB : cB;
        for (int t = 0; t < nt; t += 2) {
            const bool last = (t == nt - 2);
            const PG8_GAS char* a1 = cA + (size_t)(t + 1) * kstep;
            const PG8_GAS char* a2 = last ? nA : cA + (size_t)(t + 2) * kstep; const PG8_GAS char* b2 = last ? nB : cB + (size_t)(t + 2) * kstep;
            const PG8_GAS char* a3 = a2 + kstep; const PG8_GAS char* b3 = b2 + kstep;
            PG8_LDB(B0, 0, 0); PG8_LDB(B1, 0, 1); PG8_SCHED; PG8_LDA(At, 0, 0); PG8_STAGE(PG8_SA(1, 1), a1 + hstepA, voffA);
            PG8_WAIT_V(8); PG8_WAIT_L(0); PG8_BAR; PG8_MMA(0, 0, At, B0); PG8_MMA(0, 1, At, B1); PG8_BAR; PG8_SCHED;
            PG8_LDA(At, 0, 1); PG8_STAGE(PG8_SB(0, 0), b2, voffB); PG8_STAGE(PG8_SB(0, 1), b2 + hstepB, voffB); PG8_STAGE(PG8_SA(0, 0), a2, voffA);
            PG8_WAIT_V(8); PG8_WAIT_L(0); PG8_BAR; PG8_MMA(1, 0, At, B0); PG8_MMA(1, 1, At, B1); PG8_BAR; PG8_SCHED;
            PG8_LDB(B0, 1, 0); PG8_LDB(B1, 1, 1); PG8_SCHED; PG8_LDA(At, 1, 0); PG8_STAGE(PG8_SA(0, 1), a2 + hstepA, voffA);
            PG8_WAIT_V(8); PG8_WAIT_L(0); PG8_BAR; PG8_MMA(0, 0, At, B0); PG8_MMA(0, 1, At, B1); PG8_BAR; PG8_SCHED;
            PG8_LDA(At, 1, 1); PG8_STAGE(PG8_SB(1, 0), b3, voffB); PG8_STAGE(PG8_SB(1, 1), b3 + hstepB, voffB); PG8_STAGE(PG8_SA(1, 0), a3, voffA);
            PG8_WAIT_V(8); PG8_WAIT_L(0); PG8_BAR; PG8_MMA(1, 0, At, B0); PG8_MMA(1, 1, At, B1); PG8_BAR; PG8_SCHED;
        }
        if constexpr (ALIGN_EPI) { if (wr == 0) PG8_BAR; }
        E(acc, cur, wr, wc, fr, fq);
        if (!has_next) break;
#pragma unroll
        for (int a = 0; a < 2; ++a)
#pragma unroll
            for (int b = 0; b < 2; ++b)
#pragma unroll
                for (int m = 0; m < 4; ++m)
#pragma unroll
                    for (int n = 0; n < 2; ++n) acc[a][b][m][n] = (f32x4){0.f, 0.f, 0.f, 0.f};
        cur = nxt; cA = nA; cB = nB; ++ui;
        if constexpr (ALIGN_EPI) { if (wr == 1) PG8_BAR; }
    }
    PG8_WAIT_V(0);
    if constexpr (!ALIGN_EPI) { if (wr == 0) PG8_BAR; }
    PG8_BAR;
#undef PG8_SA
#undef PG8_SB
#undef PG8_STAGE
#undef PG8_LDA
#undef PG8_LDB
#undef PG8_MMA
#undef PG8_WAIT_V
#undef PG8_WAIT_L
#undef PG8_BAR
#undef PG8_SCHED
}
}

constexpr int NWAVES = 8;
constexpr int BATCH = 4, SEQ = 8192, D = 1024, NH = 16, HD = 64, FF = 4096, M = BATCH * SEQ, NQKV = 3 * D, NBLK = 32, BLK = 256;
constexpr float EPS = 1e-6f;
constexpr float LOG2E = 1.4426950408889634f;

constexpr size_t MiB = 1u << 20;
constexpr size_t WS_CTL = 0, CTL_ZERO_BYTES = 1 * MiB;
constexpr size_t WS_MOD = 1 * MiB;
constexpr size_t WS_BIAS_UP0 = WS_MOD + 256 * 1024;
constexpr size_t WS_BIAS_QKV = WS_BIAS_UP0 + 64 * 1024;
constexpr size_t WS_BIAS_UP1 = WS_BIAS_QKV + 64 * 1024;
constexpr size_t WS_KMP = 2 * MiB;
constexpr size_t WS_SS = 3 * MiB;
constexpr size_t WS_WPOOL = 6 * MiB, WS_WQKV = 8 * MiB, WS_WO = 14 * MiB, WS_WUP0 = 16 * MiB, WS_WUP1 = 24 * MiB, WS_WDN0 = 32 * MiB, WS_WDN1 = 40 * MiB;
constexpr size_t WS_XNA = 48 * MiB, WS_XNB = 112 * MiB;
constexpr size_t WS_HB = 176 * MiB;
constexpr size_t WS_Q = 176 * MiB, WS_K = 240 * MiB, WS_V = 304 * MiB;
constexpr size_t WS_END = 432 * MiB;
constexpr int CW_BAR = 4096;

constexpr int RING_OFF = 0, RING_BYTES = 131072;
constexpr int LDSCTL_OFF = RING_BYTES, MISC_OFF = LDSCTL_OFF + 320;
constexpr int LDS_BYTES = 147456;

#define GAS __attribute__((address_space(1)))
#define LAS __attribute__((address_space(3)))
typedef unsigned short bf16;
typedef unsigned v4u __attribute__((ext_vector_type(4)));
typedef unsigned v2u __attribute__((ext_vector_type(2)));
typedef float f32x4 __attribute__((ext_vector_type(4)));
typedef GAS unsigned gu32;
#define RLX_AGENT __ATOMIC_RELAXED, __HIP_MEMORY_SCOPE_AGENT
#define LDS_WAIT() asm volatile("s_waitcnt lgkmcnt(0)" ::: "memory")
__device__ __forceinline__ unsigned f2bf(float f) { unsigned u = __builtin_bit_cast(unsigned, f); return (u + 0x7fffu + ((u >> 16) & 1u)) >> 16; }
__device__ __forceinline__ unsigned pk2(float lo, float hi) { return f2bf(lo) | (f2bf(hi) << 16); }
__device__ __forceinline__ float bf2f(unsigned short v) { return __builtin_bit_cast(float, (unsigned)v << 16); }

#define XB_TMO      128
#define XB_XCNT(j)  (256  + 64 * (j))
#define XB_XSUB(j)  (1280 + 64 * (j))
#define XB_XGEN(j)  (2304 + 64 * (j))
#define XB_TOP      3328
#define XB_TOPGEN   3392
#define XCD_BAR_WORDS 3456
#define XB_SPIN_CAP (1u << 18)
__device__ __forceinline__ unsigned xb_ld(GAS unsigned* p)              { return __hip_atomic_load(p, __ATOMIC_RELAXED, __HIP_MEMORY_SCOPE_AGENT); }
__device__ __forceinline__ unsigned xb_add(GAS unsigned* p, unsigned v) { return __hip_atomic_fetch_add(p, v, __ATOMIC_RELAXED, __HIP_MEMORY_SCOPE_AGENT); }
__device__ __forceinline__ unsigned xb_xcc_id() { return (unsigned)__builtin_amdgcn_s_getreg((3 << 11) | 20) & 0xFu; }
#define XB_SPIN(cond, bar) do { unsigned _sp = 0; while (cond) { __builtin_amdgcn_s_sleep(1); \
    if ((++_sp & 255u) == 0u) { if (xb_ld(&(bar)[XB_TMO])) break; if (_sp > XB_SPIN_CAP) { (void)xb_add(&(bar)[XB_TMO], 1u); break; } } } } while (0)
struct XcdBarrier { GAS unsigned* bar; unsigned x; volatile LAS unsigned* st; };
__device__ __forceinline__ XcdBarrier xcd_barrier_post(GAS unsigned* bar, volatile LAS unsigned* st) {
    XcdBarrier b; b.bar = bar; b.x = xb_xcc_id(); b.st = st;
    if (threadIdx.x == 0) (void)xb_add(&bar[XB_XCNT(b.x)], 1u);
    return b;
}
__device__ __forceinline__ void xcd_barrier_complete(GAS unsigned* bar, unsigned x, unsigned& nloc, unsigned& nx) {
    const unsigned G = gridDim.x * gridDim.y * gridDim.z;
    unsigned sum, cnt, mine, sp = 0u;
    for (;;) {
        sum = 0u; cnt = 0u; mine = 0u;
#pragma unroll
        for (unsigned j = 0; j < 16; ++j) { const unsigned c = xb_ld(&bar[XB_XCNT(j)]); sum += c; cnt += (c > 0u) ? 1u : 0u; mine = (j == x) ? c : mine; }
        if (sum == G) break;
        __builtin_amdgcn_s_sleep(1);
        if ((++sp & 255u) == 0u) { if (xb_ld(&bar[XB_TMO])) break; if (sp > XB_SPIN_CAP) { (void)xb_add(&bar[XB_TMO], 1u); break; } }
    }
    nloc = mine > 0u ? mine : 1u; nx = cnt > 0u ? cnt : 1u;
}
__device__ __forceinline__ void xcd_barrier(const XcdBarrier& b) {
    asm volatile("s_waitcnt vmcnt(0)" ::: "memory");
    __syncthreads();
    if (threadIdx.x == 0) {
        GAS unsigned* bar = b.bar; asm volatile("" : "+s"(bar));
        __builtin_amdgcn_s_waitcnt(0);
        unsigned nloc = b.st[0], nx = b.st[1];
        if (nloc == 0u) { xcd_barrier_complete(bar, b.x, nloc, nx); b.st[0] = nloc; b.st[1] = nx; }
        const unsigned old = xb_add(&bar[XB_XSUB(b.x)], 1u);
        const unsigned gen = old / nloc;
        if (old + 1u == (gen + 1u) * nloc) {
            __builtin_amdgcn_fence(__ATOMIC_RELEASE, "agent");
            asm volatile("s_waitcnt vmcnt(0)" ::: "memory");
            const unsigned og = xb_add(&bar[XB_TOP], 1u);
            const unsigned tg = og / nx;
            if (og + 1u == (tg + 1u) * nx) xb_add(&bar[XB_TOPGEN], 1u);
            else XB_SPIN(xb_ld(&bar[XB_TOPGEN]) == tg, bar);
            __builtin_amdgcn_fence(__ATOMIC_ACQUIRE, "agent");
            xb_add(&bar[XB_XGEN(b.x)], 1u);
            asm volatile("s_waitcnt vmcnt(0)" ::: "memory");
        } else {
            XB_SPIN(xb_ld(&bar[XB_XGEN(b.x)]) == gen, bar);
            __builtin_amdgcn_fence(__ATOMIC_ACQUIRE, "agent");
            asm volatile("s_waitcnt vmcnt(0)" ::: "memory");
        }
    }
    __syncthreads();
}

struct Args { const GAS float* in[14]; GAS float* out; GAS unsigned char* ws; };
struct Frame {
    LAS unsigned char* lds; int tid, lane, wave, vcu, G;
    const GAS float *x, *c, *rel_bias, *w_mod, *b_mod, *norm_mix, *norm_mlp, *w_pool, *pool_scale, *w_qkv, *w_o, *w_up, *w_down, *norm_final;
    GAS float* out; GAS unsigned char* ws;
};
__device__ __forceinline__ float wave_sum(float v) {
#pragma unroll
    for (int o = 1; o < 64; o <<= 1) v += __shfl_xor(v, o);
    return v;
}

__device__ __forceinline__ void p0_transpose_item(const GAS float* W, int K, int N, GAS bf16* WT, int row_off, LAS float* scr, int item, int lane) {
    const int nblk = N / 32, kb = item / nblk, nb = item % nblk, k0 = 64 * kb, n0 = 32 * nb;
#pragma unroll 8
    for (int i = 0; i < 32; ++i) { const int kk = 2 * i + (lane >> 5); scr[kk * 33 + (lane & 31)] = W[(size_t)(k0 + kk) * N + n0 + (lane & 31)]; }
    LDS_WAIT(); asm volatile("" ::: "memory");
    const int c = lane & 7;
#pragma unroll
    for (int j = 0; j < 4; ++j) { const int n = (lane >> 3) + 8 * j; const LAS float* s = scr + (8 * c) * 33 + n;
        v4u o; o.x = pk2(s[0 * 33], s[1 * 33]); o.y = pk2(s[2 * 33], s[3 * 33]); o.z = pk2(s[4 * 33], s[5 * 33]); o.w = pk2(s[6 * 33], s[7 * 33]);
        *(GAS v4u*)(WT + (size_t)(row_off + n0 + n) * K + k0 + 8 * c) = o; }
    LDS_WAIT(); asm volatile("" ::: "memory");
}
__device__ __forceinline__ void p0_prologue(Frame& F) {
    if (F.vcu < 192) {
        LAS float* cact = (LAS float*)(F.lds + 67584);
        LAS float* red = (LAS float*)(F.lds + 67584 + 16384);
        const int l = F.vcu / 96, j0 = (F.vcu % 96) * 64;
        for (int i = F.tid; i < 4096; i += NWAVES * 64) { const float v = F.c[i]; cact[i] = v / (1.f + __expf(-v)); }
        __syncthreads();
        const int sub = F.lane >> 4, c4 = F.lane & 15;
        f32x4 a0 = {0.f, 0.f, 0.f, 0.f}, a1 = a0, a2 = a0, a3 = a0;
        const GAS float* wb = F.w_mod + (size_t)l * 1024 * 6144 + j0 + 4 * c4;
#pragma unroll 4
        for (int it = 0; it < 32; ++it) { const int k = 32 * it + 4 * F.wave + sub; const f32x4 wv = *(const GAS f32x4*)(wb + (size_t)k * 6144);
            a0 += wv * cact[k]; a1 += wv * cact[1024 + k]; a2 += wv * cact[2048 + k]; a3 += wv * cact[3072 + k]; }
#pragma unroll
        for (int j = 0; j < 4; ++j) { a0[j] += __shfl_xor(a0[j], 16); a0[j] += __shfl_xor(a0[j], 32); a1[j] += __shfl_xor(a1[j], 16); a1[j] += __shfl_xor(a1[j], 32);
            a2[j] += __shfl_xor(a2[j], 16); a2[j] += __shfl_xor(a2[j], 32); a3[j] += __shfl_xor(a3[j], 16); a3[j] += __shfl_xor(a3[j], 32); }
        if (sub == 0) { LAS f32x4* r4 = (LAS f32x4*)(red + F.wave * 256); r4[0 * 16 + c4] = a0; r4[1 * 16 + c4] = a1; r4[2 * 16 + c4] = a2; r4[3 * 16 + c4] = a3; }
        __syncthreads();
        if (F.tid < 256) { const int b = F.tid >> 6, col = F.tid & 63; float s = 0.f;
#pragma unroll
            for (int w = 0; w < 8; ++w) s += red[w * 256 + b * 64 + col];
            ((GAS float*)(F.ws + WS_MOD))[(l * 4 + b) * 6144 + j0 + col] = s + F.b_mod[l * 6144 + j0 + col]; }
    }
    LAS float* scr = (LAS float*)(F.lds + RING_OFF + F.wave * 8448);
    const int gw = F.vcu * NWAVES + F.wave, NGW = F.G * NWAVES;
    constexpr int I_POOL = 4 * 32, I_QKV = 16 * 96, I_O = 16 * 32, I_UP = 16 * 128, I_DN = 64 * 32;
    constexpr int NITEMS = I_POOL + I_QKV + I_O + 2 * I_UP + 2 * I_DN;
    for (int it = gw; it < NITEMS; it += NGW) {
        int r = it;
        if (r < I_POOL) { const int g = r / 32; p0_transpose_item(F.w_pool + (size_t)g * 65536, 256, 256, (GAS bf16*)(F.ws + WS_WPOOL), g * 256, scr, r % 32, F.lane); continue; } r -= I_POOL;
        if (r < I_QKV) { p0_transpose_item(F.w_qkv, D, NQKV, (GAS bf16*)(F.ws + WS_WQKV), 0, scr, r, F.lane); continue; } r -= I_QKV;
        if (r < I_O) { p0_transpose_item(F.w_o, D, D, (GAS bf16*)(F.ws + WS_WO), 0, scr, r, F.lane); continue; } r -= I_O;
        if (r < 2 * I_UP) { const int l = r / I_UP; p0_transpose_item(F.w_up + (size_t)l * D * FF, D, FF, (GAS bf16*)(F.ws + (l ? WS_WUP1 : WS_WUP0)), 0, scr, r % I_UP, F.lane); continue; } r -= 2 * I_UP;
        { const int l = r / I_DN; p0_transpose_item(F.w_down + (size_t)l * FF * D, FF, D, (GAS bf16*)(F.ws + (l ? WS_WDN1 : WS_WDN0)), 0, scr, r % I_DN, F.lane); }
    }
}

__device__ __forceinline__ void p1_bias(Frame& F) {
    const int gw = F.vcu * NWAVES + F.wave, NGW = F.G * NWAVES;
    const GAS float* MOD = (const GAS float*)(F.ws + WS_MOD);
    for (int it = gw; it < 4096 + 3072 + 4096; it += NGW) {
        const GAS bf16* wt; const GAS float* sh; GAS float* dst; int n, N;
        if (it < 4096) { n = it; N = 4096; wt = (const GAS bf16*)(F.ws + WS_WUP0); sh = MOD + 3072; dst = (GAS float*)(F.ws + WS_BIAS_UP0); }
        else if (it < 4096 + 3072) { n = it - 4096; N = 3072; wt = (const GAS bf16*)(F.ws + WS_WQKV); sh = MOD + 4 * 6144; dst = (GAS float*)(F.ws + WS_BIAS_QKV); }
        else { n = it - 7168; N = 4096; wt = (const GAS bf16*)(F.ws + WS_WUP1); sh = MOD + 4 * 6144 + 3072; dst = (GAS float*)(F.ws + WS_BIAS_UP1); }
        const v4u w0 = *(const GAS v4u*)(wt + (size_t)n * 1024 + F.lane * 16), w1 = *(const GAS v4u*)(wt + (size_t)n * 1024 + F.lane * 16 + 8);
        float wf[16];
#pragma unroll
        for (int j = 0; j < 4; ++j) { wf[2 * j] = __builtin_bit_cast(float, w0[j] << 16); wf[2 * j + 1] = __builtin_bit_cast(float, w0[j] & 0xffff0000u);
            wf[8 + 2 * j] = __builtin_bit_cast(float, w1[j] << 16); wf[8 + 2 * j + 1] = __builtin_bit_cast(float, w1[j] & 0xffff0000u); }
#pragma unroll
        for (int b = 0; b < 4; ++b) { const GAS f32x4* sp = (const GAS f32x4*)(sh + b * 6144 + F.lane * 16); float s = 0.f;
#pragma unroll
            for (int j = 0; j < 4; ++j) { const f32x4 sv = sp[j]; s += wf[4 * j] * sv[0] + wf[4 * j + 1] * sv[1] + wf[4 * j + 2] * sv[2] + wf[4 * j + 3] * sv[3]; }
            s = wave_sum(s); if (F.lane == 0) dst[b * N + n] = s; }
    }
}
__device__ __forceinline__ void p1_pool(Frame& F) {
    LAS float* ring = (LAS float*)(F.lds + RING_OFF);
    const GAS float* MOD = (const GAS float*)(F.ws + WS_MOD); GAS bf16* XN = (GAS bf16*)(F.ws + WS_XNA);
    for (int run = F.vcu; run < M / 128; run += F.G) {
        const int t0 = run * 128, s0 = t0 % SEQ, b = t0 / SEQ;
        f32x4 gam[4];
#pragma unroll
        for (int j = 0; j < 4; ++j) gam[j] = *(const GAS f32x4*)(F.norm_mix + 4 * (F.lane + 64 * j));
        const int c4 = F.tid & 255, rh = F.tid >> 8, gi = c4 >> 6, w = 2 << gi;
        const f32x4 sc1 = *(const GAS f32x4*)(MOD + b * 6144 + 1024 + 4 * c4) + 1.0f;
        for (int st = (s0 > 0 ? -1 : 0); st < 8; ++st) {
#pragma unroll
            for (int rr = 0; rr < 2; ++rr) { const int s = s0 + 16 * st + 2 * F.wave + rr; const GAS float* xr = F.x + ((size_t)b * SEQ + s) * D;
                f32x4 v[4]; float ss = 0.f;
#pragma unroll
                for (int j = 0; j < 4; ++j) { v[j] = *(const GAS f32x4*)(xr + 4 * (F.lane + 64 * j)); ss += (v[j][0] * v[j][0] + v[j][1] * v[j][1]) + (v[j][2] * v[j][2] + v[j][3] * v[j][3]); }
                const float rstd = rsqrtf(wave_sum(ss) * (1.0f / D) + EPS);
#pragma unroll
                for (int j = 0; j < 4; ++j) *(LAS f32x4*)(ring + (s & 31) * 1024 + 4 * (F.lane + 64 * j)) = v[j] * rstd * gam[j]; }
            __syncthreads();
            if (st >= 0) {
                const int sA = s0 + 16 * st + 8 * rh;
                f32x4 sum = {0.f, 0.f, 0.f, 0.f};
                { const int cnt0 = (sA < w) ? sA : w; for (int i = 1; i <= cnt0; ++i) sum += *(const LAS f32x4*)(ring + ((sA - i) & 31) * 1024 + 4 * c4); }
#pragma unroll
                for (int r = 0; r < 8; ++r) { const int s = sA + r; const f32x4 cur = *(const LAS f32x4*)(ring + (s & 31) * 1024 + 4 * c4);
                    sum += cur; if (s >= w) sum -= *(const LAS f32x4*)(ring + ((s - w) & 31) * 1024 + 4 * c4);
                    const float inv = 1.0f / (float)((s + 1 < w) ? s + 1 : w);
                    const f32x4 p = (sum * inv - cur) * sc1;
                    v2u o; o.x = pk2(p[0], p[1]); o.y = pk2(p[2], p[3]);
                    *(GAS v2u*)(XN + ((size_t)b * SEQ + s) * D + 4 * c4) = o; }
            }
            __syncthreads();
        }
    }
}

__device__ __forceinline__ int t5_bucket(int dist) {
    if (dist < 16) return dist;
    int b = 16;
    b += (dist >= 21); b += (dist >= 27); b += (dist >= 35); b += (dist >= 46); b += (dist >= 59); b += (dist >= 77); b += (dist >= 99); b += (dist >= 128);
    b += (dist >= 166); b += (dist >= 216); b += (dist >= 280); b += (dist >= 363); b += (dist >= 470); b += (dist >= 609); b += (dist >= 790);
    return b;
}
__device__ __forceinline__ void attn_naive(Frame& F) {
    LAS float* kms = (LAS float*)(F.lds);
    LAS float* Ks = (LAS float*)(F.lds + 8192);
    LAS float* Vs = (LAS float*)(F.lds + 8192 + 16384);
    LAS float* lut = (LAS float*)(F.lds + 8192 + 32768);
    const GAS bf16* Qb = (const GAS bf16*)(F.ws + WS_Q); const GAS bf16* Kb = (const GAS bf16*)(F.ws + WS_K); const GAS bf16* Vb = (const GAS bf16*)(F.ws + WS_V); GAS bf16* Ob = (GAS bf16*)(F.ws + WS_Q);
    const GAS float* KMP = (const GAS float*)(F.ws + WS_KMP);
    int tid = F.tid; asm volatile("" : "+v"(tid));
    for (int id = F.vcu; id < BATCH * NH * NBLK; id += F.G) {
        const int own = id >> 6, bh = id & 63, b = bh >> 4, h = bh & 15;
        __syncthreads();
        for (int i = tid; i < NBLK * 64; i += 512) { const int n = i >> 6, d = i & 63; const size_t o = ((size_t)(b * 32 + n) * 2) * 1024 + h * 64 + d; kms[i] = (KMP[o] + KMP[o + 1024]) * (1.0f / 256.0f); }
        for (int i = tid; i < 1024; i += 512) lut[i] = F.rel_bias[t5_bucket(i) * NH + h] * LOG2E;
        const int tq = own * BLK + (tid & 255);
        float q[64];
        { const GAS v4u* qp = (const GAS v4u*)(Qb + ((size_t)b * SEQ + tq) * D + h * 64);
#pragma unroll
          for (int i = 0; i < 8; ++i) { const v4u v = qp[i];
#pragma unroll
              for (int j = 0; j < 4; ++j) { q[8 * i + 2 * j] = __builtin_bit_cast(float, v[j] << 16); q[8 * i + 2 * j + 1] = __builtin_bit_cast(float, v[j] & 0xffff0000u); } } }
        __syncthreads();
        float g1 = -INFINITY, g2 = -INFINITY, g3 = -INFINITY; int i1 = -1, i2 = -1, i3 = -1;
        for (int n = 0; n < own; ++n) {
            float g = 0.f;
#pragma unroll
            for (int d = 0; d < 64; ++d) g += q[d] * kms[n * 64 + d];
            if (g > g1) { g3 = g2; i3 = i2; g2 = g1; i2 = i1; g1 = g; i1 = n; }
            else if (g > g2) { g3 = g2; i3 = i2; g2 = g; i2 = n; }
            else if (g > g3) { g3 = g; i3 = n; }
        }
        unsigned mask = 1u << own;
        if (i1 >= 0) mask |= 1u << i1; if (i2 >= 0) mask |= 1u << i2; if (i3 >= 0) mask |= 1u << i3;
        if (tid >= 256) mask = 0u;
        float o[64];
#pragma unroll
        for (int d = 0; d < 64; ++d) o[d] = 0.f;
        float m = -INFINITY, l = 0.f;
        for (int n = 0; n <= own; ++n) {
            const bool act = (mask >> n) & 1u;
            for (int cc = 0; cc < 4; ++cc) {
                __syncthreads();
                const int k0 = n * BLK + cc * 64;
                { const int r = tid >> 3, c8 = tid & 7; const size_t go = ((size_t)b * SEQ + k0 + r) * D + h * 64 + c8 * 8;
                  const v4u kv = *(const GAS v4u*)(Kb + go), vv = *(const GAS v4u*)(Vb + go);
#pragma unroll
                  for (int j = 0; j < 4; ++j) { Ks[r * 64 + c8 * 8 + 2 * j] = __builtin_bit_cast(float, kv[j] << 16); Ks[r * 64 + c8 * 8 + 2 * j + 1] = __builtin_bit_cast(float, kv[j] & 0xffff0000u);
                      Vs[r * 64 + c8 * 8 + 2 * j] = __builtin_bit_cast(float, vv[j] << 16); Vs[r * 64 + c8 * 8 + 2 * j + 1] = __builtin_bit_cast(float, vv[j] & 0xffff0000u); } }
                __syncthreads();
                if (act) {
                    for (int j = 0; j < 64; ++j) {
                        const int tk = k0 + j;
                        if (tk <= tq) {
                            float s = 0.f;
#pragma unroll
                            for (int d4 = 0; d4 < 16; ++d4) { const f32x4 kv = *(const LAS f32x4*)(Ks + j * 64 + 4 * d4); s += q[4 * d4] * kv[0] + q[4 * d4 + 1] * kv[1] + q[4 * d4 + 2] * kv[2] + q[4 * d4 + 3] * kv[3]; }
                            int dist = tq - tk; dist = dist > 1023 ? 1023 : dist;
                            s += lut[dist];
                            if (s > m) { const float f = __builtin_amdgcn_exp2f(m - s);
#pragma unroll
                                for (int d = 0; d < 64; ++d) o[d] *= f;
                                l *= f; m = s; }
                            const float pz = __builtin_amdgcn_exp2f(s - m); l += pz;
#pragma unroll
                            for (int d4 = 0; d4 < 16; ++d4) { const f32x4 vv = *(const LAS f32x4*)(Vs + j * 64 + 4 * d4); o[4 * d4] += pz * vv[0]; o[4 * d4 + 1] += pz * vv[1]; o[4 * d4 + 2] += pz * vv[2]; o[4 * d4 + 3] += pz * vv[3]; }
                        }
                    }
                }
            }
        }
        if (tid < 256) { const float inv = 1.f / l; GAS v4u* op = (GAS v4u*)(Ob + ((size_t)b * SEQ + tq) * D + h * 64);
#pragma unroll
            for (int i = 0; i < 8; ++i) { v4u v; v.x = pk2(o[8 * i] * inv, o[8 * i + 1] * inv); v.y = pk2(o[8 * i + 2] * inv, o[8 * i + 3] * inv); v.z = pk2(o[8 * i + 4] * inv, o[8 * i + 5] * inv); v.w = pk2(o[8 * i + 6] * inv, o[8 * i + 7] * inv); op[i] = v; } }
    }
    __syncthreads();
}

__device__ __forceinline__ void final_norm(Frame& Fr) {
    struct { int lane, vcu, wave, G; const GAS float* norm_final; GAS float* out; } F{Fr.lane, Fr.vcu, Fr.wave, Fr.G, Fr.norm_final, Fr.out};
    asm volatile("" : "+v"(F.lane));
    const int gw = F.vcu * NWAVES + F.wave, NGW = F.G * NWAVES;
    f32x4 gam[4];
#pragma unroll
    for (int j = 0; j < 4; ++j) gam[j] = *(const GAS f32x4*)(F.norm_final + 4 * (F.lane + 64 * j));
    for (int row = gw; row < M; row += NGW) { GAS float* xr = F.out + (size_t)row * D; f32x4 v[4]; float ss = 0.f;
#pragma unroll
        for (int j = 0; j < 4; ++j) { v[j] = *(const GAS f32x4*)(xr + 4 * (F.lane + 64 * j)); ss += (v[j][0] * v[j][0] + v[j][1] * v[j][1]) + (v[j][2] * v[j][2] + v[j][3] * v[j][3]); }
        const float rstd = rsqrtf(wave_sum(ss) * (1.0f / D) + EPS);
#pragma unroll
        for (int j = 0; j < 4; ++j) *(GAS f32x4*)(xr + 4 * (F.lane + 64 * j)) = v[j] * rstd * gam[j]; }
}

__global__ void __launch_bounds__(NWAVES * 64, 2) fwd_megakernel(Args args) {
    __shared__ __attribute__((aligned(16))) unsigned char lds[LDS_BYTES];
    Frame F;
    F.lds = (LAS unsigned char*)lds;
    F.tid = threadIdx.x; F.lane = F.tid & 63; F.wave = __builtin_amdgcn_readfirstlane(F.tid >> 6);
    F.G = gridDim.x; { const int bx = blockIdx.x; F.vcu = (F.G % 8 == 0) ? (bx % 8) * (F.G / 8) + bx / 8 : bx; }
    F.x = args.in[0]; F.c = args.in[1]; F.rel_bias = args.in[2]; F.w_mod = args.in[3]; F.b_mod = args.in[4]; F.norm_mix = args.in[5]; F.norm_mlp = args.in[6];
    F.w_pool = args.in[7]; F.pool_scale = args.in[8]; F.w_qkv = args.in[9]; F.w_o = args.in[10]; F.w_up = args.in[11]; F.w_down = args.in[12]; F.norm_final = args.in[13];
    F.out = args.out; F.ws = args.ws;
    volatile LAS unsigned* MISC = (volatile LAS unsigned*)(F.lds + MISC_OFF);
    for (int u = F.tid; u < (LDS_BYTES - LDSCTL_OFF) / 4; u += NWAVES * 64) ((LAS unsigned*)(F.lds + LDSCTL_OFF))[u] = 0u;
    __syncthreads();
    gu32* ctl = (gu32*)(F.ws + WS_CTL);
    XcdBarrier bar = xcd_barrier_post((GAS unsigned*)(ctl + CW_BAR), MISC + 8);
    GAS unsigned char* ws = F.ws;
#define WSB(off) ((GAS bf16*)(ws + (off)))
#define WSF(off) ((GAS float*)(ws + (off)))

    p0_prologue(F);
    xcd_barrier(bar);
    p1_bias(F); p1_pool(F);
    xcd_barrier(bar);

    for (int ph = 0; ph < 9; ++ph) {
        asm volatile("" : "+s"(ws));
        const GAS float* MOD = WSF(WS_MOD); GAS float* SS = WSF(WS_SS);
        const int kind = (ph == 0 || ph == 2 || ph == 5 || ph == 7) ? 0 : (ph == 1 || ph == 6) ? 1 : (ph == 3) ? 2 : (ph == 4) ? 3 : 4;
        if (kind == 0) {
            pg8::Gemm g; pg8::EpiRes E;
            if (ph == 0) { g = pg8::Gemm{WSB(WS_XNA), WSB(WS_WPOOL), M, D, 256, D, 256};
                E = pg8::EpiRes{F.x, F.out, MOD + 2048, F.pool_scale, F.norm_mlp, MOD + 4096, WSB(WS_XNB), SS}; }
            else if (ph == 2) { g = pg8::Gemm{WSB(WS_HB), WSB(WS_WDN0), M, D, FF, FF, 0};
                E = pg8::EpiRes{F.out, F.out, MOD + 5120, nullptr, F.norm_mix + D, MOD + 4 * 6144 + 1024, WSB(WS_XNA), SS}; }
            else if (ph == 5) { g = pg8::Gemm{WSB(WS_Q), WSB(WS_WO), M, D, D, D, 0};
                E = pg8::EpiRes{F.out, F.out, MOD + 4 * 6144 + 2048, nullptr, F.norm_mlp + D, MOD + 4 * 6144 + 4096, WSB(WS_XNB), SS}; }
            else { g = pg8::Gemm{WSB(WS_HB), WSB(WS_WDN1), M, D, FF, FF, 0};
                E = pg8::EpiRes{F.out, F.out, MOD + 4 * 6144 + 5120, nullptr, nullptr, nullptr, nullptr, nullptr}; }
            pg8::StaticOrder S; S.init(M, D, F.G, (int)blockIdx.x);
            pg8::gemm_phase<pg8::EpiRes, pg8::StaticOrder, true>(F.lds + RING_OFF, g, S, E);
        } else if (kind == 1) {
            const pg8::Gemm g{WSB(WS_XNB), WSB(ph == 1 ? WS_WUP0 : WS_WUP1), M, FF, D, D, 0};
            const pg8::EpiUp E{SS, WSF(ph == 1 ? WS_BIAS_UP0 : WS_BIAS_UP1), WSB(WS_HB), FF};
            pg8::StaticOrder S; S.init(M, FF, F.G, (int)blockIdx.x);
            pg8::gemm_phase<pg8::EpiUp, pg8::StaticOrder, true>(F.lds + RING_OFF, g, S, E);
        } else if (kind == 2) {
            const pg8::Gemm g{WSB(WS_XNA), WSB(WS_WQKV), M, NQKV, D, D, 0};
            const pg8::EpiQKV E{SS, WSF(WS_BIAS_QKV), WSB(WS_Q), (size_t)(WS_K - WS_Q) / 2, WSF(WS_KMP)};
            pg8::StaticOrder S; S.init(M, NQKV, F.G, (int)blockIdx.x);
            pg8::gemm_phase<pg8::EpiQKV, pg8::StaticOrder, true>(F.lds + RING_OFF, g, S, E);
        } else if (kind == 3) {
            F.ws = ws; attn_naive(F);
        } else {
            final_norm(F); break;
        }
        xcd_barrier(bar);
    }
}

extern "C" void kernel_launch(void* const* d_in, const int* in_sizes, int n_in, void* d_out, int out_size, void* d_ws, size_t ws_size, hipStream_t stream) {
    static int grid = 0;
    if (grid == 0) {
        if (n_in != 14 || in_sizes[0] != M * D || out_size != M * D || ws_size < WS_END) { fprintf(stderr, "kernel_launch: unexpected shapes / workspace (n_in %d, in0 %d, out %d, ws %zu)\n", n_in, n_in > 0 ? in_sizes[0] : -1, out_size, ws_size); grid = -1; return; }
        int dev = 0, cus = 0, per_cu = 0;
        if (hipGetDevice(&dev) != hipSuccess || hipDeviceGetAttribute(&cus, hipDeviceAttributeMultiprocessorCount, dev) != hipSuccess) { grid = -1; return; }
        if (hipOccupancyMaxActiveBlocksPerMultiprocessor(&per_cu, (const void*)fwd_megakernel, NWAVES * 64, 0) != hipSuccess || per_cu < 1) { fprintf(stderr, "kernel_launch: occupancy query says %d blocks per CU\n", per_cu); }
        (void)hipGetLastError();
        grid = cus;
    }
    if (grid < 0) return;
    if (hipMemsetAsync((char*)d_ws + WS_CTL, 0, CTL_ZERO_BYTES, stream) != hipSuccess) return;
    Args a{};
    for (int i = 0; i < 14; ++i) a.in[i] = (const GAS float*)d_in[i];
    a.out = (GAS float*)d_out; a.ws = (GAS unsigned char*)d_ws;
    hipLaunchKernelGGL(fwd_megakernel, dim3(grid), dim3(NWAVES * 64), 0, stream, a);
}
```

```cpp
#include <hip/hip_runtime.h>
#include <cstdio>
#include <cstdint>

namespace pg8 {
#define PG8_LAS __attribute__((address_space(3)))
#define PG8_GAS __attribute__((address_space(1)))
typedef unsigned short bf16_t;
typedef short bf16x8 __attribute__((ext_vector_type(8)));
typedef float f32x4 __attribute__((ext_vector_type(4)));
typedef unsigned u32x4 __attribute__((ext_vector_type(4)));
constexpr int BM = 256, BK = 64, HALF = 128, HTB = HALF * BK * 2, STAGE_BYTES = 8 * HTB, NXCD = 8, WGM = 8;

__host__ __device__ __forceinline__ int lds_byte(int r, int c) { const int st = (r >> 4) * 2 + (c >> 5), rr = r & 15, cc = c & 31, ob = rr * 64 + cc * 2; return st * 1024 + (ob ^ (((ob >> 9) & 1) << 5)); }
__host__ __device__ __forceinline__ void stage_rc(int b, int& R, int& C) { const int st = b / 1024, sb = b % 1024, swz = sb ^ (((sb >> 9) & 1) << 5); R = (st >> 1) * 16 + swz / 64; C = (st & 1) * 32 + (swz % 64) / 2; }
__host__ __device__ __forceinline__ int perm32(int rho) { const int n = rho >> 4, i = rho & 15; return 8 * (i >> 2) + 4 * n + (i & 3); }

struct Unit { int pm, pn; };
struct Gemm { const PG8_GAS bf16_t* A; const PG8_GAS bf16_t* Bt; int M, N, K, lda, a_pn_off; };

struct StaticOrder {
    int nM, nN, nwg, G, c;
    __host__ __device__ void init(int M, int N, int G_, int c_) { nM = M / BM; nN = N / BM; nwg = nM * nN; G = G_; c = c_; }
    __host__ __device__ bool next(int i, Unit& u) const {
        const long L = (long)i * G + c; if (L >= nwg) return false;
        int wgid = (int)L; { const int q = nwg / NXCD, r = nwg % NXCD, xcd = wgid % NXCD, off = wgid / NXCD; wgid = (xcd < r ? xcd * (q + 1) : r * (q + 1) + (xcd - r) * q) + off; }
        const int nig = WGM * nN, gid = wgid / nig, fm = gid * WGM, gsz = (nM - fm) < WGM ? (nM - fm) : WGM;
        u.pm = fm + ((wgid % nig) % gsz); u.pn = (wgid % nig) / gsz; return true;
    }
};

__device__ __forceinline__ unsigned cvt_pk_bf16(float lo, float hi) { unsigned r; asm volatile("v_cvt_pk_bf16_f32 %0, %1, %2" : "=v"(r) : "v"(lo), "v"(hi)); return r; }

constexpr int SEQ_ = 8192;
constexpr float EPS_ = 1e-6f;
constexpr float C2_ = 0.125f * 1.4426950408889634f;


__device__ __forceinline__ float row_rstd(const PG8_GAS float* SS, int row, int fq) {
    const f32x4 s4 = *(const PG8_GAS f32x4*)(SS + (size_t)row * 16 + 4 * fq);
    float s = (s4[0] + s4[1]) + (s4[2] + s4[3]);
    s += __shfl_xor(s, 16); s += __shfl_xor(s, 32);
    return rsqrtf(s * (1.0f / 1024.0f) + EPS_);
}

struct EpiRes {
    static constexpr bool PERM = true;
    const PG8_GAS float* R; PG8_GAS float* X; const PG8_GAS float* gate; const PG8_GAS float* cscale; const PG8_GAS float* gnext; const PG8_GAS float* scn; PG8_GAS bf16_t* XN; PG8_GAS float* SS;
    __device__ __forceinline__ void operator()(const f32x4 (&acc)[2][2][4][2], const Unit& u, int wr, int wc, int fr, int fq) const {
        const int b = u.pm >> 5, colb = u.pn * BM + wc * 32 + 8 * fq, row0 = u.pm * BM + wr * 64 + fr;
        float ssq[2][4];
#pragma unroll
        for (int bj = 0; bj < 2; ++bj) {
            f32x4 gt[2], cs[2];
#pragma unroll
            for (int n = 0; n < 2; ++n) { const int col = colb + bj * HALF + 4 * n;
                f32x4 gv = *(const PG8_GAS f32x4*)(gate + b * 6144 + col); if (cscale) gv = gv * *(const PG8_GAS f32x4*)(cscale + col); gt[n] = gv;
                if (XN) { const f32x4 sc = *(const PG8_GAS f32x4*)(scn + b * 6144 + col); cs[n] = *(const PG8_GAS f32x4*)(gnext + col) * (sc + 1.0f); } else cs[n] = (f32x4){0.f, 0.f, 0.f, 0.f}; }
#pragma unroll
            for (int ai = 0; ai < 2; ++ai)
#pragma unroll
                for (int m = 0; m < 4; ++m) { const size_t off = (size_t)(row0 + ai * HALF + m * 16) * 1024 + colb + bj * HALF;
                    const f32x4 r0 = *(const PG8_GAS f32x4*)(R + off), r1 = *(const PG8_GAS f32x4*)(R + off + 4);
                    const f32x4 x0 = r0 + gt[0] * acc[ai][bj][m][0], x1 = r1 + gt[1] * acc[ai][bj][m][1];
                    *(PG8_GAS f32x4*)(X + off) = x0; *(PG8_GAS f32x4*)(X + off + 4) = x1;
                    const float q = (x0[0] * x0[0] + x0[1] * x0[1]) + (x0[2] * x0[2] + x0[3] * x0[3]) + (x1[0] * x1[0] + x1[1] * x1[1]) + (x1[2] * x1[2] + x1[3] * x1[3]);
                    ssq[ai][m] = (bj == 0) ? q : ssq[ai][m] + q;
                    if (XN) { const f32x4 a0 = x0 * cs[0], a1 = x1 * cs[1]; u32x4 w; w.x = cvt_pk_bf16(a0[0], a0[1]); w.y = cvt_pk_bf16(a0[2], a0[3]); w.z = cvt_pk_bf16(a1[0], a1[1]); w.w = cvt_pk_bf16(a1[2], a1[3]);
                        *(PG8_GAS u32x4*)(XN + off) = w; }
                }
        }
        if (SS) {
#pragma unroll
            for (int ai = 0; ai < 2; ++ai)
#pragma unroll
                for (int m = 0; m < 4; ++m) { float q = ssq[ai][m]; q += __shfl_xor(q, 16); q += __shfl_xor(q, 32); if (fq == 0) SS[(size_t)(row0 + ai * HALF + m * 16) * 16 + u.pn * 4 + wc] = q; }
        }
    }
};

struct EpiUp {
    static constexpr bool PERM = true;
    const PG8_GAS float* SS; const PG8_GAS float* bias; PG8_GAS bf16_t* O; int ldc;
    __device__ __forceinline__ void operator()(const f32x4 (&acc)[2][2][4][2], const Unit& u, int wr, int wc, int fr, int fq) const {
        const int b = u.pm >> 5, colb = u.pn * BM + wc * 32 + 8 * fq, row0 = u.pm * BM + wr * 64 + fr;
        float rs[2][4];
#pragma unroll
        for (int ai = 0; ai < 2; ++ai)
#pragma unroll
            for (int m = 0; m < 4; ++m) rs[ai][m] = row_rstd(SS, row0 + ai * HALF + m * 16, fq);
#pragma unroll
        for (int bj = 0; bj < 2; ++bj) {
            const f32x4 bv0 = *(const PG8_GAS f32x4*)(bias + (size_t)b * ldc + colb + bj * HALF), bv1 = *(const PG8_GAS f32x4*)(bias + (size_t)b * ldc + colb + bj * HALF + 4);
#pragma unroll
            for (int ai = 0; ai < 2; ++ai)
#pragma unroll
                for (int m = 0; m < 4; ++m) { f32x4 v0 = acc[ai][bj][m][0] * rs[ai][m] + bv0, v1 = acc[ai][bj][m][1] * rs[ai][m] + bv1;
#pragma unroll
                    for (int j = 0; j < 4; ++j) { v0[j] = fmaxf(v0[j], 0.f); v1[j] = fmaxf(v1[j], 0.f); }
                    v0 = v0 * v0; v1 = v1 * v1;
                    u32x4 w; w.x = cvt_pk_bf16(v0[0], v0[1]); w.y = cvt_pk_bf16(v0[2], v0[3]); w.z = cvt_pk_bf16(v1[0], v1[1]); w.w = cvt_pk_bf16(v1[2], v1[3]);
                    *(PG8_GAS u32x4*)(O + (size_t)(row0 + ai * HALF + m * 16) * ldc + colb + bj * HALF) = w; }
        }
    }
};

struct EpiQKV {
    static constexpr bool PERM = true;
    const PG8_GAS float* SS; const PG8_GAS float* bias; PG8_GAS bf16_t* Q; size_t split_stride; PG8_GAS float* KMP;
    __device__ __forceinline__ void operator()(const f32x4 (&acc)[2][2][4][2], const Unit& u, int wr, int wc, int fr, int fq) const {
        const int b = u.pm >> 5, t = u.pn >> 2, colt = (u.pn & 3) * BM + wc * 32 + 8 * fq, colb = u.pn * BM + wc * 32 + 8 * fq, row0 = u.pm * BM + wr * 64 + fr;
        PG8_GAS bf16_t* base = Q + (size_t)t * split_stride; const float sc = (t == 0) ? C2_ : 1.0f;
        float rs[2][4];
#pragma unroll
        for (int ai = 0; ai < 2; ++ai)
#pragma unroll
            for (int m = 0; m < 4; ++m) rs[ai][m] = row_rstd(SS, row0 + ai * HALF + m * 16, fq);
#pragma unroll
        for (int bj = 0; bj < 2; ++bj) {
            const f32x4 bv0 = *(const PG8_GAS f32x4*)(bias + (size_t)b * 3072 + colb + bj * HALF), bv1 = *(const PG8_GAS f32x4*)(bias + (size_t)b * 3072 + colb + bj * HALF + 4);
            f32x4 cs0 = {0.f, 0.f, 0.f, 0.f}, cs1 = cs0;
#pragma unroll
            for (int ai = 0; ai < 2; ++ai)
#pragma unroll
                for (int m = 0; m < 4; ++m) { f32x4 v0 = acc[ai][bj][m][0] * rs[ai][m] + bv0, v1 = acc[ai][bj][m][1] * rs[ai][m] + bv1;
                    cs0 += v0; cs1 += v1; v0 = v0 * sc; v1 = v1 * sc;
                    u32x4 w; w.x = cvt_pk_bf16(v0[0], v0[1]); w.y = cvt_pk_bf16(v0[2], v0[3]); w.z = cvt_pk_bf16(v1[0], v1[1]); w.w = cvt_pk_bf16(v1[2], v1[3]);
                    *(PG8_GAS u32x4*)(base + (size_t)(row0 + ai * HALF + m * 16) * 1024 + colt + bj * HALF) = w; }
            if (t == 1) {
#pragma unroll
                for (int o = 1; o < 16; o <<= 1) {
#pragma unroll
                    for (int j = 0; j < 4; ++j) { cs0[j] += __shfl_xor(cs0[j], o); cs1[j] += __shfl_xor(cs1[j], o); } }
                if (fr == 0) { PG8_GAS float* kp = KMP + ((size_t)u.pm * 2 + wr) * 1024 + colt + bj * HALF; *(f32x4*)kp = cs0; *(PG8_GAS f32x4*)(kp + 4) = cs1; }
            }
        }
    }
};

template <class Epi, class Sched, bool ALIGN_EPI>
__device__ __forceinline__ void gemm_phase(PG8_LAS unsigned char* lds, const Gemm g, const Sched& S, const Epi& E) {
    int tid = threadIdx.x; asm volatile("" : "+v"(tid));
    const int wid = __builtin_amdgcn_readfirstlane(tid >> 6), lane = tid & 63, wr = wid >> 2, wc = wid & 3, fr = lane & 15, fq = lane >> 4;
    const int K = g.K, nt = K / BK, lda = g.lda;
    unsigned voffA[2], voffB[2];
#pragma unroll
    for (int i = 0; i < 2; ++i) { int R, C; stage_rc(tid * 16 + i * 8192, R, C); const int Rb = Epi::PERM ? ((R & ~31) + perm32(R & 31)) : R;
        voffA[i] = (unsigned)(R * lda + C) * 2u; voffB[i] = (unsigned)(Rb * K + C) * 2u; }
    const size_t kstep = (size_t)(BK * 2);
    const size_t hstepA = (size_t)HALF * lda * 2, tstepA = 2 * hstepA, hstepB = (size_t)HALF * K * 2, tstepB = 2 * hstepB;
    const unsigned ldsw = (unsigned)wid * 1024u;
    const int aoff = lds_byte(wr * 64 + fr, fq * 8), boff = lds_byte(wc * 32 + fr, fq * 8);
#define PG8_SA(b, h) (((b) * 2 + (h)) * HTB)
#define PG8_SB(b, h) ((4 + (b) * 2 + (h)) * HTB)
#define PG8_STAGE(bufoff, gbase, voff) do { _Pragma("unroll") for (int _i = 0; _i < 2; ++_i) \
        __builtin_amdgcn_global_load_lds((const PG8_GAS unsigned*)((const PG8_GAS char*)(gbase) + (voff)[_i]), (PG8_LAS unsigned*)(lds + (bufoff) + ldsw + _i * 8192), 16, 0, 0); } while (0)
#define PG8_LDA(dst, b, h) do { _Pragma("unroll") for (int m = 0; m < 4; ++m) _Pragma("unroll") for (int k = 0; k < 2; ++k) dst[m][k] = *(const PG8_LAS bf16x8*)(lds + PG8_SA(b, h) + aoff + m * 2048 + k * 1024); } while (0)
#define PG8_LDB(dst, b, h) do { _Pragma("unroll") for (int n = 0; n < 2; ++n) _Pragma("unroll") for (int k = 0; k < 2; ++k) dst[n][k] = *(const PG8_LAS bf16x8*)(lds + PG8_SB(b, h) + boff + n * 2048 + k * 1024); } while (0)
#define PG8_MMA(ai, bj, At, Bt) do { __builtin_amdgcn_s_setprio(1); _Pragma("unroll") for (int m = 0; m < 4; ++m) _Pragma("unroll") for (int n = 0; n < 2; ++n) _Pragma("unroll") for (int k = 0; k < 2; ++k) \
        acc[ai][bj][m][n] = __builtin_amdgcn_mfma_f32_16x16x32_bf16(Bt[n][k], At[m][k], acc[ai][bj][m][n], 0, 0, 0); __builtin_amdgcn_s_setprio(0); } while (0)
#define PG8_WAIT_V(n) asm volatile("s_waitcnt vmcnt(" #n ")" ::: "memory")
#define PG8_WAIT_L(n) asm volatile("s_waitcnt lgkmcnt(" #n ")" ::: "memory")
#define PG8_BAR __builtin_amdgcn_s_barrier()
#define PG8_SCHED __builtin_amdgcn_sched_barrier(0)
    Unit cur, nxt; int ui = 0;
    if (!S.next(0, cur)) return;
    f32x4 acc[2][2][4][2];
#pragma unroll
    for (int a = 0; a < 2; ++a)
#pragma unroll
        for (int b = 0; b < 2; ++b)
#pragma unroll
            for (int m = 0; m < 4; ++m)
#pragma unroll
                for (int n = 0; n < 2; ++n) acc[a][b][m][n] = (f32x4){0.f, 0.f, 0.f, 0.f};
    bf16x8 At[4][2], B0[2][2], B1[2][2];
    const PG8_GAS char* cA = (const PG8_GAS char*)g.A + (size_t)cur.pm * tstepA + (size_t)cur.pn * g.a_pn_off * 2; const PG8_GAS char* cB = (const PG8_GAS char*)g.Bt + (size_t)cur.pn * tstepB;
    PG8_STAGE(PG8_SB(0, 0), cB, voffB); PG8_STAGE(PG8_SB(0, 1), cB + hstepB, voffB); PG8_STAGE(PG8_SA(0, 0), cA, voffA); PG8_STAGE(PG8_SA(0, 1), cA + hstepA, voffA);
    if (wr == 1) PG8_BAR;
    PG8_WAIT_V(2); PG8_BAR;
    PG8_STAGE(PG8_SB(1, 0), cB + kstep, voffB); PG8_STAGE(PG8_SA(1, 0), cA + kstep, voffA); PG8_STAGE(PG8_SB(1, 1), cB + hstepB + kstep, voffB);
    PG8_WAIT_V(6); PG8_BAR;
    for (;;) {
        const bool has_next = S.next(ui + 1, nxt);
        const PG8_GAS char* nA = has_next ? (const PG8_GAS char*)g.A + (size_t)nxt.pm * tstepA + (size_t)nxt.pn * g.a_pn_off * 2 : cA; const PG8_GAS char* nB = has_next ? (const PG8_GAS char*)g.Bt + (size_t)nxt.pn * tstepB : cB;
        for (int t = 0; t < nt; t += 2) {
            const bool last = (t == nt - 2);
            const PG8_GAS char* a1 = cA + (size_t)(t + 1) * kstep;
            const PG8_GAS char* a2 = last ? nA : cA + (size_t)(t + 2) * kstep; const PG8_GAS char* b2 = last ? nB : cB + (size_t)(t + 2) * kstep;
            const PG8_GAS char* a3 = a2 + kstep; const PG8_GAS char* b3 = b2 + kstep;
            PG8_LDB(B0, 0, 0); PG8_LDB(B1, 0, 1); PG8_SCHED; PG8_LDA(At, 0, 0); PG8_STAGE(PG8_SA(1, 1), a1 + hstepA, voffA);
            PG8_WAIT_V(8); PG8_WAIT_L(0); PG8_BAR; PG8_MMA(0, 0, At, B0); PG8_MMA(0, 1, At, B1); PG8_BAR; PG8_SCHED;
            PG8_LDA(At, 0, 1); PG8_STAGE(PG8_SB(0, 0), b2, voffB); PG8_STAGE(PG8_SB(0, 1), b2 + hstepB, voffB); PG8_STAGE(PG8_SA(0, 0), a2, voffA);
            PG8_WAIT_V(8); PG8_WAIT_L(0); PG8_BAR; PG8_MMA(1, 0, At, B0); PG8_MMA(1, 1, At, B1); PG8_BAR; PG8_SCHED;
            PG8_LDB(B0, 1, 0); PG8_LDB(B1, 1, 1); PG8_SCHED; PG8_LDA(At, 1, 0); PG8_STAGE(PG8_SA(0, 1), a2 + hstepA, voffA);
            PG8_WAIT_V(8); PG8_WAIT_L(0); PG8_BAR; PG8_MMA(0, 0, At, B0); PG8_MMA(0, 1, At, B1); PG8_BAR; PG8_SCHED;
            PG8_LDA(At, 1, 1); PG8_STAGE(PG8_SB(1, 0), b3, voffB); PG8_STAGE(PG8_SB(1, 1), b3 + hstepB, voffB); PG8_STAGE(PG8_SA(1, 0), a3, voffA);
            PG8_WAIT_V(8); PG8_WAIT_L(0); PG8_BAR; PG8_MMA(1, 0, At, B0); PG8_MMA(1, 1, At, B1); PG8_BAR; PG8_SCHED;
        }
        if constexpr (ALIGN_EPI) { if (wr == 0) PG8_BAR; }
        E(acc, cur, wr, wc, fr, fq);
        if (!has_next) break;
#pragma unroll
        for (int a = 0; a < 2; ++a)
#pragma unroll
            for (int b = 0; b < 2; ++b)
#pragma unroll
                for (int m = 0; m < 4; ++m)
#pragma unroll
                    for (int n = 0; n < 2; ++n) acc[a][b][m][n] = (f32x4){0.f, 0.f, 0.f, 0.f};
        cur = nxt; cA = nA; cB = nB; ++ui;
        if constexpr (ALIGN_EPI) { if (wr == 1) PG8_BAR; }
    }
    PG8_WAIT_V(0);
    if constexpr (!ALIGN_EPI) { if (wr == 0) PG8_BAR; }
    PG8_BAR;
#undef PG8_SA
#undef PG8_SB
#undef PG8_STAGE
#undef PG8_LDA
#undef PG8_LDB
#undef PG8_MMA
#undef PG8_WAIT_V
#undef PG8_WAIT_L
#undef PG8_BAR
#undef PG8_SCHED
}
}

constexpr int NWAVES = 8;
constexpr int BATCH = 4, SEQ = 8192, D = 1024, NH = 16, HD = 64, FF = 4096, M = BATCH * SEQ, NQKV = 3 * D, NBLK = 32, BLK = 256;
constexpr float EPS = 1e-6f;
constexpr float LOG2E = 1.4426950408889634f;

constexpr size_t MiB = 1u << 20;
constexpr size_t WS_CTL = 0, CTL_ZERO_BYTES = 1 * MiB;
constexpr size_t WS_MOD = 1 * MiB;
constexpr size_t WS_BIAS_UP0 = WS_MOD + 256 * 1024;
constexpr size_t WS_BIAS_QKV = WS_BIAS_UP0 + 64 * 1024;
constexpr size_t WS_BIAS_UP1 = WS_BIAS_QKV + 64 * 1024;
constexpr size_t WS_KMP = 2 * MiB;
constexpr size_t WS_SS = 3 * MiB;
constexpr size_t WS_WPOOL = 6 * MiB, WS_WQKV = 8 * MiB, WS_WO = 14 * MiB, WS_WUP0 = 16 * MiB, WS_WUP1 = 24 * MiB, WS_WDN0 = 32 * MiB, WS_WDN1 = 40 * MiB;
constexpr size_t WS_XNA = 48 * MiB, WS_XNB = 112 * MiB;
constexpr size_t WS_HB = 176 * MiB;
constexpr size_t WS_Q = 176 * MiB, WS_K = 240 * MiB, WS_V = 304 * MiB;
constexpr size_t WS_POA = 48 * MiB;
constexpr size_t WS_PL = 150 * MiB;
constexpr size_t WS_CNT = 158 * MiB;
constexpr size_t WS_KBM = 159 * MiB;
constexpr size_t WS_POB = 368 * MiB;
constexpr size_t WS_SEG = 470 * MiB;
constexpr size_t WS_END = 504 * MiB;
constexpr int CW_BAR = 4096;
constexpr int CW_TOT = 16384;

constexpr int RING_OFF = 0, RING_BYTES = 131072;
constexpr int LDSCTL_OFF = RING_BYTES, MISC_OFF = LDSCTL_OFF + 320;
constexpr int LDS_BYTES = 147456;

#define GAS __attribute__((address_space(1)))
#define LAS __attribute__((address_space(3)))
typedef unsigned short bf16;
typedef unsigned v4u __attribute__((ext_vector_type(4)));
typedef unsigned v2u __attribute__((ext_vector_type(2)));
typedef float f32x4 __attribute__((ext_vector_type(4)));
typedef GAS unsigned gu32;
#define RLX_AGENT __ATOMIC_RELAXED, __HIP_MEMORY_SCOPE_AGENT
#define LDS_WAIT() asm volatile("s_waitcnt lgkmcnt(0)" ::: "memory")
__device__ __forceinline__ unsigned f2bf(float f) { unsigned u = __builtin_bit_cast(unsigned, f); return (u + 0x7fffu + ((u >> 16) & 1u)) >> 16; }
__device__ __forceinline__ unsigned pk2(float lo, float hi) { return f2bf(lo) | (f2bf(hi) << 16); }
__device__ __forceinline__ float bf2f(unsigned short v) { return __builtin_bit_cast(float, (unsigned)v << 16); }

#define XB_TMO      128
#define XB_XCNT(j)  (256  + 64 * (j))
#define XB_XSUB(j)  (1280 + 64 * (j))
#define XB_XGEN(j)  (2304 + 64 * (j))
#define XB_TOP      3328
#define XB_TOPGEN   3392
#define XCD_BAR_WORDS 3456
#define XB_SPIN_CAP (1u << 18)
__device__ __forceinline__ unsigned xb_ld(GAS unsigned* p)              { return __hip_atomic_load(p, __ATOMIC_RELAXED, __HIP_MEMORY_SCOPE_AGENT); }
__device__ __forceinline__ unsigned xb_add(GAS unsigned* p, unsigned v) { return __hip_atomic_fetch_add(p, v, __ATOMIC_RELAXED, __HIP_MEMORY_SCOPE_AGENT); }
__device__ __forceinline__ unsigned xb_xcc_id() { return (unsigned)__builtin_amdgcn_s_getreg((3 << 11) | 20) & 0xFu; }
#define XB_SPIN(cond, bar) do { unsigned _sp = 0; while (cond) { __builtin_amdgcn_s_sleep(1); \
    if ((++_sp & 255u) == 0u) { if (xb_ld(&(bar)[XB_TMO])) break; if (_sp > XB_SPIN_CAP) { (void)xb_add(&(bar)[XB_TMO], 1u); break; } } } } while (0)
struct XcdBarrier { GAS unsigned* bar; unsigned x; volatile LAS unsigned* st; };
__device__ __forceinline__ XcdBarrier xcd_barrier_post(GAS unsigned* bar, volatile LAS unsigned* st) {
    XcdBarrier b; b.bar = bar; b.x = xb_xcc_id(); b.st = st;
    if (threadIdx.x == 0) (void)xb_add(&bar[XB_XCNT(b.x)], 1u);
    return b;
}
__device__ __forceinline__ void xcd_barrier_complete(GAS unsigned* bar, unsigned x, unsigned& nloc, unsigned& nx) {
    const unsigned G = gridDim.x * gridDim.y * gridDim.z;
    unsigned sum, cnt, mine, sp = 0u;
    for (;;) {
        sum = 0u; cnt = 0u; mine = 0u;
#pragma unroll
        for (unsigned j = 0; j < 16; ++j) { const unsigned c = xb_ld(&bar[XB_XCNT(j)]); sum += c; cnt += (c > 0u) ? 1u : 0u; mine = (j == x) ? c : mine; }
        if (sum == G) break;
        __builtin_amdgcn_s_sleep(1);
        if ((++sp & 255u) == 0u) { if (xb_ld(&bar[XB_TMO])) break; if (sp > XB_SPIN_CAP) { (void)xb_add(&bar[XB_TMO], 1u); break; } }
    }
    nloc = mine > 0u ? mine : 1u; nx = cnt > 0u ? cnt : 1u;
}
__device__ __forceinline__ void xcd_barrier(const XcdBarrier& b) {
    asm volatile("s_waitcnt vmcnt(0)" ::: "memory");
    __syncthreads();
    if (threadIdx.x == 0) {
        GAS unsigned* bar = b.bar; asm volatile("" : "+s"(bar));
        const unsigned bx = xb_xcc_id();
        __builtin_amdgcn_s_waitcnt(0);
        unsigned nloc = b.st[0], nx = b.st[1];
        if (nloc == 0u) { xcd_barrier_complete(bar, bx, nloc, nx); b.st[0] = nloc; b.st[1] = nx; }
        const unsigned old = xb_add(&bar[XB_XSUB(bx)], 1u);
        const unsigned gen = old / nloc;
        if (old + 1u == (gen + 1u) * nloc) {
            __builtin_amdgcn_fence(__ATOMIC_RELEASE, "agent");
            asm volatile("s_waitcnt vmcnt(0)" ::: "memory");
            const unsigned og = xb_add(&bar[XB_TOP], 1u);
            const unsigned tg = og / nx;
            if (og + 1u == (tg + 1u) * nx) xb_add(&bar[XB_TOPGEN], 1u);
            else XB_SPIN(xb_ld(&bar[XB_TOPGEN]) == tg, bar);
            __builtin_amdgcn_fence(__ATOMIC_ACQUIRE, "agent");
            xb_add(&bar[XB_XGEN(bx)], 1u);
            asm volatile("s_waitcnt vmcnt(0)" ::: "memory");
        } else {
            XB_SPIN(xb_ld(&bar[XB_XGEN(bx)]) == gen, bar);
            __builtin_amdgcn_fence(__ATOMIC_ACQUIRE, "agent");
            asm volatile("s_waitcnt vmcnt(0)" ::: "memory");
        }
    }
    __syncthreads();
}

struct Args { const GAS float* in[14]; GAS float* out; GAS unsigned char* ws; };
struct Frame {
    LAS unsigned char* lds; int tid, lane, wave, vcu, G;
    const GAS float *x, *c, *rel_bias, *w_mod, *b_mod, *norm_mix, *norm_mlp, *w_pool, *pool_scale, *w_qkv, *w_o, *w_up, *w_down, *norm_final;
    GAS float* out; GAS unsigned char* ws;
};
__device__ __forceinline__ float wave_sum(float v) {
#pragma unroll
    for (int o = 1; o < 64; o <<= 1) v += __shfl_xor(v, o);
    return v;
}

__device__ __forceinline__ void p0_transpose_item(const GAS float* W, int K, int N, GAS bf16* WT, int row_off, LAS float* scr, int item, int lane) {
    const int nblk = N / 32, kb = item / nblk, nb = item % nblk, k0 = 64 * kb, n0 = 32 * nb;
#pragma unroll 8
    for (int i = 0; i < 32; ++i) { const int kk = 2 * i + (lane >> 5); scr[kk * 33 + (lane & 31)] = W[(size_t)(k0 + kk) * N + n0 + (lane & 31)]; }
    LDS_WAIT(); asm volatile("" ::: "memory");
    const int c = lane & 7;
#pragma unroll
    for (int j = 0; j < 4; ++j) { const int n = (lane >> 3) + 8 * j; const LAS float* s = scr + (8 * c) * 33 + n;
        v4u o; o.x = pk2(s[0 * 33], s[1 * 33]); o.y = pk2(s[2 * 33], s[3 * 33]); o.z = pk2(s[4 * 33], s[5 * 33]); o.w = pk2(s[6 * 33], s[7 * 33]);
        *(GAS v4u*)(WT + (size_t)(row_off + n0 + n) * K + k0 + 8 * c) = o; }
    LDS_WAIT(); asm volatile("" ::: "memory");
}
__device__ __forceinline__ void p0_prologue(Frame& F) {
    if (F.vcu < 192) {
        LAS float* cact = (LAS float*)(F.lds + 67584);
        LAS float* red = (LAS float*)(F.lds + 67584 + 16384);
        const int l = F.vcu / 96, j0 = (F.vcu % 96) * 64;
        for (int i = F.tid; i < 4096; i += NWAVES * 64) { const float v = F.c[i]; cact[i] = v / (1.f + __expf(-v)); }
        __syncthreads();
        const int sub = F.lane >> 4, c4 = F.lane & 15;
        f32x4 a0 = {0.f, 0.f, 0.f, 0.f}, a1 = a0, a2 = a0, a3 = a0;
        const GAS float* wb = F.w_mod + (size_t)l * 1024 * 6144 + j0 + 4 * c4;
#pragma unroll 4
        for (int it = 0; it < 32; ++it) { const int k = 32 * it + 4 * F.wave + sub; const f32x4 wv = *(const GAS f32x4*)(wb + (size_t)k * 6144);
            a0 += wv * cact[k]; a1 += wv * cact[1024 + k]; a2 += wv * cact[2048 + k]; a3 += wv * cact[3072 + k]; }
#pragma unroll
        for (int j = 0; j < 4; ++j) { a0[j] += __shfl_xor(a0[j], 16); a0[j] += __shfl_xor(a0[j], 32); a1[j] += __shfl_xor(a1[j], 16); a1[j] += __shfl_xor(a1[j], 32);
            a2[j] += __shfl_xor(a2[j], 16); a2[j] += __shfl_xor(a2[j], 32); a3[j] += __shfl_xor(a3[j], 16); a3[j] += __shfl_xor(a3[j], 32); }
        if (sub == 0) { LAS f32x4* r4 = (LAS f32x4*)(red + F.wave * 256); r4[0 * 16 + c4] = a0; r4[1 * 16 + c4] = a1; r4[2 * 16 + c4] = a2; r4[3 * 16 + c4] = a3; }
        __syncthreads();
        if (F.tid < 256) { const int b = F.tid >> 6, col = F.tid & 63; float s = 0.f;
#pragma unroll
            for (int w = 0; w < 8; ++w) s += red[w * 256 + b * 64 + col];
            ((GAS float*)(F.ws + WS_MOD))[(l * 4 + b) * 6144 + j0 + col] = s + F.b_mod[l * 6144 + j0 + col]; }
    }
    LAS float* scr = (LAS float*)(F.lds + RING_OFF + F.wave * 8448);
    const int gw = F.vcu * NWAVES + F.wave, NGW = F.G * NWAVES;
    constexpr int I_POOL = 4 * 32, I_QKV = 16 * 96, I_O = 16 * 32, I_UP = 16 * 128, I_DN = 64 * 32;
    constexpr int NITEMS = I_POOL + I_QKV + I_O + 2 * I_UP + 2 * I_DN;
    for (int it = gw; it < NITEMS; it += NGW) {
        int r = it;
        if (r < I_POOL) { const int g = r / 32; p0_transpose_item(F.w_pool + (size_t)g * 65536, 256, 256, (GAS bf16*)(F.ws + WS_WPOOL), g * 256, scr, r % 32, F.lane); continue; } r -= I_POOL;
        if (r < I_QKV) { p0_transpose_item(F.w_qkv, D, NQKV, (GAS bf16*)(F.ws + WS_WQKV), 0, scr, r, F.lane); continue; } r -= I_QKV;
        if (r < I_O) { p0_transpose_item(F.w_o, D, D, (GAS bf16*)(F.ws + WS_WO), 0, scr, r, F.lane); continue; } r -= I_O;
        if (r < 2 * I_UP) { const int l = r / I_UP; p0_transpose_item(F.w_up + (size_t)l * D * FF, D, FF, (GAS bf16*)(F.ws + (l ? WS_WUP1 : WS_WUP0)), 0, scr, r % I_UP, F.lane); continue; } r -= 2 * I_UP;
        { const int l = r / I_DN; p0_transpose_item(F.w_down + (size_t)l * FF * D, FF, D, (GAS bf16*)(F.ws + (l ? WS_WDN1 : WS_WDN0)), 0, scr, r % I_DN, F.lane); }
    }
}

__device__ __forceinline__ void p1_bias(Frame& F) {
    const int gw = F.vcu * NWAVES + F.wave, NGW = F.G * NWAVES;
    const GAS float* MOD = (const GAS float*)(F.ws + WS_MOD);
    for (int it = gw; it < 4096 + 3072 + 4096; it += NGW) {
        const GAS bf16* wt; const GAS float* sh; GAS float* dst; int n, N;
        if (it < 4096) { n = it; N = 4096; wt = (const GAS bf16*)(F.ws + WS_WUP0); sh = MOD + 3072; dst = (GAS float*)(F.ws + WS_BIAS_UP0); }
        else if (it < 4096 + 3072) { n = it - 4096; N = 3072; wt = (const GAS bf16*)(F.ws + WS_WQKV); sh = MOD + 4 * 6144; dst = (GAS float*)(F.ws + WS_BIAS_QKV); }
        else { n = it - 7168; N = 4096; wt = (const GAS bf16*)(F.ws + WS_WUP1); sh = MOD + 4 * 6144 + 3072; dst = (GAS float*)(F.ws + WS_BIAS_UP1); }
        const v4u w0 = *(const GAS v4u*)(wt + (size_t)n * 1024 + F.lane * 16), w1 = *(const GAS v4u*)(wt + (size_t)n * 1024 + F.lane * 16 + 8);
        float wf[16];
#pragma unroll
        for (int j = 0; j < 4; ++j) { wf[2 * j] = __builtin_bit_cast(float, w0[j] << 16); wf[2 * j + 1] = __builtin_bit_cast(float, w0[j] & 0xffff0000u);
            wf[8 + 2 * j] = __builtin_bit_cast(float, w1[j] << 16); wf[8 + 2 * j + 1] = __builtin_bit_cast(float, w1[j] & 0xffff0000u); }
#pragma unroll
        for (int b = 0; b < 4; ++b) { const GAS f32x4* sp = (const GAS f32x4*)(sh + b * 6144 + F.lane * 16); float s = 0.f;
#pragma unroll
            for (int j = 0; j < 4; ++j) { const f32x4 sv = sp[j]; s += wf[4 * j] * sv[0] + wf[4 * j + 1] * sv[1] + wf[4 * j + 2] * sv[2] + wf[4 * j + 3] * sv[3]; }
            s = wave_sum(s); if (F.lane == 0) dst[b * N + n] = s; }
    }
}
__device__ __forceinline__ void p1_pool(Frame& F) {
    LAS float* ring = (LAS float*)(F.lds + RING_OFF);
    const GAS float* MOD = (const GAS float*)(F.ws + WS_MOD); GAS bf16* XN = (GAS bf16*)(F.ws + WS_XNA);
    for (int run = F.vcu; run < M / 128; run += F.G) {
        const int t0 = run * 128, s0 = t0 % SEQ, b = t0 / SEQ;
        f32x4 gam[4];
#pragma unroll
        for (int j = 0; j < 4; ++j) gam[j] = *(const GAS f32x4*)(F.norm_mix + 4 * (F.lane + 64 * j));
        const int c4 = F.tid & 255, rh = F.tid >> 8, gi = c4 >> 6, w = 2 << gi;
        const f32x4 sc1 = *(const GAS f32x4*)(MOD + b * 6144 + 1024 + 4 * c4) + 1.0f;
        for (int st = (s0 > 0 ? -1 : 0); st < 8; ++st) {
#pragma unroll
            for (int rr = 0; rr < 2; ++rr) { const int s = s0 + 16 * st + 2 * F.wave + rr; const GAS float* xr = F.x + ((size_t)b * SEQ + s) * D;
                f32x4 v[4]; float ss = 0.f;
#pragma unroll
                for (int j = 0; j < 4; ++j) { v[j] = *(const GAS f32x4*)(xr + 4 * (F.lane + 64 * j)); ss += (v[j][0] * v[j][0] + v[j][1] * v[j][1]) + (v[j][2] * v[j][2] + v[j][3] * v[j][3]); }
                const float rstd = rsqrtf(wave_sum(ss) * (1.0f / D) + EPS);
#pragma unroll
                for (int j = 0; j < 4; ++j) *(LAS f32x4*)(ring + (s & 31) * 1024 + 4 * (F.lane + 64 * j)) = v[j] * rstd * gam[j]; }
            __syncthreads();
            if (st >= 0) {
                const int sA = s0 + 16 * st + 8 * rh;
                f32x4 sum = {0.f, 0.f, 0.f, 0.f};
                { const int cnt0 = (sA < w) ? sA : w; for (int i = 1; i <= cnt0; ++i) sum += *(const LAS f32x4*)(ring + ((sA - i) & 31) * 1024 + 4 * c4); }
#pragma unroll
                for (int r = 0; r < 8; ++r) { const int s = sA + r; const f32x4 cur = *(const LAS f32x4*)(ring + (s & 31) * 1024 + 4 * c4);
                    sum += cur; if (s >= w) sum -= *(const LAS f32x4*)(ring + ((s - w) & 31) * 1024 + 4 * c4);
                    const float inv = 1.0f / (float)((s + 1 < w) ? s + 1 : w);
                    const f32x4 p = (sum * inv - cur) * sc1;
                    v2u o; o.x = pk2(p[0], p[1]); o.y = pk2(p[2], p[3]);
                    *(GAS v2u*)(XN + ((size_t)b * SEQ + s) * D + 4 * c4) = o; }
            }
            __syncthreads();
        }
    }
}

__device__ __forceinline__ int t5_bucket(int dist) {
    if (dist < 16) return dist;
    int b = 16;
    b += (dist >= 21); b += (dist >= 27); b += (dist >= 35); b += (dist >= 46); b += (dist >= 59); b += (dist >= 77); b += (dist >= 99); b += (dist >= 128);
    b += (dist >= 166); b += (dist >= 216); b += (dist >= 280); b += (dist >= 363); b += (dist >= 470); b += (dist >= 609); b += (dist >= 790);
    return b;
}
namespace att {
typedef short bf16x8 __attribute__((ext_vector_type(8)));
typedef short s16x4 __attribute__((ext_vector_type(4)));
typedef short v4i16_t __attribute__((ext_vector_type(4)));
typedef float f32x16 __attribute__((ext_vector_type(16)));
typedef float f32x2_t __attribute__((ext_vector_type(2)));
typedef __bf16 bf16x2_t __attribute__((ext_vector_type(2)));
typedef LAS const char* lds_cptr;
constexpr int L_K = 0, L_V = 32768, L_LUT = 65536, L_OST = 75776, L_QI = 108544, L_PRE = 110592, L_CUM = 118784, L_SM = 119040;
constexpr int LUTN = 2304;
__device__ __forceinline__ int crow(int r, int hi) { return (r & 3) + 8 * (r >> 2) + 4 * hi; }
__device__ __forceinline__ unsigned cvtpk(float lo, float hi) { f32x2_t v = {lo, hi}; bf16x2_t b = __builtin_convertvector(v, bf16x2_t); return __builtin_bit_cast(unsigned, b); }
__device__ __forceinline__ s16x4 vtr(lds_cptr p) { return __builtin_bit_cast(s16x4, __builtin_amdgcn_ds_read_tr16_b64_v4i16((LAS v4i16_t*)p)); }
__device__ __forceinline__ float swap_add(float v) { auto rr = __builtin_amdgcn_permlane32_swap(__float_as_uint(v), __float_as_uint(v), false, false); return __uint_as_float(rr[0]) + __uint_as_float(rr[1]); }

__device__ __forceinline__ void load_kv(LAS unsigned char* lds, const GAS bf16* Kb, const GAS bf16* Vb, int b, int h, int n, int w, int lane) {
#pragma unroll
    for (int t = 0; t < 4; ++t) {
        const size_t kr = (size_t)b * SEQ + n * BLK + 64 * t + lane, vr = (size_t)b * SEQ + n * BLK + 64 * t + 16 * (w & 3) + (lane >> 2);
        const v4u kv = *(const GAS v4u*)(Kb + kr * D + h * 64 + w * 8);
        const v4u vv = *(const GAS v4u*)(Vb + vr * D + h * 64 + (w >> 2) * 32 + (lane & 3) * 8);
        *(LAS v4u*)(lds + L_K + t * 8192 + w * 1024 + lane * 16) = kv;
        *(LAS v4u*)(lds + L_V + t * 8192 + w * 1024 + lane * 16) = vv;
    }
}
__device__ __forceinline__ void build_lut(LAS unsigned char* lds, const GAS float* rel_bias, int h, int tid) {
    for (int i = tid; i < LUTN; i += NWAVES * 64) ((LAS float*)(lds + L_LUT))[i] = (i <= 2047) ? rel_bias[t5_bucket(2047 - i) * NH + h] * LOG2E : 0.f;
}
__device__ __forceinline__ void qk_tile(f32x16& p0, f32x16& p1, lds_cptr Kt, const bf16x8* qr, const f32x16& cinit, int r32, int hi) {
    lds_cptr kb = Kt + hi * 1024 + r32 * 16;
#pragma unroll
    for (int d0 = 0; d0 < 4; ++d0) {
        const bf16x8 b0 = *(LAS const bf16x8*)(kb + d0 * 2048), b1 = *(LAS const bf16x8*)(kb + d0 * 2048 + 512);
        if (d0 == 0) { p0 = __builtin_amdgcn_mfma_f32_32x32x16_bf16(b0, qr[0], cinit, 0, 0, 0); p1 = __builtin_amdgcn_mfma_f32_32x32x16_bf16(b1, qr[0], cinit, 0, 0, 0); }
        else { p0 = __builtin_amdgcn_mfma_f32_32x32x16_bf16(b0, qr[d0], p0, 0, 0, 0); p1 = __builtin_amdgcn_mfma_f32_32x32x16_bf16(b1, qr[d0], p1, 0, 0, 0); }
    }
}
template <bool BIAS, bool MASK>
__device__ __forceinline__ void softmax_tile(f32x16& p0, f32x16& p1, LAS const float* lutp, int jt, int qrel, int hi, float& l, v4u* pa) {
#pragma unroll
    for (int r = 0; r < 16; ++r) { const int ko = 64 * jt + (r & 3) + 8 * (r >> 2);
        if (BIAS) { p0[r] += lutp[ko]; p1[r] += lutp[ko + 32]; }
        if (MASK) { const int kv = ko + 4 * hi; if (kv > qrel) p0[r] = -INFINITY; if (kv + 32 > qrel) p1[r] = -INFINITY; }
        p0[r] = __builtin_amdgcn_exp2f(p0[r]); p1[r] = __builtin_amdgcn_exp2f(p1[r]); }
    float s = 0.f;
#pragma unroll
    for (int r = 0; r < 16; ++r) s += p0[r] + p1[r];
    l += s;
    pa[0] = (v4u){cvtpk(p0[0], p0[1]), cvtpk(p0[2], p0[3]), cvtpk(p0[4], p0[5]), cvtpk(p0[6], p0[7])};
    pa[1] = (v4u){cvtpk(p0[8], p0[9]), cvtpk(p0[10], p0[11]), cvtpk(p0[12], p0[13]), cvtpk(p0[14], p0[15])};
    pa[2] = (v4u){cvtpk(p1[0], p1[1]), cvtpk(p1[2], p1[3]), cvtpk(p1[4], p1[5]), cvtpk(p1[6], p1[7])};
    pa[3] = (v4u){cvtpk(p1[8], p1[9]), cvtpk(p1[10], p1[11]), cvtpk(p1[12], p1[13]), cvtpk(p1[14], p1[15])};
}
__device__ __forceinline__ void pv_tile(f32x16* o, lds_cptr vp, const v4u* pa) {
#pragma unroll
    for (int d0 = 0; d0 < 2; ++d0)
#pragma unroll
        for (int ks = 0; ks < 4; ++ks) { const s16x4 lo = vtr(vp + d0 * 4096 + ks * 1024), hi = vtr(vp + d0 * 4096 + ks * 1024 + 512);
            const bf16x8 vf = (bf16x8){lo[0], lo[1], lo[2], lo[3], hi[0], hi[1], hi[2], hi[3]};
            o[d0] = __builtin_amdgcn_mfma_f32_32x32x16_bf16(__builtin_bit_cast(bf16x8, pa[ks]), vf, o[d0], 0, 0, 0); }
}
__device__ __forceinline__ float load_q(bf16x8* qr, const GAS bf16* Qb, size_t qrow, int h, int hi) {
    float q2 = 0.f;
#pragma unroll
    for (int d0 = 0; d0 < 4; ++d0) { const v4u v = *(const GAS v4u*)(Qb + qrow * D + h * 64 + d0 * 16 + hi * 8); qr[d0] = __builtin_bit_cast(bf16x8, v);
#pragma unroll
        for (int j = 0; j < 4; ++j) { const float a = __builtin_bit_cast(float, v[j] << 16), c = __builtin_bit_cast(float, v[j] & 0xffff0000u); q2 += a * a + c * c; } }
    return swap_add(q2);
}
__device__ __forceinline__ float ref_exponent(float q2, float kmax2, float bmax) { return __builtin_sqrtf(q2 * kmax2) * 1.002f + bmax + 0.01f; }
__device__ __forceinline__ void head_bounds(const GAS float* KBM, const GAS float* rel_bias, int bh, int h, int lane, float& kmax2, float& bmax) {
    float k = KBM[bh * 32 + (lane & 31)], bb = rel_bias[(lane & 31) * NH + h] * LOG2E;
#pragma unroll
    for (int o = 1; o < 32; o <<= 1) { k = fmaxf(k, __shfl_xor(k, o)); bb = fmaxf(bb, __shfl_xor(bb, o)); }
    kmax2 = k; bmax = bb;
}
__device__ __forceinline__ void stage_o(LAS bf16* stg, const f32x16* o, int r32, int hi) {
#pragma unroll
    for (int r = 0; r < 16; ++r) { const int orow = crow(r, hi);
#pragma unroll
        for (int d0 = 0; d0 < 2; ++d0) stg[orow * 64 + d0 * 32 + r32] = (bf16)f2bf(o[d0][r]); }
    LDS_WAIT();
}
__device__ __forceinline__ GAS bf16* po_row(GAS unsigned char* ws, int b, int h, int t, int slot) {
    return (GAS bf16*)(ws + (b < 2 ? WS_POA : WS_POB)) + ((((size_t)((b & 1) * 16 + h) * SEQ + t) * 3 + slot) * 64);
}

__device__ __forceinline__ void route(Frame& F) {
    GAS unsigned char* ws = F.ws;
    const GAS bf16* Qb = (const GAS bf16*)(ws + WS_Q); const GAS bf16* Kb = (const GAS bf16*)(ws + WS_K);
    const GAS float* KMP = (const GAS float*)(ws + WS_KMP);
    GAS unsigned short* SEG = (GAS unsigned short*)(ws + WS_SEG); GAS unsigned* CNT = (GAS unsigned*)(ws + WS_CNT); GAS unsigned* TOT = (GAS unsigned*)(ws + WS_CTL) + CW_TOT;
    GAS float* KBM = (GAS float*)(ws + WS_KBM);
    int tid = F.tid; asm volatile("" : "+v"(tid));
    const int hf = tid >> 8, t = tid & 255, lane = tid & 63, w4 = (tid >> 6) & 3;
    LAS float* kms = (LAS float*)(F.lds + hf * 16384);
    LAS unsigned* cntw = (LAS unsigned*)(F.lds + hf * 16384 + 8192);
    LAS float* kbw = (LAS float*)(F.lds + hf * 16384 + 8192 + 512);
    for (int it = 0; it < 4; ++it) {
        const int id = it * 512 + F.vcu * 2 + hf, own = id >> 6, bh = id & 63, b = bh >> 4, h = bh & 15;
        __syncthreads();
        for (int i = t; i < NBLK * 64; i += 256) { const int n = i >> 6, d = i & 63; const size_t o = ((size_t)(b * 32 + n) * 2) * 1024 + h * 64 + d; kms[i] = (KMP[o] + KMP[o + 1024]) * (1.0f / 256.0f); }
        const size_t row = (size_t)b * SEQ + own * BLK + t;
        float q[64];
        { const GAS v4u* qp = (const GAS v4u*)(Qb + row * D + h * 64);
#pragma unroll
          for (int i = 0; i < 8; ++i) { const v4u v = qp[i];
#pragma unroll
              for (int j = 0; j < 4; ++j) { q[8 * i + 2 * j] = __builtin_bit_cast(float, v[j] << 16); q[8 * i + 2 * j + 1] = __builtin_bit_cast(float, v[j] & 0xffff0000u); } } }
        { const GAS v4u* kp = (const GAS v4u*)(Kb + row * D + h * 64); float k2 = 0.f;
#pragma unroll
          for (int i = 0; i < 8; ++i) { const v4u v = kp[i];
#pragma unroll
              for (int j = 0; j < 4; ++j) { const float a = __builtin_bit_cast(float, v[j] << 16), c = __builtin_bit_cast(float, v[j] & 0xffff0000u); k2 += a * a + c * c; } }
#pragma unroll
          for (int o = 1; o < 64; o <<= 1) k2 = fmaxf(k2, __shfl_xor(k2, o));
          if (lane == 0) kbw[w4] = k2; }
        __syncthreads();
        float g1 = -INFINITY, g2 = -INFINITY, g3 = -INFINITY; int i1 = -1, i2 = -1, i3 = -1;
        for (int n = 0; n < own; ++n) {
            float g = 0.f;
#pragma unroll
            for (int d4 = 0; d4 < 16; ++d4) { const f32x4 kv = *(const LAS f32x4*)(kms + n * 64 + 4 * d4); g += q[4 * d4] * kv[0] + q[4 * d4 + 1] * kv[1] + q[4 * d4 + 2] * kv[2] + q[4 * d4 + 3] * kv[3]; }
            if (g > g1) { g3 = g2; i3 = i2; g2 = g1; i2 = i1; g1 = g; i1 = n; }
            else if (g > g2) { g3 = g2; i3 = i2; g2 = g; i2 = n; }
            else if (g > g3) { g3 = g; i3 = n; }
        }
        for (int n = 0; n < own; ++n) { const unsigned long long mm = __ballot(i1 == n || i2 == n || i3 == n); if (lane == 0) cntw[w4 * 32 + n] = (unsigned)__popcll(mm); }
        __syncthreads();
        for (int n = 0; n < own; ++n) { const bool has = (i1 == n || i2 == n || i3 == n); const unsigned long long mm = __ballot(has);
            if (has) { unsigned base = 0; for (int w = 0; w < w4; ++w) base += cntw[w * 32 + n];
                const unsigned rank = (unsigned)__popcll(mm & ((1ull << lane) - 1ull)); const unsigned slot = (i1 == n) ? 0u : (i2 == n) ? 1u : 2u;
                SEG[(((size_t)bh * 32 + own) * 32 + n) * 256 + base + rank] = (unsigned short)(t | (slot << 8)); } }
        if (t < own) { const unsigned c = cntw[t] + cntw[32 + t] + cntw[64 + t] + cntw[96 + t]; CNT[((size_t)bh * 32 + own) * 32 + t] = c; (void)__hip_atomic_fetch_add(TOT + bh * 31 + t, c, RLX_AGENT); }
        if (t == 0) KBM[bh * 32 + own] = fmaxf(fmaxf(kbw[0], kbw[1]), fmaxf(kbw[2], kbw[3]));
    }
    __syncthreads();
}

__device__ __forceinline__ void gather(Frame& F) {
    GAS unsigned char* ws = F.ws;
    const GAS bf16* Qb = (const GAS bf16*)(ws + WS_Q); const GAS bf16* Kb = (const GAS bf16*)(ws + WS_K); const GAS bf16* Vb = (const GAS bf16*)(ws + WS_V);
    const GAS unsigned short* SEG = (const GAS unsigned short*)(ws + WS_SEG); const GAS unsigned* CNT = (const GAS unsigned*)(ws + WS_CNT); const GAS unsigned* TOT = (const GAS unsigned*)(ws + WS_CTL) + CW_TOT;
    const GAS float* KBM = (const GAS float*)(ws + WS_KBM); GAS float* PL = (GAS float*)(ws + WS_PL);
    int tid = F.tid; asm volatile("" : "+v"(tid));
    const int lane = tid & 63, w = __builtin_amdgcn_readfirstlane(tid >> 6), r32 = lane & 31, hi = lane >> 5;
    LAS unsigned* pre = (LAS unsigned*)(F.lds + L_PRE);
    LAS unsigned* cum = (LAS unsigned*)(F.lds + L_CUM);
    LAS unsigned* qi = (LAS unsigned*)(F.lds + L_QI);
    __syncthreads();
    if (w == 0) { unsigned loc = 0;
        for (int i = 0; i < 31; ++i) loc += (TOT[31 * lane + i] + 255u) >> 8;
        unsigned inc = loc;
#pragma unroll
        for (int o = 1; o < 64; o <<= 1) { const unsigned v = __shfl_up(inc, o); if (lane >= o) inc += v; }
        unsigned run = inc - loc;
        for (int i = 0; i < 31; ++i) { pre[31 * lane + i] = run; run += (TOT[31 * lane + i] + 255u) >> 8; }
        if (lane == 63) pre[1984] = run; }
    __syncthreads();
    const int U = (int)pre[1984];
    const int ulo = (int)(((long)F.vcu * U) / F.G), uhi = (int)(((long)(F.vcu + 1) * U) / F.G);
    int e = 0; { int lo = 0, hi2 = 1984; while (hi2 - lo > 1) { const int mid = (lo + hi2) >> 1; if ((int)pre[mid] <= ulo) lo = mid; else hi2 = mid; } e = lo; }
    int cur_e = -1, cur_h = -1, it = 0; unsigned tot = 0; float kmax2 = 0.f, bmax = 0.f, rb31 = 0.f;
    for (int u = ulo; u < uhi; ++u, ++it) {
        while (u >= (int)pre[e + 1]) ++e;
        const int c = u - (int)pre[e], bh = e / 31, n = e - bh * 31, b = bh >> 4, h = bh & 15;
        if (e != cur_e) {
            __syncthreads();
            load_kv(F.lds, Kb, Vb, b, h, n, w, lane);
            if (h != cur_h) { build_lut(F.lds, F.rel_bias, h, tid); cur_h = h; }
            if (tid == 0) { unsigned run = 0; for (int o = 0; o <= 32; ++o) { cum[o] = run; if (o < 32 && o > n) run += CNT[((size_t)bh * 32 + o) * 32 + n]; } }
            head_bounds(KBM, F.rel_bias, bh, h, lane, kmax2, bmax); rb31 = F.rel_bias[31 * NH + h] * LOG2E;
            tot = TOT[e]; cur_e = e;
            __syncthreads();
        }
        if (tid < 256) { const unsigned g = 256u * c + tid; unsigned v;
            if (g < tot) { int own = n + 1; while (cum[own + 1] <= g) ++own;
                const unsigned ent = SEG[(((size_t)bh * 32 + own) * 32 + n) * 256 + (g - cum[own])];
                v = (unsigned)(own * BLK + (ent & 255u)) | ((ent >> 8) << 16) | (1u << 18) | ((own - n <= 4) ? (1u << 19) : 0u); }
            else v = (unsigned)(SEQ - 1);
            qi[(it & 1) * 256 + tid] = v; }
        __syncthreads();
        const unsigned info = qi[(it & 1) * 256 + w * 32 + r32];
        const int tq = (int)(info & 0xffffu); const bool near = (info >> 19) & 1u;
        bf16x8 qr[4];
        const float q2 = load_q(qr, Qb, (size_t)b * SEQ + tq, h, hi);
        const float mref = ref_exponent(q2, kmax2, bmax);
        const bool anynear = __any(near);
        const int tqrel = near ? (tq - n * BLK) : 1755;
        LAS const float* lutp = (LAS const float*)(F.lds + L_LUT) + (2047 - tqrel + 4 * hi);
        f32x16 cinit; { const float c0 = anynear ? -mref : (rb31 - mref);
#pragma unroll
            for (int r = 0; r < 16; ++r) cinit[r] = c0; }
        f32x16 o[2]; o[0] = f32x16{}; o[1] = f32x16{}; float l = 0.f;
        const lds_cptr Kl = (lds_cptr)(F.lds + L_K), vp0 = (lds_cptr)(F.lds + L_V) + ((lane >> 4) & 1) * 32 + (lane & 3) * 8 + (4 * hi + ((lane & 15) >> 2)) * 64;
#pragma unroll
        for (int j = 0; j < 4; ++j) { f32x16 p0, p1; v4u pa[4];
            qk_tile(p0, p1, Kl + j * 8192, qr, cinit, r32, hi);
            if (anynear) softmax_tile<true, false>(p0, p1, lutp, j, 0, hi, l, pa); else softmax_tile<false, false>(p0, p1, lutp, j, 0, hi, l, pa);
            pv_tile(o, vp0 + j * 8192, pa); }
        l = swap_add(l);
        LAS bf16* stg = (LAS bf16*)(F.lds + L_OST) + w * 2048;
        stage_o(stg, o, r32, hi);
        if (hi == 0 && ((info >> 18) & 1u)) PL[(((size_t)bh * SEQ + tq) * 3) + ((info >> 16) & 3u)] = l;
#pragma unroll
        for (int i = 0; i < 4; ++i) { const int rw = i * 8 + (lane >> 3), ch = lane & 7; const unsigned inf2 = qi[(it & 1) * 256 + w * 32 + rw];
            const v4u v = *(const LAS v4u*)(stg + rw * 64 + ch * 8);
            if ((inf2 >> 18) & 1u) *(GAS v4u*)(po_row(ws, b, h, (int)(inf2 & 0xffffu), (int)((inf2 >> 16) & 3u)) + ch * 8) = v; }
        LDS_WAIT();
    }
    __syncthreads();
}

__device__ __forceinline__ void own_block(Frame& F) {
    GAS unsigned char* ws = F.ws;
    const GAS bf16* Qb = (const GAS bf16*)(ws + WS_Q); const GAS bf16* Kb = (const GAS bf16*)(ws + WS_K); const GAS bf16* Vb = (const GAS bf16*)(ws + WS_V); GAS bf16* Ob = (GAS bf16*)(ws + WS_Q);
    const GAS float* KBM = (const GAS float*)(ws + WS_KBM); const GAS float* PL = (const GAS float*)(ws + WS_PL);
    int tid = F.tid; asm volatile("" : "+v"(tid));
    const int lane = tid & 63, w = __builtin_amdgcn_readfirstlane(tid >> 6), r32 = lane & 31, hi = lane >> 5;
    int cur_h = -1;
    for (int id = F.vcu; id < BATCH * NH * NBLK; id += F.G) {
        const int own = id >> 6, bh = id & 63, b = bh >> 4, h = bh & 15;
        __syncthreads();
        load_kv(F.lds, Kb, Vb, b, h, own, w, lane);
        if (h != cur_h) { build_lut(F.lds, F.rel_bias, h, tid); cur_h = h; }
        float kmax2, bmax; head_bounds(KBM, F.rel_bias, bh, h, lane, kmax2, bmax);
        const int qrel = 32 * w + r32; const size_t qrow = (size_t)b * SEQ + own * BLK + qrel;
        bf16x8 qr[4];
        const float q2 = load_q(qr, Qb, qrow, h, hi);
        const float mref = ref_exponent(q2, kmax2, bmax);
        __syncthreads();
        LAS const float* lutp = (LAS const float*)(F.lds + L_LUT) + (2047 - qrel + 4 * hi);
        f32x16 cinit;
#pragma unroll
        for (int r = 0; r < 16; ++r) cinit[r] = -mref;
        f32x16 o[2]; o[0] = f32x16{}; o[1] = f32x16{}; float l = 0.f;
        const lds_cptr Kl = (lds_cptr)(F.lds + L_K), vp0 = (lds_cptr)(F.lds + L_V) + ((lane >> 4) & 1) * 32 + (lane & 3) * 8 + (4 * hi + ((lane & 15) >> 2)) * 64;
        const int jd = w >> 1;
        for (int j = 0; j <= jd; ++j) { f32x16 p0, p1; v4u pa[4];
            qk_tile(p0, p1, Kl + j * 8192, qr, cinit, r32, hi);
            if (j == jd) softmax_tile<true, true>(p0, p1, lutp, j, qrel, hi, l, pa); else softmax_tile<true, false>(p0, p1, lutp, j, qrel, hi, l, pa);
            pv_tile(o, vp0 + j * 8192, pa); }
        l = swap_add(l);
        LAS bf16* stg = (LAS bf16*)(F.lds + L_OST) + w * 2048; LAS float* lw = (LAS float*)(F.lds + L_SM) + w * 32;
        if (hi == 0) lw[r32] = l;
        stage_o(stg, o, r32, hi);
        const int rw = lane >> 1, hf = lane & 1, nsl = own < 3 ? own : 3; const size_t trow = (size_t)b * SEQ + own * BLK + 32 * w + rw;
        float acc[32];
#pragma unroll
        for (int i = 0; i < 4; ++i) { const v4u v = *(const LAS v4u*)(stg + rw * 64 + hf * 32 + i * 8);
#pragma unroll
            for (int j = 0; j < 4; ++j) { acc[8 * i + 2 * j] = __builtin_bit_cast(float, v[j] << 16); acc[8 * i + 2 * j + 1] = __builtin_bit_cast(float, v[j] & 0xffff0000u); } }
        float lt = lw[rw];
        for (int s = 0; s < nsl; ++s) { const GAS bf16* pr = po_row(ws, b, h, own * BLK + 32 * w + rw, s) + hf * 32;
            lt += PL[(((size_t)bh * SEQ + own * BLK + 32 * w + rw) * 3) + s];
#pragma unroll
            for (int i = 0; i < 4; ++i) { const v4u v = *(const GAS v4u*)(pr + i * 8);
#pragma unroll
                for (int j = 0; j < 4; ++j) { acc[8 * i + 2 * j] += __builtin_bit_cast(float, v[j] << 16); acc[8 * i + 2 * j + 1] += __builtin_bit_cast(float, v[j] & 0xffff0000u); } } }
        const float inv = 1.0f / lt;
#pragma unroll
        for (int i = 0; i < 4; ++i) { v4u v; v.x = pk2(acc[8 * i] * inv, acc[8 * i + 1] * inv); v.y = pk2(acc[8 * i + 2] * inv, acc[8 * i + 3] * inv); v.z = pk2(acc[8 * i + 4] * inv, acc[8 * i + 5] * inv); v.w = pk2(acc[8 * i + 6] * inv, acc[8 * i + 7] * inv);
            *(GAS v4u*)(Ob + trow * D + h * 64 + hf * 32 + i * 8) = v; }
        LDS_WAIT();
    }
    __syncthreads();
}
}

__device__ __forceinline__ void final_norm(Frame& Fr) {
    struct { int lane, vcu, wave, G; const GAS float* norm_final; GAS float* out; } F{Fr.tid, Fr.vcu, Fr.wave, Fr.G, Fr.norm_final, Fr.out};
    asm volatile("" : "+v"(F.lane)); F.lane &= 63;
    const int gw = F.vcu * NWAVES + F.wave, NGW = F.G * NWAVES;
    f32x4 gam[4];
#pragma unroll
    for (int j = 0; j < 4; ++j) gam[j] = *(const GAS f32x4*)(F.norm_final + 4 * (F.lane + 64 * j));
    for (int row = gw; row < M; row += NGW) { GAS float* xr = F.out + (size_t)row * D; f32x4 v[4]; float ss = 0.f;
#pragma unroll
        for (int j = 0; j < 4; ++j) { v[j] = *(const GAS f32x4*)(xr + 4 * (F.lane + 64 * j)); ss += (v[j][0] * v[j][0] + v[j][1] * v[j][1]) + (v[j][2] * v[j][2] + v[j][3] * v[j][3]); }
        const float rstd = rsqrtf(wave_sum(ss) * (1.0f / D) + EPS);
#pragma unroll
        for (int j = 0; j < 4; ++j) *(GAS f32x4*)(xr + 4 * (F.lane + 64 * j)) = v[j] * rstd * gam[j]; }
}

__global__ void __launch_bounds__(NWAVES * 64, 2) fwd_megakernel(Args args) {
    __shared__ __attribute__((aligned(16))) unsigned char lds[LDS_BYTES];
    Frame F;
    F.lds = (LAS unsigned char*)lds;
    F.tid = threadIdx.x; F.lane = F.tid & 63; F.wave = __builtin_amdgcn_readfirstlane(F.tid >> 6);
    F.G = gridDim.x; { const int bx = blockIdx.x; F.vcu = (F.G % 8 == 0) ? (bx % 8) * (F.G / 8) + bx / 8 : bx; }
    F.x = args.in[0]; F.c = args.in[1]; F.rel_bias = args.in[2]; F.w_mod = args.in[3]; F.b_mod = args.in[4]; F.norm_mix = args.in[5]; F.norm_mlp = args.in[6];
    F.w_pool = args.in[7]; F.pool_scale = args.in[8]; F.w_qkv = args.in[9]; F.w_o = args.in[10]; F.w_up = args.in[11]; F.w_down = args.in[12]; F.norm_final = args.in[13];
    F.out = args.out; F.ws = args.ws;
    volatile LAS unsigned* MISC = (volatile LAS unsigned*)(F.lds + MISC_OFF);
    for (int u = F.tid; u < (LDS_BYTES - LDSCTL_OFF) / 4; u += NWAVES * 64) ((LAS unsigned*)(F.lds + LDSCTL_OFF))[u] = 0u;
    __syncthreads();
    gu32* ctl = (gu32*)(F.ws + WS_CTL);
    XcdBarrier bar = xcd_barrier_post((GAS unsigned*)(ctl + CW_BAR), MISC + 8);
    GAS unsigned char* ws = F.ws;
#define WSB(off) ((GAS bf16*)(ws + (off)))
#define WSF(off) ((GAS float*)(ws + (off)))

    p0_prologue(F);
    xcd_barrier(bar);
    p1_bias(F); p1_pool(F);
    xcd_barrier(bar);

    for (int ph = 0; ph < 11; ++ph) {
        asm volatile("" : "+s"(ws));
        const GAS float* MOD = WSF(WS_MOD); GAS float* SS = WSF(WS_SS);
        const int kind = (ph == 0 || ph == 2 || ph == 7 || ph == 9) ? 0 : (ph == 1 || ph == 8) ? 1 : (ph == 3) ? 2 : (ph == 4) ? 3 : (ph == 5) ? 4 : (ph == 6) ? 5 : 6;
        if (kind == 0) {
            pg8::Gemm g; pg8::EpiRes E;
            if (ph == 0) { g = pg8::Gemm{WSB(WS_XNA), WSB(WS_WPOOL), M, D, 256, D, 256};
                E = pg8::EpiRes{F.x, F.out, MOD + 2048, F.pool_scale, F.norm_mlp, MOD + 4096, WSB(WS_XNB), SS}; }
            else if (ph == 2) { g = pg8::Gemm{WSB(WS_HB), WSB(WS_WDN0), M, D, FF, FF, 0};
                E = pg8::EpiRes{F.out, F.out, MOD + 5120, nullptr, F.norm_mix + D, MOD + 4 * 6144 + 1024, WSB(WS_XNA), SS}; }
            else if (ph == 7) { g = pg8::Gemm{WSB(WS_Q), WSB(WS_WO), M, D, D, D, 0};
                E = pg8::EpiRes{F.out, F.out, MOD + 4 * 6144 + 2048, nullptr, F.norm_mlp + D, MOD + 4 * 6144 + 4096, WSB(WS_XNB), SS}; }
            else { g = pg8::Gemm{WSB(WS_HB), WSB(WS_WDN1), M, D, FF, FF, 0};
                E = pg8::EpiRes{F.out, F.out, MOD + 4 * 6144 + 5120, nullptr, nullptr, nullptr, nullptr, nullptr}; }
            pg8::StaticOrder S; S.init(M, D, F.G, (int)blockIdx.x);
            pg8::gemm_phase<pg8::EpiRes, pg8::StaticOrder, true>(F.lds + RING_OFF, g, S, E);
        } else if (kind == 1) {
            const pg8::Gemm g{WSB(WS_XNB), WSB(ph == 1 ? WS_WUP0 : WS_WUP1), M, FF, D, D, 0};
            const pg8::EpiUp E{SS, WSF(ph == 1 ? WS_BIAS_UP0 : WS_BIAS_UP1), WSB(WS_HB), FF};
            pg8::StaticOrder S; S.init(M, FF, F.G, (int)blockIdx.x);
            pg8::gemm_phase<pg8::EpiUp, pg8::StaticOrder, true>(F.lds + RING_OFF, g, S, E);
        } else if (kind == 2) {
            const pg8::Gemm g{WSB(WS_XNA), WSB(WS_WQKV), M, NQKV, D, D, 0};
            const pg8::EpiQKV E{SS, WSF(WS_BIAS_QKV), WSB(WS_Q), (size_t)(WS_K - WS_Q) / 2, WSF(WS_KMP)};
            pg8::StaticOrder S; S.init(M, NQKV, F.G, (int)blockIdx.x);
            pg8::gemm_phase<pg8::EpiQKV, pg8::StaticOrder, true>(F.lds + RING_OFF, g, S, E);
        } else if (kind == 3) { F.ws = ws; att::route(F);
        } else if (kind == 4) { F.ws = ws; att::gather(F);
        } else if (kind == 5) { F.ws = ws; att::own_block(F);
        } else { final_norm(F); break; }
        xcd_barrier(bar);
    }
}

extern "C" void kernel_launch(void* const* d_in, const int* in_sizes, int n_in, void* d_out, int out_size, void* d_ws, size_t ws_size, hipStream_t stream) {
    static int grid = 0;
    if (grid == 0) {
        if (n_in != 14 || in_sizes[0] != M * D || out_size != M * D || ws_size < WS_END) { fprintf(stderr, "kernel_launch: unexpected shapes / workspace (n_in %d, in0 %d, out %d, ws %zu)\n", n_in, n_in > 0 ? in_sizes[0] : -1, out_size, ws_size); grid = -1; return; }
        int dev = 0, cus = 0, per_cu = 0;
        if (hipGetDevice(&dev) != hipSuccess || hipDeviceGetAttribute(&cus, hipDeviceAttributeMultiprocessorCount, dev) != hipSuccess) { grid = -1; return; }
        if (hipOccupancyMaxActiveBlocksPerMultiprocessor(&per_cu, (const void*)fwd_megakernel, NWAVES * 64, 0) != hipSuccess || per_cu < 1) { fprintf(stderr, "kernel_launch: occupancy query says %d blocks per CU\n", per_cu); }
        (void)hipGetLastError();
        grid = cus;
    }
    if (grid < 0) return;
    if (hipMemsetAsync((char*)d_ws + WS_CTL, 0, CTL_ZERO_BYTES, stream) != hipSuccess) return;
    Args a{};
    for (int i = 0; i < 14; ++i) a.in[i] = (const GAS float*)d_in[i];
    a.out = (GAS float*)d_out; a.ws = (GAS unsigned char*)d_ws;
    hipLaunchKernelGGL(fwd_megakernel, dim3(grid), dim3(NWAVES * 64), 0, stream, a);
}
```

```cpp
#include <hip/hip_runtime.h>
#include <cstdio>
#include <cstdint>

__device__ __forceinline__ float shx(float v, int m, int lane) { return __builtin_bit_cast(float, __builtin_amdgcn_ds_bpermute((lane ^ m) << 2, __builtin_bit_cast(int, v))); }
__device__ __forceinline__ unsigned shup(unsigned v, int o, int lane) { return (unsigned)__builtin_amdgcn_ds_bpermute(((lane - o) & 63) << 2, (int)v); }
__device__ __forceinline__ int lane_id() { return (int)__builtin_amdgcn_mbcnt_hi(~0u, __builtin_amdgcn_mbcnt_lo(~0u, 0u)); }

namespace pg8 {
#define PG8_LAS __attribute__((address_space(3)))
#define PG8_GAS __attribute__((address_space(1)))
typedef unsigned short bf16_t;
typedef short bf16x8 __attribute__((ext_vector_type(8)));
typedef float f32x4 __attribute__((ext_vector_type(4)));
typedef unsigned u32x4 __attribute__((ext_vector_type(4)));
constexpr int BM = 256, BK = 64, HALF = 128, HTB = HALF * BK * 2, STAGE_BYTES = 8 * HTB, NXCD = 8, WGM = 8;

__host__ __device__ __forceinline__ int lds_byte(int r, int c) { const int st = (r >> 4) * 2 + (c >> 5), rr = r & 15, cc = c & 31, ob = rr * 64 + cc * 2; return st * 1024 + (ob ^ (((ob >> 9) & 1) << 5)); }
__host__ __device__ __forceinline__ void stage_rc(int b, int& R, int& C) { const int st = b / 1024, sb = b % 1024, swz = sb ^ (((sb >> 9) & 1) << 5); R = (st >> 1) * 16 + swz / 64; C = (st & 1) * 32 + (swz % 64) / 2; }
__host__ __device__ __forceinline__ int perm32(int rho) { const int n = rho >> 4, i = rho & 15; return 8 * (i >> 2) + 4 * n + (i & 3); }

struct Unit { int pm, pn; };
struct Gemm { const PG8_GAS bf16_t* A; const PG8_GAS bf16_t* Bt; int M, N, K, lda, a_pn_off; };

struct StaticOrder {
    int nM, nN, nwg, G, c;
    __host__ __device__ void init(int M, int N, int G_, int c_) { nM = M / BM; nN = N / BM; nwg = nM * nN; G = G_; c = c_; }
    __host__ __device__ bool next(int i, Unit& u) const {
        const long L = (long)i * G + c; if (L >= nwg) return false;
        int wgid = (int)L; { const int q = nwg / NXCD, r = nwg % NXCD, xcd = wgid % NXCD, off = wgid / NXCD; wgid = (xcd < r ? xcd * (q + 1) : r * (q + 1) + (xcd - r) * q) + off; }
        const int nig = WGM * nN, gid = wgid / nig, fm = gid * WGM, gsz = (nM - fm) < WGM ? (nM - fm) : WGM;
        u.pm = fm + ((wgid % nig) % gsz); u.pn = (wgid % nig) / gsz; return true;
    }
};

__device__ __forceinline__ unsigned cvt_pk_bf16(float lo, float hi) { unsigned r; asm volatile("v_cvt_pk_bf16_f32 %0, %1, %2" : "=v"(r) : "v"(lo), "v"(hi)); return r; }

constexpr int SEQ_ = 8192;
constexpr float EPS_ = 1e-6f;
constexpr float C2_ = 0.125f * 1.4426950408889634f;


__device__ __forceinline__ float row_rstd(const PG8_GAS float* SS, int row, int fq, int fr) {
    const f32x4 s4 = *(const PG8_GAS f32x4*)(SS + (size_t)row * 16 + 4 * fq);
    float s = (s4[0] + s4[1]) + (s4[2] + s4[3]);
    const int ln = fq * 16 + fr; s += shx(s, 16, ln); s += shx(s, 32, ln);
    return rsqrtf(s * (1.0f / 1024.0f) + EPS_);
}

struct EpiRes {
    static constexpr bool PERM = true;
    const PG8_GAS float* R; PG8_GAS float* X; const PG8_GAS float* gate; const PG8_GAS float* cscale; const PG8_GAS float* gnext; const PG8_GAS float* scn; PG8_GAS bf16_t* XN; PG8_GAS float* SS;
    __device__ __forceinline__ void operator()(f32x4 (&acc)[2][2][4][2], const Unit& u, int wr, int wc, int fr, int fq) const {
        const int b = u.pm >> 5, colb = u.pn * BM + wc * 32 + 8 * fq, row0 = u.pm * BM + wr * 64 + fr;
        float ssq[2][4];
#pragma unroll
        for (int bj = 0; bj < 2; ++bj) {
            f32x4 gt[2], cs[2];
#pragma unroll
            for (int n = 0; n < 2; ++n) { const int col = colb + bj * HALF + 4 * n;
                f32x4 gv = *(const PG8_GAS f32x4*)(gate + b * 6144 + col); if (cscale) gv = gv * *(const PG8_GAS f32x4*)(cscale + col); gt[n] = gv;
                if (XN) { const f32x4 sc = *(const PG8_GAS f32x4*)(scn + b * 6144 + col); cs[n] = *(const PG8_GAS f32x4*)(gnext + col) * (sc + 1.0f); } else cs[n] = (f32x4){0.f, 0.f, 0.f, 0.f}; }
#pragma unroll
            for (int ai = 0; ai < 2; ++ai)
#pragma unroll
                for (int m = 0; m < 4; ++m) { const size_t off = (size_t)(row0 + ai * HALF + m * 16) * 1024 + colb + bj * HALF;
                    const f32x4 r0 = *(const PG8_GAS f32x4*)(R + off), r1 = *(const PG8_GAS f32x4*)(R + off + 4);
                    const f32x4 x0 = r0 + gt[0] * acc[ai][bj][m][0], x1 = r1 + gt[1] * acc[ai][bj][m][1];
                    *(PG8_GAS f32x4*)(X + off) = x0; *(PG8_GAS f32x4*)(X + off + 4) = x1;
                    const float q = (x0[0] * x0[0] + x0[1] * x0[1]) + (x0[2] * x0[2] + x0[3] * x0[3]) + (x1[0] * x1[0] + x1[1] * x1[1]) + (x1[2] * x1[2] + x1[3] * x1[3]);
                    ssq[ai][m] = (bj == 0) ? q : ssq[ai][m] + q;
                    if (XN) { const f32x4 a0 = x0 * cs[0], a1 = x1 * cs[1]; u32x4 w; w.x = cvt_pk_bf16(a0[0], a0[1]); w.y = cvt_pk_bf16(a0[2], a0[3]); w.z = cvt_pk_bf16(a1[0], a1[1]); w.w = cvt_pk_bf16(a1[2], a1[3]);
                        *(PG8_GAS u32x4*)(XN + off) = w; }
                }
        }
        if (SS) {
#pragma unroll
            for (int ai = 0; ai < 2; ++ai)
#pragma unroll
                for (int m = 0; m < 4; ++m) { float q = ssq[ai][m]; q += shx(q, 16, fq * 16 + fr); q += shx(q, 32, fq * 16 + fr); if (fq == 0) SS[(size_t)(row0 + ai * HALF + m * 16) * 16 + u.pn * 4 + wc] = q; }
        }
    }
};

struct EpiFinal {
    static constexpr bool PERM = true;
    const PG8_GAS float* R; PG8_GAS float* OUT; const PG8_GAS float* gate; const PG8_GAS float* gfin; PG8_GAS float* SS; PG8_GAS unsigned* cnt;
    __device__ __forceinline__ void operator()(f32x4 (&acc)[2][2][4][2], const Unit& u, int wr, int wc, int fr, int fq) const {
        const int b = u.pm >> 5, colb = u.pn * BM + wc * 32 + 8 * fq, row0 = u.pm * BM + wr * 64 + fr, ln = fq * 16 + fr;
        float ssq[2][4];
#pragma unroll
        for (int bj = 0; bj < 2; ++bj) {
            const f32x4 gt0 = *(const PG8_GAS f32x4*)(gate + b * 6144 + colb + bj * HALF), gt1 = *(const PG8_GAS f32x4*)(gate + b * 6144 + colb + bj * HALF + 4);
#pragma unroll
            for (int ai = 0; ai < 2; ++ai)
#pragma unroll
                for (int m = 0; m < 4; ++m) { const size_t off = (size_t)(row0 + ai * HALF + m * 16) * 1024 + colb + bj * HALF;
                    const f32x4 x0 = *(const PG8_GAS f32x4*)(R + off) + gt0 * acc[ai][bj][m][0], x1 = *(const PG8_GAS f32x4*)(R + off + 4) + gt1 * acc[ai][bj][m][1];
                    acc[ai][bj][m][0] = x0; acc[ai][bj][m][1] = x1;
                    const float q = (x0[0] * x0[0] + x0[1] * x0[1]) + (x0[2] * x0[2] + x0[3] * x0[3]) + (x1[0] * x1[0] + x1[1] * x1[1]) + (x1[2] * x1[2] + x1[3] * x1[3]);
                    ssq[ai][m] = (bj == 0) ? q : ssq[ai][m] + q;
                    asm volatile("" : "+v"(acc[ai][bj][m][0]), "+v"(acc[ai][bj][m][1]), "+v"(ssq[ai][m]));
                    if (m & 1) asm volatile("" ::: "memory"); }
        }
#pragma unroll
        for (int ai = 0; ai < 2; ++ai)
#pragma unroll
            for (int m = 0; m < 4; ++m) { float q = ssq[ai][m]; q += shx(q, 16, ln); q += shx(q, 32, ln);
                if (fq == 0) __hip_atomic_store(SS + (size_t)(row0 + ai * HALF + m * 16) * 16 + u.pn * 4 + wc, q, __ATOMIC_RELAXED, __HIP_MEMORY_SCOPE_AGENT); }
        asm volatile("s_waitcnt vmcnt(0)" ::: "memory");
        PG8_GAS unsigned* c = cnt + 64 * u.pm;
        if (ln == 0) (void)__hip_atomic_fetch_add(c, 1u, __ATOMIC_RELAXED, __HIP_MEMORY_SCOPE_AGENT);
        for (unsigned sp = 0; sp < (1u << 22); ++sp) { if ((unsigned)__builtin_amdgcn_readfirstlane((int)__hip_atomic_load(c, __ATOMIC_RELAXED, __HIP_MEMORY_SCOPE_AGENT)) >= 32u) break; __builtin_amdgcn_s_sleep(2); }
        int row1 = row0, colc = colb; asm volatile("" : "+v"(row1), "+v"(colc));
        float rs[2][4];
#pragma unroll
        for (int ai = 0; ai < 2; ++ai)
#pragma unroll
            for (int m = 0; m < 4; ++m) { const PG8_GAS float* sp4 = SS + (size_t)(row1 + ai * HALF + m * 16) * 16 + 4 * fq;
                float t = (__hip_atomic_load(sp4, __ATOMIC_RELAXED, __HIP_MEMORY_SCOPE_AGENT) + __hip_atomic_load(sp4 + 1, __ATOMIC_RELAXED, __HIP_MEMORY_SCOPE_AGENT))
                        + (__hip_atomic_load(sp4 + 2, __ATOMIC_RELAXED, __HIP_MEMORY_SCOPE_AGENT) + __hip_atomic_load(sp4 + 3, __ATOMIC_RELAXED, __HIP_MEMORY_SCOPE_AGENT));
                t += shx(t, 16, ln); t += shx(t, 32, ln); rs[ai][m] = rsqrtf(t * (1.0f / 1024.0f) + EPS_); }
#pragma unroll
        for (int bj = 0; bj < 2; ++bj) {
            const f32x4 g0 = *(const PG8_GAS f32x4*)(gfin + colc + bj * HALF), g1 = *(const PG8_GAS f32x4*)(gfin + colc + bj * HALF + 4);
#pragma unroll
            for (int ai = 0; ai < 2; ++ai)
#pragma unroll
                for (int m = 0; m < 4; ++m) { const size_t off = (size_t)(row1 + ai * HALF + m * 16) * 1024 + colc + bj * HALF;
                    *(PG8_GAS f32x4*)(OUT + off) = acc[ai][bj][m][0] * rs[ai][m] * g0; *(PG8_GAS f32x4*)(OUT + off + 4) = acc[ai][bj][m][1] * rs[ai][m] * g1; }
        }
    }
};

struct EpiUp {
    static constexpr bool PERM = true;
    const PG8_GAS float* SS; const PG8_GAS float* bias; PG8_GAS bf16_t* O; int ldc;
    __device__ __forceinline__ void operator()(f32x4 (&acc)[2][2][4][2], const Unit& u, int wr, int wc, int fr, int fq) const {
        const int b = u.pm >> 5, colb = u.pn * BM + wc * 32 + 8 * fq, row0 = u.pm * BM + wr * 64 + fr;
        float rs[2][4];
#pragma unroll
        for (int ai = 0; ai < 2; ++ai)
#pragma unroll
            for (int m = 0; m < 4; ++m) rs[ai][m] = row_rstd(SS, row0 + ai * HALF + m * 16, fq, fr);
#pragma unroll
        for (int bj = 0; bj < 2; ++bj) {
            const f32x4 bv0 = *(const PG8_GAS f32x4*)(bias + (size_t)b * ldc + colb + bj * HALF), bv1 = *(const PG8_GAS f32x4*)(bias + (size_t)b * ldc + colb + bj * HALF + 4);
#pragma unroll
            for (int ai = 0; ai < 2; ++ai)
#pragma unroll
                for (int m = 0; m < 4; ++m) { f32x4 v0 = acc[ai][bj][m][0] * rs[ai][m] + bv0, v1 = acc[ai][bj][m][1] * rs[ai][m] + bv1;
#pragma unroll
                    for (int j = 0; j < 4; ++j) { v0[j] = fmaxf(v0[j], 0.f); v1[j] = fmaxf(v1[j], 0.f); }
                    v0 = v0 * v0; v1 = v1 * v1;
                    u32x4 w; w.x = cvt_pk_bf16(v0[0], v0[1]); w.y = cvt_pk_bf16(v0[2], v0[3]); w.z = cvt_pk_bf16(v1[0], v1[1]); w.w = cvt_pk_bf16(v1[2], v1[3]);
                    *(PG8_GAS u32x4*)(O + (size_t)(row0 + ai * HALF + m * 16) * ldc + colb + bj * HALF) = w; }
        }
    }
};

struct EpiQKV {
    static constexpr bool PERM = true;
    const PG8_GAS float* SS; const PG8_GAS float* bias; PG8_GAS bf16_t* Q; size_t split_stride; PG8_GAS float* KMP;
    __device__ __forceinline__ void operator()(f32x4 (&acc)[2][2][4][2], const Unit& u, int wr, int wc, int fr, int fq) const {
        const int b = u.pm >> 5, t = u.pn >> 2, colt = (u.pn & 3) * BM + wc * 32 + 8 * fq, colb = u.pn * BM + wc * 32 + 8 * fq, row0 = u.pm * BM + wr * 64 + fr;
        PG8_GAS bf16_t* base = Q + (size_t)t * split_stride; const float sc = (t == 0) ? C2_ : 1.0f;
        float rs[2][4];
#pragma unroll
        for (int ai = 0; ai < 2; ++ai)
#pragma unroll
            for (int m = 0; m < 4; ++m) rs[ai][m] = row_rstd(SS, row0 + ai * HALF + m * 16, fq, fr);
#pragma unroll
        for (int bj = 0; bj < 2; ++bj) {
            const f32x4 bv0 = *(const PG8_GAS f32x4*)(bias + (size_t)b * 3072 + colb + bj * HALF), bv1 = *(const PG8_GAS f32x4*)(bias + (size_t)b * 3072 + colb + bj * HALF + 4);
            f32x4 cs0 = {0.f, 0.f, 0.f, 0.f}, cs1 = cs0;
#pragma unroll
            for (int ai = 0; ai < 2; ++ai)
#pragma unroll
                for (int m = 0; m < 4; ++m) { f32x4 v0 = acc[ai][bj][m][0] * rs[ai][m] + bv0, v1 = acc[ai][bj][m][1] * rs[ai][m] + bv1;
                    cs0 += v0; cs1 += v1; v0 = v0 * sc; v1 = v1 * sc;
                    u32x4 w; w.x = cvt_pk_bf16(v0[0], v0[1]); w.y = cvt_pk_bf16(v0[2], v0[3]); w.z = cvt_pk_bf16(v1[0], v1[1]); w.w = cvt_pk_bf16(v1[2], v1[3]);
                    *(PG8_GAS u32x4*)(base + (size_t)(row0 + ai * HALF + m * 16) * 1024 + colt + bj * HALF) = w; }
            if (t == 1) {
#pragma unroll
                for (int o = 1; o < 16; o <<= 1) {
#pragma unroll
                    for (int j = 0; j < 4; ++j) { cs0[j] += shx(cs0[j], o, fq * 16 + fr); cs1[j] += shx(cs1[j], o, fq * 16 + fr); } }
                if (fr == 0) { PG8_GAS float* kp = KMP + ((size_t)u.pm * 2 + wr) * 1024 + colt + bj * HALF; *(f32x4*)kp = cs0; *(PG8_GAS f32x4*)(kp + 4) = cs1; }
            }
        }
    }
};

template <class Epi, class Sched, bool ALIGN_EPI>
__device__ __forceinline__ void gemm_phase(PG8_LAS unsigned char* lds, const Gemm g, const Sched& S, const Epi& E, int wave_id) {
    int tid = wave_id * 64 + lane_id(); asm volatile("" : "+v"(tid));
    const int wid = __builtin_amdgcn_readfirstlane(tid >> 6), lane = tid & 63, wr = wid >> 2, wc = wid & 3, fr = lane & 15, fq = lane >> 4;
    const int K = g.K, nt = K / BK, lda = g.lda;
    unsigned voffA[2], voffB[2];
#pragma unroll
    for (int i = 0; i < 2; ++i) { int R, C; stage_rc(tid * 16 + i * 8192, R, C); const int Rb = Epi::PERM ? ((R & ~31) + perm32(R & 31)) : R;
        voffA[i] = (unsigned)(R * lda + C) * 2u; voffB[i] = (unsigned)(Rb * K + C) * 2u; }
    const size_t kstep = (size_t)(BK * 2);
    const size_t hstepA = (size_t)HALF * lda * 2, tstepA = 2 * hstepA, hstepB = (size_t)HALF * K * 2, tstepB = 2 * hstepB;
    const unsigned ldsw = (unsigned)wid * 1024u;
    const int aoff = lds_byte(wr * 64 + fr, fq * 8), boff = lds_byte(wc * 32 + fr, fq * 8);
#define PG8_SA(b, h) (((b) * 2 + (h)) * HTB)
#define PG8_SB(b, h) ((4 + (b) * 2 + (h)) * HTB)
#define PG8_STAGE(bufoff, gbase, voff) do { _Pragma("unroll") for (int _i = 0; _i < 2; ++_i) \
        __builtin_amdgcn_global_load_lds((const PG8_GAS unsigned*)((const PG8_GAS char*)(gbase) + (voff)[_i]), (PG8_LAS unsigned*)(lds + (bufoff) + ldsw + _i * 8192), 16, 0, 0); } while (0)
#define PG8_LDA(dst, b, h) do { _Pragma("unroll") for (int m = 0; m < 4; ++m) _Pragma("unroll") for (int k = 0; k < 2; ++k) dst[m][k] = *(const PG8_LAS bf16x8*)(lds + PG8_SA(b, h) + aoff + m * 2048 + k * 1024); } while (0)
#define PG8_LDB(dst, b, h) do { _Pragma("unroll") for (int n = 0; n < 2; ++n) _Pragma("unroll") for (int k = 0; k < 2; ++k) dst[n][k] = *(const PG8_LAS bf16x8*)(lds + PG8_SB(b, h) + boff + n * 2048 + k * 1024); } while (0)
#define PG8_MMA(ai, bj, At, Bt) do { __builtin_amdgcn_s_setprio(1); _Pragma("unroll") for (int m = 0; m < 4; ++m) _Pragma("unroll") for (int n = 0; n < 2; ++n) _Pragma("unroll") for (int k = 0; k < 2; ++k) \
        acc[ai][bj][m][n] = __builtin_amdgcn_mfma_f32_16x16x32_bf16(Bt[n][k], At[m][k], acc[ai][bj][m][n], 0, 0, 0); __builtin_amdgcn_s_setprio(0); } while (0)
#define PG8_WAIT_V(n) asm volatile("s_waitcnt vmcnt(" #n ")" ::: "memory")
#define PG8_WAIT_L(n) asm volatile("s_waitcnt lgkmcnt(" #n ")" ::: "memory")
#define PG8_BAR __builtin_amdgcn_s_barrier()
#define PG8_SCHED __builtin_amdgcn_sched_barrier(0)
    Unit cur, nxt; int ui = 0;
    if (!S.next(0, cur)) return;
    f32x4 acc[2][2][4][2];
#pragma unroll
    for (int a = 0; a < 2; ++a)
#pragma unroll
        for (int b = 0; b < 2; ++b)
#pragma unroll
            for (int m = 0; m < 4; ++m)
#pragma unroll
                for (int n = 0; n < 2; ++n) acc[a][b][m][n] = (f32x4){0.f, 0.f, 0.f, 0.f};
    bf16x8 At[4][2], B0[2][2], B1[2][2];
    const PG8_GAS char* cA = (const PG8_GAS char*)g.A + (size_t)cur.pm * tstepA + (size_t)cur.pn * g.a_pn_off * 2; const PG8_GAS char* cB = (const PG8_GAS char*)g.Bt + (size_t)cur.pn * tstepB;
    PG8_STAGE(PG8_SB(0, 0), cB, voffB); PG8_STAGE(PG8_SB(0, 1), cB + hstepB, voffB); PG8_STAGE(PG8_SA(0, 0), cA, voffA); PG8_STAGE(PG8_SA(0, 1), cA + hstepA, voffA);
    if (wr == 1) PG8_BAR;
    PG8_WAIT_V(2); PG8_BAR;
    PG8_STAGE(PG8_SB(1, 0), cB + kstep, voffB); PG8_STAGE(PG8_SA(1, 0), cA + kstep, voffA); PG8_STAGE(PG8_SB(1, 1), cB + hstepB + kstep, voffB);
    PG8_WAIT_V(6); PG8_BAR;
    for (;;) {
        const bool has_next = S.next(ui + 1, nxt);
        const PG8_GAS char* nA = has_next ? (const PG8_GAS char*)g.A + (size_t)nxt.pm * tstepA + (size_t)nxt.pn * g.a_pn_off * 2 : cA; const PG8_GAS char* nB = has_next ? (const PG8_GAS char*)g.Bt + (size_t)nxt.pn * tstepB : cB;
        for (int t = 0; t < nt; t += 2) {
            const bool last = (t == nt - 2);
            const PG8_GAS char* a1 = cA + (size_t)(t + 1) * kstep;
            const PG8_GAS char* a2 = last ? nA : cA + (size_t)(t + 2) * kstep; const PG8_GAS char* b2 = last ? nB : cB + (size_t)(t + 2) * kstep;
            const PG8_GAS char* a3 = a2 + kstep; const PG8_GAS char* b3 = b2 + kstep;
            PG8_LDB(B0, 0, 0); PG8_LDB(B1, 0, 1); PG8_SCHED; PG8_LDA(At, 0, 0); PG8_STAGE(PG8_SA(1, 1), a1 + hstepA, voffA);
            PG8_WAIT_V(8); PG8_WAIT_L(0); PG8_BAR; PG8_MMA(0, 0, At, B0); PG8_MMA(0, 1, At, B1); PG8_BAR; PG8_SCHED;
            PG8_LDA(At, 0, 1); PG8_STAGE(PG8_SB(0, 0), b2, voffB); PG8_STAGE(PG8_SB(0, 1), b2 + hstepB, voffB); PG8_STAGE(PG8_SA(0, 0), a2, voffA);
            PG8_WAIT_V(8); PG8_WAIT_L(0); PG8_BAR; PG8_MMA(1, 0, At, B0); PG8_MMA(1, 1, At, B1); PG8_BAR; PG8_SCHED;
            PG8_LDB(B0, 1, 0); PG8_LDB(B1, 1, 1); PG8_SCHED; PG8_LDA(At, 1, 0); PG8_STAGE(PG8_SA(0, 1), a2 + hstepA, voffA);
            PG8_WAIT_V(8); PG8_WAIT_L(0); PG8_BAR; PG8_MMA(0, 0, At, B0); PG8_MMA(0, 1, At, B1); PG8_BAR; PG8_SCHED;
            PG8_LDA(At, 1, 1); PG8_STAGE(PG8_SB(1, 0), b3, voffB); PG8_STAGE(PG8_SB(1, 1), b3 + hstepB, voffB); PG8_STAGE(PG8_SA(1, 0), a3, voffA);
            PG8_WAIT_V(8); PG8_WAIT_L(0); PG8_BAR; PG8_MMA(1, 0, At, B0); PG8_MMA(1, 1, At, B1); PG8_BAR; PG8_SCHED;
        }
        if constexpr (ALIGN_EPI) { if (wr == 0) PG8_BAR; }
        E(acc, cur, wr, wc, fr, fq);
        if (!has_next) break;
#pragma unroll
        for (int a = 0; a < 2; ++a)
#pragma unroll
            for (int b = 0; b < 2; ++b)
#pragma unroll
                for (int m = 0; m < 4; ++m)
#pragma unroll
                    for (int n = 0; n < 2; ++n) acc[a][b][m][n] = (f32x4){0.f, 0.f, 0.f, 0.f};
        cur = nxt; cA = nA; cB = nB; ++ui;
        if constexpr (ALIGN_EPI) { if (wr == 1) PG8_BAR; }
    }
    PG8_WAIT_V(0);
    if constexpr (!ALIGN_EPI) { if (wr == 0) PG8_BAR; }
    PG8_BAR;
#undef PG8_SA
#undef PG8_SB
#undef PG8_STAGE
#undef PG8_LDA
#undef PG8_LDB
#undef PG8_MMA
#undef PG8_WAIT_V
#undef PG8_WAIT_L
#undef PG8_BAR
#undef PG8_SCHED
}
}

constexpr int NWAVES = 8;
constexpr int BATCH = 4, SEQ = 8192, D = 1024, NH = 16, HD = 64, FF = 4096, M = BATCH * SEQ, NQKV = 3 * D, NBLK = 32, BLK = 256;
constexpr float EPS = 1e-6f;
constexpr float LOG2E = 1.4426950408889634f;

constexpr size_t MiB = 1u << 20;
constexpr size_t WS_CTL = 0, CTL_ZERO_BYTES = 1 * MiB;
constexpr size_t WS_MOD = 1 * MiB;
constexpr size_t WS_BIAS_UP0 = WS_MOD + 256 * 1024;
constexpr size_t WS_BIAS_QKV = WS_BIAS_UP0 + 64 * 1024;
constexpr size_t WS_BIAS_UP1 = WS_BIAS_QKV + 64 * 1024;
constexpr size_t WS_KMP = 2 * MiB;
constexpr size_t WS_SS = 3 * MiB;
constexpr size_t WS_WPOOL = 6 * MiB, WS_WQKV = 8 * MiB, WS_WO = 14 * MiB, WS_WUP0 = 16 * MiB, WS_WUP1 = 24 * MiB, WS_WDN0 = 32 * MiB, WS_WDN1 = 40 * MiB;
constexpr size_t WS_XNA = 48 * MiB, WS_XNB = 112 * MiB;
constexpr size_t WS_HB = 176 * MiB;
constexpr size_t WS_Q = 176 * MiB, WS_K = 240 * MiB, WS_V = 304 * MiB;
constexpr size_t WS_POA = 48 * MiB;
constexpr size_t WS_PL = 150 * MiB;
constexpr size_t WS_CNT = 158 * MiB;
constexpr size_t WS_KBM = 159 * MiB;
constexpr size_t WS_POB = 368 * MiB;
constexpr size_t WS_SEG = 470 * MiB;
constexpr size_t WS_END = 504 * MiB;
constexpr int CW_BAR = 4096;
constexpr int CW_FIN = 24576;
constexpr int CW_TOT = 16384;

constexpr int RING_OFF = 0, RING_BYTES = 131072;
constexpr int LDSCTL_OFF = RING_BYTES, MISC_OFF = LDSCTL_OFF + 320;
constexpr int LDS_BYTES = 151552;

#define GAS __attribute__((address_space(1)))
#define LAS __attribute__((address_space(3)))
typedef unsigned short bf16;
typedef unsigned v4u __attribute__((ext_vector_type(4)));
typedef unsigned v2u __attribute__((ext_vector_type(2)));
typedef float f32x4 __attribute__((ext_vector_type(4)));
typedef GAS unsigned gu32;
#define RLX_AGENT __ATOMIC_RELAXED, __HIP_MEMORY_SCOPE_AGENT
#define LDS_WAIT() asm volatile("s_waitcnt lgkmcnt(0)" ::: "memory")
__device__ __forceinline__ unsigned f2bf(float f) { unsigned u = __builtin_bit_cast(unsigned, f); return (u + 0x7fffu + ((u >> 16) & 1u)) >> 16; }
__device__ __forceinline__ unsigned pk2(float lo, float hi) { return f2bf(lo) | (f2bf(hi) << 16); }
__device__ __forceinline__ float bf2f(unsigned short v) { return __builtin_bit_cast(float, (unsigned)v << 16); }

#define XB_TMO      128
#define XB_XCNT(j)  (256  + 64 * (j))
#define XB_XSUB(j)  (1280 + 64 * (j))
#define XB_XGEN(j)  (2304 + 64 * (j))
#define XB_TOP      3328
#define XB_TOPGEN   3392
#define XCD_BAR_WORDS 3456
#define XB_SPIN_CAP (1u << 18)
__device__ __forceinline__ unsigned xb_ld(GAS unsigned* p)              { return __hip_atomic_load(p, __ATOMIC_RELAXED, __HIP_MEMORY_SCOPE_AGENT); }
__device__ __forceinline__ unsigned xb_add(GAS unsigned* p, unsigned v) { return __hip_atomic_fetch_add(p, v, __ATOMIC_RELAXED, __HIP_MEMORY_SCOPE_AGENT); }
__device__ __forceinline__ unsigned xb_xcc_id() { return (unsigned)__builtin_amdgcn_s_getreg((3 << 11) | 20) & 0xFu; }
#define XB_SPIN(cond, bar) do { unsigned _sp = 0; while (cond) { __builtin_amdgcn_s_sleep(1); \
    if ((++_sp & 255u) == 0u) { if (xb_ld(&(bar)[XB_TMO])) break; if (_sp > XB_SPIN_CAP) { (void)xb_add(&(bar)[XB_TMO], 1u); break; } } } } while (0)
struct XcdBarrier { GAS unsigned* bar; unsigned x; volatile LAS unsigned* st; int wave; };
__device__ __forceinline__ XcdBarrier xcd_barrier_post(GAS unsigned* bar, volatile LAS unsigned* st) {
    XcdBarrier b; b.bar = bar; b.x = xb_xcc_id(); b.st = st;
    if (threadIdx.x == 0) (void)xb_add(&bar[XB_XCNT(b.x)], 1u);
    return b;
}
__device__ __forceinline__ void xcd_barrier_complete(GAS unsigned* bar, unsigned x, unsigned& nloc, unsigned& nx) {
    const unsigned G = gridDim.x * gridDim.y * gridDim.z;
    unsigned sum, cnt, mine, sp = 0u;
    for (;;) {
        sum = 0u; cnt = 0u; mine = 0u;
#pragma unroll
        for (unsigned j = 0; j < 16; ++j) { const unsigned c = xb_ld(&bar[XB_XCNT(j)]); sum += c; cnt += (c > 0u) ? 1u : 0u; mine = (j == x) ? c : mine; }
        if (sum == G) break;
        __builtin_amdgcn_s_sleep(1);
        if ((++sp & 255u) == 0u) { if (xb_ld(&bar[XB_TMO])) break; if (sp > XB_SPIN_CAP) { (void)xb_add(&bar[XB_TMO], 1u); break; } }
    }
    nloc = mine > 0u ? mine : 1u; nx = cnt > 0u ? cnt : 1u;
}
__device__ __forceinline__ void xcd_barrier(const XcdBarrier& b) {
    asm volatile("s_waitcnt vmcnt(0)" ::: "memory");
    __syncthreads();
    if (b.wave == 0 && lane_id() == 0) {
        GAS unsigned* bar = b.bar; asm volatile("" : "+s"(bar));
        const unsigned bx = xb_xcc_id();
        __builtin_amdgcn_s_waitcnt(0);
        unsigned nloc = b.st[0], nx = b.st[1];
        if (nloc == 0u) { xcd_barrier_complete(bar, bx, nloc, nx); b.st[0] = nloc; b.st[1] = nx; }
        const unsigned old = xb_add(&bar[XB_XSUB(bx)], 1u);
        const unsigned gen = old / nloc;
        if (old + 1u == (gen + 1u) * nloc) {
            __builtin_amdgcn_fence(__ATOMIC_RELEASE, "agent");
            asm volatile("s_waitcnt vmcnt(0)" ::: "memory");
            const unsigned og = xb_add(&bar[XB_TOP], 1u);
            const unsigned tg = og / nx;
            if (og + 1u == (tg + 1u) * nx) xb_add(&bar[XB_TOPGEN], 1u);
            else XB_SPIN(xb_ld(&bar[XB_TOPGEN]) == tg, bar);
            __builtin_amdgcn_fence(__ATOMIC_ACQUIRE, "agent");
            xb_add(&bar[XB_XGEN(bx)], 1u);
            asm volatile("s_waitcnt vmcnt(0)" ::: "memory");
        } else {
            XB_SPIN(xb_ld(&bar[XB_XGEN(bx)]) == gen, bar);
            __builtin_amdgcn_fence(__ATOMIC_ACQUIRE, "agent");
            asm volatile("s_waitcnt vmcnt(0)" ::: "memory");
        }
    }
    __syncthreads();
}

struct Args { const GAS float* in[14]; GAS float* out; GAS unsigned char* ws; };
struct Frame {
    LAS unsigned char* lds; int tid, lane, wave, vcu, G;
    const GAS float *x, *c, *rel_bias, *w_mod, *b_mod, *norm_mix, *norm_mlp, *w_pool, *pool_scale, *w_qkv, *w_o, *w_up, *w_down, *norm_final;
    GAS float* out; GAS unsigned char* ws;
};
__device__ __forceinline__ float wave_sum(float v) {
#pragma unroll
    for (int o = 1; o < 64; o <<= 1) v += __shfl_xor(v, o);
    return v;
}

__device__ __forceinline__ void p0_transpose_item(const GAS float* W, int K, int N, GAS bf16* WT, int row_off, LAS float* scr, int item, int lane) {
    const int nblk = N / 32, kb = item / nblk, nb = item % nblk, k0 = 64 * kb, n0 = 32 * nb;
    { f32x4 t[8];
#pragma unroll
      for (int i = 0; i < 8; ++i) t[i] = *(const GAS f32x4*)(W + (size_t)(k0 + 8 * i + (lane >> 3)) * N + n0 + 4 * (lane & 7));
#pragma unroll
      for (int i = 0; i < 8; ++i) { LAS float* d = scr + (8 * i + (lane >> 3)) * 33 + 4 * (lane & 7); d[0] = t[i][0]; d[1] = t[i][1]; d[2] = t[i][2]; d[3] = t[i][3]; } }
    LDS_WAIT(); asm volatile("" ::: "memory");
    const int c = lane & 7;
#pragma unroll
    for (int j = 0; j < 4; ++j) { const int n = (lane >> 3) + 8 * j; const LAS float* s = scr + (8 * c) * 33 + n;
        v4u o; o.x = pk2(s[0 * 33], s[1 * 33]); o.y = pk2(s[2 * 33], s[3 * 33]); o.z = pk2(s[4 * 33], s[5 * 33]); o.w = pk2(s[6 * 33], s[7 * 33]);
        *(GAS v4u*)(WT + (size_t)(row_off + n0 + n) * K + k0 + 8 * c) = o; }
    LDS_WAIT(); asm volatile("" ::: "memory");
}
__device__ __forceinline__ void p0_prologue(Frame& F) {
    if (F.vcu < 192) {
        LAS float* cact = (LAS float*)(F.lds + 67584);
        LAS float* red = (LAS float*)(F.lds + 67584 + 16384);
        const int l = F.vcu / 96, j0 = (F.vcu % 96) * 64;
        for (int i = F.tid; i < 4096; i += NWAVES * 64) { const float v = F.c[i]; cact[i] = v / (1.f + __expf(-v)); }
        __syncthreads();
        const int sub = F.lane >> 4, c4 = F.lane & 15;
        f32x4 a0 = {0.f, 0.f, 0.f, 0.f}, a1 = a0, a2 = a0, a3 = a0;
        const GAS float* wb = F.w_mod + (size_t)l * 1024 * 6144 + j0 + 4 * c4;
#pragma unroll 4
        for (int it = 0; it < 32; ++it) { const int k = 32 * it + 4 * F.wave + sub; const f32x4 wv = *(const GAS f32x4*)(wb + (size_t)k * 6144);
            a0 += wv * cact[k]; a1 += wv * cact[1024 + k]; a2 += wv * cact[2048 + k]; a3 += wv * cact[3072 + k]; }
#pragma unroll
        for (int j = 0; j < 4; ++j) { a0[j] += __shfl_xor(a0[j], 16); a0[j] += __shfl_xor(a0[j], 32); a1[j] += __shfl_xor(a1[j], 16); a1[j] += __shfl_xor(a1[j], 32);
            a2[j] += __shfl_xor(a2[j], 16); a2[j] += __shfl_xor(a2[j], 32); a3[j] += __shfl_xor(a3[j], 16); a3[j] += __shfl_xor(a3[j], 32); }
        if (sub == 0) { LAS f32x4* r4 = (LAS f32x4*)(red + F.wave * 256); r4[0 * 16 + c4] = a0; r4[1 * 16 + c4] = a1; r4[2 * 16 + c4] = a2; r4[3 * 16 + c4] = a3; }
        __syncthreads();
        if (F.tid < 256) { const int b = F.tid >> 6, col = F.tid & 63; float s = 0.f;
#pragma unroll
            for (int w = 0; w < 8; ++w) s += red[w * 256 + b * 64 + col];
            ((GAS float*)(F.ws + WS_MOD))[(l * 4 + b) * 6144 + j0 + col] = s + F.b_mod[l * 6144 + j0 + col]; }
    }
    LAS float* scr = (LAS float*)(F.lds + RING_OFF + F.wave * 8448);
    const int gw = F.vcu * NWAVES + F.wave, NGW = F.G * NWAVES;
    constexpr int I_POOL = 4 * 32, I_QKV = 16 * 96, I_O = 16 * 32, I_UP = 16 * 128, I_DN = 64 * 32;
    constexpr int NITEMS = I_POOL + I_QKV + I_O + 2 * I_UP + 2 * I_DN;
    for (int it = gw; it < NITEMS; it += NGW) {
        int r = it;
        if (r < I_POOL) { const int g = r / 32; p0_transpose_item(F.w_pool + (size_t)g * 65536, 256, 256, (GAS bf16*)(F.ws + WS_WPOOL), g * 256, scr, r % 32, F.lane); continue; } r -= I_POOL;
        if (r < I_QKV) { p0_transpose_item(F.w_qkv, D, NQKV, (GAS bf16*)(F.ws + WS_WQKV), 0, scr, r, F.lane); continue; } r -= I_QKV;
        if (r < I_O) { p0_transpose_item(F.w_o, D, D, (GAS bf16*)(F.ws + WS_WO), 0, scr, r, F.lane); continue; } r -= I_O;
        if (r < 2 * I_UP) { const int l = r / I_UP; p0_transpose_item(F.w_up + (size_t)l * D * FF, D, FF, (GAS bf16*)(F.ws + (l ? WS_WUP1 : WS_WUP0)), 0, scr, r % I_UP, F.lane); continue; } r -= 2 * I_UP;
        { const int l = r / I_DN; p0_transpose_item(F.w_down + (size_t)l * FF * D, FF, D, (GAS bf16*)(F.ws + (l ? WS_WDN1 : WS_WDN0)), 0, scr, r % I_DN, F.lane); }
    }
}

__device__ __forceinline__ void p1_bias(Frame& F) {
    const int gw = F.vcu * NWAVES + F.wave, NGW = F.G * NWAVES;
    const GAS float* MOD = (const GAS float*)(F.ws + WS_MOD);
    for (int it = gw; it < 4096 + 3072 + 4096; it += NGW) {
        const GAS bf16* wt; const GAS float* sh; GAS float* dst; int n, N;
        if (it < 4096) { n = it; N = 4096; wt = (const GAS bf16*)(F.ws + WS_WUP0); sh = MOD + 3072; dst = (GAS float*)(F.ws + WS_BIAS_UP0); }
        else if (it < 4096 + 3072) { n = it - 4096; N = 3072; wt = (const GAS bf16*)(F.ws + WS_WQKV); sh = MOD + 4 * 6144; dst = (GAS float*)(F.ws + WS_BIAS_QKV); }
        else { n = it - 7168; N = 4096; wt = (const GAS bf16*)(F.ws + WS_WUP1); sh = MOD + 4 * 6144 + 3072; dst = (GAS float*)(F.ws + WS_BIAS_UP1); }
        const v4u w0 = *(const GAS v4u*)(wt + (size_t)n * 1024 + F.lane * 16), w1 = *(const GAS v4u*)(wt + (size_t)n * 1024 + F.lane * 16 + 8);
        float wf[16];
#pragma unroll
        for (int j = 0; j < 4; ++j) { wf[2 * j] = __builtin_bit_cast(float, w0[j] << 16); wf[2 * j + 1] = __builtin_bit_cast(float, w0[j] & 0xffff0000u);
            wf[8 + 2 * j] = __builtin_bit_cast(float, w1[j] << 16); wf[8 + 2 * j + 1] = __builtin_bit_cast(float, w1[j] & 0xffff0000u); }
#pragma unroll
        for (int b = 0; b < 4; ++b) { const GAS f32x4* sp = (const GAS f32x4*)(sh + b * 6144 + F.lane * 16); float s = 0.f;
#pragma unroll
            for (int j = 0; j < 4; ++j) { const f32x4 sv = sp[j]; s += wf[4 * j] * sv[0] + wf[4 * j + 1] * sv[1] + wf[4 * j + 2] * sv[2] + wf[4 * j + 3] * sv[3]; }
            s = wave_sum(s); if (F.lane == 0) dst[b * N + n] = s; }
    }
}
__device__ __forceinline__ void p1_pool(Frame& F) {
    LAS float* ring = (LAS float*)(F.lds + RING_OFF);
    const GAS float* MOD = (const GAS float*)(F.ws + WS_MOD); GAS bf16* XN = (GAS bf16*)(F.ws + WS_XNA);
    for (int run = F.vcu; run < M / 128; run += F.G) {
        const int t0 = run * 128, s0 = t0 % SEQ, b = t0 / SEQ;
        f32x4 gam[4];
#pragma unroll
        for (int j = 0; j < 4; ++j) gam[j] = *(const GAS f32x4*)(F.norm_mix + 4 * (F.lane + 64 * j));
        const int c4 = F.tid & 255, rh = F.tid >> 8, gi = c4 >> 6, w = 2 << gi;
        const f32x4 sc1 = *(const GAS f32x4*)(MOD + b * 6144 + 1024 + 4 * c4) + 1.0f;
        f32x4 v[2][4];
        const GAS float* xb = F.x + (size_t)b * SEQ * D + 4 * F.lane;
        int st = (s0 > 0 ? -1 : 0);
#pragma unroll
        for (int rr = 0; rr < 2; ++rr)
#pragma unroll
            for (int j = 0; j < 4; ++j) v[rr][j] = *(const GAS f32x4*)(xb + (size_t)(s0 + 16 * st + 2 * F.wave + rr) * D + 256 * j);
        for (; st < 8; ++st) {
            float ss0 = 0.f, ss1 = 0.f;
#pragma unroll
            for (int j = 0; j < 4; ++j) { ss0 += (v[0][j][0] * v[0][j][0] + v[0][j][1] * v[0][j][1]) + (v[0][j][2] * v[0][j][2] + v[0][j][3] * v[0][j][3]);
                ss1 += (v[1][j][0] * v[1][j][0] + v[1][j][1] * v[1][j][1]) + (v[1][j][2] * v[1][j][2] + v[1][j][3] * v[1][j][3]); }
#pragma unroll
            for (int o = 1; o < 64; o <<= 1) { ss0 += __shfl_xor(ss0, o); ss1 += __shfl_xor(ss1, o); }
            const float rs0 = rsqrtf(ss0 * (1.0f / D) + EPS), rs1 = rsqrtf(ss1 * (1.0f / D) + EPS);
            { const int sr = s0 + 16 * st + 2 * F.wave;
#pragma unroll
              for (int j = 0; j < 4; ++j) { *(LAS f32x4*)(ring + (sr & 31) * 1024 + 4 * (F.lane + 64 * j)) = v[0][j] * rs0 * gam[j]; *(LAS f32x4*)(ring + ((sr + 1) & 31) * 1024 + 4 * (F.lane + 64 * j)) = v[1][j] * rs1 * gam[j]; } }
            if (st + 1 < 8) {
#pragma unroll
                for (int rr = 0; rr < 2; ++rr)
#pragma unroll
                    for (int j = 0; j < 4; ++j) v[rr][j] = *(const GAS f32x4*)(xb + (size_t)(s0 + 16 * (st + 1) + 2 * F.wave + rr) * D + 256 * j); }
            __syncthreads();
            if (st >= 0) {
                const int sA = s0 + 16 * st + 8 * rh;
                f32x4 sum = {0.f, 0.f, 0.f, 0.f};
                { const int cnt0 = (sA < w) ? sA : w; for (int i = 1; i <= cnt0; ++i) sum += *(const LAS f32x4*)(ring + ((sA - i) & 31) * 1024 + 4 * c4); }
#pragma unroll
                for (int r = 0; r < 8; ++r) { const int s = sA + r; const f32x4 cur = *(const LAS f32x4*)(ring + (s & 31) * 1024 + 4 * c4);
                    sum += cur; if (s >= w) sum -= *(const LAS f32x4*)(ring + ((s - w) & 31) * 1024 + 4 * c4);
                    const float inv = 1.0f / (float)((s + 1 < w) ? s + 1 : w);
                    const f32x4 p = (sum * inv - cur) * sc1;
                    v2u o; o.x = pk2(p[0], p[1]); o.y = pk2(p[2], p[3]);
                    *(GAS v2u*)(XN + ((size_t)b * SEQ + s) * D + 4 * c4) = o; }
            }
            __syncthreads();
        }
    }
}

__device__ __forceinline__ int t5_bucket(int dist) {
    if (dist < 16) return dist;
    int b = 16;
    b += (dist >= 21); b += (dist >= 27); b += (dist >= 35); b += (dist >= 46); b += (dist >= 59); b += (dist >= 77); b += (dist >= 99); b += (dist >= 128);
    b += (dist >= 166); b += (dist >= 216); b += (dist >= 280); b += (dist >= 363); b += (dist >= 470); b += (dist >= 609); b += (dist >= 790);
    return b;
}
namespace att {
typedef short bf16x8 __attribute__((ext_vector_type(8)));
typedef short s16x4 __attribute__((ext_vector_type(4)));
typedef short v4i16_t __attribute__((ext_vector_type(4)));
typedef float f32x16 __attribute__((ext_vector_type(16)));
typedef float f32x2_t __attribute__((ext_vector_type(2)));
typedef __bf16 bf16x2_t __attribute__((ext_vector_type(2)));
typedef LAS const char* lds_cptr;
constexpr int L_K = 0, L_V = 32768, L_LUT = 132096, L_QI = 141312, L_CUM = 142336, L_PRE = 142592;
constexpr int LUTN = 2304;
__device__ __forceinline__ int crow(int r, int hi) { return (r & 3) + 8 * (r >> 2) + 4 * hi; }
__device__ __forceinline__ unsigned cvtpk(float lo, float hi) { f32x2_t v = {lo, hi}; bf16x2_t b = __builtin_convertvector(v, bf16x2_t); return __builtin_bit_cast(unsigned, b); }
__device__ __forceinline__ s16x4 vtr(lds_cptr p) { return __builtin_bit_cast(s16x4, __builtin_amdgcn_ds_read_tr16_b64_v4i16((LAS v4i16_t*)p)); }
__device__ __forceinline__ float swap_add(float v) { auto rr = __builtin_amdgcn_permlane32_swap(__float_as_uint(v), __float_as_uint(v), false, false); return __uint_as_float(rr[0]) + __uint_as_float(rr[1]); }

__device__ __forceinline__ void load_kv(LAS unsigned char* lds, const GAS bf16* Kb, const GAS bf16* Vb, int b, int h, int n, int w, int lane) {
#pragma unroll
    for (int t = 0; t < 4; ++t) {
        const size_t kr = (size_t)b * SEQ + n * BLK + 64 * t + lane, vr = (size_t)b * SEQ + n * BLK + 64 * t + 16 * (w & 3) + (lane >> 2);
        const v4u kv = *(const GAS v4u*)(Kb + kr * D + h * 64 + w * 8);
        const v4u vv = *(const GAS v4u*)(Vb + vr * D + h * 64 + (w >> 2) * 32 + (lane & 3) * 8);
        *(LAS v4u*)(lds + L_K + t * 8192 + w * 1024 + lane * 16) = kv;
        *(LAS v4u*)(lds + L_V + t * 8192 + w * 1024 + lane * 16) = vv;
    }
}
__device__ __forceinline__ void build_lut(LAS unsigned char* lds, const GAS float* rel_bias, int h, int tid) {
    for (int i = tid; i < LUTN; i += NWAVES * 64) ((LAS float*)(lds + L_LUT))[i] = (i <= 2047) ? rel_bias[t5_bucket(2047 - i) * NH + h] * LOG2E : 0.f;
}
__device__ __forceinline__ void qk_tile(f32x16& p0, f32x16& p1, lds_cptr Kt, const bf16x8* qr, const f32x16& cinit, int r32, int hi) {
    lds_cptr kb = Kt + hi * 1024 + r32 * 16;
#pragma unroll
    for (int d0 = 0; d0 < 4; ++d0) {
        const bf16x8 b0 = *(LAS const bf16x8*)(kb + d0 * 2048), b1 = *(LAS const bf16x8*)(kb + d0 * 2048 + 512);
        if (d0 == 0) { p0 = __builtin_amdgcn_mfma_f32_32x32x16_bf16(b0, qr[0], cinit, 0, 0, 0); p1 = __builtin_amdgcn_mfma_f32_32x32x16_bf16(b1, qr[0], cinit, 0, 0, 0); }
        else { p0 = __builtin_amdgcn_mfma_f32_32x32x16_bf16(b0, qr[d0], p0, 0, 0, 0); p1 = __builtin_amdgcn_mfma_f32_32x32x16_bf16(b1, qr[d0], p1, 0, 0, 0); }
    }
}
template <bool BIAS, bool MASK>
__device__ __forceinline__ void softmax_tile(f32x16& p0, f32x16& p1, LAS const float* lutp, int jt, int qrel, int hi, float& l, v4u* pa) {
#pragma unroll
    for (int r = 0; r < 16; ++r) { const int ko = 64 * jt + (r & 3) + 8 * (r >> 2);
        if (BIAS) { p0[r] += lutp[ko]; p1[r] += lutp[ko + 32]; }
        if (MASK) { const int kv = ko + 4 * hi; if (kv > qrel) p0[r] = -INFINITY; if (kv + 32 > qrel) p1[r] = -INFINITY; }
        p0[r] = __builtin_amdgcn_exp2f(p0[r]); p1[r] = __builtin_amdgcn_exp2f(p1[r]); }
    float s = 0.f;
#pragma unroll
    for (int r = 0; r < 16; ++r) s += p0[r] + p1[r];
    l += s;
    pa[0] = (v4u){cvtpk(p0[0], p0[1]), cvtpk(p0[2], p0[3]), cvtpk(p0[4], p0[5]), cvtpk(p0[6], p0[7])};
    pa[1] = (v4u){cvtpk(p0[8], p0[9]), cvtpk(p0[10], p0[11]), cvtpk(p0[12], p0[13]), cvtpk(p0[14], p0[15])};
    pa[2] = (v4u){cvtpk(p1[0], p1[1]), cvtpk(p1[2], p1[3]), cvtpk(p1[4], p1[5]), cvtpk(p1[6], p1[7])};
    pa[3] = (v4u){cvtpk(p1[8], p1[9]), cvtpk(p1[10], p1[11]), cvtpk(p1[12], p1[13]), cvtpk(p1[14], p1[15])};
}
__device__ __forceinline__ void pv_tile(f32x16* o, lds_cptr vp, const v4u* pa) {
#pragma unroll
    for (int d0 = 0; d0 < 2; ++d0)
#pragma unroll
        for (int ks = 0; ks < 4; ++ks) { const s16x4 lo = vtr(vp + d0 * 4096 + ks * 1024), hi = vtr(vp + d0 * 4096 + ks * 1024 + 512);
            const bf16x8 vf = (bf16x8){lo[0], lo[1], lo[2], lo[3], hi[0], hi[1], hi[2], hi[3]};
            o[d0] = __builtin_amdgcn_mfma_f32_32x32x16_bf16(vf, __builtin_bit_cast(bf16x8, pa[ks]), o[d0], 0, 0, 0); }
}
__device__ __forceinline__ void load_q_raw(bf16x8* qr, const GAS bf16* Qb, size_t qrow, int h, int hi) {
#pragma unroll
    for (int d0 = 0; d0 < 4; ++d0) { const v4u v = *(const GAS v4u*)(Qb + qrow * D + h * 64 + d0 * 16 + hi * 8); qr[d0] = __builtin_bit_cast(bf16x8, v); }
}
__device__ __forceinline__ float q_norm2(const bf16x8* qr) {
    float q2 = 0.f;
#pragma unroll
    for (int d0 = 0; d0 < 4; ++d0) { const v4u v = __builtin_bit_cast(v4u, qr[d0]);
#pragma unroll
        for (int j = 0; j < 4; ++j) { const float a = __builtin_bit_cast(float, v[j] << 16), c = __builtin_bit_cast(float, v[j] & 0xffff0000u); q2 += a * a + c * c; } }
    return swap_add(q2);
}
__device__ __forceinline__ float load_q(bf16x8* qr, const GAS bf16* Qb, size_t qrow, int h, int hi) { load_q_raw(qr, Qb, qrow, h, hi); return q_norm2(qr); }
__device__ __forceinline__ float ref_exponent(float q2, float kmax2, float bmax) { return __builtin_sqrtf(q2 * kmax2) * 1.002f + bmax + 0.01f; }
__device__ __forceinline__ void head_bounds(const GAS float* KBM, const GAS float* rel_bias, int bh, int h, int lane, float& kmax2, float& bmax) {
    float k = KBM[bh * 32 + (lane & 31)], bb = rel_bias[(lane & 31) * NH + h] * LOG2E;
#pragma unroll
    for (int o = 1; o < 32; o <<= 1) { k = fmaxf(k, shx(k, o, lane)); bb = fmaxf(bb, shx(bb, o, lane)); }
    kmax2 = k; bmax = bb;
}
__device__ __forceinline__ void store_row(GAS bf16* rowp, const f32x16* o, float scale, int hi, bool act) {
    unsigned w0[8], w1[8];
#pragma unroll
    for (int k = 0; k < 4; ++k) { w0[2 * k] = cvtpk(o[0][4 * k] * scale, o[0][4 * k + 1] * scale); w0[2 * k + 1] = cvtpk(o[0][4 * k + 2] * scale, o[0][4 * k + 3] * scale);
        w1[2 * k] = cvtpk(o[1][4 * k] * scale, o[1][4 * k + 1] * scale); w1[2 * k + 1] = cvtpk(o[1][4 * k + 2] * scale, o[1][4 * k + 3] * scale); }
#pragma unroll
    for (int i = 0; i < 8; ++i) { auto r = __builtin_amdgcn_permlane32_swap(w0[i], w1[i], false, false); w0[i] = r[0]; w1[i] = r[1]; }
    if (act) {
#pragma unroll
        for (int k = 0; k < 4; ++k) *(GAS v4u*)(rowp + 32 * hi + 8 * k) = (v4u){w0[2 * k], w0[2 * k + 1], w1[2 * k], w1[2 * k + 1]}; }
}
__device__ __forceinline__ void add_row(f32x16* o, const GAS bf16* rowp, int hi) {
    v4u v[4];
#pragma unroll
    for (int k = 0; k < 4; ++k) v[k] = *(const GAS v4u*)(rowp + 32 * hi + 8 * k);
#pragma unroll
    for (int k = 0; k < 4; ++k) { auto r0 = __builtin_amdgcn_permlane32_swap(v[k][0], v[k][2], false, false); auto r1 = __builtin_amdgcn_permlane32_swap(v[k][1], v[k][3], false, false);
        o[0][4 * k] += __builtin_bit_cast(float, r0[0] << 16); o[0][4 * k + 1] += __builtin_bit_cast(float, r0[0] & 0xffff0000u);
        o[0][4 * k + 2] += __builtin_bit_cast(float, r1[0] << 16); o[0][4 * k + 3] += __builtin_bit_cast(float, r1[0] & 0xffff0000u);
        o[1][4 * k] += __builtin_bit_cast(float, r0[1] << 16); o[1][4 * k + 1] += __builtin_bit_cast(float, r0[1] & 0xffff0000u);
        o[1][4 * k + 2] += __builtin_bit_cast(float, r1[1] << 16); o[1][4 * k + 3] += __builtin_bit_cast(float, r1[1] & 0xffff0000u); }
}
__device__ __forceinline__ GAS bf16* po_row(GAS unsigned char* ws, int b, int h, int t, int slot) {
    return (GAS bf16*)(ws + (b < 2 ? WS_POA : WS_POB)) + ((((size_t)((b & 1) * 16 + h) * SEQ + t) * 3 + slot) * 64);
}

__device__ __forceinline__ void route(Frame& F) {
    GAS unsigned char* ws = F.ws;
    const GAS bf16* Qb = (const GAS bf16*)(ws + WS_Q); const GAS bf16* Kb = (const GAS bf16*)(ws + WS_K);
    const GAS float* KMP = (const GAS float*)(ws + WS_KMP);
    GAS unsigned short* SEG = (GAS unsigned short*)(ws + WS_SEG); GAS unsigned* CNT = (GAS unsigned*)(ws + WS_CNT); GAS unsigned* TOT = (GAS unsigned*)(ws + WS_CTL) + CW_TOT;
    GAS float* KBM = (GAS float*)(ws + WS_KBM);
    int tid = F.wave * 64 + lane_id(); asm volatile("" : "+v"(tid));
    const int hf = tid >> 8, t = tid & 255, lane = tid & 63, w4 = (tid >> 6) & 3;
    LAS float* kms = (LAS float*)(F.lds + hf * 16384);
    LAS unsigned* cntw = (LAS unsigned*)(F.lds + hf * 16384 + 8192);
    LAS float* kbw = (LAS float*)(F.lds + hf * 16384 + 8192 + 512);
    for (int it = 0; it < 4; ++it) {
        const int id = it * 512 + F.vcu * 2 + hf, own = id >> 6, bh = id & 63, b = bh >> 4, h = bh & 15;
        __syncthreads();
        for (int i = t; i < NBLK * 64; i += 256) { const int n = i >> 6, d = i & 63; const size_t o = ((size_t)(b * 32 + n) * 2) * 1024 + h * 64 + d; kms[i] = (KMP[o] + KMP[o + 1024]) * (1.0f / 256.0f); }
        const size_t row = (size_t)b * SEQ + own * BLK + t;
        float q[64];
        { const GAS v4u* qp = (const GAS v4u*)(Qb + row * D + h * 64);
#pragma unroll
          for (int i = 0; i < 8; ++i) { const v4u v = qp[i];
#pragma unroll
              for (int j = 0; j < 4; ++j) { q[8 * i + 2 * j] = __builtin_bit_cast(float, v[j] << 16); q[8 * i + 2 * j + 1] = __builtin_bit_cast(float, v[j] & 0xffff0000u); } } }
        { const GAS v4u* kp = (const GAS v4u*)(Kb + row * D + h * 64); float k2 = 0.f;
#pragma unroll
          for (int i = 0; i < 8; ++i) { const v4u v = kp[i];
#pragma unroll
              for (int j = 0; j < 4; ++j) { const float a = __builtin_bit_cast(float, v[j] << 16), c = __builtin_bit_cast(float, v[j] & 0xffff0000u); k2 += a * a + c * c; } }
#pragma unroll
          for (int o = 1; o < 64; o <<= 1) k2 = fmaxf(k2, shx(k2, o, lane));
          if (lane == 0) kbw[w4] = k2; }
        __syncthreads();
        float g1 = -INFINITY, g2 = -INFINITY, g3 = -INFINITY; int i1 = -1, i2 = -1, i3 = -1;
        for (int n = 0; n < own; ++n) {
            float g = 0.f;
#pragma unroll
            for (int d4 = 0; d4 < 16; ++d4) { const f32x4 kv = *(const LAS f32x4*)(kms + n * 64 + 4 * d4); g += q[4 * d4] * kv[0] + q[4 * d4 + 1] * kv[1] + q[4 * d4 + 2] * kv[2] + q[4 * d4 + 3] * kv[3]; }
            if (g > g1) { g3 = g2; i3 = i2; g2 = g1; i2 = i1; g1 = g; i1 = n; }
            else if (g > g2) { g3 = g2; i3 = i2; g2 = g; i2 = n; }
            else if (g > g3) { g3 = g; i3 = n; }
        }
        for (int n = 0; n < own; ++n) { const unsigned long long mm = __ballot(i1 == n || i2 == n || i3 == n); if (lane == 0) cntw[w4 * 32 + n] = (unsigned)__popcll(mm); }
        __syncthreads();
        for (int n = 0; n < own; ++n) { const bool has = (i1 == n || i2 == n || i3 == n); const unsigned long long mm = __ballot(has);
            if (has) { unsigned base = 0; for (int w = 0; w < w4; ++w) base += cntw[w * 32 + n];
                const unsigned rank = (unsigned)__popcll(mm & ((1ull << lane) - 1ull)); const unsigned slot = (i1 == n) ? 0u : (i2 == n) ? 1u : 2u;
                SEG[(((size_t)bh * 32 + own) * 32 + n) * 256 + base + rank] = (unsigned short)(t | (slot << 8)); } }
        if (t < own) { const unsigned c = cntw[t] + cntw[32 + t] + cntw[64 + t] + cntw[96 + t]; CNT[((size_t)bh * 32 + own) * 32 + t] = c; (void)__hip_atomic_fetch_add(TOT + bh * 31 + t, c, RLX_AGENT); }
        if (t == 0) KBM[bh * 32 + own] = fmaxf(fmaxf(kbw[0], kbw[1]), fmaxf(kbw[2], kbw[3]));
    }
    __syncthreads();
}

struct GTile { unsigned info; bf16x8 qr[4]; };
struct GRun { int e, c0, c1; };
__device__ __forceinline__ void dma_kv(LAS unsigned char* kv, const GAS bf16* Kb, const GAS bf16* Vb, int b, int h, int n, int w, int lane) {
#pragma unroll
    for (int t = 0; t < 4; ++t) {
        const size_t kr = (size_t)b * SEQ + n * BLK + 64 * t + lane, vr = (size_t)b * SEQ + n * BLK + 64 * t + 16 * (w & 3) + (lane >> 2);
        __builtin_amdgcn_global_load_lds((const GAS unsigned*)(Kb + kr * D + h * 64 + w * 8), (LAS unsigned*)(kv + L_K + t * 8192 + w * 1024), 16, 0, 0);
        __builtin_amdgcn_global_load_lds((const GAS unsigned*)(Vb + vr * D + h * 64 + (w >> 2) * 32 + (lane & 3) * 8), (LAS unsigned*)(kv + L_V + t * 8192 + w * 1024), 16, 0, 0);
    }
}
__device__ __forceinline__ void gather(Frame& F) {
    GAS unsigned char* ws = F.ws;
    const GAS bf16* Qb = (const GAS bf16*)(ws + WS_Q); const GAS bf16* Kb = (const GAS bf16*)(ws + WS_K); const GAS bf16* Vb = (const GAS bf16*)(ws + WS_V);
    const GAS unsigned short* SEG = (const GAS unsigned short*)(ws + WS_SEG); const GAS unsigned* CNT = (const GAS unsigned*)(ws + WS_CNT); const GAS unsigned* TOT = (const GAS unsigned*)(ws + WS_CTL) + CW_TOT;
    const GAS float* KBM = (const GAS float*)(ws + WS_KBM); GAS float* PL = (GAS float*)(ws + WS_PL);
    int tid = F.wave * 64 + lane_id(); asm volatile("" : "+v"(tid));
    const int lane = tid & 63, w = __builtin_amdgcn_readfirstlane(tid >> 6), r32 = lane & 31, hi = lane >> 5;
    LAS unsigned* pre = (LAS unsigned*)(F.lds + L_PRE);
    __syncthreads();
    if (w == 0) { unsigned loc = 0;
        for (int i = 0; i < 31; ++i) { const unsigned nc = (TOT[31 * lane + i] + 255u) >> 8; loc += nc + (nc ? 1u : 0u); }
        unsigned inc = loc;
#pragma unroll
        for (int o = 1; o < 64; o <<= 1) { const unsigned v = shup(inc, o, lane); if (lane >= o) inc += v; }
        unsigned run = inc - loc;
        for (int i = 0; i < 31; ++i) { pre[31 * lane + i] = run; const unsigned nc = (TOT[31 * lane + i] + 255u) >> 8; run += nc + (nc ? 1u : 0u); }
        if (lane == 63) pre[1984] = run; }
    __syncthreads();
    const int U = (int)pre[1984];
    int p = (int)(((long)F.vcu * U) / F.G); const int phi = (int)(((long)(F.vcu + 1) * U) / F.G);
    int e = 0; { int lo = 0, hi2 = 1984; while (hi2 - lo > 1) { const int mid = (lo + hi2) >> 1; if ((int)pre[mid] <= p) lo = mid; else hi2 = mid; } e = lo; }
    auto next_run = [&](GRun& R) -> bool {
        while (p < phi) {
            while (p >= (int)pre[e + 1]) ++e;
            const int k = p - (int)pre[e], nch = (int)pre[e + 1] - (int)pre[e] - 1;
            const int c0 = k > 0 ? k - 1 : 0; int c1 = phi - (int)pre[e] - 1; c1 = c1 < nch ? c1 : nch;
            p = (int)pre[e] + 1 + c1;
            if (c1 > c0) { R.e = e; R.c0 = c0; R.c1 = c1; return true; }
        }
        return false;
    };
    auto scan_cnt = [&](unsigned v) -> unsigned { unsigned inc = v;
#pragma unroll
        for (int o = 1; o < 32; o <<= 1) { const unsigned t2 = shup(inc, o, lane); if ((lane & 31) >= o) inc += t2; }
        return inc; };
    int cur_h = -1, cur_bh = -1, rb = 0; float kmax2 = 0.f, bmax = 0.f, rb31 = 0.f;
    GRun cur, nxt; bool hc = next_run(cur);
    unsigned cntN = 0, totN = 0, cumv = 0, tot = 0;
    if (hc) { const int bh = cur.e / 31, n = cur.e - bh * 31; dma_kv(F.lds, Kb, Vb, bh >> 4, bh & 15, n, w, lane);
        cntN = ((lane & 31) > n) ? CNT[((size_t)bh * 32 + (lane & 31)) * 32 + n] : 0u; totN = TOT[cur.e]; }
    GTile tcur, tnxt; unsigned ownB = 0, entB = 0xffffffffu; bool mine = false;
    auto fetch_ent = [&](int c, int n, const GAS unsigned short* segb, unsigned cv, unsigned tt, unsigned& own_o) -> unsigned {
        const unsigned g0 = 256u * c + 32u * w, g = g0 + r32;
        if (g0 >= tt) { own_o = 0; return 0xffffffffu; }
        int lo = n + 1, hi2 = 32;
        while (hi2 - lo > 1) { const int mid = (lo + hi2) >> 1; if (__builtin_amdgcn_readlane(cv, mid - 1) <= g0) lo = mid; else hi2 = mid; }
        unsigned own = (unsigned)lo, base = (lo == n + 1) ? 0u : __builtin_amdgcn_readlane(cv, lo - 1);
        for (int o = lo + 1; o < 32; ++o) { const unsigned s2 = __builtin_amdgcn_readlane(cv, o - 1); if (s2 > g0 + 31u) break; if (s2 <= g) { own = (unsigned)o; base = s2; } }
        own_o = own;
        return (g < tt) ? (unsigned)segb[(size_t)own * 32 * 256 + (g - base)] : 0xffffffffu;
    };
    auto make_tile = [&](unsigned ent, unsigned own, int b, int h, int n, GTile& T) {
        const bool act = ent != 0xffffffffu;
        const int tq = act ? (int)(own * BLK + (ent & 255u)) : SEQ - 1;
        T.info = (unsigned)tq | (act ? (((ent >> 8) & 3u) << 16) | (1u << 18) | ((own - n <= 4) ? (1u << 19) : 0u) : 0u);
        load_q_raw(T.qr, Qb, (size_t)b * SEQ + tq, h, hi);
    };
    auto start_run = [&](const GRun& R) {
        const int bh = R.e / 31, n = R.e - bh * 31; const GAS unsigned short* segb = SEG + ((size_t)bh * 32 * 32 + n) * 256;
        cumv = scan_cnt(cntN); tot = totN;
        mine = (unsigned)(256 * R.c0 + 32 * w) < tot;
        entB = 0xffffffffu; ownB = 0;
        if (mine) { unsigned ownA; const unsigned entA = fetch_ent(R.c0, n, segb, cumv, tot, ownA); make_tile(entA, ownA, bh >> 4, bh & 15, n, tcur);
            if (R.c0 + 1 < R.c1) entB = fetch_ent(R.c0 + 1, n, segb, cumv, tot, ownB); }
    };
    if (hc) start_run(cur);
    while (hc) {
        const bool hn = next_run(nxt);
        const int c0 = cur.c0, c1 = cur.c1, bh = cur.e / 31, n = cur.e - bh * 31, b = bh >> 4, h = bh & 15;
        const GAS unsigned short* segb = SEG + ((size_t)bh * 32 * 32 + n) * 256;
        LAS unsigned char* kv = F.lds + rb * 65536;
        asm volatile("s_waitcnt vmcnt(0)" ::: "memory");
        __syncthreads();
        if (hn) { const int bh2 = nxt.e / 31, n2 = nxt.e - bh2 * 31; dma_kv(F.lds + (rb ^ 1) * 65536, Kb, Vb, bh2 >> 4, bh2 & 15, n2, w, lane);
            cntN = ((lane & 31) > n2) ? CNT[((size_t)bh2 * 32 + (lane & 31)) * 32 + n2] : 0u; totN = TOT[nxt.e]; }
        if (bh != cur_bh) { head_bounds(KBM, F.rel_bias, bh, h, lane, kmax2, bmax); rb31 = F.rel_bias[31 * NH + h] * LOG2E; cur_bh = bh;
            if (h != cur_h) { build_lut(F.lds, F.rel_bias, h, tid); cur_h = h; __syncthreads(); } }
        const lds_cptr Kl = (lds_cptr)(kv + L_K), vp0 = (lds_cptr)(kv + L_V) + ((lane >> 4) & 1) * 32 + (lane & 3) * 8 + (4 * hi + ((lane & 15) >> 2)) * 64;
        if (mine) for (int c = c0; c < c1; ++c) {
            if ((unsigned)(256 * c + 32 * w) >= tot) break;
            const bool has1 = (c + 1 < c1) && ((unsigned)(256 * (c + 1) + 32 * w) < tot);
            if (has1) make_tile(entB, ownB, b, h, n, tnxt);
            if (c + 2 < c1) entB = fetch_ent(c + 2, n, segb, cumv, tot, ownB); else { entB = 0xffffffffu; ownB = 0; }
            const unsigned info = tcur.info; const int tq = (int)(info & 0xffffu); const bool near = (info >> 19) & 1u;
            const float mref = ref_exponent(q_norm2(tcur.qr), kmax2, bmax);
            const bool anynear = __any(near);
            const int tqrel = near ? (tq - n * BLK) : 1755;
            LAS const float* lutp = (LAS const float*)(F.lds + L_LUT) + (2047 - tqrel + 4 * hi);
            f32x16 cinit; { const float cc = anynear ? -mref : (rb31 - mref);
#pragma unroll
                for (int r = 0; r < 16; ++r) cinit[r] = cc; }
            f32x16 o[2]; o[0] = f32x16{}; o[1] = f32x16{}; float l = 0.f;
#pragma unroll
            for (int j = 0; j < 4; ++j) { f32x16 p0, p1; v4u pa[4];
                qk_tile(p0, p1, Kl + j * 8192, tcur.qr, cinit, r32, hi);
                if (anynear) softmax_tile<true, false>(p0, p1, lutp, j, 0, hi, l, pa); else softmax_tile<false, false>(p0, p1, lutp, j, 0, hi, l, pa);
                pv_tile(o, vp0 + j * 8192, pa); }
            l = swap_add(l);
            { const bool act = (info >> 18) & 1u; const int slot = (int)((info >> 16) & 3u);
              store_row(po_row(ws, b, h, tq, slot), o, 1.0f, hi, act);
              if (act && hi == 0) PL[(((size_t)bh * SEQ + tq) * 3) + slot] = l; }
            if (has1) tcur = tnxt;
        }
        if (hn) start_run(nxt);
        cur = nxt; hc = hn; rb ^= 1;
    }
    asm volatile("s_waitcnt vmcnt(0)" ::: "memory");
    __syncthreads();
}

__device__ __forceinline__ void own_block(Frame& F) {
    GAS unsigned char* ws = F.ws;
    const GAS bf16* Qb = (const GAS bf16*)(ws + WS_Q); const GAS bf16* Kb = (const GAS bf16*)(ws + WS_K); const GAS bf16* Vb = (const GAS bf16*)(ws + WS_V); GAS bf16* Ob = (GAS bf16*)(ws + WS_Q);
    const GAS float* KBM = (const GAS float*)(ws + WS_KBM); const GAS float* PL = (const GAS float*)(ws + WS_PL);
    int tid = F.wave * 64 + lane_id(); asm volatile("" : "+v"(tid));
    const int lane = tid & 63, w = __builtin_amdgcn_readfirstlane(tid >> 6), r32 = lane & 31, hi = lane >> 5;
    int cur_h = -1;
    for (int id = F.vcu; id < BATCH * NH * NBLK; id += F.G) {
        const int own = id >> 6, bh = id & 63, b = bh >> 4, h = bh & 15;
        __syncthreads();
        load_kv(F.lds, Kb, Vb, b, h, own, w, lane);
        if (h != cur_h) { build_lut(F.lds, F.rel_bias, h, tid); cur_h = h; }
        float kmax2, bmax; head_bounds(KBM, F.rel_bias, bh, h, lane, kmax2, bmax);
        const int qrel = 32 * w + r32; const size_t qrow = (size_t)b * SEQ + own * BLK + qrel;
        bf16x8 qr[4];
        const float q2 = load_q(qr, Qb, qrow, h, hi);
        const float mref = ref_exponent(q2, kmax2, bmax);
        __syncthreads();
        LAS const float* lutp = (LAS const float*)(F.lds + L_LUT) + (2047 - qrel + 4 * hi);
        f32x16 cinit;
#pragma unroll
        for (int r = 0; r < 16; ++r) cinit[r] = -mref;
        f32x16 o[2]; o[0] = f32x16{}; o[1] = f32x16{}; float l = 0.f;
        const lds_cptr Kl = (lds_cptr)(F.lds + L_K), vp0 = (lds_cptr)(F.lds + L_V) + ((lane >> 4) & 1) * 32 + (lane & 3) * 8 + (4 * hi + ((lane & 15) >> 2)) * 64;
        const int jd = w >> 1;
        for (int j = 0; j <= jd; ++j) { f32x16 p0, p1; v4u pa[4];
            qk_tile(p0, p1, Kl + j * 8192, qr, cinit, r32, hi);
            if (j == jd) softmax_tile<true, true>(p0, p1, lutp, j, qrel, hi, l, pa); else softmax_tile<true, false>(p0, p1, lutp, j, qrel, hi, l, pa);
            pv_tile(o, vp0 + j * 8192, pa); }
        l = swap_add(l);
        const int nsl = own < 3 ? own : 3; const int tq = own * BLK + qrel;
        for (int sl = 0; sl < nsl; ++sl) { add_row(o, po_row(ws, b, h, tq, sl), hi); l += PL[(((size_t)bh * SEQ + tq) * 3) + sl]; }
        store_row(Ob + qrow * D + h * 64, o, 1.0f / l, hi, true);
    }
    __syncthreads();
}
}

__device__ __forceinline__ void final_norm(Frame& Fr) {
    struct { int lane, vcu, wave, G; const GAS float* norm_final; GAS float* out; } F{Fr.wave * 64 + lane_id(), Fr.vcu, Fr.wave, Fr.G, Fr.norm_final, Fr.out};
    asm volatile("" : "+v"(F.lane)); F.lane &= 63;
    const int gw = F.vcu * NWAVES + F.wave, NGW = F.G * NWAVES;
    f32x4 gam[4];
#pragma unroll
    for (int j = 0; j < 4; ++j) gam[j] = *(const GAS f32x4*)(F.norm_final + 4 * (F.lane + 64 * j));
    for (int row = gw; row < M; row += NGW) { GAS float* xr = F.out + (size_t)row * D; f32x4 v[4]; float ss = 0.f;
#pragma unroll
        for (int j = 0; j < 4; ++j) { v[j] = *(const GAS f32x4*)(xr + 4 * (F.lane + 64 * j)); ss += (v[j][0] * v[j][0] + v[j][1] * v[j][1]) + (v[j][2] * v[j][2] + v[j][3] * v[j][3]); }
#pragma unroll
        for (int o = 1; o < 64; o <<= 1) ss += shx(ss, o, F.lane);
        const float rstd = rsqrtf(ss * (1.0f / D) + EPS);
#pragma unroll
        for (int j = 0; j < 4; ++j) *(GAS f32x4*)(xr + 4 * (F.lane + 64 * j)) = v[j] * rstd * gam[j]; }
}

__global__ void __launch_bounds__(NWAVES * 64, 2) fwd_megakernel(Args args) {
    __shared__ __attribute__((aligned(16))) unsigned char lds[LDS_BYTES];
    Frame F;
    F.lds = (LAS unsigned char*)lds;
    F.tid = threadIdx.x; F.lane = F.tid & 63; F.wave = __builtin_amdgcn_readfirstlane(F.tid >> 6);
    F.G = gridDim.x; { const int bx = blockIdx.x; F.vcu = (F.G % 8 == 0) ? (bx % 8) * (F.G / 8) + bx / 8 : bx; }
    F.x = args.in[0]; F.c = args.in[1]; F.rel_bias = args.in[2]; F.w_mod = args.in[3]; F.b_mod = args.in[4]; F.norm_mix = args.in[5]; F.norm_mlp = args.in[6];
    F.w_pool = args.in[7]; F.pool_scale = args.in[8]; F.w_qkv = args.in[9]; F.w_o = args.in[10]; F.w_up = args.in[11]; F.w_down = args.in[12]; F.norm_final = args.in[13];
    F.out = args.out; F.ws = args.ws;
    volatile LAS unsigned* MISC = (volatile LAS unsigned*)(F.lds + MISC_OFF);
    for (int u = F.tid; u < (LDS_BYTES - LDSCTL_OFF) / 4; u += NWAVES * 64) ((LAS unsigned*)(F.lds + LDSCTL_OFF))[u] = 0u;
    __syncthreads();
    gu32* ctl = (gu32*)(F.ws + WS_CTL);
    XcdBarrier bar = xcd_barrier_post((GAS unsigned*)(ctl + CW_BAR), MISC + 8); bar.wave = F.wave;
    GAS unsigned char* ws = F.ws;
#define WSB(off) ((GAS bf16*)(ws + (off)))
#define WSF(off) ((GAS float*)(ws + (off)))

    p0_prologue(F);
    xcd_barrier(bar);
    p1_bias(F); p1_pool(F);
    xcd_barrier(bar);

    for (int ph = 0; ph < 10; ++ph) {
        asm volatile("" : "+s"(ws));
        const GAS float* MOD = WSF(WS_MOD); GAS float* SS = WSF(WS_SS);
        const int kind = (ph == 0 || ph == 2 || ph == 7) ? 0 : (ph == 1 || ph == 8) ? 1 : (ph == 3) ? 2 : (ph == 4) ? 3 : (ph == 5) ? 4 : (ph == 6) ? 5 : 7;
        if (kind == 0) {
            pg8::Gemm g; pg8::EpiRes E;
            if (ph == 0) { g = pg8::Gemm{WSB(WS_XNA), WSB(WS_WPOOL), M, D, 256, D, 256};
                E = pg8::EpiRes{F.x, F.out, MOD + 2048, F.pool_scale, F.norm_mlp, MOD + 4096, WSB(WS_XNB), SS}; }
            else if (ph == 2) { g = pg8::Gemm{WSB(WS_HB), WSB(WS_WDN0), M, D, FF, FF, 0};
                E = pg8::EpiRes{F.out, F.out, MOD + 5120, nullptr, F.norm_mix + D, MOD + 4 * 6144 + 1024, WSB(WS_XNA), SS}; }
            else { g = pg8::Gemm{WSB(WS_Q), WSB(WS_WO), M, D, D, D, 0};
                E = pg8::EpiRes{F.out, F.out, MOD + 4 * 6144 + 2048, nullptr, F.norm_mlp + D, MOD + 4 * 6144 + 4096, WSB(WS_XNB), SS}; }
            pg8::StaticOrder S; S.init(M, D, F.G, (int)blockIdx.x);
            pg8::gemm_phase<pg8::EpiRes, pg8::StaticOrder, true>(F.lds + RING_OFF, g, S, E, F.wave);
        } else if (kind == 1) {
            const pg8::Gemm g{WSB(WS_XNB), WSB(ph == 1 ? WS_WUP0 : WS_WUP1), M, FF, D, D, 0};
            const pg8::EpiUp E{SS, WSF(ph == 1 ? WS_BIAS_UP0 : WS_BIAS_UP1), WSB(WS_HB), FF};
            pg8::StaticOrder S; S.init(M, FF, F.G, (int)blockIdx.x);
            pg8::gemm_phase<pg8::EpiUp, pg8::StaticOrder, true>(F.lds + RING_OFF, g, S, E, F.wave);
        } else if (kind == 2) {
            const pg8::Gemm g{WSB(WS_XNA), WSB(WS_WQKV), M, NQKV, D, D, 0};
            const pg8::EpiQKV E{SS, WSF(WS_BIAS_QKV), WSB(WS_Q), (size_t)(WS_K - WS_Q) / 2, WSF(WS_KMP)};
            pg8::StaticOrder S; S.init(M, NQKV, F.G, (int)blockIdx.x);
            pg8::gemm_phase<pg8::EpiQKV, pg8::StaticOrder, true>(F.lds + RING_OFF, g, S, E, F.wave);
        } else if (kind == 3) { F.ws = ws; att::route(F);
        } else if (kind == 4) { F.ws = ws; att::gather(F);
        } else if (kind == 5) { F.ws = ws; att::own_block(F);
        } else {
            const pg8::Gemm g{WSB(WS_HB), WSB(WS_WDN1), M, D, FF, FF, 0};
            const pg8::EpiFinal E{F.out, F.out, MOD + 4 * 6144 + 5120, F.norm_final, SS, (GAS unsigned*)(ws + WS_CTL) + CW_FIN};
            pg8::StaticOrder S; S.init(M, D, F.G, (int)blockIdx.x);
            pg8::gemm_phase<pg8::EpiFinal, pg8::StaticOrder, true>(F.lds + RING_OFF, g, S, E, F.wave);
            break;
        }
        xcd_barrier(bar);
    }
}

extern "C" void kernel_launch(void* const* d_in, const int* in_sizes, int n_in, void* d_out, int out_size, void* d_ws, size_t ws_size, hipStream_t stream) {
    static int grid = 0;
    if (grid == 0) {
        if (n_in != 14 || in_sizes[0] != M * D || out_size != M * D || ws_size < WS_END) { fprintf(stderr, "kernel_launch: unexpected shapes / workspace (n_in %d, in0 %d, out %d, ws %zu)\n", n_in, n_in > 0 ? in_sizes[0] : -1, out_size, ws_size); grid = -1; return; }
        int dev = 0, cus = 0, per_cu = 0;
        if (hipGetDevice(&dev) != hipSuccess || hipDeviceGetAttribute(&cus, hipDeviceAttributeMultiprocessorCount, dev) != hipSuccess) { grid = -1; return; }
        if (hipOccupancyMaxActiveBlocksPerMultiprocessor(&per_cu, (const void*)fwd_megakernel, NWAVES * 64, 0) != hipSuccess || per_cu < 1) { fprintf(stderr, "kernel_launch: occupancy query says %d blocks per CU\n", per_cu); }
        (void)hipGetLastError();
        grid = cus;
    }
    if (grid < 0) return;
    if (hipMemsetAsync((char*)d_ws + WS_CTL, 0, CTL_ZERO_BYTES, stream) != hipSuccess) return;
    Args a{};
    for (int i = 0; i < 14; ++i) a.in[i] = (const GAS float*)d_in[i];
    a.out = (GAS float*)d_out; a.ws = (GAS unsigned char*)d_ws;
    hipLaunchKernelGGL(fwd_megakernel, dim3(grid), dim3(NWAVES * 64), 0, stream, a);
}
```

```cpp
#include <hip/hip_runtime.h>
#include <cstdio>
#include <cstdint>

__device__ __forceinline__ float shx(float v, int m, int lane) { return __builtin_bit_cast(float, __builtin_amdgcn_ds_bpermute((lane ^ m) << 2, __builtin_bit_cast(int, v))); }
__device__ __forceinline__ unsigned shup(unsigned v, int o, int lane) { return (unsigned)__builtin_amdgcn_ds_bpermute(((lane - o) & 63) << 2, (int)v); }
__device__ __forceinline__ int lane_id() { unsigned z = 0u; asm volatile("" : "+s"(z)); return (int)__builtin_amdgcn_mbcnt_hi(~0u, __builtin_amdgcn_mbcnt_lo(~0u, z)); }

namespace pg8 {
#define PG8_LAS __attribute__((address_space(3)))
#define PG8_GAS __attribute__((address_space(1)))
typedef unsigned short bf16_t;
typedef short bf16x8 __attribute__((ext_vector_type(8)));
typedef float f32x4 __attribute__((ext_vector_type(4)));
typedef unsigned u32x4 __attribute__((ext_vector_type(4)));
constexpr int BM = 256, BK = 64, HALF = 128, HTB = HALF * BK * 2, STAGE_BYTES = 8 * HTB, NXCD = 8, WGM = 8;

__host__ __device__ __forceinline__ int lds_byte(int r, int c) { const int st = (r >> 4) * 2 + (c >> 5), rr = r & 15, cc = c & 31, ob = rr * 64 + cc * 2; return st * 1024 + (ob ^ (((ob >> 9) & 1) << 5)); }
__host__ __device__ __forceinline__ void stage_rc(int b, int& R, int& C) { const int st = b / 1024, sb = b % 1024, swz = sb ^ (((sb >> 9) & 1) << 5); R = (st >> 1) * 16 + swz / 64; C = (st & 1) * 32 + (swz % 64) / 2; }
__host__ __device__ __forceinline__ int perm32(int rho) { const int n = rho >> 4, i = rho & 15; return 8 * (i >> 2) + 4 * n + (i & 3); }

struct Unit { int pm, pn; };
struct Gemm { const PG8_GAS bf16_t* A; const PG8_GAS bf16_t* Bt; int M, N, K, lda, a_pn_off; };

struct StaticOrder {
    int nM, nN, nwg, G, c;
    __host__ __device__ void init(int M, int N, int G_, int c_) { nM = M / BM; nN = N / BM; nwg = nM * nN; G = G_; c = c_; }
    __host__ __device__ bool next(int i, Unit& u) const {
        const long L = (long)i * G + c; if (L >= nwg) return false;
        int wgid = (int)L; { const int q = nwg / NXCD, r = nwg % NXCD, xcd = wgid % NXCD, off = wgid / NXCD; wgid = (xcd < r ? xcd * (q + 1) : r * (q + 1) + (xcd - r) * q) + off; }
        const int nig = WGM * nN, gid = wgid / nig, fm = gid * WGM, gsz = (nM - fm) < WGM ? (nM - fm) : WGM;
        u.pm = fm + ((wgid % nig) % gsz); u.pn = (wgid % nig) / gsz; return true;
    }
};

__device__ __forceinline__ unsigned cvt_pk_bf16(float lo, float hi) { unsigned r; asm volatile("v_cvt_pk_bf16_f32 %0, %1, %2" : "=v"(r) : "v"(lo), "v"(hi)); return r; }

constexpr int SEQ_ = 8192;
constexpr float EPS_ = 1e-6f;
constexpr float C2_ = 0.125f * 1.4426950408889634f;


__device__ __forceinline__ float row_rstd(const PG8_GAS float* SS, int row, int fq, int fr) {
    const f32x4 s4 = *(const PG8_GAS f32x4*)(SS + (size_t)row * 16 + 4 * fq);
    float s = (s4[0] + s4[1]) + (s4[2] + s4[3]);
    const int ln = fq * 16 + fr; s += shx(s, 16, ln); s += shx(s, 32, ln);
    return rsqrtf(s * (1.0f / 1024.0f) + EPS_);
}

__device__ __forceinline__ f32x4 bf_lo4(const u32x4& w) { return (f32x4){__builtin_bit_cast(float, w.x << 16), __builtin_bit_cast(float, w.x & 0xffff0000u), __builtin_bit_cast(float, w.y << 16), __builtin_bit_cast(float, w.y & 0xffff0000u)}; }
__device__ __forceinline__ f32x4 bf_hi4(const u32x4& w) { return (f32x4){__builtin_bit_cast(float, w.z << 16), __builtin_bit_cast(float, w.z & 0xffff0000u), __builtin_bit_cast(float, w.w << 16), __builtin_bit_cast(float, w.w & 0xffff0000u)}; }
struct EpiRes {
    static constexpr bool PERM = true;
    const PG8_GAS bf16_t* Rb; PG8_GAS bf16_t* Xb; const PG8_GAS float* gate; const PG8_GAS float* cscale; const PG8_GAS float* gnext; const PG8_GAS float* scn; PG8_GAS bf16_t* XN; PG8_GAS float* SS;
    __device__ __forceinline__ void operator()(f32x4 (&acc)[2][2][4][2], const Unit& u, int wr, int wc, int fr, int fq) const {
        const int b = u.pm >> 5, colb = u.pn * BM + wc * 32 + 8 * fq, row0 = u.pm * BM + wr * 64 + fr;
        float ssq[2][4];
#pragma unroll
        for (int bj = 0; bj < 2; ++bj) {
            f32x4 gt[2], cs[2];
#pragma unroll
            for (int n = 0; n < 2; ++n) { const int col = colb + bj * HALF + 4 * n;
                f32x4 gv = *(const PG8_GAS f32x4*)(gate + b * 6144 + col); if (cscale) gv = gv * *(const PG8_GAS f32x4*)(cscale + col); gt[n] = gv;
                const f32x4 sc = *(const PG8_GAS f32x4*)(scn + b * 6144 + col); cs[n] = *(const PG8_GAS f32x4*)(gnext + col) * (sc + 1.0f); }
#pragma unroll
            for (int ai = 0; ai < 2; ++ai)
#pragma unroll
                for (int m = 0; m < 4; ++m) { const size_t off = (size_t)(row0 + ai * HALF + m * 16) * 1024 + colb + bj * HALF;
                    const u32x4 rw = *(const PG8_GAS u32x4*)(Rb + off); const f32x4 r0 = bf_lo4(rw), r1 = bf_hi4(rw);
                    const f32x4 y0 = r0 + gt[0] * acc[ai][bj][m][0], y1 = r1 + gt[1] * acc[ai][bj][m][1];
                    u32x4 xw; xw.x = cvt_pk_bf16(y0[0], y0[1]); xw.y = cvt_pk_bf16(y0[2], y0[3]); xw.z = cvt_pk_bf16(y1[0], y1[1]); xw.w = cvt_pk_bf16(y1[2], y1[3]);
                    *(PG8_GAS u32x4*)(Xb + off) = xw;
                    const f32x4 x0 = bf_lo4(xw), x1 = bf_hi4(xw);
                    const float q = (x0[0] * x0[0] + x0[1] * x0[1]) + (x0[2] * x0[2] + x0[3] * x0[3]) + (x1[0] * x1[0] + x1[1] * x1[1]) + (x1[2] * x1[2] + x1[3] * x1[3]);
                    ssq[ai][m] = (bj == 0) ? q : ssq[ai][m] + q;
                    const f32x4 a0 = x0 * cs[0], a1 = x1 * cs[1]; u32x4 w; w.x = cvt_pk_bf16(a0[0], a0[1]); w.y = cvt_pk_bf16(a0[2], a0[3]); w.z = cvt_pk_bf16(a1[0], a1[1]); w.w = cvt_pk_bf16(a1[2], a1[3]);
                    *(PG8_GAS u32x4*)(XN + off) = w;
                }
        }
#pragma unroll
        for (int ai = 0; ai < 2; ++ai)
#pragma unroll
            for (int m = 0; m < 4; ++m) { float q = ssq[ai][m]; q += shx(q, 16, fq * 16 + fr); q += shx(q, 32, fq * 16 + fr); if (fq == 0) SS[(size_t)(row0 + ai * HALF + m * 16) * 16 + u.pn * 4 + wc] = q; }
    }
};

struct EpiFinal {
    static constexpr bool PERM = true;
    const PG8_GAS bf16_t* R; PG8_GAS float* OUT; const PG8_GAS float* gate; const PG8_GAS float* gfin; PG8_GAS float* SS; PG8_GAS unsigned* cnt;
    __device__ __forceinline__ void operator()(f32x4 (&acc)[2][2][4][2], const Unit& u, int wr, int wc, int fr, int fq) const {
        const int b = u.pm >> 5, colb = u.pn * BM + wc * 32 + 8 * fq, row0 = u.pm * BM + wr * 64 + fr, ln = fq * 16 + fr;
        float ssq[2][4];
#pragma unroll
        for (int bj = 0; bj < 2; ++bj) {
            const f32x4 gt0 = *(const PG8_GAS f32x4*)(gate + b * 6144 + colb + bj * HALF), gt1 = *(const PG8_GAS f32x4*)(gate + b * 6144 + colb + bj * HALF + 4);
#pragma unroll
            for (int ai = 0; ai < 2; ++ai)
#pragma unroll
                for (int m = 0; m < 4; ++m) { const size_t off = (size_t)(row0 + ai * HALF + m * 16) * 1024 + colb + bj * HALF;
                    const u32x4 rw = *(const PG8_GAS u32x4*)(R + off);
                    const f32x4 x0 = bf_lo4(rw) + gt0 * acc[ai][bj][m][0], x1 = bf_hi4(rw) + gt1 * acc[ai][bj][m][1];
                    acc[ai][bj][m][0] = x0; acc[ai][bj][m][1] = x1;
                    const float q = (x0[0] * x0[0] + x0[1] * x0[1]) + (x0[2] * x0[2] + x0[3] * x0[3]) + (x1[0] * x1[0] + x1[1] * x1[1]) + (x1[2] * x1[2] + x1[3] * x1[3]);
                    ssq[ai][m] = (bj == 0) ? q : ssq[ai][m] + q;
                    asm volatile("" : "+v"(acc[ai][bj][m][0]), "+v"(acc[ai][bj][m][1]), "+v"(ssq[ai][m]));
                    if (m & 1) asm volatile("" ::: "memory"); }
        }
#pragma unroll
        for (int ai = 0; ai < 2; ++ai)
#pragma unroll
            for (int m = 0; m < 4; ++m) { float q = ssq[ai][m]; q += shx(q, 16, ln); q += shx(q, 32, ln);
                if (fq == 0) __hip_atomic_store(SS + (size_t)(row0 + ai * HALF + m * 16) * 16 + u.pn * 4 + wc, q, __ATOMIC_RELAXED, __HIP_MEMORY_SCOPE_AGENT); }
        asm volatile("s_waitcnt vmcnt(0)" ::: "memory");
        PG8_GAS unsigned* c = cnt + 64 * u.pm;
        if (ln == 0) (void)__hip_atomic_fetch_add(c, 1u, __ATOMIC_RELAXED, __HIP_MEMORY_SCOPE_AGENT);
        for (unsigned sp = 0; sp < (1u << 22); ++sp) { if ((unsigned)__builtin_amdgcn_readfirstlane((int)__hip_atomic_load(c, __ATOMIC_RELAXED, __HIP_MEMORY_SCOPE_AGENT)) >= 32u) break; __builtin_amdgcn_s_sleep(2); }
        int row1 = row0, colc = colb; asm volatile("" : "+v"(row1), "+v"(colc));
        float rs[2][4];
#pragma unroll
        for (int ai = 0; ai < 2; ++ai)
#pragma unroll
            for (int m = 0; m < 4; ++m) { const PG8_GAS float* sp4 = SS + (size_t)(row1 + ai * HALF + m * 16) * 16 + 4 * fq;
                float t = (__hip_atomic_load(sp4, __ATOMIC_RELAXED, __HIP_MEMORY_SCOPE_AGENT) + __hip_atomic_load(sp4 + 1, __ATOMIC_RELAXED, __HIP_MEMORY_SCOPE_AGENT))
                        + (__hip_atomic_load(sp4 + 2, __ATOMIC_RELAXED, __HIP_MEMORY_SCOPE_AGENT) + __hip_atomic_load(sp4 + 3, __ATOMIC_RELAXED, __HIP_MEMORY_SCOPE_AGENT));
                t += shx(t, 16, ln); t += shx(t, 32, ln); rs[ai][m] = rsqrtf(t * (1.0f / 1024.0f) + EPS_); }
#pragma unroll
        for (int bj = 0; bj < 2; ++bj) {
            const f32x4 g0 = *(const PG8_GAS f32x4*)(gfin + colc + bj * HALF), g1 = *(const PG8_GAS f32x4*)(gfin + colc + bj * HALF + 4);
#pragma unroll
            for (int ai = 0; ai < 2; ++ai)
#pragma unroll
                for (int m = 0; m < 4; ++m) { const size_t off = (size_t)(row1 + ai * HALF + m * 16) * 1024 + colc + bj * HALF;
                    *(PG8_GAS f32x4*)(OUT + off) = acc[ai][bj][m][0] * rs[ai][m] * g0; *(PG8_GAS f32x4*)(OUT + off + 4) = acc[ai][bj][m][1] * rs[ai][m] * g1; }
        }
    }
};

struct EpiUp {
    static constexpr bool PERM = true;
    const PG8_GAS float* SS; const PG8_GAS float* bias; PG8_GAS bf16_t* O; int ldc;
    __device__ __forceinline__ void operator()(f32x4 (&acc)[2][2][4][2], const Unit& u, int wr, int wc, int fr, int fq) const {
        const int b = u.pm >> 5, colb = u.pn * BM + wc * 32 + 8 * fq, row0 = u.pm * BM + wr * 64 + fr;
        float rs[2][4];
#pragma unroll
        for (int ai = 0; ai < 2; ++ai)
#pragma unroll
            for (int m = 0; m < 4; ++m) rs[ai][m] = row_rstd(SS, row0 + ai * HALF + m * 16, fq, fr);
#pragma unroll
        for (int bj = 0; bj < 2; ++bj) {
            const f32x4 bv0 = *(const PG8_GAS f32x4*)(bias + (size_t)b * ldc + colb + bj * HALF), bv1 = *(const PG8_GAS f32x4*)(bias + (size_t)b * ldc + colb + bj * HALF + 4);
#pragma unroll
            for (int ai = 0; ai < 2; ++ai)
#pragma unroll
                for (int m = 0; m < 4; ++m) { f32x4 v0 = acc[ai][bj][m][0] * rs[ai][m] + bv0, v1 = acc[ai][bj][m][1] * rs[ai][m] + bv1;
#pragma unroll
                    for (int j = 0; j < 4; ++j) { v0[j] = fmaxf(v0[j], 0.f); v1[j] = fmaxf(v1[j], 0.f); }
                    v0 = v0 * v0; v1 = v1 * v1;
                    u32x4 w; w.x = cvt_pk_bf16(v0[0], v0[1]); w.y = cvt_pk_bf16(v0[2], v0[3]); w.z = cvt_pk_bf16(v1[0], v1[1]); w.w = cvt_pk_bf16(v1[2], v1[3]);
                    *(PG8_GAS u32x4*)(O + (size_t)(row0 + ai * HALF + m * 16) * ldc + colb + bj * HALF) = w; }
        }
    }
};

struct EpiQKV {
    static constexpr bool PERM = true;
    const PG8_GAS float* SS; const PG8_GAS float* bias; PG8_GAS bf16_t* Q; size_t split_stride; PG8_GAS float* KMP;
    __device__ __forceinline__ void operator()(f32x4 (&acc)[2][2][4][2], const Unit& u, int wr, int wc, int fr, int fq) const {
        const int b = u.pm >> 5, t = u.pn >> 2, colt = (u.pn & 3) * BM + wc * 32 + 8 * fq, colb = u.pn * BM + wc * 32 + 8 * fq, row0 = u.pm * BM + wr * 64 + fr;
        PG8_GAS bf16_t* base = Q + (size_t)t * split_stride; const float sc = (t == 0) ? C2_ : 1.0f;
        float rs[2][4];
#pragma unroll
        for (int ai = 0; ai < 2; ++ai)
#pragma unroll
            for (int m = 0; m < 4; ++m) rs[ai][m] = row_rstd(SS, row0 + ai * HALF + m * 16, fq, fr);
#pragma unroll
        for (int bj = 0; bj < 2; ++bj) {
            const f32x4 bv0 = *(const PG8_GAS f32x4*)(bias + (size_t)b * 3072 + colb + bj * HALF), bv1 = *(const PG8_GAS f32x4*)(bias + (size_t)b * 3072 + colb + bj * HALF + 4);
            f32x4 cs0 = {0.f, 0.f, 0.f, 0.f}, cs1 = cs0;
#pragma unroll
            for (int ai = 0; ai < 2; ++ai)
#pragma unroll
                for (int m = 0; m < 4; ++m) { f32x4 v0 = acc[ai][bj][m][0] * rs[ai][m] + bv0, v1 = acc[ai][bj][m][1] * rs[ai][m] + bv1;
                    cs0 += v0; cs1 += v1; v0 = v0 * sc; v1 = v1 * sc;
                    u32x4 w; w.x = cvt_pk_bf16(v0[0], v0[1]); w.y = cvt_pk_bf16(v0[2], v0[3]); w.z = cvt_pk_bf16(v1[0], v1[1]); w.w = cvt_pk_bf16(v1[2], v1[3]);
                    *(PG8_GAS u32x4*)(base + (size_t)(row0 + ai * HALF + m * 16) * 1024 + colt + bj * HALF) = w; }
            if (t == 1) {
#pragma unroll
                for (int o = 1; o < 16; o <<= 1) {
#pragma unroll
                    for (int j = 0; j < 4; ++j) { cs0[j] += shx(cs0[j], o, fq * 16 + fr); cs1[j] += shx(cs1[j], o, fq * 16 + fr); } }
                if (fr == 0) { PG8_GAS float* kp = KMP + ((size_t)u.pm * 2 + wr) * 1024 + colt + bj * HALF; *(f32x4*)kp = cs0; *(PG8_GAS f32x4*)(kp + 4) = cs1; }
            }
        }
    }
};

template <class Epi, class Sched, bool ALIGN_EPI>
__device__ __forceinline__ void gemm_phase(PG8_LAS unsigned char* lds, const Gemm g, const Sched& S, const Epi& E, int wave_id) {
    int tid = wave_id * 64 + lane_id(); asm volatile("" : "+v"(tid));
    const int wid = __builtin_amdgcn_readfirstlane(tid >> 6), lane = tid & 63, wr = wid >> 2, wc = wid & 3, fr = lane & 15, fq = lane >> 4;
    const int K = g.K, nt = K / BK, lda = g.lda;
    unsigned voffA[2], voffB[2];
#pragma unroll
    for (int i = 0; i < 2; ++i) { int R, C; stage_rc(tid * 16 + i * 8192, R, C); const int Rb = Epi::PERM ? ((R & ~31) + perm32(R & 31)) : R;
        voffA[i] = (unsigned)(R * lda + C) * 2u; voffB[i] = (unsigned)(Rb * K + C) * 2u; }
    const size_t kstep = (size_t)(BK * 2);
    const size_t hstepA = (size_t)HALF * lda * 2, tstepA = 2 * hstepA, hstepB = (size_t)HALF * K * 2, tstepB = 2 * hstepB;
    const unsigned ldsw = (unsigned)wid * 1024u;
    const int aoff = lds_byte(wr * 64 + fr, fq * 8), boff = lds_byte(wc * 32 + fr, fq * 8);
#define PG8_SA(b, h) (((b) * 2 + (h)) * HTB)
#define PG8_SB(b, h) ((4 + (b) * 2 + (h)) * HTB)
#define PG8_STAGE(bufoff, gbase, voff) do { _Pragma("unroll") for (int _i = 0; _i < 2; ++_i) \
        __builtin_amdgcn_global_load_lds((const PG8_GAS unsigned*)((const PG8_GAS char*)(gbase) + (voff)[_i]), (PG8_LAS unsigned*)(lds + (bufoff) + ldsw + _i * 8192), 16, 0, 0); } while (0)
#define PG8_LDA(dst, b, h) do { _Pragma("unroll") for (int m = 0; m < 4; ++m) _Pragma("unroll") for (int k = 0; k < 2; ++k) dst[m][k] = *(const PG8_LAS bf16x8*)(lds + PG8_SA(b, h) + aoff + m * 2048 + k * 1024); } while (0)
#define PG8_LDB(dst, b, h) do { _Pragma("unroll") for (int n = 0; n < 2; ++n) _Pragma("unroll") for (int k = 0; k < 2; ++k) dst[n][k] = *(const PG8_LAS bf16x8*)(lds + PG8_SB(b, h) + boff + n * 2048 + k * 1024); } while (0)
#define PG8_MMA(ai, bj, At, Bt) do { __builtin_amdgcn_s_setprio(1); _Pragma("unroll") for (int m = 0; m < 4; ++m) _Pragma("unroll") for (int n = 0; n < 2; ++n) _Pragma("unroll") for (int k = 0; k < 2; ++k) \
        acc[ai][bj][m][n] = __builtin_amdgcn_mfma_f32_16x16x32_bf16(Bt[n][k], At[m][k], acc[ai][bj][m][n], 0, 0, 0); __builtin_amdgcn_s_setprio(0); } while (0)
#define PG8_WAIT_V(n) asm volatile("s_waitcnt vmcnt(" #n ")" ::: "memory")
#define PG8_WAIT_L(n) asm volatile("s_waitcnt lgkmcnt(" #n ")" ::: "memory")
#define PG8_BAR __builtin_amdgcn_s_barrier()
#define PG8_SCHED __builtin_amdgcn_sched_barrier(0)
    Unit cur, nxt; int ui = 0;
    if (!S.next(0, cur)) return;
    f32x4 acc[2][2][4][2];
#pragma unroll
    for (int a = 0; a < 2; ++a)
#pragma unroll
        for (int b = 0; b < 2; ++b)
#pragma unroll
            for (int m = 0; m < 4; ++m)
#pragma unroll
                for (int n = 0; n < 2; ++n) acc[a][b][m][n] = (f32x4){0.f, 0.f, 0.f, 0.f};
    bf16x8 At[4][2], B0[2][2], B1[2][2];
    const PG8_GAS char* cA = (const PG8_GAS char*)g.A + (size_t)cur.pm * tstepA + (size_t)cur.pn * g.a_pn_off * 2; const PG8_GAS char* cB = (const PG8_GAS char*)g.Bt + (size_t)cur.pn * tstepB;
    PG8_STAGE(PG8_SB(0, 0), cB, voffB); PG8_STAGE(PG8_SB(0, 1), cB + hstepB, voffB); PG8_STAGE(PG8_SA(0, 0), cA, voffA); PG8_STAGE(PG8_SA(0, 1), cA + hstepA, voffA);
    if (wr == 1) PG8_BAR;
    PG8_WAIT_V(2); PG8_BAR;
    PG8_STAGE(PG8_SB(1, 0), cB + kstep, voffB); PG8_STAGE(PG8_SA(1, 0), cA + kstep, voffA); PG8_STAGE(PG8_SB(1, 1), cB + hstepB + kstep, voffB);
    PG8_WAIT_V(6); PG8_BAR;
    for (;;) {
        const bool has_next = S.next(ui + 1, nxt);
        const PG8_GAS char* nA = has_next ? (const PG8_GAS char*)g.A + (size_t)nxt.pm * tstepA + (size_t)nxt.pn * g.a_pn_off * 2 : cA; const PG8_GAS char* nB = has_next ? (const PG8_GAS char*)g.Bt + (size_t)nxt.pn * tstepB : cB;
        for (int t = 0; t < nt; t += 2) {
            const bool last = (t == nt - 2);
            const PG8_GAS char* a1 = cA + (size_t)(t + 1) * kstep;
            const PG8_GAS char* a2 = last ? nA : cA + (size_t)(t + 2) * kstep; const PG8_GAS char* b2 = last ? nB : cB + (size_t)(t + 2) * kstep;
            const PG8_GAS char* a3 = a2 + kstep; const PG8_GAS char* b3 = b2 + kstep;
            PG8_LDB(B0, 0, 0); PG8_LDB(B1, 0, 1); PG8_SCHED; PG8_LDA(At, 0, 0); PG8_STAGE(PG8_SA(1, 1), a1 + hstepA, voffA);
            PG8_WAIT_V(8); PG8_WAIT_L(0); PG8_BAR; PG8_MMA(0, 0, At, B0); PG8_MMA(0, 1, At, B1); PG8_BAR; PG8_SCHED;
            PG8_LDA(At, 0, 1); PG8_STAGE(PG8_SB(0, 0), b2, voffB); PG8_STAGE(PG8_SB(0, 1), b2 + hstepB, voffB); PG8_STAGE(PG8_SA(0, 0), a2, voffA);
            PG8_WAIT_V(8); PG8_WAIT_L(0); PG8_BAR; PG8_MMA(1, 0, At, B0); PG8_MMA(1, 1, At, B1); PG8_BAR; PG8_SCHED;
            PG8_LDB(B0, 1, 0); PG8_LDB(B1, 1, 1); PG8_SCHED; PG8_LDA(At, 1, 0); PG8_STAGE(PG8_SA(0, 1), a2 + hstepA, voffA);
            PG8_WAIT_V(8); PG8_WAIT_L(0); PG8_BAR; PG8_MMA(0, 0, At, B0); PG8_MMA(0, 1, At, B1); PG8_BAR; PG8_SCHED;
            PG8_LDA(At, 1, 1); PG8_STAGE(PG8_SB(1, 0), b3, voffB); PG8_STAGE(PG8_SB(1, 1), b3 + hstepB, voffB); PG8_STAGE(PG8_SA(1, 0), a3, voffA);
            PG8_WAIT_V(8); PG8_WAIT_L(0); PG8_BAR; PG8_MMA(1, 0, At, B0); PG8_MMA(1, 1, At, B1); PG8_BAR; PG8_SCHED;
        }
        if constexpr (ALIGN_EPI) { if (wr == 0) PG8_BAR; }
        E(acc, cur, wr, wc, fr, fq);
        if (!has_next) break;
#pragma unroll
        for (int a = 0; a < 2; ++a)
#pragma unroll
            for (int b = 0; b < 2; ++b)
#pragma unroll
                for (int m = 0; m < 4; ++m)
#pragma unroll
                    for (int n = 0; n < 2; ++n) acc[a][b][m][n] = (f32x4){0.f, 0.f, 0.f, 0.f};
        cur = nxt; cA = nA; cB = nB; ++ui;
        if constexpr (ALIGN_EPI) { if (wr == 1) PG8_BAR; }
    }
    PG8_WAIT_V(0);
    if constexpr (!ALIGN_EPI) { if (wr == 0) PG8_BAR; }
    PG8_BAR;
#undef PG8_SA
#undef PG8_SB
#undef PG8_STAGE
#undef PG8_LDA
#undef PG8_LDB
#undef PG8_MMA
#undef PG8_WAIT_V
#undef PG8_WAIT_L
#undef PG8_BAR
#undef PG8_SCHED
}
}

constexpr int NWAVES = 8;
constexpr int BATCH = 4, SEQ = 8192, D = 1024, NH = 16, HD = 64, FF = 4096, M = BATCH * SEQ, NQKV = 3 * D, NBLK = 32, BLK = 256;
constexpr float EPS = 1e-6f;
constexpr float LOG2E = 1.4426950408889634f;

constexpr size_t MiB = 1u << 20;
constexpr size_t WS_CTL = 0, CTL_ZERO_BYTES = 1 * MiB;
constexpr size_t WS_MOD = 1 * MiB;
constexpr size_t WS_BIAS_UP0 = WS_MOD + 256 * 1024;
constexpr size_t WS_BIAS_QKV = WS_BIAS_UP0 + 64 * 1024;
constexpr size_t WS_BIAS_UP1 = WS_BIAS_QKV + 64 * 1024;
constexpr size_t WS_KMP = 2 * MiB;
constexpr size_t WS_SS = 3 * MiB;
constexpr size_t WS_WPOOL = 6 * MiB, WS_WQKV = 8 * MiB, WS_WO = 14 * MiB, WS_WUP0 = 16 * MiB, WS_WUP1 = 24 * MiB, WS_WDN0 = 32 * MiB, WS_WDN1 = 40 * MiB;
constexpr size_t WS_XNA = 48 * MiB, WS_XNB = 112 * MiB;
constexpr size_t WS_HB = 176 * MiB;
constexpr size_t WS_Q = 176 * MiB, WS_K = 240 * MiB, WS_V = 304 * MiB;
constexpr size_t WS_PL = 402 * MiB;
constexpr size_t WS_CNT = 410 * MiB;
constexpr size_t WS_KBM = 411 * MiB;
constexpr size_t WS_POB = 48 * MiB;
constexpr size_t WS_SEG = 368 * MiB;
constexpr size_t WS_XR = 432 * MiB;
constexpr size_t WS_END = 496 * MiB;
constexpr int CW_BAR = 4096;
constexpr int CW_FIN = 24576;
constexpr int CW_TOT = 16384;

constexpr int RING_OFF = 0, RING_BYTES = 131072;
constexpr int LDSCTL_OFF = RING_BYTES, MISC_OFF = LDSCTL_OFF + 320;
constexpr int LDS_BYTES = 151552;

#define GAS __attribute__((address_space(1)))
#define LAS __attribute__((address_space(3)))
typedef unsigned short bf16;
typedef unsigned v4u __attribute__((ext_vector_type(4)));
typedef unsigned v2u __attribute__((ext_vector_type(2)));
typedef float f32x4 __attribute__((ext_vector_type(4)));
typedef GAS unsigned gu32;
#define RLX_AGENT __ATOMIC_RELAXED, __HIP_MEMORY_SCOPE_AGENT
#define LDS_WAIT() asm volatile("s_waitcnt lgkmcnt(0)" ::: "memory")
__device__ __forceinline__ unsigned f2bf(float f) { unsigned u = __builtin_bit_cast(unsigned, f); return (u + 0x7fffu + ((u >> 16) & 1u)) >> 16; }
__device__ __forceinline__ unsigned pk2(float lo, float hi) { return f2bf(lo) | (f2bf(hi) << 16); }
__device__ __forceinline__ float bf2f(unsigned short v) { return __builtin_bit_cast(float, (unsigned)v << 16); }

#define XB_TMO      128
#define XB_XCNT(j)  (256  + 64 * (j))
#define XB_XSUB(j)  (1280 + 64 * (j))
#define XB_XGEN(j)  (2304 + 64 * (j))
#define XB_TOP      3328
#define XB_TOPGEN   3392
#define XCD_BAR_WORDS 3456
#define XB_SPIN_CAP (1u << 18)
__device__ __forceinline__ unsigned xb_ld(GAS unsigned* p)              { return __hip_atomic_load(p, __ATOMIC_RELAXED, __HIP_MEMORY_SCOPE_AGENT); }
__device__ __forceinline__ unsigned xb_add(GAS unsigned* p, unsigned v) { return __hip_atomic_fetch_add(p, v, __ATOMIC_RELAXED, __HIP_MEMORY_SCOPE_AGENT); }
__device__ __forceinline__ unsigned xb_xcc_id() { return (unsigned)__builtin_amdgcn_s_getreg((3 << 11) | 20) & 0xFu; }
#define XB_SPIN(cond, bar) do { unsigned _sp = 0; while (cond) { __builtin_amdgcn_s_sleep(1); \
    if ((++_sp & 255u) == 0u) { if (xb_ld(&(bar)[XB_TMO])) break; if (_sp > XB_SPIN_CAP) { (void)xb_add(&(bar)[XB_TMO], 1u); break; } } } } while (0)
struct XcdBarrier { GAS unsigned* bar; unsigned x; volatile LAS unsigned* st; int wave; };
__device__ __forceinline__ XcdBarrier xcd_barrier_post(GAS unsigned* bar, volatile LAS unsigned* st) {
    XcdBarrier b; b.bar = bar; b.x = xb_xcc_id(); b.st = st;
    if (threadIdx.x == 0) (void)xb_add(&bar[XB_XCNT(b.x)], 1u);
    return b;
}
__device__ __forceinline__ void xcd_barrier_complete(GAS unsigned* bar, unsigned x, unsigned& nloc, unsigned& nx) {
    const unsigned G = gridDim.x * gridDim.y * gridDim.z;
    unsigned sum, cnt, mine, sp = 0u;
    for (;;) {
        sum = 0u; cnt = 0u; mine = 0u;
#pragma unroll
        for (unsigned j = 0; j < 16; ++j) { const unsigned c = xb_ld(&bar[XB_XCNT(j)]); sum += c; cnt += (c > 0u) ? 1u : 0u; mine = (j == x) ? c : mine; }
        if (sum == G) break;
        __builtin_amdgcn_s_sleep(1);
        if ((++sp & 255u) == 0u) { if (xb_ld(&bar[XB_TMO])) break; if (sp > XB_SPIN_CAP) { (void)xb_add(&bar[XB_TMO], 1u); break; } }
    }
    nloc = mine > 0u ? mine : 1u; nx = cnt > 0u ? cnt : 1u;
}
__device__ __forceinline__ void xcd_barrier(const XcdBarrier& b) {
    asm volatile("s_waitcnt vmcnt(0)" ::: "memory");
    __syncthreads();
    if (b.wave == 0 && lane_id() == 0) {
        GAS unsigned* bar = b.bar; asm volatile("" : "+s"(bar));
        const unsigned bx = xb_xcc_id();
        __builtin_amdgcn_s_waitcnt(0);
        unsigned nloc = b.st[0], nx = b.st[1];
        if (nloc == 0u) { xcd_barrier_complete(bar, bx, nloc, nx); b.st[0] = nloc; b.st[1] = nx; }
        const unsigned old = xb_add(&bar[XB_XSUB(bx)], 1u);
        const unsigned gen = old / nloc;
        if (old + 1u == (gen + 1u) * nloc) {
            __builtin_amdgcn_fence(__ATOMIC_RELEASE, "agent");
            asm volatile("s_waitcnt vmcnt(0)" ::: "memory");
            const unsigned og = xb_add(&bar[XB_TOP], 1u);
            const unsigned tg = og / nx;
            if (og + 1u == (tg + 1u) * nx) xb_add(&bar[XB_TOPGEN], 1u);
            else XB_SPIN(xb_ld(&bar[XB_TOPGEN]) == tg, bar);
            __builtin_amdgcn_fence(__ATOMIC_ACQUIRE, "agent");
            xb_add(&bar[XB_XGEN(bx)], 1u);
            asm volatile("s_waitcnt vmcnt(0)" ::: "memory");
        } else {
            XB_SPIN(xb_ld(&bar[XB_XGEN(bx)]) == gen, bar);
            __builtin_amdgcn_fence(__ATOMIC_ACQUIRE, "agent");
            asm volatile("s_waitcnt vmcnt(0)" ::: "memory");
        }
    }
    __syncthreads();
}

struct Args { const GAS float* in[14]; GAS float* out; GAS unsigned char* ws; };
struct Frame {
    LAS unsigned char* lds; int tid, lane, wave, vcu, G;
    const GAS float *x, *c, *rel_bias, *w_mod, *b_mod, *norm_mix, *norm_mlp, *w_pool, *pool_scale, *w_qkv, *w_o, *w_up, *w_down, *norm_final;
    GAS float* out; GAS unsigned char* ws;
};
__device__ __forceinline__ float wave_sum(float v) {
#pragma unroll
    for (int o = 1; o < 64; o <<= 1) v += __shfl_xor(v, o);
    return v;
}

__device__ __forceinline__ void p0_transpose_item(const GAS float* W, int K, int N, GAS bf16* WT, int row_off, LAS float* scr, int item, int lane) {
    const int nblk = N / 32, kb = item / nblk, nb = item % nblk, k0 = 64 * kb, n0 = 32 * nb;
    { f32x4 t[8];
#pragma unroll
      for (int i = 0; i < 8; ++i) t[i] = *(const GAS f32x4*)(W + (size_t)(k0 + 8 * i + (lane >> 3)) * N + n0 + 4 * (lane & 7));
#pragma unroll
      for (int i = 0; i < 8; ++i) { LAS float* d = scr + (8 * i + (lane >> 3)) * 33 + 4 * (lane & 7); d[0] = t[i][0]; d[1] = t[i][1]; d[2] = t[i][2]; d[3] = t[i][3]; } }
    LDS_WAIT(); asm volatile("" ::: "memory");
    const int c = lane & 7;
#pragma unroll
    for (int j = 0; j < 4; ++j) { const int n = (lane >> 3) + 8 * j; const LAS float* s = scr + (8 * c) * 33 + n;
        v4u o; o.x = pk2(s[0 * 33], s[1 * 33]); o.y = pk2(s[2 * 33], s[3 * 33]); o.z = pk2(s[4 * 33], s[5 * 33]); o.w = pk2(s[6 * 33], s[7 * 33]);
        *(GAS v4u*)(WT + (size_t)(row_off + n0 + n) * K + k0 + 8 * c) = o; }
    LDS_WAIT(); asm volatile("" ::: "memory");
}
__device__ __forceinline__ void p0_prologue(Frame& F) {
    if (F.vcu < 192) {
        LAS float* cact = (LAS float*)(F.lds + 67584);
        LAS float* red = (LAS float*)(F.lds + 67584 + 16384);
        const int l = F.vcu / 96, j0 = (F.vcu % 96) * 64;
        for (int i = F.tid; i < 4096; i += NWAVES * 64) { const float v = F.c[i]; cact[i] = v / (1.f + __expf(-v)); }
        __syncthreads();
        const int sub = F.lane >> 4, c4 = F.lane & 15;
        f32x4 a0 = {0.f, 0.f, 0.f, 0.f}, a1 = a0, a2 = a0, a3 = a0;
        const GAS float* wb = F.w_mod + (size_t)l * 1024 * 6144 + j0 + 4 * c4;
#pragma unroll 4
        for (int it = 0; it < 32; ++it) { const int k = 32 * it + 4 * F.wave + sub; const f32x4 wv = *(const GAS f32x4*)(wb + (size_t)k * 6144);
            a0 += wv * cact[k]; a1 += wv * cact[1024 + k]; a2 += wv * cact[2048 + k]; a3 += wv * cact[3072 + k]; }
#pragma unroll
        for (int j = 0; j < 4; ++j) { a0[j] += __shfl_xor(a0[j], 16); a0[j] += __shfl_xor(a0[j], 32); a1[j] += __shfl_xor(a1[j], 16); a1[j] += __shfl_xor(a1[j], 32);
            a2[j] += __shfl_xor(a2[j], 16); a2[j] += __shfl_xor(a2[j], 32); a3[j] += __shfl_xor(a3[j], 16); a3[j] += __shfl_xor(a3[j], 32); }
        if (sub == 0) { LAS f32x4* r4 = (LAS f32x4*)(red + F.wave * 256); r4[0 * 16 + c4] = a0; r4[1 * 16 + c4] = a1; r4[2 * 16 + c4] = a2; r4[3 * 16 + c4] = a3; }
        __syncthreads();
        if (F.tid < 256) { const int b = F.tid >> 6, col = F.tid & 63; float s = 0.f;
#pragma unroll
            for (int w = 0; w < 8; ++w) s += red[w * 256 + b * 64 + col];
            ((GAS float*)(F.ws + WS_MOD))[(l * 4 + b) * 6144 + j0 + col] = s + F.b_mod[l * 6144 + j0 + col]; }
    }
    LAS float* scr = (LAS float*)(F.lds + RING_OFF + F.wave * 8448);
    const int gw = F.vcu * NWAVES + F.wave, NGW = F.G * NWAVES;
    constexpr int I_POOL = 4 * 32, I_QKV = 16 * 96, I_O = 16 * 32, I_UP = 16 * 128, I_DN = 64 * 32;
    constexpr int NITEMS = I_POOL + I_QKV + I_O + 2 * I_UP + 2 * I_DN;
    for (int it = gw; it < NITEMS; it += NGW) {
        int r = it;
        if (r < I_POOL) { const int g = r / 32; p0_transpose_item(F.w_pool + (size_t)g * 65536, 256, 256, (GAS bf16*)(F.ws + WS_WPOOL), g * 256, scr, r % 32, F.lane); continue; } r -= I_POOL;
        if (r < I_QKV) { p0_transpose_item(F.w_qkv, D, NQKV, (GAS bf16*)(F.ws + WS_WQKV), 0, scr, r, F.lane); continue; } r -= I_QKV;
        if (r < I_O) { p0_transpose_item(F.w_o, D, D, (GAS bf16*)(F.ws + WS_WO), 0, scr, r, F.lane); continue; } r -= I_O;
        if (r < 2 * I_UP) { const int l = r / I_UP; p0_transpose_item(F.w_up + (size_t)l * D * FF, D, FF, (GAS bf16*)(F.ws + (l ? WS_WUP1 : WS_WUP0)), 0, scr, r % I_UP, F.lane); continue; } r -= 2 * I_UP;
        { const int l = r / I_DN; p0_transpose_item(F.w_down + (size_t)l * FF * D, FF, D, (GAS bf16*)(F.ws + (l ? WS_WDN1 : WS_WDN0)), 0, scr, r % I_DN, F.lane); }
    }
}

__device__ __forceinline__ void p1_bias(Frame& F) {
    const int gw = F.vcu * NWAVES + F.wave, NGW = F.G * NWAVES;
    const GAS float* MOD = (const GAS float*)(F.ws + WS_MOD);
    for (int it = gw; it < 4096 + 3072 + 4096; it += NGW) {
        const GAS bf16* wt; const GAS float* sh; GAS float* dst; int n, N;
        if (it < 4096) { n = it; N = 4096; wt = (const GAS bf16*)(F.ws + WS_WUP0); sh = MOD + 3072; dst = (GAS float*)(F.ws + WS_BIAS_UP0); }
        else if (it < 4096 + 3072) { n = it - 4096; N = 3072; wt = (const GAS bf16*)(F.ws + WS_WQKV); sh = MOD + 4 * 6144; dst = (GAS float*)(F.ws + WS_BIAS_QKV); }
        else { n = it - 7168; N = 4096; wt = (const GAS bf16*)(F.ws + WS_WUP1); sh = MOD + 4 * 6144 + 3072; dst = (GAS float*)(F.ws + WS_BIAS_UP1); }
        const v4u w0 = *(const GAS v4u*)(wt + (size_t)n * 1024 + F.lane * 16), w1 = *(const GAS v4u*)(wt + (size_t)n * 1024 + F.lane * 16 + 8);
        float wf[16];
#pragma unroll
        for (int j = 0; j < 4; ++j) { wf[2 * j] = __builtin_bit_cast(float, w0[j] << 16); wf[2 * j + 1] = __builtin_bit_cast(float, w0[j] & 0xffff0000u);
            wf[8 + 2 * j] = __builtin_bit_cast(float, w1[j] << 16); wf[8 + 2 * j + 1] = __builtin_bit_cast(float, w1[j] & 0xffff0000u); }
#pragma unroll
        for (int b = 0; b < 4; ++b) { const GAS f32x4* sp = (const GAS f32x4*)(sh + b * 6144 + F.lane * 16); float s = 0.f;
#pragma unroll
            for (int j = 0; j < 4; ++j) { const f32x4 sv = sp[j]; s += wf[4 * j] * sv[0] + wf[4 * j + 1] * sv[1] + wf[4 * j + 2] * sv[2] + wf[4 * j + 3] * sv[3]; }
            s = wave_sum(s); if (F.lane == 0) dst[b * N + n] = s; }
    }
}
__device__ __forceinline__ void p1_pool(Frame& F) {
    LAS float* ring = (LAS float*)(F.lds + RING_OFF);
    const GAS float* MOD = (const GAS float*)(F.ws + WS_MOD); GAS bf16* XN = (GAS bf16*)(F.ws + WS_XNA); GAS bf16* XR = (GAS bf16*)(F.ws + WS_XR);
    for (int run = F.vcu; run < M / 128; run += F.G) {
        const int t0 = run * 128, s0 = t0 % SEQ, b = t0 / SEQ;
        f32x4 gam[4];
#pragma unroll
        for (int j = 0; j < 4; ++j) gam[j] = *(const GAS f32x4*)(F.norm_mix + 4 * (F.lane + 64 * j));
        const int c4 = F.tid & 255, rh = F.tid >> 8, gi = c4 >> 6, w = 2 << gi;
        const f32x4 sc1 = *(const GAS f32x4*)(MOD + b * 6144 + 1024 + 4 * c4) + 1.0f;
        f32x4 v[2][4];
        const GAS float* xb = F.x + (size_t)b * SEQ * D + 4 * F.lane;
        int st = (s0 > 0 ? -1 : 0);
#pragma unroll
        for (int rr = 0; rr < 2; ++rr)
#pragma unroll
            for (int j = 0; j < 4; ++j) v[rr][j] = *(const GAS f32x4*)(xb + (size_t)(s0 + 16 * st + 2 * F.wave + rr) * D + 256 * j);
        for (; st < 8; ++st) {
            if (st >= 0) {
#pragma unroll
                for (int rr = 0; rr < 2; ++rr)
#pragma unroll
                    for (int j = 0; j < 4; ++j) { v2u o2; o2.x = pk2(v[rr][j][0], v[rr][j][1]); o2.y = pk2(v[rr][j][2], v[rr][j][3]);
                        *(GAS v2u*)(XR + ((size_t)b * SEQ + s0 + 16 * st + 2 * F.wave + rr) * D + 4 * F.lane + 256 * j) = o2; } }
            float ss0 = 0.f, ss1 = 0.f;
#pragma unroll
            for (int j = 0; j < 4; ++j) { ss0 += (v[0][j][0] * v[0][j][0] + v[0][j][1] * v[0][j][1]) + (v[0][j][2] * v[0][j][2] + v[0][j][3] * v[0][j][3]);
                ss1 += (v[1][j][0] * v[1][j][0] + v[1][j][1] * v[1][j][1]) + (v[1][j][2] * v[1][j][2] + v[1][j][3] * v[1][j][3]); }
#pragma unroll
            for (int o = 1; o < 64; o <<= 1) { ss0 += __shfl_xor(ss0, o); ss1 += __shfl_xor(ss1, o); }
            const float rs0 = rsqrtf(ss0 * (1.0f / D) + EPS), rs1 = rsqrtf(ss1 * (1.0f / D) + EPS);
            { const int sr = s0 + 16 * st + 2 * F.wave;
#pragma unroll
              for (int j = 0; j < 4; ++j) { *(LAS f32x4*)(ring + (sr & 31) * 1024 + 4 * (F.lane + 64 * j)) = v[0][j] * rs0 * gam[j]; *(LAS f32x4*)(ring + ((sr + 1) & 31) * 1024 + 4 * (F.lane + 64 * j)) = v[1][j] * rs1 * gam[j]; } }
            if (st + 1 < 8) {
#pragma unroll
                for (int rr = 0; rr < 2; ++rr)
#pragma unroll
                    for (int j = 0; j < 4; ++j) v[rr][j] = *(const GAS f32x4*)(xb + (size_t)(s0 + 16 * (st + 1) + 2 * F.wave + rr) * D + 256 * j); }
            __syncthreads();
            if (st >= 0) {
                const int sA = s0 + 16 * st + 8 * rh;
                f32x4 sum = {0.f, 0.f, 0.f, 0.f};
                { const int cnt0 = (sA < w) ? sA : w; for (int i = 1; i <= cnt0; ++i) sum += *(const LAS f32x4*)(ring + ((sA - i) & 31) * 1024 + 4 * c4); }
#pragma unroll
                for (int r = 0; r < 8; ++r) { const int s = sA + r; const f32x4 cur = *(const LAS f32x4*)(ring + (s & 31) * 1024 + 4 * c4);
                    sum += cur; if (s >= w) sum -= *(const LAS f32x4*)(ring + ((s - w) & 31) * 1024 + 4 * c4);
                    const float inv = 1.0f / (float)((s + 1 < w) ? s + 1 : w);
                    const f32x4 p = (sum * inv - cur) * sc1;
                    v2u o; o.x = pk2(p[0], p[1]); o.y = pk2(p[2], p[3]);
                    *(GAS v2u*)(XN + ((size_t)b * SEQ + s) * D + 4 * c4) = o; }
            }
            __syncthreads();
        }
    }
}

__device__ __forceinline__ int t5_bucket(int dist) {
    if (dist < 16) return dist;
    int b = 16;
    b += (dist >= 21); b += (dist >= 27); b += (dist >= 35); b += (dist >= 46); b += (dist >= 59); b += (dist >= 77); b += (dist >= 99); b += (dist >= 128);
    b += (dist >= 166); b += (dist >= 216); b += (dist >= 280); b += (dist >= 363); b += (dist >= 470); b += (dist >= 609); b += (dist >= 790);
    return b;
}
namespace att {
typedef short bf16x8 __attribute__((ext_vector_type(8)));
typedef short s16x4 __attribute__((ext_vector_type(4)));
typedef short v4i16_t __attribute__((ext_vector_type(4)));
typedef float f32x16 __attribute__((ext_vector_type(16)));
typedef float f32x2_t __attribute__((ext_vector_type(2)));
typedef __bf16 bf16x2_t __attribute__((ext_vector_type(2)));
typedef LAS const char* lds_cptr;
constexpr int L_K = 0, L_V = 32768, L_LUT = 132096, L_QI = 141312, L_CUM = 142336, L_PRE = 142592;
constexpr int LUTN = 2304;
__device__ __forceinline__ int crow(int r, int hi) { return (r & 3) + 8 * (r >> 2) + 4 * hi; }
__device__ __forceinline__ unsigned cvtpk(float lo, float hi) { f32x2_t v = {lo, hi}; bf16x2_t b = __builtin_convertvector(v, bf16x2_t); return __builtin_bit_cast(unsigned, b); }
__device__ __forceinline__ s16x4 vtr(lds_cptr p) { return __builtin_bit_cast(s16x4, __builtin_amdgcn_ds_read_tr16_b64_v4i16((LAS v4i16_t*)p)); }
__device__ __forceinline__ float swap_add(float v) { auto rr = __builtin_amdgcn_permlane32_swap(__float_as_uint(v), __float_as_uint(v), false, false); return __uint_as_float(rr[0]) + __uint_as_float(rr[1]); }

__device__ __forceinline__ void load_kv(LAS unsigned char* lds, const GAS bf16* Kb, const GAS bf16* Vb, int b, int h, int n, int w, int lane) {
#pragma unroll
    for (int t = 0; t < 4; ++t) {
        const size_t kr = (size_t)b * SEQ + n * BLK + 64 * t + lane, vr = (size_t)b * SEQ + n * BLK + 64 * t + 16 * (w & 3) + (lane >> 2);
        const v4u kv = *(const GAS v4u*)(Kb + kr * D + h * 64 + w * 8);
        const v4u vv = *(const GAS v4u*)(Vb + vr * D + h * 64 + (w >> 2) * 32 + (lane & 3) * 8);
        *(LAS v4u*)(lds + L_K + t * 8192 + w * 1024 + lane * 16) = kv;
        *(LAS v4u*)(lds + L_V + t * 8192 + w * 1024 + lane * 16) = vv;
    }
}
__device__ __forceinline__ void build_lut(LAS unsigned char* lds, const GAS float* rel_bias, int h, int tid) {
    for (int i = tid; i < LUTN; i += NWAVES * 64) ((LAS float*)(lds + L_LUT))[i] = (i <= 2047) ? rel_bias[t5_bucket(2047 - i) * NH + h] * LOG2E : 0.f;
}
__device__ __forceinline__ void qk_tile(f32x16& p0, f32x16& p1, lds_cptr Kt, const bf16x8* qr, const f32x16& cinit, int r32, int hi) {
    lds_cptr kb = Kt + hi * 1024 + r32 * 16;
#pragma unroll
    for (int d0 = 0; d0 < 4; ++d0) {
        const bf16x8 b0 = *(LAS const bf16x8*)(kb + d0 * 2048), b1 = *(LAS const bf16x8*)(kb + d0 * 2048 + 512);
        if (d0 == 0) { p0 = __builtin_amdgcn_mfma_f32_32x32x16_bf16(b0, qr[0], cinit, 0, 0, 0); p1 = __builtin_amdgcn_mfma_f32_32x32x16_bf16(b1, qr[0], cinit, 0, 0, 0); }
        else { p0 = __builtin_amdgcn_mfma_f32_32x32x16_bf16(b0, qr[d0], p0, 0, 0, 0); p1 = __builtin_amdgcn_mfma_f32_32x32x16_bf16(b1, qr[d0], p1, 0, 0, 0); }
    }
}
template <bool BIAS, bool MASK>
__device__ __forceinline__ void softmax_tile(f32x16& p0, f32x16& p1, LAS const float* lutp, int jt, int qrel, int hi, float& l, v4u* pa) {
#pragma unroll
    for (int r = 0; r < 16; ++r) { const int ko = 64 * jt + (r & 3) + 8 * (r >> 2);
        if (BIAS) { p0[r] += lutp[ko]; p1[r] += lutp[ko + 32]; }
        if (MASK) { const int kv = ko + 4 * hi; if (kv > qrel) p0[r] = -INFINITY; if (kv + 32 > qrel) p1[r] = -INFINITY; }
        p0[r] = __builtin_amdgcn_exp2f(p0[r]); p1[r] = __builtin_amdgcn_exp2f(p1[r]); }
    float s = 0.f;
#pragma unroll
    for (int r = 0; r < 16; ++r) s += p0[r] + p1[r];
    l += s;
    pa[0] = (v4u){cvtpk(p0[0], p0[1]), cvtpk(p0[2], p0[3]), cvtpk(p0[4], p0[5]), cvtpk(p0[6], p0[7])};
    pa[1] = (v4u){cvtpk(p0[8], p0[9]), cvtpk(p0[10], p0[11]), cvtpk(p0[12], p0[13]), cvtpk(p0[14], p0[15])};
    pa[2] = (v4u){cvtpk(p1[0], p1[1]), cvtpk(p1[2], p1[3]), cvtpk(p1[4], p1[5]), cvtpk(p1[6], p1[7])};
    pa[3] = (v4u){cvtpk(p1[8], p1[9]), cvtpk(p1[10], p1[11]), cvtpk(p1[12], p1[13]), cvtpk(p1[14], p1[15])};
}
__device__ __forceinline__ void pv_tile(f32x16* o, lds_cptr vp, const v4u* pa) {
#pragma unroll
    for (int d0 = 0; d0 < 2; ++d0)
#pragma unroll
        for (int ks = 0; ks < 4; ++ks) { const s16x4 lo = vtr(vp + d0 * 4096 + ks * 1024), hi = vtr(vp + d0 * 4096 + ks * 1024 + 512);
            const bf16x8 vf = (bf16x8){lo[0], lo[1], lo[2], lo[3], hi[0], hi[1], hi[2], hi[3]};
            o[d0] = __builtin_amdgcn_mfma_f32_32x32x16_bf16(vf, __builtin_bit_cast(bf16x8, pa[ks]), o[d0], 0, 0, 0); }
}
__device__ __forceinline__ void load_q_raw(bf16x8* qr, const GAS bf16* Qb, size_t qrow, int h, int hi) {
#pragma unroll
    for (int d0 = 0; d0 < 4; ++d0) { const v4u v = *(const GAS v4u*)(Qb + qrow * D + h * 64 + d0 * 16 + hi * 8); qr[d0] = __builtin_bit_cast(bf16x8, v); }
}
__device__ __forceinline__ float q_norm2(const bf16x8* qr) {
    float q2 = 0.f;
#pragma unroll
    for (int d0 = 0; d0 < 4; ++d0) { const v4u v = __builtin_bit_cast(v4u, qr[d0]);
#pragma unroll
        for (int j = 0; j < 4; ++j) { const float a = __builtin_bit_cast(float, v[j] << 16), c = __builtin_bit_cast(float, v[j] & 0xffff0000u); q2 += a * a + c * c; } }
    return swap_add(q2);
}
__device__ __forceinline__ float load_q(bf16x8* qr, const GAS bf16* Qb, size_t qrow, int h, int hi) { load_q_raw(qr, Qb, qrow, h, hi); return q_norm2(qr); }
__device__ __forceinline__ float ref_exponent(float q2, float kmax2, float bmax) { return __builtin_sqrtf(q2 * kmax2) * 1.002f + bmax + 0.01f; }
__device__ __forceinline__ void head_bounds(const GAS float* KBM, const GAS float* rel_bias, int bh, int h, int lane, float& kmax2, float& bmax) {
    float k = KBM[bh * 32 + (lane & 31)], bb = rel_bias[(lane & 31) * NH + h] * LOG2E;
#pragma unroll
    for (int o = 1; o < 32; o <<= 1) { k = fmaxf(k, shx(k, o, lane)); bb = fmaxf(bb, shx(bb, o, lane)); }
    kmax2 = k; bmax = bb;
}
__device__ __forceinline__ void store_row(GAS bf16* rowp, const f32x16* o, float scale, int hi, bool act) {
    unsigned w0[8], w1[8];
#pragma unroll
    for (int k = 0; k < 4; ++k) { w0[2 * k] = cvtpk(o[0][4 * k] * scale, o[0][4 * k + 1] * scale); w0[2 * k + 1] = cvtpk(o[0][4 * k + 2] * scale, o[0][4 * k + 3] * scale);
        w1[2 * k] = cvtpk(o[1][4 * k] * scale, o[1][4 * k + 1] * scale); w1[2 * k + 1] = cvtpk(o[1][4 * k + 2] * scale, o[1][4 * k + 3] * scale); }
#pragma unroll
    for (int i = 0; i < 8; ++i) { auto r = __builtin_amdgcn_permlane32_swap(w0[i], w1[i], false, false); w0[i] = r[0]; w1[i] = r[1]; }
    if (act) {
#pragma unroll
        for (int k = 0; k < 4; ++k) *(GAS v4u*)(rowp + 32 * hi + 8 * k) = (v4u){w0[2 * k], w0[2 * k + 1], w1[2 * k], w1[2 * k + 1]}; }
}
__device__ __forceinline__ void add_row(f32x16* o, const GAS bf16* rowp, int hi) {
    v4u v[4];
#pragma unroll
    for (int k = 0; k < 4; ++k) v[k] = *(const GAS v4u*)(rowp + 32 * hi + 8 * k);
#pragma unroll
    for (int k = 0; k < 4; ++k) { auto r0 = __builtin_amdgcn_permlane32_swap(v[k][0], v[k][2], false, false); auto r1 = __builtin_amdgcn_permlane32_swap(v[k][1], v[k][3], false, false);
        o[0][4 * k] += __builtin_bit_cast(float, r0[0] << 16); o[0][4 * k + 1] += __builtin_bit_cast(float, r0[0] & 0xffff0000u);
        o[0][4 * k + 2] += __builtin_bit_cast(float, r1[0] << 16); o[0][4 * k + 3] += __builtin_bit_cast(float, r1[0] & 0xffff0000u);
        o[1][4 * k] += __builtin_bit_cast(float, r0[1] << 16); o[1][4 * k + 1] += __builtin_bit_cast(float, r0[1] & 0xffff0000u);
        o[1][4 * k + 2] += __builtin_bit_cast(float, r1[1] << 16); o[1][4 * k + 3] += __builtin_bit_cast(float, r1[1] & 0xffff0000u); }
}
__device__ __forceinline__ GAS bf16* po_row(GAS unsigned char* ws, GAS float* outbuf, int b, int h, int t, int slot) {
    return (b < 2 ? (GAS bf16*)outbuf : (GAS bf16*)(ws + WS_POB)) + ((((size_t)((b & 1) * 16 + h) * SEQ + t) * 3 + slot) * 64);
}

__device__ __forceinline__ void route(Frame& F) {
    GAS unsigned char* ws = F.ws;
    const GAS bf16* Qb = (const GAS bf16*)(ws + WS_Q); const GAS bf16* Kb = (const GAS bf16*)(ws + WS_K);
    const GAS float* KMP = (const GAS float*)(ws + WS_KMP);
    GAS unsigned short* SEG = (GAS unsigned short*)(ws + WS_SEG); GAS unsigned* CNT = (GAS unsigned*)(ws + WS_CNT); GAS unsigned* TOT = (GAS unsigned*)(ws + WS_CTL) + CW_TOT;
    GAS float* KBM = (GAS float*)(ws + WS_KBM);
    int tid = F.wave * 64 + lane_id(); asm volatile("" : "+v"(tid));
    const int hf = tid >> 8, t = tid & 255, lane = tid & 63, w4 = (tid >> 6) & 3;
    LAS float* kms = (LAS float*)(F.lds + hf * 16384);
    LAS unsigned* cntw = (LAS unsigned*)(F.lds + hf * 16384 + 8192);
    LAS float* kbw = (LAS float*)(F.lds + hf * 16384 + 8192 + 512);
    for (int it = 0; it < 4; ++it) {
        const int id = it * 512 + F.vcu * 2 + hf, own = id >> 6, bh = id & 63, b = bh >> 4, h = bh & 15;
        __syncthreads();
        for (int i = t; i < NBLK * 64; i += 256) { const int n = i >> 6, d = i & 63; const size_t o = ((size_t)(b * 32 + n) * 2) * 1024 + h * 64 + d; kms[i] = (KMP[o] + KMP[o + 1024]) * (1.0f / 256.0f); }
        const size_t row = (size_t)b * SEQ + own * BLK + t;
        float q[64];
        { const GAS v4u* qp = (const GAS v4u*)(Qb + row * D + h * 64);
#pragma unroll
          for (int i = 0; i < 8; ++i) { const v4u v = qp[i];
#pragma unroll
              for (int j = 0; j < 4; ++j) { q[8 * i + 2 * j] = __builtin_bit_cast(float, v[j] << 16); q[8 * i + 2 * j + 1] = __builtin_bit_cast(float, v[j] & 0xffff0000u); } } }
        { const GAS v4u* kp = (const GAS v4u*)(Kb + row * D + h * 64); float k2 = 0.f;
#pragma unroll
          for (int i = 0; i < 8; ++i) { const v4u v = kp[i];
#pragma unroll
              for (int j = 0; j < 4; ++j) { const float a = __builtin_bit_cast(float, v[j] << 16), c = __builtin_bit_cast(float, v[j] & 0xffff0000u); k2 += a * a + c * c; } }
#pragma unroll
          for (int o = 1; o < 64; o <<= 1) k2 = fmaxf(k2, shx(k2, o, lane));
          if (lane == 0) kbw[w4] = k2; }
        __syncthreads();
        float g1 = -INFINITY, g2 = -INFINITY, g3 = -INFINITY; int i1 = -1, i2 = -1, i3 = -1;
        for (int n = 0; n < own; ++n) {
            float g = 0.f;
#pragma unroll
            for (int d4 = 0; d4 < 16; ++d4) { const f32x4 kv = *(const LAS f32x4*)(kms + n * 64 + 4 * d4); g += q[4 * d4] * kv[0] + q[4 * d4 + 1] * kv[1] + q[4 * d4 + 2] * kv[2] + q[4 * d4 + 3] * kv[3]; }
            if (g > g1) { g3 = g2; i3 = i2; g2 = g1; i2 = i1; g1 = g; i1 = n; }
            else if (g > g2) { g3 = g2; i3 = i2; g2 = g; i2 = n; }
            else if (g > g3) { g3 = g; i3 = n; }
        }
        for (int n = 0; n < own; ++n) { const unsigned long long mm = __ballot(i1 == n || i2 == n || i3 == n); if (lane == 0) cntw[w4 * 32 + n] = (unsigned)__popcll(mm); }
        __syncthreads();
        for (int n = 0; n < own; ++n) { const bool has = (i1 == n || i2 == n || i3 == n); const unsigned long long mm = __ballot(has);
            if (has) { unsigned base = 0; for (int w = 0; w < w4; ++w) base += cntw[w * 32 + n];
                const unsigned rank = (unsigned)__popcll(mm & ((1ull << lane) - 1ull)); const unsigned slot = (i1 == n) ? 0u : (i2 == n) ? 1u : 2u;
                SEG[(((size_t)bh * 32 + own) * 32 + n) * 256 + base + rank] = (unsigned short)(t | (slot << 8)); } }
        if (t < own) { const unsigned c = cntw[t] + cntw[32 + t] + cntw[64 + t] + cntw[96 + t]; CNT[((size_t)bh * 32 + own) * 32 + t] = c; (void)__hip_atomic_fetch_add(TOT + bh * 31 + t, c, RLX_AGENT); }
        if (t == 0) KBM[bh * 32 + own] = fmaxf(fmaxf(kbw[0], kbw[1]), fmaxf(kbw[2], kbw[3]));
    }
    __syncthreads();
}

struct GTile { unsigned info; bf16x8 qr[4]; };
struct GRun { int e, c0, c1; };
__device__ __forceinline__ void dma_kv(LAS unsigned char* kv, const GAS bf16* Kb, const GAS bf16* Vb, int b, int h, int n, int w, int lane) {
#pragma unroll
    for (int t = 0; t < 4; ++t) {
        const size_t kr = (size_t)b * SEQ + n * BLK + 64 * t + lane, vr = (size_t)b * SEQ + n * BLK + 64 * t + 16 * (w & 3) + (lane >> 2);
        __builtin_amdgcn_global_load_lds((const GAS unsigned*)(Kb + kr * D + h * 64 + w * 8), (LAS unsigned*)(kv + L_K + t * 8192 + w * 1024), 16, 0, 0);
        __builtin_amdgcn_global_load_lds((const GAS unsigned*)(Vb + vr * D + h * 64 + (w >> 2) * 32 + (lane & 3) * 8), (LAS unsigned*)(kv + L_V + t * 8192 + w * 1024), 16, 0, 0);
    }
}
__device__ __forceinline__ void gather(Frame& F) {
    GAS unsigned char* ws = F.ws;
    const GAS bf16* Qb = (const GAS bf16*)(ws + WS_Q); const GAS bf16* Kb = (const GAS bf16*)(ws + WS_K); const GAS bf16* Vb = (const GAS bf16*)(ws + WS_V);
    const GAS unsigned short* SEG = (const GAS unsigned short*)(ws + WS_SEG); const GAS unsigned* CNT = (const GAS unsigned*)(ws + WS_CNT); const GAS unsigned* TOT = (const GAS unsigned*)(ws + WS_CTL) + CW_TOT;
    const GAS float* KBM = (const GAS float*)(ws + WS_KBM); GAS float* PL = (GAS float*)(ws + WS_PL);
    int tid = F.wave * 64 + lane_id(); asm volatile("" : "+v"(tid));
    const int lane = tid & 63, w = __builtin_amdgcn_readfirstlane(tid >> 6), r32 = lane & 31, hi = lane >> 5;
    LAS unsigned* pre = (LAS unsigned*)(F.lds + L_PRE);
    __syncthreads();
    if (w == 0) { unsigned loc = 0;
        for (int i = 0; i < 31; ++i) { const unsigned nc = (TOT[31 * lane + i] + 255u) >> 8; loc += nc + (nc ? 1u : 0u); }
        unsigned inc = loc;
#pragma unroll
        for (int o = 1; o < 64; o <<= 1) { const unsigned v = shup(inc, o, lane); if (lane >= o) inc += v; }
        unsigned run = inc - loc;
        for (int i = 0; i < 31; ++i) { pre[31 * lane + i] = run; const unsigned nc = (TOT[31 * lane + i] + 255u) >> 8; run += nc + (nc ? 1u : 0u); }
        if (lane == 63) pre[1984] = run; }
    __syncthreads();
    const int U = (int)pre[1984];
    int p = (int)(((long)F.vcu * U) / F.G); const int phi = (int)(((long)(F.vcu + 1) * U) / F.G);
    int e = 0; { int lo = 0, hi2 = 1984; while (hi2 - lo > 1) { const int mid = (lo + hi2) >> 1; if ((int)pre[mid] <= p) lo = mid; else hi2 = mid; } e = lo; }
    auto next_run = [&](GRun& R) -> bool {
        while (p < phi) {
            while (p >= (int)pre[e + 1]) ++e;
            const int k = p - (int)pre[e], nch = (int)pre[e + 1] - (int)pre[e] - 1;
            const int c0 = k > 0 ? k - 1 : 0; int c1 = phi - (int)pre[e] - 1; c1 = c1 < nch ? c1 : nch;
            p = (int)pre[e] + 1 + c1;
            if (c1 > c0) { R.e = e; R.c0 = c0; R.c1 = c1; return true; }
        }
        return false;
    };
    auto scan_cnt = [&](unsigned v) -> unsigned { unsigned inc = v;
#pragma unroll
        for (int o = 1; o < 32; o <<= 1) { const unsigned t2 = shup(inc, o, lane); if ((lane & 31) >= o) inc += t2; }
        return inc; };
    int cur_h = -1, cur_bh = -1, rb = 0; float kmax2 = 0.f, bmax = 0.f, rb31 = 0.f;
    GRun cur, nxt; bool hc = next_run(cur);
    unsigned cntN = 0, totN = 0, cumv = 0, tot = 0;
    if (hc) { const int bh = cur.e / 31, n = cur.e - bh * 31; dma_kv(F.lds, Kb, Vb, bh >> 4, bh & 15, n, w, lane);
        cntN = ((lane & 31) > n) ? CNT[((size_t)bh * 32 + (lane & 31)) * 32 + n] : 0u; totN = TOT[cur.e]; }
    GTile tcur, tnxt; unsigned ownB = 0, entB = 0xffffffffu; bool mine = false;
    auto fetch_ent = [&](int c, int n, const GAS unsigned short* segb, unsigned cv, unsigned tt, unsigned& own_o) -> unsigned {
        const unsigned g0 = 256u * c + 32u * w, g = g0 + r32;
        if (g0 >= tt) { own_o = 0; return 0xffffffffu; }
        int lo = n + 1, hi2 = 32;
        while (hi2 - lo > 1) { const int mid = (lo + hi2) >> 1; if (__builtin_amdgcn_readlane(cv, mid - 1) <= g0) lo = mid; else hi2 = mid; }
        unsigned own = (unsigned)lo, base = (lo == n + 1) ? 0u : __builtin_amdgcn_readlane(cv, lo - 1);
        for (int o = lo + 1; o < 32; ++o) { const unsigned s2 = __builtin_amdgcn_readlane(cv, o - 1); if (s2 > g0 + 31u) break; if (s2 <= g) { own = (unsigned)o; base = s2; } }
        own_o = own;
        return (g < tt) ? (unsigned)segb[(size_t)own * 32 * 256 + (g - base)] : 0xffffffffu;
    };
    auto make_tile = [&](unsigned ent, unsigned own, int b, int h, int n, GTile& T) {
        const bool act = ent != 0xffffffffu;
        const int tq = act ? (int)(own * BLK + (ent & 255u)) : SEQ - 1;
        T.info = (unsigned)tq | (act ? (((ent >> 8) & 3u) << 16) | (1u << 18) | ((own - n <= 4) ? (1u << 19) : 0u) : 0u);
        load_q_raw(T.qr, Qb, (size_t)b * SEQ + tq, h, hi);
    };
    auto start_run = [&](const GRun& R) {
        const int bh = R.e / 31, n = R.e - bh * 31; const GAS unsigned short* segb = SEG + ((size_t)bh * 32 * 32 + n) * 256;
        cumv = scan_cnt(cntN); tot = totN;
        mine = (unsigned)(256 * R.c0 + 32 * w) < tot;
        entB = 0xffffffffu; ownB = 0;
        if (mine) { unsigned ownA; const unsigned entA = fetch_ent(R.c0, n, segb, cumv, tot, ownA); make_tile(entA, ownA, bh >> 4, bh & 15, n, tcur);
            if (R.c0 + 1 < R.c1) entB = fetch_ent(R.c0 + 1, n, segb, cumv, tot, ownB); }
    };
    if (hc) start_run(cur);
    while (hc) {
        const bool hn = next_run(nxt);
        const int c0 = cur.c0, c1 = cur.c1, bh = cur.e / 31, n = cur.e - bh * 31, b = bh >> 4, h = bh & 15;
        const GAS unsigned short* segb = SEG + ((size_t)bh * 32 * 32 + n) * 256;
        LAS unsigned char* kv = F.lds + rb * 65536;
        asm volatile("s_waitcnt vmcnt(0)" ::: "memory");
        __syncthreads();
        if (hn) { const int bh2 = nxt.e / 31, n2 = nxt.e - bh2 * 31; dma_kv(F.lds + (rb ^ 1) * 65536, Kb, Vb, bh2 >> 4, bh2 & 15, n2, w, lane);
            cntN = ((lane & 31) > n2) ? CNT[((size_t)bh2 * 32 + (lane & 31)) * 32 + n2] : 0u; totN = TOT[nxt.e]; }
        if (bh != cur_bh) { head_bounds(KBM, F.rel_bias, bh, h, lane, kmax2, bmax); rb31 = F.rel_bias[31 * NH + h] * LOG2E; cur_bh = bh;
            if (h != cur_h) { build_lut(F.lds, F.rel_bias, h, tid); cur_h = h; __syncthreads(); } }
        const lds_cptr Kl = (lds_cptr)(kv + L_K), vp0 = (lds_cptr)(kv + L_V) + ((lane >> 4) & 1) * 32 + (lane & 3) * 8 + (4 * hi + ((lane & 15) >> 2)) * 64;
        if (mine) for (int c = c0; c < c1; ++c) {
            if ((unsigned)(256 * c + 32 * w) >= tot) break;
            const bool has1 = (c + 1 < c1) && ((unsigned)(256 * (c + 1) + 32 * w) < tot);
            if (has1) make_tile(entB, ownB, b, h, n, tnxt);
            if (c + 2 < c1) entB = fetch_ent(c + 2, n, segb, cumv, tot, ownB); else { entB = 0xffffffffu; ownB = 0; }
            const unsigned info = tcur.info; const int tq = (int)(info & 0xffffu); const bool near = (info >> 19) & 1u;
            const float mref = ref_exponent(q_norm2(tcur.qr), kmax2, bmax);
            const bool anynear = __any(near);
            const int tqrel = near ? (tq - n * BLK) : 1755;
            LAS const float* lutp = (LAS const float*)(F.lds + L_LUT) + (2047 - tqrel + 4 * hi);
            f32x16 cinit; { const float cc = anynear ? -mref : (rb31 - mref);
#pragma unroll
                for (int r = 0; r < 16; ++r) cinit[r] = cc; }
            f32x16 o[2]; o[0] = f32x16{}; o[1] = f32x16{}; float l = 0.f;
#pragma unroll
            for (int j = 0; j < 4; ++j) { f32x16 p0, p1; v4u pa[4];
                qk_tile(p0, p1, Kl + j * 8192, tcur.qr, cinit, r32, hi);
                if (anynear) softmax_tile<true, false>(p0, p1, lutp, j, 0, hi, l, pa); else softmax_tile<false, false>(p0, p1, lutp, j, 0, hi, l, pa);
                pv_tile(o, vp0 + j * 8192, pa); }
            l = swap_add(l);
            { const bool act = (info >> 18) & 1u; const int slot = (int)((info >> 16) & 3u);
              store_row(po_row(ws, F.out, b, h, tq, slot), o, 1.0f, hi, act);
              if (act && hi == 0) PL[(((size_t)bh * SEQ + tq) * 3) + slot] = l; }
            if (has1) tcur = tnxt;
        }
        if (hn) start_run(nxt);
        cur = nxt; hc = hn; rb ^= 1;
    }
    asm volatile("s_waitcnt vmcnt(0)" ::: "memory");
    __syncthreads();
}

__device__ __forceinline__ void own_block(Frame& F) {
    GAS unsigned char* ws = F.ws;
    const GAS bf16* Qb = (const GAS bf16*)(ws + WS_Q); const GAS bf16* Kb = (const GAS bf16*)(ws + WS_K); const GAS bf16* Vb = (const GAS bf16*)(ws + WS_V); GAS bf16* Ob = (GAS bf16*)(ws + WS_Q);
    const GAS float* KBM = (const GAS float*)(ws + WS_KBM); const GAS float* PL = (const GAS float*)(ws + WS_PL);
    int tid = F.wave * 64 + lane_id(); asm volatile("" : "+v"(tid));
    const int lane = tid & 63, w = __builtin_amdgcn_readfirstlane(tid >> 6), r32 = lane & 31, hi = lane >> 5;
    int cur_h = -1;
    for (int id = F.vcu; id < BATCH * NH * NBLK; id += F.G) {
        const int own = id >> 6, bh = id & 63, b = bh >> 4, h = bh & 15;
        __syncthreads();
        load_kv(F.lds, Kb, Vb, b, h, own, w, lane);
        if (h != cur_h) { build_lut(F.lds, F.rel_bias, h, tid); cur_h = h; }
        float kmax2, bmax; head_bounds(KBM, F.rel_bias, bh, h, lane, kmax2, bmax);
        const int qrel = 32 * w + r32; const size_t qrow = (size_t)b * SEQ + own * BLK + qrel;
        bf16x8 qr[4];
        const float q2 = load_q(qr, Qb, qrow, h, hi);
        const float mref = ref_exponent(q2, kmax2, bmax);
        __syncthreads();
        LAS const float* lutp = (LAS const float*)(F.lds + L_LUT) + (2047 - qrel + 4 * hi);
        f32x16 cinit;
#pragma unroll
        for (int r = 0; r < 16; ++r) cinit[r] = -mref;
        f32x16 o[2]; o[0] = f32x16{}; o[1] = f32x16{}; float l = 0.f;
        const lds_cptr Kl = (lds_cptr)(F.lds + L_K), vp0 = (lds_cptr)(F.lds + L_V) + ((lane >> 4) & 1) * 32 + (lane & 3) * 8 + (4 * hi + ((lane & 15) >> 2)) * 64;
        const int jd = w >> 1;
        for (int j = 0; j <= jd; ++j) { f32x16 p0, p1; v4u pa[4];
            qk_tile(p0, p1, Kl + j * 8192, qr, cinit, r32, hi);
            if (j == jd) softmax_tile<true, true>(p0, p1, lutp, j, qrel, hi, l, pa); else softmax_tile<true, false>(p0, p1, lutp, j, qrel, hi, l, pa);
            pv_tile(o, vp0 + j * 8192, pa); }
        l = swap_add(l);
        const int nsl = own < 3 ? own : 3; const int tq = own * BLK + qrel;
        for (int sl = 0; sl < nsl; ++sl) { add_row(o, po_row(ws, F.out, b, h, tq, sl), hi); l += PL[(((size_t)bh * SEQ + tq) * 3) + sl]; }
        store_row(Ob + qrow * D + h * 64, o, 1.0f / l, hi, true);
    }
    __syncthreads();
}
}

__device__ __forceinline__ void final_norm(Frame& Fr) {
    struct { int lane, vcu, wave, G; const GAS float* norm_final; GAS float* out; } F{Fr.wave * 64 + lane_id(), Fr.vcu, Fr.wave, Fr.G, Fr.norm_final, Fr.out};
    asm volatile("" : "+v"(F.lane)); F.lane &= 63;
    const int gw = F.vcu * NWAVES + F.wave, NGW = F.G * NWAVES;
    f32x4 gam[4];
#pragma unroll
    for (int j = 0; j < 4; ++j) gam[j] = *(const GAS f32x4*)(F.norm_final + 4 * (F.lane + 64 * j));
    for (int row = gw; row < M; row += NGW) { GAS float* xr = F.out + (size_t)row * D; f32x4 v[4]; float ss = 0.f;
#pragma unroll
        for (int j = 0; j < 4; ++j) { v[j] = *(const GAS f32x4*)(xr + 4 * (F.lane + 64 * j)); ss += (v[j][0] * v[j][0] + v[j][1] * v[j][1]) + (v[j][2] * v[j][2] + v[j][3] * v[j][3]); }
#pragma unroll
        for (int o = 1; o < 64; o <<= 1) ss += shx(ss, o, F.lane);
        const float rstd = rsqrtf(ss * (1.0f / D) + EPS);
#pragma unroll
        for (int j = 0; j < 4; ++j) *(GAS f32x4*)(xr + 4 * (F.lane + 64 * j)) = v[j] * rstd * gam[j]; }
}

__global__ void __launch_bounds__(NWAVES * 64, 2) fwd_megakernel(Args args) {
    __shared__ __attribute__((aligned(16))) unsigned char lds[LDS_BYTES];
    Frame F;
    F.lds = (LAS unsigned char*)lds;
    F.tid = threadIdx.x; F.lane = F.tid & 63; F.wave = __builtin_amdgcn_readfirstlane(F.tid >> 6);
    F.G = gridDim.x; { const int bx = blockIdx.x; F.vcu = (F.G % 8 == 0) ? (bx % 8) * (F.G / 8) + bx / 8 : bx; }
    F.x = args.in[0]; F.c = args.in[1]; F.rel_bias = args.in[2]; F.w_mod = args.in[3]; F.b_mod = args.in[4]; F.norm_mix = args.in[5]; F.norm_mlp = args.in[6];
    F.w_pool = args.in[7]; F.pool_scale = args.in[8]; F.w_qkv = args.in[9]; F.w_o = args.in[10]; F.w_up = args.in[11]; F.w_down = args.in[12]; F.norm_final = args.in[13];
    F.out = args.out; F.ws = args.ws;
    volatile LAS unsigned* MISC = (volatile LAS unsigned*)(F.lds + MISC_OFF);
    for (int u = F.tid; u < (LDS_BYTES - LDSCTL_OFF) / 4; u += NWAVES * 64) ((LAS unsigned*)(F.lds + LDSCTL_OFF))[u] = 0u;
    __syncthreads();
    gu32* ctl = (gu32*)(F.ws + WS_CTL);
    XcdBarrier bar = xcd_barrier_post((GAS unsigned*)(ctl + CW_BAR), MISC + 8); bar.wave = F.wave;
    GAS unsigned char* ws = F.ws;
#define WSB(off) ((GAS bf16*)(ws + (off)))
#define WSF(off) ((GAS float*)(ws + (off)))

    p0_prologue(F);
    xcd_barrier(bar);
    p1_bias(F); p1_pool(F);
    xcd_barrier(bar);

    for (int ph = 0; ph < 10; ++ph) {
        asm volatile("" : "+s"(ws));
        const GAS float* MOD = WSF(WS_MOD); GAS float* SS = WSF(WS_SS);
        const int kind = (ph == 0 || ph == 2 || ph == 7) ? 0 : (ph == 1 || ph == 8) ? 1 : (ph == 3) ? 2 : (ph == 4) ? 3 : (ph == 5) ? 4 : (ph == 6) ? 5 : 7;
        if (kind == 0) {
            pg8::Gemm g; pg8::EpiRes E;
            if (ph == 0) { g = pg8::Gemm{WSB(WS_XNA), WSB(WS_WPOOL), M, D, 256, D, 256};
                E = pg8::EpiRes{WSB(WS_XR), WSB(WS_XR), MOD + 2048, F.pool_scale, F.norm_mlp, MOD + 4096, WSB(WS_XNB), SS}; }
            else if (ph == 2) { g = pg8::Gemm{WSB(WS_HB), WSB(WS_WDN0), M, D, FF, FF, 0};
                E = pg8::EpiRes{WSB(WS_XR), WSB(WS_XR), MOD + 5120, nullptr, F.norm_mix + D, MOD + 4 * 6144 + 1024, WSB(WS_XNA), SS}; }
            else { g = pg8::Gemm{WSB(WS_Q), WSB(WS_WO), M, D, D, D, 0};
                E = pg8::EpiRes{WSB(WS_XR), WSB(WS_XR), MOD + 4 * 6144 + 2048, nullptr, F.norm_mlp + D, MOD + 4 * 6144 + 4096, WSB(WS_XNB), SS}; }
            pg8::StaticOrder S; S.init(M, D, F.G, (int)blockIdx.x);
            pg8::gemm_phase<pg8::EpiRes, pg8::StaticOrder, true>(F.lds + RING_OFF, g, S, E, F.wave);
        } else if (kind == 1) {
            const pg8::Gemm g{WSB(WS_XNB), WSB(ph == 1 ? WS_WUP0 : WS_WUP1), M, FF, D, D, 0};
            const pg8::EpiUp E{SS, WSF(ph == 1 ? WS_BIAS_UP0 : WS_BIAS_UP1), WSB(WS_HB), FF};
            pg8::StaticOrder S; S.init(M, FF, F.G, (int)blockIdx.x);
            pg8::gemm_phase<pg8::EpiUp, pg8::StaticOrder, true>(F.lds + RING_OFF, g, S, E, F.wave);
        } else if (kind == 2) {
            const pg8::Gemm g{WSB(WS_XNA), WSB(WS_WQKV), M, NQKV, D, D, 0};
            const pg8::EpiQKV E{SS, WSF(WS_BIAS_QKV), WSB(WS_Q), (size_t)(WS_K - WS_Q) / 2, WSF(WS_KMP)};
            pg8::StaticOrder S; S.init(M, NQKV, F.G, (int)blockIdx.x);
            pg8::gemm_phase<pg8::EpiQKV, pg8::StaticOrder, true>(F.lds + RING_OFF, g, S, E, F.wave);
        } else if (kind == 3) { F.ws = ws; att::route(F);
        } else if (kind == 4) { F.ws = ws; att::gather(F);
        } else if (kind == 5) { F.ws = ws; att::own_block(F);
        } else {
            const pg8::Gemm g{WSB(WS_HB), WSB(WS_WDN1), M, D, FF, FF, 0};
            const pg8::EpiFinal E{WSB(WS_XR), F.out, MOD + 4 * 6144 + 5120, F.norm_final, SS, (GAS unsigned*)(ws + WS_CTL) + CW_FIN};
            pg8::StaticOrder S; S.init(M, D, F.G, (int)blockIdx.x);
            pg8::gemm_phase<pg8::EpiFinal, pg8::StaticOrder, true>(F.lds + RING_OFF, g, S, E, F.wave);
            break;
        }
        xcd_barrier(bar);
    }
}

extern "C" void kernel_launch(void* const* d_in, const int* in_sizes, int n_in, void* d_out, int out_size, void* d_ws, size_t ws_size, hipStream_t stream) {
    static int grid = 0;
    if (grid == 0) {
        if (n_in != 14 || in_sizes[0] != M * D || out_size != M * D || ws_size < WS_END) { fprintf(stderr, "kernel_launch: unexpected shapes / workspace (n_in %d, in0 %d, out %d, ws %zu)\n", n_in, n_in > 0 ? in_sizes[0] : -1, out_size, ws_size); grid = -1; return; }
        int dev = 0, cus = 0, per_cu = 0;
        if (hipGetDevice(&dev) != hipSuccess || hipDeviceGetAttribute(&cus, hipDeviceAttributeMultiprocessorCount, dev) != hipSuccess) { grid = -1; return; }
        if (hipOccupancyMaxActiveBlocksPerMultiprocessor(&per_cu, (const void*)fwd_megakernel, NWAVES * 64, 0) != hipSuccess || per_cu < 1) { fprintf(stderr, "kernel_launch: occupancy query says %d blocks per CU\n", per_cu); }
        (void)hipGetLastError();
        grid = cus;
    }
    if (grid < 0) return;
    if (hipMemsetAsync((char*)d_ws + WS_CTL, 0, CTL_ZERO_BYTES, stream) != hipSuccess) return;
    Args a{};
    for (int i = 0; i < 14; ++i) a.in[i] = (const GAS float*)d_in[i];
    a.out = (GAS float*)d_out; a.ws = (GAS unsigned char*)d_ws;
    hipLaunchKernelGGL(fwd_megakernel, dim3(grid), dim3(NWAVES * 64), 0, stream, a);
}
```

```cpp
#include <hip/hip_runtime.h>
#include <cstdio>
#include <cstdint>

__device__ __forceinline__ float shx(float v, int m, int lane) { return __builtin_bit_cast(float, __builtin_amdgcn_ds_bpermute((lane ^ m) << 2, __builtin_bit_cast(int, v))); }
__device__ __forceinline__ unsigned shup(unsigned v, int o, int lane) { return (unsigned)__builtin_amdgcn_ds_bpermute(((lane - o) & 63) << 2, (int)v); }
__device__ __forceinline__ size_t hm_off(size_t row, int b, int h) { return (row + (size_t)(15 * b + h) * 8192) * 64; }
__device__ __forceinline__ int lane_id() { unsigned z = 0u; asm volatile("" : "+s"(z)); return (int)__builtin_amdgcn_mbcnt_hi(~0u, __builtin_amdgcn_mbcnt_lo(~0u, z)); }

namespace pg8 {
#define PG8_LAS __attribute__((address_space(3)))
#define PG8_GAS __attribute__((address_space(1)))
typedef unsigned short bf16_t;
typedef short bf16x8 __attribute__((ext_vector_type(8)));
typedef float f32x4 __attribute__((ext_vector_type(4)));
typedef unsigned u32x4 __attribute__((ext_vector_type(4)));
constexpr int BM = 256, BK = 64, HALF = 128, HTB = HALF * BK * 2, STAGE_BYTES = 8 * HTB, NXCD = 8, WGM = 8;

__host__ __device__ __forceinline__ int lds_byte(int r, int c) { const int st = (r >> 4) * 2 + (c >> 5), rr = r & 15, cc = c & 31, ob = rr * 64 + cc * 2; return st * 1024 + (ob ^ (((ob >> 9) & 1) << 5)); }
__host__ __device__ __forceinline__ void stage_rc(int b, int& R, int& C) { const int st = b / 1024, sb = b % 1024, swz = sb ^ (((sb >> 9) & 1) << 5); R = (st >> 1) * 16 + swz / 64; C = (st & 1) * 32 + (swz % 64) / 2; }
__host__ __device__ __forceinline__ int perm32(int rho) { const int n = rho >> 4, i = rho & 15; return 8 * (i >> 2) + 4 * n + (i & 3); }

struct Unit { int pm, pn; };
struct Gemm { const PG8_GAS bf16_t* A; const PG8_GAS bf16_t* Bt; int M, N, K, lda, a_pn_off; };

struct StaticOrder {
    int nM, nN, nwg, G, c;
    __host__ __device__ void init(int M, int N, int G_, int c_) { nM = M / BM; nN = N / BM; nwg = nM * nN; G = G_; c = c_; }
    __host__ __device__ bool next(int i, Unit& u) const {
        const long L = (long)i * G + c; if (L >= nwg) return false;
        int wgid = (int)L; { const int q = nwg / NXCD, r = nwg % NXCD, xcd = wgid % NXCD, off = wgid / NXCD; wgid = (xcd < r ? xcd * (q + 1) : r * (q + 1) + (xcd - r) * q) + off; }
        const int nig = WGM * nN, gid = wgid / nig, fm = gid * WGM, gsz = (nM - fm) < WGM ? (nM - fm) : WGM;
        u.pm = fm + ((wgid % nig) % gsz); u.pn = (wgid % nig) / gsz; return true;
    }
};

__device__ __forceinline__ unsigned cvt_pk_bf16(float lo, float hi) { unsigned r; asm volatile("v_cvt_pk_bf16_f32 %0, %1, %2" : "=v"(r) : "v"(lo), "v"(hi)); return r; }

constexpr int SEQ_ = 8192;
constexpr float EPS_ = 1e-6f;
constexpr float C2_ = 0.125f * 1.4426950408889634f;


__device__ __forceinline__ float row_rstd(const PG8_GAS float* SS, int row, int fq, int fr) {
    const f32x4 s4 = *(const PG8_GAS f32x4*)(SS + (size_t)row * 16 + 4 * fq);
    float s = (s4[0] + s4[1]) + (s4[2] + s4[3]);
    const int ln = fq * 16 + fr; s += shx(s, 16, ln); s += shx(s, 32, ln);
    return rsqrtf(s * (1.0f / 1024.0f) + EPS_);
}

__device__ __forceinline__ f32x4 bf_lo4(const u32x4& w) { return (f32x4){__builtin_bit_cast(float, w.x << 16), __builtin_bit_cast(float, w.x & 0xffff0000u), __builtin_bit_cast(float, w.y << 16), __builtin_bit_cast(float, w.y & 0xffff0000u)}; }
__device__ __forceinline__ f32x4 bf_hi4(const u32x4& w) { return (f32x4){__builtin_bit_cast(float, w.z << 16), __builtin_bit_cast(float, w.z & 0xffff0000u), __builtin_bit_cast(float, w.w << 16), __builtin_bit_cast(float, w.w & 0xffff0000u)}; }
struct EpiRes {
    static constexpr bool PERM = true;
    const PG8_GAS bf16_t* Rb; PG8_GAS bf16_t* Xb; const PG8_GAS float* gate; const PG8_GAS float* cscale; const PG8_GAS float* gnext; const PG8_GAS float* scn; PG8_GAS bf16_t* XN; PG8_GAS float* SS;
    __device__ __forceinline__ void operator()(f32x4 (&acc)[2][2][4][2], const Unit& u, int wr, int wc, int fr, int fq) const {
        const int b = u.pm >> 5, colb = u.pn * BM + wc * 32 + 8 * fq, row0 = u.pm * BM + wr * 64 + fr;
        float ssq[2][4];
#pragma unroll
        for (int bj = 0; bj < 2; ++bj) {
            f32x4 gt[2], cs[2];
#pragma unroll
            for (int n = 0; n < 2; ++n) { const int col = colb + bj * HALF + 4 * n;
                f32x4 gv = *(const PG8_GAS f32x4*)(gate + b * 6144 + col); if (cscale) gv = gv * *(const PG8_GAS f32x4*)(cscale + col); gt[n] = gv;
                const f32x4 sc = *(const PG8_GAS f32x4*)(scn + b * 6144 + col); cs[n] = *(const PG8_GAS f32x4*)(gnext + col) * (sc + 1.0f); }
#pragma unroll
            for (int ai = 0; ai < 2; ++ai)
#pragma unroll
                for (int m = 0; m < 4; ++m) { const size_t off = (size_t)(row0 + ai * HALF + m * 16) * 1024 + colb + bj * HALF;
                    const u32x4 rw = *(const PG8_GAS u32x4*)(Rb + off); const f32x4 r0 = bf_lo4(rw), r1 = bf_hi4(rw);
                    const f32x4 y0 = r0 + gt[0] * acc[ai][bj][m][0], y1 = r1 + gt[1] * acc[ai][bj][m][1];
                    u32x4 xw; xw.x = cvt_pk_bf16(y0[0], y0[1]); xw.y = cvt_pk_bf16(y0[2], y0[3]); xw.z = cvt_pk_bf16(y1[0], y1[1]); xw.w = cvt_pk_bf16(y1[2], y1[3]);
                    *(PG8_GAS u32x4*)(Xb + off) = xw;
                    const f32x4 x0 = bf_lo4(xw), x1 = bf_hi4(xw);
                    const float q = (x0[0] * x0[0] + x0[1] * x0[1]) + (x0[2] * x0[2] + x0[3] * x0[3]) + (x1[0] * x1[0] + x1[1] * x1[1]) + (x1[2] * x1[2] + x1[3] * x1[3]);
                    ssq[ai][m] = (bj == 0) ? q : ssq[ai][m] + q;
                    const f32x4 a0 = x0 * cs[0], a1 = x1 * cs[1]; u32x4 w; w.x = cvt_pk_bf16(a0[0], a0[1]); w.y = cvt_pk_bf16(a0[2], a0[3]); w.z = cvt_pk_bf16(a1[0], a1[1]); w.w = cvt_pk_bf16(a1[2], a1[3]);
                    *(PG8_GAS u32x4*)(XN + off) = w;
                }
        }
#pragma unroll
        for (int ai = 0; ai < 2; ++ai)
#pragma unroll
            for (int m = 0; m < 4; ++m) { float q = ssq[ai][m]; q += shx(q, 16, fq * 16 + fr); q += shx(q, 32, fq * 16 + fr); if (fq == 0) SS[(size_t)(row0 + ai * HALF + m * 16) * 16 + u.pn * 4 + wc] = q; }
    }
};

struct EpiFinal {
    static constexpr bool PERM = true;
    const PG8_GAS bf16_t* R; PG8_GAS float* OUT; const PG8_GAS float* gate; const PG8_GAS float* gfin; PG8_GAS float* SS; PG8_GAS unsigned* cnt;
    __device__ __forceinline__ void operator()(f32x4 (&acc)[2][2][4][2], const Unit& u, int wr, int wc, int fr, int fq) const {
        const int b = u.pm >> 5, colb = u.pn * BM + wc * 32 + 8 * fq, row0 = u.pm * BM + wr * 64 + fr, ln = fq * 16 + fr;
        float ssq[2][4];
#pragma unroll
        for (int bj = 0; bj < 2; ++bj) {
            const f32x4 gt0 = *(const PG8_GAS f32x4*)(gate + b * 6144 + colb + bj * HALF), gt1 = *(const PG8_GAS f32x4*)(gate + b * 6144 + colb + bj * HALF + 4);
#pragma unroll
            for (int ai = 0; ai < 2; ++ai)
#pragma unroll
                for (int m = 0; m < 4; ++m) { const size_t off = (size_t)(row0 + ai * HALF + m * 16) * 1024 + colb + bj * HALF;
                    const u32x4 rw = *(const PG8_GAS u32x4*)(R + off);
                    const f32x4 x0 = bf_lo4(rw) + gt0 * acc[ai][bj][m][0], x1 = bf_hi4(rw) + gt1 * acc[ai][bj][m][1];
                    acc[ai][bj][m][0] = x0; acc[ai][bj][m][1] = x1;
                    const float q = (x0[0] * x0[0] + x0[1] * x0[1]) + (x0[2] * x0[2] + x0[3] * x0[3]) + (x1[0] * x1[0] + x1[1] * x1[1]) + (x1[2] * x1[2] + x1[3] * x1[3]);
                    ssq[ai][m] = (bj == 0) ? q : ssq[ai][m] + q;
                    asm volatile("" : "+v"(acc[ai][bj][m][0]), "+v"(acc[ai][bj][m][1]), "+v"(ssq[ai][m]));
                    if (m & 1) asm volatile("" ::: "memory"); }
        }
#pragma unroll
        for (int ai = 0; ai < 2; ++ai)
#pragma unroll
            for (int m = 0; m < 4; ++m) { float q = ssq[ai][m]; q += shx(q, 16, ln); q += shx(q, 32, ln);
                if (fq == 0) __hip_atomic_store(SS + (size_t)(row0 + ai * HALF + m * 16) * 16 + u.pn * 4 + wc, q, __ATOMIC_RELAXED, __HIP_MEMORY_SCOPE_AGENT); }
        asm volatile("s_waitcnt vmcnt(0)" ::: "memory");
        PG8_GAS unsigned* c = cnt + 64 * u.pm;
        if (ln == 0) (void)__hip_atomic_fetch_add(c, 1u, __ATOMIC_RELAXED, __HIP_MEMORY_SCOPE_AGENT);
        for (unsigned sp = 0; sp < (1u << 22); ++sp) { if ((unsigned)__builtin_amdgcn_readfirstlane((int)__hip_atomic_load(c, __ATOMIC_RELAXED, __HIP_MEMORY_SCOPE_AGENT)) >= 32u) break; __builtin_amdgcn_s_sleep(2); }
        int row1 = row0, colc = colb; asm volatile("" : "+v"(row1), "+v"(colc));
        float rs[2][4];
#pragma unroll
        for (int ai = 0; ai < 2; ++ai)
#pragma unroll
            for (int m = 0; m < 4; ++m) { const PG8_GAS float* sp4 = SS + (size_t)(row1 + ai * HALF + m * 16) * 16 + 4 * fq;
                float t = (__hip_atomic_load(sp4, __ATOMIC_RELAXED, __HIP_MEMORY_SCOPE_AGENT) + __hip_atomic_load(sp4 + 1, __ATOMIC_RELAXED, __HIP_MEMORY_SCOPE_AGENT))
                        + (__hip_atomic_load(sp4 + 2, __ATOMIC_RELAXED, __HIP_MEMORY_SCOPE_AGENT) + __hip_atomic_load(sp4 + 3, __ATOMIC_RELAXED, __HIP_MEMORY_SCOPE_AGENT));
                t += shx(t, 16, ln); t += shx(t, 32, ln); rs[ai][m] = rsqrtf(t * (1.0f / 1024.0f) + EPS_); }
#pragma unroll
        for (int bj = 0; bj < 2; ++bj) {
            const f32x4 g0 = *(const PG8_GAS f32x4*)(gfin + colc + bj * HALF), g1 = *(const PG8_GAS f32x4*)(gfin + colc + bj * HALF + 4);
#pragma unroll
            for (int ai = 0; ai < 2; ++ai)
#pragma unroll
                for (int m = 0; m < 4; ++m) { const size_t off = (size_t)(row1 + ai * HALF + m * 16) * 1024 + colc + bj * HALF;
                    *(PG8_GAS f32x4*)(OUT + off) = acc[ai][bj][m][0] * rs[ai][m] * g0; *(PG8_GAS f32x4*)(OUT + off + 4) = acc[ai][bj][m][1] * rs[ai][m] * g1; }
        }
    }
};

struct EpiUp {
    static constexpr bool PERM = true;
    const PG8_GAS float* SS; const PG8_GAS float* bias; PG8_GAS bf16_t* O; int ldc;
    __device__ __forceinline__ void operator()(f32x4 (&acc)[2][2][4][2], const Unit& u, int wr, int wc, int fr, int fq) const {
        const int b = u.pm >> 5, colb = u.pn * BM + wc * 32 + 8 * fq, row0 = u.pm * BM + wr * 64 + fr;
        float rs[2][4];
#pragma unroll
        for (int ai = 0; ai < 2; ++ai)
#pragma unroll
            for (int m = 0; m < 4; ++m) rs[ai][m] = row_rstd(SS, row0 + ai * HALF + m * 16, fq, fr);
#pragma unroll
        for (int bj = 0; bj < 2; ++bj) {
            const f32x4 bv0 = *(const PG8_GAS f32x4*)(bias + (size_t)b * ldc + colb + bj * HALF), bv1 = *(const PG8_GAS f32x4*)(bias + (size_t)b * ldc + colb + bj * HALF + 4);
#pragma unroll
            for (int ai = 0; ai < 2; ++ai)
#pragma unroll
                for (int m = 0; m < 4; ++m) { f32x4 v0 = acc[ai][bj][m][0] * rs[ai][m] + bv0, v1 = acc[ai][bj][m][1] * rs[ai][m] + bv1;
#pragma unroll
                    for (int j = 0; j < 4; ++j) { v0[j] = fmaxf(v0[j], 0.f); v1[j] = fmaxf(v1[j], 0.f); }
                    v0 = v0 * v0; v1 = v1 * v1;
                    u32x4 w; w.x = cvt_pk_bf16(v0[0], v0[1]); w.y = cvt_pk_bf16(v0[2], v0[3]); w.z = cvt_pk_bf16(v1[0], v1[1]); w.w = cvt_pk_bf16(v1[2], v1[3]);
                    *(PG8_GAS u32x4*)(O + (size_t)(row0 + ai * HALF + m * 16) * ldc + colb + bj * HALF) = w; }
        }
    }
};

struct EpiQKV {
    static constexpr bool PERM = true;
    const PG8_GAS float* SS; const PG8_GAS float* bias; PG8_GAS bf16_t* Q; size_t split_stride; PG8_GAS float* KMP;
    __device__ __forceinline__ void operator()(f32x4 (&acc)[2][2][4][2], const Unit& u, int wr, int wc, int fr, int fq) const {
        const int b = u.pm >> 5, t = u.pn >> 2, colt = (u.pn & 3) * BM + wc * 32 + 8 * fq, colb = u.pn * BM + wc * 32 + 8 * fq, row0 = u.pm * BM + wr * 64 + fr;
        PG8_GAS bf16_t* base = Q + (size_t)t * split_stride; const float sc = (t == 0) ? C2_ : 1.0f;
        float rs[2][4];
#pragma unroll
        for (int ai = 0; ai < 2; ++ai)
#pragma unroll
            for (int m = 0; m < 4; ++m) rs[ai][m] = row_rstd(SS, row0 + ai * HALF + m * 16, fq, fr);
#pragma unroll
        for (int bj = 0; bj < 2; ++bj) {
            const f32x4 bv0 = *(const PG8_GAS f32x4*)(bias + (size_t)b * 3072 + colb + bj * HALF), bv1 = *(const PG8_GAS f32x4*)(bias + (size_t)b * 3072 + colb + bj * HALF + 4);
            f32x4 cs0 = {0.f, 0.f, 0.f, 0.f}, cs1 = cs0;
#pragma unroll
            for (int ai = 0; ai < 2; ++ai)
#pragma unroll
                for (int m = 0; m < 4; ++m) { f32x4 v0 = acc[ai][bj][m][0] * rs[ai][m] + bv0, v1 = acc[ai][bj][m][1] * rs[ai][m] + bv1;
                    cs0 += v0; cs1 += v1; v0 = v0 * sc; v1 = v1 * sc;
                    u32x4 w; w.x = cvt_pk_bf16(v0[0], v0[1]); w.y = cvt_pk_bf16(v0[2], v0[3]); w.z = cvt_pk_bf16(v1[0], v1[1]); w.w = cvt_pk_bf16(v1[2], v1[3]);
                    *(PG8_GAS u32x4*)(base + hm_off((size_t)(row0 + ai * HALF + m * 16), b, (colt + bj * HALF) >> 6) + ((colt + bj * HALF) & 63)) = w; }
            if (t == 1) {
#pragma unroll
                for (int o = 1; o < 16; o <<= 1) {
#pragma unroll
                    for (int j = 0; j < 4; ++j) { cs0[j] += shx(cs0[j], o, fq * 16 + fr); cs1[j] += shx(cs1[j], o, fq * 16 + fr); } }
                if (fr == 0) { PG8_GAS float* kp = KMP + ((size_t)u.pm * 2 + wr) * 1024 + colt + bj * HALF; *(f32x4*)kp = cs0; *(PG8_GAS f32x4*)(kp + 4) = cs1; }
            }
        }
    }
};

template <class Epi, class Sched, bool ALIGN_EPI>
__device__ __forceinline__ void gemm_phase(PG8_LAS unsigned char* lds, const Gemm g, const Sched& S, const Epi& E, int wave_id) {
    int tid = wave_id * 64 + lane_id(); asm volatile("" : "+v"(tid));
    const int wid = __builtin_amdgcn_readfirstlane(tid >> 6), lane = tid & 63, wr = wid >> 2, wc = wid & 3, fr = lane & 15, fq = lane >> 4;
    const int K = g.K, nt = K / BK, lda = g.lda;
    unsigned voffA[2], voffB[2];
#pragma unroll
    for (int i = 0; i < 2; ++i) { int R, C; stage_rc(tid * 16 + i * 8192, R, C); const int Rb = Epi::PERM ? ((R & ~31) + perm32(R & 31)) : R;
        voffA[i] = (unsigned)(R * lda + C) * 2u; voffB[i] = (unsigned)(Rb * K + C) * 2u; }
    const size_t kstep = (size_t)(BK * 2);
    const size_t hstepA = (size_t)HALF * lda * 2, tstepA = 2 * hstepA, hstepB = (size_t)HALF * K * 2, tstepB = 2 * hstepB;
    const unsigned ldsw = (unsigned)wid * 1024u;
    const int aoff = lds_byte(wr * 64 + fr, fq * 8), boff = lds_byte(wc * 32 + fr, fq * 8);
#define PG8_SA(b, h) (((b) * 2 + (h)) * HTB)
#define PG8_SB(b, h) ((4 + (b) * 2 + (h)) * HTB)
#define PG8_STAGE(bufoff, gbase, voff) do { _Pragma("unroll") for (int _i = 0; _i < 2; ++_i) \
        __builtin_amdgcn_global_load_lds((const PG8_GAS unsigned*)((const PG8_GAS char*)(gbase) + (voff)[_i]), (PG8_LAS unsigned*)(lds + (bufoff) + ldsw + _i * 8192), 16, 0, 0); } while (0)
#define PG8_LDA(dst, b, h) do { _Pragma("unroll") for (int m = 0; m < 4; ++m) _Pragma("unroll") for (int k = 0; k < 2; ++k) dst[m][k] = *(const PG8_LAS bf16x8*)(lds + PG8_SA(b, h) + aoff + m * 2048 + k * 1024); } while (0)
#define PG8_LDB(dst, b, h) do { _Pragma("unroll") for (int n = 0; n < 2; ++n) _Pragma("unroll") for (int k = 0; k < 2; ++k) dst[n][k] = *(const PG8_LAS bf16x8*)(lds + PG8_SB(b, h) + boff + n * 2048 + k * 1024); } while (0)
#define PG8_MMA(ai, bj, At, Bt) do { __builtin_amdgcn_s_setprio(1); _Pragma("unroll") for (int m = 0; m < 4; ++m) _Pragma("unroll") for (int n = 0; n < 2; ++n) _Pragma("unroll") for (int k = 0; k < 2; ++k) \
        acc[ai][bj][m][n] = __builtin_amdgcn_mfma_f32_16x16x32_bf16(Bt[n][k], At[m][k], acc[ai][bj][m][n], 0, 0, 0); __builtin_amdgcn_s_setprio(0); } while (0)
#define PG8_WAIT_V(n) asm volatile("s_waitcnt vmcnt(" #n ")" ::: "memory")
#define PG8_WAIT_L(n) asm volatile("s_waitcnt lgkmcnt(" #n ")" ::: "memory")
#define PG8_BAR __builtin_amdgcn_s_barrier()
#define PG8_SCHED __builtin_amdgcn_sched_barrier(0)
    Unit cur, nxt; int ui = 0;
    if (!S.next(0, cur)) return;
    f32x4 acc[2][2][4][2];
#pragma unroll
    for (int a = 0; a < 2; ++a)
#pragma unroll
        for (int b = 0; b < 2; ++b)
#pragma unroll
            for (int m = 0; m < 4; ++m)
#pragma unroll
                for (int n = 0; n < 2; ++n) acc[a][b][m][n] = (f32x4){0.f, 0.f, 0.f, 0.f};
    bf16x8 At[4][2], B0[2][2], B1[2][2];
    const PG8_GAS char* cA = (const PG8_GAS char*)g.A + (size_t)cur.pm * tstepA + (size_t)cur.pn * g.a_pn_off * 2; const PG8_GAS char* cB = (const PG8_GAS char*)g.Bt + (size_t)cur.pn * tstepB;
    PG8_STAGE(PG8_SB(0, 0), cB, voffB); PG8_STAGE(PG8_SB(0, 1), cB + hstepB, voffB); PG8_STAGE(PG8_SA(0, 0), cA, voffA); PG8_STAGE(PG8_SA(0, 1), cA + hstepA, voffA);
    if (wr == 1) PG8_BAR;
    PG8_WAIT_V(2); PG8_BAR;
    PG8_STAGE(PG8_SB(1, 0), cB + kstep, voffB); PG8_STAGE(PG8_SA(1, 0), cA + kstep, voffA); PG8_STAGE(PG8_SB(1, 1), cB + hstepB + kstep, voffB);
    PG8_WAIT_V(6); PG8_BAR;
    for (;;) {
        const bool has_next = S.next(ui + 1, nxt);
        const PG8_GAS char* nA = has_next ? (const PG8_GAS char*)g.A + (size_t)nxt.pm * tstepA + (size_t)nxt.pn * g.a_pn_off * 2 : cA; const PG8_GAS char* nB = has_next ? (const PG8_GAS char*)g.Bt + (size_t)nxt.pn * tstepB : cB;
        for (int t = 0; t < nt; t += 2) {
            const bool last = (t == nt - 2);
            const PG8_GAS char* a1 = cA + (size_t)(t + 1) * kstep;
            const PG8_GAS char* a2 = last ? nA : cA + (size_t)(t + 2) * kstep; const PG8_GAS char* b2 = last ? nB : cB + (size_t)(t + 2) * kstep;
            const PG8_GAS char* a3 = a2 + kstep; const PG8_GAS char* b3 = b2 + kstep;
            PG8_LDB(B0, 0, 0); PG8_LDB(B1, 0, 1); PG8_SCHED; PG8_LDA(At, 0, 0); PG8_STAGE(PG8_SA(1, 1), a1 + hstepA, voffA);
            PG8_WAIT_V(8); PG8_WAIT_L(0); PG8_BAR; PG8_MMA(0, 0, At, B0); PG8_MMA(0, 1, At, B1); PG8_BAR; PG8_SCHED;
            PG8_LDA(At, 0, 1); PG8_STAGE(PG8_SB(0, 0), b2, voffB); PG8_STAGE(PG8_SB(0, 1), b2 + hstepB, voffB); PG8_STAGE(PG8_SA(0, 0), a2, voffA);
            PG8_WAIT_V(8); PG8_WAIT_L(0); PG8_BAR; PG8_MMA(1, 0, At, B0); PG8_MMA(1, 1, At, B1); PG8_BAR; PG8_SCHED;
            PG8_LDB(B0, 1, 0); PG8_LDB(B1, 1, 1); PG8_SCHED; PG8_LDA(At, 1, 0); PG8_STAGE(PG8_SA(0, 1), a2 + hstepA, voffA);
            PG8_WAIT_V(8); PG8_WAIT_L(0); PG8_BAR; PG8_MMA(0, 0, At, B0); PG8_MMA(0, 1, At, B1); PG8_BAR; PG8_SCHED;
            PG8_LDA(At, 1, 1); PG8_STAGE(PG8_SB(1, 0), b3, voffB); PG8_STAGE(PG8_SB(1, 1), b3 + hstepB, voffB); PG8_STAGE(PG8_SA(1, 0), a3, voffA);
            PG8_WAIT_V(8); PG8_WAIT_L(0); PG8_BAR; PG8_MMA(1, 0, At, B0); PG8_MMA(1, 1, At, B1); PG8_BAR; PG8_SCHED;
        }
        if constexpr (ALIGN_EPI) { if (wr == 0) PG8_BAR; }
        E(acc, cur, wr, wc, fr, fq);
        if (!has_next) break;
#pragma unroll
        for (int a = 0; a < 2; ++a)
#pragma unroll
            for (int b = 0; b < 2; ++b)
#pragma unroll
                for (int m = 0; m < 4; ++m)
#pragma unroll
                    for (int n = 0; n < 2; ++n) acc[a][b][m][n] = (f32x4){0.f, 0.f, 0.f, 0.f};
        cur = nxt; cA = nA; cB = nB; ++ui;
        if constexpr (ALIGN_EPI) { if (wr == 1) PG8_BAR; }
    }
    PG8_WAIT_V(0);
    if constexpr (!ALIGN_EPI) { if (wr == 0) PG8_BAR; }
    PG8_BAR;
#undef PG8_SA
#undef PG8_SB
#undef PG8_STAGE
#undef PG8_LDA
#undef PG8_LDB
#undef PG8_MMA
#undef PG8_WAIT_V
#undef PG8_WAIT_L
#undef PG8_BAR
#undef PG8_SCHED
}
}

constexpr int NWAVES = 8;
constexpr int BATCH = 4, SEQ = 8192, D = 1024, NH = 16, HD = 64, FF = 4096, M = BATCH * SEQ, NQKV = 3 * D, NBLK = 32, BLK = 256;
constexpr float EPS = 1e-6f;
constexpr float LOG2E = 1.4426950408889634f;

constexpr size_t MiB = 1u << 20;
constexpr size_t WS_CTL = 0, CTL_ZERO_BYTES = 1 * MiB;
constexpr size_t WS_MOD = 1 * MiB;
constexpr size_t WS_BIAS_UP0 = WS_MOD + 256 * 1024;
constexpr size_t WS_BIAS_QKV = WS_BIAS_UP0 + 64 * 1024;
constexpr size_t WS_BIAS_UP1 = WS_BIAS_QKV + 64 * 1024;
constexpr size_t WS_KMP = 2 * MiB;
constexpr size_t WS_SS = 3 * MiB;
constexpr size_t WS_WPOOL = 6 * MiB, WS_WQKV = 8 * MiB, WS_WO = 14 * MiB, WS_WUP0 = 16 * MiB, WS_WUP1 = 24 * MiB, WS_WDN0 = 32 * MiB, WS_WDN1 = 40 * MiB;
constexpr size_t WS_XNA = 48 * MiB, WS_XNB = 112 * MiB;
constexpr size_t WS_HB = 176 * MiB;
constexpr size_t WS_Q = 176 * MiB, WS_K = 240 * MiB, WS_V = 304 * MiB;
constexpr size_t WS_PL = 496 * MiB;
constexpr size_t WS_CNT = 503 * MiB;
constexpr size_t WS_KBM = 503 * MiB + 512 * 1024;
constexpr size_t WS_POB = 48 * MiB;
constexpr size_t WS_SEG = 368 * MiB;
constexpr size_t WS_XR = 432 * MiB;
constexpr size_t WS_O = 368 * MiB;
constexpr size_t WS_END = 504 * MiB;
constexpr int CW_BAR = 4096;
constexpr int CW_FIN = 24576;
constexpr int CW_TOT = 16384;

constexpr int RING_OFF = 0, RING_BYTES = 131072;
constexpr int LDSCTL_OFF = RING_BYTES, MISC_OFF = LDSCTL_OFF + 320;
constexpr int LDS_BYTES = 151552;

#define GAS __attribute__((address_space(1)))
#define LAS __attribute__((address_space(3)))
typedef unsigned short bf16;
typedef unsigned v4u __attribute__((ext_vector_type(4)));
typedef unsigned v2u __attribute__((ext_vector_type(2)));
typedef float f32x4 __attribute__((ext_vector_type(4)));
typedef GAS unsigned gu32;
#define RLX_AGENT __ATOMIC_RELAXED, __HIP_MEMORY_SCOPE_AGENT
#define LDS_WAIT() asm volatile("s_waitcnt lgkmcnt(0)" ::: "memory")
__device__ __forceinline__ unsigned f2bf(float f) { unsigned u = __builtin_bit_cast(unsigned, f); return (u + 0x7fffu + ((u >> 16) & 1u)) >> 16; }
__device__ __forceinline__ unsigned pk2(float lo, float hi) { return f2bf(lo) | (f2bf(hi) << 16); }
__device__ __forceinline__ float bf2f(unsigned short v) { return __builtin_bit_cast(float, (unsigned)v << 16); }

#define XB_TMO      128
#define XB_XCNT(j)  (256  + 64 * (j))
#define XB_XSUB(j)  (1280 + 64 * (j))
#define XB_XGEN(j)  (2304 + 64 * (j))
#define XB_TOP      3328
#define XB_TOPGEN   3392
#define XCD_BAR_WORDS 3456
#define XB_SPIN_CAP (1u << 18)
__device__ __forceinline__ unsigned xb_ld(GAS unsigned* p)              { return __hip_atomic_load(p, __ATOMIC_RELAXED, __HIP_MEMORY_SCOPE_AGENT); }
__device__ __forceinline__ unsigned xb_add(GAS unsigned* p, unsigned v) { return __hip_atomic_fetch_add(p, v, __ATOMIC_RELAXED, __HIP_MEMORY_SCOPE_AGENT); }
__device__ __forceinline__ unsigned xb_xcc_id() { return (unsigned)__builtin_amdgcn_s_getreg((3 << 11) | 20) & 0xFu; }
#define XB_SPIN(cond, bar) do { unsigned _sp = 0; while (cond) { __builtin_amdgcn_s_sleep(1); \
    if ((++_sp & 255u) == 0u) { if (xb_ld(&(bar)[XB_TMO])) break; if (_sp > XB_SPIN_CAP) { (void)xb_add(&(bar)[XB_TMO], 1u); break; } } } } while (0)
struct XcdBarrier { GAS unsigned* bar; unsigned x; volatile LAS unsigned* st; int wave; };
__device__ __forceinline__ XcdBarrier xcd_barrier_post(GAS unsigned* bar, volatile LAS unsigned* st) {
    XcdBarrier b; b.bar = bar; b.x = xb_xcc_id(); b.st = st;
    if (threadIdx.x == 0) (void)xb_add(&bar[XB_XCNT(b.x)], 1u);
    return b;
}
__device__ __forceinline__ void xcd_barrier_complete(GAS unsigned* bar, unsigned x, unsigned& nloc, unsigned& nx) {
    const unsigned G = gridDim.x * gridDim.y * gridDim.z;
    unsigned sum, cnt, mine, sp = 0u;
    for (;;) {
        sum = 0u; cnt = 0u; mine = 0u;
#pragma unroll
        for (unsigned j = 0; j < 16; ++j) { const unsigned c = xb_ld(&bar[XB_XCNT(j)]); sum += c; cnt += (c > 0u) ? 1u : 0u; mine = (j == x) ? c : mine; }
        if (sum == G) break;
        __builtin_amdgcn_s_sleep(1);
        if ((++sp & 255u) == 0u) { if (xb_ld(&bar[XB_TMO])) break; if (sp > XB_SPIN_CAP) { (void)xb_add(&bar[XB_TMO], 1u); break; } }
    }
    nloc = mine > 0u ? mine : 1u; nx = cnt > 0u ? cnt : 1u;
}
__device__ __forceinline__ void xcd_barrier(const XcdBarrier& b) {
    asm volatile("s_waitcnt vmcnt(0)" ::: "memory");
    __syncthreads();
    if (b.wave == 0 && lane_id() == 0) {
        GAS unsigned* bar = b.bar; asm volatile("" : "+s"(bar));
        const unsigned bx = xb_xcc_id();
        __builtin_amdgcn_s_waitcnt(0);
        unsigned nloc = b.st[0], nx = b.st[1];
        if (nloc == 0u) { xcd_barrier_complete(bar, bx, nloc, nx); b.st[0] = nloc; b.st[1] = nx; }
        const unsigned old = xb_add(&bar[XB_XSUB(bx)], 1u);
        const unsigned gen = old / nloc;
        if (old + 1u == (gen + 1u) * nloc) {
            __builtin_amdgcn_fence(__ATOMIC_RELEASE, "agent");
            asm volatile("s_waitcnt vmcnt(0)" ::: "memory");
            const unsigned og = xb_add(&bar[XB_TOP], 1u);
            const unsigned tg = og / nx;
            if (og + 1u == (tg + 1u) * nx) xb_add(&bar[XB_TOPGEN], 1u);
            else XB_SPIN(xb_ld(&bar[XB_TOPGEN]) == tg, bar);
            __builtin_amdgcn_fence(__ATOMIC_ACQUIRE, "agent");
            xb_add(&bar[XB_XGEN(bx)], 1u);
            asm volatile("s_waitcnt vmcnt(0)" ::: "memory");
        } else {
            XB_SPIN(xb_ld(&bar[XB_XGEN(bx)]) == gen, bar);
            __builtin_amdgcn_fence(__ATOMIC_ACQUIRE, "agent");
            asm volatile("s_waitcnt vmcnt(0)" ::: "memory");
        }
    }
    __syncthreads();
}

struct Args { const GAS float* in[14]; GAS float* out; GAS unsigned char* ws; };
struct Frame {
    LAS unsigned char* lds; int tid, lane, wave, vcu, G;
    const GAS float *x, *c, *rel_bias, *w_mod, *b_mod, *norm_mix, *norm_mlp, *w_pool, *pool_scale, *w_qkv, *w_o, *w_up, *w_down, *norm_final;
    GAS float* out; GAS unsigned char* ws;
};
__device__ __forceinline__ float wave_sum(float v) {
#pragma unroll
    for (int o = 1; o < 64; o <<= 1) v += __shfl_xor(v, o);
    return v;
}

struct TItem { const GAS float* W; GAS bf16* WT; int K, N, row_off, item; };
__device__ __forceinline__ void tload(const TItem& I, f32x4 (&t)[8], int lane) {
    const int nblk = I.N / 32, kb = I.item / nblk, nb = I.item % nblk, k0 = 64 * kb, n0 = 32 * nb;
#pragma unroll
    for (int i = 0; i < 8; ++i) t[i] = *(const GAS f32x4*)(I.W + (size_t)(k0 + 8 * i + (lane >> 3)) * I.N + n0 + 4 * (lane & 7));
}
__device__ __forceinline__ void tstore(const TItem& I, const f32x4 (&t)[8], LAS float* scr, int lane) {
    const int nblk = I.N / 32, kb = I.item / nblk, nb = I.item % nblk, k0 = 64 * kb, n0 = 32 * nb;
#pragma unroll
    for (int i = 0; i < 8; ++i) { LAS float* d = scr + (8 * i + (lane >> 3)) * 33 + 4 * (lane & 7); d[0] = t[i][0]; d[1] = t[i][1]; d[2] = t[i][2]; d[3] = t[i][3]; }
    LDS_WAIT(); asm volatile("" ::: "memory");
    const int c = lane & 7;
#pragma unroll
    for (int j = 0; j < 4; ++j) { const int n = (lane >> 3) + 8 * j; const LAS float* s = scr + (8 * c) * 33 + n;
        v4u o; o.x = pk2(s[0 * 33], s[1 * 33]); o.y = pk2(s[2 * 33], s[3 * 33]); o.z = pk2(s[4 * 33], s[5 * 33]); o.w = pk2(s[6 * 33], s[7 * 33]);
        *(GAS v4u*)(I.WT + (size_t)(I.row_off + n0 + n) * I.K + k0 + 8 * c) = o; }
    LDS_WAIT(); asm volatile("" ::: "memory");
}
__device__ __forceinline__ void p0_prologue(Frame& F) {
    if (F.vcu < 192) {
        LAS float* cact = (LAS float*)(F.lds + 67584);
        LAS float* red = (LAS float*)(F.lds + 67584 + 16384);
        const int l = F.vcu / 96, j0 = (F.vcu % 96) * 64;
        for (int i = F.tid; i < 4096; i += NWAVES * 64) { const float v = F.c[i]; cact[i] = v / (1.f + __expf(-v)); }
        __syncthreads();
        const int sub = F.lane >> 4, c4 = F.lane & 15;
        f32x4 a0 = {0.f, 0.f, 0.f, 0.f}, a1 = a0, a2 = a0, a3 = a0;
        const GAS float* wb = F.w_mod + (size_t)l * 1024 * 6144 + j0 + 4 * c4;
#pragma unroll 4
        for (int it = 0; it < 32; ++it) { const int k = 32 * it + 4 * F.wave + sub; const f32x4 wv = *(const GAS f32x4*)(wb + (size_t)k * 6144);
            a0 += wv * cact[k]; a1 += wv * cact[1024 + k]; a2 += wv * cact[2048 + k]; a3 += wv * cact[3072 + k]; }
#pragma unroll
        for (int j = 0; j < 4; ++j) { a0[j] += __shfl_xor(a0[j], 16); a0[j] += __shfl_xor(a0[j], 32); a1[j] += __shfl_xor(a1[j], 16); a1[j] += __shfl_xor(a1[j], 32);
            a2[j] += __shfl_xor(a2[j], 16); a2[j] += __shfl_xor(a2[j], 32); a3[j] += __shfl_xor(a3[j], 16); a3[j] += __shfl_xor(a3[j], 32); }
        if (sub == 0) { LAS f32x4* r4 = (LAS f32x4*)(red + F.wave * 256); r4[0 * 16 + c4] = a0; r4[1 * 16 + c4] = a1; r4[2 * 16 + c4] = a2; r4[3 * 16 + c4] = a3; }
        __syncthreads();
        if (F.tid < 256) { const int b = F.tid >> 6, col = F.tid & 63; float s = 0.f;
#pragma unroll
            for (int w = 0; w < 8; ++w) s += red[w * 256 + b * 64 + col];
            ((GAS float*)(F.ws + WS_MOD))[(l * 4 + b) * 6144 + j0 + col] = s + F.b_mod[l * 6144 + j0 + col]; }
    }
    LAS float* scr = (LAS float*)(F.lds + RING_OFF + F.wave * 8448);
    const int gw = F.vcu * NWAVES + F.wave, NGW = F.G * NWAVES;
    constexpr int I_POOL = 4 * 32, I_QKV = 16 * 96, I_O = 16 * 32, I_UP = 16 * 128, I_DN = 64 * 32;
    constexpr int NITEMS = I_POOL + I_QKV + I_O + 2 * I_UP + 2 * I_DN;
    auto desc = [&](int it) -> TItem {
        int r = it;
        if (r < I_POOL) { const int g = r / 32; return TItem{F.w_pool + (size_t)g * 65536, (GAS bf16*)(F.ws + WS_WPOOL), 256, 256, g * 256, r % 32}; } r -= I_POOL;
        if (r < I_QKV) return TItem{F.w_qkv, (GAS bf16*)(F.ws + WS_WQKV), D, NQKV, 0, r}; r -= I_QKV;
        if (r < I_O) return TItem{F.w_o, (GAS bf16*)(F.ws + WS_WO), D, D, 0, r}; r -= I_O;
        if (r < 2 * I_UP) { const int l = r / I_UP; return TItem{F.w_up + (size_t)l * D * FF, (GAS bf16*)(F.ws + (l ? WS_WUP1 : WS_WUP0)), D, FF, 0, r % I_UP}; } r -= 2 * I_UP;
        const int l = r / I_DN; return TItem{F.w_down + (size_t)l * FF * D, (GAS bf16*)(F.ws + (l ? WS_WDN1 : WS_WDN0)), FF, D, 0, r % I_DN};
    };
    f32x4 ta[8], tb[8];
    int it = gw;
    if (it < NITEMS) { TItem cur = desc(it); tload(cur, ta, F.lane);
        for (;;) {
            const int itn = it + NGW; const bool hn = itn < NITEMS; TItem nxt = cur;
            if (hn) { nxt = desc(itn); tload(nxt, tb, F.lane); }
            tstore(cur, ta, scr, F.lane);
            if (!hn) break;
#pragma unroll
            for (int i = 0; i < 8; ++i) ta[i] = tb[i];
            cur = nxt; it = itn;
        } }
}

__device__ __forceinline__ void p1_bias(Frame& F) {
    const int gw = F.vcu * NWAVES + F.wave, NGW = F.G * NWAVES;
    const GAS float* MOD = (const GAS float*)(F.ws + WS_MOD);
    for (int it = gw; it < 4096 + 3072 + 4096; it += NGW) {
        const GAS bf16* wt; const GAS float* sh; GAS float* dst; int n, N;
        if (it < 4096) { n = it; N = 4096; wt = (const GAS bf16*)(F.ws + WS_WUP0); sh = MOD + 3072; dst = (GAS float*)(F.ws + WS_BIAS_UP0); }
        else if (it < 4096 + 3072) { n = it - 4096; N = 3072; wt = (const GAS bf16*)(F.ws + WS_WQKV); sh = MOD + 4 * 6144; dst = (GAS float*)(F.ws + WS_BIAS_QKV); }
        else { n = it - 7168; N = 4096; wt = (const GAS bf16*)(F.ws + WS_WUP1); sh = MOD + 4 * 6144 + 3072; dst = (GAS float*)(F.ws + WS_BIAS_UP1); }
        const v4u w0 = *(const GAS v4u*)(wt + (size_t)n * 1024 + F.lane * 16), w1 = *(const GAS v4u*)(wt + (size_t)n * 1024 + F.lane * 16 + 8);
        float wf[16];
#pragma unroll
        for (int j = 0; j < 4; ++j) { wf[2 * j] = __builtin_bit_cast(float, w0[j] << 16); wf[2 * j + 1] = __builtin_bit_cast(float, w0[j] & 0xffff0000u);
            wf[8 + 2 * j] = __builtin_bit_cast(float, w1[j] << 16); wf[8 + 2 * j + 1] = __builtin_bit_cast(float, w1[j] & 0xffff0000u); }
#pragma unroll
        for (int b = 0; b < 4; ++b) { const GAS f32x4* sp = (const GAS f32x4*)(sh + b * 6144 + F.lane * 16); float s = 0.f;
#pragma unroll
            for (int j = 0; j < 4; ++j) { const f32x4 sv = sp[j]; s += wf[4 * j] * sv[0] + wf[4 * j + 1] * sv[1] + wf[4 * j + 2] * sv[2] + wf[4 * j + 3] * sv[3]; }
            s = wave_sum(s); if (F.lane == 0) dst[b * N + n] = s; }
    }
}
__device__ __forceinline__ void p1_pool(Frame& F) {
    LAS float* ring = (LAS float*)(F.lds + RING_OFF);
    const GAS float* MOD = (const GAS float*)(F.ws + WS_MOD); GAS bf16* XN = (GAS bf16*)(F.ws + WS_XNA); GAS bf16* XR = (GAS bf16*)(F.ws + WS_XR);
    for (int run = F.vcu; run < M / 128; run += F.G) {
        const int t0 = run * 128, s0 = t0 % SEQ, b = t0 / SEQ;
        f32x4 gam[4];
#pragma unroll
        for (int j = 0; j < 4; ++j) gam[j] = *(const GAS f32x4*)(F.norm_mix + 4 * (F.lane + 64 * j));
        const int c4 = F.tid & 255, rh = F.tid >> 8, gi = c4 >> 6, w = 2 << gi;
        const f32x4 sc1 = *(const GAS f32x4*)(MOD + b * 6144 + 1024 + 4 * c4) + 1.0f;
        f32x4 v[2][4];
        const GAS float* xb = F.x + (size_t)b * SEQ * D + 4 * F.lane;
        int st = (s0 > 0 ? -1 : 0);
#pragma unroll
        for (int rr = 0; rr < 2; ++rr)
#pragma unroll
            for (int j = 0; j < 4; ++j) v[rr][j] = *(const GAS f32x4*)(xb + (size_t)(s0 + 16 * st + 2 * F.wave + rr) * D + 256 * j);
        for (; st < 8; ++st) {
            if (st >= 0) {
#pragma unroll
                for (int rr = 0; rr < 2; ++rr)
#pragma unroll
                    for (int j = 0; j < 4; ++j) { v2u o2; o2.x = pk2(v[rr][j][0], v[rr][j][1]); o2.y = pk2(v[rr][j][2], v[rr][j][3]);
                        *(GAS v2u*)(XR + ((size_t)b * SEQ + s0 + 16 * st + 2 * F.wave + rr) * D + 4 * F.lane + 256 * j) = o2; } }
            float ss0 = 0.f, ss1 = 0.f;
#pragma unroll
            for (int j = 0; j < 4; ++j) { ss0 += (v[0][j][0] * v[0][j][0] + v[0][j][1] * v[0][j][1]) + (v[0][j][2] * v[0][j][2] + v[0][j][3] * v[0][j][3]);
                ss1 += (v[1][j][0] * v[1][j][0] + v[1][j][1] * v[1][j][1]) + (v[1][j][2] * v[1][j][2] + v[1][j][3] * v[1][j][3]); }
#pragma unroll
            for (int o = 1; o < 64; o <<= 1) { ss0 += __shfl_xor(ss0, o); ss1 += __shfl_xor(ss1, o); }
            const float rs0 = rsqrtf(ss0 * (1.0f / D) + EPS), rs1 = rsqrtf(ss1 * (1.0f / D) + EPS);
            { const int sr = s0 + 16 * st + 2 * F.wave;
#pragma unroll
              for (int j = 0; j < 4; ++j) { *(LAS f32x4*)(ring + (sr & 31) * 1024 + 4 * (F.lane + 64 * j)) = v[0][j] * rs0 * gam[j]; *(LAS f32x4*)(ring + ((sr + 1) & 31) * 1024 + 4 * (F.lane + 64 * j)) = v[1][j] * rs1 * gam[j]; } }
            if (st + 1 < 8) {
#pragma unroll
                for (int rr = 0; rr < 2; ++rr)
#pragma unroll
                    for (int j = 0; j < 4; ++j) v[rr][j] = *(const GAS f32x4*)(xb + (size_t)(s0 + 16 * (st + 1) + 2 * F.wave + rr) * D + 256 * j); }
            __syncthreads();
            if (st >= 0) {
                const int sA = s0 + 16 * st + 8 * rh;
                f32x4 sum = {0.f, 0.f, 0.f, 0.f};
                { const int cnt0 = (sA < w) ? sA : w; for (int i = 1; i <= cnt0; ++i) sum += *(const LAS f32x4*)(ring + ((sA - i) & 31) * 1024 + 4 * c4); }
#pragma unroll
                for (int r = 0; r < 8; ++r) { const int s = sA + r; const f32x4 cur = *(const LAS f32x4*)(ring + (s & 31) * 1024 + 4 * c4);
                    sum += cur; if (s >= w) sum -= *(const LAS f32x4*)(ring + ((s - w) & 31) * 1024 + 4 * c4);
                    const float inv = 1.0f / (float)((s + 1 < w) ? s + 1 : w);
                    const f32x4 p = (sum * inv - cur) * sc1;
                    v2u o; o.x = pk2(p[0], p[1]); o.y = pk2(p[2], p[3]);
                    *(GAS v2u*)(XN + ((size_t)b * SEQ + s) * D + 4 * c4) = o; }
            }
            __syncthreads();
        }
    }
}

__device__ __forceinline__ int t5_bucket(int dist) {
    if (dist < 16) return dist;
    int b = 16;
    b += (dist >= 21); b += (dist >= 27); b += (dist >= 35); b += (dist >= 46); b += (dist >= 59); b += (dist >= 77); b += (dist >= 99); b += (dist >= 128);
    b += (dist >= 166); b += (dist >= 216); b += (dist >= 280); b += (dist >= 363); b += (dist >= 470); b += (dist >= 609); b += (dist >= 790);
    return b;
}
namespace att {
typedef short bf16x8 __attribute__((ext_vector_type(8)));
typedef short s16x4 __attribute__((ext_vector_type(4)));
typedef short v4i16_t __attribute__((ext_vector_type(4)));
typedef float f32x16 __attribute__((ext_vector_type(16)));
typedef float f32x2_t __attribute__((ext_vector_type(2)));
typedef __bf16 bf16x2_t __attribute__((ext_vector_type(2)));
typedef LAS const char* lds_cptr;
constexpr int L_K = 0, L_V = 32768, L_LUT = 132096, L_QI = 141312, L_CUM = 142336, L_PRE = 142592;
constexpr int LUTN = 2304;
__device__ __forceinline__ int crow(int r, int hi) { return (r & 3) + 8 * (r >> 2) + 4 * hi; }
__device__ __forceinline__ unsigned cvtpk(float lo, float hi) { f32x2_t v = {lo, hi}; bf16x2_t b = __builtin_convertvector(v, bf16x2_t); return __builtin_bit_cast(unsigned, b); }
__device__ __forceinline__ s16x4 vtr(lds_cptr p) { return __builtin_bit_cast(s16x4, __builtin_amdgcn_ds_read_tr16_b64_v4i16((LAS v4i16_t*)p)); }
__device__ __forceinline__ float swap_add(float v) { auto rr = __builtin_amdgcn_permlane32_swap(__float_as_uint(v), __float_as_uint(v), false, false); return __uint_as_float(rr[0]) + __uint_as_float(rr[1]); }

__device__ __forceinline__ void load_kv(LAS unsigned char* lds, const GAS bf16* Kb, const GAS bf16* Vb, int b, int h, int n, int w, int lane) {
#pragma unroll
    for (int t = 0; t < 4; ++t) {
        const size_t kr = (size_t)b * SEQ + n * BLK + 64 * t + lane, vr = (size_t)b * SEQ + n * BLK + 64 * t + 16 * (w & 3) + (lane >> 2);
        const v4u kv = *(const GAS v4u*)(Kb + hm_off(kr, b, h) + w * 8);
        const v4u vv = *(const GAS v4u*)(Vb + hm_off(vr, b, h) + (w >> 2) * 32 + (lane & 3) * 8);
        *(LAS v4u*)(lds + L_K + t * 8192 + w * 1024 + lane * 16) = kv;
        *(LAS v4u*)(lds + L_V + t * 8192 + w * 1024 + lane * 16) = vv;
    }
}
__device__ __forceinline__ void build_lut(LAS unsigned char* lds, const GAS float* rel_bias, int h, int tid) {
    for (int i = tid; i < LUTN; i += NWAVES * 64) ((LAS float*)(lds + L_LUT))[i] = (i <= 2047) ? rel_bias[t5_bucket(2047 - i) * NH + h] * LOG2E : 0.f;
}
__device__ __forceinline__ void qk_tile(f32x16& p0, f32x16& p1, lds_cptr Kt, const bf16x8* qr, const f32x16& cinit, int r32, int hi) {
    lds_cptr kb = Kt + hi * 1024 + r32 * 16;
#pragma unroll
    for (int d0 = 0; d0 < 4; ++d0) {
        const bf16x8 b0 = *(LAS const bf16x8*)(kb + d0 * 2048), b1 = *(LAS const bf16x8*)(kb + d0 * 2048 + 512);
        if (d0 == 0) { p0 = __builtin_amdgcn_mfma_f32_32x32x16_bf16(b0, qr[0], cinit, 0, 0, 0); p1 = __builtin_amdgcn_mfma_f32_32x32x16_bf16(b1, qr[0], cinit, 0, 0, 0); }
        else { p0 = __builtin_amdgcn_mfma_f32_32x32x16_bf16(b0, qr[d0], p0, 0, 0, 0); p1 = __builtin_amdgcn_mfma_f32_32x32x16_bf16(b1, qr[d0], p1, 0, 0, 0); }
    }
}
template <bool BIAS, bool MASK>
__device__ __forceinline__ void softmax_tile(f32x16& p0, f32x16& p1, LAS const float* lutp, int jt, int qrel, int hi, float& l, v4u* pa) {
#pragma unroll
    for (int r = 0; r < 16; ++r) { const int ko = 64 * jt + (r & 3) + 8 * (r >> 2);
        if (BIAS) { p0[r] += lutp[ko]; p1[r] += lutp[ko + 32]; }
        if (MASK) { const int kv = ko + 4 * hi; if (kv > qrel) p0[r] = -INFINITY; if (kv + 32 > qrel) p1[r] = -INFINITY; }
        p0[r] = __builtin_amdgcn_exp2f(p0[r]); p1[r] = __builtin_amdgcn_exp2f(p1[r]); }
    float s = 0.f;
#pragma unroll
    for (int r = 0; r < 16; ++r) s += p0[r] + p1[r];
    l += s;
    pa[0] = (v4u){cvtpk(p0[0], p0[1]), cvtpk(p0[2], p0[3]), cvtpk(p0[4], p0[5]), cvtpk(p0[6], p0[7])};
    pa[1] = (v4u){cvtpk(p0[8], p0[9]), cvtpk(p0[10], p0[11]), cvtpk(p0[12], p0[13]), cvtpk(p0[14], p0[15])};
    pa[2] = (v4u){cvtpk(p1[0], p1[1]), cvtpk(p1[2], p1[3]), cvtpk(p1[4], p1[5]), cvtpk(p1[6], p1[7])};
    pa[3] = (v4u){cvtpk(p1[8], p1[9]), cvtpk(p1[10], p1[11]), cvtpk(p1[12], p1[13]), cvtpk(p1[14], p1[15])};
}
__device__ __forceinline__ void pv_tile(f32x16* o, lds_cptr vp, const v4u* pa) {
#pragma unroll
    for (int d0 = 0; d0 < 2; ++d0)
#pragma unroll
        for (int ks = 0; ks < 4; ++ks) { const s16x4 lo = vtr(vp + d0 * 4096 + ks * 1024), hi = vtr(vp + d0 * 4096 + ks * 1024 + 512);
            const bf16x8 vf = (bf16x8){lo[0], lo[1], lo[2], lo[3], hi[0], hi[1], hi[2], hi[3]};
            o[d0] = __builtin_amdgcn_mfma_f32_32x32x16_bf16(vf, __builtin_bit_cast(bf16x8, pa[ks]), o[d0], 0, 0, 0); }
}
__device__ __forceinline__ void load_q_raw(bf16x8* qr, const GAS bf16* Qb, size_t qrow, int b, int h, int hi) {
#pragma unroll
    for (int d0 = 0; d0 < 4; ++d0) { const v4u v = *(const GAS v4u*)(Qb + hm_off(qrow, b, h) + d0 * 16 + hi * 8); qr[d0] = __builtin_bit_cast(bf16x8, v); }
}
__device__ __forceinline__ float q_norm2(const bf16x8* qr) {
    float q2 = 0.f;
#pragma unroll
    for (int d0 = 0; d0 < 4; ++d0) { const v4u v = __builtin_bit_cast(v4u, qr[d0]);
#pragma unroll
        for (int j = 0; j < 4; ++j) { const float a = __builtin_bit_cast(float, v[j] << 16), c = __builtin_bit_cast(float, v[j] & 0xffff0000u); q2 += a * a + c * c; } }
    return swap_add(q2);
}

__device__ __forceinline__ float ref_exponent(float q2, float kmax2, float bmax) { return __builtin_sqrtf(q2 * kmax2) * 1.002f + bmax + 0.01f; }
__device__ __forceinline__ void head_bounds(const GAS float* KBM, const GAS float* rel_bias, int bh, int h, int lane, float& kmax2, float& bmax) {
    float k = KBM[bh * 32 + (lane & 31)], bb = rel_bias[(lane & 31) * NH + h] * LOG2E;
#pragma unroll
    for (int o = 1; o < 32; o <<= 1) { k = fmaxf(k, shx(k, o, lane)); bb = fmaxf(bb, shx(bb, o, lane)); }
    kmax2 = k; bmax = bb;
}
__device__ __forceinline__ void store_row(GAS bf16* rowp, const f32x16* o, float scale, int hi, bool act) {
    unsigned w0[8], w1[8];
#pragma unroll
    for (int k = 0; k < 4; ++k) { w0[2 * k] = cvtpk(o[0][4 * k] * scale, o[0][4 * k + 1] * scale); w0[2 * k + 1] = cvtpk(o[0][4 * k + 2] * scale, o[0][4 * k + 3] * scale);
        w1[2 * k] = cvtpk(o[1][4 * k] * scale, o[1][4 * k + 1] * scale); w1[2 * k + 1] = cvtpk(o[1][4 * k + 2] * scale, o[1][4 * k + 3] * scale); }
#pragma unroll
    for (int i = 0; i < 8; ++i) { auto r = __builtin_amdgcn_permlane32_swap(w0[i], w1[i], false, false); w0[i] = r[0]; w1[i] = r[1]; }
    if (act) {
#pragma unroll
        for (int k = 0; k < 4; ++k) *(GAS v4u*)(rowp + 32 * hi + 8 * k) = (v4u){w0[2 * k], w0[2 * k + 1], w1[2 * k], w1[2 * k + 1]}; }
}
__device__ __forceinline__ void add_row(f32x16* o, const GAS bf16* rowp, int hi) {
    v4u v[4];
#pragma unroll
    for (int k = 0; k < 4; ++k) v[k] = *(const GAS v4u*)(rowp + 32 * hi + 8 * k);
#pragma unroll
    for (int k = 0; k < 4; ++k) { auto r0 = __builtin_amdgcn_permlane32_swap(v[k][0], v[k][2], false, false); auto r1 = __builtin_amdgcn_permlane32_swap(v[k][1], v[k][3], false, false);
        o[0][4 * k] += __builtin_bit_cast(float, r0[0] << 16); o[0][4 * k + 1] += __builtin_bit_cast(float, r0[0] & 0xffff0000u);
        o[0][4 * k + 2] += __builtin_bit_cast(float, r1[0] << 16); o[0][4 * k + 3] += __builtin_bit_cast(float, r1[0] & 0xffff0000u);
        o[1][4 * k] += __builtin_bit_cast(float, r0[1] << 16); o[1][4 * k + 1] += __builtin_bit_cast(float, r0[1] & 0xffff0000u);
        o[1][4 * k + 2] += __builtin_bit_cast(float, r1[1] << 16); o[1][4 * k + 3] += __builtin_bit_cast(float, r1[1] & 0xffff0000u); }
}
__device__ __forceinline__ GAS bf16* po_row(GAS unsigned char* ws, GAS float* outbuf, int b, int h, int t, int slot) {
    return (b < 2 ? (GAS bf16*)outbuf : (GAS bf16*)(ws + WS_POB)) + ((((size_t)((b & 1) * 16 + h) * SEQ + t) * 3 + slot) * 64);
}

__device__ __forceinline__ void route(Frame& F) {
    GAS unsigned char* ws = F.ws;
    const GAS bf16* Qb = (const GAS bf16*)(ws + WS_Q); const GAS bf16* Kb = (const GAS bf16*)(ws + WS_K);
    const GAS float* KMP = (const GAS float*)(ws + WS_KMP);
    GAS unsigned short* SEG = (GAS unsigned short*)(ws + WS_SEG); GAS unsigned* CNT = (GAS unsigned*)(ws + WS_CNT); GAS unsigned* TOT = (GAS unsigned*)(ws + WS_CTL) + CW_TOT;
    GAS float* KBM = (GAS float*)(ws + WS_KBM);
    int tid = F.wave * 64 + lane_id(); asm volatile("" : "+v"(tid));
    const int hf = tid >> 8, t = tid & 255, lane = tid & 63, w4 = (tid >> 6) & 3;
    LAS float* kms = (LAS float*)(F.lds + hf * 16384);
    LAS unsigned* cntw = (LAS unsigned*)(F.lds + hf * 16384 + 8192);
    LAS float* kbw = (LAS float*)(F.lds + hf * 16384 + 8192 + 512);
    for (int it = 0; it < 4; ++it) {
        const int id = it * 512 + F.vcu * 2 + hf, own = id >> 6, bh = id & 63, b = bh >> 4, h = bh & 15;
        __syncthreads();
        for (int i = t; i < NBLK * 64; i += 256) { const int n = i >> 6, d = i & 63; const size_t o = ((size_t)(b * 32 + n) * 2) * 1024 + h * 64 + d; kms[i] = (KMP[o] + KMP[o + 1024]) * (1.0f / 256.0f); }
        const size_t row = (size_t)b * SEQ + own * BLK + t;
        float q[64];
        { const GAS v4u* qp = (const GAS v4u*)(Qb + hm_off(row, b, h));
#pragma unroll
          for (int i = 0; i < 8; ++i) { const v4u v = qp[i];
#pragma unroll
              for (int j = 0; j < 4; ++j) { q[8 * i + 2 * j] = __builtin_bit_cast(float, v[j] << 16); q[8 * i + 2 * j + 1] = __builtin_bit_cast(float, v[j] & 0xffff0000u); } } }
        { const GAS v4u* kp = (const GAS v4u*)(Kb + hm_off(row, b, h)); float k2 = 0.f;
#pragma unroll
          for (int i = 0; i < 8; ++i) { const v4u v = kp[i];
#pragma unroll
              for (int j = 0; j < 4; ++j) { const float a = __builtin_bit_cast(float, v[j] << 16), c = __builtin_bit_cast(float, v[j] & 0xffff0000u); k2 += a * a + c * c; } }
#pragma unroll
          for (int o = 1; o < 64; o <<= 1) k2 = fmaxf(k2, shx(k2, o, lane));
          if (lane == 0) kbw[w4] = k2; }
        __syncthreads();
        float g1 = -INFINITY, g2 = -INFINITY, g3 = -INFINITY; int i1 = -1, i2 = -1, i3 = -1;
        for (int n = 0; n < own; ++n) {
            float g = 0.f;
#pragma unroll
            for (int d4 = 0; d4 < 16; ++d4) { const f32x4 kv = *(const LAS f32x4*)(kms + n * 64 + 4 * d4); g += q[4 * d4] * kv[0] + q[4 * d4 + 1] * kv[1] + q[4 * d4 + 2] * kv[2] + q[4 * d4 + 3] * kv[3]; }
            if (g > g1) { g3 = g2; i3 = i2; g2 = g1; i2 = i1; g1 = g; i1 = n; }
            else if (g > g2) { g3 = g2; i3 = i2; g2 = g; i2 = n; }
            else if (g > g3) { g3 = g; i3 = n; }
        }
        for (int n = 0; n < own; ++n) { const unsigned long long mm = __ballot(i1 == n || i2 == n || i3 == n); if (lane == 0) cntw[w4 * 32 + n] = (unsigned)__popcll(mm); }
        __syncthreads();
        for (int n = 0; n < own; ++n) { const bool has = (i1 == n || i2 == n || i3 == n); const unsigned long long mm = __ballot(has);
            if (has) { unsigned base = 0; for (int w = 0; w < w4; ++w) base += cntw[w * 32 + n];
                const unsigned rank = (unsigned)__popcll(mm & ((1ull << lane) - 1ull)); const unsigned slot = (i1 == n) ? 0u : (i2 == n) ? 1u : 2u;
                SEG[(((size_t)bh * 32 + own) * 32 + n) * 256 + base + rank] = (unsigned short)(t | (slot << 8)); } }
        if (t < own) { const unsigned c = cntw[t] + cntw[32 + t] + cntw[64 + t] + cntw[96 + t]; CNT[((size_t)bh * 32 + own) * 32 + t] = c; (void)__hip_atomic_fetch_add(TOT + bh * 31 + t, c, RLX_AGENT); }
        if (t == 0) KBM[bh * 32 + own] = fmaxf(fmaxf(kbw[0], kbw[1]), fmaxf(kbw[2], kbw[3]));
    }
    __syncthreads();
}

struct GTile { unsigned info; bf16x8 qr[4]; };
struct GRun { int e, c0, c1; };
__device__ __forceinline__ void dma_kv(LAS unsigned char* kv, const GAS bf16* Kb, const GAS bf16* Vb, int b, int h, int n, int w, int lane) {
#pragma unroll
    for (int t = 0; t < 4; ++t) {
        const size_t kr = (size_t)b * SEQ + n * BLK + 64 * t + lane, vr = (size_t)b * SEQ + n * BLK + 64 * t + 16 * (w & 3) + (lane >> 2);
        __builtin_amdgcn_global_load_lds((const GAS unsigned*)(Kb + hm_off(kr, b, h) + w * 8), (LAS unsigned*)(kv + L_K + t * 8192 + w * 1024), 16, 0, 0);
        __builtin_amdgcn_global_load_lds((const GAS unsigned*)(Vb + hm_off(vr, b, h) + (w >> 2) * 32 + (lane & 3) * 8), (LAS unsigned*)(kv + L_V + t * 8192 + w * 1024), 16, 0, 0);
    }
}
__device__ __forceinline__ void gather(Frame& F) {
    GAS unsigned char* ws = F.ws;
    const GAS bf16* Qb = (const GAS bf16*)(ws + WS_Q); const GAS bf16* Kb = (const GAS bf16*)(ws + WS_K); const GAS bf16* Vb = (const GAS bf16*)(ws + WS_V);
    const GAS unsigned short* SEG = (const GAS unsigned short*)(ws + WS_SEG); const GAS unsigned* CNT = (const GAS unsigned*)(ws + WS_CNT); const GAS unsigned* TOT = (const GAS unsigned*)(ws + WS_CTL) + CW_TOT;
    const GAS float* KBM = (const GAS float*)(ws + WS_KBM); GAS float* PL = (GAS float*)(ws + WS_PL);
    int tid = F.wave * 64 + lane_id(); asm volatile("" : "+v"(tid));
    const int lane = tid & 63, w = __builtin_amdgcn_readfirstlane(tid >> 6), r32 = lane & 31, hi = lane >> 5;
    LAS unsigned* pre = (LAS unsigned*)(F.lds + L_PRE);
    __syncthreads();
    if (w == 0) { unsigned loc = 0;
        for (int i = 0; i < 31; ++i) { const unsigned nc = (TOT[31 * lane + i] + 255u) >> 8; loc += nc + (nc ? 1u : 0u); }
        unsigned inc = loc;
#pragma unroll
        for (int o = 1; o < 64; o <<= 1) { const unsigned v = shup(inc, o, lane); if (lane >= o) inc += v; }
        unsigned run = inc - loc;
        for (int i = 0; i < 31; ++i) { pre[31 * lane + i] = run; const unsigned nc = (TOT[31 * lane + i] + 255u) >> 8; run += nc + (nc ? 1u : 0u); }
        if (lane == 63) pre[1984] = run; }
    __syncthreads();
    const int U = (int)pre[1984];
    int p = (int)(((long)F.vcu * U) / F.G); const int phi = (int)(((long)(F.vcu + 1) * U) / F.G);
    int e = 0; { int lo = 0, hi2 = 1984; while (hi2 - lo > 1) { const int mid = (lo + hi2) >> 1; if ((int)pre[mid] <= p) lo = mid; else hi2 = mid; } e = lo; }
    auto next_run = [&](GRun& R) -> bool {
        while (p < phi) {
            while (p >= (int)pre[e + 1]) ++e;
            const int k = p - (int)pre[e], nch = (int)pre[e + 1] - (int)pre[e] - 1;
            const int c0 = k > 0 ? k - 1 : 0; int c1 = phi - (int)pre[e] - 1; c1 = c1 < nch ? c1 : nch;
            p = (int)pre[e] + 1 + c1;
            if (c1 > c0) { R.e = e; R.c0 = c0; R.c1 = c1; return true; }
        }
        return false;
    };
    auto scan_cnt = [&](unsigned v) -> unsigned { unsigned inc = v;
#pragma unroll
        for (int o = 1; o < 32; o <<= 1) { const unsigned t2 = shup(inc, o, lane); if ((lane & 31) >= o) inc += t2; }
        return inc; };
    int cur_h = -1, cur_bh = -1, rb = 0; float kmax2 = 0.f, bmax = 0.f, rb31 = 0.f;
    GRun cur, nxt; bool hc = next_run(cur);
    unsigned cntN = 0, totN = 0, cumv = 0, tot = 0;
    if (hc) { const int bh = cur.e / 31, n = cur.e - bh * 31; dma_kv(F.lds, Kb, Vb, bh >> 4, bh & 15, n, w, lane);
        cntN = ((lane & 31) > n) ? CNT[((size_t)bh * 32 + (lane & 31)) * 32 + n] : 0u; totN = TOT[cur.e]; }
    GTile tcur, tnxt; unsigned ownB = 0, entB = 0xffffffffu; bool mine = false;
    auto fetch_ent = [&](int c, int n, const GAS unsigned short* segb, unsigned cv, unsigned tt, unsigned& own_o) -> unsigned {
        const unsigned g0 = 256u * c + 32u * w, g = g0 + r32;
        if (g0 >= tt) { own_o = 0; return 0xffffffffu; }
        int lo = n + 1, hi2 = 32;
        while (hi2 - lo > 1) { const int mid = (lo + hi2) >> 1; if (__builtin_amdgcn_readlane(cv, mid - 1) <= g0) lo = mid; else hi2 = mid; }
        unsigned own = (unsigned)lo, base = (lo == n + 1) ? 0u : __builtin_amdgcn_readlane(cv, lo - 1);
        for (int o = lo + 1; o < 32; ++o) { const unsigned s2 = __builtin_amdgcn_readlane(cv, o - 1); if (s2 > g0 + 31u) break; if (s2 <= g) { own = (unsigned)o; base = s2; } }
        own_o = own;
        return (g < tt) ? (unsigned)segb[(size_t)own * 32 * 256 + (g - base)] : 0xffffffffu;
    };
    auto make_tile = [&](unsigned ent, unsigned own, int b, int h, int n, GTile& T) {
        const bool act = ent != 0xffffffffu;
        const int tq = act ? (int)(own * BLK + (ent & 255u)) : SEQ - 1;
        T.info = (unsigned)tq | (act ? (((ent >> 8) & 3u) << 16) | (1u << 18) | ((own - n <= 4) ? (1u << 19) : 0u) : 0u);
        load_q_raw(T.qr, Qb, (size_t)b * SEQ + tq, b, h, hi);
    };
    auto start_run = [&](const GRun& R) {
        const int bh = R.e / 31, n = R.e - bh * 31; const GAS unsigned short* segb = SEG + ((size_t)bh * 32 * 32 + n) * 256;
        cumv = scan_cnt(cntN); tot = totN;
        mine = (unsigned)(256 * R.c0 + 32 * w) < tot;
        entB = 0xffffffffu; ownB = 0;
        if (mine) { unsigned ownA; const unsigned entA = fetch_ent(R.c0, n, segb, cumv, tot, ownA); make_tile(entA, ownA, bh >> 4, bh & 15, n, tcur);
            if (R.c0 + 1 < R.c1) entB = fetch_ent(R.c0 + 1, n, segb, cumv, tot, ownB); }
    };
    if (hc) start_run(cur);
    while (hc) {
        const bool hn = next_run(nxt);
        const int c0 = cur.c0, c1 = cur.c1, bh = cur.e / 31, n = cur.e - bh * 31, b = bh >> 4, h = bh & 15;
        const GAS unsigned short* segb = SEG + ((size_t)bh * 32 * 32 + n) * 256;
        LAS unsigned char* kv = F.lds + rb * 65536;
        asm volatile("s_waitcnt vmcnt(0)" ::: "memory");
        __syncthreads();
        if (hn) { const int bh2 = nxt.e / 31, n2 = nxt.e - bh2 * 31; dma_kv(F.lds + (rb ^ 1) * 65536, Kb, Vb, bh2 >> 4, bh2 & 15, n2, w, lane);
            cntN = ((lane & 31) > n2) ? CNT[((size_t)bh2 * 32 + (lane & 31)) * 32 + n2] : 0u; totN = TOT[nxt.e]; }
        if (bh != cur_bh) { head_bounds(KBM, F.rel_bias, bh, h, lane, kmax2, bmax); rb31 = F.rel_bias[31 * NH + h] * LOG2E; cur_bh = bh;
            if (h != cur_h) { build_lut(F.lds, F.rel_bias, h, tid); cur_h = h; __syncthreads(); } }
        const lds_cptr Kl = (lds_cptr)(kv + L_K), vp0 = (lds_cptr)(kv + L_V) + ((lane >> 4) & 1) * 32 + (lane & 3) * 8 + (4 * hi + ((lane & 15) >> 2)) * 64;
        if (mine) for (int c = c0; c < c1; ++c) {
            if ((unsigned)(256 * c + 32 * w) >= tot) break;
            const bool has1 = (c + 1 < c1) && ((unsigned)(256 * (c + 1) + 32 * w) < tot);
            if (has1) make_tile(entB, ownB, b, h, n, tnxt);
            if (c + 2 < c1) entB = fetch_ent(c + 2, n, segb, cumv, tot, ownB); else { entB = 0xffffffffu; ownB = 0; }
            const unsigned info = tcur.info; const int tq = (int)(info & 0xffffu); const bool near = (info >> 19) & 1u;
            const float mref = ref_exponent(q_norm2(tcur.qr), kmax2, bmax);
            const bool anynear = __any(near);
            const int tqrel = near ? (tq - n * BLK) : 1755;
            LAS const float* lutp = (LAS const float*)(F.lds + L_LUT) + (2047 - tqrel + 4 * hi);
            f32x16 cinit; { const float cc = anynear ? -mref : (rb31 - mref);
#pragma unroll
                for (int r = 0; r < 16; ++r) cinit[r] = cc; }
            f32x16 o[2]; o[0] = f32x16{}; o[1] = f32x16{}; float l = 0.f;
#pragma unroll
            for (int j = 0; j < 4; ++j) { f32x16 p0, p1; v4u pa[4];
                qk_tile(p0, p1, Kl + j * 8192, tcur.qr, cinit, r32, hi);
                if (anynear) softmax_tile<true, false>(p0, p1, lutp, j, 0, hi, l, pa); else softmax_tile<false, false>(p0, p1, lutp, j, 0, hi, l, pa);
                pv_tile(o, vp0 + j * 8192, pa); }
            l = swap_add(l);
            { const bool act = (info >> 18) & 1u; const int slot = (int)((info >> 16) & 3u);
              store_row(po_row(ws, F.out, b, h, tq, slot), o, 1.0f, hi, act);
              if (act && hi == 0) PL[(((size_t)bh * SEQ + tq) * 3) + slot] = l; }
            if (has1) tcur = tnxt;
        }
        if (hn) start_run(nxt);
        cur = nxt; hc = hn; rb ^= 1;
    }
    asm volatile("s_waitcnt vmcnt(0)" ::: "memory");
    __syncthreads();
}

__device__ __forceinline__ void own_block(Frame& F) {
    GAS unsigned char* ws = F.ws;
    const GAS bf16* Qb = (const GAS bf16*)(ws + WS_Q); const GAS bf16* Kb = (const GAS bf16*)(ws + WS_K); const GAS bf16* Vb = (const GAS bf16*)(ws + WS_V); GAS bf16* Ob = (GAS bf16*)(ws + WS_O);
    const GAS float* KBM = (const GAS float*)(ws + WS_KBM); const GAS float* PL = (const GAS float*)(ws + WS_PL);
    int tid = F.wave * 64 + lane_id(); asm volatile("" : "+v"(tid));
    const int lane = tid & 63, w = __builtin_amdgcn_readfirstlane(tid >> 6), r32 = lane & 31, hi = lane >> 5;
    const int bh = F.vcu & 63, b = bh >> 4, h = bh & 15, own0 = F.vcu >> 6, nun = (NBLK - own0 + 3) / 4;
    __syncthreads();
    build_lut(F.lds, F.rel_bias, h, tid);
    float kmax2, bmax; head_bounds(KBM, F.rel_bias, bh, h, lane, kmax2, bmax);
    const int qrel = 32 * w + r32;
    LAS const float* lutp = (LAS const float*)(F.lds + L_LUT) + (2047 - qrel + 4 * hi);
    const int jd = w >> 1;
    bf16x8 qn[4];
    dma_kv(F.lds, Kb, Vb, b, h, own0, w, lane);
    load_q_raw(qn, Qb, (size_t)b * SEQ + own0 * BLK + qrel, b, h, hi);
    for (int i = 0; i < nun; ++i) {
        const int own = own0 + 4 * i; const size_t qrow = (size_t)b * SEQ + own * BLK + qrel;
        LAS unsigned char* kv = F.lds + (i & 1) * 65536;
        bf16x8 qr[4];
#pragma unroll
        for (int d0 = 0; d0 < 4; ++d0) qr[d0] = qn[d0];
        asm volatile("s_waitcnt vmcnt(0)" ::: "memory");
        __syncthreads();
        if (i + 1 < nun) { dma_kv(F.lds + ((i + 1) & 1) * 65536, Kb, Vb, b, h, own + 4, w, lane); load_q_raw(qn, Qb, qrow + 4 * BLK, b, h, hi); }
        const float mref = ref_exponent(q_norm2(qr), kmax2, bmax);
        f32x16 cinit;
#pragma unroll
        for (int r = 0; r < 16; ++r) cinit[r] = -mref;
        f32x16 o[2]; o[0] = f32x16{}; o[1] = f32x16{}; float l = 0.f;
        const lds_cptr Kl = (lds_cptr)(kv + L_K), vp0 = (lds_cptr)(kv + L_V) + ((lane >> 4) & 1) * 32 + (lane & 3) * 8 + (4 * hi + ((lane & 15) >> 2)) * 64;
        for (int j = 0; j <= jd; ++j) { f32x16 p0, p1; v4u pa[4];
            qk_tile(p0, p1, Kl + j * 8192, qr, cinit, r32, hi);
            if (j == jd) softmax_tile<true, true>(p0, p1, lutp, j, qrel, hi, l, pa); else softmax_tile<true, false>(p0, p1, lutp, j, qrel, hi, l, pa);
            pv_tile(o, vp0 + j * 8192, pa); }
        l = swap_add(l);
        const int nsl = own < 3 ? own : 3; const int tq = own * BLK + qrel;
        for (int sl = 0; sl < nsl; ++sl) { add_row(o, po_row(ws, F.out, b, h, tq, sl), hi); l += PL[(((size_t)bh * SEQ + tq) * 3) + sl]; }
        store_row(Ob + qrow * D + h * 64, o, 1.0f / l, hi, true);
    }
    asm volatile("s_waitcnt vmcnt(0)" ::: "memory");
    __syncthreads();
}
}

__device__ __forceinline__ void final_norm(Frame& Fr) {
    struct { int lane, vcu, wave, G; const GAS float* norm_final; GAS float* out; } F{Fr.wave * 64 + lane_id(), Fr.vcu, Fr.wave, Fr.G, Fr.norm_final, Fr.out};
    asm volatile("" : "+v"(F.lane)); F.lane &= 63;
    const int gw = F.vcu * NWAVES + F.wave, NGW = F.G * NWAVES;
    f32x4 gam[4];
#pragma unroll
    for (int j = 0; j < 4; ++j) gam[j] = *(const GAS f32x4*)(F.norm_final + 4 * (F.lane + 64 * j));
    for (int row = gw; row < M; row += NGW) { GAS float* xr = F.out + (size_t)row * D; f32x4 v[4]; float ss = 0.f;
#pragma unroll
        for (int j = 0; j < 4; ++j) { v[j] = *(const GAS f32x4*)(xr + 4 * (F.lane + 64 * j)); ss += (v[j][0] * v[j][0] + v[j][1] * v[j][1]) + (v[j][2] * v[j][2] + v[j][3] * v[j][3]); }
#pragma unroll
        for (int o = 1; o < 64; o <<= 1) ss += shx(ss, o, F.lane);
        const float rstd = rsqrtf(ss * (1.0f / D) + EPS);
#pragma unroll
        for (int j = 0; j < 4; ++j) *(GAS f32x4*)(xr + 4 * (F.lane + 64 * j)) = v[j] * rstd * gam[j]; }
}

__global__ void __launch_bounds__(NWAVES * 64, 2) fwd_megakernel(Args args) {
    __shared__ __attribute__((aligned(16))) unsigned char lds[LDS_BYTES];
    Frame F;
    F.lds = (LAS unsigned char*)lds;
    F.tid = threadIdx.x; F.lane = F.tid & 63; F.wave = __builtin_amdgcn_readfirstlane(F.tid >> 6);
    F.G = gridDim.x; { const int bx = blockIdx.x; F.vcu = (F.G % 8 == 0) ? (bx % 8) * (F.G / 8) + bx / 8 : bx; }
    F.x = args.in[0]; F.c = args.in[1]; F.rel_bias = args.in[2]; F.w_mod = args.in[3]; F.b_mod = args.in[4]; F.norm_mix = args.in[5]; F.norm_mlp = args.in[6];
    F.w_pool = args.in[7]; F.pool_scale = args.in[8]; F.w_qkv = args.in[9]; F.w_o = args.in[10]; F.w_up = args.in[11]; F.w_down = args.in[12]; F.norm_final = args.in[13];
    F.out = args.out; F.ws = args.ws;
    volatile LAS unsigned* MISC = (volatile LAS unsigned*)(F.lds + MISC_OFF);
    for (int u = F.tid; u < (LDS_BYTES - LDSCTL_OFF) / 4; u += NWAVES * 64) ((LAS unsigned*)(F.lds + LDSCTL_OFF))[u] = 0u;
    __syncthreads();
    gu32* ctl = (gu32*)(F.ws + WS_CTL);
    XcdBarrier bar = xcd_barrier_post((GAS unsigned*)(ctl + CW_BAR), MISC + 8); bar.wave = F.wave;
    GAS unsigned char* ws = F.ws;
#define WSB(off) ((GAS bf16*)(ws + (off)))
#define WSF(off) ((GAS float*)(ws + (off)))

    p0_prologue(F);
    xcd_barrier(bar);
    p1_bias(F); p1_pool(F);
    xcd_barrier(bar);

    for (int ph = 0; ph < 10; ++ph) {
        asm volatile("" : "+s"(ws));
        const GAS float* MOD = WSF(WS_MOD); GAS float* SS = WSF(WS_SS);
        const int kind = (ph == 0 || ph == 2 || ph == 7) ? 0 : (ph == 1 || ph == 8) ? 1 : (ph == 3) ? 2 : (ph == 4) ? 3 : (ph == 5) ? 4 : (ph == 6) ? 5 : 7;
        if (kind == 0) {
            pg8::Gemm g; pg8::EpiRes E;
            if (ph == 0) { g = pg8::Gemm{WSB(WS_XNA), WSB(WS_WPOOL), M, D, 256, D, 256};
                E = pg8::EpiRes{WSB(WS_XR), WSB(WS_XR), MOD + 2048, F.pool_scale, F.norm_mlp, MOD + 4096, WSB(WS_XNB), SS}; }
            else if (ph == 2) { g = pg8::Gemm{WSB(WS_HB), WSB(WS_WDN0), M, D, FF, FF, 0};
                E = pg8::EpiRes{WSB(WS_XR), WSB(WS_XR), MOD + 5120, nullptr, F.norm_mix + D, MOD + 4 * 6144 + 1024, WSB(WS_XNA), SS}; }
            else { g = pg8::Gemm{WSB(WS_O), WSB(WS_WO), M, D, D, D, 0};
                E = pg8::EpiRes{WSB(WS_XR), WSB(WS_XR), MOD + 4 * 6144 + 2048, nullptr, F.norm_mlp + D, MOD + 4 * 6144 + 4096, WSB(WS_XNB), SS}; }
            pg8::StaticOrder S; S.init(M, D, F.G, (int)blockIdx.x);
            pg8::gemm_phase<pg8::EpiRes, pg8::StaticOrder, true>(F.lds + RING_OFF, g, S, E, F.wave);
        } else if (kind == 1) {
            const pg8::Gemm g{WSB(WS_XNB), WSB(ph == 1 ? WS_WUP0 : WS_WUP1), M, FF, D, D, 0};
            const pg8::EpiUp E{SS, WSF(ph == 1 ? WS_BIAS_UP0 : WS_BIAS_UP1), WSB(WS_HB), FF};
            pg8::StaticOrder S; S.init(M, FF, F.G, (int)blockIdx.x);
            pg8::gemm_phase<pg8::EpiUp, pg8::StaticOrder, true>(F.lds + RING_OFF, g, S, E, F.wave);
        } else if (kind == 2) {
            const pg8::Gemm g{WSB(WS_XNA), WSB(WS_WQKV), M, NQKV, D, D, 0};
            const pg8::EpiQKV E{SS, WSF(WS_BIAS_QKV), WSB(WS_Q), (size_t)(WS_K - WS_Q) / 2, WSF(WS_KMP)};
            pg8::StaticOrder S; S.init(M, NQKV, F.G, (int)blockIdx.x);
            pg8::gemm_phase<pg8::EpiQKV, pg8::StaticOrder, true>(F.lds + RING_OFF, g, S, E, F.wave);
        } else if (kind == 3) { F.ws = ws; att::route(F);
        } else if (kind == 4) { F.ws = ws; att::gather(F);
        } else if (kind == 5) { F.ws = ws; att::own_block(F);
        } else {
            const pg8::Gemm g{WSB(WS_HB), WSB(WS_WDN1), M, D, FF, FF, 0};
            const pg8::EpiFinal E{WSB(WS_XR), F.out, MOD + 4 * 6144 + 5120, F.norm_final, SS, (GAS unsigned*)(ws + WS_CTL) + CW_FIN};
            pg8::StaticOrder S; S.init(M, D, F.G, (int)blockIdx.x);
            pg8::gemm_phase<pg8::EpiFinal, pg8::StaticOrder, true>(F.lds + RING_OFF, g, S, E, F.wave);
            break;
        }
        xcd_barrier(bar);
    }
}

extern "C" void kernel_launch(void* const* d_in, const int* in_sizes, int n_in, void* d_out, int out_size, void* d_ws, size_t ws_size, hipStream_t stream) {
    static int grid = 0;
    if (grid == 0) {
        if (n_in != 14 || in_sizes[0] != M * D || out_size != M * D || ws_size < WS_END) { fprintf(stderr, "kernel_launch: unexpected shapes / workspace (n_in %d, in0 %d, out %d, ws %zu)\n", n_in, n_in > 0 ? in_sizes[0] : -1, out_size, ws_size); grid = -1; return; }
        int dev = 0, cus = 0, per_cu = 0;
        if (hipGetDevice(&dev) != hipSuccess || hipDeviceGetAttribute(&cus, hipDeviceAttributeMultiprocessorCount, dev) != hipSuccess) { grid = -1; return; }
        if (hipOccupancyMaxActiveBlocksPerMultiprocessor(&per_cu, (const void*)fwd_megakernel, NWAVES * 64, 0) != hipSuccess || per_cu < 1) { fprintf(stderr, "kernel_launch: occupancy query says %d blocks per CU\n", per_cu); }
        (void)hipGetLastError();
        grid = cus;
    }
    if (grid < 0) return;
    if (hipMemsetAsync((char*)d_ws + WS_CTL, 0, CTL_ZERO_BYTES, stream) != hipSuccess) return;
    Args a{};
    for (int i = 0; i < 14; ++i) a.in[i] = (const GAS float*)d_in[i];
    a.out = (GAS float*)d_out; a.ws = (GAS unsigned char*)d_ws;
    hipLaunchKernelGGL(fwd_megakernel, dim3(grid), dim3(NWAVES * 64), 0, stream, a);
}
```

```cpp
#include <hip/hip_runtime.h>
#include <cstdio>
#include <cstdint>

__device__ __forceinline__ float shx(float v, int m, int lane) { return __builtin_bit_cast(float, __builtin_amdgcn_ds_bpermute((lane ^ m) << 2, __builtin_bit_cast(int, v))); }
__device__ __forceinline__ unsigned shup(unsigned v, int o, int lane) { return (unsigned)__builtin_amdgcn_ds_bpermute(((lane - o) & 63) << 2, (int)v); }
__device__ __forceinline__ size_t hm_off(size_t row, int b, int h) { return (row + (size_t)(15 * b + h) * 8192) * 64; }
__device__ __forceinline__ int lane_id() { unsigned z = 0u; asm volatile("" : "+s"(z)); return (int)__builtin_amdgcn_mbcnt_hi(~0u, __builtin_amdgcn_mbcnt_lo(~0u, z)); }

namespace pg8 {
#define PG8_LAS __attribute__((address_space(3)))
#define PG8_GAS __attribute__((address_space(1)))
typedef unsigned short bf16_t;
typedef short bf16x8 __attribute__((ext_vector_type(8)));
typedef float f32x4 __attribute__((ext_vector_type(4)));
typedef unsigned u32x4 __attribute__((ext_vector_type(4)));
constexpr int BM = 256, BK = 64, HALF = 128, HTB = HALF * BK * 2, STAGE_BYTES = 8 * HTB, NXCD = 8, WGM = 8;

__host__ __device__ __forceinline__ int lds_byte(int r, int c) { const int st = (r >> 4) * 2 + (c >> 5), rr = r & 15, cc = c & 31, ob = rr * 64 + cc * 2; return st * 1024 + (ob ^ (((ob >> 9) & 1) << 5)); }
__host__ __device__ __forceinline__ void stage_rc(int b, int& R, int& C) { const int st = b / 1024, sb = b % 1024, swz = sb ^ (((sb >> 9) & 1) << 5); R = (st >> 1) * 16 + swz / 64; C = (st & 1) * 32 + (swz % 64) / 2; }
__host__ __device__ __forceinline__ int perm32(int rho) { const int n = rho >> 4, i = rho & 15; return 8 * (i >> 2) + 4 * n + (i & 3); }

struct Unit { int pm, pn; };
struct Gemm { const PG8_GAS bf16_t* A; const PG8_GAS bf16_t* Bt; int M, N, K, lda, a_pn_off, a_tileb; };

struct StaticOrder {
    int nM, nN, nwg, G, c;
    __host__ __device__ void init(int M, int N, int G_, int c_) { nM = M / BM; nN = N / BM; nwg = nM * nN; G = G_; c = c_; }
    __host__ __device__ bool next(int i, Unit& u) const {
        const long L = (long)i * G + c; if (L >= nwg) return false;
        int wgid = (int)L; { const int q = nwg / NXCD, r = nwg % NXCD, xcd = wgid % NXCD, off = wgid / NXCD; wgid = (xcd < r ? xcd * (q + 1) : r * (q + 1) + (xcd - r) * q) + off; }
        const int nig = WGM * nN, gid = wgid / nig, fm = gid * WGM, gsz = (nM - fm) < WGM ? (nM - fm) : WGM;
        u.pm = fm + ((wgid % nig) % gsz); u.pn = (wgid % nig) / gsz; return true;
    }
};

__device__ __forceinline__ unsigned cvt_pk_bf16(float lo, float hi) { unsigned r; asm volatile("v_cvt_pk_bf16_f32 %0, %1, %2" : "=v"(r) : "v"(lo), "v"(hi)); return r; }

constexpr int SEQ_ = 8192;
constexpr float EPS_ = 1e-6f;
constexpr float C2_ = 0.125f * 1.4426950408889634f;


__device__ __forceinline__ float row_rstd(const PG8_GAS float* SS, int row, int fq, int fr) {
    const f32x4 s4 = *(const PG8_GAS f32x4*)(SS + (size_t)row * 16 + 4 * fq);
    float s = (s4[0] + s4[1]) + (s4[2] + s4[3]);
    const int ln = fq * 16 + fr; s += shx(s, 16, ln); s += shx(s, 32, ln);
    return rsqrtf(s * (1.0f / 1024.0f) + EPS_);
}

__device__ __forceinline__ f32x4 bf_lo4(const u32x4& w) { return (f32x4){__builtin_bit_cast(float, w.x << 16), __builtin_bit_cast(float, w.x & 0xffff0000u), __builtin_bit_cast(float, w.y << 16), __builtin_bit_cast(float, w.y & 0xffff0000u)}; }
__device__ __forceinline__ f32x4 bf_hi4(const u32x4& w) { return (f32x4){__builtin_bit_cast(float, w.z << 16), __builtin_bit_cast(float, w.z & 0xffff0000u), __builtin_bit_cast(float, w.w << 16), __builtin_bit_cast(float, w.w & 0xffff0000u)}; }
struct EpiRes {
    static constexpr bool PERM = true;
    const PG8_GAS bf16_t* Rb; PG8_GAS bf16_t* Xb; const PG8_GAS float* gate; const PG8_GAS float* cscale; const PG8_GAS float* gnext; const PG8_GAS float* scn; PG8_GAS bf16_t* XN; PG8_GAS float* SS;
    __device__ __forceinline__ void operator()(f32x4 (&acc)[2][2][4][2], const Unit& u, int wr, int wc, int fr, int fq) const {
        const int b = u.pm >> 5, colb = u.pn * BM + wc * 32 + 8 * fq, row0 = u.pm * BM + wr * 64 + fr;
        float ssq[2][4];
#pragma unroll
        for (int bj = 0; bj < 2; ++bj) {
            f32x4 gt[2], cs[2];
#pragma unroll
            for (int n = 0; n < 2; ++n) { const int col = colb + bj * HALF + 4 * n;
                f32x4 gv = *(const PG8_GAS f32x4*)(gate + b * 6144 + col); if (cscale) gv = gv * *(const PG8_GAS f32x4*)(cscale + col); gt[n] = gv;
                const f32x4 sc = *(const PG8_GAS f32x4*)(scn + b * 6144 + col); cs[n] = *(const PG8_GAS f32x4*)(gnext + col) * (sc + 1.0f); }
#pragma unroll
            for (int ai = 0; ai < 2; ++ai)
#pragma unroll
                for (int m = 0; m < 4; ++m) { const size_t off = ((size_t)(u.pm * 4 + u.pn) * 256 + (wr * 64 + fr + ai * HALF + m * 16)) * 256 + (wc * 32 + 8 * fq + bj * HALF);
                    const u32x4 rw = *(const PG8_GAS u32x4*)(Rb + off); const f32x4 r0 = bf_lo4(rw), r1 = bf_hi4(rw);
                    const f32x4 y0 = r0 + gt[0] * acc[ai][bj][m][0], y1 = r1 + gt[1] * acc[ai][bj][m][1];
                    u32x4 xw; xw.x = cvt_pk_bf16(y0[0], y0[1]); xw.y = cvt_pk_bf16(y0[2], y0[3]); xw.z = cvt_pk_bf16(y1[0], y1[1]); xw.w = cvt_pk_bf16(y1[2], y1[3]);
                    *(PG8_GAS u32x4*)(Xb + off) = xw;
                    const f32x4 x0 = bf_lo4(xw), x1 = bf_hi4(xw);
                    const float q = (x0[0] * x0[0] + x0[1] * x0[1]) + (x0[2] * x0[2] + x0[3] * x0[3]) + (x1[0] * x1[0] + x1[1] * x1[1]) + (x1[2] * x1[2] + x1[3] * x1[3]);
                    ssq[ai][m] = (bj == 0) ? q : ssq[ai][m] + q;
                    const f32x4 a0 = x0 * cs[0], a1 = x1 * cs[1]; u32x4 w; w.x = cvt_pk_bf16(a0[0], a0[1]); w.y = cvt_pk_bf16(a0[2], a0[3]); w.z = cvt_pk_bf16(a1[0], a1[1]); w.w = cvt_pk_bf16(a1[2], a1[3]);
                    *(PG8_GAS u32x4*)(XN + off) = w;
                }
        }
#pragma unroll
        for (int ai = 0; ai < 2; ++ai)
#pragma unroll
            for (int m = 0; m < 4; ++m) { float q = ssq[ai][m]; q += shx(q, 16, fq * 16 + fr); q += shx(q, 32, fq * 16 + fr); if (fq == 0) SS[(size_t)(row0 + ai * HALF + m * 16) * 16 + u.pn * 4 + wc] = q; }
    }
};

struct EpiFinal {
    static constexpr bool PERM = true;
    const PG8_GAS bf16_t* R; PG8_GAS float* OUT; const PG8_GAS float* gate; const PG8_GAS float* gfin; PG8_GAS float* SS; PG8_GAS unsigned* cnt;
    __device__ __forceinline__ void operator()(f32x4 (&acc)[2][2][4][2], const Unit& u, int wr, int wc, int fr_, int fq_) const {
        int fr = fr_, fq = fq_; asm volatile("" : "+v"(fr), "+v"(fq));
        const int b = u.pm >> 5, colb = u.pn * BM + wc * 32 + 8 * fq, row0 = u.pm * BM + wr * 64 + fr, ln = fq * 16 + fr;
        float ssq[2][4];
#pragma unroll
        for (int bj = 0; bj < 2; ++bj) {
            const f32x4 gt0 = *(const PG8_GAS f32x4*)(gate + b * 6144 + colb + bj * HALF), gt1 = *(const PG8_GAS f32x4*)(gate + b * 6144 + colb + bj * HALF + 4);
#pragma unroll
            for (int ai = 0; ai < 2; ++ai)
#pragma unroll
                for (int m = 0; m < 4; ++m) { const size_t off = (size_t)(row0 + ai * HALF + m * 16) * 1024 + colb + bj * HALF;
                    const u32x4 rw = *(const PG8_GAS u32x4*)(R + ((size_t)(u.pm * 4 + u.pn) * 256 + (wr * 64 + fr + ai * HALF + m * 16)) * 256 + (wc * 32 + 8 * fq + bj * HALF));
                    const f32x4 x0 = bf_lo4(rw) + gt0 * acc[ai][bj][m][0], x1 = bf_hi4(rw) + gt1 * acc[ai][bj][m][1];
                    acc[ai][bj][m][0] = x0; acc[ai][bj][m][1] = x1;
                    const float q = (x0[0] * x0[0] + x0[1] * x0[1]) + (x0[2] * x0[2] + x0[3] * x0[3]) + (x1[0] * x1[0] + x1[1] * x1[1]) + (x1[2] * x1[2] + x1[3] * x1[3]);
                    ssq[ai][m] = (bj == 0) ? q : ssq[ai][m] + q;
                    asm volatile("" : "+v"(acc[ai][bj][m][0]), "+v"(acc[ai][bj][m][1]), "+v"(ssq[ai][m]));
                    if (m & 1) asm volatile("" ::: "memory"); }
        }
#pragma unroll
        for (int ai = 0; ai < 2; ++ai)
#pragma unroll
            for (int m = 0; m < 4; ++m) { float q = ssq[ai][m]; q += shx(q, 16, ln); q += shx(q, 32, ln);
                if (fq == 0) __hip_atomic_store(SS + (size_t)(row0 + ai * HALF + m * 16) * 16 + u.pn * 4 + wc, q, __ATOMIC_RELAXED, __HIP_MEMORY_SCOPE_AGENT); }
        asm volatile("s_waitcnt vmcnt(0)" ::: "memory");
        PG8_GAS unsigned* c = cnt + 64 * u.pm;
        if (ln == 0) (void)__hip_atomic_fetch_add(c, 1u, __ATOMIC_RELAXED, __HIP_MEMORY_SCOPE_AGENT);
        for (unsigned sp = 0; sp < (1u << 22); ++sp) { if ((unsigned)__builtin_amdgcn_readfirstlane((int)__hip_atomic_load(c, __ATOMIC_RELAXED, __HIP_MEMORY_SCOPE_AGENT)) >= 32u) break; __builtin_amdgcn_s_sleep(2); }
        int row1 = row0, colc = colb; asm volatile("" : "+v"(row1), "+v"(colc));
        float rs[2][4];
#pragma unroll
        for (int ai = 0; ai < 2; ++ai)
#pragma unroll
            for (int m = 0; m < 4; ++m) { const PG8_GAS float* sp4 = SS + (size_t)(row1 + ai * HALF + m * 16) * 16 + 4 * fq;
                float t = (__hip_atomic_load(sp4, __ATOMIC_RELAXED, __HIP_MEMORY_SCOPE_AGENT) + __hip_atomic_load(sp4 + 1, __ATOMIC_RELAXED, __HIP_MEMORY_SCOPE_AGENT))
                        + (__hip_atomic_load(sp4 + 2, __ATOMIC_RELAXED, __HIP_MEMORY_SCOPE_AGENT) + __hip_atomic_load(sp4 + 3, __ATOMIC_RELAXED, __HIP_MEMORY_SCOPE_AGENT));
                t += shx(t, 16, ln); t += shx(t, 32, ln); rs[ai][m] = rsqrtf(t * (1.0f / 1024.0f) + EPS_); }
#pragma unroll
        for (int bj = 0; bj < 2; ++bj) {
            const f32x4 g0 = *(const PG8_GAS f32x4*)(gfin + colc + bj * HALF), g1 = *(const PG8_GAS f32x4*)(gfin + colc + bj * HALF + 4);
#pragma unroll
            for (int ai = 0; ai < 2; ++ai)
#pragma unroll
                for (int m = 0; m < 4; ++m) { const size_t off = (size_t)(row1 + ai * HALF + m * 16) * 1024 + colc + bj * HALF;
                    *(PG8_GAS f32x4*)(OUT + off) = acc[ai][bj][m][0] * rs[ai][m] * g0; *(PG8_GAS f32x4*)(OUT + off + 4) = acc[ai][bj][m][1] * rs[ai][m] * g1; }
        }
    }
};

struct EpiUp {
    static constexpr bool PERM = true;
    const PG8_GAS float* SS; const PG8_GAS float* bias; PG8_GAS bf16_t* O; int ldc;
    __device__ __forceinline__ void operator()(f32x4 (&acc)[2][2][4][2], const Unit& u, int wr, int wc, int fr, int fq) const {
        const int b = u.pm >> 5, colb = u.pn * BM + wc * 32 + 8 * fq, row0 = u.pm * BM + wr * 64 + fr;
        float rs[2][4];
#pragma unroll
        for (int ai = 0; ai < 2; ++ai)
#pragma unroll
            for (int m = 0; m < 4; ++m) rs[ai][m] = row_rstd(SS, row0 + ai * HALF + m * 16, fq, fr);
#pragma unroll
        for (int bj = 0; bj < 2; ++bj) {
            const f32x4 bv0 = *(const PG8_GAS f32x4*)(bias + (size_t)b * ldc + colb + bj * HALF), bv1 = *(const PG8_GAS f32x4*)(bias + (size_t)b * ldc + colb + bj * HALF + 4);
#pragma unroll
            for (int ai = 0; ai < 2; ++ai)
#pragma unroll
                for (int m = 0; m < 4; ++m) { f32x4 v0 = acc[ai][bj][m][0] * rs[ai][m] + bv0, v1 = acc[ai][bj][m][1] * rs[ai][m] + bv1;
#pragma unroll
                    for (int j = 0; j < 4; ++j) { v0[j] = fmaxf(v0[j], 0.f); v1[j] = fmaxf(v1[j], 0.f); }
                    v0 = v0 * v0; v1 = v1 * v1;
                    u32x4 w; w.x = cvt_pk_bf16(v0[0], v0[1]); w.y = cvt_pk_bf16(v0[2], v0[3]); w.z = cvt_pk_bf16(v1[0], v1[1]); w.w = cvt_pk_bf16(v1[2], v1[3]);
                    *(PG8_GAS u32x4*)(O + ((size_t)(u.pm * 16 + u.pn) * 256 + (wr * 64 + fr + ai * HALF + m * 16)) * 256 + (wc * 32 + 8 * fq + bj * HALF)) = w; }
        }
    }
};

struct EpiQKV {
    static constexpr bool PERM = true;
    const PG8_GAS float* SS; const PG8_GAS float* bias; PG8_GAS bf16_t* Q; size_t split_stride; PG8_GAS float* KMP;
    __device__ __forceinline__ void operator()(f32x4 (&acc)[2][2][4][2], const Unit& u, int wr, int wc, int fr, int fq) const {
        const int b = u.pm >> 5, t = u.pn >> 2, colt = (u.pn & 3) * BM + wc * 32 + 8 * fq, colb = u.pn * BM + wc * 32 + 8 * fq, row0 = u.pm * BM + wr * 64 + fr;
        PG8_GAS bf16_t* base = Q + (size_t)t * split_stride; const float sc = (t == 0) ? C2_ : 1.0f;
        float rs[2][4];
#pragma unroll
        for (int ai = 0; ai < 2; ++ai)
#pragma unroll
            for (int m = 0; m < 4; ++m) rs[ai][m] = row_rstd(SS, row0 + ai * HALF + m * 16, fq, fr);
#pragma unroll
        for (int bj = 0; bj < 2; ++bj) {
            const f32x4 bv0 = *(const PG8_GAS f32x4*)(bias + (size_t)b * 3072 + colb + bj * HALF), bv1 = *(const PG8_GAS f32x4*)(bias + (size_t)b * 3072 + colb + bj * HALF + 4);
            f32x4 cs0 = {0.f, 0.f, 0.f, 0.f}, cs1 = cs0;
#pragma unroll
            for (int ai = 0; ai < 2; ++ai)
#pragma unroll
                for (int m = 0; m < 4; ++m) { f32x4 v0 = acc[ai][bj][m][0] * rs[ai][m] + bv0, v1 = acc[ai][bj][m][1] * rs[ai][m] + bv1;
                    cs0 += v0; cs1 += v1; v0 = v0 * sc; v1 = v1 * sc;
                    u32x4 w; w.x = cvt_pk_bf16(v0[0], v0[1]); w.y = cvt_pk_bf16(v0[2], v0[3]); w.z = cvt_pk_bf16(v1[0], v1[1]); w.w = cvt_pk_bf16(v1[2], v1[3]);
                    *(PG8_GAS u32x4*)(base + hm_off((size_t)(row0 + ai * HALF + m * 16), b, (colt + bj * HALF) >> 6) + ((colt + bj * HALF) & 63)) = w; }
            if (t == 1) {
#pragma unroll
                for (int o = 1; o < 16; o <<= 1) {
#pragma unroll
                    for (int j = 0; j < 4; ++j) { cs0[j] += shx(cs0[j], o, fq * 16 + fr); cs1[j] += shx(cs1[j], o, fq * 16 + fr); } }
                if (fr == 0) { PG8_GAS float* kp = KMP + ((size_t)u.pm * 2 + wr) * 1024 + colt + bj * HALF; *(f32x4*)kp = cs0; *(PG8_GAS f32x4*)(kp + 4) = cs1; }
            }
        }
    }
};

template <class Epi, class Sched, bool ALIGN_EPI>
__device__ __forceinline__ void gemm_phase(PG8_LAS unsigned char* lds, const Gemm g, const Sched& S, const Epi& E, int wave_id) {
    int tid = wave_id * 64 + lane_id(); asm volatile("" : "+v"(tid));
    const int wid = __builtin_amdgcn_readfirstlane(tid >> 6), lane = tid & 63, wr = wid >> 2, wc = wid & 3, fr = lane & 15, fq = lane >> 4;
    const int K = g.K, nt = K / BK, lda = g.lda;
    unsigned voffA[2], voffB[2];
#pragma unroll
    for (int i = 0; i < 2; ++i) { int R, C; stage_rc(tid * 16 + i * 8192, R, C); const int Rb = Epi::PERM ? ((R & ~31) + perm32(R & 31)) : R;
        voffA[i] = (unsigned)(R * lda + C) * 2u; voffB[i] = (unsigned)(Rb * K + C) * 2u; }
    const size_t kstep = (size_t)(BK * 2);
    const size_t hstepA = (size_t)HALF * lda * 2, tstepA = (g.a_tileb == 512) ? 2 * hstepA : (size_t)(K / 256) * g.a_tileb, hstepB = (size_t)HALF * K * 2, tstepB = 2 * hstepB;
    const size_t tileb = (size_t)g.a_tileb;
#define PG8_KOFF(t) ((size_t)((t) >> 2) * tileb + (size_t)((t) & 3) * 128)
    const unsigned ldsw = (unsigned)wid * 1024u;
    const int aoff = lds_byte(wr * 64 + fr, fq * 8), boff = lds_byte(wc * 32 + fr, fq * 8);
#define PG8_SA(b, h) (((b) * 2 + (h)) * HTB)
#define PG8_SB(b, h) ((4 + (b) * 2 + (h)) * HTB)
#define PG8_STAGE(bufoff, gbase, voff) do { _Pragma("unroll") for (int _i = 0; _i < 2; ++_i) \
        __builtin_amdgcn_global_load_lds((const PG8_GAS unsigned*)((const PG8_GAS char*)(gbase) + (voff)[_i]), (PG8_LAS unsigned*)(lds + (bufoff) + ldsw + _i * 8192), 16, 0, 0); } while (0)
#define PG8_LDA(dst, b, h) do { _Pragma("unroll") for (int m = 0; m < 4; ++m) _Pragma("unroll") for (int k = 0; k < 2; ++k) dst[m][k] = *(const PG8_LAS bf16x8*)(lds + PG8_SA(b, h) + aoff + m * 2048 + k * 1024); } while (0)
#define PG8_LDB(dst, b, h) do { _Pragma("unroll") for (int n = 0; n < 2; ++n) _Pragma("unroll") for (int k = 0; k < 2; ++k) dst[n][k] = *(const PG8_LAS bf16x8*)(lds + PG8_SB(b, h) + boff + n * 2048 + k * 1024); } while (0)
#define PG8_MMA(ai, bj, At, Bt) do { __builtin_amdgcn_s_setprio(1); _Pragma("unroll") for (int m = 0; m < 4; ++m) _Pragma("unroll") for (int n = 0; n < 2; ++n) _Pragma("unroll") for (int k = 0; k < 2; ++k) \
        acc[ai][bj][m][n] = __builtin_amdgcn_mfma_f32_16x16x32_bf16(Bt[n][k], At[m][k], acc[ai][bj][m][n], 0, 0, 0); __builtin_amdgcn_s_setprio(0); } while (0)
#define PG8_WAIT_V(n) asm volatile("s_waitcnt vmcnt(" #n ")" ::: "memory")
#define PG8_WAIT_L(n) asm volatile("s_waitcnt lgkmcnt(" #n ")" ::: "memory")
#define PG8_BAR __builtin_amdgcn_s_barrier()
#define PG8_SCHED __builtin_amdgcn_sched_barrier(0)
    Unit cur, nxt; int ui = 0;
    if (!S.next(0, cur)) return;
    f32x4 acc[2][2][4][2];
#pragma unroll
    for (int a = 0; a < 2; ++a)
#pragma unroll
        for (int b = 0; b < 2; ++b)
#pragma unroll
            for (int m = 0; m < 4; ++m)
#pragma unroll
                for (int n = 0; n < 2; ++n) acc[a][b][m][n] = (f32x4){0.f, 0.f, 0.f, 0.f};
    bf16x8 At[4][2], B0[2][2], B1[2][2];
    const PG8_GAS char* cA = (const PG8_GAS char*)g.A + (size_t)cur.pm * tstepA + (size_t)cur.pn * g.a_pn_off * 2; const PG8_GAS char* cB = (const PG8_GAS char*)g.Bt + (size_t)cur.pn * tstepB;
    PG8_STAGE(PG8_SB(0, 0), cB, voffB); PG8_STAGE(PG8_SB(0, 1), cB + hstepB, voffB); PG8_STAGE(PG8_SA(0, 0), cA, voffA); PG8_STAGE(PG8_SA(0, 1), cA + hstepA, voffA);
    if (wr == 1) PG8_BAR;
    PG8_WAIT_V(2); PG8_BAR;
    PG8_STAGE(PG8_SB(1, 0), cB + kstep, voffB); PG8_STAGE(PG8_SA(1, 0), cA + kstep, voffA); PG8_STAGE(PG8_SB(1, 1), cB + hstepB + kstep, voffB);
    PG8_WAIT_V(6); PG8_BAR;
    for (;;) {
        const bool has_next = S.next(ui + 1, nxt);
        const PG8_GAS char* nA = has_next ? (const PG8_GAS char*)g.A + (size_t)nxt.pm * tstepA + (size_t)nxt.pn * g.a_pn_off * 2 : cA; const PG8_GAS char* nB = has_next ? (const PG8_GAS char*)g.Bt + (size_t)nxt.pn * tstepB : cB;
        for (int t = 0; t < nt; t += 2) {
            const bool last = (t == nt - 2);
            const PG8_GAS char* a1 = cA + PG8_KOFF(t + 1);
            const PG8_GAS char* a2 = last ? nA : cA + PG8_KOFF(t + 2); const PG8_GAS char* b2 = last ? nB : cB + (size_t)(t + 2) * kstep;
            const PG8_GAS char* a3 = a2 + kstep; const PG8_GAS char* b3 = b2 + kstep;
            PG8_LDB(B0, 0, 0); PG8_LDB(B1, 0, 1); PG8_SCHED; PG8_LDA(At, 0, 0); PG8_STAGE(PG8_SA(1, 1), a1 + hstepA, voffA);
            PG8_WAIT_V(8); PG8_WAIT_L(0); PG8_BAR; PG8_MMA(0, 0, At, B0); PG8_MMA(0, 1, At, B1); PG8_BAR; PG8_SCHED;
            PG8_LDA(At, 0, 1); PG8_STAGE(PG8_SB(0, 0), b2, voffB); PG8_STAGE(PG8_SB(0, 1), b2 + hstepB, voffB); PG8_STAGE(PG8_SA(0, 0), a2, voffA);
            PG8_WAIT_V(8); PG8_WAIT_L(0); PG8_BAR; PG8_MMA(1, 0, At, B0); PG8_MMA(1, 1, At, B1); PG8_BAR; PG8_SCHED;
            PG8_LDB(B0, 1, 0); PG8_LDB(B1, 1, 1); PG8_SCHED; PG8_LDA(At, 1, 0); PG8_STAGE(PG8_SA(0, 1), a2 + hstepA, voffA);
            PG8_WAIT_V(8); PG8_WAIT_L(0); PG8_BAR; PG8_MMA(0, 0, At, B0); PG8_MMA(0, 1, At, B1); PG8_BAR; PG8_SCHED;
            PG8_LDA(At, 1, 1); PG8_STAGE(PG8_SB(1, 0), b3, voffB); PG8_STAGE(PG8_SB(1, 1), b3 + hstepB, voffB); PG8_STAGE(PG8_SA(1, 0), a3, voffA);
            PG8_WAIT_V(8); PG8_WAIT_L(0); PG8_BAR; PG8_MMA(1, 0, At, B0); PG8_MMA(1, 1, At, B1); PG8_BAR; PG8_SCHED;
        }
        if constexpr (ALIGN_EPI) { if (wr == 0) PG8_BAR; }
        E(acc, cur, wr, wc, fr, fq);
        if (!has_next) break;
#pragma unroll
        for (int a = 0; a < 2; ++a)
#pragma unroll
            for (int b = 0; b < 2; ++b)
#pragma unroll
                for (int m = 0; m < 4; ++m)
#pragma unroll
                    for (int n = 0; n < 2; ++n) acc[a][b][m][n] = (f32x4){0.f, 0.f, 0.f, 0.f};
        cur = nxt; cA = nA; cB = nB; ++ui;
        if constexpr (ALIGN_EPI) { if (wr == 1) PG8_BAR; }
    }
    PG8_WAIT_V(0);
    if constexpr (!ALIGN_EPI) { if (wr == 0) PG8_BAR; }
    PG8_BAR;
#undef PG8_KOFF
#undef PG8_SA
#undef PG8_SB
#undef PG8_STAGE
#undef PG8_LDA
#undef PG8_LDB
#undef PG8_MMA
#undef PG8_WAIT_V
#undef PG8_WAIT_L
#undef PG8_BAR
#undef PG8_SCHED
}
}

constexpr int NWAVES = 8;
constexpr int BATCH = 4, SEQ = 8192, D = 1024, NH = 16, HD = 64, FF = 4096, M = BATCH * SEQ, NQKV = 3 * D, NBLK = 32, BLK = 256;
constexpr float EPS = 1e-6f;
constexpr float LOG2E = 1.4426950408889634f;

constexpr size_t MiB = 1u << 20;
constexpr size_t WS_CTL = 0, CTL_ZERO_BYTES = 1 * MiB;
constexpr size_t WS_MOD = 1 * MiB;
constexpr size_t WS_BIAS_UP0 = WS_MOD + 256 * 1024;
constexpr size_t WS_BIAS_QKV = WS_BIAS_UP0 + 64 * 1024;
constexpr size_t WS_BIAS_UP1 = WS_BIAS_QKV + 64 * 1024;
constexpr size_t WS_KMP = 2 * MiB;
constexpr size_t WS_SS = 3 * MiB;
constexpr size_t WS_WPOOL = 6 * MiB, WS_WQKV = 8 * MiB, WS_WO = 14 * MiB, WS_WUP0 = 16 * MiB, WS_WUP1 = 24 * MiB, WS_WDN0 = 32 * MiB, WS_WDN1 = 40 * MiB;
constexpr size_t WS_XNA = 48 * MiB, WS_XNB = 112 * MiB;
constexpr size_t WS_HB = 176 * MiB;
constexpr size_t WS_Q = 176 * MiB, WS_K = 240 * MiB, WS_V = 304 * MiB;
constexpr size_t WS_PL = 496 * MiB;
constexpr size_t WS_CNT = 503 * MiB;
constexpr size_t WS_KBM = 503 * MiB + 512 * 1024;
constexpr size_t WS_POB = 48 * MiB;
constexpr size_t WS_SEG = 368 * MiB;
constexpr size_t WS_XR = 432 * MiB;
constexpr size_t WS_O = 368 * MiB;
constexpr size_t WS_DUMP = 504 * MiB;
constexpr size_t WS_END = 506 * MiB;
constexpr int CW_BAR = 4096;
constexpr int CW_FIN = 24576;
constexpr int CW_TOT = 16384;

constexpr int RING_OFF = 0, RING_BYTES = 131072;
constexpr int LDSCTL_OFF = RING_BYTES, MISC_OFF = LDSCTL_OFF + 320;
constexpr int LDS_BYTES = 151552;

#define GAS __attribute__((address_space(1)))
#define LAS __attribute__((address_space(3)))
typedef unsigned short bf16;
typedef unsigned v4u __attribute__((ext_vector_type(4)));
typedef unsigned v2u __attribute__((ext_vector_type(2)));
typedef float f32x4 __attribute__((ext_vector_type(4)));
typedef GAS unsigned gu32;
#define RLX_AGENT __ATOMIC_RELAXED, __HIP_MEMORY_SCOPE_AGENT
#define LDS_WAIT() asm volatile("s_waitcnt lgkmcnt(0)" ::: "memory")
__device__ __forceinline__ unsigned f2bf(float f) { unsigned u = __builtin_bit_cast(unsigned, f); return (u + 0x7fffu + ((u >> 16) & 1u)) >> 16; }
__device__ __forceinline__ unsigned pk2(float lo, float hi) { return f2bf(lo) | (f2bf(hi) << 16); }
__device__ __forceinline__ float bf2f(unsigned short v) { return __builtin_bit_cast(float, (unsigned)v << 16); }

#define XB_TMO      128
#define XB_XCNT(j)  (256  + 64 * (j))
#define XB_XSUB(j)  (1280 + 64 * (j))
#define XB_XGEN(j)  (2304 + 64 * (j))
#define XB_TOP      3328
#define XB_TOPGEN   3392
#define XCD_BAR_WORDS 3456
#define XB_SPIN_CAP (1u << 18)
__device__ __forceinline__ unsigned xb_ld(GAS unsigned* p)              { return __hip_atomic_load(p, __ATOMIC_RELAXED, __HIP_MEMORY_SCOPE_AGENT); }
__device__ __forceinline__ unsigned xb_add(GAS unsigned* p, unsigned v) { return __hip_atomic_fetch_add(p, v, __ATOMIC_RELAXED, __HIP_MEMORY_SCOPE_AGENT); }
__device__ __forceinline__ unsigned xb_xcc_id() { return (unsigned)__builtin_amdgcn_s_getreg((3 << 11) | 20) & 0xFu; }
#define XB_SPIN(cond, bar) do { unsigned _sp = 0; while (cond) { __builtin_amdgcn_s_sleep(1); \
    if ((++_sp & 255u) == 0u) { if (xb_ld(&(bar)[XB_TMO])) break; if (_sp > XB_SPIN_CAP) { (void)xb_add(&(bar)[XB_TMO], 1u); break; } } } } while (0)
struct XcdBarrier { GAS unsigned* bar; unsigned x; volatile LAS unsigned* st; int wave; };
__device__ __forceinline__ XcdBarrier xcd_barrier_post(GAS unsigned* bar, volatile LAS unsigned* st) {
    XcdBarrier b; b.bar = bar; b.x = xb_xcc_id(); b.st = st;
    if (threadIdx.x == 0) (void)xb_add(&bar[XB_XCNT(b.x)], 1u);
    return b;
}
__device__ __forceinline__ void xcd_barrier_complete(GAS unsigned* bar, unsigned x, unsigned& nloc, unsigned& nx) {
    const unsigned G = gridDim.x * gridDim.y * gridDim.z;
    unsigned sum, cnt, mine, sp = 0u;
    for (;;) {
        sum = 0u; cnt = 0u; mine = 0u;
#pragma unroll
        for (unsigned j = 0; j < 16; ++j) { const unsigned c = xb_ld(&bar[XB_XCNT(j)]); sum += c; cnt += (c > 0u) ? 1u : 0u; mine = (j == x) ? c : mine; }
        if (sum == G) break;
        __builtin_amdgcn_s_sleep(1);
        if ((++sp & 255u) == 0u) { if (xb_ld(&bar[XB_TMO])) break; if (sp > XB_SPIN_CAP) { (void)xb_add(&bar[XB_TMO], 1u); break; } }
    }
    nloc = mine > 0u ? mine : 1u; nx = cnt > 0u ? cnt : 1u;
}
__device__ __forceinline__ void xcd_barrier(const XcdBarrier& b) {
    asm volatile("s_waitcnt vmcnt(0)" ::: "memory");
    __syncthreads();
    if (b.wave == 0 && lane_id() == 0) {
        GAS unsigned* bar = b.bar; asm volatile("" : "+s"(bar));
        const unsigned bx = xb_xcc_id();
        __builtin_amdgcn_s_waitcnt(0);
        unsigned nloc = b.st[0], nx = b.st[1];
        if (nloc == 0u) { xcd_barrier_complete(bar, bx, nloc, nx); b.st[0] = nloc; b.st[1] = nx; }
        const unsigned old = xb_add(&bar[XB_XSUB(bx)], 1u);
        const unsigned gen = old / nloc;
        if (old + 1u == (gen + 1u) * nloc) {
            __builtin_amdgcn_fence(__ATOMIC_RELEASE, "agent");
            asm volatile("s_waitcnt vmcnt(0)" ::: "memory");
            const unsigned og = xb_add(&bar[XB_TOP], 1u);
            const unsigned tg = og / nx;
            if (og + 1u == (tg + 1u) * nx) xb_add(&bar[XB_TOPGEN], 1u);
            else XB_SPIN(xb_ld(&bar[XB_TOPGEN]) == tg, bar);
            __builtin_amdgcn_fence(__ATOMIC_ACQUIRE, "agent");
            xb_add(&bar[XB_XGEN(bx)], 1u);
            asm volatile("s_waitcnt vmcnt(0)" ::: "memory");
        } else {
            XB_SPIN(xb_ld(&bar[XB_XGEN(bx)]) == gen, bar);
            __builtin_amdgcn_fence(__ATOMIC_ACQUIRE, "agent");
            asm volatile("s_waitcnt vmcnt(0)" ::: "memory");
        }
    }
    __syncthreads();
}

struct Args { const GAS float* in[14]; GAS float* out; GAS unsigned char* ws; };
struct Frame {
    LAS unsigned char* lds; int tid, lane, wave, vcu, G;
    const GAS float *x, *c, *rel_bias, *w_mod, *b_mod, *norm_mix, *norm_mlp, *w_pool, *pool_scale, *w_qkv, *w_o, *w_up, *w_down, *norm_final;
    GAS float* out; GAS unsigned char* ws;
};
__device__ __forceinline__ float wave_sum(float v) {
#pragma unroll
    for (int o = 1; o < 64; o <<= 1) v += __shfl_xor(v, o);
    return v;
}

struct TItem { const GAS float* W; GAS bf16* WT; int K, N, row_off, item; };
__device__ __forceinline__ void tload(const TItem& I, f32x4 (&t)[8], int lane) {
    const int nblk = I.N / 32, kb = I.item / nblk, nb = I.item % nblk, k0 = 64 * kb, n0 = 32 * nb;
#pragma unroll
    for (int i = 0; i < 8; ++i) t[i] = *(const GAS f32x4*)(I.W + (size_t)(k0 + 8 * i + (lane >> 3)) * I.N + n0 + 4 * (lane & 7));
}
__device__ __forceinline__ void tstore(const TItem& I, const f32x4 (&t)[8], LAS float* scr, int lane) {
    const int nblk = I.N / 32, kb = I.item / nblk, nb = I.item % nblk, k0 = 64 * kb, n0 = 32 * nb;
#pragma unroll
    for (int i = 0; i < 8; ++i) { LAS float* d = scr + (8 * i + (lane >> 3)) * 33 + 4 * (lane & 7); d[0] = t[i][0]; d[1] = t[i][1]; d[2] = t[i][2]; d[3] = t[i][3]; }
    LDS_WAIT(); asm volatile("" ::: "memory");
    const int c = lane & 7;
#pragma unroll
    for (int j = 0; j < 4; ++j) { const int n = (lane >> 3) + 8 * j; const LAS float* s = scr + (8 * c) * 33 + n;
        v4u o; o.x = pk2(s[0 * 33], s[1 * 33]); o.y = pk2(s[2 * 33], s[3 * 33]); o.z = pk2(s[4 * 33], s[5 * 33]); o.w = pk2(s[6 * 33], s[7 * 33]);
        *(GAS v4u*)(I.WT + (size_t)(I.row_off + n0 + n) * I.K + k0 + 8 * c) = o; }
    LDS_WAIT(); asm volatile("" ::: "memory");
}
__device__ __forceinline__ void p0_prologue(Frame& F) {
    if (F.vcu < 192) {
        LAS float* cact = (LAS float*)(F.lds + 67584);
        LAS float* red = (LAS float*)(F.lds + 67584 + 16384);
        const int l = F.vcu / 96, j0 = (F.vcu % 96) * 64;
        for (int i = F.tid; i < 4096; i += NWAVES * 64) { const float v = F.c[i]; cact[i] = v / (1.f + __expf(-v)); }
        __syncthreads();
        const int sub = F.lane >> 4, c4 = F.lane & 15;
        f32x4 a0 = {0.f, 0.f, 0.f, 0.f}, a1 = a0, a2 = a0, a3 = a0;
        const GAS float* wb = F.w_mod + (size_t)l * 1024 * 6144 + j0 + 4 * c4;
#pragma unroll 4
        for (int it = 0; it < 32; ++it) { const int k = 32 * it + 4 * F.wave + sub; const f32x4 wv = *(const GAS f32x4*)(wb + (size_t)k * 6144);
            a0 += wv * cact[k]; a1 += wv * cact[1024 + k]; a2 += wv * cact[2048 + k]; a3 += wv * cact[3072 + k]; }
#pragma unroll
        for (int j = 0; j < 4; ++j) { a0[j] += __shfl_xor(a0[j], 16); a0[j] += __shfl_xor(a0[j], 32); a1[j] += __shfl_xor(a1[j], 16); a1[j] += __shfl_xor(a1[j], 32);
            a2[j] += __shfl_xor(a2[j], 16); a2[j] += __shfl_xor(a2[j], 32); a3[j] += __shfl_xor(a3[j], 16); a3[j] += __shfl_xor(a3[j], 32); }
        if (sub == 0) { LAS f32x4* r4 = (LAS f32x4*)(red + F.wave * 256); r4[0 * 16 + c4] = a0; r4[1 * 16 + c4] = a1; r4[2 * 16 + c4] = a2; r4[3 * 16 + c4] = a3; }
        __syncthreads();
        if (F.tid < 256) { const int b = F.tid >> 6, col = F.tid & 63; float s = 0.f;
#pragma unroll
            for (int w = 0; w < 8; ++w) s += red[w * 256 + b * 64 + col];
            ((GAS float*)(F.ws + WS_MOD))[(l * 4 + b) * 6144 + j0 + col] = s + F.b_mod[l * 6144 + j0 + col]; }
    }
    LAS float* scr = (LAS float*)(F.lds + RING_OFF + F.wave * 8448);
    const int gw = F.vcu * NWAVES + F.wave, NGW = F.G * NWAVES;
    constexpr int I_POOL = 4 * 32, I_QKV = 16 * 96, I_O = 16 * 32, I_UP = 16 * 128, I_DN = 64 * 32;
    constexpr int NITEMS = I_POOL + I_QKV + I_O + 2 * I_UP + 2 * I_DN;
    auto desc = [&](int it) -> TItem {
        int r = it;
        if (r < I_POOL) { const int g = r / 32; return TItem{F.w_pool + (size_t)g * 65536, (GAS bf16*)(F.ws + WS_WPOOL), 256, 256, g * 256, r % 32}; } r -= I_POOL;
        if (r < I_QKV) return TItem{F.w_qkv, (GAS bf16*)(F.ws + WS_WQKV), D, NQKV, 0, r}; r -= I_QKV;
        if (r < I_O) return TItem{F.w_o, (GAS bf16*)(F.ws + WS_WO), D, D, 0, r}; r -= I_O;
        if (r < 2 * I_UP) { const int l = r / I_UP; return TItem{F.w_up + (size_t)l * D * FF, (GAS bf16*)(F.ws + (l ? WS_WUP1 : WS_WUP0)), D, FF, 0, r % I_UP}; } r -= 2 * I_UP;
        const int l = r / I_DN; return TItem{F.w_down + (size_t)l * FF * D, (GAS bf16*)(F.ws + (l ? WS_WDN1 : WS_WDN0)), FF, D, 0, r % I_DN};
    };
    f32x4 ta[8], tb[8];
    int it = gw;
    if (it < NITEMS) { TItem cur = desc(it); tload(cur, ta, F.lane);
        for (;;) {
            const int itn = it + NGW; const bool hn = itn < NITEMS; TItem nxt = cur;
            if (hn) { nxt = desc(itn); tload(nxt, tb, F.lane); }
            tstore(cur, ta, scr, F.lane);
            if (!hn) break;
#pragma unroll
            for (int i = 0; i < 8; ++i) ta[i] = tb[i];
            cur = nxt; it = itn;
        } }
}

__device__ __forceinline__ void p1_bias(Frame& F) {
    const int gw = F.vcu * NWAVES + F.wave, NGW = F.G * NWAVES;
    const GAS float* MOD = (const GAS float*)(F.ws + WS_MOD);
    for (int it = gw; it < 4096 + 3072 + 4096; it += NGW) {
        const GAS bf16* wt; const GAS float* sh; GAS float* dst; int n, N;
        if (it < 4096) { n = it; N = 4096; wt = (const GAS bf16*)(F.ws + WS_WUP0); sh = MOD + 3072; dst = (GAS float*)(F.ws + WS_BIAS_UP0); }
        else if (it < 4096 + 3072) { n = it - 4096; N = 3072; wt = (const GAS bf16*)(F.ws + WS_WQKV); sh = MOD + 4 * 6144; dst = (GAS float*)(F.ws + WS_BIAS_QKV); }
        else { n = it - 7168; N = 4096; wt = (const GAS bf16*)(F.ws + WS_WUP1); sh = MOD + 4 * 6144 + 3072; dst = (GAS float*)(F.ws + WS_BIAS_UP1); }
        const v4u w0 = *(const GAS v4u*)(wt + (size_t)n * 1024 + F.lane * 16), w1 = *(const GAS v4u*)(wt + (size_t)n * 1024 + F.lane * 16 + 8);
        float wf[16];
#pragma unroll
        for (int j = 0; j < 4; ++j) { wf[2 * j] = __builtin_bit_cast(float, w0[j] << 16); wf[2 * j + 1] = __builtin_bit_cast(float, w0[j] & 0xffff0000u);
            wf[8 + 2 * j] = __builtin_bit_cast(float, w1[j] << 16); wf[8 + 2 * j + 1] = __builtin_bit_cast(float, w1[j] & 0xffff0000u); }
#pragma unroll
        for (int b = 0; b < 4; ++b) { const GAS f32x4* sp = (const GAS f32x4*)(sh + b * 6144 + F.lane * 16); float s = 0.f;
#pragma unroll
            for (int j = 0; j < 4; ++j) { const f32x4 sv = sp[j]; s += wf[4 * j] * sv[0] + wf[4 * j + 1] * sv[1] + wf[4 * j + 2] * sv[2] + wf[4 * j + 3] * sv[3]; }
            s = wave_sum(s); if (F.lane == 0) dst[b * N + n] = s; }
    }
}
__device__ __forceinline__ void p1_pool(Frame& F) {
    LAS float* ring = (LAS float*)(F.lds + RING_OFF);
    const GAS float* MOD = (const GAS float*)(F.ws + WS_MOD); GAS bf16* XN = (GAS bf16*)(F.ws + WS_XNA); GAS bf16* XR = (GAS bf16*)(F.ws + WS_XR);
    for (int run = F.vcu; run < M / 128; run += F.G) {
        const int t0 = run * 128, s0 = t0 % SEQ, b = t0 / SEQ;
        f32x4 gam[4];
#pragma unroll
        for (int j = 0; j < 4; ++j) gam[j] = *(const GAS f32x4*)(F.norm_mix + 4 * (F.lane + 64 * j));
        const int c4 = F.tid & 255, rh = F.tid >> 8, gi = c4 >> 6, w = 2 << gi;
        const f32x4 sc1 = *(const GAS f32x4*)(MOD + b * 6144 + 1024 + 4 * c4) + 1.0f;
        f32x4 v[2][4];
        const GAS float* xb = F.x + (size_t)b * SEQ * D + 4 * F.lane;
        int st = (s0 > 0 ? -1 : 0);
#pragma unroll
        for (int rr = 0; rr < 2; ++rr)
#pragma unroll
            for (int j = 0; j < 4; ++j) v[rr][j] = *(const GAS f32x4*)(xb + (size_t)(s0 + 16 * st + 2 * F.wave + rr) * D + 256 * j);
        for (; st < 8; ++st) {
            if (st >= 0) {
#pragma unroll
                for (int rr = 0; rr < 2; ++rr)
#pragma unroll
                    for (int j = 0; j < 4; ++j) { v2u o2; o2.x = pk2(v[rr][j][0], v[rr][j][1]); o2.y = pk2(v[rr][j][2], v[rr][j][3]);
                        { const size_t trow = (size_t)b * SEQ + s0 + 16 * st + 2 * F.wave + rr; *(GAS v2u*)(XR + (((trow >> 8) * 4 + j) * 256 + (trow & 255)) * 256 + 4 * F.lane) = o2; } } }
            float ss0 = 0.f, ss1 = 0.f;
#pragma unroll
            for (int j = 0; j < 4; ++j) { ss0 += (v[0][j][0] * v[0][j][0] + v[0][j][1] * v[0][j][1]) + (v[0][j][2] * v[0][j][2] + v[0][j][3] * v[0][j][3]);
                ss1 += (v[1][j][0] * v[1][j][0] + v[1][j][1] * v[1][j][1]) + (v[1][j][2] * v[1][j][2] + v[1][j][3] * v[1][j][3]); }
#pragma unroll
            for (int o = 1; o < 64; o <<= 1) { ss0 += __shfl_xor(ss0, o); ss1 += __shfl_xor(ss1, o); }
            const float rs0 = rsqrtf(ss0 * (1.0f / D) + EPS), rs1 = rsqrtf(ss1 * (1.0f / D) + EPS);
            { const int sr = s0 + 16 * st + 2 * F.wave;
#pragma unroll
              for (int j = 0; j < 4; ++j) { *(LAS f32x4*)(ring + (sr & 31) * 1024 + 4 * (F.lane + 64 * j)) = v[0][j] * rs0 * gam[j]; *(LAS f32x4*)(ring + ((sr + 1) & 31) * 1024 + 4 * (F.lane + 64 * j)) = v[1][j] * rs1 * gam[j]; } }
            if (st + 1 < 8) {
#pragma unroll
                for (int rr = 0; rr < 2; ++rr)
#pragma unroll
                    for (int j = 0; j < 4; ++j) v[rr][j] = *(const GAS f32x4*)(xb + (size_t)(s0 + 16 * (st + 1) + 2 * F.wave + rr) * D + 256 * j); }
            __syncthreads();
            if (st >= 0) {
                const int sA = s0 + 16 * st + 8 * rh;
                f32x4 sum = {0.f, 0.f, 0.f, 0.f};
                { const int cnt0 = (sA < w) ? sA : w; for (int i = 1; i <= cnt0; ++i) sum += *(const LAS f32x4*)(ring + ((sA - i) & 31) * 1024 + 4 * c4); }
#pragma unroll
                for (int r = 0; r < 8; ++r) { const int s = sA + r; const f32x4 cur = *(const LAS f32x4*)(ring + (s & 31) * 1024 + 4 * c4);
                    sum += cur; if (s >= w) sum -= *(const LAS f32x4*)(ring + ((s - w) & 31) * 1024 + 4 * c4);
                    const float inv = 1.0f / (float)((s + 1 < w) ? s + 1 : w);
                    const f32x4 p = (sum * inv - cur) * sc1;
                    v2u o; o.x = pk2(p[0], p[1]); o.y = pk2(p[2], p[3]);
                    *(GAS v2u*)(XN + ((size_t)b * SEQ + s) * D + 4 * c4) = o; }
            }
            __syncthreads();
        }
    }
}

__device__ __forceinline__ int t5_bucket(int dist) {
    if (dist < 16) return dist;
    int b = 16;
    b += (dist >= 21); b += (dist >= 27); b += (dist >= 35); b += (dist >= 46); b += (dist >= 59); b += (dist >= 77); b += (dist >= 99); b += (dist >= 128);
    b += (dist >= 166); b += (dist >= 216); b += (dist >= 280); b += (dist >= 363); b += (dist >= 470); b += (dist >= 609); b += (dist >= 790);
    return b;
}
namespace att {
typedef short bf16x8 __attribute__((ext_vector_type(8)));
typedef short s16x4 __attribute__((ext_vector_type(4)));
typedef short v4i16_t __attribute__((ext_vector_type(4)));
typedef float f32x16 __attribute__((ext_vector_type(16)));
typedef float f32x2_t __attribute__((ext_vector_type(2)));
typedef __bf16 bf16x2_t __attribute__((ext_vector_type(2)));
typedef LAS const char* lds_cptr;
constexpr int L_K = 0, L_V = 32768, L_LUT = 132096, L_QI = 141312, L_CUM = 142336, L_PRE = 142592;
constexpr int LUTN = 2304;
__device__ __forceinline__ int crow(int r, int hi) { return (r & 3) + 8 * (r >> 2) + 4 * hi; }
__device__ __forceinline__ unsigned cvtpk(float lo, float hi) { f32x2_t v = {lo, hi}; bf16x2_t b = __builtin_convertvector(v, bf16x2_t); return __builtin_bit_cast(unsigned, b); }
__device__ __forceinline__ s16x4 vtr(lds_cptr p) { return __builtin_bit_cast(s16x4, __builtin_amdgcn_ds_read_tr16_b64_v4i16((LAS v4i16_t*)p)); }
__device__ __forceinline__ float swap_add(float v) { auto rr = __builtin_amdgcn_permlane32_swap(__float_as_uint(v), __float_as_uint(v), false, false); return __uint_as_float(rr[0]) + __uint_as_float(rr[1]); }

__device__ __forceinline__ void load_kv(LAS unsigned char* lds, const GAS bf16* Kb, const GAS bf16* Vb, int b, int h, int n, int w, int lane) {
#pragma unroll
    for (int t = 0; t < 4; ++t) {
        const size_t kr = (size_t)b * SEQ + n * BLK + 64 * t + lane, vr = (size_t)b * SEQ + n * BLK + 64 * t + 16 * (w & 3) + (lane >> 2);
        const v4u kv = *(const GAS v4u*)(Kb + hm_off(kr, b, h) + w * 8);
        const v4u vv = *(const GAS v4u*)(Vb + hm_off(vr, b, h) + (w >> 2) * 32 + (lane & 3) * 8);
        *(LAS v4u*)(lds + L_K + t * 8192 + w * 1024 + lane * 16) = kv;
        *(LAS v4u*)(lds + L_V + t * 8192 + w * 1024 + lane * 16) = vv;
    }
}
__device__ __forceinline__ void build_lut(LAS unsigned char* lds, const GAS float* rel_bias, int h, int tid) {
    for (int i = tid; i < LUTN; i += NWAVES * 64) ((LAS float*)(lds + L_LUT))[i] = (i <= 2047) ? rel_bias[t5_bucket(2047 - i) * NH + h] * LOG2E : 0.f;
}
__device__ __forceinline__ void qk_tile(f32x16& p0, f32x16& p1, lds_cptr Kt, const bf16x8* qr, const f32x16& cinit, int r32, int hi) {
    lds_cptr kb = Kt + hi * 1024 + r32 * 16;
#pragma unroll
    for (int d0 = 0; d0 < 4; ++d0) {
        const bf16x8 b0 = *(LAS const bf16x8*)(kb + d0 * 2048), b1 = *(LAS const bf16x8*)(kb + d0 * 2048 + 512);
        if (d0 == 0) { p0 = __builtin_amdgcn_mfma_f32_32x32x16_bf16(b0, qr[0], cinit, 0, 0, 0); p1 = __builtin_amdgcn_mfma_f32_32x32x16_bf16(b1, qr[0], cinit, 0, 0, 0); }
        else { p0 = __builtin_amdgcn_mfma_f32_32x32x16_bf16(b0, qr[d0], p0, 0, 0, 0); p1 = __builtin_amdgcn_mfma_f32_32x32x16_bf16(b1, qr[d0], p1, 0, 0, 0); }
    }
}
template <bool BIAS, bool MASK>
__device__ __forceinline__ void softmax_tile(f32x16& p0, f32x16& p1, LAS const float* lutp, int jt, int qrel, int hi, float& l, v4u* pa) {
#pragma unroll
    for (int r = 0; r < 16; ++r) { const int ko = 64 * jt + (r & 3) + 8 * (r >> 2);
        if (BIAS) { p0[r] += lutp[ko]; p1[r] += lutp[ko + 32]; }
        if (MASK) { const int kv = ko + 4 * hi; if (kv > qrel) p0[r] = -INFINITY; if (kv + 32 > qrel) p1[r] = -INFINITY; }
        p0[r] = __builtin_amdgcn_exp2f(p0[r]); p1[r] = __builtin_amdgcn_exp2f(p1[r]); }
    float s = 0.f;
#pragma unroll
    for (int r = 0; r < 16; ++r) s += p0[r] + p1[r];
    l += s;
    pa[0] = (v4u){cvtpk(p0[0], p0[1]), cvtpk(p0[2], p0[3]), cvtpk(p0[4], p0[5]), cvtpk(p0[6], p0[7])};
    pa[1] = (v4u){cvtpk(p0[8], p0[9]), cvtpk(p0[10], p0[11]), cvtpk(p0[12], p0[13]), cvtpk(p0[14], p0[15])};
    pa[2] = (v4u){cvtpk(p1[0], p1[1]), cvtpk(p1[2], p1[3]), cvtpk(p1[4], p1[5]), cvtpk(p1[6], p1[7])};
    pa[3] = (v4u){cvtpk(p1[8], p1[9]), cvtpk(p1[10], p1[11]), cvtpk(p1[12], p1[13]), cvtpk(p1[14], p1[15])};
}
__device__ __forceinline__ void pv_tile(f32x16* o, lds_cptr vp, const v4u* pa) {
#pragma unroll
    for (int d0 = 0; d0 < 2; ++d0)
#pragma unroll
        for (int ks = 0; ks < 4; ++ks) { const s16x4 lo = vtr(vp + d0 * 4096 + ks * 1024), hi = vtr(vp + d0 * 4096 + ks * 1024 + 512);
            const bf16x8 vf = (bf16x8){lo[0], lo[1], lo[2], lo[3], hi[0], hi[1], hi[2], hi[3]};
            o[d0] = __builtin_amdgcn_mfma_f32_32x32x16_bf16(vf, __builtin_bit_cast(bf16x8, pa[ks]), o[d0], 0, 0, 0); }
}
__device__ __forceinline__ void load_q_raw(bf16x8* qr, const GAS bf16* Qb, size_t qrow, int b, int h, int hi) {
#pragma unroll
    for (int d0 = 0; d0 < 4; ++d0) { const v4u v = *(const GAS v4u*)(Qb + hm_off(qrow, b, h) + d0 * 16 + hi * 8); qr[d0] = __builtin_bit_cast(bf16x8, v); }
}
__device__ __forceinline__ float q_norm2(const bf16x8* qr) {
    float q2 = 0.f;
#pragma unroll
    for (int d0 = 0; d0 < 4; ++d0) { const v4u v = __builtin_bit_cast(v4u, qr[d0]);
#pragma unroll
        for (int j = 0; j < 4; ++j) { const float a = __builtin_bit_cast(float, v[j] << 16), c = __builtin_bit_cast(float, v[j] & 0xffff0000u); q2 += a * a + c * c; } }
    return swap_add(q2);
}

__device__ __forceinline__ float ref_exponent(float q2, float kmax2, float bmax) { return __builtin_sqrtf(q2 * kmax2) * 1.002f + bmax + 0.01f; }
__device__ __forceinline__ void head_bounds(const GAS float* KBM, const GAS float* rel_bias, int bh, int h, int lane, float& kmax2, float& bmax) {
    float k = KBM[bh * 32 + (lane & 31)], bb = rel_bias[(lane & 31) * NH + h] * LOG2E;
#pragma unroll
    for (int o = 1; o < 32; o <<= 1) { k = fmaxf(k, shx(k, o, lane)); bb = fmaxf(bb, shx(bb, o, lane)); }
    kmax2 = k; bmax = bb;
}
__device__ __forceinline__ void store_row(GAS bf16* rowp, const f32x16* o, float scale, int hi, bool act) {
    unsigned w0[8], w1[8];
#pragma unroll
    for (int k = 0; k < 4; ++k) { w0[2 * k] = cvtpk(o[0][4 * k] * scale, o[0][4 * k + 1] * scale); w0[2 * k + 1] = cvtpk(o[0][4 * k + 2] * scale, o[0][4 * k + 3] * scale);
        w1[2 * k] = cvtpk(o[1][4 * k] * scale, o[1][4 * k + 1] * scale); w1[2 * k + 1] = cvtpk(o[1][4 * k + 2] * scale, o[1][4 * k + 3] * scale); }
#pragma unroll
    for (int i = 0; i < 8; ++i) { auto r = __builtin_amdgcn_permlane32_swap(w0[i], w1[i], false, false); w0[i] = r[0]; w1[i] = r[1]; }
    if (act) {
#pragma unroll
        for (int k = 0; k < 4; ++k) *(GAS v4u*)(rowp + 32 * hi + 8 * k) = (v4u){w0[2 * k], w0[2 * k + 1], w1[2 * k], w1[2 * k + 1]}; }
}
__device__ __forceinline__ void add_row(f32x16* o, const GAS bf16* rowp, int hi) {
    v4u v[4];
#pragma unroll
    for (int k = 0; k < 4; ++k) v[k] = *(const GAS v4u*)(rowp + 32 * hi + 8 * k);
#pragma unroll
    for (int k = 0; k < 4; ++k) { auto r0 = __builtin_amdgcn_permlane32_swap(v[k][0], v[k][2], false, false); auto r1 = __builtin_amdgcn_permlane32_swap(v[k][1], v[k][3], false, false);
        o[0][4 * k] += __builtin_bit_cast(float, r0[0] << 16); o[0][4 * k + 1] += __builtin_bit_cast(float, r0[0] & 0xffff0000u);
        o[0][4 * k + 2] += __builtin_bit_cast(float, r1[0] << 16); o[0][4 * k + 3] += __builtin_bit_cast(float, r1[0] & 0xffff0000u);
        o[1][4 * k] += __builtin_bit_cast(float, r0[1] << 16); o[1][4 * k + 1] += __builtin_bit_cast(float, r0[1] & 0xffff0000u);
        o[1][4 * k + 2] += __builtin_bit_cast(float, r1[1] << 16); o[1][4 * k + 3] += __builtin_bit_cast(float, r1[1] & 0xffff0000u); }
}
__device__ __forceinline__ GAS bf16* po_row(GAS unsigned char* ws, GAS float* outbuf, int b, int h, int t, int slot) {
    return (b < 2 ? (GAS bf16*)outbuf : (GAS bf16*)(ws + WS_POB)) + ((((size_t)((b & 1) * 16 + h) * SEQ + t) * 3 + slot) * 64);
}

__device__ __forceinline__ void route(Frame& F) {
    GAS unsigned char* ws = F.ws;
    const GAS bf16* Qb = (const GAS bf16*)(ws + WS_Q); const GAS bf16* Kb = (const GAS bf16*)(ws + WS_K);
    const GAS float* KMP = (const GAS float*)(ws + WS_KMP);
    GAS unsigned short* SEG = (GAS unsigned short*)(ws + WS_SEG); GAS unsigned* CNT = (GAS unsigned*)(ws + WS_CNT); GAS unsigned* TOT = (GAS unsigned*)(ws + WS_CTL) + CW_TOT;
    GAS float* KBM = (GAS float*)(ws + WS_KBM);
    int tid = F.wave * 64 + lane_id(); asm volatile("" : "+v"(tid));
    const int hf = tid >> 8, t = tid & 255, lane = tid & 63, w4 = (tid >> 6) & 3;
    LAS float* kms = (LAS float*)(F.lds + hf * 16384);
    LAS unsigned* cntw = (LAS unsigned*)(F.lds + hf * 16384 + 8192);
    LAS float* kbw = (LAS float*)(F.lds + hf * 16384 + 8192 + 512);
    for (int it = 0; it < 4; ++it) {
        const int id = it * 512 + F.vcu * 2 + hf, own = id >> 6, bh = id & 63, b = bh >> 4, h = bh & 15;
        __syncthreads();
        for (int i = t; i < NBLK * 64; i += 256) { const int n = i >> 6, d = i & 63; const size_t o = ((size_t)(b * 32 + n) * 2) * 1024 + h * 64 + d; kms[i] = (KMP[o] + KMP[o + 1024]) * (1.0f / 256.0f); }
        const size_t row = (size_t)b * SEQ + own * BLK + t;
        float q[64];
        { const GAS v4u* qp = (const GAS v4u*)(Qb + hm_off(row, b, h));
#pragma unroll
          for (int i = 0; i < 8; ++i) { const v4u v = qp[i];
#pragma unroll
              for (int j = 0; j < 4; ++j) { q[8 * i + 2 * j] = __builtin_bit_cast(float, v[j] << 16); q[8 * i + 2 * j + 1] = __builtin_bit_cast(float, v[j] & 0xffff0000u); } } }
        { const GAS v4u* kp = (const GAS v4u*)(Kb + hm_off(row, b, h)); float k2 = 0.f;
#pragma unroll
          for (int i = 0; i < 8; ++i) { const v4u v = kp[i];
#pragma unroll
              for (int j = 0; j < 4; ++j) { const float a = __builtin_bit_cast(float, v[j] << 16), c = __builtin_bit_cast(float, v[j] & 0xffff0000u); k2 += a * a + c * c; } }
#pragma unroll
          for (int o = 1; o < 64; o <<= 1) k2 = fmaxf(k2, shx(k2, o, lane));
          if (lane == 0) kbw[w4] = k2; }
        __syncthreads();
        float g1 = -INFINITY, g2 = -INFINITY, g3 = -INFINITY; int i1 = -1, i2 = -1, i3 = -1;
        for (int n = 0; n < own; ++n) {
            float g = 0.f;
#pragma unroll
            for (int d4 = 0; d4 < 16; ++d4) { const f32x4 kv = *(const LAS f32x4*)(kms + n * 64 + 4 * d4); g += q[4 * d4] * kv[0] + q[4 * d4 + 1] * kv[1] + q[4 * d4 + 2] * kv[2] + q[4 * d4 + 3] * kv[3]; }
            if (g > g1) { g3 = g2; i3 = i2; g2 = g1; i2 = i1; g1 = g; i1 = n; }
            else if (g > g2) { g3 = g2; i3 = i2; g2 = g; i2 = n; }
            else if (g > g3) { g3 = g; i3 = n; }
        }
        for (int n = 0; n < own; ++n) { const unsigned long long mm = __ballot(i1 == n || i2 == n || i3 == n); if (lane == 0) cntw[w4 * 32 + n] = (unsigned)__popcll(mm); }
        __syncthreads();
        for (int n = 0; n < own; ++n) { const bool has = (i1 == n || i2 == n || i3 == n); const unsigned long long mm = __ballot(has);
            if (has) { unsigned base = 0; for (int w = 0; w < w4; ++w) base += cntw[w * 32 + n];
                const unsigned rank = (unsigned)__popcll(mm & ((1ull << lane) - 1ull)); const unsigned slot = (i1 == n) ? 0u : (i2 == n) ? 1u : 2u;
                SEG[(((size_t)bh * 32 + own) * 32 + n) * 256 + base + rank] = (unsigned short)(t | (slot << 8)); } }
        if (t < own) { const unsigned c = cntw[t] + cntw[32 + t] + cntw[64 + t] + cntw[96 + t]; CNT[((size_t)bh * 32 + own) * 32 + t] = c; (void)__hip_atomic_fetch_add(TOT + bh * 31 + t, c, RLX_AGENT); }
        if (t == 0) KBM[bh * 32 + own] = fmaxf(fmaxf(kbw[0], kbw[1]), fmaxf(kbw[2], kbw[3]));
    }
    __syncthreads();
}

struct GTile { unsigned info; bf16x8 qr[4]; };
struct GRun { int e, c0, c1; };
__device__ __forceinline__ void dma_kv(LAS unsigned char* kv, const GAS bf16* Kb, const GAS bf16* Vb, int b, int h, int n, int w, int lane) {
#pragma unroll
    for (int t = 0; t < 4; ++t) {
        const size_t kr = (size_t)b * SEQ + n * BLK + 64 * t + lane, vr = (size_t)b * SEQ + n * BLK + 64 * t + 16 * (w & 3) + (lane >> 2);
        __builtin_amdgcn_global_load_lds((const GAS unsigned*)(Kb + hm_off(kr, b, h) + w * 8), (LAS unsigned*)(kv + L_K + t * 8192 + w * 1024), 16, 0, 0);
        __builtin_amdgcn_global_load_lds((const GAS unsigned*)(Vb + hm_off(vr, b, h) + (w >> 2) * 32 + (lane & 3) * 8), (LAS unsigned*)(kv + L_V + t * 8192 + w * 1024), 16, 0, 0);
    }
}
__device__ __forceinline__ void gather(Frame& F) {
    GAS unsigned char* ws = F.ws;
    const GAS bf16* Qb = (const GAS bf16*)(ws + WS_Q); const GAS bf16* Kb = (const GAS bf16*)(ws + WS_K); const GAS bf16* Vb = (const GAS bf16*)(ws + WS_V);
    const GAS unsigned short* SEG = (const GAS unsigned short*)(ws + WS_SEG); const GAS unsigned* CNT = (const GAS unsigned*)(ws + WS_CNT); const GAS unsigned* TOT = (const GAS unsigned*)(ws + WS_CTL) + CW_TOT;
    const GAS float* KBM = (const GAS float*)(ws + WS_KBM); GAS float* PL = (GAS float*)(ws + WS_PL);
    int tid = F.wave * 64 + lane_id(); asm volatile("" : "+v"(tid));
    const int lane = tid & 63, w = __builtin_amdgcn_readfirstlane(tid >> 6), r32 = lane & 31, hi = lane >> 5;
    LAS unsigned* pre = (LAS unsigned*)(F.lds + L_PRE);
    __syncthreads();
    if (w == 0) { unsigned loc = 0;
        for (int i = 0; i < 31; ++i) { const unsigned nc = (TOT[31 * lane + i] + 255u) >> 8; loc += nc + (nc ? 1u : 0u); }
        unsigned inc = loc;
#pragma unroll
        for (int o = 1; o < 64; o <<= 1) { const unsigned v = shup(inc, o, lane); if (lane >= o) inc += v; }
        unsigned run = inc - loc;
        for (int i = 0; i < 31; ++i) { pre[31 * lane + i] = run; const unsigned nc = (TOT[31 * lane + i] + 255u) >> 8; run += nc + (nc ? 1u : 0u); }
        if (lane == 63) pre[1984] = run; }
    __syncthreads();
    const int U = (int)pre[1984];
    int p = (int)(((long)F.vcu * U) / F.G); const int phi = (int)(((long)(F.vcu + 1) * U) / F.G);
    int e = 0; { int lo = 0, hi2 = 1984; while (hi2 - lo > 1) { const int mid = (lo + hi2) >> 1; if ((int)pre[mid] <= p) lo = mid; else hi2 = mid; } e = lo; }
    auto next_run = [&](GRun& R) -> bool {
        while (p < phi) {
            while (p >= (int)pre[e + 1]) ++e;
            const int k = p - (int)pre[e], nch = (int)pre[e + 1] - (int)pre[e] - 1;
            const int c0 = k > 0 ? k - 1 : 0; int c1 = phi - (int)pre[e] - 1; c1 = c1 < nch ? c1 : nch;
            p = (int)pre[e] + 1 + c1;
            if (c1 > c0) { R.e = e; R.c0 = c0; R.c1 = c1; return true; }
        }
        return false;
    };
    auto scan_cnt = [&](unsigned v) -> unsigned { unsigned inc = v;
#pragma unroll
        for (int o = 1; o < 32; o <<= 1) { const unsigned t2 = shup(inc, o, lane); if ((lane & 31) >= o) inc += t2; }
        return inc; };
    int cur_h = -1, cur_bh = -1, rb = 0; float kmax2 = 0.f, bmax = 0.f, rb31 = 0.f;
    GRun cur, nxt; bool hc = next_run(cur);
    unsigned cntN = 0, totN = 0, cumv = 0, tot = 0;
    if (hc) { const int bh = cur.e / 31, n = cur.e - bh * 31; dma_kv(F.lds, Kb, Vb, bh >> 4, bh & 15, n, w, lane);
        cntN = ((lane & 31) > n) ? CNT[((size_t)bh * 32 + (lane & 31)) * 32 + n] : 0u; totN = TOT[cur.e]; }
    GTile tcur, tnxt; unsigned ownB = 0, entB = 0xffffffffu; bool mine = false;
    auto fetch_ent = [&](int c, bool valid, int n, const GAS unsigned short* segb, unsigned cv, unsigned tt, unsigned& own_o) -> unsigned {
        const unsigned g0 = 256u * c + 32u * w, g = g0 + r32;
        const bool tile_ok = valid && g0 < tt;
        unsigned own = (unsigned)(n + 1), base = 0u;
        if (tile_ok) {
            int lo = n + 1, hi2 = 32;
            while (hi2 - lo > 1) { const int mid = (lo + hi2) >> 1; if (__builtin_amdgcn_readlane(cv, mid - 1) <= g0) lo = mid; else hi2 = mid; }
            own = (unsigned)lo; base = (lo == n + 1) ? 0u : __builtin_amdgcn_readlane(cv, lo - 1);
            for (int o = lo + 1; o < 32; ++o) { const unsigned s2 = __builtin_amdgcn_readlane(cv, o - 1); if (s2 > g0 + 31u) break; if (s2 <= g) { own = (unsigned)o; base = s2; } }
        }
        const bool lane_ok = tile_ok && g < tt;
        const unsigned idx = lane_ok ? (g - base) : 0u;
        const unsigned v = (unsigned)segb[(size_t)own * 32 * 256 + idx];
        own_o = own;
        return lane_ok ? v : 0xffffffffu;
    };
    auto make_tile = [&](unsigned ent, unsigned own, int b, int h, int n, GTile& T) {
        const bool act = ent != 0xffffffffu;
        const int tq = act ? (int)(own * BLK + (ent & 255u)) : SEQ - 1;
        T.info = (unsigned)tq | (act ? (((ent >> 8) & 3u) << 16) | (1u << 18) | ((own - n <= 4) ? (1u << 19) : 0u) : 0u);
        load_q_raw(T.qr, Qb, (size_t)b * SEQ + tq, b, h, hi);
    };
    auto start_run = [&](const GRun& R) {
        const int bh = R.e / 31, n = R.e - bh * 31; const GAS unsigned short* segb = SEG + ((size_t)bh * 32 * 32 + n) * 256;
        cumv = scan_cnt(cntN); tot = totN;
        mine = (unsigned)(256 * R.c0 + 32 * w) < tot;
        entB = 0xffffffffu; ownB = 0;
        if (mine) { unsigned ownA; const unsigned entA = fetch_ent(R.c0, true, n, segb, cumv, tot, ownA); make_tile(entA, ownA, bh >> 4, bh & 15, n, tcur);
            entB = fetch_ent(R.c0 + 1, R.c0 + 1 < R.c1, n, segb, cumv, tot, ownB); }
    };
    if (hc) start_run(cur);
    while (hc) {
        const bool hn = next_run(nxt);
        const int c0 = cur.c0, c1 = cur.c1, bh = cur.e / 31, n = cur.e - bh * 31, b = bh >> 4, h = bh & 15;
        const GAS unsigned short* segb = SEG + ((size_t)bh * 32 * 32 + n) * 256;
        LAS unsigned char* kv = F.lds + rb * 65536;
        __builtin_amdgcn_s_waitcnt(0x0F70);
        __syncthreads();
        if (hn) { const int bh2 = nxt.e / 31, n2 = nxt.e - bh2 * 31;
            cntN = ((lane & 31) > n2) ? CNT[((size_t)bh2 * 32 + (lane & 31)) * 32 + n2] : 0u; totN = TOT[nxt.e]; }
        if (bh != cur_bh) { head_bounds(KBM, F.rel_bias, bh, h, lane, kmax2, bmax); rb31 = F.rel_bias[31 * NH + h] * LOG2E; cur_bh = bh;
            if (h != cur_h) { build_lut(F.lds, F.rel_bias, h, tid); cur_h = h; __syncthreads(); } }
        const lds_cptr Kl = (lds_cptr)(kv + L_K), vp0 = (lds_cptr)(kv + L_V) + ((lane >> 4) & 1) * 32 + (lane & 3) * 8 + (4 * hi + ((lane & 15) >> 2)) * 64;
        if (mine) for (int c = c0; c < c1; ++c) {
            if ((unsigned)(256 * c + 32 * w) >= tot) break;
            make_tile(entB, ownB, b, h, n, tnxt);
            entB = fetch_ent(c + 2, c + 2 < c1, n, segb, cumv, tot, ownB);
            const unsigned info = tcur.info; const int tq = (int)(info & 0xffffu); const bool near = (info >> 19) & 1u;
            const float mref = ref_exponent(q_norm2(tcur.qr), kmax2, bmax);
            const bool anynear = __any(near);
            const int tqrel = near ? (tq - n * BLK) : 1755;
            LAS const float* lutp = (LAS const float*)(F.lds + L_LUT) + (2047 - tqrel + 4 * hi);
            f32x16 cinit; { const float cc = anynear ? -mref : (rb31 - mref);
#pragma unroll
                for (int r = 0; r < 16; ++r) cinit[r] = cc; }
            f32x16 o[2]; o[0] = f32x16{}; o[1] = f32x16{}; float l = 0.f;
            { f32x16 pA0, pA1, pB0, pB1; v4u pa[4];
              qk_tile(pA0, pA1, Kl, tcur.qr, cinit, r32, hi);
#pragma unroll
              for (int j = 0; j < 4; ++j) {
                if (j < 3) qk_tile(pB0, pB1, Kl + (j + 1) * 8192, tcur.qr, cinit, r32, hi);
                if (anynear) softmax_tile<true, false>(pA0, pA1, lutp, j, 0, hi, l, pa); else softmax_tile<false, false>(pA0, pA1, lutp, j, 0, hi, l, pa);
                pv_tile(o, vp0 + j * 8192, pa);
                pA0 = pB0; pA1 = pB1; } }
            l = swap_add(l);
            { const bool act = (info >> 18) & 1u; const int slot = (int)((info >> 16) & 3u);
              GAS bf16* dump = (GAS bf16*)(ws + WS_DUMP) + (size_t)F.vcu * 4096 + lane * 64;
              store_row(act ? po_row(ws, F.out, b, h, tq, slot) : dump - 32 * hi, o, 1.0f, hi, true);
              GAS float* plp = act ? PL + (((size_t)bh * SEQ + tq) * 3) + slot : (GAS float*)dump;
              *plp = l; }
            tcur = tnxt;
        }
        if (hn) { start_run(nxt);
            const int bh2 = nxt.e / 31, n2 = nxt.e - bh2 * 31; dma_kv(F.lds + (rb ^ 1) * 65536, Kb, Vb, bh2 >> 4, bh2 & 15, n2, w, lane); }
        cur = nxt; hc = hn; rb ^= 1;
    }
    asm volatile("s_waitcnt vmcnt(0)" ::: "memory");
    __syncthreads();
}

__device__ __forceinline__ void own_block(Frame& F) {
    GAS unsigned char* ws = F.ws;
    const GAS bf16* Qb = (const GAS bf16*)(ws + WS_Q); const GAS bf16* Kb = (const GAS bf16*)(ws + WS_K); const GAS bf16* Vb = (const GAS bf16*)(ws + WS_V); GAS bf16* Ob = (GAS bf16*)(ws + WS_O);
    const GAS float* KBM = (const GAS float*)(ws + WS_KBM); const GAS float* PL = (const GAS float*)(ws + WS_PL);
    int tid = F.wave * 64 + lane_id(); asm volatile("" : "+v"(tid));
    const int lane = tid & 63, w = __builtin_amdgcn_readfirstlane(tid >> 6), r32 = lane & 31, hi = lane >> 5;
    const int bh = F.vcu & 63, b = bh >> 4, h = bh & 15, own0 = F.vcu >> 6, nun = (NBLK - own0 + 3) / 4;
    __syncthreads();
    build_lut(F.lds, F.rel_bias, h, tid);
    float kmax2, bmax; head_bounds(KBM, F.rel_bias, bh, h, lane, kmax2, bmax);
    const int qrel = 32 * w + r32;
    LAS const float* lutp = (LAS const float*)(F.lds + L_LUT) + (2047 - qrel + 4 * hi);
    const int jd = w >> 1;
    bf16x8 qn[4];
    dma_kv(F.lds, Kb, Vb, b, h, own0, w, lane);
    load_q_raw(qn, Qb, (size_t)b * SEQ + own0 * BLK + qrel, b, h, hi);
    for (int i = 0; i < nun; ++i) {
        const int own = own0 + 4 * i; const size_t qrow = (size_t)b * SEQ + own * BLK + qrel;
        LAS unsigned char* kv = F.lds + (i & 1) * 65536;
        bf16x8 qr[4];
#pragma unroll
        for (int d0 = 0; d0 < 4; ++d0) qr[d0] = qn[d0];
        asm volatile("s_waitcnt vmcnt(0)" ::: "memory");
        __syncthreads();
        if (i + 1 < nun) { dma_kv(F.lds + ((i + 1) & 1) * 65536, Kb, Vb, b, h, own + 4, w, lane); load_q_raw(qn, Qb, qrow + 4 * BLK, b, h, hi); }
        const float mref = ref_exponent(q_norm2(qr), kmax2, bmax);
        f32x16 cinit;
#pragma unroll
        for (int r = 0; r < 16; ++r) cinit[r] = -mref;
        f32x16 o[2]; o[0] = f32x16{}; o[1] = f32x16{}; float l = 0.f;
        const lds_cptr Kl = (lds_cptr)(kv + L_K), vp0 = (lds_cptr)(kv + L_V) + ((lane >> 4) & 1) * 32 + (lane & 3) * 8 + (4 * hi + ((lane & 15) >> 2)) * 64;
        for (int j = 0; j <= jd; ++j) { f32x16 p0, p1; v4u pa[4];
            qk_tile(p0, p1, Kl + j * 8192, qr, cinit, r32, hi);
            if (j == jd) softmax_tile<true, true>(p0, p1, lutp, j, qrel, hi, l, pa); else softmax_tile<true, false>(p0, p1, lutp, j, qrel, hi, l, pa);
            pv_tile(o, vp0 + j * 8192, pa); }
        l = swap_add(l);
        const int nsl = own < 3 ? own : 3; const int tq = own * BLK + qrel;
        for (int sl = 0; sl < nsl; ++sl) { add_row(o, po_row(ws, F.out, b, h, tq, sl), hi); l += PL[(((size_t)bh * SEQ + tq) * 3) + sl]; }
        store_row(Ob + qrow * D + h * 64, o, 1.0f / l, hi, true);
    }
    asm volatile("s_waitcnt vmcnt(0)" ::: "memory");
    __syncthreads();
}
}

__device__ __forceinline__ void final_norm(Frame& Fr) {
    struct { int lane, vcu, wave, G; const GAS float* norm_final; GAS float* out; } F{Fr.wave * 64 + lane_id(), Fr.vcu, Fr.wave, Fr.G, Fr.norm_final, Fr.out};
    asm volatile("" : "+v"(F.lane)); F.lane &= 63;
    const int gw = F.vcu * NWAVES + F.wave, NGW = F.G * NWAVES;
    f32x4 gam[4];
#pragma unroll
    for (int j = 0; j < 4; ++j) gam[j] = *(const GAS f32x4*)(F.norm_final + 4 * (F.lane + 64 * j));
    for (int row = gw; row < M; row += NGW) { GAS float* xr = F.out + (size_t)row * D; f32x4 v[4]; float ss = 0.f;
#pragma unroll
        for (int j = 0; j < 4; ++j) { v[j] = *(const GAS f32x4*)(xr + 4 * (F.lane + 64 * j)); ss += (v[j][0] * v[j][0] + v[j][1] * v[j][1]) + (v[j][2] * v[j][2] + v[j][3] * v[j][3]); }
#pragma unroll
        for (int o = 1; o < 64; o <<= 1) ss += shx(ss, o, F.lane);
        const float rstd = rsqrtf(ss * (1.0f / D) + EPS);
#pragma unroll
        for (int j = 0; j < 4; ++j) *(GAS f32x4*)(xr + 4 * (F.lane + 64 * j)) = v[j] * rstd * gam[j]; }
}

__global__ void __launch_bounds__(NWAVES * 64, 2) fwd_megakernel(Args args) {
    __shared__ __attribute__((aligned(16))) unsigned char lds[LDS_BYTES];
    Frame F;
    F.lds = (LAS unsigned char*)lds;
    F.tid = threadIdx.x; F.lane = F.tid & 63; F.wave = __builtin_amdgcn_readfirstlane(F.tid >> 6);
    F.G = gridDim.x; { const int bx = blockIdx.x; F.vcu = (F.G % 8 == 0) ? (bx % 8) * (F.G / 8) + bx / 8 : bx; }
    F.x = args.in[0]; F.c = args.in[1]; F.rel_bias = args.in[2]; F.w_mod = args.in[3]; F.b_mod = args.in[4]; F.norm_mix = args.in[5]; F.norm_mlp = args.in[6];
    F.w_pool = args.in[7]; F.pool_scale = args.in[8]; F.w_qkv = args.in[9]; F.w_o = args.in[10]; F.w_up = args.in[11]; F.w_down = args.in[12]; F.norm_final = args.in[13];
    F.out = args.out; F.ws = args.ws;
    volatile LAS unsigned* MISC = (volatile LAS unsigned*)(F.lds + MISC_OFF);
    for (int u = F.tid; u < (LDS_BYTES - LDSCTL_OFF) / 4; u += NWAVES * 64) ((LAS unsigned*)(F.lds + LDSCTL_OFF))[u] = 0u;
    __syncthreads();
    gu32* ctl = (gu32*)(F.ws + WS_CTL);
    XcdBarrier bar = xcd_barrier_post((GAS unsigned*)(ctl + CW_BAR), MISC + 8); bar.wave = F.wave;
    GAS unsigned char* ws = F.ws;
#define WSB(off) ((GAS bf16*)(ws + (off)))
#define WSF(off) ((GAS float*)(ws + (off)))

    p0_prologue(F);
    xcd_barrier(bar);
    p1_bias(F); p1_pool(F);
    xcd_barrier(bar);

    for (int ph = 0; ph < 10; ++ph) {
        asm volatile("" : "+s"(ws));
        const GAS float* MOD = WSF(WS_MOD); GAS float* SS = WSF(WS_SS);
        const int kind = (ph == 0 || ph == 2 || ph == 7) ? 0 : (ph == 1 || ph == 8) ? 1 : (ph == 3) ? 2 : (ph == 4) ? 3 : (ph == 5) ? 4 : (ph == 6) ? 5 : 7;
        if (kind == 0) {
            pg8::Gemm g; pg8::EpiRes E;
            if (ph == 0) { g = pg8::Gemm{WSB(WS_XNA), WSB(WS_WPOOL), M, D, 256, D, 256, 512};
                E = pg8::EpiRes{WSB(WS_XR), WSB(WS_XR), MOD + 2048, F.pool_scale, F.norm_mlp, MOD + 4096, WSB(WS_XNB), SS}; }
            else if (ph == 2) { g = pg8::Gemm{WSB(WS_HB), WSB(WS_WDN0), M, D, FF, 256, 0, 131072};
                E = pg8::EpiRes{WSB(WS_XR), WSB(WS_XR), MOD + 5120, nullptr, F.norm_mix + D, MOD + 4 * 6144 + 1024, WSB(WS_XNA), SS}; }
            else { g = pg8::Gemm{WSB(WS_O), WSB(WS_WO), M, D, D, D, 0, 512};
                E = pg8::EpiRes{WSB(WS_XR), WSB(WS_XR), MOD + 4 * 6144 + 2048, nullptr, F.norm_mlp + D, MOD + 4 * 6144 + 4096, WSB(WS_XNB), SS}; }
            pg8::StaticOrder S; S.init(M, D, F.G, (int)blockIdx.x);
            pg8::gemm_phase<pg8::EpiRes, pg8::StaticOrder, true>(F.lds + RING_OFF, g, S, E, F.wave);
        } else if (kind == 1) {
            const pg8::Gemm g{WSB(WS_XNB), WSB(ph == 1 ? WS_WUP0 : WS_WUP1), M, FF, D, 256, 0, 131072};
            const pg8::EpiUp E{SS, WSF(ph == 1 ? WS_BIAS_UP0 : WS_BIAS_UP1), WSB(WS_HB), FF};
            pg8::StaticOrder S; S.init(M, FF, F.G, (int)blockIdx.x);
            pg8::gemm_phase<pg8::EpiUp, pg8::StaticOrder, true>(F.lds + RING_OFF, g, S, E, F.wave);
        } else if (kind == 2) {
            const pg8::Gemm g{WSB(WS_XNA), WSB(WS_WQKV), M, NQKV, D, 256, 0, 131072};
            const pg8::EpiQKV E{SS, WSF(WS_BIAS_QKV), WSB(WS_Q), (size_t)(WS_K - WS_Q) / 2, WSF(WS_KMP)};
            pg8::StaticOrder S; S.init(M, NQKV, F.G, (int)blockIdx.x);
            pg8::gemm_phase<pg8::EpiQKV, pg8::StaticOrder, true>(F.lds + RING_OFF, g, S, E, F.wave);
        } else if (kind == 3) { F.ws = ws; att::route(F);
        } else if (kind == 4) { F.ws = ws; att::gather(F);
        } else if (kind == 5) { F.ws = ws; att::own_block(F);
        } else {
            const pg8::Gemm g{WSB(WS_HB), WSB(WS_WDN1), M, D, FF, 256, 0, 131072};
            const pg8::EpiFinal E{WSB(WS_XR), F.out, MOD + 4 * 6144 + 5120, F.norm_final, SS, (GAS unsigned*)(ws + WS_CTL) + CW_FIN};
            pg8::StaticOrder S; S.init(M, D, F.G, (int)blockIdx.x);
            pg8::gemm_phase<pg8::EpiFinal, pg8::StaticOrder, true>(F.lds + RING_OFF, g, S, E, F.wave);
            break;
        }
        xcd_barrier(bar);
    }
}

extern "C" void kernel_launch(void* const* d_in, const int* in_sizes, int n_in, void* d_out, int out_size, void* d_ws, size_t ws_size, hipStream_t stream) {
    static int grid = 0;
    if (grid == 0) {
        if (n_in != 14 || in_sizes[0] != M * D || out_size != M * D || ws_size < WS_END) { fprintf(stderr, "kernel_launch: unexpected shapes / workspace (n_in %d, in0 %d, out %d, ws %zu)\n", n_in, n_in > 0 ? in_sizes[0] : -1, out_size, ws_size); grid = -1; return; }
        int dev = 0, cus = 0, per_cu = 0;
        if (hipGetDevice(&dev) != hipSuccess || hipDeviceGetAttribute(&cus, hipDeviceAttributeMultiprocessorCount, dev) != hipSuccess) { grid = -1; return; }
        if (hipOccupancyMaxActiveBlocksPerMultiprocessor(&per_cu, (const void*)fwd_megakernel, NWAVES * 64, 0) != hipSuccess || per_cu < 1) { fprintf(stderr, "kernel_launch: occupancy query says %d blocks per CU\n", per_cu); }
        (void)hipGetLastError();
        grid = cus;
    }
    if (grid < 0) return;
    if (hipMemsetAsync((char*)d_ws + WS_CTL, 0, CTL_ZERO_BYTES, stream) != hipSuccess) return;
    Args a{};
    for (int i = 0; i < 14; ++i) a.in[i] = (const GAS float*)d_in[i];
    a.out = (GAS float*)d_out; a.ws = (GAS unsigned char*)d_ws;
    hipLaunchKernelGGL(fwd_megakernel, dim3(grid), dim3(NWAVES * 64), 0, stream, a);
}
```

```cpp
#include <hip/hip_runtime.h>
#include <cstdio>
#include <cstdint>

__device__ __forceinline__ float shx(float v, int m, int lane) { return __builtin_bit_cast(float, __builtin_amdgcn_ds_bpermute((lane ^ m) << 2, __builtin_bit_cast(int, v))); }
__device__ __forceinline__ unsigned shup(unsigned v, int o, int lane) { return (unsigned)__builtin_amdgcn_ds_bpermute(((lane - o) & 63) << 2, (int)v); }
__device__ __forceinline__ size_t hm_off(size_t row, int b, int h) { return (row + (size_t)(15 * b + h) * 8192) * 64; }
__device__ __forceinline__ int lane_id() { unsigned z = 0u; asm volatile("" : "+s"(z)); return (int)__builtin_amdgcn_mbcnt_hi(~0u, __builtin_amdgcn_mbcnt_lo(~0u, z)); }

namespace pg8 {
#define PG8_LAS __attribute__((address_space(3)))
#define PG8_GAS __attribute__((address_space(1)))
typedef unsigned short bf16_t;
typedef short bf16x8 __attribute__((ext_vector_type(8)));
typedef float f32x4 __attribute__((ext_vector_type(4)));
typedef unsigned u32x4 __attribute__((ext_vector_type(4)));
constexpr int BM = 256, BK = 64, HALF = 128, HTB = HALF * BK * 2, STAGE_BYTES = 8 * HTB, NXCD = 8, WGM = 8;

__host__ __device__ __forceinline__ int lds_byte(int r, int c) { const int st = (r >> 4) * 2 + (c >> 5), rr = r & 15, cc = c & 31, ob = rr * 64 + cc * 2; return st * 1024 + (ob ^ (((ob >> 9) & 1) << 5)); }
__host__ __device__ __forceinline__ void stage_rc(int b, int& R, int& C) { const int st = b / 1024, sb = b % 1024, swz = sb ^ (((sb >> 9) & 1) << 5); R = (st >> 1) * 16 + swz / 64; C = (st & 1) * 32 + (swz % 64) / 2; }
__host__ __device__ __forceinline__ int perm32(int rho) { const int n = rho >> 4, i = rho & 15; return 8 * (i >> 2) + 4 * n + (i & 3); }

struct Unit { int pm, pn; };
struct Gemm { const PG8_GAS bf16_t* A; const PG8_GAS bf16_t* Bt; int M, N, K, lda, a_pn_off, a_tileb; };

struct StaticOrder {
    int nM, nN, nwg, G, c;
    __host__ __device__ void init(int M, int N, int G_, int c_) { nM = M / BM; nN = N / BM; nwg = nM * nN; G = G_; c = c_; }
    __host__ __device__ bool next(int i, Unit& u) const {
        const long L = (long)i * G + c; if (L >= nwg) return false;
        int wgid = (int)L; { const int q = nwg / NXCD, r = nwg % NXCD, xcd = wgid % NXCD, off = wgid / NXCD; wgid = (xcd < r ? xcd * (q + 1) : r * (q + 1) + (xcd - r) * q) + off; }
        const int nig = WGM * nN, gid = wgid / nig, fm = gid * WGM, gsz = (nM - fm) < WGM ? (nM - fm) : WGM;
        u.pm = fm + ((wgid % nig) % gsz); u.pn = (wgid % nig) / gsz; return true;
    }
};

__device__ __forceinline__ unsigned cvt_pk_bf16(float lo, float hi) { unsigned r; asm volatile("v_cvt_pk_bf16_f32 %0, %1, %2" : "=v"(r) : "v"(lo), "v"(hi)); return r; }

constexpr int SEQ_ = 8192;
constexpr float EPS_ = 1e-6f;
constexpr float C2_ = 0.125f * 1.4426950408889634f;


__device__ __forceinline__ float row_rstd(const PG8_GAS float* SS, int row, int fq, int fr) {
    const f32x4 s4 = *(const PG8_GAS f32x4*)(SS + (size_t)row * 16 + 4 * fq);
    float s = (s4[0] + s4[1]) + (s4[2] + s4[3]);
    const int ln = fq * 16 + fr; s += shx(s, 16, ln); s += shx(s, 32, ln);
    return rsqrtf(s * (1.0f / 1024.0f) + EPS_);
}

constexpr int RSTD_TAB_OFF = 132096;
__device__ __forceinline__ void fill_rstd_tab(PG8_LAS unsigned char* ldsbase, int par, const PG8_GAS float* SS, int pm, int wid, int lane) {
    if (lane < 32) { const int r = wid * 32 + lane; const PG8_GAS f32x4* p = (const PG8_GAS f32x4*)(SS + (size_t)(pm * BM + r) * 16);
        const f32x4 a = p[0], b = p[1], c = p[2], d = p[3];
        const float g0 = (a[0] + a[1]) + (a[2] + a[3]), g1 = (b[0] + b[1]) + (b[2] + b[3]), g2 = (c[0] + c[1]) + (c[2] + c[3]), g3 = (d[0] + d[1]) + (d[2] + d[3]);
        ((PG8_LAS float*)(ldsbase + RSTD_TAB_OFF + par * 1024))[r] = rsqrtf(((g0 + g1) + (g2 + g3)) * (1.0f / 1024.0f) + EPS_); }
}
__device__ __forceinline__ f32x4 bf_lo4(const u32x4& w) { return (f32x4){__builtin_bit_cast(float, w.x << 16), __builtin_bit_cast(float, w.x & 0xffff0000u), __builtin_bit_cast(float, w.y << 16), __builtin_bit_cast(float, w.y & 0xffff0000u)}; }
__device__ __forceinline__ f32x4 bf_hi4(const u32x4& w) { return (f32x4){__builtin_bit_cast(float, w.z << 16), __builtin_bit_cast(float, w.z & 0xffff0000u), __builtin_bit_cast(float, w.w << 16), __builtin_bit_cast(float, w.w & 0xffff0000u)}; }
struct EpiRes {
    static constexpr bool PERM = true, NEEDS_RSTD = false;
    const PG8_GAS bf16_t* Rb; PG8_GAS bf16_t* Xb; const PG8_GAS float* gate; const PG8_GAS float* cscale; const PG8_GAS float* gnext; const PG8_GAS float* scn; PG8_GAS bf16_t* XN; PG8_GAS float* SS;
    __device__ __forceinline__ void operator()(f32x4 (&acc)[2][2][4][2], const Unit& u, int wr, int wc, int fr, int fq) const {
        const int b = u.pm >> 5, colb = u.pn * BM + wc * 32 + 8 * fq, row0 = u.pm * BM + wr * 64 + fr;
        float ssq[2][4];
#pragma unroll
        for (int bj = 0; bj < 2; ++bj) {
            f32x4 gt[2], cs[2];
#pragma unroll
            for (int n = 0; n < 2; ++n) { const int col = colb + bj * HALF + 4 * n;
                f32x4 gv = *(const PG8_GAS f32x4*)(gate + b * 6144 + col); if (cscale) gv = gv * *(const PG8_GAS f32x4*)(cscale + col); gt[n] = gv;
                const f32x4 sc = *(const PG8_GAS f32x4*)(scn + b * 6144 + col); cs[n] = *(const PG8_GAS f32x4*)(gnext + col) * (sc + 1.0f); }
#pragma unroll
            for (int ai = 0; ai < 2; ++ai)
#pragma unroll
                for (int m = 0; m < 4; ++m) { const size_t off = ((size_t)(u.pm * 4 + u.pn) * 256 + (wr * 64 + fr + ai * HALF + m * 16)) * 256 + (wc * 32 + 8 * fq + bj * HALF);
                    const u32x4 rw = *(const PG8_GAS u32x4*)(Rb + off); const f32x4 r0 = bf_lo4(rw), r1 = bf_hi4(rw);
                    const f32x4 y0 = r0 + gt[0] * acc[ai][bj][m][0], y1 = r1 + gt[1] * acc[ai][bj][m][1];
                    u32x4 xw; xw.x = cvt_pk_bf16(y0[0], y0[1]); xw.y = cvt_pk_bf16(y0[2], y0[3]); xw.z = cvt_pk_bf16(y1[0], y1[1]); xw.w = cvt_pk_bf16(y1[2], y1[3]);
                    *(PG8_GAS u32x4*)(Xb + off) = xw;
                    const f32x4 x0 = bf_lo4(xw), x1 = bf_hi4(xw);
                    const float q = (x0[0] * x0[0] + x0[1] * x0[1]) + (x0[2] * x0[2] + x0[3] * x0[3]) + (x1[0] * x1[0] + x1[1] * x1[1]) + (x1[2] * x1[2] + x1[3] * x1[3]);
                    ssq[ai][m] = (bj == 0) ? q : ssq[ai][m] + q;
                    const f32x4 a0 = x0 * cs[0], a1 = x1 * cs[1]; u32x4 w; w.x = cvt_pk_bf16(a0[0], a0[1]); w.y = cvt_pk_bf16(a0[2], a0[3]); w.z = cvt_pk_bf16(a1[0], a1[1]); w.w = cvt_pk_bf16(a1[2], a1[3]);
                    *(PG8_GAS u32x4*)(XN + off) = w;
                }
        }
#pragma unroll
        for (int ai = 0; ai < 2; ++ai)
#pragma unroll
            for (int m = 0; m < 4; ++m) { float q = ssq[ai][m]; q += shx(q, 16, fq * 16 + fr); q += shx(q, 32, fq * 16 + fr); if (fq == 0) SS[(size_t)(row0 + ai * HALF + m * 16) * 16 + u.pn * 4 + wc] = q; }
    }
};

struct EpiFinal {
    static constexpr bool PERM = true, NEEDS_RSTD = false;
    const PG8_GAS bf16_t* R; PG8_GAS float* OUT; const PG8_GAS float* gate; const PG8_GAS float* gfin; PG8_GAS float* SS; PG8_GAS unsigned* cnt;
    __device__ __forceinline__ void operator()(f32x4 (&acc)[2][2][4][2], const Unit& u, int wr, int wc, int fr_, int fq_) const {
        int fr = fr_, fq = fq_; asm volatile("" : "+v"(fr), "+v"(fq));
        const int b = u.pm >> 5, colb = u.pn * BM + wc * 32 + 8 * fq, row0 = u.pm * BM + wr * 64 + fr, ln = fq * 16 + fr;
        float ssq[2][4];
#pragma unroll
        for (int bj = 0; bj < 2; ++bj) {
            const f32x4 gt0 = *(const PG8_GAS f32x4*)(gate + b * 6144 + colb + bj * HALF), gt1 = *(const PG8_GAS f32x4*)(gate + b * 6144 + colb + bj * HALF + 4);
#pragma unroll
            for (int ai = 0; ai < 2; ++ai)
#pragma unroll
                for (int m = 0; m < 4; ++m) { const size_t off = (size_t)(row0 + ai * HALF + m * 16) * 1024 + colb + bj * HALF;
                    const u32x4 rw = *(const PG8_GAS u32x4*)(R + ((size_t)(u.pm * 4 + u.pn) * 256 + (wr * 64 + fr + ai * HALF + m * 16)) * 256 + (wc * 32 + 8 * fq + bj * HALF));
                    const f32x4 x0 = bf_lo4(rw) + gt0 * acc[ai][bj][m][0], x1 = bf_hi4(rw) + gt1 * acc[ai][bj][m][1];
                    acc[ai][bj][m][0] = x0; acc[ai][bj][m][1] = x1;
                    const float q = (x0[0] * x0[0] + x0[1] * x0[1]) + (x0[2] * x0[2] + x0[3] * x0[3]) + (x1[0] * x1[0] + x1[1] * x1[1]) + (x1[2] * x1[2] + x1[3] * x1[3]);
                    ssq[ai][m] = (bj == 0) ? q : ssq[ai][m] + q;
                    asm volatile("" : "+v"(acc[ai][bj][m][0]), "+v"(acc[ai][bj][m][1]), "+v"(ssq[ai][m]));
                    if (m & 1) asm volatile("" ::: "memory"); }
        }
#pragma unroll
        for (int ai = 0; ai < 2; ++ai)
#pragma unroll
            for (int m = 0; m < 4; ++m) { float q = ssq[ai][m]; q += shx(q, 16, ln); q += shx(q, 32, ln);
                if (fq == 0) __hip_atomic_store(SS + (size_t)(row0 + ai * HALF + m * 16) * 16 + u.pn * 4 + wc, q, __ATOMIC_RELAXED, __HIP_MEMORY_SCOPE_AGENT); }
        asm volatile("s_waitcnt vmcnt(0)" ::: "memory");
        PG8_GAS unsigned* c = cnt + 64 * u.pm;
        if (ln == 0) (void)__hip_atomic_fetch_add(c, 1u, __ATOMIC_RELAXED, __HIP_MEMORY_SCOPE_AGENT);
        for (unsigned sp = 0; sp < (1u << 22); ++sp) { if ((unsigned)__builtin_amdgcn_readfirstlane((int)__hip_atomic_load(c, __ATOMIC_RELAXED, __HIP_MEMORY_SCOPE_AGENT)) >= 32u) break; __builtin_amdgcn_s_sleep(2); }
        int row1 = row0, colc = colb; asm volatile("" : "+v"(row1), "+v"(colc));
        float rs[2][4];
#pragma unroll
        for (int ai = 0; ai < 2; ++ai)
#pragma unroll
            for (int m = 0; m < 4; ++m) { const PG8_GAS float* sp4 = SS + (size_t)(row1 + ai * HALF + m * 16) * 16 + 4 * fq;
                float t = (__hip_atomic_load(sp4, __ATOMIC_RELAXED, __HIP_MEMORY_SCOPE_AGENT) + __hip_atomic_load(sp4 + 1, __ATOMIC_RELAXED, __HIP_MEMORY_SCOPE_AGENT))
                        + (__hip_atomic_load(sp4 + 2, __ATOMIC_RELAXED, __HIP_MEMORY_SCOPE_AGENT) + __hip_atomic_load(sp4 + 3, __ATOMIC_RELAXED, __HIP_MEMORY_SCOPE_AGENT));
                t += shx(t, 16, ln); t += shx(t, 32, ln); rs[ai][m] = rsqrtf(t * (1.0f / 1024.0f) + EPS_); }
#pragma unroll
        for (int bj = 0; bj < 2; ++bj) {
            const f32x4 g0 = *(const PG8_GAS f32x4*)(gfin + colc + bj * HALF), g1 = *(const PG8_GAS f32x4*)(gfin + colc + bj * HALF + 4);
#pragma unroll
            for (int ai = 0; ai < 2; ++ai)
#pragma unroll
                for (int m = 0; m < 4; ++m) { const size_t off = (size_t)(row1 + ai * HALF + m * 16) * 1024 + colc + bj * HALF;
                    *(PG8_GAS f32x4*)(OUT + off) = acc[ai][bj][m][0] * rs[ai][m] * g0; *(PG8_GAS f32x4*)(OUT + off + 4) = acc[ai][bj][m][1] * rs[ai][m] * g1; }
        }
    }
};

struct EpiUp {
    static constexpr bool PERM = true;
    static constexpr bool NEEDS_RSTD = true;
    const PG8_GAS float* SS; const PG8_GAS float* bias; PG8_GAS bf16_t* O; int ldc; PG8_LAS unsigned char* ldsb; int par;
    __device__ __forceinline__ void operator()(f32x4 (&acc)[2][2][4][2], const Unit& u, int wr, int wc, int fr, int fq) const {
        const int b = u.pm >> 5, colb = u.pn * BM + wc * 32 + 8 * fq, row0 = u.pm * BM + wr * 64 + fr;
        float rs[2][4];
#pragma unroll
        for (int ai = 0; ai < 2; ++ai)
#pragma unroll
            for (int m = 0; m < 4; ++m) rs[ai][m] = ((const PG8_LAS float*)(ldsb + RSTD_TAB_OFF + par * 1024))[wr * 64 + fr + ai * HALF + m * 16];
#pragma unroll
        for (int bj = 0; bj < 2; ++bj) {
            const f32x4 bv0 = *(const PG8_GAS f32x4*)(bias + (size_t)b * ldc + colb + bj * HALF), bv1 = *(const PG8_GAS f32x4*)(bias + (size_t)b * ldc + colb + bj * HALF + 4);
#pragma unroll
            for (int ai = 0; ai < 2; ++ai)
#pragma unroll
                for (int m = 0; m < 4; ++m) { f32x4 v0 = acc[ai][bj][m][0] * rs[ai][m] + bv0, v1 = acc[ai][bj][m][1] * rs[ai][m] + bv1;
#pragma unroll
                    for (int j = 0; j < 4; ++j) { v0[j] = fmaxf(v0[j], 0.f); v1[j] = fmaxf(v1[j], 0.f); }
                    v0 = v0 * v0; v1 = v1 * v1;
                    u32x4 w; w.x = cvt_pk_bf16(v0[0], v0[1]); w.y = cvt_pk_bf16(v0[2], v0[3]); w.z = cvt_pk_bf16(v1[0], v1[1]); w.w = cvt_pk_bf16(v1[2], v1[3]);
                    *(PG8_GAS u32x4*)(O + ((size_t)(u.pm * 16 + u.pn) * 256 + (wr * 64 + fr + ai * HALF + m * 16)) * 256 + (wc * 32 + 8 * fq + bj * HALF)) = w; }
        }
    }
};

struct EpiQKV {
    static constexpr bool PERM = true;
    static constexpr bool NEEDS_RSTD = true;
    const PG8_GAS float* SS; const PG8_GAS float* bias; PG8_GAS bf16_t* Q; size_t split_stride; PG8_GAS float* KMP; PG8_LAS unsigned char* ldsb; int par;
    __device__ __forceinline__ void operator()(f32x4 (&acc)[2][2][4][2], const Unit& u, int wr, int wc, int fr, int fq) const {
        const int b = u.pm >> 5, t = u.pn >> 2, colt = (u.pn & 3) * BM + wc * 32 + 8 * fq, colb = u.pn * BM + wc * 32 + 8 * fq, row0 = u.pm * BM + wr * 64 + fr;
        PG8_GAS bf16_t* base = Q + (size_t)t * split_stride; const float sc = (t == 0) ? C2_ : 1.0f;
        float rs[2][4];
#pragma unroll
        for (int ai = 0; ai < 2; ++ai)
#pragma unroll
            for (int m = 0; m < 4; ++m) rs[ai][m] = ((const PG8_LAS float*)(ldsb + RSTD_TAB_OFF + par * 1024))[wr * 64 + fr + ai * HALF + m * 16];
#pragma unroll
        for (int bj = 0; bj < 2; ++bj) {
            const f32x4 bv0 = *(const PG8_GAS f32x4*)(bias + (size_t)b * 3072 + colb + bj * HALF), bv1 = *(const PG8_GAS f32x4*)(bias + (size_t)b * 3072 + colb + bj * HALF + 4);
            f32x4 cs0 = {0.f, 0.f, 0.f, 0.f}, cs1 = cs0;
#pragma unroll
            for (int ai = 0; ai < 2; ++ai)
#pragma unroll
                for (int m = 0; m < 4; ++m) { f32x4 v0 = acc[ai][bj][m][0] * rs[ai][m] + bv0, v1 = acc[ai][bj][m][1] * rs[ai][m] + bv1;
                    cs0 += v0; cs1 += v1; v0 = v0 * sc; v1 = v1 * sc;
                    u32x4 w; w.x = cvt_pk_bf16(v0[0], v0[1]); w.y = cvt_pk_bf16(v0[2], v0[3]); w.z = cvt_pk_bf16(v1[0], v1[1]); w.w = cvt_pk_bf16(v1[2], v1[3]);
                    *(PG8_GAS u32x4*)(base + hm_off((size_t)(row0 + ai * HALF + m * 16), b, (colt + bj * HALF) >> 6) + ((colt + bj * HALF) & 63)) = w; }
            if (t == 1) {
#pragma unroll
                for (int o = 1; o < 16; o <<= 1) {
#pragma unroll
                    for (int j = 0; j < 4; ++j) { cs0[j] += shx(cs0[j], o, fq * 16 + fr); cs1[j] += shx(cs1[j], o, fq * 16 + fr); } }
                if (fr == 0) { PG8_GAS float* kp = KMP + ((size_t)u.pm * 2 + wr) * 1024 + colt + bj * HALF; *(f32x4*)kp = cs0; *(PG8_GAS f32x4*)(kp + 4) = cs1; }
            }
        }
    }
};

template <class Epi, class Sched, bool ALIGN_EPI>
__device__ __forceinline__ void gemm_phase(PG8_LAS unsigned char* lds, const Gemm g, const Sched& S, const Epi& E_, int wave_id) {
    Epi E = E_;
    int tid = wave_id * 64 + lane_id(); asm volatile("" : "+v"(tid));
    const int wid = __builtin_amdgcn_readfirstlane(tid >> 6), lane = tid & 63, wr = wid >> 2, wc = wid & 3, fr = lane & 15, fq = lane >> 4;
    const int K = g.K, nt = K / BK, lda = g.lda;
    unsigned voffA[2], voffB[2];
#pragma unroll
    for (int i = 0; i < 2; ++i) { int R, C; stage_rc(tid * 16 + i * 8192, R, C); const int Rb = Epi::PERM ? ((R & ~31) + perm32(R & 31)) : R;
        voffA[i] = (unsigned)(R * lda + C) * 2u; voffB[i] = (unsigned)(Rb * K + C) * 2u; }
    const size_t kstep = (size_t)(BK * 2);
    const size_t hstepA = (size_t)HALF * lda * 2, tstepA = (g.a_tileb == 512) ? 2 * hstepA : (size_t)(K / 256) * g.a_tileb, hstepB = (size_t)HALF * K * 2, tstepB = 2 * hstepB;
    const size_t tileb = (size_t)g.a_tileb;
#define PG8_KOFF(t) ((size_t)((t) >> 2) * tileb + (size_t)((t) & 3) * 128)
    const unsigned ldsw = (unsigned)wid * 1024u;
    const int aoff = lds_byte(wr * 64 + fr, fq * 8), boff = lds_byte(wc * 32 + fr, fq * 8);
#define PG8_SA(b, h) (((b) * 2 + (h)) * HTB)
#define PG8_SB(b, h) ((4 + (b) * 2 + (h)) * HTB)
#define PG8_STAGE(bufoff, gbase, voff) do { _Pragma("unroll") for (int _i = 0; _i < 2; ++_i) \
        __builtin_amdgcn_global_load_lds((const PG8_GAS unsigned*)((const PG8_GAS char*)(gbase) + (voff)[_i]), (PG8_LAS unsigned*)(lds + (bufoff) + ldsw + _i * 8192), 16, 0, 0); } while (0)
#define PG8_LDA(dst, b, h) do { _Pragma("unroll") for (int m = 0; m < 4; ++m) _Pragma("unroll") for (int k = 0; k < 2; ++k) dst[m][k] = *(const PG8_LAS bf16x8*)(lds + PG8_SA(b, h) + aoff + m * 2048 + k * 1024); } while (0)
#define PG8_LDB(dst, b, h) do { _Pragma("unroll") for (int n = 0; n < 2; ++n) _Pragma("unroll") for (int k = 0; k < 2; ++k) dst[n][k] = *(const PG8_LAS bf16x8*)(lds + PG8_SB(b, h) + boff + n * 2048 + k * 1024); } while (0)
#define PG8_MMA(ai, bj, At, Bt) do { __builtin_amdgcn_s_setprio(1); _Pragma("unroll") for (int m = 0; m < 4; ++m) _Pragma("unroll") for (int n = 0; n < 2; ++n) _Pragma("unroll") for (int k = 0; k < 2; ++k) \
        acc[ai][bj][m][n] = __builtin_amdgcn_mfma_f32_16x16x32_bf16(Bt[n][k], At[m][k], acc[ai][bj][m][n], 0, 0, 0); __builtin_amdgcn_s_setprio(0); } while (0)
#define PG8_WAIT_V(n) asm volatile("s_waitcnt vmcnt(" #n ")" ::: "memory")
#define PG8_WAIT_L(n) asm volatile("s_waitcnt lgkmcnt(" #n ")" ::: "memory")
#define PG8_BAR __builtin_amdgcn_s_barrier()
#define PG8_SCHED __builtin_amdgcn_sched_barrier(0)
    Unit cur, nxt; int ui = 0;
    if (!S.next(0, cur)) return;
    int rpar = 0;
    if constexpr (Epi::NEEDS_RSTD) { fill_rstd_tab(lds, 0, E.SS, cur.pm, wid, lane); E.par = 0; }
    f32x4 acc[2][2][4][2];
#pragma unroll
    for (int a = 0; a < 2; ++a)
#pragma unroll
        for (int b = 0; b < 2; ++b)
#pragma unroll
            for (int m = 0; m < 4; ++m)
#pragma unroll
                for (int n = 0; n < 2; ++n) acc[a][b][m][n] = (f32x4){0.f, 0.f, 0.f, 0.f};
    bf16x8 At[4][2], B0[2][2], B1[2][2];
    const PG8_GAS char* cA = (const PG8_GAS char*)g.A + (size_t)cur.pm * tstepA + (size_t)cur.pn * g.a_pn_off * 2; const PG8_GAS char* cB = (const PG8_GAS char*)g.Bt + (size_t)cur.pn * tstepB;
    PG8_STAGE(PG8_SB(0, 0), cB, voffB); PG8_STAGE(PG8_SB(0, 1), cB + hstepB, voffB); PG8_STAGE(PG8_SA(0, 0), cA, voffA); PG8_STAGE(PG8_SA(0, 1), cA + hstepA, voffA);
    if (wr == 1) PG8_BAR;
    PG8_WAIT_V(2); PG8_BAR;
    PG8_STAGE(PG8_SB(1, 0), cB + kstep, voffB); PG8_STAGE(PG8_SA(1, 0), cA + kstep, voffA); PG8_STAGE(PG8_SB(1, 1), cB + hstepB + kstep, voffB);
    PG8_WAIT_V(6); PG8_BAR;
    for (;;) {
        const bool has_next = S.next(ui + 1, nxt);
        const PG8_GAS char* nA = has_next ? (const PG8_GAS char*)g.A + (size_t)nxt.pm * tstepA + (size_t)nxt.pn * g.a_pn_off * 2 : cA; const PG8_GAS char* nB = has_next ? (const PG8_GAS char*)g.Bt + (size_t)nxt.pn * tstepB : cB;
        for (int t = 0; t < nt; t += 2) {
            const bool last = (t == nt - 2);
            const PG8_GAS char* a1 = cA + PG8_KOFF(t + 1);
            const PG8_GAS char* a2 = last ? nA : cA + PG8_KOFF(t + 2); const PG8_GAS char* b2 = last ? nB : cB + (size_t)(t + 2) * kstep;
            const PG8_GAS char* a3 = a2 + kstep; const PG8_GAS char* b3 = b2 + kstep;
            PG8_LDB(B0, 0, 0); PG8_LDB(B1, 0, 1); PG8_SCHED; PG8_LDA(At, 0, 0); PG8_STAGE(PG8_SA(1, 1), a1 + hstepA, voffA);
            PG8_WAIT_V(8); PG8_WAIT_L(0); PG8_BAR; PG8_MMA(0, 0, At, B0); PG8_MMA(0, 1, At, B1); PG8_BAR; PG8_SCHED;
            PG8_LDA(At, 0, 1); PG8_STAGE(PG8_SB(0, 0), b2, voffB); PG8_STAGE(PG8_SB(0, 1), b2 + hstepB, voffB); PG8_STAGE(PG8_SA(0, 0), a2, voffA);
            PG8_WAIT_V(8); PG8_WAIT_L(0); PG8_BAR; PG8_MMA(1, 0, At, B0); PG8_MMA(1, 1, At, B1); PG8_BAR; PG8_SCHED;
            PG8_LDB(B0, 1, 0); PG8_LDB(B1, 1, 1); PG8_SCHED; PG8_LDA(At, 1, 0); PG8_STAGE(PG8_SA(0, 1), a2 + hstepA, voffA);
            PG8_WAIT_V(8); PG8_WAIT_L(0); PG8_BAR; PG8_MMA(0, 0, At, B0); PG8_MMA(0, 1, At, B1); PG8_BAR; PG8_SCHED;
            PG8_LDA(At, 1, 1); PG8_STAGE(PG8_SB(1, 0), b3, voffB); PG8_STAGE(PG8_SB(1, 1), b3 + hstepB, voffB); PG8_STAGE(PG8_SA(1, 0), a3, voffA);
            PG8_WAIT_V(8); PG8_WAIT_L(0); PG8_BAR; PG8_MMA(1, 0, At, B0); PG8_MMA(1, 1, At, B1); PG8_BAR; PG8_SCHED;
        }
        if constexpr (ALIGN_EPI) { if (wr == 0) PG8_BAR; }
        if constexpr (Epi::NEEDS_RSTD) E.par = rpar;
        E(acc, cur, wr, wc, fr, fq);
        if constexpr (Epi::NEEDS_RSTD) { if (has_next && nxt.pm != cur.pm) { rpar ^= 1; fill_rstd_tab(lds, rpar, E.SS, nxt.pm, wid, lane); } }
        if (!has_next) break;
#pragma unroll
        for (int a = 0; a < 2; ++a)
#pragma unroll
            for (int b = 0; b < 2; ++b)
#pragma unroll
                for (int m = 0; m < 4; ++m)
#pragma unroll
                    for (int n = 0; n < 2; ++n) acc[a][b][m][n] = (f32x4){0.f, 0.f, 0.f, 0.f};
        cur = nxt; cA = nA; cB = nB; ++ui;
        if constexpr (ALIGN_EPI) { if (wr == 1) PG8_BAR; }
    }
    PG8_WAIT_V(0);
    if constexpr (!ALIGN_EPI) { if (wr == 0) PG8_BAR; }
    PG8_BAR;
#undef PG8_KOFF
#undef PG8_SA
#undef PG8_SB
#undef PG8_STAGE
#undef PG8_LDA
#undef PG8_LDB
#undef PG8_MMA
#undef PG8_WAIT_V
#undef PG8_WAIT_L
#undef PG8_BAR
#undef PG8_SCHED
}
}

constexpr int NWAVES = 8;
constexpr int BATCH = 4, SEQ = 8192, D = 1024, NH = 16, HD = 64, FF = 4096, M = BATCH * SEQ, NQKV = 3 * D, NBLK = 32, BLK = 256;
constexpr float EPS = 1e-6f;
constexpr float LOG2E = 1.4426950408889634f;

constexpr size_t MiB = 1u << 20;
constexpr size_t WS_CTL = 0, CTL_ZERO_BYTES = 1 * MiB;
constexpr size_t WS_MOD = 1 * MiB;
constexpr size_t WS_BIAS_UP0 = WS_MOD + 256 * 1024;
constexpr size_t WS_BIAS_QKV = WS_BIAS_UP0 + 64 * 1024;
constexpr size_t WS_BIAS_UP1 = WS_BIAS_QKV + 64 * 1024;
constexpr size_t WS_KMP = 2 * MiB;
constexpr size_t WS_SS = 3 * MiB;
constexpr size_t WS_WPOOL = 6 * MiB, WS_WQKV = 8 * MiB, WS_WO = 14 * MiB, WS_WUP0 = 16 * MiB, WS_WUP1 = 24 * MiB, WS_WDN0 = 32 * MiB, WS_WDN1 = 40 * MiB;
constexpr size_t WS_XNA = 48 * MiB, WS_XNB = 112 * MiB;
constexpr size_t WS_HB = 176 * MiB;
constexpr size_t WS_Q = 176 * MiB, WS_K = 240 * MiB, WS_V = 304 * MiB;
constexpr size_t WS_PL = 496 * MiB;
constexpr size_t WS_CNT = 503 * MiB;
constexpr size_t WS_KBM = 503 * MiB + 512 * 1024;
constexpr size_t WS_POB = 48 * MiB;
constexpr size_t WS_SEG = 368 * MiB;
constexpr size_t WS_XR = 432 * MiB;
constexpr size_t WS_O = 368 * MiB;
constexpr size_t WS_DUMP = 504 * MiB;
constexpr size_t WS_END = 506 * MiB;
constexpr int CW_BAR = 4096;
constexpr int CW_FIN = 24576;
constexpr int CW_TOT = 16384;

constexpr int RING_OFF = 0, RING_BYTES = 131072;
constexpr int LDSCTL_OFF = RING_BYTES, MISC_OFF = LDSCTL_OFF + 320;
constexpr int LDS_BYTES = 151552;

#define GAS __attribute__((address_space(1)))
#define LAS __attribute__((address_space(3)))
typedef unsigned short bf16;
typedef unsigned v4u __attribute__((ext_vector_type(4)));
typedef unsigned v2u __attribute__((ext_vector_type(2)));
typedef float f32x4 __attribute__((ext_vector_type(4)));
typedef GAS unsigned gu32;
#define RLX_AGENT __ATOMIC_RELAXED, __HIP_MEMORY_SCOPE_AGENT
#define LDS_WAIT() asm volatile("s_waitcnt lgkmcnt(0)" ::: "memory")
__device__ __forceinline__ unsigned f2bf(float f) { unsigned u = __builtin_bit_cast(unsigned, f); return (u + 0x7fffu + ((u >> 16) & 1u)) >> 16; }
__device__ __forceinline__ unsigned pk2(float lo, float hi) { return f2bf(lo) | (f2bf(hi) << 16); }
__device__ __forceinline__ float bf2f(unsigned short v) { return __builtin_bit_cast(float, (unsigned)v << 16); }

#define XB_TMO      128
#define XB_XCNT(j)  (256  + 64 * (j))
#define XB_XSUB(j)  (1280 + 64 * (j))
#define XB_XGEN(j)  (2304 + 64 * (j))
#define XB_TOP      3328
#define XB_TOPGEN   3392
#define XCD_BAR_WORDS 3456
#define XB_SPIN_CAP (1u << 18)
__device__ __forceinline__ unsigned xb_ld(GAS unsigned* p)              { return __hip_atomic_load(p, __ATOMIC_RELAXED, __HIP_MEMORY_SCOPE_AGENT); }
__device__ __forceinline__ unsigned xb_add(GAS unsigned* p, unsigned v) { return __hip_atomic_fetch_add(p, v, __ATOMIC_RELAXED, __HIP_MEMORY_SCOPE_AGENT); }
__device__ __forceinline__ unsigned xb_xcc_id() { return (unsigned)__builtin_amdgcn_s_getreg((3 << 11) | 20) & 0xFu; }
#define XB_SPIN(cond, bar) do { unsigned _sp = 0; while (cond) { __builtin_amdgcn_s_sleep(1); \
    if ((++_sp & 255u) == 0u) { if (xb_ld(&(bar)[XB_TMO])) break; if (_sp > XB_SPIN_CAP) { (void)xb_add(&(bar)[XB_TMO], 1u); break; } } } } while (0)
struct XcdBarrier { GAS unsigned* bar; unsigned x; volatile LAS unsigned* st; int wave; };
__device__ __forceinline__ XcdBarrier xcd_barrier_post(GAS unsigned* bar, volatile LAS unsigned* st) {
    XcdBarrier b; b.bar = bar; b.x = xb_xcc_id(); b.st = st;
    if (threadIdx.x == 0) (void)xb_add(&bar[XB_XCNT(b.x)], 1u);
    return b;
}
__device__ __forceinline__ void xcd_barrier_complete(GAS unsigned* bar, unsigned x, unsigned& nloc, unsigned& nx) {
    const unsigned G = gridDim.x * gridDim.y * gridDim.z;
    unsigned sum, cnt, mine, sp = 0u;
    for (;;) {
        sum = 0u; cnt = 0u; mine = 0u;
#pragma unroll
        for (unsigned j = 0; j < 16; ++j) { const unsigned c = xb_ld(&bar[XB_XCNT(j)]); sum += c; cnt += (c > 0u) ? 1u : 0u; mine = (j == x) ? c : mine; }
        if (sum == G) break;
        __builtin_amdgcn_s_sleep(1);
        if ((++sp & 255u) == 0u) { if (xb_ld(&bar[XB_TMO])) break; if (sp > XB_SPIN_CAP) { (void)xb_add(&bar[XB_TMO], 1u); break; } }
    }
    nloc = mine > 0u ? mine : 1u; nx = cnt > 0u ? cnt : 1u;
}
__device__ __forceinline__ void xcd_barrier(const XcdBarrier& b) {
    asm volatile("s_waitcnt vmcnt(0)" ::: "memory");
    __syncthreads();
    if (b.wave == 0 && lane_id() == 0) {
        GAS unsigned* bar = b.bar; asm volatile("" : "+s"(bar));
        const unsigned bx = xb_xcc_id();
        __builtin_amdgcn_s_waitcnt(0);
        unsigned nloc = b.st[0], nx = b.st[1];
        if (nloc == 0u) { xcd_barrier_complete(bar, bx, nloc, nx); b.st[0] = nloc; b.st[1] = nx; }
        const unsigned old = xb_add(&bar[XB_XSUB(bx)], 1u);
        const unsigned gen = old / nloc;
        if (old + 1u == (gen + 1u) * nloc) {
            __builtin_amdgcn_fence(__ATOMIC_RELEASE, "agent");
            asm volatile("s_waitcnt vmcnt(0)" ::: "memory");
            const unsigned og = xb_add(&bar[XB_TOP], 1u);
            const unsigned tg = og / nx;
            if (og + 1u == (tg + 1u) * nx) xb_add(&bar[XB_TOPGEN], 1u);
            else XB_SPIN(xb_ld(&bar[XB_TOPGEN]) == tg, bar);
            __builtin_amdgcn_fence(__ATOMIC_ACQUIRE, "agent");
            xb_add(&bar[XB_XGEN(bx)], 1u);
            asm volatile("s_waitcnt vmcnt(0)" ::: "memory");
        } else {
            XB_SPIN(xb_ld(&bar[XB_XGEN(bx)]) == gen, bar);
            __builtin_amdgcn_fence(__ATOMIC_ACQUIRE, "agent");
            asm volatile("s_waitcnt vmcnt(0)" ::: "memory");
        }
    }
    __syncthreads();
}

struct Args { const GAS float* in[14]; GAS float* out; GAS unsigned char* ws; };
struct Frame {
    LAS unsigned char* lds; int tid, lane, wave, vcu, G;
    const GAS float *x, *c, *rel_bias, *w_mod, *b_mod, *norm_mix, *norm_mlp, *w_pool, *pool_scale, *w_qkv, *w_o, *w_up, *w_down, *norm_final;
    GAS float* out; GAS unsigned char* ws;
};
__device__ __forceinline__ float wave_sum(float v) {
#pragma unroll
    for (int o = 1; o < 64; o <<= 1) v += __shfl_xor(v, o);
    return v;
}

struct TItem { const GAS float* W; GAS bf16* WT; int K, N, row_off, item; };
__device__ __forceinline__ void tload(const TItem& I, f32x4 (&t)[8], int lane) {
    const int nblk = I.N / 32, kb = I.item / nblk, nb = I.item % nblk, k0 = 64 * kb, n0 = 32 * nb;
#pragma unroll
    for (int i = 0; i < 8; ++i) t[i] = *(const GAS f32x4*)(I.W + (size_t)(k0 + 8 * i + (lane >> 3)) * I.N + n0 + 4 * (lane & 7));
}
__device__ __forceinline__ void tstore(const TItem& I, const f32x4 (&t)[8], LAS float* scr, int lane) {
    const int nblk = I.N / 32, kb = I.item / nblk, nb = I.item % nblk, k0 = 64 * kb, n0 = 32 * nb;
#pragma unroll
    for (int i = 0; i < 8; ++i) { LAS float* d = scr + (8 * i + (lane >> 3)) * 33 + 4 * (lane & 7); d[0] = t[i][0]; d[1] = t[i][1]; d[2] = t[i][2]; d[3] = t[i][3]; }
    LDS_WAIT(); asm volatile("" ::: "memory");
    const int c = lane & 7;
#pragma unroll
    for (int j = 0; j < 4; ++j) { const int n = (lane >> 3) + 8 * j; const LAS float* s = scr + (8 * c) * 33 + n;
        v4u o; o.x = pk2(s[0 * 33], s[1 * 33]); o.y = pk2(s[2 * 33], s[3 * 33]); o.z = pk2(s[4 * 33], s[5 * 33]); o.w = pk2(s[6 * 33], s[7 * 33]);
        *(GAS v4u*)(I.WT + (size_t)(I.row_off + n0 + n) * I.K + k0 + 8 * c) = o; }
    LDS_WAIT(); asm volatile("" ::: "memory");
}
__device__ __forceinline__ void p0_prologue(Frame& F) {
    if (F.vcu < 192) {
        LAS float* cact = (LAS float*)(F.lds + 67584);
        LAS float* red = (LAS float*)(F.lds + 67584 + 16384);
        const int l = F.vcu / 96, j0 = (F.vcu % 96) * 64;
        for (int i = F.tid; i < 4096; i += NWAVES * 64) { const float v = F.c[i]; cact[i] = v / (1.f + __expf(-v)); }
        __syncthreads();
        const int sub = F.lane >> 4, c4 = F.lane & 15;
        f32x4 a0 = {0.f, 0.f, 0.f, 0.f}, a1 = a0, a2 = a0, a3 = a0;
        const GAS float* wb = F.w_mod + (size_t)l * 1024 * 6144 + j0 + 4 * c4;
#pragma unroll 4
        for (int it = 0; it < 32; ++it) { const int k = 32 * it + 4 * F.wave + sub; const f32x4 wv = *(const GAS f32x4*)(wb + (size_t)k * 6144);
            a0 += wv * cact[k]; a1 += wv * cact[1024 + k]; a2 += wv * cact[2048 + k]; a3 += wv * cact[3072 + k]; }
#pragma unroll
        for (int j = 0; j < 4; ++j) { a0[j] += __shfl_xor(a0[j], 16); a0[j] += __shfl_xor(a0[j], 32); a1[j] += __shfl_xor(a1[j], 16); a1[j] += __shfl_xor(a1[j], 32);
            a2[j] += __shfl_xor(a2[j], 16); a2[j] += __shfl_xor(a2[j], 32); a3[j] += __shfl_xor(a3[j], 16); a3[j] += __shfl_xor(a3[j], 32); }
        if (sub == 0) { LAS f32x4* r4 = (LAS f32x4*)(red + F.wave * 256); r4[0 * 16 + c4] = a0; r4[1 * 16 + c4] = a1; r4[2 * 16 + c4] = a2; r4[3 * 16 + c4] = a3; }
        __syncthreads();
        if (F.tid < 256) { const int b = F.tid >> 6, col = F.tid & 63; float s = 0.f;
#pragma unroll
            for (int w = 0; w < 8; ++w) s += red[w * 256 + b * 64 + col];
            ((GAS float*)(F.ws + WS_MOD))[(l * 4 + b) * 6144 + j0 + col] = s + F.b_mod[l * 6144 + j0 + col]; }
    }
    LAS float* scr = (LAS float*)(F.lds + RING_OFF + F.wave * 8448);
    const int gw = F.vcu * NWAVES + F.wave, NGW = F.G * NWAVES;
    constexpr int I_POOL = 4 * 32, I_QKV = 16 * 96, I_O = 16 * 32, I_UP = 16 * 128, I_DN = 64 * 32;
    constexpr int NITEMS = I_POOL + I_QKV + I_O + 2 * I_UP + 2 * I_DN;
    auto desc = [&](int it) -> TItem {
        int r = it;
        if (r < I_POOL) { const int g = r / 32; return TItem{F.w_pool + (size_t)g * 65536, (GAS bf16*)(F.ws + WS_WPOOL), 256, 256, g * 256, r % 32}; } r -= I_POOL;
        if (r < I_QKV) return TItem{F.w_qkv, (GAS bf16*)(F.ws + WS_WQKV), D, NQKV, 0, r}; r -= I_QKV;
        if (r < I_O) return TItem{F.w_o, (GAS bf16*)(F.ws + WS_WO), D, D, 0, r}; r -= I_O;
        if (r < 2 * I_UP) { const int l = r / I_UP; return TItem{F.w_up + (size_t)l * D * FF, (GAS bf16*)(F.ws + (l ? WS_WUP1 : WS_WUP0)), D, FF, 0, r % I_UP}; } r -= 2 * I_UP;
        const int l = r / I_DN; return TItem{F.w_down + (size_t)l * FF * D, (GAS bf16*)(F.ws + (l ? WS_WDN1 : WS_WDN0)), FF, D, 0, r % I_DN};
    };
    f32x4 ta[8], tb[8];
    int it = gw;
    if (it < NITEMS) { TItem cur = desc(it); tload(cur, ta, F.lane);
        for (;;) {
            const int itn = it + NGW; const bool hn = itn < NITEMS; TItem nxt = cur;
            if (hn) { nxt = desc(itn); tload(nxt, tb, F.lane); }
            tstore(cur, ta, scr, F.lane);
            if (!hn) break;
#pragma unroll
            for (int i = 0; i < 8; ++i) ta[i] = tb[i];
            cur = nxt; it = itn;
        } }
}

__device__ __forceinline__ void p1_bias(Frame& F) {
    const int gw = F.vcu * NWAVES + F.wave, NGW = F.G * NWAVES;
    const GAS float* MOD = (const GAS float*)(F.ws + WS_MOD);
    for (int it = gw; it < 4096 + 3072 + 4096; it += NGW) {
        const GAS bf16* wt; const GAS float* sh; GAS float* dst; int n, N;
        if (it < 4096) { n = it; N = 4096; wt = (const GAS bf16*)(F.ws + WS_WUP0); sh = MOD + 3072; dst = (GAS float*)(F.ws + WS_BIAS_UP0); }
        else if (it < 4096 + 3072) { n = it - 4096; N = 3072; wt = (const GAS bf16*)(F.ws + WS_WQKV); sh = MOD + 4 * 6144; dst = (GAS float*)(F.ws + WS_BIAS_QKV); }
        else { n = it - 7168; N = 4096; wt = (const GAS bf16*)(F.ws + WS_WUP1); sh = MOD + 4 * 6144 + 3072; dst = (GAS float*)(F.ws + WS_BIAS_UP1); }
        const v4u w0 = *(const GAS v4u*)(wt + (size_t)n * 1024 + F.lane * 16), w1 = *(const GAS v4u*)(wt + (size_t)n * 1024 + F.lane * 16 + 8);
        float wf[16];
#pragma unroll
        for (int j = 0; j < 4; ++j) { wf[2 * j] = __builtin_bit_cast(float, w0[j] << 16); wf[2 * j + 1] = __builtin_bit_cast(float, w0[j] & 0xffff0000u);
            wf[8 + 2 * j] = __builtin_bit_cast(float, w1[j] << 16); wf[8 + 2 * j + 1] = __builtin_bit_cast(float, w1[j] & 0xffff0000u); }
#pragma unroll
        for (int b = 0; b < 4; ++b) { const GAS f32x4* sp = (const GAS f32x4*)(sh + b * 6144 + F.lane * 16); float s = 0.f;
#pragma unroll
            for (int j = 0; j < 4; ++j) { const f32x4 sv = sp[j]; s += wf[4 * j] * sv[0] + wf[4 * j + 1] * sv[1] + wf[4 * j + 2] * sv[2] + wf[4 * j + 3] * sv[3]; }
            s = wave_sum(s); if (F.lane == 0) dst[b * N + n] = s; }
    }
}
__device__ __forceinline__ void p1_pool(Frame& F) {
    LAS float* ring = (LAS float*)(F.lds + RING_OFF);
    const GAS float* MOD = (const GAS float*)(F.ws + WS_MOD); GAS bf16* XN = (GAS bf16*)(F.ws + WS_XNA); GAS bf16* XR = (GAS bf16*)(F.ws + WS_XR);
    for (int run = F.vcu; run < M / 128; run += F.G) {
        const int t0 = run * 128, s0 = t0 % SEQ, b = t0 / SEQ;
        f32x4 gam[4];
#pragma unroll
        for (int j = 0; j < 4; ++j) gam[j] = *(const GAS f32x4*)(F.norm_mix + 4 * (F.lane + 64 * j));
        const int c4 = F.tid & 255, rh = F.tid >> 8, gi = c4 >> 6, w = 2 << gi;
        const f32x4 sc1 = *(const GAS f32x4*)(MOD + b * 6144 + 1024 + 4 * c4) + 1.0f;
        f32x4 v[2][4];
        const GAS float* xb = F.x + (size_t)b * SEQ * D + 4 * F.lane;
        int st = (s0 > 0 ? -1 : 0);
#pragma unroll
        for (int rr = 0; rr < 2; ++rr)
#pragma unroll
            for (int j = 0; j < 4; ++j) v[rr][j] = *(const GAS f32x4*)(xb + (size_t)(s0 + 16 * st + 2 * F.wave + rr) * D + 256 * j);
        for (; st < 8; ++st) {
            if (st >= 0) {
#pragma unroll
                for (int rr = 0; rr < 2; ++rr)
#pragma unroll
                    for (int j = 0; j < 4; ++j) { v2u o2; o2.x = pk2(v[rr][j][0], v[rr][j][1]); o2.y = pk2(v[rr][j][2], v[rr][j][3]);
                        { const size_t trow = (size_t)b * SEQ + s0 + 16 * st + 2 * F.wave + rr; *(GAS v2u*)(XR + (((trow >> 8) * 4 + j) * 256 + (trow & 255)) * 256 + 4 * F.lane) = o2; } } }
            float ss0 = 0.f, ss1 = 0.f;
#pragma unroll
            for (int j = 0; j < 4; ++j) { ss0 += (v[0][j][0] * v[0][j][0] + v[0][j][1] * v[0][j][1]) + (v[0][j][2] * v[0][j][2] + v[0][j][3] * v[0][j][3]);
                ss1 += (v[1][j][0] * v[1][j][0] + v[1][j][1] * v[1][j][1]) + (v[1][j][2] * v[1][j][2] + v[1][j][3] * v[1][j][3]); }
#pragma unroll
            for (int o = 1; o < 64; o <<= 1) { ss0 += __shfl_xor(ss0, o); ss1 += __shfl_xor(ss1, o); }
            const float rs0 = rsqrtf(ss0 * (1.0f / D) + EPS), rs1 = rsqrtf(ss1 * (1.0f / D) + EPS);
            { const int sr = s0 + 16 * st + 2 * F.wave;
#pragma unroll
              for (int j = 0; j < 4; ++j) { *(LAS f32x4*)(ring + (sr & 31) * 1024 + 4 * (F.lane + 64 * j)) = v[0][j] * rs0 * gam[j]; *(LAS f32x4*)(ring + ((sr + 1) & 31) * 1024 + 4 * (F.lane + 64 * j)) = v[1][j] * rs1 * gam[j]; } }
            if (st + 1 < 8) {
#pragma unroll
                for (int rr = 0; rr < 2; ++rr)
#pragma unroll
                    for (int j = 0; j < 4; ++j) v[rr][j] = *(const GAS f32x4*)(xb + (size_t)(s0 + 16 * (st + 1) + 2 * F.wave + rr) * D + 256 * j); }
            __syncthreads();
            if (st >= 0) {
                const int sA = s0 + 16 * st + 8 * rh;
                f32x4 sum = {0.f, 0.f, 0.f, 0.f};
                { const int cnt0 = (sA < w) ? sA : w; for (int i = 1; i <= cnt0; ++i) sum += *(const LAS f32x4*)(ring + ((sA - i) & 31) * 1024 + 4 * c4); }
#pragma unroll
                for (int r = 0; r < 8; ++r) { const int s = sA + r; const f32x4 cur = *(const LAS f32x4*)(ring + (s & 31) * 1024 + 4 * c4);
                    sum += cur; if (s >= w) sum -= *(const LAS f32x4*)(ring + ((s - w) & 31) * 1024 + 4 * c4);
                    const float inv = 1.0f / (float)((s + 1 < w) ? s + 1 : w);
                    const f32x4 p = (sum * inv - cur) * sc1;
                    v2u o; o.x = pk2(p[0], p[1]); o.y = pk2(p[2], p[3]);
                    *(GAS v2u*)(XN + ((size_t)b * SEQ + s) * D + 4 * c4) = o; }
            }
            __syncthreads();
        }
    }
}

__device__ __forceinline__ int t5_bucket(int dist) {
    if (dist < 16) return dist;
    int b = 16;
    b += (dist >= 21); b += (dist >= 27); b += (dist >= 35); b += (dist >= 46); b += (dist >= 59); b += (dist >= 77); b += (dist >= 99); b += (dist >= 128);
    b += (dist >= 166); b += (dist >= 216); b += (dist >= 280); b += (dist >= 363); b += (dist >= 470); b += (dist >= 609); b += (dist >= 790);
    return b;
}
namespace att {
typedef short bf16x8 __attribute__((ext_vector_type(8)));
typedef short s16x4 __attribute__((ext_vector_type(4)));
typedef short v4i16_t __attribute__((ext_vector_type(4)));
typedef float f32x16 __attribute__((ext_vector_type(16)));
typedef float f32x2_t __attribute__((ext_vector_type(2)));
typedef __bf16 bf16x2_t __attribute__((ext_vector_type(2)));
typedef LAS const char* lds_cptr;
constexpr int L_K = 0, L_V = 32768, L_LUT = 132096, L_QI = 141312, L_CUM = 142336, L_PRE = 142592;
constexpr int LUTN = 2304;
__device__ __forceinline__ int crow(int r, int hi) { return (r & 3) + 8 * (r >> 2) + 4 * hi; }
__device__ __forceinline__ unsigned cvtpk(float lo, float hi) { f32x2_t v = {lo, hi}; bf16x2_t b = __builtin_convertvector(v, bf16x2_t); return __builtin_bit_cast(unsigned, b); }
__device__ __forceinline__ s16x4 vtr(lds_cptr p) { return __builtin_bit_cast(s16x4, __builtin_amdgcn_ds_read_tr16_b64_v4i16((LAS v4i16_t*)p)); }
__device__ __forceinline__ float swap_add(float v) { auto rr = __builtin_amdgcn_permlane32_swap(__float_as_uint(v), __float_as_uint(v), false, false); return __uint_as_float(rr[0]) + __uint_as_float(rr[1]); }

__device__ __forceinline__ void load_kv(LAS unsigned char* lds, const GAS bf16* Kb, const GAS bf16* Vb, int b, int h, int n, int w, int lane) {
#pragma unroll
    for (int t = 0; t < 4; ++t) {
        const size_t kr = (size_t)b * SEQ + n * BLK + 64 * t + lane, vr = (size_t)b * SEQ + n * BLK + 64 * t + 16 * (w & 3) + (lane >> 2);
        const v4u kv = *(const GAS v4u*)(Kb + hm_off(kr, b, h) + w * 8);
        const v4u vv = *(const GAS v4u*)(Vb + hm_off(vr, b, h) + (w >> 2) * 32 + (lane & 3) * 8);
        *(LAS v4u*)(lds + L_K + t * 8192 + w * 1024 + lane * 16) = kv;
        *(LAS v4u*)(lds + L_V + t * 8192 + w * 1024 + lane * 16) = vv;
    }
}
__device__ __forceinline__ void build_lut(LAS unsigned char* lds, const GAS float* rel_bias, int h, int tid) {
    for (int i = tid; i < LUTN; i += NWAVES * 64) ((LAS float*)(lds + L_LUT))[i] = (i <= 2047) ? rel_bias[t5_bucket(2047 - i) * NH + h] * LOG2E : 0.f;
}
__device__ __forceinline__ void qk_tile(f32x16& p0, f32x16& p1, lds_cptr Kt, const bf16x8* qr, const f32x16& cinit, int r32, int hi) {
    lds_cptr kb = Kt + hi * 1024 + r32 * 16;
#pragma unroll
    for (int d0 = 0; d0 < 4; ++d0) {
        const bf16x8 b0 = *(LAS const bf16x8*)(kb + d0 * 2048), b1 = *(LAS const bf16x8*)(kb + d0 * 2048 + 512);
        if (d0 == 0) { p0 = __builtin_amdgcn_mfma_f32_32x32x16_bf16(b0, qr[0], cinit, 0, 0, 0); p1 = __builtin_amdgcn_mfma_f32_32x32x16_bf16(b1, qr[0], cinit, 0, 0, 0); }
        else { p0 = __builtin_amdgcn_mfma_f32_32x32x16_bf16(b0, qr[d0], p0, 0, 0, 0); p1 = __builtin_amdgcn_mfma_f32_32x32x16_bf16(b1, qr[d0], p1, 0, 0, 0); }
    }
}
template <bool BIAS, bool MASK>
__device__ __forceinline__ void softmax_tile(f32x16& p0, f32x16& p1, LAS const float* lutp, int jt, int qrel, int hi, float& l, v4u* pa) {
#pragma unroll
    for (int r = 0; r < 16; ++r) { const int ko = 64 * jt + (r & 3) + 8 * (r >> 2);
        if (BIAS) { p0[r] += lutp[ko]; p1[r] += lutp[ko + 32]; }
        if (MASK) { const int kv = ko + 4 * hi; if (kv > qrel) p0[r] = -INFINITY; if (kv + 32 > qrel) p1[r] = -INFINITY; }
        p0[r] = __builtin_amdgcn_exp2f(p0[r]); p1[r] = __builtin_amdgcn_exp2f(p1[r]); }
    float s = 0.f;
#pragma unroll
    for (int r = 0; r < 16; ++r) s += p0[r] + p1[r];
    l += s;
    pa[0] = (v4u){cvtpk(p0[0], p0[1]), cvtpk(p0[2], p0[3]), cvtpk(p0[4], p0[5]), cvtpk(p0[6], p0[7])};
    pa[1] = (v4u){cvtpk(p0[8], p0[9]), cvtpk(p0[10], p0[11]), cvtpk(p0[12], p0[13]), cvtpk(p0[14], p0[15])};
    pa[2] = (v4u){cvtpk(p1[0], p1[1]), cvtpk(p1[2], p1[3]), cvtpk(p1[4], p1[5]), cvtpk(p1[6], p1[7])};
    pa[3] = (v4u){cvtpk(p1[8], p1[9]), cvtpk(p1[10], p1[11]), cvtpk(p1[12], p1[13]), cvtpk(p1[14], p1[15])};
}
__device__ __forceinline__ void pv_tile(f32x16* o, lds_cptr vp, const v4u* pa) {
#pragma unroll
    for (int d0 = 0; d0 < 2; ++d0)
#pragma unroll
        for (int ks = 0; ks < 4; ++ks) { const s16x4 lo = vtr(vp + d0 * 4096 + ks * 1024), hi = vtr(vp + d0 * 4096 + ks * 1024 + 512);
            const bf16x8 vf = (bf16x8){lo[0], lo[1], lo[2], lo[3], hi[0], hi[1], hi[2], hi[3]};
            o[d0] = __builtin_amdgcn_mfma_f32_32x32x16_bf16(vf, __builtin_bit_cast(bf16x8, pa[ks]), o[d0], 0, 0, 0); }
}
__device__ __forceinline__ void load_q_raw(bf16x8* qr, const GAS bf16* Qb, size_t qrow, int b, int h, int hi) {
#pragma unroll
    for (int d0 = 0; d0 < 4; ++d0) { const v4u v = *(const GAS v4u*)(Qb + hm_off(qrow, b, h) + d0 * 16 + hi * 8); qr[d0] = __builtin_bit_cast(bf16x8, v); }
}
__device__ __forceinline__ float q_norm2(const bf16x8* qr) {
    float q2 = 0.f;
#pragma unroll
    for (int d0 = 0; d0 < 4; ++d0) { const v4u v = __builtin_bit_cast(v4u, qr[d0]);
#pragma unroll
        for (int j = 0; j < 4; ++j) { const float a = __builtin_bit_cast(float, v[j] << 16), c = __builtin_bit_cast(float, v[j] & 0xffff0000u); q2 += a * a + c * c; } }
    return swap_add(q2);
}

__device__ __forceinline__ float ref_exponent(float q2, float kmax2, float bmax) { return __builtin_sqrtf(q2 * kmax2) * 1.002f + bmax + 0.01f; }
__device__ __forceinline__ void head_bounds(const GAS float* KBM, const GAS float* rel_bias, int bh, int h, int lane, float& kmax2, float& bmax) {
    float k = KBM[bh * 32 + (lane & 31)], bb = rel_bias[(lane & 31) * NH + h] * LOG2E;
#pragma unroll
    for (int o = 1; o < 32; o <<= 1) { k = fmaxf(k, shx(k, o, lane)); bb = fmaxf(bb, shx(bb, o, lane)); }
    kmax2 = k; bmax = bb;
}
__device__ __forceinline__ void store_row(GAS bf16* rowp, const f32x16* o, float scale, int hi, bool act) {
    unsigned w0[8], w1[8];
#pragma unroll
    for (int k = 0; k < 4; ++k) { w0[2 * k] = cvtpk(o[0][4 * k] * scale, o[0][4 * k + 1] * scale); w0[2 * k + 1] = cvtpk(o[0][4 * k + 2] * scale, o[0][4 * k + 3] * scale);
        w1[2 * k] = cvtpk(o[1][4 * k] * scale, o[1][4 * k + 1] * scale); w1[2 * k + 1] = cvtpk(o[1][4 * k + 2] * scale, o[1][4 * k + 3] * scale); }
#pragma unroll
    for (int i = 0; i < 8; ++i) { auto r = __builtin_amdgcn_permlane32_swap(w0[i], w1[i], false, false); w0[i] = r[0]; w1[i] = r[1]; }
    if (act) {
#pragma unroll
        for (int k = 0; k < 4; ++k) *(GAS v4u*)(rowp + 32 * hi + 8 * k) = (v4u){w0[2 * k], w0[2 * k + 1], w1[2 * k], w1[2 * k + 1]}; }
}
__device__ __forceinline__ void add_row(f32x16* o, const GAS bf16* rowp, int hi) {
    v4u v[4];
#pragma unroll
    for (int k = 0; k < 4; ++k) v[k] = *(const GAS v4u*)(rowp + 32 * hi + 8 * k);
#pragma unroll
    for (int k = 0; k < 4; ++k) { auto r0 = __builtin_amdgcn_permlane32_swap(v[k][0], v[k][2], false, false); auto r1 = __builtin_amdgcn_permlane32_swap(v[k][1], v[k][3], false, false);
        o[0][4 * k] += __builtin_bit_cast(float, r0[0] << 16); o[0][4 * k + 1] += __builtin_bit_cast(float, r0[0] & 0xffff0000u);
        o[0][4 * k + 2] += __builtin_bit_cast(float, r1[0] << 16); o[0][4 * k + 3] += __builtin_bit_cast(float, r1[0] & 0xffff0000u);
        o[1][4 * k] += __builtin_bit_cast(float, r0[1] << 16); o[1][4 * k + 1] += __builtin_bit_cast(float, r0[1] & 0xffff0000u);
        o[1][4 * k + 2] += __builtin_bit_cast(float, r1[1] << 16); o[1][4 * k + 3] += __builtin_bit_cast(float, r1[1] & 0xffff0000u); }
}
__device__ __forceinline__ GAS bf16* po_row(GAS unsigned char* ws, GAS float* outbuf, int b, int h, int t, int slot) {
    return (b < 2 ? (GAS bf16*)outbuf : (GAS bf16*)(ws + WS_POB)) + ((((size_t)((b & 1) * 16 + h) * SEQ + t) * 3 + slot) * 64);
}

__device__ __forceinline__ void route(Frame& F) {
    GAS unsigned char* ws = F.ws;
    const GAS bf16* Qb = (const GAS bf16*)(ws + WS_Q); const GAS bf16* Kb = (const GAS bf16*)(ws + WS_K);
    const GAS float* KMP = (const GAS float*)(ws + WS_KMP);
    GAS unsigned short* SEG = (GAS unsigned short*)(ws + WS_SEG); GAS unsigned* CNT = (GAS unsigned*)(ws + WS_CNT); GAS unsigned* TOT = (GAS unsigned*)(ws + WS_CTL) + CW_TOT;
    GAS float* KBM = (GAS float*)(ws + WS_KBM);
    int tid = F.wave * 64 + lane_id(); asm volatile("" : "+v"(tid));
    const int hf = tid >> 8, t = tid & 255, lane = tid & 63, w4 = (tid >> 6) & 3;
    LAS float* kms = (LAS float*)(F.lds + hf * 16384);
    LAS unsigned* cntw = (LAS unsigned*)(F.lds + hf * 16384 + 8192);
    LAS float* kbw = (LAS float*)(F.lds + hf * 16384 + 8192 + 512);
    for (int it = 0; it < 4; ++it) {
        const int id = it * 512 + F.vcu * 2 + hf, own = id >> 6, bh = id & 63, b = bh >> 4, h = bh & 15;
        __syncthreads();
        for (int i = t; i < NBLK * 64; i += 256) { const int n = i >> 6, d = i & 63; const size_t o = ((size_t)(b * 32 + n) * 2) * 1024 + h * 64 + d; kms[i] = (KMP[o] + KMP[o + 1024]) * (1.0f / 256.0f); }
        const size_t row = (size_t)b * SEQ + own * BLK + t;
        float q[64];
        { const GAS v4u* qp = (const GAS v4u*)(Qb + hm_off(row, b, h));
#pragma unroll
          for (int i = 0; i < 8; ++i) { const v4u v = qp[i];
#pragma unroll
              for (int j = 0; j < 4; ++j) { q[8 * i + 2 * j] = __builtin_bit_cast(float, v[j] << 16); q[8 * i + 2 * j + 1] = __builtin_bit_cast(float, v[j] & 0xffff0000u); } } }
        { const GAS v4u* kp = (const GAS v4u*)(Kb + hm_off(row, b, h)); float k2 = 0.f;
#pragma unroll
          for (int i = 0; i < 8; ++i) { const v4u v = kp[i];
#pragma unroll
              for (int j = 0; j < 4; ++j) { const float a = __builtin_bit_cast(float, v[j] << 16), c = __builtin_bit_cast(float, v[j] & 0xffff0000u); k2 += a * a + c * c; } }
#pragma unroll
          for (int o = 1; o < 64; o <<= 1) k2 = fmaxf(k2, shx(k2, o, lane));
          if (lane == 0) kbw[w4] = k2; }
        __syncthreads();
        float g1 = -INFINITY, g2 = -INFINITY, g3 = -INFINITY; int i1 = -1, i2 = -1, i3 = -1;
        for (int n = 0; n < own; ++n) {
            float g = 0.f;
#pragma unroll
            for (int d4 = 0; d4 < 16; ++d4) { const f32x4 kv = *(const LAS f32x4*)(kms + n * 64 + 4 * d4); g += q[4 * d4] * kv[0] + q[4 * d4 + 1] * kv[1] + q[4 * d4 + 2] * kv[2] + q[4 * d4 + 3] * kv[3]; }
            if (g > g1) { g3 = g2; i3 = i2; g2 = g1; i2 = i1; g1 = g; i1 = n; }
            else if (g > g2) { g3 = g2; i3 = i2; g2 = g; i2 = n; }
            else if (g > g3) { g3 = g; i3 = n; }
        }
        for (int n = 0; n < own; ++n) { const unsigned long long mm = __ballot(i1 == n || i2 == n || i3 == n); if (lane == 0) cntw[w4 * 32 + n] = (unsigned)__popcll(mm); }
        __syncthreads();
        for (int n = 0; n < own; ++n) { const bool has = (i1 == n || i2 == n || i3 == n); const unsigned long long mm = __ballot(has);
            if (has) { unsigned base = 0; for (int w = 0; w < w4; ++w) base += cntw[w * 32 + n];
                const unsigned rank = (unsigned)__popcll(mm & ((1ull << lane) - 1ull)); const unsigned slot = (i1 == n) ? 0u : (i2 == n) ? 1u : 2u;
                SEG[(((size_t)bh * 32 + own) * 32 + n) * 256 + base + rank] = (unsigned short)(t | (slot << 8)); } }
        if (t < own) { const unsigned c = cntw[t] + cntw[32 + t] + cntw[64 + t] + cntw[96 + t]; CNT[((size_t)bh * 32 + own) * 32 + t] = c; (void)__hip_atomic_fetch_add(TOT + bh * 31 + t, c, RLX_AGENT); }
        if (t == 0) KBM[bh * 32 + own] = fmaxf(fmaxf(kbw[0], kbw[1]), fmaxf(kbw[2], kbw[3]));
    }
    __syncthreads();
}

struct GTile { unsigned info; bf16x8 qr[4]; };
struct GRun { int e, c0, c1; };
__device__ __forceinline__ void dma_kv(LAS unsigned char* kv, const GAS bf16* Kb, const GAS bf16* Vb, int b, int h, int n, int w, int lane) {
#pragma unroll
    for (int t = 0; t < 4; ++t) {
        const size_t kr = (size_t)b * SEQ + n * BLK + 64 * t + lane, vr = (size_t)b * SEQ + n * BLK + 64 * t + 16 * (w & 3) + (lane >> 2);
        __builtin_amdgcn_global_load_lds((const GAS unsigned*)(Kb + hm_off(kr, b, h) + w * 8), (LAS unsigned*)(kv + L_K + t * 8192 + w * 1024), 16, 0, 0);
        __builtin_amdgcn_global_load_lds((const GAS unsigned*)(Vb + hm_off(vr, b, h) + (w >> 2) * 32 + (lane & 3) * 8), (LAS unsigned*)(kv + L_V + t * 8192 + w * 1024), 16, 0, 0);
    }
}
__device__ __forceinline__ void gather(Frame& F) {
    GAS unsigned char* ws = F.ws;
    const GAS bf16* Qb = (const GAS bf16*)(ws + WS_Q); const GAS bf16* Kb = (const GAS bf16*)(ws + WS_K); const GAS bf16* Vb = (const GAS bf16*)(ws + WS_V);
    const GAS unsigned short* SEG = (const GAS unsigned short*)(ws + WS_SEG); const GAS unsigned* CNT = (const GAS unsigned*)(ws + WS_CNT); const GAS unsigned* TOT = (const GAS unsigned*)(ws + WS_CTL) + CW_TOT;
    const GAS float* KBM = (const GAS float*)(ws + WS_KBM); GAS float* PL = (GAS float*)(ws + WS_PL);
    int tid = F.wave * 64 + lane_id(); asm volatile("" : "+v"(tid));
    const int lane = tid & 63, w = __builtin_amdgcn_readfirstlane(tid >> 6), r32 = lane & 31, hi = lane >> 5;
    LAS unsigned* pre = (LAS unsigned*)(F.lds + L_PRE);
    __syncthreads();
    if (w == 0) { unsigned loc = 0;
        for (int i = 0; i < 31; ++i) { const unsigned nc = (TOT[31 * lane + i] + 255u) >> 8; loc += nc + (nc ? 1u : 0u); }
        unsigned inc = loc;
#pragma unroll
        for (int o = 1; o < 64; o <<= 1) { const unsigned v = shup(inc, o, lane); if (lane >= o) inc += v; }
        unsigned run = inc - loc;
        for (int i = 0; i < 31; ++i) { pre[31 * lane + i] = run; const unsigned nc = (TOT[31 * lane + i] + 255u) >> 8; run += nc + (nc ? 1u : 0u); }
        if (lane == 63) pre[1984] = run; }
    __syncthreads();
    const int U = (int)pre[1984];
    int p = (int)(((long)F.vcu * U) / F.G); const int phi = (int)(((long)(F.vcu + 1) * U) / F.G);
    int e = 0; { int lo = 0, hi2 = 1984; while (hi2 - lo > 1) { const int mid = (lo + hi2) >> 1; if ((int)pre[mid] <= p) lo = mid; else hi2 = mid; } e = lo; }
    auto next_run = [&](GRun& R) -> bool {
        while (p < phi) {
            while (p >= (int)pre[e + 1]) ++e;
            const int k = p - (int)pre[e], nch = (int)pre[e + 1] - (int)pre[e] - 1;
            const int c0 = k > 0 ? k - 1 : 0; int c1 = phi - (int)pre[e] - 1; c1 = c1 < nch ? c1 : nch;
            p = (int)pre[e] + 1 + c1;
            if (c1 > c0) { R.e = e; R.c0 = c0; R.c1 = c1; return true; }
        }
        return false;
    };
    auto scan_cnt = [&](unsigned v) -> unsigned { unsigned inc = v;
#pragma unroll
        for (int o = 1; o < 32; o <<= 1) { const unsigned t2 = shup(inc, o, lane); if ((lane & 31) >= o) inc += t2; }
        return inc; };
    int cur_h = -1, cur_bh = -1, rb = 0; float kmax2 = 0.f, bmax = 0.f, rb31 = 0.f;
    GRun cur, nxt; bool hc = next_run(cur);
    unsigned cntN = 0, totN = 0, cumv = 0, tot = 0;
    if (hc) { const int bh = cur.e / 31, n = cur.e - bh * 31; dma_kv(F.lds, Kb, Vb, bh >> 4, bh & 15, n, w, lane);
        cntN = ((lane & 31) > n) ? CNT[((size_t)bh * 32 + (lane & 31)) * 32 + n] : 0u; totN = TOT[cur.e]; }
    GTile tcur, tnxt; unsigned ownB = 0, entB = 0xffffffffu; bool mine = false;
    auto fetch_ent = [&](int c, bool valid, int n, const GAS unsigned short* segb, unsigned cv, unsigned tt, unsigned& own_o) -> unsigned {
        const unsigned g0 = 256u * c + 32u * w, g = g0 + r32;
        const bool tile_ok = valid && g0 < tt;
        unsigned own = (unsigned)(n + 1), base = 0u;
        if (tile_ok) {
            int lo = n + 1, hi2 = 32;
            while (hi2 - lo > 1) { const int mid = (lo + hi2) >> 1; if (__builtin_amdgcn_readlane(cv, mid - 1) <= g0) lo = mid; else hi2 = mid; }
            own = (unsigned)lo; base = (lo == n + 1) ? 0u : __builtin_amdgcn_readlane(cv, lo - 1);
            for (int o = lo + 1; o < 32; ++o) { const unsigned s2 = __builtin_amdgcn_readlane(cv, o - 1); if (s2 > g0 + 31u) break; if (s2 <= g) { own = (unsigned)o; base = s2; } }
        }
        const bool lane_ok = tile_ok && g < tt;
        const unsigned idx = lane_ok ? (g - base) : 0u;
        const unsigned v = (unsigned)segb[(size_t)own * 32 * 256 + idx];
        own_o = own;
        return lane_ok ? v : 0xffffffffu;
    };
    auto make_tile = [&](unsigned ent, unsigned own, int b, int h, int n, GTile& T) {
        const bool act = ent != 0xffffffffu;
        const int tq = act ? (int)(own * BLK + (ent & 255u)) : SEQ - 1;
        T.info = (unsigned)tq | (act ? (((ent >> 8) & 3u) << 16) | (1u << 18) | ((own - n <= 4) ? (1u << 19) : 0u) : 0u);
        load_q_raw(T.qr, Qb, (size_t)b * SEQ + tq, b, h, hi);
    };
    auto start_run = [&](const GRun& R) {
        const int bh = R.e / 31, n = R.e - bh * 31; const GAS unsigned short* segb = SEG + ((size_t)bh * 32 * 32 + n) * 256;
        cumv = scan_cnt(cntN); tot = totN;
        mine = (unsigned)(256 * R.c0 + 32 * w) < tot;
        entB = 0xffffffffu; ownB = 0;
        if (mine) { unsigned ownA; const unsigned entA = fetch_ent(R.c0, true, n, segb, cumv, tot, ownA); make_tile(entA, ownA, bh >> 4, bh & 15, n, tcur);
            entB = fetch_ent(R.c0 + 1, R.c0 + 1 < R.c1, n, segb, cumv, tot, ownB); }
    };
    if (hc) start_run(cur);
    while (hc) {
        const bool hn = next_run(nxt);
        const int c0 = cur.c0, c1 = cur.c1, bh = cur.e / 31, n = cur.e - bh * 31, b = bh >> 4, h = bh & 15;
        const GAS unsigned short* segb = SEG + ((size_t)bh * 32 * 32 + n) * 256;
        LAS unsigned char* kv = F.lds + rb * 65536;
        __builtin_amdgcn_s_waitcnt(0x0F70);
        __syncthreads();
        if (hn) { const int bh2 = nxt.e / 31, n2 = nxt.e - bh2 * 31;
            cntN = ((lane & 31) > n2) ? CNT[((size_t)bh2 * 32 + (lane & 31)) * 32 + n2] : 0u; totN = TOT[nxt.e]; }
        if (bh != cur_bh) { head_bounds(KBM, F.rel_bias, bh, h, lane, kmax2, bmax); rb31 = F.rel_bias[31 * NH + h] * LOG2E; cur_bh = bh;
            if (h != cur_h) { build_lut(F.lds, F.rel_bias, h, tid); cur_h = h; __syncthreads(); } }
        const lds_cptr Kl = (lds_cptr)(kv + L_K), vp0 = (lds_cptr)(kv + L_V) + ((lane >> 4) & 1) * 32 + (lane & 3) * 8 + (4 * hi + ((lane & 15) >> 2)) * 64;
        if (mine) for (int c = c0; c < c1; ++c) {
            if ((unsigned)(256 * c + 32 * w) >= tot) break;
            make_tile(entB, ownB, b, h, n, tnxt);
            entB = fetch_ent(c + 2, c + 2 < c1, n, segb, cumv, tot, ownB);
            const unsigned info = tcur.info; const int tq = (int)(info & 0xffffu); const bool near = (info >> 19) & 1u;
            const float mref = ref_exponent(q_norm2(tcur.qr), kmax2, bmax);
            const bool anynear = __any(near);
            const int tqrel = near ? (tq - n * BLK) : 1755;
            LAS const float* lutp = (LAS const float*)(F.lds + L_LUT) + (2047 - tqrel + 4 * hi);
            f32x16 cinit; { const float cc = anynear ? -mref : (rb31 - mref);
#pragma unroll
                for (int r = 0; r < 16; ++r) cinit[r] = cc; }
            f32x16 o[2]; o[0] = f32x16{}; o[1] = f32x16{}; float l = 0.f;
            { f32x16 pA0, pA1, pB0, pB1; v4u pa[4];
              qk_tile(pA0, pA1, Kl, tcur.qr, cinit, r32, hi);
#pragma unroll
              for (int j = 0; j < 4; ++j) {
                if (j < 3) qk_tile(pB0, pB1, Kl + (j + 1) * 8192, tcur.qr, cinit, r32, hi);
                if (anynear) softmax_tile<true, false>(pA0, pA1, lutp, j, 0, hi, l, pa); else softmax_tile<false, false>(pA0, pA1, lutp, j, 0, hi, l, pa);
                pv_tile(o, vp0 + j * 8192, pa);
                pA0 = pB0; pA1 = pB1; } }
            l = swap_add(l);
            { const bool act = (info >> 18) & 1u; const int slot = (int)((info >> 16) & 3u);
              GAS bf16* dump = (GAS bf16*)(ws + WS_DUMP) + (size_t)F.vcu * 4096 + lane * 64;
              store_row(act ? po_row(ws, F.out, b, h, tq, slot) : dump - 32 * hi, o, 1.0f, hi, true);
              GAS float* plp = act ? PL + (((size_t)bh * SEQ + tq) * 3) + slot : (GAS float*)dump;
              *plp = l; }
            tcur = tnxt;
        }
        if (hn) { start_run(nxt);
            const int bh2 = nxt.e / 31, n2 = nxt.e - bh2 * 31; dma_kv(F.lds + (rb ^ 1) * 65536, Kb, Vb, bh2 >> 4, bh2 & 15, n2, w, lane); }
        cur = nxt; hc = hn; rb ^= 1;
    }
    asm volatile("s_waitcnt vmcnt(0)" ::: "memory");
    __syncthreads();
}

__device__ __forceinline__ void own_block(Frame& F) {
    GAS unsigned char* ws = F.ws;
    const GAS bf16* Qb = (const GAS bf16*)(ws + WS_Q); const GAS bf16* Kb = (const GAS bf16*)(ws + WS_K); const GAS bf16* Vb = (const GAS bf16*)(ws + WS_V); GAS bf16* Ob = (GAS bf16*)(ws + WS_O);
    const GAS float* KBM = (const GAS float*)(ws + WS_KBM); const GAS float* PL = (const GAS float*)(ws + WS_PL);
    int tid = F.wave * 64 + lane_id(); asm volatile("" : "+v"(tid));
    const int lane = tid & 63, w = __builtin_amdgcn_readfirstlane(tid >> 6), r32 = lane & 31, hi = lane >> 5;
    const int bh = F.vcu & 63, b = bh >> 4, h = bh & 15, own0 = F.vcu >> 6, nun = (NBLK - own0 + 3) / 4;
    __syncthreads();
    build_lut(F.lds, F.rel_bias, h, tid);
    float kmax2, bmax; head_bounds(KBM, F.rel_bias, bh, h, lane, kmax2, bmax);
    const int qrel = 32 * w + r32;
    LAS const float* lutp = (LAS const float*)(F.lds + L_LUT) + (2047 - qrel + 4 * hi);
    const int jd = w >> 1;
    bf16x8 qn[4];
    dma_kv(F.lds, Kb, Vb, b, h, own0, w, lane);
    load_q_raw(qn, Qb, (size_t)b * SEQ + own0 * BLK + qrel, b, h, hi);
    for (int i = 0; i < nun; ++i) {
        const int own = own0 + 4 * i; const size_t qrow = (size_t)b * SEQ + own * BLK + qrel;
        LAS unsigned char* kv = F.lds + (i & 1) * 65536;
        bf16x8 qr[4];
#pragma unroll
        for (int d0 = 0; d0 < 4; ++d0) qr[d0] = qn[d0];
        asm volatile("s_waitcnt vmcnt(0)" ::: "memory");
        __syncthreads();
        if (i + 1 < nun) { dma_kv(F.lds + ((i + 1) & 1) * 65536, Kb, Vb, b, h, own + 4, w, lane); load_q_raw(qn, Qb, qrow + 4 * BLK, b, h, hi); }
        const float mref = ref_exponent(q_norm2(qr), kmax2, bmax);
        f32x16 cinit;
#pragma unroll
        for (int r = 0; r < 16; ++r) cinit[r] = -mref;
        f32x16 o[2]; o[0] = f32x16{}; o[1] = f32x16{}; float l = 0.f;
        const lds_cptr Kl = (lds_cptr)(kv + L_K), vp0 = (lds_cptr)(kv + L_V) + ((lane >> 4) & 1) * 32 + (lane & 3) * 8 + (4 * hi + ((lane & 15) >> 2)) * 64;
        for (int j = 0; j <= jd; ++j) { f32x16 p0, p1; v4u pa[4];
            qk_tile(p0, p1, Kl + j * 8192, qr, cinit, r32, hi);
            if (j == jd) softmax_tile<true, true>(p0, p1, lutp, j, qrel, hi, l, pa); else softmax_tile<true, false>(p0, p1, lutp, j, qrel, hi, l, pa);
            pv_tile(o, vp0 + j * 8192, pa); }
        l = swap_add(l);
        const int nsl = own < 3 ? own : 3; const int tq = own * BLK + qrel;
        for (int sl = 0; sl < nsl; ++sl) { add_row(o, po_row(ws, F.out, b, h, tq, sl), hi); l += PL[(((size_t)bh * SEQ + tq) * 3) + sl]; }
        store_row(Ob + qrow * D + h * 64, o, 1.0f / l, hi, true);
    }
    asm volatile("s_waitcnt vmcnt(0)" ::: "memory");
    __syncthreads();
}
}

__device__ __forceinline__ void final_norm(Frame& Fr) {
    struct { int lane, vcu, wave, G; const GAS float* norm_final; GAS float* out; } F{Fr.wave * 64 + lane_id(), Fr.vcu, Fr.wave, Fr.G, Fr.norm_final, Fr.out};
    asm volatile("" : "+v"(F.lane)); F.lane &= 63;
    const int gw = F.vcu * NWAVES + F.wave, NGW = F.G * NWAVES;
    f32x4 gam[4];
#pragma unroll
    for (int j = 0; j < 4; ++j) gam[j] = *(const GAS f32x4*)(F.norm_final + 4 * (F.lane + 64 * j));
    for (int row = gw; row < M; row += NGW) { GAS float* xr = F.out + (size_t)row * D; f32x4 v[4]; float ss = 0.f;
#pragma unroll
        for (int j = 0; j < 4; ++j) { v[j] = *(const GAS f32x4*)(xr + 4 * (F.lane + 64 * j)); ss += (v[j][0] * v[j][0] + v[j][1] * v[j][1]) + (v[j][2] * v[j][2] + v[j][3] * v[j][3]); }
#pragma unroll
        for (int o = 1; o < 64; o <<= 1) ss += shx(ss, o, F.lane);
        const float rstd = rsqrtf(ss * (1.0f / D) + EPS);
#pragma unroll
        for (int j = 0; j < 4; ++j) *(GAS f32x4*)(xr + 4 * (F.lane + 64 * j)) = v[j] * rstd * gam[j]; }
}

__global__ void __launch_bounds__(NWAVES * 64, 2) fwd_megakernel(Args args) {
    __shared__ __attribute__((aligned(16))) unsigned char lds[LDS_BYTES];
    Frame F;
    F.lds = (LAS unsigned char*)lds;
    F.tid = threadIdx.x; F.lane = F.tid & 63; F.wave = __builtin_amdgcn_readfirstlane(F.tid >> 6);
    F.G = gridDim.x; { const int bx = blockIdx.x; F.vcu = (F.G % 8 == 0) ? (bx % 8) * (F.G / 8) + bx / 8 : bx; }
    F.x = args.in[0]; F.c = args.in[1]; F.rel_bias = args.in[2]; F.w_mod = args.in[3]; F.b_mod = args.in[4]; F.norm_mix = args.in[5]; F.norm_mlp = args.in[6];
    F.w_pool = args.in[7]; F.pool_scale = args.in[8]; F.w_qkv = args.in[9]; F.w_o = args.in[10]; F.w_up = args.in[11]; F.w_down = args.in[12]; F.norm_final = args.in[13];
    F.out = args.out; F.ws = args.ws;
    volatile LAS unsigned* MISC = (volatile LAS unsigned*)(F.lds + MISC_OFF);
    for (int u = F.tid; u < (LDS_BYTES - LDSCTL_OFF) / 4; u += NWAVES * 64) ((LAS unsigned*)(F.lds + LDSCTL_OFF))[u] = 0u;
    __syncthreads();
    gu32* ctl = (gu32*)(F.ws + WS_CTL);
    XcdBarrier bar = xcd_barrier_post((GAS unsigned*)(ctl + CW_BAR), MISC + 8); bar.wave = F.wave;
    GAS unsigned char* ws = F.ws;
#define WSB(off) ((GAS bf16*)(ws + (off)))
#define WSF(off) ((GAS float*)(ws + (off)))

    p0_prologue(F);
    xcd_barrier(bar);
    p1_bias(F); p1_pool(F);
    xcd_barrier(bar);

    for (int ph = 0; ph < 10; ++ph) {
        asm volatile("" : "+s"(ws));
        const GAS float* MOD = WSF(WS_MOD); GAS float* SS = WSF(WS_SS);
        const int kind = (ph == 0 || ph == 2 || ph == 7) ? 0 : (ph == 1 || ph == 8) ? 1 : (ph == 3) ? 2 : (ph == 4) ? 3 : (ph == 5) ? 4 : (ph == 6) ? 5 : 7;
        if (kind == 0) {
            pg8::Gemm g; pg8::EpiRes E;
            if (ph == 0) { g = pg8::Gemm{WSB(WS_XNA), WSB(WS_WPOOL), M, D, 256, D, 256, 512};
                E = pg8::EpiRes{WSB(WS_XR), WSB(WS_XR), MOD + 2048, F.pool_scale, F.norm_mlp, MOD + 4096, WSB(WS_XNB), SS}; }
            else if (ph == 2) { g = pg8::Gemm{WSB(WS_HB), WSB(WS_WDN0), M, D, FF, 256, 0, 131072};
                E = pg8::EpiRes{WSB(WS_XR), WSB(WS_XR), MOD + 5120, nullptr, F.norm_mix + D, MOD + 4 * 6144 + 1024, WSB(WS_XNA), SS}; }
            else { g = pg8::Gemm{WSB(WS_O), WSB(WS_WO), M, D, D, D, 0, 512};
                E = pg8::EpiRes{WSB(WS_XR), WSB(WS_XR), MOD + 4 * 6144 + 2048, nullptr, F.norm_mlp + D, MOD + 4 * 6144 + 4096, WSB(WS_XNB), SS}; }
            pg8::StaticOrder S; S.init(M, D, F.G, (int)blockIdx.x);
            pg8::gemm_phase<pg8::EpiRes, pg8::StaticOrder, true>(F.lds + RING_OFF, g, S, E, F.wave);
        } else if (kind == 1) {
            const pg8::Gemm g{WSB(WS_XNB), WSB(ph == 1 ? WS_WUP0 : WS_WUP1), M, FF, D, 256, 0, 131072};
            const pg8::EpiUp E{SS, WSF(ph == 1 ? WS_BIAS_UP0 : WS_BIAS_UP1), WSB(WS_HB), FF, F.lds, 0};
            pg8::StaticOrder S; S.init(M, FF, F.G, (int)blockIdx.x);
            pg8::gemm_phase<pg8::EpiUp, pg8::StaticOrder, true>(F.lds + RING_OFF, g, S, E, F.wave);
        } else if (kind == 2) {
            const pg8::Gemm g{WSB(WS_XNA), WSB(WS_WQKV), M, NQKV, D, 256, 0, 131072};
            const pg8::EpiQKV E{SS, WSF(WS_BIAS_QKV), WSB(WS_Q), (size_t)(WS_K - WS_Q) / 2, WSF(WS_KMP), F.lds, 0};
            pg8::StaticOrder S; S.init(M, NQKV, F.G, (int)blockIdx.x);
            pg8::gemm_phase<pg8::EpiQKV, pg8::StaticOrder, true>(F.lds + RING_OFF, g, S, E, F.wave);
        } else if (kind == 3) { F.ws = ws; att::route(F);
        } else if (kind == 4) { F.ws = ws; att::gather(F);
        } else if (kind == 5) { F.ws = ws; att::own_block(F);
        } else {
            const pg8::Gemm g{WSB(WS_HB), WSB(WS_WDN1), M, D, FF, 256, 0, 131072};
            const pg8::EpiFinal E{WSB(WS_XR), F.out, MOD + 4 * 6144 + 5120, F.norm_final, SS, (GAS unsigned*)(ws + WS_CTL) + CW_FIN};
            pg8::StaticOrder S; S.init(M, D, F.G, (int)blockIdx.x);
            pg8::gemm_phase<pg8::EpiFinal, pg8::StaticOrder, true>(F.lds + RING_OFF, g, S, E, F.wave);
            break;
        }
        xcd_barrier(bar);
    }
}

extern "C" void kernel_launch(void* const* d_in, const int* in_sizes, int n_in, void* d_out, int out_size, void* d_ws, size_t ws_size, hipStream_t stream) {
    static int grid = 0;
    if (grid == 0) {
        if (n_in != 14 || in_sizes[0] != M * D || out_size != M * D || ws_size < WS_END) { fprintf(stderr, "kernel_launch: unexpected shapes / workspace (n_in %d, in0 %d, out %d, ws %zu)\n", n_in, n_in > 0 ? in_sizes[0] : -1, out_size, ws_size); grid = -1; return; }
        int dev = 0, cus = 0, per_cu = 0;
        if (hipGetDevice(&dev) != hipSuccess || hipDeviceGetAttribute(&cus, hipDeviceAttributeMultiprocessorCount, dev) != hipSuccess) { grid = -1; return; }
        if (hipOccupancyMaxActiveBlocksPerMultiprocessor(&per_cu, (const void*)fwd_megakernel, NWAVES * 64, 0) != hipSuccess || per_cu < 1) { fprintf(stderr, "kernel_launch: occupancy query says %d blocks per CU\n", per_cu); }
        (void)hipGetLastError();
        grid = cus;
    }
    if (grid < 0) return;
    if (hipMemsetAsync((char*)d_ws + WS_CTL, 0, CTL_ZERO_BYTES, stream) != hipSuccess) return;
    Args a{};
    for (int i = 0; i < 14; ++i) a.in[i] = (const GAS float*)d_in[i];
    a.out = (GAS float*)d_out; a.ws = (GAS unsigned char*)d_ws;
    hipLaunchKernelGGL(fwd_megakernel, dim3(grid), dim3(NWAVES * 64), 0, stream, a);
}
```

```cpp
#include <hip/hip_runtime.h>
#include <utility>
#include <cstdio>
#include <cstdint>

__device__ __forceinline__ float shx(float v, int m, int lane) { return __builtin_bit_cast(float, __builtin_amdgcn_ds_bpermute((lane ^ m) << 2, __builtin_bit_cast(int, v))); }
__device__ __forceinline__ unsigned shup(unsigned v, int o, int lane) { return (unsigned)__builtin_amdgcn_ds_bpermute(((lane - o) & 63) << 2, (int)v); }
__device__ __forceinline__ size_t hm_off(size_t row, int b, int h) { return (row + (size_t)(15 * b + h) * 8192) * 64; }
__device__ __forceinline__ int lane_id() { unsigned z = 0u; asm volatile("" : "+s"(z)); return (int)__builtin_amdgcn_mbcnt_hi(~0u, __builtin_amdgcn_mbcnt_lo(~0u, z)); }

namespace pg8 {
#define PG8_LAS __attribute__((address_space(3)))
#define PG8_GAS __attribute__((address_space(1)))
typedef unsigned short bf16_t;
typedef short bf16x8 __attribute__((ext_vector_type(8)));
typedef float f32x4 __attribute__((ext_vector_type(4)));
typedef unsigned u32x4 __attribute__((ext_vector_type(4)));
constexpr int BM = 256, BK = 64, HALF = 128, HTB = HALF * BK * 2, STAGE_BYTES = 8 * HTB, NXCD = 8, WGM = 8;

__host__ __device__ __forceinline__ int lds_byte(int r, int c) { const int st = (r >> 4) * 2 + (c >> 5), rr = r & 15, cc = c & 31, ob = rr * 64 + cc * 2; return st * 1024 + (ob ^ (((ob >> 9) & 1) << 5)); }
__host__ __device__ __forceinline__ void stage_rc(int b, int& R, int& C) { const int st = b / 1024, sb = b % 1024, swz = sb ^ (((sb >> 9) & 1) << 5); R = (st >> 1) * 16 + swz / 64; C = (st & 1) * 32 + (swz % 64) / 2; }
__host__ __device__ __forceinline__ int perm32(int rho) { const int n = rho >> 4, i = rho & 15; return 8 * (i >> 2) + 4 * n + (i & 3); }

struct Unit { int pm, pn; };
struct Gemm { const PG8_GAS bf16_t* A; const PG8_GAS bf16_t* Bt; int M, N, K, lda, a_pn_off, a_tileb; };

struct StaticOrder {
    int nM, nN, nwg, G, c;
    __host__ __device__ void init(int M, int N, int G_, int c_) { nM = M / BM; nN = N / BM; nwg = nM * nN; G = G_; c = c_; }
    __host__ __device__ bool next(int i, Unit& u) const {
        const long L = (long)i * G + c; if (L >= nwg) return false;
        int wgid = (int)L; { const int q = nwg / NXCD, r = nwg % NXCD, xcd = wgid % NXCD, off = wgid / NXCD; wgid = (xcd < r ? xcd * (q + 1) : r * (q + 1) + (xcd - r) * q) + off; }
        const int nig = WGM * nN, gid = wgid / nig, fm = gid * WGM, gsz = (nM - fm) < WGM ? (nM - fm) : WGM;
        u.pm = fm + ((wgid % nig) % gsz); u.pn = (wgid % nig) / gsz; return true;
    }
};

__device__ __forceinline__ unsigned cvt_pk_bf16(float lo, float hi) { unsigned r; asm volatile("v_cvt_pk_bf16_f32 %0, %1, %2" : "=v"(r) : "v"(lo), "v"(hi)); return r; }

constexpr int SEQ_ = 8192;
constexpr float EPS_ = 1e-6f;
constexpr float C2_ = 0.125f * 1.4426950408889634f;


__device__ __forceinline__ float row_rstd(const PG8_GAS float* SS, int row, int fq, int fr) {
    const f32x4 s4 = *(const PG8_GAS f32x4*)(SS + (size_t)row * 16 + 4 * fq);
    float s = (s4[0] + s4[1]) + (s4[2] + s4[3]);
    const int ln = fq * 16 + fr; s += shx(s, 16, ln); s += shx(s, 32, ln);
    return rsqrtf(s * (1.0f / 1024.0f) + EPS_);
}

constexpr int RSTD_TAB_OFF = 132096;
__device__ __forceinline__ void fill_rstd_tab(PG8_LAS unsigned char* ldsbase, int par, const PG8_GAS float* SS, int pm, int wid, int lane) {
    if (lane < 32) { const int r = wid * 32 + lane; const PG8_GAS f32x4* p = (const PG8_GAS f32x4*)(SS + (size_t)(pm * BM + r) * 16);
        const f32x4 a = p[0], b = p[1], c = p[2], d = p[3];
        const float g0 = (a[0] + a[1]) + (a[2] + a[3]), g1 = (b[0] + b[1]) + (b[2] + b[3]), g2 = (c[0] + c[1]) + (c[2] + c[3]), g3 = (d[0] + d[1]) + (d[2] + d[3]);
        ((PG8_LAS float*)(ldsbase + RSTD_TAB_OFF + par * 1024))[r] = rsqrtf(((g0 + g1) + (g2 + g3)) * (1.0f / 1024.0f) + EPS_); }
}
__device__ __forceinline__ f32x4 bf_lo4(const u32x4& w) { return (f32x4){__builtin_bit_cast(float, w.x << 16), __builtin_bit_cast(float, w.x & 0xffff0000u), __builtin_bit_cast(float, w.y << 16), __builtin_bit_cast(float, w.y & 0xffff0000u)}; }
__device__ __forceinline__ f32x4 bf_hi4(const u32x4& w) { return (f32x4){__builtin_bit_cast(float, w.z << 16), __builtin_bit_cast(float, w.z & 0xffff0000u), __builtin_bit_cast(float, w.w << 16), __builtin_bit_cast(float, w.w & 0xffff0000u)}; }
struct EpiRes {
    static constexpr bool PERM = true, NEEDS_RSTD = false;
    const PG8_GAS bf16_t* Rb; PG8_GAS bf16_t* Xb; const PG8_GAS float* gate; const PG8_GAS float* cscale; const PG8_GAS float* gnext; const PG8_GAS float* scn; PG8_GAS bf16_t* XN; PG8_GAS float* SS;
    __device__ __forceinline__ void operator()(f32x4 (&acc)[2][2][4][2], const Unit& u, int wr, int wc, int fr, int fq) const {
        const int b = u.pm >> 5, colb = u.pn * BM + wc * 32 + 8 * fq, row0 = u.pm * BM + wr * 64 + fr;
        float ssq[2][4];
#pragma unroll
        for (int bj = 0; bj < 2; ++bj) {
            f32x4 gt[2], cs[2];
#pragma unroll
            for (int n = 0; n < 2; ++n) { const int col = colb + bj * HALF + 4 * n;
                f32x4 gv = *(const PG8_GAS f32x4*)(gate + b * 6144 + col); if (cscale) gv = gv * *(const PG8_GAS f32x4*)(cscale + col); gt[n] = gv;
                const f32x4 sc = *(const PG8_GAS f32x4*)(scn + b * 6144 + col); cs[n] = *(const PG8_GAS f32x4*)(gnext + col) * (sc + 1.0f); }
#pragma unroll
            for (int ai = 0; ai < 2; ++ai)
#pragma unroll
                for (int m = 0; m < 4; ++m) { const size_t off = ((size_t)(u.pm * 4 + u.pn) * 256 + (wr * 64 + fr + ai * HALF + m * 16)) * 256 + (wc * 32 + 8 * fq + bj * HALF);
                    const u32x4 rw = *(const PG8_GAS u32x4*)(Rb + off); const f32x4 r0 = bf_lo4(rw), r1 = bf_hi4(rw);
                    const f32x4 y0 = r0 + gt[0] * acc[ai][bj][m][0], y1 = r1 + gt[1] * acc[ai][bj][m][1];
                    u32x4 xw; xw.x = cvt_pk_bf16(y0[0], y0[1]); xw.y = cvt_pk_bf16(y0[2], y0[3]); xw.z = cvt_pk_bf16(y1[0], y1[1]); xw.w = cvt_pk_bf16(y1[2], y1[3]);
                    *(PG8_GAS u32x4*)(Xb + off) = xw;
                    const f32x4 x0 = bf_lo4(xw), x1 = bf_hi4(xw);
                    const float q = (x0[0] * x0[0] + x0[1] * x0[1]) + (x0[2] * x0[2] + x0[3] * x0[3]) + (x1[0] * x1[0] + x1[1] * x1[1]) + (x1[2] * x1[2] + x1[3] * x1[3]);
                    ssq[ai][m] = (bj == 0) ? q : ssq[ai][m] + q;
                    const f32x4 a0 = x0 * cs[0], a1 = x1 * cs[1]; u32x4 w; w.x = cvt_pk_bf16(a0[0], a0[1]); w.y = cvt_pk_bf16(a0[2], a0[3]); w.z = cvt_pk_bf16(a1[0], a1[1]); w.w = cvt_pk_bf16(a1[2], a1[3]);
                    *(PG8_GAS u32x4*)(XN + off) = w;
                }
        }
#pragma unroll
        for (int ai = 0; ai < 2; ++ai)
#pragma unroll
            for (int m = 0; m < 4; ++m) { float q = ssq[ai][m]; q += shx(q, 16, fq * 16 + fr); q += shx(q, 32, fq * 16 + fr); if (fq == 0) SS[(size_t)(row0 + ai * HALF + m * 16) * 16 + u.pn * 4 + wc] = q; }
    }
};

struct EpiFinal {
    static constexpr bool PERM = true, NEEDS_RSTD = false;
    const PG8_GAS bf16_t* R; PG8_GAS float* OUT; const PG8_GAS float* gate; const PG8_GAS float* gfin; PG8_GAS float* SS; PG8_GAS unsigned* cnt;
    __device__ __forceinline__ void operator()(f32x4 (&acc)[2][2][4][2], const Unit& u, int wr, int wc, int fr_, int fq_) const {
        int fr = fr_, fq = fq_; asm volatile("" : "+v"(fr), "+v"(fq));
        const int b = u.pm >> 5, colb = u.pn * BM + wc * 32 + 8 * fq, row0 = u.pm * BM + wr * 64 + fr, ln = fq * 16 + fr;
        float ssq[2][4];
#pragma unroll
        for (int bj = 0; bj < 2; ++bj) {
            const f32x4 gt0 = *(const PG8_GAS f32x4*)(gate + b * 6144 + colb + bj * HALF), gt1 = *(const PG8_GAS f32x4*)(gate + b * 6144 + colb + bj * HALF + 4);
#pragma unroll
            for (int ai = 0; ai < 2; ++ai)
#pragma unroll
                for (int m = 0; m < 4; ++m) { const size_t off = (size_t)(row0 + ai * HALF + m * 16) * 1024 + colb + bj * HALF;
                    const u32x4 rw = *(const PG8_GAS u32x4*)(R + ((size_t)(u.pm * 4 + u.pn) * 256 + (wr * 64 + fr + ai * HALF + m * 16)) * 256 + (wc * 32 + 8 * fq + bj * HALF));
                    const f32x4 x0 = bf_lo4(rw) + gt0 * acc[ai][bj][m][0], x1 = bf_hi4(rw) + gt1 * acc[ai][bj][m][1];
                    acc[ai][bj][m][0] = x0; acc[ai][bj][m][1] = x1;
                    const float q = (x0[0] * x0[0] + x0[1] * x0[1]) + (x0[2] * x0[2] + x0[3] * x0[3]) + (x1[0] * x1[0] + x1[1] * x1[1]) + (x1[2] * x1[2] + x1[3] * x1[3]);
                    ssq[ai][m] = (bj == 0) ? q : ssq[ai][m] + q;
                    asm volatile("" : "+v"(acc[ai][bj][m][0]), "+v"(acc[ai][bj][m][1]), "+v"(ssq[ai][m]));
                    if (m & 1) asm volatile("" ::: "memory"); }
        }
#pragma unroll
        for (int ai = 0; ai < 2; ++ai)
#pragma unroll
            for (int m = 0; m < 4; ++m) { float q = ssq[ai][m]; q += shx(q, 16, ln); q += shx(q, 32, ln);
                if (fq == 0) __hip_atomic_store(SS + (size_t)(row0 + ai * HALF + m * 16) * 16 + u.pn * 4 + wc, q, __ATOMIC_RELAXED, __HIP_MEMORY_SCOPE_AGENT); }
        asm volatile("s_waitcnt vmcnt(0)" ::: "memory");
        PG8_GAS unsigned* c = cnt + 64 * u.pm;
        if (ln == 0) (void)__hip_atomic_fetch_add(c, 1u, __ATOMIC_RELAXED, __HIP_MEMORY_SCOPE_AGENT);
        for (unsigned sp = 0; sp < (1u << 22); ++sp) { if ((unsigned)__builtin_amdgcn_readfirstlane((int)__hip_atomic_load(c, __ATOMIC_RELAXED, __HIP_MEMORY_SCOPE_AGENT)) >= 32u) break; __builtin_amdgcn_s_sleep(2); }
        int row1 = row0, colc = colb; asm volatile("" : "+v"(row1), "+v"(colc));
        float rs[2][4];
#pragma unroll
        for (int ai = 0; ai < 2; ++ai)
#pragma unroll
            for (int m = 0; m < 4; ++m) { const PG8_GAS float* sp4 = SS + (size_t)(row1 + ai * HALF + m * 16) * 16 + 4 * fq;
                float t = (__hip_atomic_load(sp4, __ATOMIC_RELAXED, __HIP_MEMORY_SCOPE_AGENT) + __hip_atomic_load(sp4 + 1, __ATOMIC_RELAXED, __HIP_MEMORY_SCOPE_AGENT))
                        + (__hip_atomic_load(sp4 + 2, __ATOMIC_RELAXED, __HIP_MEMORY_SCOPE_AGENT) + __hip_atomic_load(sp4 + 3, __ATOMIC_RELAXED, __HIP_MEMORY_SCOPE_AGENT));
                t += shx(t, 16, ln); t += shx(t, 32, ln); rs[ai][m] = rsqrtf(t * (1.0f / 1024.0f) + EPS_); }
#pragma unroll
        for (int bj = 0; bj < 2; ++bj) {
            const f32x4 g0 = *(const PG8_GAS f32x4*)(gfin + colc + bj * HALF), g1 = *(const PG8_GAS f32x4*)(gfin + colc + bj * HALF + 4);
#pragma unroll
            for (int ai = 0; ai < 2; ++ai)
#pragma unroll
                for (int m = 0; m < 4; ++m) { const size_t off = (size_t)(row1 + ai * HALF + m * 16) * 1024 + colc + bj * HALF;
                    *(PG8_GAS f32x4*)(OUT + off) = acc[ai][bj][m][0] * rs[ai][m] * g0; *(PG8_GAS f32x4*)(OUT + off + 4) = acc[ai][bj][m][1] * rs[ai][m] * g1; }
        }
    }
};

struct EpiUp {
    static constexpr bool PERM = true;
    static constexpr bool NEEDS_RSTD = true;
    const PG8_GAS float* SS; const PG8_GAS float* bias; PG8_GAS bf16_t* O; int ldc; PG8_LAS unsigned char* ldsb; int par;
    __device__ __forceinline__ void operator()(f32x4 (&acc)[2][2][4][2], const Unit& u, int wr, int wc, int fr, int fq) const {
        const int b = u.pm >> 5, colb = u.pn * BM + wc * 32 + 8 * fq, row0 = u.pm * BM + wr * 64 + fr;
        float rs[2][4];
#pragma unroll
        for (int ai = 0; ai < 2; ++ai)
#pragma unroll
            for (int m = 0; m < 4; ++m) rs[ai][m] = ((const PG8_LAS float*)(ldsb + RSTD_TAB_OFF + par * 1024))[wr * 64 + fr + ai * HALF + m * 16];
#pragma unroll
        for (int bj = 0; bj < 2; ++bj) {
            const f32x4 bv0 = *(const PG8_GAS f32x4*)(bias + (size_t)b * ldc + colb + bj * HALF), bv1 = *(const PG8_GAS f32x4*)(bias + (size_t)b * ldc + colb + bj * HALF + 4);
#pragma unroll
            for (int ai = 0; ai < 2; ++ai)
#pragma unroll
                for (int m = 0; m < 4; ++m) { f32x4 v0 = acc[ai][bj][m][0] * rs[ai][m] + bv0, v1 = acc[ai][bj][m][1] * rs[ai][m] + bv1;
#pragma unroll
                    for (int j = 0; j < 4; ++j) { v0[j] = fmaxf(v0[j], 0.f); v1[j] = fmaxf(v1[j], 0.f); }
                    v0 = v0 * v0; v1 = v1 * v1;
                    u32x4 w; w.x = cvt_pk_bf16(v0[0], v0[1]); w.y = cvt_pk_bf16(v0[2], v0[3]); w.z = cvt_pk_bf16(v1[0], v1[1]); w.w = cvt_pk_bf16(v1[2], v1[3]);
                    *(PG8_GAS u32x4*)(O + ((size_t)(u.pm * 16 + u.pn) * 256 + (wr * 64 + fr + ai * HALF + m * 16)) * 256 + (wc * 32 + 8 * fq + bj * HALF)) = w; }
        }
    }
};

struct EpiQKV {
    static constexpr bool PERM = true;
    static constexpr bool NEEDS_RSTD = true;
    const PG8_GAS float* SS; const PG8_GAS float* bias; PG8_GAS bf16_t* Q; size_t split_stride; PG8_GAS float* KMP; PG8_LAS unsigned char* ldsb; int par;
    __device__ __forceinline__ void operator()(f32x4 (&acc)[2][2][4][2], const Unit& u, int wr, int wc, int fr, int fq) const {
        const int b = u.pm >> 5, t = u.pn >> 2, colt = (u.pn & 3) * BM + wc * 32 + 8 * fq, colb = u.pn * BM + wc * 32 + 8 * fq, row0 = u.pm * BM + wr * 64 + fr;
        PG8_GAS bf16_t* base = Q + (size_t)t * split_stride; const float sc = (t == 0) ? C2_ : 1.0f;
        float rs[2][4];
#pragma unroll
        for (int ai = 0; ai < 2; ++ai)
#pragma unroll
            for (int m = 0; m < 4; ++m) rs[ai][m] = ((const PG8_LAS float*)(ldsb + RSTD_TAB_OFF + par * 1024))[wr * 64 + fr + ai * HALF + m * 16];
#pragma unroll
        for (int bj = 0; bj < 2; ++bj) {
            const f32x4 bv0 = *(const PG8_GAS f32x4*)(bias + (size_t)b * 3072 + colb + bj * HALF), bv1 = *(const PG8_GAS f32x4*)(bias + (size_t)b * 3072 + colb + bj * HALF + 4);
            f32x4 cs0 = {0.f, 0.f, 0.f, 0.f}, cs1 = cs0;
#pragma unroll
            for (int ai = 0; ai < 2; ++ai)
#pragma unroll
                for (int m = 0; m < 4; ++m) { f32x4 v0 = acc[ai][bj][m][0] * rs[ai][m] + bv0, v1 = acc[ai][bj][m][1] * rs[ai][m] + bv1;
                    cs0 += v0; cs1 += v1; v0 = v0 * sc; v1 = v1 * sc;
                    u32x4 w; w.x = cvt_pk_bf16(v0[0], v0[1]); w.y = cvt_pk_bf16(v0[2], v0[3]); w.z = cvt_pk_bf16(v1[0], v1[1]); w.w = cvt_pk_bf16(v1[2], v1[3]);
                    *(PG8_GAS u32x4*)(base + hm_off((size_t)(row0 + ai * HALF + m * 16), b, (colt + bj * HALF) >> 6) + ((colt + bj * HALF) & 63)) = w; }
            if (t == 1) {
#pragma unroll
                for (int o = 1; o < 16; o <<= 1) {
#pragma unroll
                    for (int j = 0; j < 4; ++j) { cs0[j] += shx(cs0[j], o, fq * 16 + fr); cs1[j] += shx(cs1[j], o, fq * 16 + fr); } }
                if (fr == 0) { PG8_GAS float* kp = KMP + ((size_t)u.pm * 2 + wr) * 1024 + colt + bj * HALF; *(f32x4*)kp = cs0; *(PG8_GAS f32x4*)(kp + 4) = cs1; }
            }
        }
    }
};

template <class Epi, class Sched, bool ALIGN_EPI>
__device__ __forceinline__ void gemm_phase(PG8_LAS unsigned char* lds, const Gemm g, const Sched& S, const Epi& E_, int wave_id) {
    Epi E = E_;
    int tid = wave_id * 64 + lane_id(); asm volatile("" : "+v"(tid));
    const int wid = __builtin_amdgcn_readfirstlane(tid >> 6), lane = tid & 63, wr = wid >> 2, wc = wid & 3, fr = lane & 15, fq = lane >> 4;
    const int K = g.K, nt = K / BK, lda = g.lda;
    unsigned voffA[2], voffB[2];
#pragma unroll
    for (int i = 0; i < 2; ++i) { int R, C; stage_rc(tid * 16 + i * 8192, R, C); const int Rb = Epi::PERM ? ((R & ~31) + perm32(R & 31)) : R;
        voffA[i] = (unsigned)(R * lda + C) * 2u; voffB[i] = (unsigned)(Rb * K + C) * 2u; }
    const size_t kstep = (size_t)(BK * 2);
    const size_t hstepA = (size_t)HALF * lda * 2, tstepA = (g.a_tileb == 512) ? 2 * hstepA : (size_t)(K / 256) * g.a_tileb, hstepB = (size_t)HALF * K * 2, tstepB = 2 * hstepB;
    const size_t tileb = (size_t)g.a_tileb;
#define PG8_KOFF(t) ((size_t)((t) >> 2) * tileb + (size_t)((t) & 3) * 128)
    const unsigned ldsw = (unsigned)wid * 1024u;
    const int aoff = lds_byte(wr * 64 + fr, fq * 8), boff = lds_byte(wc * 32 + fr, fq * 8);
#define PG8_SA(b, h) (((b) * 2 + (h)) * HTB)
#define PG8_SB(b, h) ((4 + (b) * 2 + (h)) * HTB)
#define PG8_STAGE(bufoff, gbase, voff) do { _Pragma("unroll") for (int _i = 0; _i < 2; ++_i) \
        __builtin_amdgcn_global_load_lds((const PG8_GAS unsigned*)((const PG8_GAS char*)(gbase) + (voff)[_i]), (PG8_LAS unsigned*)(lds + (bufoff) + ldsw + _i * 8192), 16, 0, 0); } while (0)
#define PG8_LDA(dst, b, h) do { _Pragma("unroll") for (int m = 0; m < 4; ++m) _Pragma("unroll") for (int k = 0; k < 2; ++k) dst[m][k] = *(const PG8_LAS bf16x8*)(lds + PG8_SA(b, h) + aoff + m * 2048 + k * 1024); } while (0)
#define PG8_LDB(dst, b, h) do { _Pragma("unroll") for (int n = 0; n < 2; ++n) _Pragma("unroll") for (int k = 0; k < 2; ++k) dst[n][k] = *(const PG8_LAS bf16x8*)(lds + PG8_SB(b, h) + boff + n * 2048 + k * 1024); } while (0)
#define PG8_MMA(ai, bj, At, Bt) do { __builtin_amdgcn_s_setprio(1); _Pragma("unroll") for (int m = 0; m < 4; ++m) _Pragma("unroll") for (int n = 0; n < 2; ++n) _Pragma("unroll") for (int k = 0; k < 2; ++k) \
        acc[ai][bj][m][n] = __builtin_amdgcn_mfma_f32_16x16x32_bf16(Bt[n][k], At[m][k], acc[ai][bj][m][n], 0, 0, 0); __builtin_amdgcn_s_setprio(0); } while (0)
#define PG8_WAIT_V(n) asm volatile("s_waitcnt vmcnt(" #n ")" ::: "memory")
#define PG8_WAIT_L(n) asm volatile("s_waitcnt lgkmcnt(" #n ")" ::: "memory")
#define PG8_BAR __builtin_amdgcn_s_barrier()
#define PG8_SCHED __builtin_amdgcn_sched_barrier(0)
    Unit cur, nxt; int ui = 0;
    if (!S.next(0, cur)) return;
    int rpar = 0;
    if constexpr (Epi::NEEDS_RSTD) { fill_rstd_tab(lds, 0, E.SS, cur.pm, wid, lane); E.par = 0; }
    f32x4 acc[2][2][4][2];
#pragma unroll
    for (int a = 0; a < 2; ++a)
#pragma unroll
        for (int b = 0; b < 2; ++b)
#pragma unroll
            for (int m = 0; m < 4; ++m)
#pragma unroll
                for (int n = 0; n < 2; ++n) acc[a][b][m][n] = (f32x4){0.f, 0.f, 0.f, 0.f};
    bf16x8 At[4][2], B0[2][2], B1[2][2];
    const PG8_GAS char* cA = (const PG8_GAS char*)g.A + (size_t)cur.pm * tstepA + (size_t)cur.pn * g.a_pn_off * 2; const PG8_GAS char* cB = (const PG8_GAS char*)g.Bt + (size_t)cur.pn * tstepB;
    PG8_STAGE(PG8_SB(0, 0), cB, voffB); PG8_STAGE(PG8_SB(0, 1), cB + hstepB, voffB); PG8_STAGE(PG8_SA(0, 0), cA, voffA); PG8_STAGE(PG8_SA(0, 1), cA + hstepA, voffA);
    if (wr == 1) PG8_BAR;
    PG8_WAIT_V(2); PG8_BAR;
    PG8_STAGE(PG8_SB(1, 0), cB + kstep, voffB); PG8_STAGE(PG8_SA(1, 0), cA + kstep, voffA); PG8_STAGE(PG8_SB(1, 1), cB + hstepB + kstep, voffB);
    PG8_WAIT_V(6); PG8_BAR;
    for (;;) {
        const bool has_next = S.next(ui + 1, nxt);
        const PG8_GAS char* nA = has_next ? (const PG8_GAS char*)g.A + (size_t)nxt.pm * tstepA + (size_t)nxt.pn * g.a_pn_off * 2 : cA; const PG8_GAS char* nB = has_next ? (const PG8_GAS char*)g.Bt + (size_t)nxt.pn * tstepB : cB;
        for (int t = 0; t < nt; t += 2) {
            const bool last = (t == nt - 2);
            const PG8_GAS char* a1 = cA + PG8_KOFF(t + 1);
            const PG8_GAS char* a2 = last ? nA : cA + PG8_KOFF(t + 2); const PG8_GAS char* b2 = last ? nB : cB + (size_t)(t + 2) * kstep;
            const PG8_GAS char* a3 = a2 + kstep; const PG8_GAS char* b3 = b2 + kstep;
            PG8_LDB(B0, 0, 0); PG8_LDB(B1, 0, 1); PG8_SCHED; PG8_LDA(At, 0, 0); PG8_STAGE(PG8_SA(1, 1), a1 + hstepA, voffA);
            PG8_WAIT_V(8); PG8_WAIT_L(0); PG8_BAR; PG8_MMA(0, 0, At, B0); PG8_MMA(0, 1, At, B1); PG8_BAR; PG8_SCHED;
            PG8_LDA(At, 0, 1); PG8_STAGE(PG8_SB(0, 0), b2, voffB); PG8_STAGE(PG8_SB(0, 1), b2 + hstepB, voffB); PG8_STAGE(PG8_SA(0, 0), a2, voffA);
            PG8_WAIT_V(8); PG8_WAIT_L(0); PG8_BAR; PG8_MMA(1, 0, At, B0); PG8_MMA(1, 1, At, B1); PG8_BAR; PG8_SCHED;
            PG8_LDB(B0, 1, 0); PG8_LDB(B1, 1, 1); PG8_SCHED; PG8_LDA(At, 1, 0); PG8_STAGE(PG8_SA(0, 1), a2 + hstepA, voffA);
            PG8_WAIT_V(8); PG8_WAIT_L(0); PG8_BAR; PG8_MMA(0, 0, At, B0); PG8_MMA(0, 1, At, B1); PG8_BAR; PG8_SCHED;
            PG8_LDA(At, 1, 1); PG8_STAGE(PG8_SB(1, 0), b3, voffB); PG8_STAGE(PG8_SB(1, 1), b3 + hstepB, voffB); PG8_STAGE(PG8_SA(1, 0), a3, voffA);
            PG8_WAIT_V(8); PG8_WAIT_L(0); PG8_BAR; PG8_MMA(1, 0, At, B0); PG8_MMA(1, 1, At, B1); PG8_BAR; PG8_SCHED;
        }
        if constexpr (ALIGN_EPI) { if (wr == 0) PG8_BAR; }
        if constexpr (Epi::NEEDS_RSTD) E.par = rpar;
        E(acc, cur, wr, wc, fr, fq);
        if constexpr (Epi::NEEDS_RSTD) { if (has_next && nxt.pm != cur.pm) { rpar ^= 1; fill_rstd_tab(lds, rpar, E.SS, nxt.pm, wid, lane); } }
        if (!has_next) break;
#pragma unroll
        for (int a = 0; a < 2; ++a)
#pragma unroll
            for (int b = 0; b < 2; ++b)
#pragma unroll
                for (int m = 0; m < 4; ++m)
#pragma unroll
                    for (int n = 0; n < 2; ++n) acc[a][b][m][n] = (f32x4){0.f, 0.f, 0.f, 0.f};
        cur = nxt; cA = nA; cB = nB; ++ui;
        if constexpr (ALIGN_EPI) { if (wr == 1) PG8_BAR; }
    }
    PG8_WAIT_V(0);
    if constexpr (!ALIGN_EPI) { if (wr == 0) PG8_BAR; }
    PG8_BAR;
#undef PG8_KOFF
#undef PG8_SA
#undef PG8_SB
#undef PG8_STAGE
#undef PG8_LDA
#undef PG8_LDB
#undef PG8_MMA
#undef PG8_WAIT_V
#undef PG8_WAIT_L
#undef PG8_BAR
#undef PG8_SCHED
}
}

constexpr int NWAVES = 8;
constexpr int BATCH = 4, SEQ = 8192, D = 1024, NH = 16, HD = 64, FF = 4096, M = BATCH * SEQ, NQKV = 3 * D, NBLK = 32, BLK = 256;
constexpr float EPS = 1e-6f;
constexpr float LOG2E = 1.4426950408889634f;

constexpr size_t MiB = 1u << 20;
constexpr size_t WS_CTL = 0, CTL_ZERO_BYTES = 1 * MiB;
constexpr size_t WS_MOD = 1 * MiB;
constexpr size_t WS_BIAS_UP0 = WS_MOD + 256 * 1024;
constexpr size_t WS_BIAS_QKV = WS_BIAS_UP0 + 64 * 1024;
constexpr size_t WS_BIAS_UP1 = WS_BIAS_QKV + 64 * 1024;
constexpr size_t WS_KMP = 2 * MiB;
constexpr size_t WS_SS = 3 * MiB;
constexpr size_t WS_WPOOL = 6 * MiB, WS_WQKV = 8 * MiB, WS_WO = 14 * MiB, WS_WUP0 = 16 * MiB, WS_WUP1 = 24 * MiB, WS_WDN0 = 32 * MiB, WS_WDN1 = 40 * MiB;
constexpr size_t WS_XNA = 48 * MiB, WS_XNB = 112 * MiB;
constexpr size_t WS_HB = 176 * MiB;
constexpr size_t WS_Q = 176 * MiB, WS_K = 240 * MiB, WS_V = 304 * MiB;
constexpr size_t WS_PL = 496 * MiB;
constexpr size_t WS_CNT = 503 * MiB;
constexpr size_t WS_KBM = 503 * MiB + 512 * 1024;
constexpr size_t WS_POB = 48 * MiB;
constexpr size_t WS_SEG = 368 * MiB;
constexpr size_t WS_XR = 432 * MiB;
constexpr size_t WS_O = 368 * MiB;
constexpr size_t WS_DUMP = 504 * MiB;
constexpr size_t WS_END = 506 * MiB;
constexpr int CW_BAR = 4096;
constexpr int CW_FIN = 24576;
constexpr int CW_TOT = 16384;

constexpr int RING_OFF = 0, RING_BYTES = 131072;
constexpr int LDSCTL_OFF = RING_BYTES, MISC_OFF = LDSCTL_OFF + 320;
constexpr int LDS_BYTES = 151552;

#define GAS __attribute__((address_space(1)))
#define LAS __attribute__((address_space(3)))
typedef unsigned short bf16;
typedef unsigned v4u __attribute__((ext_vector_type(4)));
typedef unsigned v2u __attribute__((ext_vector_type(2)));
typedef float f32x4 __attribute__((ext_vector_type(4)));
typedef GAS unsigned gu32;
#define RLX_AGENT __ATOMIC_RELAXED, __HIP_MEMORY_SCOPE_AGENT
#define LDS_WAIT() asm volatile("s_waitcnt lgkmcnt(0)" ::: "memory")
__device__ __forceinline__ unsigned f2bf(float f) { unsigned u = __builtin_bit_cast(unsigned, f); return (u + 0x7fffu + ((u >> 16) & 1u)) >> 16; }
__device__ __forceinline__ unsigned pk2(float lo, float hi) { return f2bf(lo) | (f2bf(hi) << 16); }
__device__ __forceinline__ float bf2f(unsigned short v) { return __builtin_bit_cast(float, (unsigned)v << 16); }

#define XB_TMO      128
#define XB_XCNT(j)  (256  + 64 * (j))
#define XB_XSUB(j)  (1280 + 64 * (j))
#define XB_XGEN(j)  (2304 + 64 * (j))
#define XB_TOP      3328
#define XB_TOPGEN   3392
#define XCD_BAR_WORDS 3456
#define XB_SPIN_CAP (1u << 18)
__device__ __forceinline__ unsigned xb_ld(GAS unsigned* p)              { return __hip_atomic_load(p, __ATOMIC_RELAXED, __HIP_MEMORY_SCOPE_AGENT); }
__device__ __forceinline__ unsigned xb_add(GAS unsigned* p, unsigned v) { return __hip_atomic_fetch_add(p, v, __ATOMIC_RELAXED, __HIP_MEMORY_SCOPE_AGENT); }
__device__ __forceinline__ unsigned xb_xcc_id() { return (unsigned)__builtin_amdgcn_s_getreg((3 << 11) | 20) & 0xFu; }
#define XB_SPIN(cond, bar) do { unsigned _sp = 0; while (cond) { __builtin_amdgcn_s_sleep(1); \
    if ((++_sp & 255u) == 0u) { if (xb_ld(&(bar)[XB_TMO])) break; if (_sp > XB_SPIN_CAP) { (void)xb_add(&(bar)[XB_TMO], 1u); break; } } } } while (0)
struct XcdBarrier { GAS unsigned* bar; unsigned x; volatile LAS unsigned* st; int wave; };
__device__ __forceinline__ XcdBarrier xcd_barrier_post(GAS unsigned* bar, volatile LAS unsigned* st) {
    XcdBarrier b; b.bar = bar; b.x = xb_xcc_id(); b.st = st;
    if (threadIdx.x == 0) (void)xb_add(&bar[XB_XCNT(b.x)], 1u);
    return b;
}
__device__ __forceinline__ void xcd_barrier_complete(GAS unsigned* bar, unsigned x, unsigned& nloc, unsigned& nx) {
    const unsigned G = gridDim.x * gridDim.y * gridDim.z;
    unsigned sum, cnt, mine, sp = 0u;
    for (;;) {
        sum = 0u; cnt = 0u; mine = 0u;
#pragma unroll
        for (unsigned j = 0; j < 16; ++j) { const unsigned c = xb_ld(&bar[XB_XCNT(j)]); sum += c; cnt += (c > 0u) ? 1u : 0u; mine = (j == x) ? c : mine; }
        if (sum == G) break;
        __builtin_amdgcn_s_sleep(1);
        if ((++sp & 255u) == 0u) { if (xb_ld(&bar[XB_TMO])) break; if (sp > XB_SPIN_CAP) { (void)xb_add(&bar[XB_TMO], 1u); break; } }
    }
    nloc = mine > 0u ? mine : 1u; nx = cnt > 0u ? cnt : 1u;
}
__device__ __forceinline__ void xcd_barrier(const XcdBarrier& b) {
    asm volatile("s_waitcnt vmcnt(0)" ::: "memory");
    __syncthreads();
    if (b.wave == 0 && lane_id() == 0) {
        GAS unsigned* bar = b.bar; asm volatile("" : "+s"(bar));
        const unsigned bx = xb_xcc_id();
        __builtin_amdgcn_s_waitcnt(0);
        unsigned nloc = b.st[0], nx = b.st[1];
        if (nloc == 0u) { xcd_barrier_complete(bar, bx, nloc, nx); b.st[0] = nloc; b.st[1] = nx; }
        const unsigned old = xb_add(&bar[XB_XSUB(bx)], 1u);
        const unsigned gen = old / nloc;
        if (old + 1u == (gen + 1u) * nloc) {
            __builtin_amdgcn_fence(__ATOMIC_RELEASE, "agent");
            asm volatile("s_waitcnt vmcnt(0)" ::: "memory");
            const unsigned og = xb_add(&bar[XB_TOP], 1u);
            const unsigned tg = og / nx;
            if (og + 1u == (tg + 1u) * nx) xb_add(&bar[XB_TOPGEN], 1u);
            else XB_SPIN(xb_ld(&bar[XB_TOPGEN]) == tg, bar);
            __builtin_amdgcn_fence(__ATOMIC_ACQUIRE, "agent");
            xb_add(&bar[XB_XGEN(bx)], 1u);
            asm volatile("s_waitcnt vmcnt(0)" ::: "memory");
        } else {
            XB_SPIN(xb_ld(&bar[XB_XGEN(bx)]) == gen, bar);
            __builtin_amdgcn_fence(__ATOMIC_ACQUIRE, "agent");
            asm volatile("s_waitcnt vmcnt(0)" ::: "memory");
        }
    }
    __syncthreads();
}

struct Args { const GAS float* in[14]; GAS float* out; GAS unsigned char* ws; };
struct Frame {
    LAS unsigned char* lds; int tid, lane, wave, vcu, G;
    const GAS float *x, *c, *rel_bias, *w_mod, *b_mod, *norm_mix, *norm_mlp, *w_pool, *pool_scale, *w_qkv, *w_o, *w_up, *w_down, *norm_final;
    GAS float* out; GAS unsigned char* ws;
};
__device__ __forceinline__ float wave_sum(float v) {
#pragma unroll
    for (int o = 1; o < 64; o <<= 1) v += __shfl_xor(v, o);
    return v;
}

struct TItem { const GAS float* W; GAS bf16* WT; int K, N, row_off, item; };
__device__ __forceinline__ void tload(const TItem& I, f32x4 (&t)[8], int lane) {
    const int nblk = I.N / 32, kb = I.item / nblk, nb = I.item % nblk, k0 = 64 * kb, n0 = 32 * nb;
#pragma unroll
    for (int i = 0; i < 8; ++i) t[i] = *(const GAS f32x4*)(I.W + (size_t)(k0 + 8 * i + (lane >> 3)) * I.N + n0 + 4 * (lane & 7));
}
__device__ __forceinline__ void tstore(const TItem& I, const f32x4 (&t)[8], LAS float* scr, int lane) {
    const int nblk = I.N / 32, kb = I.item / nblk, nb = I.item % nblk, k0 = 64 * kb, n0 = 32 * nb;
#pragma unroll
    for (int i = 0; i < 8; ++i) { LAS float* d = scr + (8 * i + (lane >> 3)) * 33 + 4 * (lane & 7); d[0] = t[i][0]; d[1] = t[i][1]; d[2] = t[i][2]; d[3] = t[i][3]; }
    LDS_WAIT(); asm volatile("" ::: "memory");
    const int c = lane & 7;
#pragma unroll
    for (int j = 0; j < 4; ++j) { const int n = (lane >> 3) + 8 * j; const LAS float* s = scr + (8 * c) * 33 + n;
        v4u o; o.x = pk2(s[0 * 33], s[1 * 33]); o.y = pk2(s[2 * 33], s[3 * 33]); o.z = pk2(s[4 * 33], s[5 * 33]); o.w = pk2(s[6 * 33], s[7 * 33]);
        *(GAS v4u*)(I.WT + (size_t)(I.row_off + n0 + n) * I.K + k0 + 8 * c) = o; }
    LDS_WAIT(); asm volatile("" ::: "memory");
}
__device__ __forceinline__ void p0_prologue(Frame& F) {
    if (F.vcu < 192) {
        LAS float* cact = (LAS float*)(F.lds + 67584);
        LAS float* red = (LAS float*)(F.lds + 67584 + 16384);
        const int l = F.vcu / 96, j0 = (F.vcu % 96) * 64;
        for (int i = F.tid; i < 4096; i += NWAVES * 64) { const float v = F.c[i]; cact[i] = v / (1.f + __expf(-v)); }
        __syncthreads();
        const int sub = F.lane >> 4, c4 = F.lane & 15;
        f32x4 a0 = {0.f, 0.f, 0.f, 0.f}, a1 = a0, a2 = a0, a3 = a0;
        const GAS float* wb = F.w_mod + (size_t)l * 1024 * 6144 + j0 + 4 * c4;
#pragma unroll 4
        for (int it = 0; it < 32; ++it) { const int k = 32 * it + 4 * F.wave + sub; const f32x4 wv = *(const GAS f32x4*)(wb + (size_t)k * 6144);
            a0 += wv * cact[k]; a1 += wv * cact[1024 + k]; a2 += wv * cact[2048 + k]; a3 += wv * cact[3072 + k]; }
#pragma unroll
        for (int j = 0; j < 4; ++j) { a0[j] += __shfl_xor(a0[j], 16); a0[j] += __shfl_xor(a0[j], 32); a1[j] += __shfl_xor(a1[j], 16); a1[j] += __shfl_xor(a1[j], 32);
            a2[j] += __shfl_xor(a2[j], 16); a2[j] += __shfl_xor(a2[j], 32); a3[j] += __shfl_xor(a3[j], 16); a3[j] += __shfl_xor(a3[j], 32); }
        if (sub == 0) { LAS f32x4* r4 = (LAS f32x4*)(red + F.wave * 256); r4[0 * 16 + c4] = a0; r4[1 * 16 + c4] = a1; r4[2 * 16 + c4] = a2; r4[3 * 16 + c4] = a3; }
        __syncthreads();
        if (F.tid < 256) { const int b = F.tid >> 6, col = F.tid & 63; float s = 0.f;
#pragma unroll
            for (int w = 0; w < 8; ++w) s += red[w * 256 + b * 64 + col];
            ((GAS float*)(F.ws + WS_MOD))[(l * 4 + b) * 6144 + j0 + col] = s + F.b_mod[l * 6144 + j0 + col]; }
    }
    LAS float* scr = (LAS float*)(F.lds + RING_OFF + F.wave * 8448);
    const int gw = F.vcu * NWAVES + F.wave, NGW = F.G * NWAVES;
    constexpr int I_POOL = 4 * 32, I_QKV = 16 * 96, I_O = 16 * 32, I_UP = 16 * 128, I_DN = 64 * 32;
    constexpr int NITEMS = I_POOL + I_QKV + I_O + 2 * I_UP + 2 * I_DN;
    auto desc = [&](int it) -> TItem {
        int r = it;
        if (r < I_POOL) { const int g = r / 32; return TItem{F.w_pool + (size_t)g * 65536, (GAS bf16*)(F.ws + WS_WPOOL), 256, 256, g * 256, r % 32}; } r -= I_POOL;
        if (r < I_QKV) return TItem{F.w_qkv, (GAS bf16*)(F.ws + WS_WQKV), D, NQKV, 0, r}; r -= I_QKV;
        if (r < I_O) return TItem{F.w_o, (GAS bf16*)(F.ws + WS_WO), D, D, 0, r}; r -= I_O;
        if (r < 2 * I_UP) { const int l = r / I_UP; return TItem{F.w_up + (size_t)l * D * FF, (GAS bf16*)(F.ws + (l ? WS_WUP1 : WS_WUP0)), D, FF, 0, r % I_UP}; } r -= 2 * I_UP;
        const int l = r / I_DN; return TItem{F.w_down + (size_t)l * FF * D, (GAS bf16*)(F.ws + (l ? WS_WDN1 : WS_WDN0)), FF, D, 0, r % I_DN};
    };
    f32x4 ta[8], tb[8];
    int it = gw;
    if (it < NITEMS) { TItem cur = desc(it); tload(cur, ta, F.lane);
        for (;;) {
            const int itn = it + NGW; const bool hn = itn < NITEMS; TItem nxt = cur;
            if (hn) { nxt = desc(itn); tload(nxt, tb, F.lane); }
            tstore(cur, ta, scr, F.lane);
            if (!hn) break;
#pragma unroll
            for (int i = 0; i < 8; ++i) ta[i] = tb[i];
            cur = nxt; it = itn;
        } }
}

__device__ __forceinline__ void p1_bias(Frame& F) {
    const int gw = F.vcu * NWAVES + F.wave, NGW = F.G * NWAVES;
    const GAS float* MOD = (const GAS float*)(F.ws + WS_MOD);
    for (int it = gw; it < 4096 + 3072 + 4096; it += NGW) {
        const GAS bf16* wt; const GAS float* sh; GAS float* dst; int n, N;
        if (it < 4096) { n = it; N = 4096; wt = (const GAS bf16*)(F.ws + WS_WUP0); sh = MOD + 3072; dst = (GAS float*)(F.ws + WS_BIAS_UP0); }
        else if (it < 4096 + 3072) { n = it - 4096; N = 3072; wt = (const GAS bf16*)(F.ws + WS_WQKV); sh = MOD + 4 * 6144; dst = (GAS float*)(F.ws + WS_BIAS_QKV); }
        else { n = it - 7168; N = 4096; wt = (const GAS bf16*)(F.ws + WS_WUP1); sh = MOD + 4 * 6144 + 3072; dst = (GAS float*)(F.ws + WS_BIAS_UP1); }
        const v4u w0 = *(const GAS v4u*)(wt + (size_t)n * 1024 + F.lane * 16), w1 = *(const GAS v4u*)(wt + (size_t)n * 1024 + F.lane * 16 + 8);
        float wf[16];
#pragma unroll
        for (int j = 0; j < 4; ++j) { wf[2 * j] = __builtin_bit_cast(float, w0[j] << 16); wf[2 * j + 1] = __builtin_bit_cast(float, w0[j] & 0xffff0000u);
            wf[8 + 2 * j] = __builtin_bit_cast(float, w1[j] << 16); wf[8 + 2 * j + 1] = __builtin_bit_cast(float, w1[j] & 0xffff0000u); }
#pragma unroll
        for (int b = 0; b < 4; ++b) { const GAS f32x4* sp = (const GAS f32x4*)(sh + b * 6144 + F.lane * 16); float s = 0.f;
#pragma unroll
            for (int j = 0; j < 4; ++j) { const f32x4 sv = sp[j]; s += wf[4 * j] * sv[0] + wf[4 * j + 1] * sv[1] + wf[4 * j + 2] * sv[2] + wf[4 * j + 3] * sv[3]; }
            s = wave_sum(s); if (F.lane == 0) dst[b * N + n] = s; }
    }
}
__device__ __forceinline__ void p1_pool(Frame& F) {
    LAS float* ring = (LAS float*)(F.lds + RING_OFF);
    const GAS float* MOD = (const GAS float*)(F.ws + WS_MOD); GAS bf16* XN = (GAS bf16*)(F.ws + WS_XNA); GAS bf16* XR = (GAS bf16*)(F.ws + WS_XR);
    for (int run = F.vcu; run < M / 128; run += F.G) {
        const int t0 = run * 128, s0 = t0 % SEQ, b = t0 / SEQ;
        f32x4 gam[4];
#pragma unroll
        for (int j = 0; j < 4; ++j) gam[j] = *(const GAS f32x4*)(F.norm_mix + 4 * (F.lane + 64 * j));
        const int c4 = F.tid & 255, rh = F.tid >> 8, gi = c4 >> 6, w = 2 << gi;
        const f32x4 sc1 = *(const GAS f32x4*)(MOD + b * 6144 + 1024 + 4 * c4) + 1.0f;
        f32x4 v[2][4];
        const GAS float* xb = F.x + (size_t)b * SEQ * D + 4 * F.lane;
        int st = (s0 > 0 ? -1 : 0);
#pragma unroll
        for (int rr = 0; rr < 2; ++rr)
#pragma unroll
            for (int j = 0; j < 4; ++j) v[rr][j] = *(const GAS f32x4*)(xb + (size_t)(s0 + 16 * st + 2 * F.wave + rr) * D + 256 * j);
        for (; st < 8; ++st) {
            if (st >= 0) {
#pragma unroll
                for (int rr = 0; rr < 2; ++rr)
#pragma unroll
                    for (int j = 0; j < 4; ++j) { v2u o2; o2.x = pk2(v[rr][j][0], v[rr][j][1]); o2.y = pk2(v[rr][j][2], v[rr][j][3]);
                        { const size_t trow = (size_t)b * SEQ + s0 + 16 * st + 2 * F.wave + rr; *(GAS v2u*)(XR + (((trow >> 8) * 4 + j) * 256 + (trow & 255)) * 256 + 4 * F.lane) = o2; } } }
            float ss0 = 0.f, ss1 = 0.f;
#pragma unroll
            for (int j = 0; j < 4; ++j) { ss0 += (v[0][j][0] * v[0][j][0] + v[0][j][1] * v[0][j][1]) + (v[0][j][2] * v[0][j][2] + v[0][j][3] * v[0][j][3]);
                ss1 += (v[1][j][0] * v[1][j][0] + v[1][j][1] * v[1][j][1]) + (v[1][j][2] * v[1][j][2] + v[1][j][3] * v[1][j][3]); }
#pragma unroll
            for (int o = 1; o < 64; o <<= 1) { ss0 += __shfl_xor(ss0, o); ss1 += __shfl_xor(ss1, o); }
            const float rs0 = rsqrtf(ss0 * (1.0f / D) + EPS), rs1 = rsqrtf(ss1 * (1.0f / D) + EPS);
            { const int sr = s0 + 16 * st + 2 * F.wave;
#pragma unroll
              for (int j = 0; j < 4; ++j) { *(LAS f32x4*)(ring + (sr & 31) * 1024 + 4 * (F.lane + 64 * j)) = v[0][j] * rs0 * gam[j]; *(LAS f32x4*)(ring + ((sr + 1) & 31) * 1024 + 4 * (F.lane + 64 * j)) = v[1][j] * rs1 * gam[j]; } }
            if (st + 1 < 8) {
#pragma unroll
                for (int rr = 0; rr < 2; ++rr)
#pragma unroll
                    for (int j = 0; j < 4; ++j) v[rr][j] = *(const GAS f32x4*)(xb + (size_t)(s0 + 16 * (st + 1) + 2 * F.wave + rr) * D + 256 * j); }
            __syncthreads();
            if (st >= 0) {
                const int sA = s0 + 16 * st + 8 * rh;
                f32x4 sum = {0.f, 0.f, 0.f, 0.f};
                { const int cnt0 = (sA < w) ? sA : w; for (int i = 1; i <= cnt0; ++i) sum += *(const LAS f32x4*)(ring + ((sA - i) & 31) * 1024 + 4 * c4); }
#pragma unroll
                for (int r = 0; r < 8; ++r) { const int s = sA + r; const f32x4 cur = *(const LAS f32x4*)(ring + (s & 31) * 1024 + 4 * c4);
                    sum += cur; if (s >= w) sum -= *(const LAS f32x4*)(ring + ((s - w) & 31) * 1024 + 4 * c4);
                    const float inv = 1.0f / (float)((s + 1 < w) ? s + 1 : w);
                    const f32x4 p = (sum * inv - cur) * sc1;
                    v2u o; o.x = pk2(p[0], p[1]); o.y = pk2(p[2], p[3]);
                    *(GAS v2u*)(XN + ((size_t)b * SEQ + s) * D + 4 * c4) = o; }
            }
            __syncthreads();
        }
    }
}

__device__ __forceinline__ int t5_bucket(int dist) {
    if (dist < 16) return dist;
    int b = 16;
    b += (dist >= 21); b += (dist >= 27); b += (dist >= 35); b += (dist >= 46); b += (dist >= 59); b += (dist >= 77); b += (dist >= 99); b += (dist >= 128);
    b += (dist >= 166); b += (dist >= 216); b += (dist >= 280); b += (dist >= 363); b += (dist >= 470); b += (dist >= 609); b += (dist >= 790);
    return b;
}
namespace att {
typedef short bf16x8 __attribute__((ext_vector_type(8)));
typedef short s16x4 __attribute__((ext_vector_type(4)));
typedef short v4i16_t __attribute__((ext_vector_type(4)));
typedef float f32x16 __attribute__((ext_vector_type(16)));
typedef float f32x2_t __attribute__((ext_vector_type(2)));
typedef __bf16 bf16x2_t __attribute__((ext_vector_type(2)));
typedef LAS const char* lds_cptr;
constexpr int L_K = 0, L_V = 32768, L_LUT = 132096, L_QI = 141312, L_CUM = 142336, L_PRE = 142592;
constexpr int LUTN = 2304;
__device__ __forceinline__ int crow(int r, int hi) { return (r & 3) + 8 * (r >> 2) + 4 * hi; }
__device__ __forceinline__ unsigned cvtpk(float lo, float hi) { f32x2_t v = {lo, hi}; bf16x2_t b = __builtin_convertvector(v, bf16x2_t); return __builtin_bit_cast(unsigned, b); }
__device__ __forceinline__ s16x4 vtr(lds_cptr p) { return __builtin_bit_cast(s16x4, __builtin_amdgcn_ds_read_tr16_b64_v4i16((LAS v4i16_t*)p)); }
__device__ __forceinline__ float swap_add(float v) { auto rr = __builtin_amdgcn_permlane32_swap(__float_as_uint(v), __float_as_uint(v), false, false); return __uint_as_float(rr[0]) + __uint_as_float(rr[1]); }

__device__ __forceinline__ void load_kv(LAS unsigned char* lds, const GAS bf16* Kb, const GAS bf16* Vb, int b, int h, int n, int w, int lane) {
#pragma unroll
    for (int t = 0; t < 4; ++t) {
        const size_t kr = (size_t)b * SEQ + n * BLK + 64 * t + lane, vr = (size_t)b * SEQ + n * BLK + 64 * t + 16 * (w & 3) + (lane >> 2);
        const v4u kv = *(const GAS v4u*)(Kb + hm_off(kr, b, h) + w * 8);
        const v4u vv = *(const GAS v4u*)(Vb + hm_off(vr, b, h) + (w >> 2) * 32 + (lane & 3) * 8);
        *(LAS v4u*)(lds + L_K + t * 8192 + w * 1024 + lane * 16) = kv;
        *(LAS v4u*)(lds + L_V + t * 8192 + w * 1024 + lane * 16) = vv;
    }
}
__device__ __forceinline__ void build_lut(LAS unsigned char* lds, const GAS float* rel_bias, int h, int tid) {
    for (int i = tid; i < LUTN; i += NWAVES * 64) ((LAS float*)(lds + L_LUT))[i] = (i <= 2047) ? rel_bias[t5_bucket(2047 - i) * NH + h] * LOG2E : 0.f;
}
__device__ __forceinline__ void qk_tile(f32x16& p0, f32x16& p1, lds_cptr Kt, const bf16x8* qr, const f32x16& cinit, int r32, int hi) {
    lds_cptr kb = Kt + hi * 1024 + r32 * 16;
#pragma unroll
    for (int d0 = 0; d0 < 4; ++d0) {
        const bf16x8 b0 = *(LAS const bf16x8*)(kb + d0 * 2048), b1 = *(LAS const bf16x8*)(kb + d0 * 2048 + 512);
        if (d0 == 0) { p0 = __builtin_amdgcn_mfma_f32_32x32x16_bf16(b0, qr[0], cinit, 0, 0, 0); p1 = __builtin_amdgcn_mfma_f32_32x32x16_bf16(b1, qr[0], cinit, 0, 0, 0); }
        else { p0 = __builtin_amdgcn_mfma_f32_32x32x16_bf16(b0, qr[d0], p0, 0, 0, 0); p1 = __builtin_amdgcn_mfma_f32_32x32x16_bf16(b1, qr[d0], p1, 0, 0, 0); }
    }
}
template <bool BIAS, bool MASK>
__device__ __forceinline__ void softmax_tile(f32x16& p0, f32x16& p1, LAS const float* lutp, int jt, int qrel, int hi, float& l, v4u* pa) {
#pragma unroll
    for (int r = 0; r < 16; ++r) { const int ko = 64 * jt + (r & 3) + 8 * (r >> 2);
        if (BIAS) { p0[r] += lutp[ko]; p1[r] += lutp[ko + 32]; }
        if (MASK) { const int kv = ko + 4 * hi; if (kv > qrel) p0[r] = -INFINITY; if (kv + 32 > qrel) p1[r] = -INFINITY; }
        p0[r] = __builtin_amdgcn_exp2f(p0[r]); p1[r] = __builtin_amdgcn_exp2f(p1[r]); }
    float s = 0.f;
#pragma unroll
    for (int r = 0; r < 16; ++r) s += p0[r] + p1[r];
    l += s;
    pa[0] = (v4u){cvtpk(p0[0], p0[1]), cvtpk(p0[2], p0[3]), cvtpk(p0[4], p0[5]), cvtpk(p0[6], p0[7])};
    pa[1] = (v4u){cvtpk(p0[8], p0[9]), cvtpk(p0[10], p0[11]), cvtpk(p0[12], p0[13]), cvtpk(p0[14], p0[15])};
    pa[2] = (v4u){cvtpk(p1[0], p1[1]), cvtpk(p1[2], p1[3]), cvtpk(p1[4], p1[5]), cvtpk(p1[6], p1[7])};
    pa[3] = (v4u){cvtpk(p1[8], p1[9]), cvtpk(p1[10], p1[11]), cvtpk(p1[12], p1[13]), cvtpk(p1[14], p1[15])};
}
__device__ __forceinline__ void pv_tile(f32x16* o, lds_cptr vp, const v4u* pa) {
#pragma unroll
    for (int d0 = 0; d0 < 2; ++d0)
#pragma unroll
        for (int ks = 0; ks < 4; ++ks) { const s16x4 lo = vtr(vp + d0 * 4096 + ks * 1024), hi = vtr(vp + d0 * 4096 + ks * 1024 + 512);
            const bf16x8 vf = (bf16x8){lo[0], lo[1], lo[2], lo[3], hi[0], hi[1], hi[2], hi[3]};
            o[d0] = __builtin_amdgcn_mfma_f32_32x32x16_bf16(vf, __builtin_bit_cast(bf16x8, pa[ks]), o[d0], 0, 0, 0); }
}
__device__ __forceinline__ void qk_half(f32x16& p, lds_cptr Kt, int s, const bf16x8* qr, const f32x16& cinit, int r32, int hi) {
    lds_cptr kb = Kt + hi * 1024 + r32 * 16 + s * 512;
#pragma unroll
    for (int d0 = 0; d0 < 4; ++d0) { const bf16x8 b0 = *(LAS const bf16x8*)(kb + d0 * 2048);
        if (d0 == 0) p = __builtin_amdgcn_mfma_f32_32x32x16_bf16(b0, qr[0], cinit, 0, 0, 0); else p = __builtin_amdgcn_mfma_f32_32x32x16_bf16(b0, qr[d0], p, 0, 0, 0); }
}
template <bool BIAS>
__device__ __forceinline__ void softmax_half(f32x16& p, LAS const float* lutp, int jt, int s, float& l, v4u& pa0, v4u& pa1) {
#pragma unroll
    for (int r = 0; r < 16; ++r) { const int ko = 64 * jt + 32 * s + (r & 3) + 8 * (r >> 2);
        if (BIAS) p[r] += lutp[ko];
        p[r] = __builtin_amdgcn_exp2f(p[r]); }
    float sm = 0.f;
#pragma unroll
    for (int r = 0; r < 16; ++r) sm += p[r];
    l += sm;
    pa0 = (v4u){cvtpk(p[0], p[1]), cvtpk(p[2], p[3]), cvtpk(p[4], p[5]), cvtpk(p[6], p[7])};
    pa1 = (v4u){cvtpk(p[8], p[9]), cvtpk(p[10], p[11]), cvtpk(p[12], p[13]), cvtpk(p[14], p[15])};
}
__device__ __forceinline__ void pv_half(f32x16* o, lds_cptr vp, int s, const v4u& pa0, const v4u& pa1) {
#pragma unroll
    for (int d0 = 0; d0 < 2; ++d0)
#pragma unroll
        for (int kk = 0; kk < 2; ++kk) { const int ks = 2 * s + kk; const s16x4 lo = vtr(vp + d0 * 4096 + ks * 1024), hi = vtr(vp + d0 * 4096 + ks * 1024 + 512);
            const bf16x8 vf = (bf16x8){lo[0], lo[1], lo[2], lo[3], hi[0], hi[1], hi[2], hi[3]};
            o[d0] = __builtin_amdgcn_mfma_f32_32x32x16_bf16(vf, __builtin_bit_cast(bf16x8, kk ? pa1 : pa0), o[d0], 0, 0, 0); }
}
struct SlotD { int kind, t, idx; };
__device__ __forceinline__ constexpr SlotD slot_desc(int g) {
    if (g < 4) return SlotD{0, 0, g};
    if (g < 8) return SlotD{0, 1, g - 4};
    if (g < 56) { const int tt = (g - 8) / 8 + 1, i = (g - 8) % 8; return (i & 1) ? SlotD{1, tt - 1, i >> 1} : SlotD{0, tt + 1, i >> 1}; }
    if (g < 60) return SlotD{1, 6, g - 56};
    return SlotD{1, 7, g - 60};
}
template <bool BIAS>
struct TileMath {
    f32x16 P[2]; unsigned pk[2][8]; v4u fr[3]; f32x2_t lv[4]; float e0, e1, l0, l1;
    f32x16* o; lds_cptr kb, vp0; const bf16x8* qr; const f32x16* cinit; LAS const float* lutp;
    template <int G> __device__ __forceinline__ v4u load_frag() { constexpr SlotD d = slot_desc(G);
        if (d.kind == 0) return *(LAS const v4u*)(kb + (d.t >> 1) * 8192 + (d.t & 1) * 512 + d.idx * 2048);
        constexpr int d0 = d.idx >> 1, ks = 2 * (d.t & 1) + (d.idx & 1); lds_cptr vp = vp0 + (d.t >> 1) * 8192 + d0 * 4096 + ks * 1024;
        const s16x4 a = vtr(vp), c = vtr(vp + 512); return __builtin_bit_cast(v4u, (bf16x8){a[0], a[1], a[2], a[3], c[0], c[1], c[2], c[3]}); }
    template <int Q> __device__ __forceinline__ f32x2_t lut_pair() { constexpr int t = Q >> 3, r0 = 2 * (Q & 7), ko = 64 * (t >> 1) + 32 * (t & 1) + (r0 & 3) + 8 * (r0 >> 2); return (f32x2_t){lutp[ko], lutp[ko + 1]}; }
    template <int Q> __device__ __forceinline__ void chunk() { constexpr int t = Q >> 3, c = Q & 7;
        if constexpr (Q > 0) { l0 += e0; l1 += e1; pk[((Q - 1) >> 3) & 1][(Q - 1) & 7] = cvtpk(e0, e1); }
        float x0 = P[t & 1][2 * c], x1 = P[t & 1][2 * c + 1];
        if constexpr (BIAS) { x0 += lv[Q & 3][0]; x1 += lv[Q & 3][1]; if constexpr (Q + 3 < 64) lv[(Q + 3) & 3] = lut_pair<Q + 3>(); }
        e0 = __builtin_amdgcn_exp2f(x0); e1 = __builtin_amdgcn_exp2f(x1); }
    template <int G> __device__ __forceinline__ void slot() {
        if constexpr (G + 2 < 64) fr[(G + 2) % 3] = load_frag<G + 2>();
        { constexpr SlotD d = slot_desc(G); const bf16x8 a = __builtin_bit_cast(bf16x8, fr[G % 3]);
          if constexpr (d.kind == 0) { if constexpr (d.idx == 0) P[d.t & 1] = __builtin_amdgcn_mfma_f32_32x32x16_bf16(a, qr[0], *cinit, 0, 0, 0); else P[d.t & 1] = __builtin_amdgcn_mfma_f32_32x32x16_bf16(a, qr[d.idx], P[d.t & 1], 0, 0, 0); }
          else { constexpr int d0 = d.idx >> 1, kk = d.idx & 1;
              o[d0] = __builtin_amdgcn_mfma_f32_32x32x16_bf16(a, __builtin_bit_cast(bf16x8, (v4u){pk[d.t & 1][4 * kk], pk[d.t & 1][4 * kk + 1], pk[d.t & 1][4 * kk + 2], pk[d.t & 1][4 * kk + 3]}), o[d0], 0, 0, 0); } }
        if constexpr (G >= 4 && G < 8) { chunk<2 * (G - 4)>(); chunk<2 * (G - 4) + 1>(); }
        else if constexpr (G >= 8 && G < 56) chunk<G>();
        else if constexpr (G >= 56 && G < 60) { chunk<56 + 2 * (G - 56)>(); chunk<56 + 2 * (G - 56) + 1>(); if constexpr (G == 59) { l0 += e0; l1 += e1; pk[1][7] = cvtpk(e0, e1); } }
        __builtin_amdgcn_sched_barrier(0);
    }
    template <int... G> __device__ __forceinline__ void run(std::integer_sequence<int, G...>) { (slot<G>(), ...); }
};
template <bool BIAS>
__device__ __forceinline__ void tile_math(f32x16* o, float& l, lds_cptr Kl, lds_cptr vp0, const bf16x8* qr, const f32x16& cinit, LAS const float* lutp, int r32, int hi) {
    TileMath<BIAS> T; T.o = o; T.kb = Kl + hi * 1024 + r32 * 16; T.vp0 = vp0; T.qr = qr; T.cinit = &cinit; T.lutp = lutp; T.e0 = T.e1 = T.l0 = T.l1 = 0.f;
    if constexpr (BIAS) { T.lv[0] = T.template lut_pair<0>(); T.lv[1] = T.template lut_pair<1>(); T.lv[2] = T.template lut_pair<2>(); }
    T.fr[0] = T.template load_frag<0>(); T.fr[1] = T.template load_frag<1>();
    __builtin_amdgcn_sched_barrier(0);
    T.run(std::make_integer_sequence<int, 64>{});
    l += T.l0 + T.l1;
}
__device__ __forceinline__ void load_q_raw(bf16x8* qr, const GAS bf16* Qb, size_t qrow, int b, int h, int hi) {
#pragma unroll
    for (int d0 = 0; d0 < 4; ++d0) { const v4u v = *(const GAS v4u*)(Qb + hm_off(qrow, b, h) + d0 * 16 + hi * 8); qr[d0] = __builtin_bit_cast(bf16x8, v); }
}
__device__ __forceinline__ float q_norm2(const bf16x8* qr) {
    float q2 = 0.f;
#pragma unroll
    for (int d0 = 0; d0 < 4; ++d0) { const v4u v = __builtin_bit_cast(v4u, qr[d0]);
#pragma unroll
        for (int j = 0; j < 4; ++j) { const float a = __builtin_bit_cast(float, v[j] << 16), c = __builtin_bit_cast(float, v[j] & 0xffff0000u); q2 += a * a + c * c; } }
    return swap_add(q2);
}

__device__ __forceinline__ float ref_exponent(float q2, float kmax2, float bmax) { return __builtin_sqrtf(q2 * kmax2) * 1.002f + bmax + 0.01f; }
__device__ __forceinline__ void head_bounds(const GAS float* KBM, const GAS float* rel_bias, int bh, int h, int lane, float& kmax2, float& bmax) {
    float k = KBM[bh * 32 + (lane & 31)], bb = rel_bias[(lane & 31) * NH + h] * LOG2E;
#pragma unroll
    for (int o = 1; o < 32; o <<= 1) { k = fmaxf(k, shx(k, o, lane)); bb = fmaxf(bb, shx(bb, o, lane)); }
    kmax2 = k; bmax = bb;
}
__device__ __forceinline__ void store_row(GAS bf16* rowp, const f32x16* o, float scale, int hi, bool act) {
    unsigned w0[8], w1[8];
#pragma unroll
    for (int k = 0; k < 4; ++k) { w0[2 * k] = cvtpk(o[0][4 * k] * scale, o[0][4 * k + 1] * scale); w0[2 * k + 1] = cvtpk(o[0][4 * k + 2] * scale, o[0][4 * k + 3] * scale);
        w1[2 * k] = cvtpk(o[1][4 * k] * scale, o[1][4 * k + 1] * scale); w1[2 * k + 1] = cvtpk(o[1][4 * k + 2] * scale, o[1][4 * k + 3] * scale); }
#pragma unroll
    for (int i = 0; i < 8; ++i) { auto r = __builtin_amdgcn_permlane32_swap(w0[i], w1[i], false, false); w0[i] = r[0]; w1[i] = r[1]; }
    if (act) {
#pragma unroll
        for (int k = 0; k < 4; ++k) *(GAS v4u*)(rowp + 32 * hi + 8 * k) = (v4u){w0[2 * k], w0[2 * k + 1], w1[2 * k], w1[2 * k + 1]}; }
}
__device__ __forceinline__ void add_row(f32x16* o, const GAS bf16* rowp, int hi) {
    v4u v[4];
#pragma unroll
    for (int k = 0; k < 4; ++k) v[k] = *(const GAS v4u*)(rowp + 32 * hi + 8 * k);
#pragma unroll
    for (int k = 0; k < 4; ++k) { auto r0 = __builtin_amdgcn_permlane32_swap(v[k][0], v[k][2], false, false); auto r1 = __builtin_amdgcn_permlane32_swap(v[k][1], v[k][3], false, false);
        o[0][4 * k] += __builtin_bit_cast(float, r0[0] << 16); o[0][4 * k + 1] += __builtin_bit_cast(float, r0[0] & 0xffff0000u);
        o[0][4 * k + 2] += __builtin_bit_cast(float, r1[0] << 16); o[0][4 * k + 3] += __builtin_bit_cast(float, r1[0] & 0xffff0000u);
        o[1][4 * k] += __builtin_bit_cast(float, r0[1] << 16); o[1][4 * k + 1] += __builtin_bit_cast(float, r0[1] & 0xffff0000u);
        o[1][4 * k + 2] += __builtin_bit_cast(float, r1[1] << 16); o[1][4 * k + 3] += __builtin_bit_cast(float, r1[1] & 0xffff0000u); }
}
__device__ __forceinline__ GAS bf16* po_row(GAS unsigned char* ws, GAS float* outbuf, int b, int h, int t, int slot) {
    return (b < 2 ? (GAS bf16*)outbuf : (GAS bf16*)(ws + WS_POB)) + ((((size_t)((b & 1) * 16 + h) * SEQ + t) * 3 + slot) * 64);
}

__device__ __forceinline__ void route(Frame& F) {
    GAS unsigned char* ws = F.ws;
    const GAS bf16* Qb = (const GAS bf16*)(ws + WS_Q); const GAS bf16* Kb = (const GAS bf16*)(ws + WS_K);
    const GAS float* KMP = (const GAS float*)(ws + WS_KMP);
    GAS unsigned short* SEG = (GAS unsigned short*)(ws + WS_SEG); GAS unsigned* CNT = (GAS unsigned*)(ws + WS_CNT); GAS unsigned* TOT = (GAS unsigned*)(ws + WS_CTL) + CW_TOT;
    GAS float* KBM = (GAS float*)(ws + WS_KBM);
    int tid = F.wave * 64 + lane_id(); asm volatile("" : "+v"(tid));
    const int hf = tid >> 8, t = tid & 255, lane = tid & 63, w4 = (tid >> 6) & 3;
    LAS float* kms = (LAS float*)(F.lds + hf * 16384);
    LAS unsigned* cntw = (LAS unsigned*)(F.lds + hf * 16384 + 8192);
    LAS float* kbw = (LAS float*)(F.lds + hf * 16384 + 8192 + 512);
    for (int it = 0; it < 4; ++it) {
        const int id = it * 512 + F.vcu * 2 + hf, own = id >> 6, bh = id & 63, b = bh >> 4, h = bh & 15;
        __syncthreads();
        for (int i = t; i < NBLK * 64; i += 256) { const int n = i >> 6, d = i & 63; const size_t o = ((size_t)(b * 32 + n) * 2) * 1024 + h * 64 + d; kms[i] = (KMP[o] + KMP[o + 1024]) * (1.0f / 256.0f); }
        const size_t row = (size_t)b * SEQ + own * BLK + t;
        float q[64];
        { const GAS v4u* qp = (const GAS v4u*)(Qb + hm_off(row, b, h));
#pragma unroll
          for (int i = 0; i < 8; ++i) { const v4u v = qp[i];
#pragma unroll
              for (int j = 0; j < 4; ++j) { q[8 * i + 2 * j] = __builtin_bit_cast(float, v[j] << 16); q[8 * i + 2 * j + 1] = __builtin_bit_cast(float, v[j] & 0xffff0000u); } } }
        { const GAS v4u* kp = (const GAS v4u*)(Kb + hm_off(row, b, h)); float k2 = 0.f;
#pragma unroll
          for (int i = 0; i < 8; ++i) { const v4u v = kp[i];
#pragma unroll
              for (int j = 0; j < 4; ++j) { const float a = __builtin_bit_cast(float, v[j] << 16), c = __builtin_bit_cast(float, v[j] & 0xffff0000u); k2 += a * a + c * c; } }
#pragma unroll
          for (int o = 1; o < 64; o <<= 1) k2 = fmaxf(k2, shx(k2, o, lane));
          if (lane == 0) kbw[w4] = k2; }
        __syncthreads();
        float g1 = -INFINITY, g2 = -INFINITY, g3 = -INFINITY; int i1 = -1, i2 = -1, i3 = -1;
        for (int n = 0; n < own; ++n) {
            float g = 0.f;
#pragma unroll
            for (int d4 = 0; d4 < 16; ++d4) { const f32x4 kv = *(const LAS f32x4*)(kms + n * 64 + 4 * d4); g += q[4 * d4] * kv[0] + q[4 * d4 + 1] * kv[1] + q[4 * d4 + 2] * kv[2] + q[4 * d4 + 3] * kv[3]; }
            if (g > g1) { g3 = g2; i3 = i2; g2 = g1; i2 = i1; g1 = g; i1 = n; }
            else if (g > g2) { g3 = g2; i3 = i2; g2 = g; i2 = n; }
            else if (g > g3) { g3 = g; i3 = n; }
        }
        for (int n = 0; n < own; ++n) { const unsigned long long mm = __ballot(i1 == n || i2 == n || i3 == n); if (lane == 0) cntw[w4 * 32 + n] = (unsigned)__popcll(mm); }
        __syncthreads();
        for (int n = 0; n < own; ++n) { const bool has = (i1 == n || i2 == n || i3 == n); const unsigned long long mm = __ballot(has);
            if (has) { unsigned base = 0; for (int w = 0; w < w4; ++w) base += cntw[w * 32 + n];
                const unsigned rank = (unsigned)__popcll(mm & ((1ull << lane) - 1ull)); const unsigned slot = (i1 == n) ? 0u : (i2 == n) ? 1u : 2u;
                SEG[(((size_t)bh * 32 + own) * 32 + n) * 256 + base + rank] = (unsigned short)(t | (slot << 8)); } }
        if (t < own) { const unsigned c = cntw[t] + cntw[32 + t] + cntw[64 + t] + cntw[96 + t]; CNT[((size_t)bh * 32 + own) * 32 + t] = c; (void)__hip_atomic_fetch_add(TOT + bh * 31 + t, c, RLX_AGENT); }
        if (t == 0) KBM[bh * 32 + own] = fmaxf(fmaxf(kbw[0], kbw[1]), fmaxf(kbw[2], kbw[3]));
    }
    __syncthreads();
}

struct GTile { unsigned info; bf16x8 qr[4]; };
struct GRun { int e, c0, c1; };
__device__ __forceinline__ void dma_kv(LAS unsigned char* kv, const GAS bf16* Kb, const GAS bf16* Vb, int b, int h, int n, int w, int lane) {
#pragma unroll
    for (int t = 0; t < 4; ++t) {
        const size_t kr = (size_t)b * SEQ + n * BLK + 64 * t + lane, vr = (size_t)b * SEQ + n * BLK + 64 * t + 16 * (w & 3) + (lane >> 2);
        __builtin_amdgcn_global_load_lds((const GAS unsigned*)(Kb + hm_off(kr, b, h) + w * 8), (LAS unsigned*)(kv + L_K + t * 8192 + w * 1024), 16, 0, 0);
        __builtin_amdgcn_global_load_lds((const GAS unsigned*)(Vb + hm_off(vr, b, h) + (w >> 2) * 32 + (lane & 3) * 8), (LAS unsigned*)(kv + L_V + t * 8192 + w * 1024), 16, 0, 0);
    }
}
__device__ __forceinline__ void gather(Frame& F) {
    GAS unsigned char* ws = F.ws;
    const GAS bf16* Qb = (const GAS bf16*)(ws + WS_Q); const GAS bf16* Kb = (const GAS bf16*)(ws + WS_K); const GAS bf16* Vb = (const GAS bf16*)(ws + WS_V);
    const GAS unsigned short* SEG = (const GAS unsigned short*)(ws + WS_SEG); const GAS unsigned* CNT = (const GAS unsigned*)(ws + WS_CNT); const GAS unsigned* TOT = (const GAS unsigned*)(ws + WS_CTL) + CW_TOT;
    const GAS float* KBM = (const GAS float*)(ws + WS_KBM); GAS float* PL = (GAS float*)(ws + WS_PL);
    int tid = F.wave * 64 + lane_id(); asm volatile("" : "+v"(tid));
    const int lane = tid & 63, w = __builtin_amdgcn_readfirstlane(tid >> 6), r32 = lane & 31, hi = lane >> 5;
    LAS unsigned* pre = (LAS unsigned*)(F.lds + L_PRE);
    __syncthreads();
    if (w == 0) { unsigned loc = 0;
        for (int i = 0; i < 31; ++i) { const unsigned nc = (TOT[31 * lane + i] + 255u) >> 8; loc += nc + (nc ? 1u : 0u); }
        unsigned inc = loc;
#pragma unroll
        for (int o = 1; o < 64; o <<= 1) { const unsigned v = shup(inc, o, lane); if (lane >= o) inc += v; }
        unsigned run = inc - loc;
        for (int i = 0; i < 31; ++i) { pre[31 * lane + i] = run; const unsigned nc = (TOT[31 * lane + i] + 255u) >> 8; run += nc + (nc ? 1u : 0u); }
        if (lane == 63) pre[1984] = run; }
    __syncthreads();
    const int U = (int)pre[1984];
    int p = (int)(((long)F.vcu * U) / F.G); const int phi = (int)(((long)(F.vcu + 1) * U) / F.G);
    int e = 0; { int lo = 0, hi2 = 1984; while (hi2 - lo > 1) { const int mid = (lo + hi2) >> 1; if ((int)pre[mid] <= p) lo = mid; else hi2 = mid; } e = lo; }
    auto next_run = [&](GRun& R) -> bool {
        while (p < phi) {
            while (p >= (int)pre[e + 1]) ++e;
            const int k = p - (int)pre[e], nch = (int)pre[e + 1] - (int)pre[e] - 1;
            const int c0 = k > 0 ? k - 1 : 0; int c1 = phi - (int)pre[e] - 1; c1 = c1 < nch ? c1 : nch;
            p = (int)pre[e] + 1 + c1;
            if (c1 > c0) { R.e = e; R.c0 = c0; R.c1 = c1; return true; }
        }
        return false;
    };
    auto scan_cnt = [&](unsigned v) -> unsigned { unsigned inc = v;
#pragma unroll
        for (int o = 1; o < 32; o <<= 1) { const unsigned t2 = shup(inc, o, lane); if ((lane & 31) >= o) inc += t2; }
        return inc; };
    int cur_h = -1, cur_bh = -1, rb = 0; float kmax2 = 0.f, bmax = 0.f, rb31 = 0.f;
    GRun cur, nxt; bool hc = next_run(cur);
    unsigned cntN = 0, totN = 0, cumv = 0, tot = 0;
    if (hc) { const int bh = cur.e / 31, n = cur.e - bh * 31; dma_kv(F.lds, Kb, Vb, bh >> 4, bh & 15, n, w, lane);
        cntN = ((lane & 31) > n) ? CNT[((size_t)bh * 32 + (lane & 31)) * 32 + n] : 0u; totN = TOT[cur.e]; }
    GTile tcur, tnxt; unsigned ownB = 0, entB = 0xffffffffu; bool mine = false;
    auto fetch_ent = [&](int c, bool valid, int n, const GAS unsigned short* segb, unsigned cv, unsigned tt, unsigned& own_o) -> unsigned {
        const unsigned g0 = 256u * c + 32u * w, g = g0 + r32;
        const bool tile_ok = valid && g0 < tt;
        unsigned own = (unsigned)(n + 1), base = 0u;
        if (tile_ok) {
            int lo = n + 1, hi2 = 32;
            while (hi2 - lo > 1) { const int mid = (lo + hi2) >> 1; if (__builtin_amdgcn_readlane(cv, mid - 1) <= g0) lo = mid; else hi2 = mid; }
            own = (unsigned)lo; base = (lo == n + 1) ? 0u : __builtin_amdgcn_readlane(cv, lo - 1);
            for (int o = lo + 1; o < 32; ++o) { const unsigned s2 = __builtin_amdgcn_readlane(cv, o - 1); if (s2 > g0 + 31u) break; if (s2 <= g) { own = (unsigned)o; base = s2; } }
        }
        const bool lane_ok = tile_ok && g < tt;
        const unsigned idx = lane_ok ? (g - base) : 0u;
        const unsigned v = (unsigned)segb[(size_t)own * 32 * 256 + idx];
        own_o = own;
        return lane_ok ? v : 0xffffffffu;
    };
    auto make_tile = [&](unsigned ent, unsigned own, int b, int h, int n, GTile& T) {
        const bool act = ent != 0xffffffffu;
        const int tq = act ? (int)(own * BLK + (ent & 255u)) : SEQ - 1;
        T.info = (unsigned)tq | (act ? (((ent >> 8) & 3u) << 16) | (1u << 18) | ((own - n <= 4) ? (1u << 19) : 0u) : 0u);
        load_q_raw(T.qr, Qb, (size_t)b * SEQ + tq, b, h, hi);
    };
    auto start_run = [&](const GRun& R) {
        const int bh = R.e / 31, n = R.e - bh * 31; const GAS unsigned short* segb = SEG + ((size_t)bh * 32 * 32 + n) * 256;
        cumv = scan_cnt(cntN); tot = totN;
        mine = (unsigned)(256 * R.c0 + 32 * w) < tot;
        entB = 0xffffffffu; ownB = 0;
        if (mine) { unsigned ownA; const unsigned entA = fetch_ent(R.c0, true, n, segb, cumv, tot, ownA); make_tile(entA, ownA, bh >> 4, bh & 15, n, tcur);
            entB = fetch_ent(R.c0 + 1, R.c0 + 1 < R.c1, n, segb, cumv, tot, ownB); }
    };
    if (hc) start_run(cur);
    while (hc) {
        const bool hn = next_run(nxt);
        const int c0 = cur.c0, c1 = cur.c1, bh = cur.e / 31, n = cur.e - bh * 31, b = bh >> 4, h = bh & 15;
        const GAS unsigned short* segb = SEG + ((size_t)bh * 32 * 32 + n) * 256;
        LAS unsigned char* kv = F.lds + rb * 65536;
        __builtin_amdgcn_s_waitcnt(0x0F70);
        __syncthreads();
        if (hn) { const int bh2 = nxt.e / 31, n2 = nxt.e - bh2 * 31;
            cntN = ((lane & 31) > n2) ? CNT[((size_t)bh2 * 32 + (lane & 31)) * 32 + n2] : 0u; totN = TOT[nxt.e]; }
        if (bh != cur_bh) { head_bounds(KBM, F.rel_bias, bh, h, lane, kmax2, bmax); rb31 = F.rel_bias[31 * NH + h] * LOG2E; cur_bh = bh;
            if (h != cur_h) { build_lut(F.lds, F.rel_bias, h, tid); cur_h = h; __syncthreads(); } }
        const lds_cptr Kl = (lds_cptr)(kv + L_K), vp0 = (lds_cptr)(kv + L_V) + ((lane >> 4) & 1) * 32 + (lane & 3) * 8 + (4 * hi + ((lane & 15) >> 2)) * 64;
        if (mine) for (int c = c0; c < c1; ++c) {
            if ((unsigned)(256 * c + 32 * w) >= tot) break;
            make_tile(entB, ownB, b, h, n, tnxt);
            entB = fetch_ent(c + 2, c + 2 < c1, n, segb, cumv, tot, ownB);
            const unsigned info = tcur.info; const int tq = (int)(info & 0xffffu); const bool near = (info >> 19) & 1u;
            const float mref = ref_exponent(q_norm2(tcur.qr), kmax2, bmax);
            const bool anynear = __any(near);
            const int tqrel = near ? (tq - n * BLK) : 1755;
            LAS const float* lutp = (LAS const float*)(F.lds + L_LUT) + (2047 - tqrel + 4 * hi);
            f32x16 cinit; { const float cc = anynear ? -mref : (rb31 - mref);
#pragma unroll
                for (int r = 0; r < 16; ++r) cinit[r] = cc; }
            f32x16 o[2]; o[0] = f32x16{}; o[1] = f32x16{}; float l = 0.f;
            if (anynear) tile_math<true>(o, l, Kl, vp0, tcur.qr, cinit, lutp, r32, hi); else tile_math<false>(o, l, Kl, vp0, tcur.qr, cinit, lutp, r32, hi);
            l = swap_add(l);
            { const bool act = (info >> 18) & 1u; const int slot = (int)((info >> 16) & 3u);
              GAS bf16* dump = (GAS bf16*)(ws + WS_DUMP) + (size_t)F.vcu * 4096 + lane * 64;
              store_row(act ? po_row(ws, F.out, b, h, tq, slot) : dump - 32 * hi, o, 1.0f, hi, true);
              GAS float* plp = act ? PL + (((size_t)bh * SEQ + tq) * 3) + slot : (GAS float*)dump;
              *plp = l; }
            tcur = tnxt;
        }
        if (hn) { start_run(nxt);
            const int bh2 = nxt.e / 31, n2 = nxt.e - bh2 * 31; dma_kv(F.lds + (rb ^ 1) * 65536, Kb, Vb, bh2 >> 4, bh2 & 15, n2, w, lane); }
        cur = nxt; hc = hn; rb ^= 1;
    }
    asm volatile("s_waitcnt vmcnt(0)" ::: "memory");
    __syncthreads();
}

__device__ __forceinline__ void own_block(Frame& F) {
    GAS unsigned char* ws = F.ws;
    const GAS bf16* Qb = (const GAS bf16*)(ws + WS_Q); const GAS bf16* Kb = (const GAS bf16*)(ws + WS_K); const GAS bf16* Vb = (const GAS bf16*)(ws + WS_V); GAS bf16* Ob = (GAS bf16*)(ws + WS_O);
    const GAS float* KBM = (const GAS float*)(ws + WS_KBM); const GAS float* PL = (const GAS float*)(ws + WS_PL);
    int tid = F.wave * 64 + lane_id(); asm volatile("" : "+v"(tid));
    const int lane = tid & 63, w = __builtin_amdgcn_readfirstlane(tid >> 6), r32 = lane & 31, hi = lane >> 5;
    const int bh = F.vcu & 63, b = bh >> 4, h = bh & 15, own0 = F.vcu >> 6, nun = (NBLK - own0 + 3) / 4;
    __syncthreads();
    build_lut(F.lds, F.rel_bias, h, tid);
    float kmax2, bmax; head_bounds(KBM, F.rel_bias, bh, h, lane, kmax2, bmax);
    const int qrel = 32 * w + r32;
    LAS const float* lutp = (LAS const float*)(F.lds + L_LUT) + (2047 - qrel + 4 * hi);
    const int jd = w >> 1;
    bf16x8 qn[4];
    dma_kv(F.lds, Kb, Vb, b, h, own0, w, lane);
    load_q_raw(qn, Qb, (size_t)b * SEQ + own0 * BLK + qrel, b, h, hi);
    for (int i = 0; i < nun; ++i) {
        const int own = own0 + 4 * i; const size_t qrow = (size_t)b * SEQ + own * BLK + qrel;
        LAS unsigned char* kv = F.lds + (i & 1) * 65536;
        bf16x8 qr[4];
#pragma unroll
        for (int d0 = 0; d0 < 4; ++d0) qr[d0] = qn[d0];
        asm volatile("s_waitcnt vmcnt(0)" ::: "memory");
        __syncthreads();
        if (i + 1 < nun) { dma_kv(F.lds + ((i + 1) & 1) * 65536, Kb, Vb, b, h, own + 4, w, lane); load_q_raw(qn, Qb, qrow + 4 * BLK, b, h, hi); }
        const float mref = ref_exponent(q_norm2(qr), kmax2, bmax);
        f32x16 cinit;
#pragma unroll
        for (int r = 0; r < 16; ++r) cinit[r] = -mref;
        f32x16 o[2]; o[0] = f32x16{}; o[1] = f32x16{}; float l = 0.f;
        const lds_cptr Kl = (lds_cptr)(kv + L_K), vp0 = (lds_cptr)(kv + L_V) + ((lane >> 4) & 1) * 32 + (lane & 3) * 8 + (4 * hi + ((lane & 15) >> 2)) * 64;
        for (int j = 0; j <= jd; ++j) { f32x16 p0, p1; v4u pa[4];
            qk_tile(p0, p1, Kl + j * 8192, qr, cinit, r32, hi);
            if (j == jd) softmax_tile<true, true>(p0, p1, lutp, j, qrel, hi, l, pa); else softmax_tile<true, false>(p0, p1, lutp, j, qrel, hi, l, pa);
            pv_tile(o, vp0 + j * 8192, pa); }
        l = swap_add(l);
        const int nsl = own < 3 ? own : 3; const int tq = own * BLK + qrel;
        for (int sl = 0; sl < nsl; ++sl) { add_row(o, po_row(ws, F.out, b, h, tq, sl), hi); l += PL[(((size_t)bh * SEQ + tq) * 3) + sl]; }
        store_row(Ob + qrow * D + h * 64, o, 1.0f / l, hi, true);
    }
    asm volatile("s_waitcnt vmcnt(0)" ::: "memory");
    __syncthreads();
}
}

__device__ __forceinline__ void final_norm(Frame& Fr) {
    struct { int lane, vcu, wave, G; const GAS float* norm_final; GAS float* out; } F{Fr.wave * 64 + lane_id(), Fr.vcu, Fr.wave, Fr.G, Fr.norm_final, Fr.out};
    asm volatile("" : "+v"(F.lane)); F.lane &= 63;
    const int gw = F.vcu * NWAVES + F.wave, NGW = F.G * NWAVES;
    f32x4 gam[4];
#pragma unroll
    for (int j = 0; j < 4; ++j) gam[j] = *(const GAS f32x4*)(F.norm_final + 4 * (F.lane + 64 * j));
    for (int row = gw; row < M; row += NGW) { GAS float* xr = F.out + (size_t)row * D; f32x4 v[4]; float ss = 0.f;
#pragma unroll
        for (int j = 0; j < 4; ++j) { v[j] = *(const GAS f32x4*)(xr + 4 * (F.lane + 64 * j)); ss += (v[j][0] * v[j][0] + v[j][1] * v[j][1]) + (v[j][2] * v[j][2] + v[j][3] * v[j][3]); }
#pragma unroll
        for (int o = 1; o < 64; o <<= 1) ss += shx(ss, o, F.lane);
        const float rstd = rsqrtf(ss * (1.0f / D) + EPS);
#pragma unroll
        for (int j = 0; j < 4; ++j) *(GAS f32x4*)(xr + 4 * (F.lane + 64 * j)) = v[j] * rstd * gam[j]; }
}

__global__ void __launch_bounds__(NWAVES * 64, 2) fwd_megakernel(Args args) {
    __shared__ __attribute__((aligned(16))) unsigned char lds[LDS_BYTES];
    Frame F;
    F.lds = (LAS unsigned char*)lds;
    F.tid = threadIdx.x; F.lane = F.tid & 63; F.wave = __builtin_amdgcn_readfirstlane(F.tid >> 6);
    F.G = gridDim.x; { const int bx = blockIdx.x; F.vcu = (F.G % 8 == 0) ? (bx % 8) * (F.G / 8) + bx / 8 : bx; }
    F.x = args.in[0]; F.c = args.in[1]; F.rel_bias = args.in[2]; F.w_mod = args.in[3]; F.b_mod = args.in[4]; F.norm_mix = args.in[5]; F.norm_mlp = args.in[6];
    F.w_pool = args.in[7]; F.pool_scale = args.in[8]; F.w_qkv = args.in[9]; F.w_o = args.in[10]; F.w_up = args.in[11]; F.w_down = args.in[12]; F.norm_final = args.in[13];
    F.out = args.out; F.ws = args.ws;
    volatile LAS unsigned* MISC = (volatile LAS unsigned*)(F.lds + MISC_OFF);
    for (int u = F.tid; u < (LDS_BYTES - LDSCTL_OFF) / 4; u += NWAVES * 64) ((LAS unsigned*)(F.lds + LDSCTL_OFF))[u] = 0u;
    __syncthreads();
    gu32* ctl = (gu32*)(F.ws + WS_CTL);
    XcdBarrier bar = xcd_barrier_post((GAS unsigned*)(ctl + CW_BAR), MISC + 8); bar.wave = F.wave;
    GAS unsigned char* ws = F.ws;
#define WSB(off) ((GAS bf16*)(ws + (off)))
#define WSF(off) ((GAS float*)(ws + (off)))

    p0_prologue(F);
    xcd_barrier(bar);
    p1_bias(F); p1_pool(F);
    xcd_barrier(bar);

    for (int ph = 0; ph < 10; ++ph) {
        asm volatile("" : "+s"(ws));
        const GAS float* MOD = WSF(WS_MOD); GAS float* SS = WSF(WS_SS);
        const int kind = (ph == 0 || ph == 2 || ph == 7) ? 0 : (ph == 1 || ph == 8) ? 1 : (ph == 3) ? 2 : (ph == 4) ? 3 : (ph == 5) ? 4 : (ph == 6) ? 5 : 7;
        if (kind == 0) {
            pg8::Gemm g; pg8::EpiRes E;
            if (ph == 0) { g = pg8::Gemm{WSB(WS_XNA), WSB(WS_WPOOL), M, D, 256, D, 256, 512};
                E = pg8::EpiRes{WSB(WS_XR), WSB(WS_XR), MOD + 2048, F.pool_scale, F.norm_mlp, MOD + 4096, WSB(WS_XNB), SS}; }
            else if (ph == 2) { g = pg8::Gemm{WSB(WS_HB), WSB(WS_WDN0), M, D, FF, 256, 0, 131072};
                E = pg8::EpiRes{WSB(WS_XR), WSB(WS_XR), MOD + 5120, nullptr, F.norm_mix + D, MOD + 4 * 6144 + 1024, WSB(WS_XNA), SS}; }
            else { g = pg8::Gemm{WSB(WS_O), WSB(WS_WO), M, D, D, D, 0, 512};
                E = pg8::EpiRes{WSB(WS_XR), WSB(WS_XR), MOD + 4 * 6144 + 2048, nullptr, F.norm_mlp + D, MOD + 4 * 6144 + 4096, WSB(WS_XNB), SS}; }
            pg8::StaticOrder S; S.init(M, D, F.G, (int)blockIdx.x);
            pg8::gemm_phase<pg8::EpiRes, pg8::StaticOrder, true>(F.lds + RING_OFF, g, S, E, F.wave);
        } else if (kind == 1) {
            const pg8::Gemm g{WSB(WS_XNB), WSB(ph == 1 ? WS_WUP0 : WS_WUP1), M, FF, D, 256, 0, 131072};
            const pg8::EpiUp E{SS, WSF(ph == 1 ? WS_BIAS_UP0 : WS_BIAS_UP1), WSB(WS_HB), FF, F.lds, 0};
            pg8::StaticOrder S; S.init(M, FF, F.G, (int)blockIdx.x);
            pg8::gemm_phase<pg8::EpiUp, pg8::StaticOrder, true>(F.lds + RING_OFF, g, S, E, F.wave);
        } else if (kind == 2) {
            const pg8::Gemm g{WSB(WS_XNA), WSB(WS_WQKV), M, NQKV, D, 256, 0, 131072};
            const pg8::EpiQKV E{SS, WSF(WS_BIAS_QKV), WSB(WS_Q), (size_t)(WS_K - WS_Q) / 2, WSF(WS_KMP), F.lds, 0};
            pg8::StaticOrder S; S.init(M, NQKV, F.G, (int)blockIdx.x);
            pg8::gemm_phase<pg8::EpiQKV, pg8::StaticOrder, true>(F.lds + RING_OFF, g, S, E, F.wave);
        } else if (kind == 3) { F.ws = ws; att::route(F);
        } else if (kind == 4) { F.ws = ws; att::gather(F);
        } else if (kind == 5) { F.ws = ws; att::own_block(F);
        } else {
            const pg8::Gemm g{WSB(WS_HB), WSB(WS_WDN1), M, D, FF, 256, 0, 131072};
            const pg8::EpiFinal E{WSB(WS_XR), F.out, MOD + 4 * 6144 + 5120, F.norm_final, SS, (GAS unsigned*)(ws + WS_CTL) + CW_FIN};
            pg8::StaticOrder S; S.init(M, D, F.G, (int)blockIdx.x);
            pg8::gemm_phase<pg8::EpiFinal, pg8::StaticOrder, true>(F.lds + RING_OFF, g, S, E, F.wave);
            break;
        }
        xcd_barrier(bar);
    }
}

extern "C" void kernel_launch(void* const* d_in, const int* in_sizes, int n_in, void* d_out, int out_size, void* d_ws, size_t ws_size, hipStream_t stream) {
    static int grid = 0;
    if (grid == 0) {
        if (n_in != 14 || in_sizes[0] != M * D || out_size != M * D || ws_size < WS_END) { fprintf(stderr, "kernel_launch: unexpected shapes / workspace (n_in %d, in0 %d, out %d, ws %zu)\n", n_in, n_in > 0 ? in_sizes[0] : -1, out_size, ws_size); grid = -1; return; }
        int dev = 0, cus = 0, per_cu = 0;
        if (hipGetDevice(&dev) != hipSuccess || hipDeviceGetAttribute(&cus, hipDeviceAttributeMultiprocessorCount, dev) != hipSuccess) { grid = -1; return; }
        if (hipOccupancyMaxActiveBlocksPerMultiprocessor(&per_cu, (const void*)fwd_megakernel, NWAVES * 64, 0) != hipSuccess || per_cu < 1) { fprintf(stderr, "kernel_launch: occupancy query says %d blocks per CU\n", per_cu); }
        (void)hipGetLastError();
        grid = cus;
    }
    if (grid < 0) return;
    if (hipMemsetAsync((char*)d_ws + WS_CTL, 0, CTL_ZERO_BYTES, stream) != hipSuccess) return;
    Args a{};
    for (int i = 0; i < 14; ++i) a.in[i] = (const GAS float*)d_in[i];
    a.out = (GAS float*)d_out; a.ws = (GAS unsigned char*)d_ws;
    hipLaunchKernelGGL(fwd_megakernel, dim3(grid), dim3(NWAVES * 64), 0, stream, a);
}
```

```cpp
#include <hip/hip_runtime.h>
#include <utility>
#include <cstdio>
#include <cstdint>

__device__ __forceinline__ float shx(float v, int m, int lane) { return __builtin_bit_cast(float, __builtin_amdgcn_ds_bpermute((lane ^ m) << 2, __builtin_bit_cast(int, v))); }
__device__ __forceinline__ unsigned shup(unsigned v, int o, int lane) { return (unsigned)__builtin_amdgcn_ds_bpermute(((lane - o) & 63) << 2, (int)v); }
__device__ __forceinline__ size_t hm_off(size_t row, int b, int h) { return (row + (size_t)(15 * b + h) * 8192) * 64; }
__device__ __forceinline__ int lane_id() { unsigned z = 0u; asm volatile("" : "+s"(z)); return (int)__builtin_amdgcn_mbcnt_hi(~0u, __builtin_amdgcn_mbcnt_lo(~0u, z)); }

namespace pg8 {
#define PG8_LAS __attribute__((address_space(3)))
#define PG8_GAS __attribute__((address_space(1)))
typedef unsigned short bf16_t;
typedef short bf16x8 __attribute__((ext_vector_type(8)));
typedef float f32x4 __attribute__((ext_vector_type(4)));
typedef unsigned u32x4 __attribute__((ext_vector_type(4)));
constexpr int BM = 256, BK = 64, HALF = 128, HTB = HALF * BK * 2, STAGE_BYTES = 8 * HTB, NXCD = 8, WGM = 8;

__host__ __device__ __forceinline__ int lds_byte(int r, int c) { const int st = (r >> 4) * 2 + (c >> 5), rr = r & 15, cc = c & 31, ob = rr * 64 + cc * 2; return st * 1024 + (ob ^ (((ob >> 9) & 1) << 5)); }
__host__ __device__ __forceinline__ void stage_rc(int b, int& R, int& C) { const int st = b / 1024, sb = b % 1024, swz = sb ^ (((sb >> 9) & 1) << 5); R = (st >> 1) * 16 + swz / 64; C = (st & 1) * 32 + (swz % 64) / 2; }
__host__ __device__ __forceinline__ int perm32(int rho) { const int n = rho >> 4, i = rho & 15; return 8 * (i >> 2) + 4 * n + (i & 3); }

struct Unit { int pm, pn; };
struct Gemm { const PG8_GAS bf16_t* A; const PG8_GAS bf16_t* Bt; int M, N, K, lda, a_pn_off, a_tileb; };

struct StaticOrder {
    int nM, nN, nwg, G, c;
    __host__ __device__ void init(int M, int N, int G_, int c_) { nM = M / BM; nN = N / BM; nwg = nM * nN; G = G_; c = c_; }
    __host__ __device__ bool next(int i, Unit& u) const {
        const long L = (long)i * G + c; if (L >= nwg) return false;
        int wgid = (int)L; { const int q = nwg / NXCD, r = nwg % NXCD, xcd = wgid % NXCD, off = wgid / NXCD; wgid = (xcd < r ? xcd * (q + 1) : r * (q + 1) + (xcd - r) * q) + off; }
        const int nig = WGM * nN, gid = wgid / nig, fm = gid * WGM, gsz = (nM - fm) < WGM ? (nM - fm) : WGM;
        u.pm = fm + ((wgid % nig) % gsz); u.pn = (wgid % nig) / gsz; return true;
    }
};

__device__ __forceinline__ unsigned cvt_pk_bf16(float lo, float hi) { unsigned r; asm volatile("v_cvt_pk_bf16_f32 %0, %1, %2" : "=v"(r) : "v"(lo), "v"(hi)); return r; }

constexpr int SEQ_ = 8192;
constexpr float EPS_ = 1e-6f;
constexpr float C2_ = 0.125f * 1.4426950408889634f;


__device__ __forceinline__ float row_rstd(const PG8_GAS float* SS, int row, int fq, int fr) {
    const f32x4 s4 = *(const PG8_GAS f32x4*)(SS + (size_t)row * 16 + 4 * fq);
    float s = (s4[0] + s4[1]) + (s4[2] + s4[3]);
    const int ln = fq * 16 + fr; s += shx(s, 16, ln); s += shx(s, 32, ln);
    return rsqrtf(s * (1.0f / 1024.0f) + EPS_);
}

constexpr int RSTD_TAB_OFF = 132096;
__device__ __forceinline__ void fill_rstd_tab(PG8_LAS unsigned char* ldsbase, int par, const PG8_GAS float* SS, int pm, int wid, int lane) {
    if (lane < 32) { const int r = wid * 32 + lane; const PG8_GAS f32x4* p = (const PG8_GAS f32x4*)(SS + (size_t)(pm * BM + r) * 16);
        const f32x4 a = p[0], b = p[1], c = p[2], d = p[3];
        const float g0 = (a[0] + a[1]) + (a[2] + a[3]), g1 = (b[0] + b[1]) + (b[2] + b[3]), g2 = (c[0] + c[1]) + (c[2] + c[3]), g3 = (d[0] + d[1]) + (d[2] + d[3]);
        ((PG8_LAS float*)(ldsbase + RSTD_TAB_OFF + par * 1024))[r] = rsqrtf(((g0 + g1) + (g2 + g3)) * (1.0f / 1024.0f) + EPS_); }
}
__device__ __forceinline__ f32x4 bf_lo4(const u32x4& w) { return (f32x4){__builtin_bit_cast(float, w.x << 16), __builtin_bit_cast(float, w.x & 0xffff0000u), __builtin_bit_cast(float, w.y << 16), __builtin_bit_cast(float, w.y & 0xffff0000u)}; }
__device__ __forceinline__ f32x4 bf_hi4(const u32x4& w) { return (f32x4){__builtin_bit_cast(float, w.z << 16), __builtin_bit_cast(float, w.z & 0xffff0000u), __builtin_bit_cast(float, w.w << 16), __builtin_bit_cast(float, w.w & 0xffff0000u)}; }
struct EpiRes {
    static constexpr bool PERM = true, NEEDS_RSTD = false;
    const PG8_GAS bf16_t* Rb; PG8_GAS bf16_t* Xb; const PG8_GAS float* gate; const PG8_GAS float* cscale; const PG8_GAS float* gnext; const PG8_GAS float* scn; PG8_GAS bf16_t* XN; PG8_GAS float* SS;
    __device__ __forceinline__ void operator()(f32x4 (&acc)[2][2][4][2], const Unit& u, int wr, int wc, int fr, int fq) const {
        const int b = u.pm >> 5, colb = u.pn * BM + wc * 32 + 8 * fq, row0 = u.pm * BM + wr * 64 + fr;
        float ssq[2][4];
#pragma unroll
        for (int bj = 0; bj < 2; ++bj) {
            f32x4 gt[2], cs[2];
#pragma unroll
            for (int n = 0; n < 2; ++n) { const int col = colb + bj * HALF + 4 * n;
                f32x4 gv = *(const PG8_GAS f32x4*)(gate + b * 6144 + col); if (cscale) gv = gv * *(const PG8_GAS f32x4*)(cscale + col); gt[n] = gv;
                const f32x4 sc = *(const PG8_GAS f32x4*)(scn + b * 6144 + col); cs[n] = *(const PG8_GAS f32x4*)(gnext + col) * (sc + 1.0f); }
#pragma unroll
            for (int ai = 0; ai < 2; ++ai)
#pragma unroll
                for (int m = 0; m < 4; ++m) { const size_t off = ((size_t)(u.pm * 4 + u.pn) * 256 + (wr * 64 + fr + ai * HALF + m * 16)) * 256 + (wc * 32 + 8 * fq + bj * HALF);
                    const u32x4 rw = *(const PG8_GAS u32x4*)(Rb + off); const f32x4 r0 = bf_lo4(rw), r1 = bf_hi4(rw);
                    const f32x4 y0 = r0 + gt[0] * acc[ai][bj][m][0], y1 = r1 + gt[1] * acc[ai][bj][m][1];
                    u32x4 xw; xw.x = cvt_pk_bf16(y0[0], y0[1]); xw.y = cvt_pk_bf16(y0[2], y0[3]); xw.z = cvt_pk_bf16(y1[0], y1[1]); xw.w = cvt_pk_bf16(y1[2], y1[3]);
                    *(PG8_GAS u32x4*)(Xb + off) = xw;
                    const f32x4 x0 = bf_lo4(xw), x1 = bf_hi4(xw);
                    const float q = (x0[0] * x0[0] + x0[1] * x0[1]) + (x0[2] * x0[2] + x0[3] * x0[3]) + (x1[0] * x1[0] + x1[1] * x1[1]) + (x1[2] * x1[2] + x1[3] * x1[3]);
                    ssq[ai][m] = (bj == 0) ? q : ssq[ai][m] + q;
                    const f32x4 a0 = x0 * cs[0], a1 = x1 * cs[1]; u32x4 w; w.x = cvt_pk_bf16(a0[0], a0[1]); w.y = cvt_pk_bf16(a0[2], a0[3]); w.z = cvt_pk_bf16(a1[0], a1[1]); w.w = cvt_pk_bf16(a1[2], a1[3]);
                    *(PG8_GAS u32x4*)(XN + off) = w;
                }
        }
#pragma unroll
        for (int ai = 0; ai < 2; ++ai)
#pragma unroll
            for (int m = 0; m < 4; ++m) { float q = ssq[ai][m]; q += shx(q, 16, fq * 16 + fr); q += shx(q, 32, fq * 16 + fr); if (fq == 0) SS[(size_t)(row0 + ai * HALF + m * 16) * 16 + u.pn * 4 + wc] = q; }
    }
};

struct EpiFinal {
    static constexpr bool PERM = true, NEEDS_RSTD = false;
    const PG8_GAS bf16_t* R; PG8_GAS float* OUT; const PG8_GAS float* gate; const PG8_GAS float* gfin; PG8_GAS float* SS; PG8_GAS unsigned* cnt;
    __device__ __forceinline__ void operator()(f32x4 (&acc)[2][2][4][2], const Unit& u, int wr, int wc, int fr_, int fq_) const {
        int fr = fr_, fq = fq_; asm volatile("" : "+v"(fr), "+v"(fq));
        const int b = u.pm >> 5, colb = u.pn * BM + wc * 32 + 8 * fq, row0 = u.pm * BM + wr * 64 + fr, ln = fq * 16 + fr;
        float ssq[2][4];
#pragma unroll
        for (int bj = 0; bj < 2; ++bj) {
            const f32x4 gt0 = *(const PG8_GAS f32x4*)(gate + b * 6144 + colb + bj * HALF), gt1 = *(const PG8_GAS f32x4*)(gate + b * 6144 + colb + bj * HALF + 4);
#pragma unroll
            for (int ai = 0; ai < 2; ++ai)
#pragma unroll
                for (int m = 0; m < 4; ++m) { const size_t off = (size_t)(row0 + ai * HALF + m * 16) * 1024 + colb + bj * HALF;
                    const u32x4 rw = *(const PG8_GAS u32x4*)(R + ((size_t)(u.pm * 4 + u.pn) * 256 + (wr * 64 + fr + ai * HALF + m * 16)) * 256 + (wc * 32 + 8 * fq + bj * HALF));
                    const f32x4 x0 = bf_lo4(rw) + gt0 * acc[ai][bj][m][0], x1 = bf_hi4(rw) + gt1 * acc[ai][bj][m][1];
                    acc[ai][bj][m][0] = x0; acc[ai][bj][m][1] = x1;
                    const float q = (x0[0] * x0[0] + x0[1] * x0[1]) + (x0[2] * x0[2] + x0[3] * x0[3]) + (x1[0] * x1[0] + x1[1] * x1[1]) + (x1[2] * x1[2] + x1[3] * x1[3]);
                    ssq[ai][m] = (bj == 0) ? q : ssq[ai][m] + q;
                    asm volatile("" : "+v"(acc[ai][bj][m][0]), "+v"(acc[ai][bj][m][1]), "+v"(ssq[ai][m]));
                    if (m & 1) asm volatile("" ::: "memory"); }
        }
#pragma unroll
        for (int ai = 0; ai < 2; ++ai)
#pragma unroll
            for (int m = 0; m < 4; ++m) { float q = ssq[ai][m]; q += shx(q, 16, ln); q += shx(q, 32, ln);
                if (fq == 0) __hip_atomic_store(SS + (size_t)(row0 + ai * HALF + m * 16) * 16 + u.pn * 4 + wc, q, __ATOMIC_RELAXED, __HIP_MEMORY_SCOPE_AGENT); }
        asm volatile("s_waitcnt vmcnt(0)" ::: "memory");
        PG8_GAS unsigned* c = cnt + 64 * u.pm;
        if (ln == 0) (void)__hip_atomic_fetch_add(c, 1u, __ATOMIC_RELAXED, __HIP_MEMORY_SCOPE_AGENT);
        for (unsigned sp = 0; sp < (1u << 22); ++sp) { if ((unsigned)__builtin_amdgcn_readfirstlane((int)__hip_atomic_load(c, __ATOMIC_RELAXED, __HIP_MEMORY_SCOPE_AGENT)) >= 32u) break; __builtin_amdgcn_s_sleep(2); }
        int row1 = row0, colc = colb; asm volatile("" : "+v"(row1), "+v"(colc));
        float rs[2][4];
#pragma unroll
        for (int ai = 0; ai < 2; ++ai)
#pragma unroll
            for (int m = 0; m < 4; ++m) { const PG8_GAS float* sp4 = SS + (size_t)(row1 + ai * HALF + m * 16) * 16 + 4 * fq;
                float t = (__hip_atomic_load(sp4, __ATOMIC_RELAXED, __HIP_MEMORY_SCOPE_AGENT) + __hip_atomic_load(sp4 + 1, __ATOMIC_RELAXED, __HIP_MEMORY_SCOPE_AGENT))
                        + (__hip_atomic_load(sp4 + 2, __ATOMIC_RELAXED, __HIP_MEMORY_SCOPE_AGENT) + __hip_atomic_load(sp4 + 3, __ATOMIC_RELAXED, __HIP_MEMORY_SCOPE_AGENT));
                t += shx(t, 16, ln); t += shx(t, 32, ln); rs[ai][m] = rsqrtf(t * (1.0f / 1024.0f) + EPS_); }
#pragma unroll
        for (int bj = 0; bj < 2; ++bj) {
            const f32x4 g0 = *(const PG8_GAS f32x4*)(gfin + colc + bj * HALF), g1 = *(const PG8_GAS f32x4*)(gfin + colc + bj * HALF + 4);
#pragma unroll
            for (int ai = 0; ai < 2; ++ai)
#pragma unroll
                for (int m = 0; m < 4; ++m) { const size_t off = (size_t)(row1 + ai * HALF + m * 16) * 1024 + colc + bj * HALF;
                    *(PG8_GAS f32x4*)(OUT + off) = acc[ai][bj][m][0] * rs[ai][m] * g0; *(PG8_GAS f32x4*)(OUT + off + 4) = acc[ai][bj][m][1] * rs[ai][m] * g1; }
        }
    }
};

struct EpiUp {
    static constexpr bool PERM = true;
    static constexpr bool NEEDS_RSTD = true;
    const PG8_GAS float* SS; const PG8_GAS float* bias; PG8_GAS bf16_t* O; int ldc; PG8_LAS unsigned char* ldsb; int par;
    __device__ __forceinline__ void operator()(f32x4 (&acc)[2][2][4][2], const Unit& u, int wr, int wc, int fr, int fq) const {
        const int b = u.pm >> 5, colb = u.pn * BM + wc * 32 + 8 * fq, row0 = u.pm * BM + wr * 64 + fr;
        float rs[2][4];
#pragma unroll
        for (int ai = 0; ai < 2; ++ai)
#pragma unroll
            for (int m = 0; m < 4; ++m) rs[ai][m] = ((const PG8_LAS float*)(ldsb + RSTD_TAB_OFF + par * 1024))[wr * 64 + fr + ai * HALF + m * 16];
#pragma unroll
        for (int bj = 0; bj < 2; ++bj) {
            const f32x4 bv0 = *(const PG8_GAS f32x4*)(bias + (size_t)b * ldc + colb + bj * HALF), bv1 = *(const PG8_GAS f32x4*)(bias + (size_t)b * ldc + colb + bj * HALF + 4);
#pragma unroll
            for (int ai = 0; ai < 2; ++ai)
#pragma unroll
                for (int m = 0; m < 4; ++m) { f32x4 v0 = acc[ai][bj][m][0] * rs[ai][m] + bv0, v1 = acc[ai][bj][m][1] * rs[ai][m] + bv1;
#pragma unroll
                    for (int j = 0; j < 4; ++j) { v0[j] = fmaxf(v0[j], 0.f); v1[j] = fmaxf(v1[j], 0.f); }
                    v0 = v0 * v0; v1 = v1 * v1;
                    u32x4 w; w.x = cvt_pk_bf16(v0[0], v0[1]); w.y = cvt_pk_bf16(v0[2], v0[3]); w.z = cvt_pk_bf16(v1[0], v1[1]); w.w = cvt_pk_bf16(v1[2], v1[3]);
                    *(PG8_GAS u32x4*)(O + ((size_t)(u.pm * 16 + u.pn) * 256 + (wr * 64 + fr + ai * HALF + m * 16)) * 256 + (wc * 32 + 8 * fq + bj * HALF)) = w; }
        }
    }
};

struct EpiQKV {
    static constexpr bool PERM = true;
    static constexpr bool NEEDS_RSTD = true;
    const PG8_GAS float* SS; const PG8_GAS float* bias; PG8_GAS bf16_t* Q; size_t split_stride; PG8_GAS float* KMP; PG8_LAS unsigned char* ldsb; int par;
    __device__ __forceinline__ void operator()(f32x4 (&acc)[2][2][4][2], const Unit& u, int wr, int wc, int fr, int fq) const {
        const int b = u.pm >> 5, t = u.pn >> 2, colt = (u.pn & 3) * BM + wc * 32 + 8 * fq, colb = u.pn * BM + wc * 32 + 8 * fq, row0 = u.pm * BM + wr * 64 + fr;
        PG8_GAS bf16_t* base = Q + (size_t)t * split_stride; const float sc = (t == 0) ? C2_ : 1.0f;
        float rs[2][4];
#pragma unroll
        for (int ai = 0; ai < 2; ++ai)
#pragma unroll
            for (int m = 0; m < 4; ++m) rs[ai][m] = ((const PG8_LAS float*)(ldsb + RSTD_TAB_OFF + par * 1024))[wr * 64 + fr + ai * HALF + m * 16];
#pragma unroll
        for (int bj = 0; bj < 2; ++bj) {
            const f32x4 bv0 = *(const PG8_GAS f32x4*)(bias + (size_t)b * 3072 + colb + bj * HALF), bv1 = *(const PG8_GAS f32x4*)(bias + (size_t)b * 3072 + colb + bj * HALF + 4);
            f32x4 cs0 = {0.f, 0.f, 0.f, 0.f}, cs1 = cs0;
#pragma unroll
            for (int ai = 0; ai < 2; ++ai)
#pragma unroll
                for (int m = 0; m < 4; ++m) { f32x4 v0 = acc[ai][bj][m][0] * rs[ai][m] + bv0, v1 = acc[ai][bj][m][1] * rs[ai][m] + bv1;
                    cs0 += v0; cs1 += v1; v0 = v0 * sc; v1 = v1 * sc;
                    u32x4 w; w.x = cvt_pk_bf16(v0[0], v0[1]); w.y = cvt_pk_bf16(v0[2], v0[3]); w.z = cvt_pk_bf16(v1[0], v1[1]); w.w = cvt_pk_bf16(v1[2], v1[3]);
                    *(PG8_GAS u32x4*)(base + hm_off((size_t)(row0 + ai * HALF + m * 16), b, (colt + bj * HALF) >> 6) + ((colt + bj * HALF) & 63)) = w; }
            if (t == 1) {
#pragma unroll
                for (int o = 1; o < 16; o <<= 1) {
#pragma unroll
                    for (int j = 0; j < 4; ++j) { cs0[j] += shx(cs0[j], o, fq * 16 + fr); cs1[j] += shx(cs1[j], o, fq * 16 + fr); } }
                if (fr == 0) { PG8_GAS float* kp = KMP + ((size_t)u.pm * 2 + wr) * 1024 + colt + bj * HALF; *(f32x4*)kp = cs0; *(PG8_GAS f32x4*)(kp + 4) = cs1; }
            }
        }
    }
};

template <class Epi, class Sched, bool ALIGN_EPI>
__device__ __forceinline__ void gemm_phase(PG8_LAS unsigned char* lds, const Gemm g, const Sched& S, const Epi& E_, int wave_id) {
    Epi E = E_;
    int tid = wave_id * 64 + lane_id(); asm volatile("" : "+v"(tid));
    const int wid = __builtin_amdgcn_readfirstlane(tid >> 6), lane = tid & 63, wr = wid >> 2, wc = wid & 3, fr = lane & 15, fq = lane >> 4;
    const int K = g.K, nt = K / BK, lda = g.lda;
    unsigned voffA[2], voffB[2];
#pragma unroll
    for (int i = 0; i < 2; ++i) { int R, C; stage_rc(tid * 16 + i * 8192, R, C); const int Rb = Epi::PERM ? ((R & ~31) + perm32(R & 31)) : R;
        voffA[i] = (unsigned)(R * lda + C) * 2u; voffB[i] = (unsigned)(Rb * K + C) * 2u; }
    const size_t kstep = (size_t)(BK * 2);
    const size_t hstepA = (size_t)HALF * lda * 2, tstepA = (g.a_tileb == 512) ? 2 * hstepA : (size_t)(K / 256) * g.a_tileb, hstepB = (size_t)HALF * K * 2, tstepB = 2 * hstepB;
    const size_t tileb = (size_t)g.a_tileb;
#define PG8_KOFF(t) ((size_t)((t) >> 2) * tileb + (size_t)((t) & 3) * 128)
    const unsigned ldsw = (unsigned)wid * 1024u;
    const int aoff = lds_byte(wr * 64 + fr, fq * 8), boff = lds_byte(wc * 32 + fr, fq * 8);
#define PG8_SA(b, h) (((b) * 2 + (h)) * HTB)
#define PG8_SB(b, h) ((4 + (b) * 2 + (h)) * HTB)
#define PG8_STAGE(bufoff, gbase, voff) do { _Pragma("unroll") for (int _i = 0; _i < 2; ++_i) \
        __builtin_amdgcn_global_load_lds((const PG8_GAS unsigned*)((const PG8_GAS char*)(gbase) + (voff)[_i]), (PG8_LAS unsigned*)(lds + (bufoff) + ldsw + _i * 8192), 16, 0, 0); } while (0)
#define PG8_LDA(dst, b, h) do { _Pragma("unroll") for (int m = 0; m < 4; ++m) _Pragma("unroll") for (int k = 0; k < 2; ++k) dst[m][k] = *(const PG8_LAS bf16x8*)(lds + PG8_SA(b, h) + aoff + m * 2048 + k * 1024); } while (0)
#define PG8_LDB(dst, b, h) do { _Pragma("unroll") for (int n = 0; n < 2; ++n) _Pragma("unroll") for (int k = 0; k < 2; ++k) dst[n][k] = *(const PG8_LAS bf16x8*)(lds + PG8_SB(b, h) + boff + n * 2048 + k * 1024); } while (0)
#define PG8_MMA(ai, bj, At, Bt) do { __builtin_amdgcn_s_setprio(1); _Pragma("unroll") for (int m = 0; m < 4; ++m) _Pragma("unroll") for (int n = 0; n < 2; ++n) _Pragma("unroll") for (int k = 0; k < 2; ++k) \
        acc[ai][bj][m][n] = __builtin_amdgcn_mfma_f32_16x16x32_bf16(Bt[n][k], At[m][k], acc[ai][bj][m][n], 0, 0, 0); __builtin_amdgcn_s_setprio(0); } while (0)
#define PG8_WAIT_V(n) asm volatile("s_waitcnt vmcnt(" #n ")" ::: "memory")
#define PG8_WAIT_L(n) asm volatile("s_waitcnt lgkmcnt(" #n ")" ::: "memory")
#define PG8_BAR __builtin_amdgcn_s_barrier()
#define PG8_SCHED __builtin_amdgcn_sched_barrier(0)
    Unit cur, nxt; int ui = 0;
    if (!S.next(0, cur)) return;
    int rpar = 0;
    if constexpr (Epi::NEEDS_RSTD) { fill_rstd_tab(lds, 0, E.SS, cur.pm, wid, lane); E.par = 0; }
    f32x4 acc[2][2][4][2];
#pragma unroll
    for (int a = 0; a < 2; ++a)
#pragma unroll
        for (int b = 0; b < 2; ++b)
#pragma unroll
            for (int m = 0; m < 4; ++m)
#pragma unroll
                for (int n = 0; n < 2; ++n) acc[a][b][m][n] = (f32x4){0.f, 0.f, 0.f, 0.f};
    bf16x8 At[4][2], B0[2][2], B1[2][2];
    const PG8_GAS char* cA = (const PG8_GAS char*)g.A + (size_t)cur.pm * tstepA + (size_t)cur.pn * g.a_pn_off * 2; const PG8_GAS char* cB = (const PG8_GAS char*)g.Bt + (size_t)cur.pn * tstepB;
    PG8_STAGE(PG8_SB(0, 0), cB, voffB); PG8_STAGE(PG8_SB(0, 1), cB + hstepB, voffB); PG8_STAGE(PG8_SA(0, 0), cA, voffA); PG8_STAGE(PG8_SA(0, 1), cA + hstepA, voffA);
    if (wr == 1) PG8_BAR;
    PG8_WAIT_V(2); PG8_BAR;
    PG8_STAGE(PG8_SB(1, 0), cB + kstep, voffB); PG8_STAGE(PG8_SA(1, 0), cA + kstep, voffA); PG8_STAGE(PG8_SB(1, 1), cB + hstepB + kstep, voffB);
    PG8_WAIT_V(6); PG8_BAR;
    for (;;) {
        const bool has_next = S.next(ui + 1, nxt);
        const PG8_GAS char* nA = has_next ? (const PG8_GAS char*)g.A + (size_t)nxt.pm * tstepA + (size_t)nxt.pn * g.a_pn_off * 2 : cA; const PG8_GAS char* nB = has_next ? (const PG8_GAS char*)g.Bt + (size_t)nxt.pn * tstepB : cB;
        for (int t = 0; t < nt; t += 2) {
            const bool last = (t == nt - 2);
            const PG8_GAS char* a1 = cA + PG8_KOFF(t + 1);
            const PG8_GAS char* a2 = last ? nA : cA + PG8_KOFF(t + 2); const PG8_GAS char* b2 = last ? nB : cB + (size_t)(t + 2) * kstep;
            const PG8_GAS char* a3 = a2 + kstep; const PG8_GAS char* b3 = b2 + kstep;
            PG8_LDB(B0, 0, 0); PG8_LDB(B1, 0, 1); PG8_SCHED; PG8_LDA(At, 0, 0); PG8_STAGE(PG8_SA(1, 1), a1 + hstepA, voffA);
            PG8_WAIT_V(8); PG8_WAIT_L(0); PG8_BAR; PG8_MMA(0, 0, At, B0); PG8_MMA(0, 1, At, B1); PG8_BAR; PG8_SCHED;
            PG8_LDA(At, 0, 1); PG8_STAGE(PG8_SB(0, 0), b2, voffB); PG8_STAGE(PG8_SB(0, 1), b2 + hstepB, voffB); PG8_STAGE(PG8_SA(0, 0), a2, voffA);
            PG8_WAIT_V(8); PG8_WAIT_L(0); PG8_BAR; PG8_MMA(1, 0, At, B0); PG8_MMA(1, 1, At, B1); PG8_BAR; PG8_SCHED;
            PG8_LDB(B0, 1, 0); PG8_LDB(B1, 1, 1); PG8_SCHED; PG8_LDA(At, 1, 0); PG8_STAGE(PG8_SA(0, 1), a2 + hstepA, voffA);
            PG8_WAIT_V(8); PG8_WAIT_L(0); PG8_BAR; PG8_MMA(0, 0, At, B0); PG8_MMA(0, 1, At, B1); PG8_BAR; PG8_SCHED;
            PG8_LDA(At, 1, 1); PG8_STAGE(PG8_SB(1, 0), b3, voffB); PG8_STAGE(PG8_SB(1, 1), b3 + hstepB, voffB); PG8_STAGE(PG8_SA(1, 0), a3, voffA);
            PG8_WAIT_V(8); PG8_WAIT_L(0); PG8_BAR; PG8_MMA(1, 0, At, B0); PG8_MMA(1, 1, At, B1); PG8_BAR; PG8_SCHED;
        }
        if constexpr (ALIGN_EPI) { if (wr == 0) PG8_BAR; }
        if constexpr (Epi::NEEDS_RSTD) E.par = rpar;
        E(acc, cur, wr, wc, fr, fq);
        if constexpr (Epi::NEEDS_RSTD) { if (has_next && nxt.pm != cur.pm) { rpar ^= 1; fill_rstd_tab(lds, rpar, E.SS, nxt.pm, wid, lane); } }
        if (!has_next) break;
#pragma unroll
        for (int a = 0; a < 2; ++a)
#pragma unroll
            for (int b = 0; b < 2; ++b)
#pragma unroll
                for (int m = 0; m < 4; ++m)
#pragma unroll
                    for (int n = 0; n < 2; ++n) acc[a][b][m][n] = (f32x4){0.f, 0.f, 0.f, 0.f};
        cur = nxt; cA = nA; cB = nB; ++ui;
        if constexpr (ALIGN_EPI) { if (wr == 1) PG8_BAR; }
    }
    PG8_WAIT_V(0);
    if constexpr (!ALIGN_EPI) { if (wr == 0) PG8_BAR; }
    PG8_BAR;
#undef PG8_KOFF
#undef PG8_SA
#undef PG8_SB
#undef PG8_STAGE
#undef PG8_LDA
#undef PG8_LDB
#undef PG8_MMA
#undef PG8_WAIT_V
#undef PG8_WAIT_L
#undef PG8_BAR
#undef PG8_SCHED
}
}

constexpr int NWAVES = 8;
constexpr int BATCH = 4, SEQ = 8192, D = 1024, NH = 16, HD = 64, FF = 4096, M = BATCH * SEQ, NQKV = 3 * D, NBLK = 32, BLK = 256;
constexpr float EPS = 1e-6f;
constexpr float LOG2E = 1.4426950408889634f;

constexpr size_t MiB = 1u << 20;
constexpr size_t WS_CTL = 0, CTL_ZERO_BYTES = 1 * MiB;
constexpr size_t WS_MOD = 1 * MiB;
constexpr size_t WS_BIAS_UP0 = WS_MOD + 256 * 1024;
constexpr size_t WS_BIAS_QKV = WS_BIAS_UP0 + 64 * 1024;
constexpr size_t WS_BIAS_UP1 = WS_BIAS_QKV + 64 * 1024;
constexpr size_t WS_KMP = 2 * MiB;
constexpr size_t WS_SS = 3 * MiB;
constexpr size_t WS_WPOOL = 6 * MiB, WS_WQKV = 8 * MiB, WS_WO = 14 * MiB, WS_WUP0 = 16 * MiB, WS_WUP1 = 24 * MiB, WS_WDN0 = 32 * MiB, WS_WDN1 = 40 * MiB;
constexpr size_t WS_XNA = 48 * MiB, WS_XNB = 112 * MiB;
constexpr size_t WS_HB = 176 * MiB;
constexpr size_t WS_Q = 176 * MiB, WS_K = 240 * MiB, WS_V = 304 * MiB;
constexpr size_t WS_PL = 496 * MiB;
constexpr size_t WS_CNT = 503 * MiB;
constexpr size_t WS_KBM = 503 * MiB + 512 * 1024;
constexpr size_t WS_POB = 48 * MiB;
constexpr size_t WS_SEG = 368 * MiB;
constexpr size_t WS_XR = 432 * MiB;
constexpr size_t WS_O = 368 * MiB;
constexpr size_t WS_DUMP = 504 * MiB;
constexpr size_t WS_END = 506 * MiB;
constexpr int CW_BAR = 4096;
constexpr int CW_FIN = 24576;
constexpr int CW_TOT = 16384;

constexpr int RING_OFF = 0, RING_BYTES = 131072;
constexpr int LDSCTL_OFF = RING_BYTES, MISC_OFF = LDSCTL_OFF + 320;
constexpr int LDS_BYTES = 151552;

#define GAS __attribute__((address_space(1)))
#define LAS __attribute__((address_space(3)))
typedef unsigned short bf16;
typedef unsigned v4u __attribute__((ext_vector_type(4)));
typedef unsigned v2u __attribute__((ext_vector_type(2)));
typedef float f32x4 __attribute__((ext_vector_type(4)));
typedef GAS unsigned gu32;
#define RLX_AGENT __ATOMIC_RELAXED, __HIP_MEMORY_SCOPE_AGENT
#define LDS_WAIT() asm volatile("s_waitcnt lgkmcnt(0)" ::: "memory")
__device__ __forceinline__ unsigned f2bf(float f) { unsigned u = __builtin_bit_cast(unsigned, f); return (u + 0x7fffu + ((u >> 16) & 1u)) >> 16; }
__device__ __forceinline__ unsigned pk2(float lo, float hi) { return f2bf(lo) | (f2bf(hi) << 16); }
__device__ __forceinline__ float bf2f(unsigned short v) { return __builtin_bit_cast(float, (unsigned)v << 16); }

#define XB_TMO      128
#define XB_XCNT(j)  (256  + 64 * (j))
#define XB_XSUB(j)  (1280 + 64 * (j))
#define XB_XGEN(j)  (2304 + 64 * (j))
#define XB_TOP      3328
#define XB_TOPGEN   3392
#define XCD_BAR_WORDS 3456
#define XB_SPIN_CAP (1u << 18)
__device__ __forceinline__ unsigned xb_ld(GAS unsigned* p)              { return __hip_atomic_load(p, __ATOMIC_RELAXED, __HIP_MEMORY_SCOPE_AGENT); }
__device__ __forceinline__ unsigned xb_add(GAS unsigned* p, unsigned v) { return __hip_atomic_fetch_add(p, v, __ATOMIC_RELAXED, __HIP_MEMORY_SCOPE_AGENT); }
__device__ __forceinline__ unsigned xb_xcc_id() { return (unsigned)__builtin_amdgcn_s_getreg((3 << 11) | 20) & 0xFu; }
#define XB_SPIN(cond, bar) do { unsigned _sp = 0; while (cond) { __builtin_amdgcn_s_sleep(1); \
    if ((++_sp & 255u) == 0u) { if (xb_ld(&(bar)[XB_TMO])) break; if (_sp > XB_SPIN_CAP) { (void)xb_add(&(bar)[XB_TMO], 1u); break; } } } } while (0)
struct XcdBarrier { GAS unsigned* bar; unsigned x; volatile LAS unsigned* st; int wave; };
__device__ __forceinline__ XcdBarrier xcd_barrier_post(GAS unsigned* bar, volatile LAS unsigned* st) {
    XcdBarrier b; b.bar = bar; b.x = xb_xcc_id(); b.st = st;
    if (threadIdx.x == 0) (void)xb_add(&bar[XB_XCNT(b.x)], 1u);
    return b;
}
__device__ __forceinline__ void xcd_barrier_complete(GAS unsigned* bar, unsigned x, unsigned& nloc, unsigned& nx) {
    const unsigned G = gridDim.x * gridDim.y * gridDim.z;
    unsigned sum, cnt, mine, sp = 0u;
    for (;;) {
        sum = 0u; cnt = 0u; mine = 0u;
#pragma unroll
        for (unsigned j = 0; j < 16; ++j) { const unsigned c = xb_ld(&bar[XB_XCNT(j)]); sum += c; cnt += (c > 0u) ? 1u : 0u; mine = (j == x) ? c : mine; }
        if (sum == G) break;
        __builtin_amdgcn_s_sleep(1);
        if ((++sp & 255u) == 0u) { if (xb_ld(&bar[XB_TMO])) break; if (sp > XB_SPIN_CAP) { (void)xb_add(&bar[XB_TMO], 1u); break; } }
    }
    nloc = mine > 0u ? mine : 1u; nx = cnt > 0u ? cnt : 1u;
}
__device__ __forceinline__ void xcd_barrier(const XcdBarrier& b) {
    asm volatile("s_waitcnt vmcnt(0)" ::: "memory");
    __syncthreads();
    if (b.wave == 0 && lane_id() == 0) {
        GAS unsigned* bar = b.bar; asm volatile("" : "+s"(bar));
        const unsigned bx = xb_xcc_id();
        __builtin_amdgcn_s_waitcnt(0);
        unsigned nloc = b.st[0], nx = b.st[1];
        if (nloc == 0u) { xcd_barrier_complete(bar, bx, nloc, nx); b.st[0] = nloc; b.st[1] = nx; }
        const unsigned old = xb_add(&bar[XB_XSUB(bx)], 1u);
        const unsigned gen = old / nloc;
        if (old + 1u == (gen + 1u) * nloc) {
            __builtin_amdgcn_fence(__ATOMIC_RELEASE, "agent");
            asm volatile("s_waitcnt vmcnt(0)" ::: "memory");
            const unsigned og = xb_add(&bar[XB_TOP], 1u);
            const unsigned tg = og / nx;
            if (og + 1u == (tg + 1u) * nx) xb_add(&bar[XB_TOPGEN], 1u);
            else XB_SPIN(xb_ld(&bar[XB_TOPGEN]) == tg, bar);
            __builtin_amdgcn_fence(__ATOMIC_ACQUIRE, "agent");
            xb_add(&bar[XB_XGEN(bx)], 1u);
            asm volatile("s_waitcnt vmcnt(0)" ::: "memory");
        } else {
            XB_SPIN(xb_ld(&bar[XB_XGEN(bx)]) == gen, bar);
            __builtin_amdgcn_fence(__ATOMIC_ACQUIRE, "agent");
            asm volatile("s_waitcnt vmcnt(0)" ::: "memory");
        }
    }
    __syncthreads();
}

struct Args { const GAS float* in[14]; GAS float* out; GAS unsigned char* ws; };
struct Frame {
    LAS unsigned char* lds; int tid, lane, wave, vcu, G;
    const GAS float *x, *c, *rel_bias, *w_mod, *b_mod, *norm_mix, *norm_mlp, *w_pool, *pool_scale, *w_qkv, *w_o, *w_up, *w_down, *norm_final;
    GAS float* out; GAS unsigned char* ws;
};
__device__ __forceinline__ float wave_sum(float v) {
#pragma unroll
    for (int o = 1; o < 64; o <<= 1) v += __shfl_xor(v, o);
    return v;
}

struct TItem { const GAS float* W; GAS bf16* WT; int K, N, row_off, item; };
__device__ __forceinline__ void tload(const TItem& I, f32x4 (&t)[8], int lane) {
    const int nblk = I.N / 32, kb = I.item / nblk, nb = I.item % nblk, k0 = 64 * kb, n0 = 32 * nb;
#pragma unroll
    for (int i = 0; i < 8; ++i) t[i] = *(const GAS f32x4*)(I.W + (size_t)(k0 + 8 * i + (lane >> 3)) * I.N + n0 + 4 * (lane & 7));
}
__device__ __forceinline__ void tstore(const TItem& I, const f32x4 (&t)[8], LAS float* scr, int lane) {
    const int nblk = I.N / 32, kb = I.item / nblk, nb = I.item % nblk, k0 = 64 * kb, n0 = 32 * nb;
#pragma unroll
    for (int i = 0; i < 8; ++i) { LAS float* d = scr + (8 * i + (lane >> 3)) * 33 + 4 * (lane & 7); d[0] = t[i][0]; d[1] = t[i][1]; d[2] = t[i][2]; d[3] = t[i][3]; }
    LDS_WAIT(); asm volatile("" ::: "memory");
    const int c = lane & 7;
#pragma unroll
    for (int j = 0; j < 4; ++j) { const int n = (lane >> 3) + 8 * j; const LAS float* s = scr + (8 * c) * 33 + n;
        v4u o; o.x = pk2(s[0 * 33], s[1 * 33]); o.y = pk2(s[2 * 33], s[3 * 33]); o.z = pk2(s[4 * 33], s[5 * 33]); o.w = pk2(s[6 * 33], s[7 * 33]);
        *(GAS v4u*)(I.WT + (size_t)(I.row_off + n0 + n) * I.K + k0 + 8 * c) = o; }
    LDS_WAIT(); asm volatile("" ::: "memory");
}
__device__ __forceinline__ void p0_prologue(Frame& F) {
    if (F.vcu < 192) {
        LAS float* cact = (LAS float*)(F.lds + 67584);
        LAS float* red = (LAS float*)(F.lds + 67584 + 16384);
        const int l = F.vcu / 96, j0 = (F.vcu % 96) * 64;
        for (int i = F.tid; i < 4096; i += NWAVES * 64) { const float v = F.c[i]; cact[i] = v / (1.f + __expf(-v)); }
        __syncthreads();
        const int sub = F.lane >> 4, c4 = F.lane & 15;
        f32x4 a0 = {0.f, 0.f, 0.f, 0.f}, a1 = a0, a2 = a0, a3 = a0;
        const GAS float* wb = F.w_mod + (size_t)l * 1024 * 6144 + j0 + 4 * c4;
#pragma unroll 4
        for (int it = 0; it < 32; ++it) { const int k = 32 * it + 4 * F.wave + sub; const f32x4 wv = *(const GAS f32x4*)(wb + (size_t)k * 6144);
            a0 += wv * cact[k]; a1 += wv * cact[1024 + k]; a2 += wv * cact[2048 + k]; a3 += wv * cact[3072 + k]; }
#pragma unroll
        for (int j = 0; j < 4; ++j) { a0[j] += __shfl_xor(a0[j], 16); a0[j] += __shfl_xor(a0[j], 32); a1[j] += __shfl_xor(a1[j], 16); a1[j] += __shfl_xor(a1[j], 32);
            a2[j] += __shfl_xor(a2[j], 16); a2[j] += __shfl_xor(a2[j], 32); a3[j] += __shfl_xor(a3[j], 16); a3[j] += __shfl_xor(a3[j], 32); }
        if (sub == 0) { LAS f32x4* r4 = (LAS f32x4*)(red + F.wave * 256); r4[0 * 16 + c4] = a0; r4[1 * 16 + c4] = a1; r4[2 * 16 + c4] = a2; r4[3 * 16 + c4] = a3; }
        __syncthreads();
        if (F.tid < 256) { const int b = F.tid >> 6, col = F.tid & 63; float s = 0.f;
#pragma unroll
            for (int w = 0; w < 8; ++w) s += red[w * 256 + b * 64 + col];
            ((GAS float*)(F.ws + WS_MOD))[(l * 4 + b) * 6144 + j0 + col] = s + F.b_mod[l * 6144 + j0 + col]; }
    }
    LAS float* scr = (LAS float*)(F.lds + RING_OFF + F.wave * 8448);
    const int gw = F.vcu * NWAVES + F.wave, NGW = F.G * NWAVES;
    constexpr int I_POOL = 4 * 32, I_QKV = 16 * 96, I_O = 16 * 32, I_UP = 16 * 128, I_DN = 64 * 32;
    constexpr int NITEMS = I_POOL + I_QKV + I_O + 2 * I_UP + 2 * I_DN;
    auto desc = [&](int it) -> TItem {
        int r = it;
        if (r < I_POOL) { const int g = r / 32; return TItem{F.w_pool + (size_t)g * 65536, (GAS bf16*)(F.ws + WS_WPOOL), 256, 256, g * 256, r % 32}; } r -= I_POOL;
        if (r < I_QKV) return TItem{F.w_qkv, (GAS bf16*)(F.ws + WS_WQKV), D, NQKV, 0, r}; r -= I_QKV;
        if (r < I_O) return TItem{F.w_o, (GAS bf16*)(F.ws + WS_WO), D, D, 0, r}; r -= I_O;
        if (r < 2 * I_UP) { const int l = r / I_UP; return TItem{F.w_up + (size_t)l * D * FF, (GAS bf16*)(F.ws + (l ? WS_WUP1 : WS_WUP0)), D, FF, 0, r % I_UP}; } r -= 2 * I_UP;
        const int l = r / I_DN; return TItem{F.w_down + (size_t)l * FF * D, (GAS bf16*)(F.ws + (l ? WS_WDN1 : WS_WDN0)), FF, D, 0, r % I_DN};
    };
    f32x4 ta[8], tb[8];
    int it = gw;
    if (it < NITEMS) { TItem cur = desc(it); tload(cur, ta, F.lane);
        for (;;) {
            const int itn = it + NGW; const bool hn = itn < NITEMS; TItem nxt = cur;
            if (hn) { nxt = desc(itn); tload(nxt, tb, F.lane); }
            tstore(cur, ta, scr, F.lane);
            if (!hn) break;
#pragma unroll
            for (int i = 0; i < 8; ++i) ta[i] = tb[i];
            cur = nxt; it = itn;
        } }
}

__device__ __forceinline__ void p1_bias(Frame& F) {
    const int gw = F.vcu * NWAVES + F.wave, NGW = F.G * NWAVES;
    const GAS float* MOD = (const GAS float*)(F.ws + WS_MOD);
    for (int it = gw; it < 4096 + 3072 + 4096; it += NGW) {
        const GAS bf16* wt; const GAS float* sh; GAS float* dst; int n, N;
        if (it < 4096) { n = it; N = 4096; wt = (const GAS bf16*)(F.ws + WS_WUP0); sh = MOD + 3072; dst = (GAS float*)(F.ws + WS_BIAS_UP0); }
        else if (it < 4096 + 3072) { n = it - 4096; N = 3072; wt = (const GAS bf16*)(F.ws + WS_WQKV); sh = MOD + 4 * 6144; dst = (GAS float*)(F.ws + WS_BIAS_QKV); }
        else { n = it - 7168; N = 4096; wt = (const GAS bf16*)(F.ws + WS_WUP1); sh = MOD + 4 * 6144 + 3072; dst = (GAS float*)(F.ws + WS_BIAS_UP1); }
        const v4u w0 = *(const GAS v4u*)(wt + (size_t)n * 1024 + F.lane * 16), w1 = *(const GAS v4u*)(wt + (size_t)n * 1024 + F.lane * 16 + 8);
        float wf[16];
#pragma unroll
        for (int j = 0; j < 4; ++j) { wf[2 * j] = __builtin_bit_cast(float, w0[j] << 16); wf[2 * j + 1] = __builtin_bit_cast(float, w0[j] & 0xffff0000u);
            wf[8 + 2 * j] = __builtin_bit_cast(float, w1[j] << 16); wf[8 + 2 * j + 1] = __builtin_bit_cast(float, w1[j] & 0xffff0000u); }
#pragma unroll
        for (int b = 0; b < 4; ++b) { const GAS f32x4* sp = (const GAS f32x4*)(sh + b * 6144 + F.lane * 16); float s = 0.f;
#pragma unroll
            for (int j = 0; j < 4; ++j) { const f32x4 sv = sp[j]; s += wf[4 * j] * sv[0] + wf[4 * j + 1] * sv[1] + wf[4 * j + 2] * sv[2] + wf[4 * j + 3] * sv[3]; }
            s = wave_sum(s); if (F.lane == 0) dst[b * N + n] = s; }
    }
}
__device__ __forceinline__ void p1_pool(Frame& F) {
    LAS float* ring = (LAS float*)(F.lds + RING_OFF);
    const GAS float* MOD = (const GAS float*)(F.ws + WS_MOD); GAS bf16* XN = (GAS bf16*)(F.ws + WS_XNA); GAS bf16* XR = (GAS bf16*)(F.ws + WS_XR);
    for (int run = F.vcu; run < M / 128; run += F.G) {
        const int t0 = run * 128, s0 = t0 % SEQ, b = t0 / SEQ;
        f32x4 gam[4];
#pragma unroll
        for (int j = 0; j < 4; ++j) gam[j] = *(const GAS f32x4*)(F.norm_mix + 4 * (F.lane + 64 * j));
        const int c4 = F.tid & 255, rh = F.tid >> 8, gi = c4 >> 6, w = 2 << gi;
        const f32x4 sc1 = *(const GAS f32x4*)(MOD + b * 6144 + 1024 + 4 * c4) + 1.0f;
        f32x4 v[2][4];
        const GAS float* xb = F.x + (size_t)b * SEQ * D + 4 * F.lane;
        int st = (s0 > 0 ? -1 : 0);
#pragma unroll
        for (int rr = 0; rr < 2; ++rr)
#pragma unroll
            for (int j = 0; j < 4; ++j) v[rr][j] = *(const GAS f32x4*)(xb + (size_t)(s0 + 16 * st + 2 * F.wave + rr) * D + 256 * j);
        for (; st < 8; ++st) {
            if (st >= 0) {
#pragma unroll
                for (int rr = 0; rr < 2; ++rr)
#pragma unroll
                    for (int j = 0; j < 4; ++j) { v2u o2; o2.x = pk2(v[rr][j][0], v[rr][j][1]); o2.y = pk2(v[rr][j][2], v[rr][j][3]);
                        { const size_t trow = (size_t)b * SEQ + s0 + 16 * st + 2 * F.wave + rr; *(GAS v2u*)(XR + (((trow >> 8) * 4 + j) * 256 + (trow & 255)) * 256 + 4 * F.lane) = o2; } } }
            float ss0 = 0.f, ss1 = 0.f;
#pragma unroll
            for (int j = 0; j < 4; ++j) { ss0 += (v[0][j][0] * v[0][j][0] + v[0][j][1] * v[0][j][1]) + (v[0][j][2] * v[0][j][2] + v[0][j][3] * v[0][j][3]);
                ss1 += (v[1][j][0] * v[1][j][0] + v[1][j][1] * v[1][j][1]) + (v[1][j][2] * v[1][j][2] + v[1][j][3] * v[1][j][3]); }
#pragma unroll
            for (int o = 1; o < 64; o <<= 1) { ss0 += __shfl_xor(ss0, o); ss1 += __shfl_xor(ss1, o); }
            const float rs0 = rsqrtf(ss0 * (1.0f / D) + EPS), rs1 = rsqrtf(ss1 * (1.0f / D) + EPS);
            { const int sr = s0 + 16 * st + 2 * F.wave;
#pragma unroll
              for (int j = 0; j < 4; ++j) { *(LAS f32x4*)(ring + (sr & 31) * 1024 + 4 * (F.lane + 64 * j)) = v[0][j] * rs0 * gam[j]; *(LAS f32x4*)(ring + ((sr + 1) & 31) * 1024 + 4 * (F.lane + 64 * j)) = v[1][j] * rs1 * gam[j]; } }
            if (st + 1 < 8) {
#pragma unroll
                for (int rr = 0; rr < 2; ++rr)
#pragma unroll
                    for (int j = 0; j < 4; ++j) v[rr][j] = *(const GAS f32x4*)(xb + (size_t)(s0 + 16 * (st + 1) + 2 * F.wave + rr) * D + 256 * j); }
            __syncthreads();
            if (st >= 0) {
                const int sA = s0 + 16 * st + 8 * rh;
                f32x4 sum = {0.f, 0.f, 0.f, 0.f};
                { const int cnt0 = (sA < w) ? sA : w; for (int i = 1; i <= cnt0; ++i) sum += *(const LAS f32x4*)(ring + ((sA - i) & 31) * 1024 + 4 * c4); }
#pragma unroll
                for (int r = 0; r < 8; ++r) { const int s = sA + r; const f32x4 cur = *(const LAS f32x4*)(ring + (s & 31) * 1024 + 4 * c4);
                    sum += cur; if (s >= w) sum -= *(const LAS f32x4*)(ring + ((s - w) & 31) * 1024 + 4 * c4);
                    const float inv = 1.0f / (float)((s + 1 < w) ? s + 1 : w);
                    const f32x4 p = (sum * inv - cur) * sc1;
                    v2u o; o.x = pk2(p[0], p[1]); o.y = pk2(p[2], p[3]);
                    *(GAS v2u*)(XN + ((size_t)b * SEQ + s) * D + 4 * c4) = o; }
            }
            __syncthreads();
        }
    }
}

__device__ __forceinline__ int t5_bucket(int dist) {
    if (dist < 16) return dist;
    int b = 16;
    b += (dist >= 21); b += (dist >= 27); b += (dist >= 35); b += (dist >= 46); b += (dist >= 59); b += (dist >= 77); b += (dist >= 99); b += (dist >= 128);
    b += (dist >= 166); b += (dist >= 216); b += (dist >= 280); b += (dist >= 363); b += (dist >= 470); b += (dist >= 609); b += (dist >= 790);
    return b;
}
namespace att {
typedef short bf16x8 __attribute__((ext_vector_type(8)));
typedef short s16x4 __attribute__((ext_vector_type(4)));
typedef short v4i16_t __attribute__((ext_vector_type(4)));
typedef float f32x16 __attribute__((ext_vector_type(16)));
typedef float f32x2_t __attribute__((ext_vector_type(2)));
typedef __bf16 bf16x2_t __attribute__((ext_vector_type(2)));
typedef LAS const char* lds_cptr;
constexpr int L_K = 0, L_V = 32768, L_LUT = 132096, L_QI = 141312, L_CUM = 142336, L_PRE = 142592;
constexpr int LUTN = 2304;
__device__ __forceinline__ int crow(int r, int hi) { return (r & 3) + 8 * (r >> 2) + 4 * hi; }
__device__ __forceinline__ unsigned cvtpk(float lo, float hi) { f32x2_t v = {lo, hi}; bf16x2_t b = __builtin_convertvector(v, bf16x2_t); return __builtin_bit_cast(unsigned, b); }
__device__ __forceinline__ s16x4 vtr(lds_cptr p) { return __builtin_bit_cast(s16x4, __builtin_amdgcn_ds_read_tr16_b64_v4i16((LAS v4i16_t*)p)); }
__device__ __forceinline__ float swap_add(float v) { auto rr = __builtin_amdgcn_permlane32_swap(__float_as_uint(v), __float_as_uint(v), false, false); return __uint_as_float(rr[0]) + __uint_as_float(rr[1]); }

__device__ __forceinline__ void load_kv(LAS unsigned char* lds, const GAS bf16* Kb, const GAS bf16* Vb, int b, int h, int n, int w, int lane) {
#pragma unroll
    for (int t = 0; t < 4; ++t) {
        const size_t kr = (size_t)b * SEQ + n * BLK + 64 * t + lane, vr = (size_t)b * SEQ + n * BLK + 64 * t + 16 * (w & 3) + (lane >> 2);
        const v4u kv = *(const GAS v4u*)(Kb + hm_off(kr, b, h) + w * 8);
        const v4u vv = *(const GAS v4u*)(Vb + hm_off(vr, b, h) + (w >> 2) * 32 + (lane & 3) * 8);
        *(LAS v4u*)(lds + L_K + t * 8192 + w * 1024 + lane * 16) = kv;
        *(LAS v4u*)(lds + L_V + t * 8192 + w * 1024 + lane * 16) = vv;
    }
}
__device__ __forceinline__ void build_lut(LAS unsigned char* lds, const GAS float* rel_bias, int h, int tid) {
    for (int i = tid; i < LUTN; i += NWAVES * 64) ((LAS float*)(lds + L_LUT))[i] = (i <= 2047) ? rel_bias[t5_bucket(2047 - i) * NH + h] * LOG2E : 0.f;
}
__device__ __forceinline__ void qk_tile(f32x16& p0, f32x16& p1, lds_cptr Kt, const bf16x8* qr, const f32x16& cinit, int r32, int hi) {
    lds_cptr kb = Kt + hi * 1024 + r32 * 16;
#pragma unroll
    for (int d0 = 0; d0 < 4; ++d0) {
        const bf16x8 b0 = *(LAS const bf16x8*)(kb + d0 * 2048), b1 = *(LAS const bf16x8*)(kb + d0 * 2048 + 512);
        if (d0 == 0) { p0 = __builtin_amdgcn_mfma_f32_32x32x16_bf16(b0, qr[0], cinit, 0, 0, 0); p1 = __builtin_amdgcn_mfma_f32_32x32x16_bf16(b1, qr[0], cinit, 0, 0, 0); }
        else { p0 = __builtin_amdgcn_mfma_f32_32x32x16_bf16(b0, qr[d0], p0, 0, 0, 0); p1 = __builtin_amdgcn_mfma_f32_32x32x16_bf16(b1, qr[d0], p1, 0, 0, 0); }
    }
}
template <bool BIAS, bool MASK>
__device__ __forceinline__ void softmax_tile(f32x16& p0, f32x16& p1, LAS const float* lutp, int jt, int qrel, int hi, float& l, v4u* pa) {
#pragma unroll
    for (int r = 0; r < 16; ++r) { const int ko = 64 * jt + (r & 3) + 8 * (r >> 2);
        if (BIAS) { p0[r] += lutp[ko]; p1[r] += lutp[ko + 32]; }
        if (MASK) { const int kv = ko + 4 * hi; if (kv > qrel) p0[r] = -INFINITY; if (kv + 32 > qrel) p1[r] = -INFINITY; }
        p0[r] = __builtin_amdgcn_exp2f(p0[r]); p1[r] = __builtin_amdgcn_exp2f(p1[r]); }
    float s = 0.f;
#pragma unroll
    for (int r = 0; r < 16; ++r) s += p0[r] + p1[r];
    l += s;
    pa[0] = (v4u){cvtpk(p0[0], p0[1]), cvtpk(p0[2], p0[3]), cvtpk(p0[4], p0[5]), cvtpk(p0[6], p0[7])};
    pa[1] = (v4u){cvtpk(p0[8], p0[9]), cvtpk(p0[10], p0[11]), cvtpk(p0[12], p0[13]), cvtpk(p0[14], p0[15])};
    pa[2] = (v4u){cvtpk(p1[0], p1[1]), cvtpk(p1[2], p1[3]), cvtpk(p1[4], p1[5]), cvtpk(p1[6], p1[7])};
    pa[3] = (v4u){cvtpk(p1[8], p1[9]), cvtpk(p1[10], p1[11]), cvtpk(p1[12], p1[13]), cvtpk(p1[14], p1[15])};
}
__device__ __forceinline__ void pv_tile(f32x16* o, lds_cptr vp, const v4u* pa) {
#pragma unroll
    for (int d0 = 0; d0 < 2; ++d0)
#pragma unroll
        for (int ks = 0; ks < 4; ++ks) { const s16x4 lo = vtr(vp + d0 * 4096 + ks * 1024), hi = vtr(vp + d0 * 4096 + ks * 1024 + 512);
            const bf16x8 vf = (bf16x8){lo[0], lo[1], lo[2], lo[3], hi[0], hi[1], hi[2], hi[3]};
            o[d0] = __builtin_amdgcn_mfma_f32_32x32x16_bf16(vf, __builtin_bit_cast(bf16x8, pa[ks]), o[d0], 0, 0, 0); }
}
__device__ __forceinline__ void qk_half(f32x16& p, lds_cptr Kt, int s, const bf16x8* qr, const f32x16& cinit, int r32, int hi) {
    lds_cptr kb = Kt + hi * 1024 + r32 * 16 + s * 512;
#pragma unroll
    for (int d0 = 0; d0 < 4; ++d0) { const bf16x8 b0 = *(LAS const bf16x8*)(kb + d0 * 2048);
        if (d0 == 0) p = __builtin_amdgcn_mfma_f32_32x32x16_bf16(b0, qr[0], cinit, 0, 0, 0); else p = __builtin_amdgcn_mfma_f32_32x32x16_bf16(b0, qr[d0], p, 0, 0, 0); }
}
template <bool BIAS>
__device__ __forceinline__ void softmax_half(f32x16& p, LAS const float* lutp, int jt, int s, float& l, v4u& pa0, v4u& pa1) {
#pragma unroll
    for (int r = 0; r < 16; ++r) { const int ko = 64 * jt + 32 * s + (r & 3) + 8 * (r >> 2);
        if (BIAS) p[r] += lutp[ko];
        p[r] = __builtin_amdgcn_exp2f(p[r]); }
    float sm = 0.f;
#pragma unroll
    for (int r = 0; r < 16; ++r) sm += p[r];
    l += sm;
    pa0 = (v4u){cvtpk(p[0], p[1]), cvtpk(p[2], p[3]), cvtpk(p[4], p[5]), cvtpk(p[6], p[7])};
    pa1 = (v4u){cvtpk(p[8], p[9]), cvtpk(p[10], p[11]), cvtpk(p[12], p[13]), cvtpk(p[14], p[15])};
}
__device__ __forceinline__ void pv_half(f32x16* o, lds_cptr vp, int s, const v4u& pa0, const v4u& pa1) {
#pragma unroll
    for (int d0 = 0; d0 < 2; ++d0)
#pragma unroll
        for (int kk = 0; kk < 2; ++kk) { const int ks = 2 * s + kk; const s16x4 lo = vtr(vp + d0 * 4096 + ks * 1024), hi = vtr(vp + d0 * 4096 + ks * 1024 + 512);
            const bf16x8 vf = (bf16x8){lo[0], lo[1], lo[2], lo[3], hi[0], hi[1], hi[2], hi[3]};
            o[d0] = __builtin_amdgcn_mfma_f32_32x32x16_bf16(vf, __builtin_bit_cast(bf16x8, kk ? pa1 : pa0), o[d0], 0, 0, 0); }
}
struct SlotD { int kind, t, idx; };
__device__ __forceinline__ constexpr SlotD slot_desc(int g) {
    if (g < 4) return SlotD{0, 0, g};
    if (g < 8) return SlotD{0, 1, g - 4};
    if (g < 56) { const int tt = (g - 8) / 8 + 1, i = (g - 8) % 8; return (i & 1) ? SlotD{1, tt - 1, i >> 1} : SlotD{0, tt + 1, i >> 1}; }
    if (g < 60) return SlotD{1, 6, g - 56};
    return SlotD{1, 7, g - 60};
}
template <bool BIAS>
struct TileMath {
    f32x16 P[2]; unsigned pk[2][8]; v4u fr[3]; f32x2_t lv[4]; float e0, e1, l0, l1;
    f32x16* o; lds_cptr kb, vp0; const bf16x8* qr; const f32x16* cinit; LAS const float* lutp;
    template <int G> __device__ __forceinline__ v4u load_frag() { constexpr SlotD d = slot_desc(G);
        if (d.kind == 0) return *(LAS const v4u*)(kb + (d.t >> 1) * 8192 + (d.t & 1) * 512 + d.idx * 2048);
        constexpr int d0 = d.idx >> 1, ks = 2 * (d.t & 1) + (d.idx & 1); lds_cptr vp = vp0 + (d.t >> 1) * 8192 + d0 * 4096 + ks * 1024;
        const s16x4 a = vtr(vp), c = vtr(vp + 512); return __builtin_bit_cast(v4u, (bf16x8){a[0], a[1], a[2], a[3], c[0], c[1], c[2], c[3]}); }
    template <int Q> __device__ __forceinline__ f32x2_t lut_pair() { constexpr int t = Q >> 3, r0 = 2 * (Q & 7), ko = 64 * (t >> 1) + 32 * (t & 1) + (r0 & 3) + 8 * (r0 >> 2); return (f32x2_t){lutp[ko], lutp[ko + 1]}; }
    template <int Q> __device__ __forceinline__ void chunk() { constexpr int t = Q >> 3, c = Q & 7;
        if constexpr (Q > 0) { l0 += e0; l1 += e1; pk[((Q - 1) >> 3) & 1][(Q - 1) & 7] = cvtpk(e0, e1); }
        float x0 = P[t & 1][2 * c], x1 = P[t & 1][2 * c + 1];
        if constexpr (BIAS) { x0 += lv[Q & 3][0]; x1 += lv[Q & 3][1]; if constexpr (Q + 3 < 64) lv[(Q + 3) & 3] = lut_pair<Q + 3>(); }
        e0 = __builtin_amdgcn_exp2f(x0); e1 = __builtin_amdgcn_exp2f(x1); }
    template <int G> __device__ __forceinline__ void slot() {
        if constexpr (G + 2 < 64) fr[(G + 2) % 3] = load_frag<G + 2>();
        { constexpr SlotD d = slot_desc(G); const bf16x8 a = __builtin_bit_cast(bf16x8, fr[G % 3]);
          if constexpr (d.kind == 0) { if constexpr (d.idx == 0) P[d.t & 1] = __builtin_amdgcn_mfma_f32_32x32x16_bf16(a, qr[0], *cinit, 0, 0, 0); else P[d.t & 1] = __builtin_amdgcn_mfma_f32_32x32x16_bf16(a, qr[d.idx], P[d.t & 1], 0, 0, 0); }
          else { constexpr int d0 = d.idx >> 1, kk = d.idx & 1;
              o[d0] = __builtin_amdgcn_mfma_f32_32x32x16_bf16(a, __builtin_bit_cast(bf16x8, (v4u){pk[d.t & 1][4 * kk], pk[d.t & 1][4 * kk + 1], pk[d.t & 1][4 * kk + 2], pk[d.t & 1][4 * kk + 3]}), o[d0], 0, 0, 0); } }
        if constexpr (G >= 4 && G < 8) { chunk<2 * (G - 4)>(); chunk<2 * (G - 4) + 1>(); }
        else if constexpr (G >= 8 && G < 56) chunk<G>();
        else if constexpr (G >= 56 && G < 60) { chunk<56 + 2 * (G - 56)>(); chunk<56 + 2 * (G - 56) + 1>(); if constexpr (G == 59) { l0 += e0; l1 += e1; pk[1][7] = cvtpk(e0, e1); } }
        __builtin_amdgcn_sched_barrier(0);
    }
    template <int... G> __device__ __forceinline__ void run(std::integer_sequence<int, G...>) { (slot<G>(), ...); }
};
template <bool BIAS>
__device__ __forceinline__ void tile_math(f32x16* o, float& l, lds_cptr Kl, lds_cptr vp0, const bf16x8* qr, const f32x16& cinit, LAS const float* lutp, int r32, int hi) {
    TileMath<BIAS> T; T.o = o; T.kb = Kl + hi * 1024 + r32 * 16; T.vp0 = vp0; T.qr = qr; T.cinit = &cinit; T.lutp = lutp; T.e0 = T.e1 = T.l0 = T.l1 = 0.f;
    if constexpr (BIAS) { T.lv[0] = T.template lut_pair<0>(); T.lv[1] = T.template lut_pair<1>(); T.lv[2] = T.template lut_pair<2>(); }
    T.fr[0] = T.template load_frag<0>(); T.fr[1] = T.template load_frag<1>();
    __builtin_amdgcn_sched_barrier(0);
    T.run(std::make_integer_sequence<int, 64>{});
    l += T.l0 + T.l1;
}
__device__ __forceinline__ void load_q_raw(bf16x8* qr, const GAS bf16* Qb, size_t qrow, int b, int h, int hi) {
#pragma unroll
    for (int d0 = 0; d0 < 4; ++d0) { const v4u v = *(const GAS v4u*)(Qb + hm_off(qrow, b, h) + d0 * 16 + hi * 8); qr[d0] = __builtin_bit_cast(bf16x8, v); }
}
__device__ __forceinline__ float q_norm2(const bf16x8* qr) {
    float q2 = 0.f;
#pragma unroll
    for (int d0 = 0; d0 < 4; ++d0) { const v4u v = __builtin_bit_cast(v4u, qr[d0]);
#pragma unroll
        for (int j = 0; j < 4; ++j) { const float a = __builtin_bit_cast(float, v[j] << 16), c = __builtin_bit_cast(float, v[j] & 0xffff0000u); q2 += a * a + c * c; } }
    return swap_add(q2);
}

__device__ __forceinline__ float ref_exponent(float q2, float kmax2, float bmax) { return __builtin_sqrtf(q2 * kmax2) * 1.002f + bmax + 0.01f; }
__device__ __forceinline__ void head_bounds(const GAS float* KBM, const GAS float* rel_bias, int bh, int h, int lane, float& kmax2, float& bmax) {
    float k = KBM[bh * 32 + (lane & 31)], bb = rel_bias[(lane & 31) * NH + h] * LOG2E;
#pragma unroll
    for (int o = 1; o < 32; o <<= 1) { k = fmaxf(k, shx(k, o, lane)); bb = fmaxf(bb, shx(bb, o, lane)); }
    kmax2 = k; bmax = bb;
}
__device__ __forceinline__ void store_row(GAS bf16* rowp, const f32x16* o, float scale, int hi, bool act) {
    unsigned w0[8], w1[8];
#pragma unroll
    for (int k = 0; k < 4; ++k) { w0[2 * k] = cvtpk(o[0][4 * k] * scale, o[0][4 * k + 1] * scale); w0[2 * k + 1] = cvtpk(o[0][4 * k + 2] * scale, o[0][4 * k + 3] * scale);
        w1[2 * k] = cvtpk(o[1][4 * k] * scale, o[1][4 * k + 1] * scale); w1[2 * k + 1] = cvtpk(o[1][4 * k + 2] * scale, o[1][4 * k + 3] * scale); }
#pragma unroll
    for (int i = 0; i < 8; ++i) { auto r = __builtin_amdgcn_permlane32_swap(w0[i], w1[i], false, false); w0[i] = r[0]; w1[i] = r[1]; }
    if (act) {
#pragma unroll
        for (int k = 0; k < 4; ++k) *(GAS v4u*)(rowp + 32 * hi + 8 * k) = (v4u){w0[2 * k], w0[2 * k + 1], w1[2 * k], w1[2 * k + 1]}; }
}
__device__ __forceinline__ void add_row(f32x16* o, const GAS bf16* rowp, int hi) {
    v4u v[4];
#pragma unroll
    for (int k = 0; k < 4; ++k) v[k] = *(const GAS v4u*)(rowp + 32 * hi + 8 * k);
#pragma unroll
    for (int k = 0; k < 4; ++k) { auto r0 = __builtin_amdgcn_permlane32_swap(v[k][0], v[k][2], false, false); auto r1 = __builtin_amdgcn_permlane32_swap(v[k][1], v[k][3], false, false);
        o[0][4 * k] += __builtin_bit_cast(float, r0[0] << 16); o[0][4 * k + 1] += __builtin_bit_cast(float, r0[0] & 0xffff0000u);
        o[0][4 * k + 2] += __builtin_bit_cast(float, r1[0] << 16); o[0][4 * k + 3] += __builtin_bit_cast(float, r1[0] & 0xffff0000u);
        o[1][4 * k] += __builtin_bit_cast(float, r0[1] << 16); o[1][4 * k + 1] += __builtin_bit_cast(float, r0[1] & 0xffff0000u);
        o[1][4 * k + 2] += __builtin_bit_cast(float, r1[1] << 16); o[1][4 * k + 3] += __builtin_bit_cast(float, r1[1] & 0xffff0000u); }
}
__device__ __forceinline__ GAS bf16* po_row(GAS unsigned char* ws, GAS float* outbuf, int b, int h, int t, int slot) {
    return (b < 2 ? (GAS bf16*)outbuf : (GAS bf16*)(ws + WS_POB)) + ((((size_t)((b & 1) * 16 + h) * SEQ + t) * 3 + slot) * 64);
}

__device__ __forceinline__ void glds16(const GAS void* gsrc, unsigned lds_dst) {
    unsigned keep;
    asm volatile("s_mov_b32 %0, m0\n\ts_mov_b32 m0, %2\n\ts_nop 0\n\tglobal_load_lds_dwordx4 %1, off\n\ts_mov_b32 m0, %0" : "=&s"(keep) : "v"(gsrc), "s"(lds_dst) : "memory");
}
struct Top3 { float g1, g2, g3; int i1, i2, i3; };
__device__ __forceinline__ void top3_insert(Top3& T, float g, int n) {
    const bool c1 = g > T.g1, c2 = g > T.g2, c3 = g > T.g3;
    T.g3 = c2 ? T.g2 : (c3 ? g : T.g3); T.i3 = c2 ? T.i2 : (c3 ? n : T.i3);
    T.g2 = c1 ? T.g1 : (c2 ? g : T.g2); T.i2 = c1 ? T.i1 : (c2 ? n : T.i2);
    T.g1 = c1 ? g : T.g1;               T.i1 = c1 ? n : T.i1;
}
__device__ __forceinline__ void top3_insert_tie(Top3& T, float g, int n) {
    const bool ok = n >= 0;
    const bool c1 = ok && (g > T.g1 || (g == T.g1 && n < T.i1) || T.i1 < 0), c2 = ok && (g > T.g2 || (g == T.g2 && n < T.i2) || T.i2 < 0), c3 = ok && (g > T.g3 || (g == T.g3 && n < T.i3) || T.i3 < 0);
    T.g3 = c2 ? T.g2 : (c3 ? g : T.g3); T.i3 = c2 ? T.i2 : (c3 ? n : T.i3);
    T.g2 = c1 ? T.g1 : (c2 ? g : T.g2); T.i2 = c1 ? T.i1 : (c2 ? n : T.i2);
    T.g1 = c1 ? g : T.g1;               T.i1 = c1 ? n : T.i1;
}
__device__ __forceinline__ void route(Frame& F) {
    GAS unsigned char* ws = F.ws;
    const GAS bf16* Qb = (const GAS bf16*)(ws + WS_Q); const GAS bf16* Kb = (const GAS bf16*)(ws + WS_K);
    const GAS float* KMP = (const GAS float*)(ws + WS_KMP);
    GAS unsigned short* SEG = (GAS unsigned short*)(ws + WS_SEG); GAS unsigned* CNT = (GAS unsigned*)(ws + WS_CNT); GAS unsigned* TOT = (GAS unsigned*)(ws + WS_CTL) + CW_TOT;
    GAS float* KBM = (GAS float*)(ws + WS_KBM);
    int tid = F.wave * 64 + lane_id(); asm volatile("" : "+v"(tid));
    const int hf = tid >> 8, t = tid & 255, lane = tid & 63, w4 = __builtin_amdgcn_readfirstlane((tid >> 6) & 3), r32 = lane & 31, hi = lane >> 5;
    constexpr int HS = 20480;
    LAS unsigned char* hb = F.lds + __builtin_amdgcn_readfirstlane(hf) * HS;
    LAS unsigned* cntw = (LAS unsigned*)(hb + 16384);
    LAS float* kbw = (LAS float*)(hb + 16384 + 512);
    const int ua = (F.vcu * 2 + hf) >> 6, bh = (F.vcu * 2 + hf) & 63, b = bh >> 4, h = bh & 15;
    auto own_of = [&](int it) -> int { return it == 0 ? ua : it == 1 ? 31 - ua : it == 2 ? 8 + ua : 23 - ua; };
    v4u kreg[8]; float kmreg[8]; bf16x8 qf[2][4];
    auto prefetch = [&](int own) {
        const size_t row0 = (size_t)b * SEQ + own * BLK + 64 * w4;
#pragma unroll
        for (int tq = 0; tq < 2; ++tq)
#pragma unroll
            for (int d0 = 0; d0 < 4; ++d0) qf[tq][d0] = __builtin_bit_cast(bf16x8, *(const GAS v4u*)(Qb + hm_off(row0 + 32 * tq + r32, b, h) + d0 * 16 + hi * 8));
#pragma unroll
        for (int i = 0; i < 8; ++i) kreg[i] = *(const GAS v4u*)(Kb + hm_off(row0 + 8 * i, b, h) + lane * 8);
#pragma unroll
        for (int j = 0; j < 8; ++j) { const int i = t + 256 * j, n = i >> 6, d = i & 63; const size_t o = ((size_t)(b * 32 + n) * 2) * 1024 + h * 64 + d; kmreg[j] = (KMP[o] + KMP[o + 1024]) * (1.0f / 256.0f); }
    };
    prefetch(own_of(0));
    const unsigned fro = (unsigned)(r32 * 128), swz = (unsigned)((r32 >> 1) & 7);
#pragma unroll 1
    for (int it = 0; it < 4; ++it) {
        const int own = own_of(it);
        LAS unsigned char* kmh = hb + (it & 1) * 8192; LAS unsigned char* kml = kmh + 4096;
#pragma unroll
        for (int j = 0; j < 8; ++j) { const int i = t + 256 * j, n = i >> 6, d = i & 63; const float x = kmreg[j];
            const unsigned xb = __builtin_bit_cast(unsigned, x), hb16 = (xb + 0x7fffu + ((xb >> 16) & 1u)) >> 16; const float xh = __builtin_bit_cast(float, hb16 << 16), xl = x - xh;
            const unsigned lb = __builtin_bit_cast(unsigned, xl), lb16 = (lb + 0x7fffu + ((lb >> 16) & 1u)) >> 16;
            const int pos = n * 128 + (((d >> 3) ^ ((n >> 1) & 7)) * 16) + (d & 7) * 2;
            *(LAS unsigned short*)(kmh + pos) = (unsigned short)hb16; *(LAS unsigned short*)(kml + pos) = (unsigned short)lb16; }
        { float k2 = 0.f;
#pragma unroll
          for (int i = 0; i < 8; ++i) { float r2 = 0.f;
#pragma unroll
              for (int j = 0; j < 4; ++j) { const float a = __builtin_bit_cast(float, kreg[i][j] << 16), c = __builtin_bit_cast(float, kreg[i][j] & 0xffff0000u); r2 += a * a + c * c; }
              r2 += shx(r2, 1, lane); r2 += shx(r2, 2, lane); r2 += shx(r2, 4, lane); k2 = fmaxf(k2, r2); }
          k2 = fmaxf(k2, shx(k2, 8, lane)); k2 = fmaxf(k2, shx(k2, 16, lane)); k2 = fmaxf(k2, shx(k2, 32, lane));
          if (lane == 0) kbw[(it & 1) * 4 + w4] = k2; }
        bf16x8 qc[2][4];
#pragma unroll
        for (int tq = 0; tq < 2; ++tq)
#pragma unroll
            for (int d0 = 0; d0 < 4; ++d0) qc[tq][d0] = qf[tq][d0];
        __syncthreads();
        if (it < 3) prefetch(own_of(it + 1));
        f32x16 acc[2]; acc[0] = f32x16{}; acc[1] = f32x16{};
#pragma unroll
        for (int d0 = 0; d0 < 4; ++d0) { const unsigned co = ((unsigned)(2 * d0 + hi) ^ swz) * 16;
            const bf16x8 ah = *(const LAS bf16x8*)(kmh + fro + co), al = *(const LAS bf16x8*)(kml + fro + co);
#pragma unroll
            for (int tq = 0; tq < 2; ++tq) { acc[tq] = __builtin_amdgcn_mfma_f32_32x32x16_bf16(ah, qc[tq][d0], acc[tq], 0, 0, 0); acc[tq] = __builtin_amdgcn_mfma_f32_32x32x16_bf16(al, qc[tq][d0], acc[tq], 0, 0, 0); } }
        Top3 R;
#pragma unroll
        for (int tq = 0; tq < 2; ++tq) { Top3 T{-INFINITY, -INFINITY, -INFINITY, -1, -1, -1};
#pragma unroll
            for (int r = 0; r < 16; ++r) { const int n = crow(r, hi); const float g = acc[tq][r]; top3_insert(T, n < own ? g : -INFINITY, n < own ? n : -1); }
            Top3 P; { auto x1 = __builtin_amdgcn_permlane32_swap(__float_as_uint(T.g1), __float_as_uint(T.g1), false, false); P.g1 = __uint_as_float(hi ? x1[0] : x1[1]);
                      auto x2 = __builtin_amdgcn_permlane32_swap(__float_as_uint(T.g2), __float_as_uint(T.g2), false, false); P.g2 = __uint_as_float(hi ? x2[0] : x2[1]);
                      auto x3 = __builtin_amdgcn_permlane32_swap(__float_as_uint(T.g3), __float_as_uint(T.g3), false, false); P.g3 = __uint_as_float(hi ? x3[0] : x3[1]);
                      auto y1 = __builtin_amdgcn_permlane32_swap((unsigned)T.i1, (unsigned)T.i1, false, false); P.i1 = (int)(hi ? y1[0] : y1[1]);
                      auto y2 = __builtin_amdgcn_permlane32_swap((unsigned)T.i2, (unsigned)T.i2, false, false); P.i2 = (int)(hi ? y2[0] : y2[1]);
                      auto y3 = __builtin_amdgcn_permlane32_swap((unsigned)T.i3, (unsigned)T.i3, false, false); P.i3 = (int)(hi ? y3[0] : y3[1]); }
            top3_insert_tie(T, P.g1, P.i1); top3_insert_tie(T, P.g2, P.i2); top3_insert_tie(T, P.g3, P.i3);
            if (tq == hi) R = T; }
        const int i1 = R.i1, i2 = R.i2, i3 = R.i3;
        unsigned rk1 = 0, rk2 = 0, rk3 = 0;
        for (int n = 0; n < own; ++n) { const bool h1 = i1 == n, h2 = i2 == n, h3 = i3 == n; const unsigned long long mm = __ballot(h1 || h2 || h3);
            const unsigned rank = __builtin_amdgcn_mbcnt_hi((unsigned)(mm >> 32), __builtin_amdgcn_mbcnt_lo((unsigned)mm, 0u));
            rk1 = h1 ? rank : rk1; rk2 = h2 ? rank : rk2; rk3 = h3 ? rank : rk3;
            if (lane == 0) cntw[w4 * 32 + n] = (unsigned)__popcll(mm); }
        __syncthreads();
#pragma unroll
        for (int sl = 0; sl < 3; ++sl) { const int n = sl == 0 ? i1 : sl == 1 ? i2 : i3; const unsigned rk = sl == 0 ? rk1 : sl == 1 ? rk2 : rk3;
            const int nn = n & 31; unsigned base = 0;
#pragma unroll
            for (int w = 0; w < 3; ++w) { const unsigned v = cntw[w * 32 + nn]; base += (w < w4) ? v : 0u; }
            if (n >= 0) SEG[(((size_t)bh * 32 + own) * 32 + n) * 256 + base + rk] = (unsigned short)(t | (sl << 8)); }
        if (t < own) { const unsigned c = cntw[t] + cntw[32 + t] + cntw[64 + t] + cntw[96 + t]; CNT[((size_t)bh * 32 + own) * 32 + t] = c; (void)__hip_atomic_fetch_add(TOT + bh * 31 + t, c, RLX_AGENT); }
        if (t == 0) KBM[bh * 32 + own] = fmaxf(fmaxf(kbw[(it & 1) * 4], kbw[(it & 1) * 4 + 1]), fmaxf(kbw[(it & 1) * 4 + 2], kbw[(it & 1) * 4 + 3]));
    }
    asm volatile("s_waitcnt vmcnt(0)" ::: "memory");
    __syncthreads();
}

struct GTile { unsigned info; bf16x8 qr[4]; };
struct GRun { int e, c0, c1; };
__device__ __forceinline__ void dma_kv(LAS unsigned char* kv, const GAS bf16* Kb, const GAS bf16* Vb, int b, int h, int n, int w, int lane) {
#pragma unroll
    for (int t = 0; t < 4; ++t) {
        const size_t kr = (size_t)b * SEQ + n * BLK + 64 * t + lane, vr = (size_t)b * SEQ + n * BLK + 64 * t + 16 * (w & 3) + (lane >> 2);
        __builtin_amdgcn_global_load_lds((const GAS unsigned*)(Kb + hm_off(kr, b, h) + w * 8), (LAS unsigned*)(kv + L_K + t * 8192 + w * 1024), 16, 0, 0);
        __builtin_amdgcn_global_load_lds((const GAS unsigned*)(Vb + hm_off(vr, b, h) + (w >> 2) * 32 + (lane & 3) * 8), (LAS unsigned*)(kv + L_V + t * 8192 + w * 1024), 16, 0, 0);
    }
}
__device__ __forceinline__ void gather(Frame& F) {
    GAS unsigned char* ws = F.ws;
    const GAS bf16* Qb = (const GAS bf16*)(ws + WS_Q); const GAS bf16* Kb = (const GAS bf16*)(ws + WS_K); const GAS bf16* Vb = (const GAS bf16*)(ws + WS_V);
    const GAS unsigned short* SEG = (const GAS unsigned short*)(ws + WS_SEG); const GAS unsigned* CNT = (const GAS unsigned*)(ws + WS_CNT); const GAS unsigned* TOT = (const GAS unsigned*)(ws + WS_CTL) + CW_TOT;
    const GAS float* KBM = (const GAS float*)(ws + WS_KBM); GAS float* PL = (GAS float*)(ws + WS_PL);
    int tid = F.wave * 64 + lane_id(); asm volatile("" : "+v"(tid));
    const int lane = tid & 63, w = __builtin_amdgcn_readfirstlane(tid >> 6), r32 = lane & 31, hi = lane >> 5;
    LAS unsigned* pre = (LAS unsigned*)(F.lds + L_PRE);
    __syncthreads();
    if (w == 0) { unsigned loc = 0;
        for (int i = 0; i < 31; ++i) { const unsigned nc = (TOT[31 * lane + i] + 255u) >> 8; loc += nc + (nc ? 1u : 0u); }
        unsigned inc = loc;
#pragma unroll
        for (int o = 1; o < 64; o <<= 1) { const unsigned v = shup(inc, o, lane); if (lane >= o) inc += v; }
        unsigned run = inc - loc;
        for (int i = 0; i < 31; ++i) { pre[31 * lane + i] = run; const unsigned nc = (TOT[31 * lane + i] + 255u) >> 8; run += nc + (nc ? 1u : 0u); }
        if (lane == 63) pre[1984] = run; }
    __syncthreads();
    const int U = (int)pre[1984];
    int p = (int)(((long)F.vcu * U) / F.G); const int phi = (int)(((long)(F.vcu + 1) * U) / F.G);
    int e = 0; { int lo = 0, hi2 = 1984; while (hi2 - lo > 1) { const int mid = (lo + hi2) >> 1; if ((int)pre[mid] <= p) lo = mid; else hi2 = mid; } e = lo; }
    auto next_run = [&](GRun& R) -> bool {
        while (p < phi) {
            while (p >= (int)pre[e + 1]) ++e;
            const int k = p - (int)pre[e], nch = (int)pre[e + 1] - (int)pre[e] - 1;
            const int c0 = k > 0 ? k - 1 : 0; int c1 = phi - (int)pre[e] - 1; c1 = c1 < nch ? c1 : nch;
            p = (int)pre[e] + 1 + c1;
            if (c1 > c0) { R.e = e; R.c0 = c0; R.c1 = c1; return true; }
        }
        return false;
    };
    auto scan_cnt = [&](unsigned v) -> unsigned { unsigned inc = v;
#pragma unroll
        for (int o = 1; o < 32; o <<= 1) { const unsigned t2 = shup(inc, o, lane); if ((lane & 31) >= o) inc += t2; }
        return inc; };
    int cur_h = -1, cur_bh = -1, rb = 0; float kmax2 = 0.f, bmax = 0.f, rb31 = 0.f;
    GRun cur, nxt; bool hc = next_run(cur);
    unsigned cntN = 0, totN = 0, cumv = 0, tot = 0;
    if (hc) { const int bh = cur.e / 31, n = cur.e - bh * 31; dma_kv(F.lds, Kb, Vb, bh >> 4, bh & 15, n, w, lane);
        cntN = ((lane & 31) > n) ? CNT[((size_t)bh * 32 + (lane & 31)) * 32 + n] : 0u; totN = TOT[cur.e]; }
    GTile tcur, tnxt; unsigned ownB = 0, entB = 0xffffffffu; bool mine = false;
    auto fetch_ent = [&](int c, bool valid, int n, const GAS unsigned short* segb, unsigned cv, unsigned tt, unsigned& own_o) -> unsigned {
        const unsigned g0 = 256u * c + 32u * w, g = g0 + r32;
        const bool tile_ok = valid && g0 < tt;
        unsigned own = (unsigned)(n + 1), base = 0u;
        if (tile_ok) {
            int lo = n + 1, hi2 = 32;
            while (hi2 - lo > 1) { const int mid = (lo + hi2) >> 1; if (__builtin_amdgcn_readlane(cv, mid - 1) <= g0) lo = mid; else hi2 = mid; }
            own = (unsigned)lo; base = (lo == n + 1) ? 0u : __builtin_amdgcn_readlane(cv, lo - 1);
            for (int o = lo + 1; o < 32; ++o) { const unsigned s2 = __builtin_amdgcn_readlane(cv, o - 1); if (s2 > g0 + 31u) break; if (s2 <= g) { own = (unsigned)o; base = s2; } }
        }
        const bool lane_ok = tile_ok && g < tt;
        const unsigned idx = lane_ok ? (g - base) : 0u;
        const unsigned v = (unsigned)segb[(size_t)own * 32 * 256 + idx];
        own_o = own;
        return lane_ok ? v : 0xffffffffu;
    };
    auto make_tile = [&](unsigned ent, unsigned own, int b, int h, int n, GTile& T) {
        const bool act = ent != 0xffffffffu;
        const int tq = act ? (int)(own * BLK + (ent & 255u)) : SEQ - 1;
        T.info = (unsigned)tq | (act ? (((ent >> 8) & 3u) << 16) | (1u << 18) | ((own - n <= 4) ? (1u << 19) : 0u) : 0u);
        load_q_raw(T.qr, Qb, (size_t)b * SEQ + tq, b, h, hi);
    };
    auto start_run = [&](const GRun& R) {
        const int bh = R.e / 31, n = R.e - bh * 31; const GAS unsigned short* segb = SEG + ((size_t)bh * 32 * 32 + n) * 256;
        cumv = scan_cnt(cntN); tot = totN;
        mine = (unsigned)(256 * R.c0 + 32 * w) < tot;
        entB = 0xffffffffu; ownB = 0;
        if (mine) { unsigned ownA; const unsigned entA = fetch_ent(R.c0, true, n, segb, cumv, tot, ownA); make_tile(entA, ownA, bh >> 4, bh & 15, n, tcur);
            entB = fetch_ent(R.c0 + 1, R.c0 + 1 < R.c1, n, segb, cumv, tot, ownB); }
    };
    if (hc) start_run(cur);
    while (hc) {
        const bool hn = next_run(nxt);
        const int c0 = cur.c0, c1 = cur.c1, bh = cur.e / 31, n = cur.e - bh * 31, b = bh >> 4, h = bh & 15;
        const GAS unsigned short* segb = SEG + ((size_t)bh * 32 * 32 + n) * 256;
        LAS unsigned char* kv = F.lds + rb * 65536;
        __builtin_amdgcn_s_waitcnt(0x0F70);
        __syncthreads();
        if (hn) { const int bh2 = nxt.e / 31, n2 = nxt.e - bh2 * 31;
            cntN = ((lane & 31) > n2) ? CNT[((size_t)bh2 * 32 + (lane & 31)) * 32 + n2] : 0u; totN = TOT[nxt.e]; }
        if (bh != cur_bh) { head_bounds(KBM, F.rel_bias, bh, h, lane, kmax2, bmax); rb31 = F.rel_bias[31 * NH + h] * LOG2E; cur_bh = bh;
            if (h != cur_h) { build_lut(F.lds, F.rel_bias, h, tid); cur_h = h; __syncthreads(); } }
        const lds_cptr Kl = (lds_cptr)(kv + L_K), vp0 = (lds_cptr)(kv + L_V) + ((lane >> 4) & 1) * 32 + (lane & 3) * 8 + (4 * hi + ((lane & 15) >> 2)) * 64;
        if (mine) for (int c = c0; c < c1; ++c) {
            if ((unsigned)(256 * c + 32 * w) >= tot) break;
            make_tile(entB, ownB, b, h, n, tnxt);
            entB = fetch_ent(c + 2, c + 2 < c1, n, segb, cumv, tot, ownB);
            const unsigned info = tcur.info; const int tq = (int)(info & 0xffffu); const bool near = (info >> 19) & 1u;
            const float mref = ref_exponent(q_norm2(tcur.qr), kmax2, bmax);
            const bool anynear = __any(near);
            const int tqrel = near ? (tq - n * BLK) : 1755;
            LAS const float* lutp = (LAS const float*)(F.lds + L_LUT) + (2047 - tqrel + 4 * hi);
            f32x16 cinit; { const float cc = anynear ? -mref : (rb31 - mref);
#pragma unroll
                for (int r = 0; r < 16; ++r) cinit[r] = cc; }
            f32x16 o[2]; o[0] = f32x16{}; o[1] = f32x16{}; float l = 0.f;
            if (anynear) tile_math<true>(o, l, Kl, vp0, tcur.qr, cinit, lutp, r32, hi); else tile_math<false>(o, l, Kl, vp0, tcur.qr, cinit, lutp, r32, hi);
            l = swap_add(l);
            { const bool act = (info >> 18) & 1u; const int slot = (int)((info >> 16) & 3u);
              GAS bf16* dump = (GAS bf16*)(ws + WS_DUMP) + (size_t)F.vcu * 4096 + lane * 64;
              store_row(act ? po_row(ws, F.out, b, h, tq, slot) : dump - 32 * hi, o, 1.0f, hi, true);
              GAS float* plp = act ? PL + (((size_t)bh * SEQ + tq) * 3) + slot : (GAS float*)dump;
              *plp = l; }
            tcur = tnxt;
        }
        if (hn) { start_run(nxt);
            const int bh2 = nxt.e / 31, n2 = nxt.e - bh2 * 31; dma_kv(F.lds + (rb ^ 1) * 65536, Kb, Vb, bh2 >> 4, bh2 & 15, n2, w, lane); }
        cur = nxt; hc = hn; rb ^= 1;
    }
    asm volatile("s_waitcnt vmcnt(0)" ::: "memory");
    __syncthreads();
}

__device__ __forceinline__ void own_block(Frame& F) {
    GAS unsigned char* ws = F.ws;
    const GAS bf16* Qb = (const GAS bf16*)(ws + WS_Q); const GAS bf16* Kb = (const GAS bf16*)(ws + WS_K); const GAS bf16* Vb = (const GAS bf16*)(ws + WS_V); GAS bf16* Ob = (GAS bf16*)(ws + WS_O);
    const GAS float* KBM = (const GAS float*)(ws + WS_KBM); const GAS float* PL = (const GAS float*)(ws + WS_PL);
    int tid = F.wave * 64 + lane_id(); asm volatile("" : "+v"(tid));
    const int lane = tid & 63, w = __builtin_amdgcn_readfirstlane(tid >> 6), r32 = lane & 31, hi = lane >> 5;
    const int bh = F.vcu & 63, b = bh >> 4, h = bh & 15, own0 = F.vcu >> 6, nun = (NBLK - own0 + 3) / 4;
    __syncthreads();
    build_lut(F.lds, F.rel_bias, h, tid);
    float kmax2, bmax; head_bounds(KBM, F.rel_bias, bh, h, lane, kmax2, bmax);
    const int qrel = 32 * w + r32;
    LAS const float* lutp = (LAS const float*)(F.lds + L_LUT) + (2047 - qrel + 4 * hi);
    const int jd = w >> 1;
    bf16x8 qn[4];
    dma_kv(F.lds, Kb, Vb, b, h, own0, w, lane);
    load_q_raw(qn, Qb, (size_t)b * SEQ + own0 * BLK + qrel, b, h, hi);
    for (int i = 0; i < nun; ++i) {
        const int own = own0 + 4 * i; const size_t qrow = (size_t)b * SEQ + own * BLK + qrel;
        LAS unsigned char* kv = F.lds + (i & 1) * 65536;
        bf16x8 qr[4];
#pragma unroll
        for (int d0 = 0; d0 < 4; ++d0) qr[d0] = qn[d0];
        asm volatile("s_waitcnt vmcnt(0)" ::: "memory");
        __syncthreads();
        if (i + 1 < nun) { dma_kv(F.lds + ((i + 1) & 1) * 65536, Kb, Vb, b, h, own + 4, w, lane); load_q_raw(qn, Qb, qrow + 4 * BLK, b, h, hi); }
        const float mref = ref_exponent(q_norm2(qr), kmax2, bmax);
        f32x16 cinit;
#pragma unroll
        for (int r = 0; r < 16; ++r) cinit[r] = -mref;
        f32x16 o[2]; o[0] = f32x16{}; o[1] = f32x16{}; float l = 0.f;
        const lds_cptr Kl = (lds_cptr)(kv + L_K), vp0 = (lds_cptr)(kv + L_V) + ((lane >> 4) & 1) * 32 + (lane & 3) * 8 + (4 * hi + ((lane & 15) >> 2)) * 64;
        for (int j = 0; j <= jd; ++j) { f32x16 p0, p1; v4u pa[4];
            qk_tile(p0, p1, Kl + j * 8192, qr, cinit, r32, hi);
            if (j == jd) softmax_tile<true, true>(p0, p1, lutp, j, qrel, hi, l, pa); else softmax_tile<true, false>(p0, p1, lutp, j, qrel, hi, l, pa);
            pv_tile(o, vp0 + j * 8192, pa); }
        l = swap_add(l);
        const int nsl = own < 3 ? own : 3; const int tq = own * BLK + qrel;
        for (int sl = 0; sl < nsl; ++sl) { add_row(o, po_row(ws, F.out, b, h, tq, sl), hi); l += PL[(((size_t)bh * SEQ + tq) * 3) + sl]; }
        store_row(Ob + qrow * D + h * 64, o, 1.0f / l, hi, true);
    }
    asm volatile("s_waitcnt vmcnt(0)" ::: "memory");
    __syncthreads();
}
}

__device__ __forceinline__ void final_norm(Frame& Fr) {
    struct { int lane, vcu, wave, G; const GAS float* norm_final; GAS float* out; } F{Fr.wave * 64 + lane_id(), Fr.vcu, Fr.wave, Fr.G, Fr.norm_final, Fr.out};
    asm volatile("" : "+v"(F.lane)); F.lane &= 63;
    const int gw = F.vcu * NWAVES + F.wave, NGW = F.G * NWAVES;
    f32x4 gam[4];
#pragma unroll
    for (int j = 0; j < 4; ++j) gam[j] = *(const GAS f32x4*)(F.norm_final + 4 * (F.lane + 64 * j));
    for (int row = gw; row < M; row += NGW) { GAS float* xr = F.out + (size_t)row * D; f32x4 v[4]; float ss = 0.f;
#pragma unroll
        for (int j = 0; j < 4; ++j) { v[j] = *(const GAS f32x4*)(xr + 4 * (F.lane + 64 * j)); ss += (v[j][0] * v[j][0] + v[j][1] * v[j][1]) + (v[j][2] * v[j][2] + v[j][3] * v[j][3]); }
#pragma unroll
        for (int o = 1; o < 64; o <<= 1) ss += shx(ss, o, F.lane);
        const float rstd = rsqrtf(ss * (1.0f / D) + EPS);
#pragma unroll
        for (int j = 0; j < 4; ++j) *(GAS f32x4*)(xr + 4 * (F.lane + 64 * j)) = v[j] * rstd * gam[j]; }
}

__global__ void __launch_bounds__(NWAVES * 64, 2) fwd_megakernel(Args args) {
    __shared__ __attribute__((aligned(16))) unsigned char lds[LDS_BYTES];
    Frame F;
    F.lds = (LAS unsigned char*)lds;
    F.tid = threadIdx.x; F.lane = F.tid & 63; F.wave = __builtin_amdgcn_readfirstlane(F.tid >> 6);
    F.G = gridDim.x; { const int bx = blockIdx.x; F.vcu = (F.G % 8 == 0) ? (bx % 8) * (F.G / 8) + bx / 8 : bx; }
    F.x = args.in[0]; F.c = args.in[1]; F.rel_bias = args.in[2]; F.w_mod = args.in[3]; F.b_mod = args.in[4]; F.norm_mix = args.in[5]; F.norm_mlp = args.in[6];
    F.w_pool = args.in[7]; F.pool_scale = args.in[8]; F.w_qkv = args.in[9]; F.w_o = args.in[10]; F.w_up = args.in[11]; F.w_down = args.in[12]; F.norm_final = args.in[13];
    F.out = args.out; F.ws = args.ws;
    volatile LAS unsigned* MISC = (volatile LAS unsigned*)(F.lds + MISC_OFF);
    for (int u = F.tid; u < (LDS_BYTES - LDSCTL_OFF) / 4; u += NWAVES * 64) ((LAS unsigned*)(F.lds + LDSCTL_OFF))[u] = 0u;
    __syncthreads();
    gu32* ctl = (gu32*)(F.ws + WS_CTL);
    XcdBarrier bar = xcd_barrier_post((GAS unsigned*)(ctl + CW_BAR), MISC + 8); bar.wave = F.wave;
    GAS unsigned char* ws = F.ws;
#define WSB(off) ((GAS bf16*)(ws + (off)))
#define WSF(off) ((GAS float*)(ws + (off)))

    p0_prologue(F);
    xcd_barrier(bar);
    p1_bias(F); p1_pool(F);
    xcd_barrier(bar);

    for (int ph = 0; ph < 10; ++ph) {
        asm volatile("" : "+s"(ws));
        const GAS float* MOD = WSF(WS_MOD); GAS float* SS = WSF(WS_SS);
        const int kind = (ph == 0 || ph == 2 || ph == 7) ? 0 : (ph == 1 || ph == 8) ? 1 : (ph == 3) ? 2 : (ph == 4) ? 3 : (ph == 5) ? 4 : (ph == 6) ? 5 : 7;
        if (kind == 0) {
            pg8::Gemm g; pg8::EpiRes E;
            if (ph == 0) { g = pg8::Gemm{WSB(WS_XNA), WSB(WS_WPOOL), M, D, 256, D, 256, 512};
                E = pg8::EpiRes{WSB(WS_XR), WSB(WS_XR), MOD + 2048, F.pool_scale, F.norm_mlp, MOD + 4096, WSB(WS_XNB), SS}; }
            else if (ph == 2) { g = pg8::Gemm{WSB(WS_HB), WSB(WS_WDN0), M, D, FF, 256, 0, 131072};
                E = pg8::EpiRes{WSB(WS_XR), WSB(WS_XR), MOD + 5120, nullptr, F.norm_mix + D, MOD + 4 * 6144 + 1024, WSB(WS_XNA), SS}; }
            else { g = pg8::Gemm{WSB(WS_O), WSB(WS_WO), M, D, D, D, 0, 512};
                E = pg8::EpiRes{WSB(WS_XR), WSB(WS_XR), MOD + 4 * 6144 + 2048, nullptr, F.norm_mlp + D, MOD + 4 * 6144 + 4096, WSB(WS_XNB), SS}; }
            pg8::StaticOrder S; S.init(M, D, F.G, (int)blockIdx.x);
            pg8::gemm_phase<pg8::EpiRes, pg8::StaticOrder, true>(F.lds + RING_OFF, g, S, E, F.wave);
        } else if (kind == 1) {
            const pg8::Gemm g{WSB(WS_XNB), WSB(ph == 1 ? WS_WUP0 : WS_WUP1), M, FF, D, 256, 0, 131072};
            const pg8::EpiUp E{SS, WSF(ph == 1 ? WS_BIAS_UP0 : WS_BIAS_UP1), WSB(WS_HB), FF, F.lds, 0};
            pg8::StaticOrder S; S.init(M, FF, F.G, (int)blockIdx.x);
            pg8::gemm_phase<pg8::EpiUp, pg8::StaticOrder, true>(F.lds + RING_OFF, g, S, E, F.wave);
        } else if (kind == 2) {
            const pg8::Gemm g{WSB(WS_XNA), WSB(WS_WQKV), M, NQKV, D, 256, 0, 131072};
            const pg8::EpiQKV E{SS, WSF(WS_BIAS_QKV), WSB(WS_Q), (size_t)(WS_K - WS_Q) / 2, WSF(WS_KMP), F.lds, 0};
            pg8::StaticOrder S; S.init(M, NQKV, F.G, (int)blockIdx.x);
            pg8::gemm_phase<pg8::EpiQKV, pg8::StaticOrder, true>(F.lds + RING_OFF, g, S, E, F.wave);
        } else if (kind == 3) { F.ws = ws; att::route(F);
        } else if (kind == 4) { F.ws = ws; att::gather(F);
        } else if (kind == 5) { F.ws = ws; att::own_block(F);
        } else {
            const pg8::Gemm g{WSB(WS_HB), WSB(WS_WDN1), M, D, FF, 256, 0, 131072};
            const pg8::EpiFinal E{WSB(WS_XR), F.out, MOD + 4 * 6144 + 5120, F.norm_final, SS, (GAS unsigned*)(ws + WS_CTL) + CW_FIN};
            pg8::StaticOrder S; S.init(M, D, F.G, (int)blockIdx.x);
            pg8::gemm_phase<pg8::EpiFinal, pg8::StaticOrder, true>(F.lds + RING_OFF, g, S, E, F.wave);
            break;
        }
        xcd_barrier(bar);
    }
}

extern "C" void kernel_launch(void* const* d_in, const int* in_sizes, int n_in, void* d_out, int out_size, void* d_ws, size_t ws_size, hipStream_t stream) {
    static int grid = 0;
    if (grid == 0) {
        if (n_in != 14 || in_sizes[0] != M * D || out_size != M * D || ws_size < WS_END) { fprintf(stderr, "kernel_launch: unexpected shapes / workspace (n_in %d, in0 %d, out %d, ws %zu)\n", n_in, n_in > 0 ? in_sizes[0] : -1, out_size, ws_size); grid = -1; return; }
        int dev = 0, cus = 0, per_cu = 0;
        if (hipGetDevice(&dev) != hipSuccess || hipDeviceGetAttribute(&cus, hipDeviceAttributeMultiprocessorCount, dev) != hipSuccess) { grid = -1; return; }
        if (hipOccupancyMaxActiveBlocksPerMultiprocessor(&per_cu, (const void*)fwd_megakernel, NWAVES * 64, 0) != hipSuccess || per_cu < 1) { fprintf(stderr, "kernel_launch: occupancy query says %d blocks per CU\n", per_cu); }
        (void)hipGetLastError();
        grid = cus;
    }
    if (grid < 0) return;
    if (hipMemsetAsync((char*)d_ws + WS_CTL, 0, CTL_ZERO_BYTES, stream) != hipSuccess) return;
    Args a{};
    for (int i = 0; i < 14; ++i) a.in[i] = (const GAS float*)d_in[i];
    a.out = (GAS float*)d_out; a.ws = (GAS unsigned char*)d_ws;
    hipLaunchKernelGGL(fwd_megakernel, dim3(grid), dim3(NWAVES * 64), 0, stream, a);
}
```

```cpp
#include <hip/hip_runtime.h>
#include <utility>
#include <cstdio>
#include <cstdint>

__device__ __forceinline__ float shx(float v, int m, int lane) { return __builtin_bit_cast(float, __builtin_amdgcn_ds_bpermute((lane ^ m) << 2, __builtin_bit_cast(int, v))); }
__device__ __forceinline__ unsigned shup(unsigned v, int o, int lane) { return (unsigned)__builtin_amdgcn_ds_bpermute(((lane - o) & 63) << 2, (int)v); }
__device__ __forceinline__ size_t hm_off(size_t row, int b, int h) { return (row + (size_t)(15 * b + h) * 8192) * 64; }
__device__ __forceinline__ int lane_id() { unsigned z = 0u; asm volatile("" : "+s"(z)); return (int)__builtin_amdgcn_mbcnt_hi(~0u, __builtin_amdgcn_mbcnt_lo(~0u, z)); }

namespace pg8 {
#define PG8_LAS __attribute__((address_space(3)))
#define PG8_GAS __attribute__((address_space(1)))
typedef unsigned short bf16_t;
typedef short bf16x8 __attribute__((ext_vector_type(8)));
typedef float f32x4 __attribute__((ext_vector_type(4)));
typedef unsigned u32x4 __attribute__((ext_vector_type(4)));
constexpr int BM = 256, BK = 64, HALF = 128, HTB = HALF * BK * 2, STAGE_BYTES = 8 * HTB, NXCD = 8, WGM = 8;

__host__ __device__ __forceinline__ int lds_byte(int r, int c) { const int st = (r >> 4) * 2 + (c >> 5), rr = r & 15, cc = c & 31, ob = rr * 64 + cc * 2; return st * 1024 + (ob ^ (((ob >> 9) & 1) << 5)); }
__host__ __device__ __forceinline__ void stage_rc(int b, int& R, int& C) { const int st = b / 1024, sb = b % 1024, swz = sb ^ (((sb >> 9) & 1) << 5); R = (st >> 1) * 16 + swz / 64; C = (st & 1) * 32 + (swz % 64) / 2; }
__host__ __device__ __forceinline__ int perm32(int rho) { const int n = rho >> 4, i = rho & 15; return 8 * (i >> 2) + 4 * n + (i & 3); }

struct Unit { int pm, pn; };
struct Gemm { const PG8_GAS bf16_t* A; const PG8_GAS bf16_t* Bt; int M, N, K, lda, a_pn_off, a_tileb; };

struct StaticOrder {
    int nM, nN, nwg, G, c;
    __host__ __device__ void init(int M, int N, int G_, int c_) { nM = M / BM; nN = N / BM; nwg = nM * nN; G = G_; c = c_; }
    __host__ __device__ bool next(int i, Unit& u) const {
        const long L = (long)i * G + c; if (L >= nwg) return false;
        int wgid = (int)L; { const int q = nwg / NXCD, r = nwg % NXCD, xcd = wgid % NXCD, off = wgid / NXCD; wgid = (xcd < r ? xcd * (q + 1) : r * (q + 1) + (xcd - r) * q) + off; }
        const int nig = WGM * nN, gid = wgid / nig, fm = gid * WGM, gsz = (nM - fm) < WGM ? (nM - fm) : WGM;
        u.pm = fm + ((wgid % nig) % gsz); u.pn = (wgid % nig) / gsz; return true;
    }
};

__device__ __forceinline__ unsigned cvt_pk_bf16(float lo, float hi) { unsigned r; asm volatile("v_cvt_pk_bf16_f32 %0, %1, %2" : "=v"(r) : "v"(lo), "v"(hi)); return r; }

constexpr int SEQ_ = 8192;
constexpr float EPS_ = 1e-6f;
constexpr float C2_ = 0.125f * 1.4426950408889634f;


__device__ __forceinline__ float row_rstd(const PG8_GAS float* SS, int row, int fq, int fr) {
    const f32x4 s4 = *(const PG8_GAS f32x4*)(SS + (size_t)row * 16 + 4 * fq);
    float s = (s4[0] + s4[1]) + (s4[2] + s4[3]);
    const int ln = fq * 16 + fr; s += shx(s, 16, ln); s += shx(s, 32, ln);
    return rsqrtf(s * (1.0f / 1024.0f) + EPS_);
}

constexpr int RSTD_TAB_OFF = 132096;
__device__ __forceinline__ void fill_rstd_tab(PG8_LAS unsigned char* ldsbase, int par, const PG8_GAS float* SS, int pm, int wid, int lane) {
    if (lane < 32) { const int r = wid * 32 + lane; const PG8_GAS f32x4* p = (const PG8_GAS f32x4*)(SS + (size_t)(pm * BM + r) * 16);
        const f32x4 a = p[0], b = p[1], c = p[2], d = p[3];
        const float g0 = (a[0] + a[1]) + (a[2] + a[3]), g1 = (b[0] + b[1]) + (b[2] + b[3]), g2 = (c[0] + c[1]) + (c[2] + c[3]), g3 = (d[0] + d[1]) + (d[2] + d[3]);
        ((PG8_LAS float*)(ldsbase + RSTD_TAB_OFF + par * 1024))[r] = rsqrtf(((g0 + g1) + (g2 + g3)) * (1.0f / 1024.0f) + EPS_); }
}
__device__ __forceinline__ f32x4 bf_lo4(const u32x4& w) { return (f32x4){__builtin_bit_cast(float, w.x << 16), __builtin_bit_cast(float, w.x & 0xffff0000u), __builtin_bit_cast(float, w.y << 16), __builtin_bit_cast(float, w.y & 0xffff0000u)}; }
__device__ __forceinline__ f32x4 bf_hi4(const u32x4& w) { return (f32x4){__builtin_bit_cast(float, w.z << 16), __builtin_bit_cast(float, w.z & 0xffff0000u), __builtin_bit_cast(float, w.w << 16), __builtin_bit_cast(float, w.w & 0xffff0000u)}; }
struct EpiRes {
    static constexpr bool PERM = true, NEEDS_RSTD = false;
    const PG8_GAS bf16_t* Rb; PG8_GAS bf16_t* Xb; const PG8_GAS float* gate; const PG8_GAS float* cscale; const PG8_GAS float* gnext; const PG8_GAS float* scn; PG8_GAS bf16_t* XN; PG8_GAS float* SS;
    __device__ __forceinline__ void operator()(f32x4 (&acc)[2][2][4][2], const Unit& u, int wr, int wc, int fr, int fq) const {
        const int b = u.pm >> 5, colb = u.pn * BM + wc * 32 + 8 * fq, row0 = u.pm * BM + wr * 64 + fr;
        float ssq[2][4];
#pragma unroll
        for (int bj = 0; bj < 2; ++bj) {
            f32x4 gt[2], cs[2];
#pragma unroll
            for (int n = 0; n < 2; ++n) { const int col = colb + bj * HALF + 4 * n;
                f32x4 gv = *(const PG8_GAS f32x4*)(gate + b * 6144 + col); if (cscale) gv = gv * *(const PG8_GAS f32x4*)(cscale + col); gt[n] = gv;
                const f32x4 sc = *(const PG8_GAS f32x4*)(scn + b * 6144 + col); cs[n] = *(const PG8_GAS f32x4*)(gnext + col) * (sc + 1.0f); }
#pragma unroll
            for (int ai = 0; ai < 2; ++ai)
#pragma unroll
                for (int m = 0; m < 4; ++m) { const size_t off = ((size_t)(u.pm * 4 + u.pn) * 256 + (wr * 64 + fr + ai * HALF + m * 16)) * 256 + (wc * 32 + 8 * fq + bj * HALF);
                    const u32x4 rw = *(const PG8_GAS u32x4*)(Rb + off); const f32x4 r0 = bf_lo4(rw), r1 = bf_hi4(rw);
                    const f32x4 y0 = r0 + gt[0] * acc[ai][bj][m][0], y1 = r1 + gt[1] * acc[ai][bj][m][1];
                    u32x4 xw; xw.x = cvt_pk_bf16(y0[0], y0[1]); xw.y = cvt_pk_bf16(y0[2], y0[3]); xw.z = cvt_pk_bf16(y1[0], y1[1]); xw.w = cvt_pk_bf16(y1[2], y1[3]);
                    *(PG8_GAS u32x4*)(Xb + off) = xw;
                    const f32x4 x0 = bf_lo4(xw), x1 = bf_hi4(xw);
                    const float q = (x0[0] * x0[0] + x0[1] * x0[1]) + (x0[2] * x0[2] + x0[3] * x0[3]) + (x1[0] * x1[0] + x1[1] * x1[1]) + (x1[2] * x1[2] + x1[3] * x1[3]);
                    ssq[ai][m] = (bj == 0) ? q : ssq[ai][m] + q;
                    const f32x4 a0 = x0 * cs[0], a1 = x1 * cs[1]; u32x4 w; w.x = cvt_pk_bf16(a0[0], a0[1]); w.y = cvt_pk_bf16(a0[2], a0[3]); w.z = cvt_pk_bf16(a1[0], a1[1]); w.w = cvt_pk_bf16(a1[2], a1[3]);
                    *(PG8_GAS u32x4*)(XN + off) = w;
                }
        }
#pragma unroll
        for (int ai = 0; ai < 2; ++ai)
#pragma unroll
            for (int m = 0; m < 4; ++m) { float q = ssq[ai][m]; q += shx(q, 16, fq * 16 + fr); q += shx(q, 32, fq * 16 + fr); if (fq == 0) SS[(size_t)(row0 + ai * HALF + m * 16) * 16 + u.pn * 4 + wc] = q; }
    }
};

struct EpiFinal {
    static constexpr bool PERM = true, NEEDS_RSTD = false;
    const PG8_GAS bf16_t* R; PG8_GAS float* OUT; const PG8_GAS float* gate; const PG8_GAS float* gfin; PG8_GAS float* SS; PG8_GAS unsigned* cnt;
    __device__ __forceinline__ void operator()(f32x4 (&acc)[2][2][4][2], const Unit& u, int wr, int wc, int fr_, int fq_) const {
        int fr = fr_, fq = fq_; asm volatile("" : "+v"(fr), "+v"(fq));
        const int b = u.pm >> 5, colb = u.pn * BM + wc * 32 + 8 * fq, row0 = u.pm * BM + wr * 64 + fr, ln = fq * 16 + fr;
        float ssq[2][4];
#pragma unroll
        for (int bj = 0; bj < 2; ++bj) {
            const f32x4 gt0 = *(const PG8_GAS f32x4*)(gate + b * 6144 + colb + bj * HALF), gt1 = *(const PG8_GAS f32x4*)(gate + b * 6144 + colb + bj * HALF + 4);
#pragma unroll
            for (int ai = 0; ai < 2; ++ai)
#pragma unroll
                for (int m = 0; m < 4; ++m) { const size_t off = (size_t)(row0 + ai * HALF + m * 16) * 1024 + colb + bj * HALF;
                    const u32x4 rw = *(const PG8_GAS u32x4*)(R + ((size_t)(u.pm * 4 + u.pn) * 256 + (wr * 64 + fr + ai * HALF + m * 16)) * 256 + (wc * 32 + 8 * fq + bj * HALF));
                    const f32x4 x0 = bf_lo4(rw) + gt0 * acc[ai][bj][m][0], x1 = bf_hi4(rw) + gt1 * acc[ai][bj][m][1];
                    acc[ai][bj][m][0] = x0; acc[ai][bj][m][1] = x1;
                    const float q = (x0[0] * x0[0] + x0[1] * x0[1]) + (x0[2] * x0[2] + x0[3] * x0[3]) + (x1[0] * x1[0] + x1[1] * x1[1]) + (x1[2] * x1[2] + x1[3] * x1[3]);
                    ssq[ai][m] = (bj == 0) ? q : ssq[ai][m] + q;
                    asm volatile("" : "+v"(acc[ai][bj][m][0]), "+v"(acc[ai][bj][m][1]), "+v"(ssq[ai][m]));
                    if (m & 1) asm volatile("" ::: "memory"); }
        }
#pragma unroll
        for (int ai = 0; ai < 2; ++ai)
#pragma unroll
            for (int m = 0; m < 4; ++m) { float q = ssq[ai][m]; q += shx(q, 16, ln); q += shx(q, 32, ln);
                if (fq == 0) __hip_atomic_store(SS + (size_t)(row0 + ai * HALF + m * 16) * 16 + u.pn * 4 + wc, q, __ATOMIC_RELAXED, __HIP_MEMORY_SCOPE_AGENT); }
        asm volatile("s_waitcnt vmcnt(0)" ::: "memory");
        PG8_GAS unsigned* c = cnt + 64 * u.pm;
        if (ln == 0) (void)__hip_atomic_fetch_add(c, 1u, __ATOMIC_RELAXED, __HIP_MEMORY_SCOPE_AGENT);
        for (unsigned sp = 0; sp < (1u << 22); ++sp) { if ((unsigned)__builtin_amdgcn_readfirstlane((int)__hip_atomic_load(c, __ATOMIC_RELAXED, __HIP_MEMORY_SCOPE_AGENT)) >= 32u) break; __builtin_amdgcn_s_sleep(2); }
        int row1 = row0, colc = colb; asm volatile("" : "+v"(row1), "+v"(colc));
        float rs[2][4];
#pragma unroll
        for (int ai = 0; ai < 2; ++ai)
#pragma unroll
            for (int m = 0; m < 4; ++m) { const PG8_GAS float* sp4 = SS + (size_t)(row1 + ai * HALF + m * 16) * 16 + 4 * fq;
                float t = (__hip_atomic_load(sp4, __ATOMIC_RELAXED, __HIP_MEMORY_SCOPE_AGENT) + __hip_atomic_load(sp4 + 1, __ATOMIC_RELAXED, __HIP_MEMORY_SCOPE_AGENT))
                        + (__hip_atomic_load(sp4 + 2, __ATOMIC_RELAXED, __HIP_MEMORY_SCOPE_AGENT) + __hip_atomic_load(sp4 + 3, __ATOMIC_RELAXED, __HIP_MEMORY_SCOPE_AGENT));
                t += shx(t, 16, ln); t += shx(t, 32, ln); rs[ai][m] = rsqrtf(t * (1.0f / 1024.0f) + EPS_); }
#pragma unroll
        for (int bj = 0; bj < 2; ++bj) {
            const f32x4 g0 = *(const PG8_GAS f32x4*)(gfin + colc + bj * HALF), g1 = *(const PG8_GAS f32x4*)(gfin + colc + bj * HALF + 4);
#pragma unroll
            for (int ai = 0; ai < 2; ++ai)
#pragma unroll
                for (int m = 0; m < 4; ++m) { const size_t off = (size_t)(row1 + ai * HALF + m * 16) * 1024 + colc + bj * HALF;
                    *(PG8_GAS f32x4*)(OUT + off) = acc[ai][bj][m][0] * rs[ai][m] * g0; *(PG8_GAS f32x4*)(OUT + off + 4) = acc[ai][bj][m][1] * rs[ai][m] * g1; }
        }
    }
};

struct EpiUp {
    static constexpr bool PERM = true;
    static constexpr bool NEEDS_RSTD = true;
    const PG8_GAS float* SS; const PG8_GAS float* bias; PG8_GAS bf16_t* O; int ldc; PG8_LAS unsigned char* ldsb; int par;
    __device__ __forceinline__ void operator()(f32x4 (&acc)[2][2][4][2], const Unit& u, int wr, int wc, int fr, int fq) const {
        const int b = u.pm >> 5, colb = u.pn * BM + wc * 32 + 8 * fq, row0 = u.pm * BM + wr * 64 + fr;
        float rs[2][4];
#pragma unroll
        for (int ai = 0; ai < 2; ++ai)
#pragma unroll
            for (int m = 0; m < 4; ++m) rs[ai][m] = ((const PG8_LAS float*)(ldsb + RSTD_TAB_OFF + par * 1024))[wr * 64 + fr + ai * HALF + m * 16];
#pragma unroll
        for (int bj = 0; bj < 2; ++bj) {
            const f32x4 bv0 = *(const PG8_GAS f32x4*)(bias + (size_t)b * ldc + colb + bj * HALF), bv1 = *(const PG8_GAS f32x4*)(bias + (size_t)b * ldc + colb + bj * HALF + 4);
#pragma unroll
            for (int ai = 0; ai < 2; ++ai)
#pragma unroll
                for (int m = 0; m < 4; ++m) { f32x4 v0 = acc[ai][bj][m][0] * rs[ai][m] + bv0, v1 = acc[ai][bj][m][1] * rs[ai][m] + bv1;
#pragma unroll
                    for (int j = 0; j < 4; ++j) { v0[j] = fmaxf(v0[j], 0.f); v1[j] = fmaxf(v1[j], 0.f); }
                    v0 = v0 * v0; v1 = v1 * v1;
                    u32x4 w; w.x = cvt_pk_bf16(v0[0], v0[1]); w.y = cvt_pk_bf16(v0[2], v0[3]); w.z = cvt_pk_bf16(v1[0], v1[1]); w.w = cvt_pk_bf16(v1[2], v1[3]);
                    *(PG8_GAS u32x4*)(O + ((size_t)(u.pm * 16 + u.pn) * 256 + (wr * 64 + fr + ai * HALF + m * 16)) * 256 + (wc * 32 + 8 * fq + bj * HALF)) = w; }
        }
    }
};

struct EpiQKV {
    static constexpr bool PERM = true;
    static constexpr bool NEEDS_RSTD = true;
    const PG8_GAS float* SS; const PG8_GAS float* bias; PG8_GAS bf16_t* Q; size_t split_stride; PG8_GAS float* KMP; PG8_LAS unsigned char* ldsb; int par;
    __device__ __forceinline__ void operator()(f32x4 (&acc)[2][2][4][2], const Unit& u, int wr, int wc, int fr, int fq) const {
        const int b = u.pm >> 5, t = u.pn >> 2, colt = (u.pn & 3) * BM + wc * 32 + 8 * fq, colb = u.pn * BM + wc * 32 + 8 * fq, row0 = u.pm * BM + wr * 64 + fr;
        PG8_GAS bf16_t* base = Q + (size_t)t * split_stride; const float sc = (t == 0) ? C2_ : 1.0f;
        float rs[2][4];
#pragma unroll
        for (int ai = 0; ai < 2; ++ai)
#pragma unroll
            for (int m = 0; m < 4; ++m) rs[ai][m] = ((const PG8_LAS float*)(ldsb + RSTD_TAB_OFF + par * 1024))[wr * 64 + fr + ai * HALF + m * 16];
#pragma unroll
        for (int bj = 0; bj < 2; ++bj) {
            const f32x4 bv0 = *(const PG8_GAS f32x4*)(bias + (size_t)b * 3072 + colb + bj * HALF), bv1 = *(const PG8_GAS f32x4*)(bias + (size_t)b * 3072 + colb + bj * HALF + 4);
            f32x4 cs0 = {0.f, 0.f, 0.f, 0.f}, cs1 = cs0;
#pragma unroll
            for (int ai = 0; ai < 2; ++ai)
#pragma unroll
                for (int m = 0; m < 4; ++m) { f32x4 v0 = acc[ai][bj][m][0] * rs[ai][m] + bv0, v1 = acc[ai][bj][m][1] * rs[ai][m] + bv1;
                    cs0 += v0; cs1 += v1; v0 = v0 * sc; v1 = v1 * sc;
                    u32x4 w; w.x = cvt_pk_bf16(v0[0], v0[1]); w.y = cvt_pk_bf16(v0[2], v0[3]); w.z = cvt_pk_bf16(v1[0], v1[1]); w.w = cvt_pk_bf16(v1[2], v1[3]);
                    *(PG8_GAS u32x4*)(base + hm_off((size_t)(row0 + ai * HALF + m * 16), b, (colt + bj * HALF) >> 6) + ((colt + bj * HALF) & 63)) = w; }
            if (t == 1) {
#pragma unroll
                for (int o = 1; o < 16; o <<= 1) {
#pragma unroll
                    for (int j = 0; j < 4; ++j) { cs0[j] += shx(cs0[j], o, fq * 16 + fr); cs1[j] += shx(cs1[j], o, fq * 16 + fr); } }
                if (fr == 0) { PG8_GAS float* kp = KMP + ((size_t)u.pm * 2 + wr) * 1024 + colt + bj * HALF; *(f32x4*)kp = cs0; *(PG8_GAS f32x4*)(kp + 4) = cs1; }
            }
        }
    }
};

template <class Epi, class Sched, bool ALIGN_EPI>
__device__ __forceinline__ void gemm_phase(PG8_LAS unsigned char* lds, const Gemm g, const Sched& S, const Epi& E_, int wave_id) {
    Epi E = E_;
    int tid = wave_id * 64 + lane_id(); asm volatile("" : "+v"(tid));
    const int wid = __builtin_amdgcn_readfirstlane(tid >> 6), lane = tid & 63, wr = wid >> 2, wc = wid & 3, fr = lane & 15, fq = lane >> 4;
    const int K = g.K, nt = K / BK, lda = g.lda;
    unsigned voffA[2], voffB[2];
#pragma unroll
    for (int i = 0; i < 2; ++i) { int R, C; stage_rc(tid * 16 + i * 8192, R, C); const int Rb = Epi::PERM ? ((R & ~31) + perm32(R & 31)) : R;
        voffA[i] = (unsigned)(R * lda + C) * 2u; voffB[i] = (unsigned)(Rb * K + C) * 2u; }
    const size_t kstep = (size_t)(BK * 2);
    const size_t hstepA = (size_t)HALF * lda * 2, tstepA = (g.a_tileb == 512) ? 2 * hstepA : (size_t)(K / 256) * g.a_tileb, hstepB = (size_t)HALF * K * 2, tstepB = 2 * hstepB;
    const size_t tileb = (size_t)g.a_tileb;
#define PG8_KOFF(t) ((size_t)((t) >> 2) * tileb + (size_t)((t) & 3) * 128)
    const unsigned ldsw = (unsigned)wid * 1024u;
    const int aoff = lds_byte(wr * 64 + fr, fq * 8), boff = lds_byte(wc * 32 + fr, fq * 8);
#define PG8_SA(b, h) (((b) * 2 + (h)) * HTB)
#define PG8_SB(b, h) ((4 + (b) * 2 + (h)) * HTB)
#define PG8_STAGE(bufoff, gbase, voff) do { _Pragma("unroll") for (int _i = 0; _i < 2; ++_i) \
        __builtin_amdgcn_global_load_lds((const PG8_GAS unsigned*)((const PG8_GAS char*)(gbase) + (voff)[_i]), (PG8_LAS unsigned*)(lds + (bufoff) + ldsw + _i * 8192), 16, 0, 0); } while (0)
#define PG8_LDA(dst, b, h) do { _Pragma("unroll") for (int m = 0; m < 4; ++m) _Pragma("unroll") for (int k = 0; k < 2; ++k) dst[m][k] = *(const PG8_LAS bf16x8*)(lds + PG8_SA(b, h) + aoff + m * 2048 + k * 1024); } while (0)
#define PG8_LDB(dst, b, h) do { _Pragma("unroll") for (int n = 0; n < 2; ++n) _Pragma("unroll") for (int k = 0; k < 2; ++k) dst[n][k] = *(const PG8_LAS bf16x8*)(lds + PG8_SB(b, h) + boff + n * 2048 + k * 1024); } while (0)
#define PG8_MMA(ai, bj, At, Bt) do { __builtin_amdgcn_s_setprio(1); _Pragma("unroll") for (int m = 0; m < 4; ++m) _Pragma("unroll") for (int n = 0; n < 2; ++n) _Pragma("unroll") for (int k = 0; k < 2; ++k) \
        acc[ai][bj][m][n] = __builtin_amdgcn_mfma_f32_16x16x32_bf16(Bt[n][k], At[m][k], acc[ai][bj][m][n], 0, 0, 0); __builtin_amdgcn_s_setprio(0); } while (0)
#define PG8_WAIT_V(n) asm volatile("s_waitcnt vmcnt(" #n ")" ::: "memory")
#define PG8_WAIT_L(n) asm volatile("s_waitcnt lgkmcnt(" #n ")" ::: "memory")
#define PG8_BAR __builtin_amdgcn_s_barrier()
#define PG8_SCHED __builtin_amdgcn_sched_barrier(0)
    Unit cur, nxt; int ui = 0;
    if (!S.next(0, cur)) return;
    int rpar = 0;
    if constexpr (Epi::NEEDS_RSTD) { fill_rstd_tab(lds, 0, E.SS, cur.pm, wid, lane); E.par = 0; }
    f32x4 acc[2][2][4][2];
#pragma unroll
    for (int a = 0; a < 2; ++a)
#pragma unroll
        for (int b = 0; b < 2; ++b)
#pragma unroll
            for (int m = 0; m < 4; ++m)
#pragma unroll
                for (int n = 0; n < 2; ++n) acc[a][b][m][n] = (f32x4){0.f, 0.f, 0.f, 0.f};
    bf16x8 At[4][2], B0[2][2], B1[2][2];
    const PG8_GAS char* cA = (const PG8_GAS char*)g.A + (size_t)cur.pm * tstepA + (size_t)cur.pn * g.a_pn_off * 2; const PG8_GAS char* cB = (const PG8_GAS char*)g.Bt + (size_t)cur.pn * tstepB;
    PG8_STAGE(PG8_SB(0, 0), cB, voffB); PG8_STAGE(PG8_SB(0, 1), cB + hstepB, voffB); PG8_STAGE(PG8_SA(0, 0), cA, voffA); PG8_STAGE(PG8_SA(0, 1), cA + hstepA, voffA);
    if (wr == 1) PG8_BAR;
    PG8_WAIT_V(2); PG8_BAR;
    PG8_STAGE(PG8_SB(1, 0), cB + kstep, voffB); PG8_STAGE(PG8_SA(1, 0), cA + kstep, voffA); PG8_STAGE(PG8_SB(1, 1), cB + hstepB + kstep, voffB);
    PG8_WAIT_V(6); PG8_BAR;
    for (;;) {
        const bool has_next = S.next(ui + 1, nxt);
        const PG8_GAS char* nA = has_next ? (const PG8_GAS char*)g.A + (size_t)nxt.pm * tstepA + (size_t)nxt.pn * g.a_pn_off * 2 : cA; const PG8_GAS char* nB = has_next ? (const PG8_GAS char*)g.Bt + (size_t)nxt.pn * tstepB : cB;
        for (int t = 0; t < nt; t += 2) {
            const bool last = (t == nt - 2);
            const PG8_GAS char* a1 = cA + PG8_KOFF(t + 1);
            const PG8_GAS char* a2 = last ? nA : cA + PG8_KOFF(t + 2); const PG8_GAS char* b2 = last ? nB : cB + (size_t)(t + 2) * kstep;
            const PG8_GAS char* a3 = a2 + kstep; const PG8_GAS char* b3 = b2 + kstep;
            PG8_LDB(B0, 0, 0); PG8_LDB(B1, 0, 1); PG8_SCHED; PG8_LDA(At, 0, 0); PG8_STAGE(PG8_SA(1, 1), a1 + hstepA, voffA);
            PG8_WAIT_V(8); PG8_WAIT_L(0); PG8_BAR; PG8_MMA(0, 0, At, B0); PG8_MMA(0, 1, At, B1); PG8_BAR; PG8_SCHED;
            PG8_LDA(At, 0, 1); PG8_STAGE(PG8_SB(0, 0), b2, voffB); PG8_STAGE(PG8_SB(0, 1), b2 + hstepB, voffB); PG8_STAGE(PG8_SA(0, 0), a2, voffA);
            PG8_WAIT_V(8); PG8_WAIT_L(0); PG8_BAR; PG8_MMA(1, 0, At, B0); PG8_MMA(1, 1, At, B1); PG8_BAR; PG8_SCHED;
            PG8_LDB(B0, 1, 0); PG8_LDB(B1, 1, 1); PG8_SCHED; PG8_LDA(At, 1, 0); PG8_STAGE(PG8_SA(0, 1), a2 + hstepA, voffA);
            PG8_WAIT_V(8); PG8_WAIT_L(0); PG8_BAR; PG8_MMA(0, 0, At, B0); PG8_MMA(0, 1, At, B1); PG8_BAR; PG8_SCHED;
            PG8_LDA(At, 1, 1); PG8_STAGE(PG8_SB(1, 0), b3, voffB); PG8_STAGE(PG8_SB(1, 1), b3 + hstepB, voffB); PG8_STAGE(PG8_SA(1, 0), a3, voffA);
            PG8_WAIT_V(8); PG8_WAIT_L(0); PG8_BAR; PG8_MMA(1, 0, At, B0); PG8_MMA(1, 1, At, B1); PG8_BAR; PG8_SCHED;
        }
        if constexpr (ALIGN_EPI) { if (wr == 0) PG8_BAR; }
        if constexpr (Epi::NEEDS_RSTD) E.par = rpar;
        E(acc, cur, wr, wc, fr, fq);
        if constexpr (Epi::NEEDS_RSTD) { if (has_next && nxt.pm != cur.pm) { rpar ^= 1; fill_rstd_tab(lds, rpar, E.SS, nxt.pm, wid, lane); } }
        if (!has_next) break;
#pragma unroll
        for (int a = 0; a < 2; ++a)
#pragma unroll
            for (int b = 0; b < 2; ++b)
#pragma unroll
                for (int m = 0; m < 4; ++m)
#pragma unroll
                    for (int n = 0; n < 2; ++n) acc[a][b][m][n] = (f32x4){0.f, 0.f, 0.f, 0.f};
        cur = nxt; cA = nA; cB = nB; ++ui;
        if constexpr (ALIGN_EPI) { if (wr == 1) PG8_BAR; }
    }
    PG8_WAIT_V(0);
    if constexpr (!ALIGN_EPI) { if (wr == 0) PG8_BAR; }
    PG8_BAR;
#undef PG8_KOFF
#undef PG8_SA
#undef PG8_SB
#undef PG8_STAGE
#undef PG8_LDA
#undef PG8_LDB
#undef PG8_MMA
#undef PG8_WAIT_V
#undef PG8_WAIT_L
#undef PG8_BAR
#undef PG8_SCHED
}
}

constexpr int NWAVES = 8;
constexpr int BATCH = 4, SEQ = 8192, D = 1024, NH = 16, HD = 64, FF = 4096, M = BATCH * SEQ, NQKV = 3 * D, NBLK = 32, BLK = 256;
constexpr float EPS = 1e-6f;
constexpr float LOG2E = 1.4426950408889634f;

constexpr size_t MiB = 1u << 20;
constexpr size_t WS_CTL = 0, CTL_ZERO_BYTES = 1 * MiB;
constexpr size_t WS_MOD = 1 * MiB;
constexpr size_t WS_BIAS_UP0 = WS_MOD + 256 * 1024;
constexpr size_t WS_BIAS_QKV = WS_BIAS_UP0 + 64 * 1024;
constexpr size_t WS_BIAS_UP1 = WS_BIAS_QKV + 64 * 1024;
constexpr size_t WS_KMP = 2 * MiB;
constexpr size_t WS_SS = 3 * MiB;
constexpr size_t WS_WPOOL = 6 * MiB, WS_WQKV = 8 * MiB, WS_WO = 14 * MiB, WS_WUP0 = 16 * MiB, WS_WUP1 = 24 * MiB, WS_WDN0 = 32 * MiB, WS_WDN1 = 40 * MiB;
constexpr size_t WS_XNA = 48 * MiB, WS_XNB = 112 * MiB;
constexpr size_t WS_HB = 176 * MiB;
constexpr size_t WS_Q = 176 * MiB, WS_K = 240 * MiB, WS_V = 304 * MiB;
constexpr size_t WS_PL = 496 * MiB;
constexpr size_t WS_CNT = 503 * MiB;
constexpr size_t WS_KBM = 503 * MiB + 512 * 1024;
constexpr size_t WS_POB = 48 * MiB;
constexpr size_t WS_SEG = 368 * MiB;
constexpr size_t WS_XR = 432 * MiB;
constexpr size_t WS_O = 368 * MiB;
constexpr size_t WS_DUMP = 504 * MiB;
constexpr size_t WS_END = 506 * MiB;
constexpr int CW_BAR = 4096;
constexpr int CW_FIN = 24576;
constexpr int CW_TOT = 16384;

constexpr int RING_OFF = 0, RING_BYTES = 131072;
constexpr int LDSCTL_OFF = RING_BYTES, MISC_OFF = LDSCTL_OFF + 320;
constexpr int LDS_BYTES = 151552;

#define GAS __attribute__((address_space(1)))
#define LAS __attribute__((address_space(3)))
typedef unsigned short bf16;
typedef unsigned v4u __attribute__((ext_vector_type(4)));
typedef unsigned v2u __attribute__((ext_vector_type(2)));
typedef float f32x4 __attribute__((ext_vector_type(4)));
typedef GAS unsigned gu32;
#define RLX_AGENT __ATOMIC_RELAXED, __HIP_MEMORY_SCOPE_AGENT
#define LDS_WAIT() asm volatile("s_waitcnt lgkmcnt(0)" ::: "memory")
__device__ __forceinline__ unsigned f2bf(float f) { unsigned u = __builtin_bit_cast(unsigned, f); return (u + 0x7fffu + ((u >> 16) & 1u)) >> 16; }
__device__ __forceinline__ unsigned pk2(float lo, float hi) { return f2bf(lo) | (f2bf(hi) << 16); }
__device__ __forceinline__ float bf2f(unsigned short v) { return __builtin_bit_cast(float, (unsigned)v << 16); }

#define XB_TMO      128
#define XB_XCNT(j)  (256  + 64 * (j))
#define XB_XSUB(j)  (1280 + 64 * (j))
#define XB_XGEN(j)  (2304 + 64 * (j))
#define XB_TOP      3328
#define XB_TOPGEN   3392
#define XCD_BAR_WORDS 3456
#define XB_SPIN_CAP (1u << 18)
__device__ __forceinline__ unsigned xb_ld(GAS unsigned* p)              { return __hip_atomic_load(p, __ATOMIC_RELAXED, __HIP_MEMORY_SCOPE_AGENT); }
__device__ __forceinline__ unsigned xb_add(GAS unsigned* p, unsigned v) { return __hip_atomic_fetch_add(p, v, __ATOMIC_RELAXED, __HIP_MEMORY_SCOPE_AGENT); }
__device__ __forceinline__ unsigned xb_xcc_id() { return (unsigned)__builtin_amdgcn_s_getreg((3 << 11) | 20) & 0xFu; }
#define XB_SPIN(cond, bar) do { unsigned _sp = 0; while (cond) { __builtin_amdgcn_s_sleep(1); \
    if ((++_sp & 255u) == 0u) { if (xb_ld(&(bar)[XB_TMO])) break; if (_sp > XB_SPIN_CAP) { (void)xb_add(&(bar)[XB_TMO], 1u); break; } } } } while (0)
struct XcdBarrier { GAS unsigned* bar; unsigned x; volatile LAS unsigned* st; int wave; };
__device__ __forceinline__ XcdBarrier xcd_barrier_post(GAS unsigned* bar, volatile LAS unsigned* st) {
    XcdBarrier b; b.bar = bar; b.x = xb_xcc_id(); b.st = st;
    if (threadIdx.x == 0) (void)xb_add(&bar[XB_XCNT(b.x)], 1u);
    return b;
}
__device__ __forceinline__ void xcd_barrier_complete(GAS unsigned* bar, unsigned x, unsigned& nloc, unsigned& nx) {
    const unsigned G = gridDim.x * gridDim.y * gridDim.z;
    unsigned sum, cnt, mine, sp = 0u;
    for (;;) {
        sum = 0u; cnt = 0u; mine = 0u;
#pragma unroll
        for (unsigned j = 0; j < 16; ++j) { const unsigned c = xb_ld(&bar[XB_XCNT(j)]); sum += c; cnt += (c > 0u) ? 1u : 0u; mine = (j == x) ? c : mine; }
        if (sum == G) break;
        __builtin_amdgcn_s_sleep(1);
        if ((++sp & 255u) == 0u) { if (xb_ld(&bar[XB_TMO])) break; if (sp > XB_SPIN_CAP) { (void)xb_add(&bar[XB_TMO], 1u); break; } }
    }
    nloc = mine > 0u ? mine : 1u; nx = cnt > 0u ? cnt : 1u;
}
__device__ __forceinline__ void xcd_barrier(const XcdBarrier& b) {
    asm volatile("s_waitcnt vmcnt(0)" ::: "memory");
    __syncthreads();
    if (b.wave == 0 && lane_id() == 0) {
        GAS unsigned* bar = b.bar; asm volatile("" : "+s"(bar));
        const unsigned bx = xb_xcc_id();
        __builtin_amdgcn_s_waitcnt(0);
        unsigned nloc = b.st[0], nx = b.st[1];
        if (nloc == 0u) { xcd_barrier_complete(bar, bx, nloc, nx); b.st[0] = nloc; b.st[1] = nx; }
        const unsigned old = xb_add(&bar[XB_XSUB(bx)], 1u);
        const unsigned gen = old / nloc;
        if (old + 1u == (gen + 1u) * nloc) {
            __builtin_amdgcn_fence(__ATOMIC_RELEASE, "agent");
            asm volatile("s_waitcnt vmcnt(0)" ::: "memory");
            const unsigned og = xb_add(&bar[XB_TOP], 1u);
            const unsigned tg = og / nx;
            if (og + 1u == (tg + 1u) * nx) xb_add(&bar[XB_TOPGEN], 1u);
            else XB_SPIN(xb_ld(&bar[XB_TOPGEN]) == tg, bar);
            __builtin_amdgcn_fence(__ATOMIC_ACQUIRE, "agent");
            xb_add(&bar[XB_XGEN(bx)], 1u);
            asm volatile("s_waitcnt vmcnt(0)" ::: "memory");
        } else {
            XB_SPIN(xb_ld(&bar[XB_XGEN(bx)]) == gen, bar);
            __builtin_amdgcn_fence(__ATOMIC_ACQUIRE, "agent");
            asm volatile("s_waitcnt vmcnt(0)" ::: "memory");
        }
    }
    __syncthreads();
}

struct Args { const GAS float* in[14]; GAS float* out; GAS unsigned char* ws; };
struct Frame {
    LAS unsigned char* lds; int tid, lane, wave, vcu, G;
    const GAS float *x, *c, *rel_bias, *w_mod, *b_mod, *norm_mix, *norm_mlp, *w_pool, *pool_scale, *w_qkv, *w_o, *w_up, *w_down, *norm_final;
    GAS float* out; GAS unsigned char* ws;
};
__device__ __forceinline__ float wave_sum(float v) {
#pragma unroll
    for (int o = 1; o < 64; o <<= 1) v += __shfl_xor(v, o);
    return v;
}

struct TItem { const GAS float* W; GAS bf16* WT; int K, N, row_off, item; };
__device__ __forceinline__ void tload(const TItem& I, f32x4 (&t)[8], int lane) {
    const int nblk = I.N / 32, kb = I.item / nblk, nb = I.item % nblk, k0 = 64 * kb, n0 = 32 * nb;
#pragma unroll
    for (int i = 0; i < 8; ++i) t[i] = *(const GAS f32x4*)(I.W + (size_t)(k0 + 8 * i + (lane >> 3)) * I.N + n0 + 4 * (lane & 7));
}
__device__ __forceinline__ void tstore(const TItem& I, const f32x4 (&t)[8], LAS float* scr, int lane) {
    const int nblk = I.N / 32, kb = I.item / nblk, nb = I.item % nblk, k0 = 64 * kb, n0 = 32 * nb;
#pragma unroll
    for (int i = 0; i < 8; ++i) { LAS float* d = scr + (8 * i + (lane >> 3)) * 33 + 4 * (lane & 7); d[0] = t[i][0]; d[1] = t[i][1]; d[2] = t[i][2]; d[3] = t[i][3]; }
    LDS_WAIT(); asm volatile("" ::: "memory");
    const int c = lane & 7;
#pragma unroll
    for (int j = 0; j < 4; ++j) { const int n = (lane >> 3) + 8 * j; const LAS float* s = scr + (8 * c) * 33 + n;
        v4u o; o.x = pk2(s[0 * 33], s[1 * 33]); o.y = pk2(s[2 * 33], s[3 * 33]); o.z = pk2(s[4 * 33], s[5 * 33]); o.w = pk2(s[6 * 33], s[7 * 33]);
        *(GAS v4u*)(I.WT + (size_t)(I.row_off + n0 + n) * I.K + k0 + 8 * c) = o; }
    LDS_WAIT(); asm volatile("" ::: "memory");
}
__device__ __forceinline__ void p0_prologue(Frame& F) {
    if (F.vcu < 192) {
        LAS float* cact = (LAS float*)(F.lds + 67584);
        LAS float* red = (LAS float*)(F.lds + 67584 + 16384);
        const int l = F.vcu / 96, j0 = (F.vcu % 96) * 64;
        for (int i = F.tid; i < 4096; i += NWAVES * 64) { const float v = F.c[i]; cact[i] = v / (1.f + __expf(-v)); }
        __syncthreads();
        const int sub = F.lane >> 4, c4 = F.lane & 15;
        f32x4 a0 = {0.f, 0.f, 0.f, 0.f}, a1 = a0, a2 = a0, a3 = a0;
        const GAS float* wb = F.w_mod + (size_t)l * 1024 * 6144 + j0 + 4 * c4;
#pragma unroll 4
        for (int it = 0; it < 32; ++it) { const int k = 32 * it + 4 * F.wave + sub; const f32x4 wv = *(const GAS f32x4*)(wb + (size_t)k * 6144);
            a0 += wv * cact[k]; a1 += wv * cact[1024 + k]; a2 += wv * cact[2048 + k]; a3 += wv * cact[3072 + k]; }
#pragma unroll
        for (int j = 0; j < 4; ++j) { a0[j] += __shfl_xor(a0[j], 16); a0[j] += __shfl_xor(a0[j], 32); a1[j] += __shfl_xor(a1[j], 16); a1[j] += __shfl_xor(a1[j], 32);
            a2[j] += __shfl_xor(a2[j], 16); a2[j] += __shfl_xor(a2[j], 32); a3[j] += __shfl_xor(a3[j], 16); a3[j] += __shfl_xor(a3[j], 32); }
        if (sub == 0) { LAS f32x4* r4 = (LAS f32x4*)(red + F.wave * 256); r4[0 * 16 + c4] = a0; r4[1 * 16 + c4] = a1; r4[2 * 16 + c4] = a2; r4[3 * 16 + c4] = a3; }
        __syncthreads();
        if (F.tid < 256) { const int b = F.tid >> 6, col = F.tid & 63; float s = 0.f;
#pragma unroll
            for (int w = 0; w < 8; ++w) s += red[w * 256 + b * 64 + col];
            ((GAS float*)(F.ws + WS_MOD))[(l * 4 + b) * 6144 + j0 + col] = s + F.b_mod[l * 6144 + j0 + col]; }
    }
    LAS float* scr = (LAS float*)(F.lds + RING_OFF + F.wave * 8448);
    const int gw = F.vcu * NWAVES + F.wave, NGW = F.G * NWAVES;
    constexpr int I_POOL = 4 * 32, I_QKV = 16 * 96, I_O = 16 * 32, I_UP = 16 * 128, I_DN = 64 * 32;
    constexpr int NITEMS = I_POOL + I_QKV + I_O + 2 * I_UP + 2 * I_DN;
    auto desc = [&](int it) -> TItem {
        int r = it;
        if (r < I_POOL) { const int g = r / 32; return TItem{F.w_pool + (size_t)g * 65536, (GAS bf16*)(F.ws + WS_WPOOL), 256, 256, g * 256, r % 32}; } r -= I_POOL;
        if (r < I_QKV) return TItem{F.w_qkv, (GAS bf16*)(F.ws + WS_WQKV), D, NQKV, 0, r}; r -= I_QKV;
        if (r < I_O) return TItem{F.w_o, (GAS bf16*)(F.ws + WS_WO), D, D, 0, r}; r -= I_O;
        if (r < 2 * I_UP) { const int l = r / I_UP; return TItem{F.w_up + (size_t)l * D * FF, (GAS bf16*)(F.ws + (l ? WS_WUP1 : WS_WUP0)), D, FF, 0, r % I_UP}; } r -= 2 * I_UP;
        const int l = r / I_DN; return TItem{F.w_down + (size_t)l * FF * D, (GAS bf16*)(F.ws + (l ? WS_WDN1 : WS_WDN0)), FF, D, 0, r % I_DN};
    };
    f32x4 ta[8], tb[8];
    int it = gw;
    if (it < NITEMS) { TItem cur = desc(it); tload(cur, ta, F.lane);
        for (;;) {
            const int itn = it + NGW; const bool hn = itn < NITEMS; TItem nxt = cur;
            if (hn) { nxt = desc(itn); tload(nxt, tb, F.lane); }
            tstore(cur, ta, scr, F.lane);
            if (!hn) break;
#pragma unroll
            for (int i = 0; i < 8; ++i) ta[i] = tb[i];
            cur = nxt; it = itn;
        } }
}

__device__ __forceinline__ void p1_bias(Frame& F) {
    const int gw = F.vcu * NWAVES + F.wave, NGW = F.G * NWAVES;
    const GAS float* MOD = (const GAS float*)(F.ws + WS_MOD);
    for (int it = gw; it < 4096 + 3072 + 4096; it += NGW) {
        const GAS bf16* wt; const GAS float* sh; GAS float* dst; int n, N;
        if (it < 4096) { n = it; N = 4096; wt = (const GAS bf16*)(F.ws + WS_WUP0); sh = MOD + 3072; dst = (GAS float*)(F.ws + WS_BIAS_UP0); }
        else if (it < 4096 + 3072) { n = it - 4096; N = 3072; wt = (const GAS bf16*)(F.ws + WS_WQKV); sh = MOD + 4 * 6144; dst = (GAS float*)(F.ws + WS_BIAS_QKV); }
        else { n = it - 7168; N = 4096; wt = (const GAS bf16*)(F.ws + WS_WUP1); sh = MOD + 4 * 6144 + 3072; dst = (GAS float*)(F.ws + WS_BIAS_UP1); }
        const v4u w0 = *(const GAS v4u*)(wt + (size_t)n * 1024 + F.lane * 16), w1 = *(const GAS v4u*)(wt + (size_t)n * 1024 + F.lane * 16 + 8);
        float wf[16];
#pragma unroll
        for (int j = 0; j < 4; ++j) { wf[2 * j] = __builtin_bit_cast(float, w0[j] << 16); wf[2 * j + 1] = __builtin_bit_cast(float, w0[j] & 0xffff0000u);
            wf[8 + 2 * j] = __builtin_bit_cast(float, w1[j] << 16); wf[8 + 2 * j + 1] = __builtin_bit_cast(float, w1[j] & 0xffff0000u); }
#pragma unroll
        for (int b = 0; b < 4; ++b) { const GAS f32x4* sp = (const GAS f32x4*)(sh + b * 6144 + F.lane * 16); float s = 0.f;
#pragma unroll
            for (int j = 0; j < 4; ++j) { const f32x4 sv = sp[j]; s += wf[4 * j] * sv[0] + wf[4 * j + 1] * sv[1] + wf[4 * j + 2] * sv[2] + wf[4 * j + 3] * sv[3]; }
            s = wave_sum(s); if (F.lane == 0) dst[b * N + n] = s; }
    }
}
__device__ __forceinline__ void p1_pool(Frame& F) {
    LAS float* ring = (LAS float*)(F.lds + RING_OFF);
    const GAS float* MOD = (const GAS float*)(F.ws + WS_MOD); GAS bf16* XN = (GAS bf16*)(F.ws + WS_XNA); GAS bf16* XR = (GAS bf16*)(F.ws + WS_XR);
    for (int run = F.vcu; run < M / 128; run += F.G) {
        const int t0 = run * 128, s0 = t0 % SEQ, b = t0 / SEQ;
        f32x4 gam[4];
#pragma unroll
        for (int j = 0; j < 4; ++j) gam[j] = *(const GAS f32x4*)(F.norm_mix + 4 * (F.lane + 64 * j));
        const int c4 = F.tid & 255, rh = F.tid >> 8, gi = c4 >> 6, w = 2 << gi;
        const f32x4 sc1 = *(const GAS f32x4*)(MOD + b * 6144 + 1024 + 4 * c4) + 1.0f;
        f32x4 v[2][4];
        const GAS float* xb = F.x + (size_t)b * SEQ * D + 4 * F.lane;
        int st = (s0 > 0 ? -1 : 0);
#pragma unroll
        for (int rr = 0; rr < 2; ++rr)
#pragma unroll
            for (int j = 0; j < 4; ++j) v[rr][j] = *(const GAS f32x4*)(xb + (size_t)(s0 + 16 * st + 2 * F.wave + rr) * D + 256 * j);
        for (; st < 8; ++st) {
            if (st >= 0) {
#pragma unroll
                for (int rr = 0; rr < 2; ++rr)
#pragma unroll
                    for (int j = 0; j < 4; ++j) { v2u o2; o2.x = pk2(v[rr][j][0], v[rr][j][1]); o2.y = pk2(v[rr][j][2], v[rr][j][3]);
                        { const size_t trow = (size_t)b * SEQ + s0 + 16 * st + 2 * F.wave + rr; *(GAS v2u*)(XR + (((trow >> 8) * 4 + j) * 256 + (trow & 255)) * 256 + 4 * F.lane) = o2; } } }
            float ss0 = 0.f, ss1 = 0.f;
#pragma unroll
            for (int j = 0; j < 4; ++j) { ss0 += (v[0][j][0] * v[0][j][0] + v[0][j][1] * v[0][j][1]) + (v[0][j][2] * v[0][j][2] + v[0][j][3] * v[0][j][3]);
                ss1 += (v[1][j][0] * v[1][j][0] + v[1][j][1] * v[1][j][1]) + (v[1][j][2] * v[1][j][2] + v[1][j][3] * v[1][j][3]); }
#pragma unroll
            for (int o = 1; o < 64; o <<= 1) { ss0 += __shfl_xor(ss0, o); ss1 += __shfl_xor(ss1, o); }
            const float rs0 = rsqrtf(ss0 * (1.0f / D) + EPS), rs1 = rsqrtf(ss1 * (1.0f / D) + EPS);
            { const int sr = s0 + 16 * st + 2 * F.wave;
#pragma unroll
              for (int j = 0; j < 4; ++j) { *(LAS f32x4*)(ring + (sr & 31) * 1024 + 4 * (F.lane + 64 * j)) = v[0][j] * rs0 * gam[j]; *(LAS f32x4*)(ring + ((sr + 1) & 31) * 1024 + 4 * (F.lane + 64 * j)) = v[1][j] * rs1 * gam[j]; } }
            if (st + 1 < 8) {
#pragma unroll
                for (int rr = 0; rr < 2; ++rr)
#pragma unroll
                    for (int j = 0; j < 4; ++j) v[rr][j] = *(const GAS f32x4*)(xb + (size_t)(s0 + 16 * (st + 1) + 2 * F.wave + rr) * D + 256 * j); }
            __syncthreads();
            if (st >= 0) {
                const int sA = s0 + 16 * st + 8 * rh;
                f32x4 sum = {0.f, 0.f, 0.f, 0.f};
                { const int cnt0 = (sA < w) ? sA : w; for (int i = 1; i <= cnt0; ++i) sum += *(const LAS f32x4*)(ring + ((sA - i) & 31) * 1024 + 4 * c4); }
#pragma unroll
                for (int r = 0; r < 8; ++r) { const int s = sA + r; const f32x4 cur = *(const LAS f32x4*)(ring + (s & 31) * 1024 + 4 * c4);
                    sum += cur; if (s >= w) sum -= *(const LAS f32x4*)(ring + ((s - w) & 31) * 1024 + 4 * c4);
                    const float inv = 1.0f / (float)((s + 1 < w) ? s + 1 : w);
                    const f32x4 p = (sum * inv - cur) * sc1;
                    v2u o; o.x = pk2(p[0], p[1]); o.y = pk2(p[2], p[3]);
                    *(GAS v2u*)(XN + ((size_t)b * SEQ + s) * D + 4 * c4) = o; }
            }
            __syncthreads();
        }
    }
}

__device__ __forceinline__ int t5_bucket(int dist) {
    if (dist < 16) return dist;
    int b = 16;
    b += (dist >= 21); b += (dist >= 27); b += (dist >= 35); b += (dist >= 46); b += (dist >= 59); b += (dist >= 77); b += (dist >= 99); b += (dist >= 128);
    b += (dist >= 166); b += (dist >= 216); b += (dist >= 280); b += (dist >= 363); b += (dist >= 470); b += (dist >= 609); b += (dist >= 790);
    return b;
}
namespace att {
typedef short bf16x8 __attribute__((ext_vector_type(8)));
typedef short s16x4 __attribute__((ext_vector_type(4)));
typedef short v4i16_t __attribute__((ext_vector_type(4)));
typedef float f32x16 __attribute__((ext_vector_type(16)));
typedef float f32x2_t __attribute__((ext_vector_type(2)));
typedef __bf16 bf16x2_t __attribute__((ext_vector_type(2)));
typedef LAS const char* lds_cptr;
constexpr int L_K = 0, L_V = 32768, L_LUT = 132096, L_QI = 141312, L_CUM = 142336, L_PRE = 142592;
constexpr int LUTN = 2304;
__device__ __forceinline__ int crow(int r, int hi) { return (r & 3) + 8 * (r >> 2) + 4 * hi; }
__device__ __forceinline__ unsigned cvtpk(float lo, float hi) { f32x2_t v = {lo, hi}; bf16x2_t b = __builtin_convertvector(v, bf16x2_t); return __builtin_bit_cast(unsigned, b); }
__device__ __forceinline__ s16x4 vtr(lds_cptr p) { return __builtin_bit_cast(s16x4, __builtin_amdgcn_ds_read_tr16_b64_v4i16((LAS v4i16_t*)p)); }
__device__ __forceinline__ float swap_add(float v) { auto rr = __builtin_amdgcn_permlane32_swap(__float_as_uint(v), __float_as_uint(v), false, false); return __uint_as_float(rr[0]) + __uint_as_float(rr[1]); }

__device__ __forceinline__ void load_kv(LAS unsigned char* lds, const GAS bf16* Kb, const GAS bf16* Vb, int b, int h, int n, int w, int lane) {
#pragma unroll
    for (int t = 0; t < 4; ++t) {
        const size_t kr = (size_t)b * SEQ + n * BLK + 64 * t + lane, vr = (size_t)b * SEQ + n * BLK + 64 * t + 16 * (w & 3) + (lane >> 2);
        const v4u kv = *(const GAS v4u*)(Kb + hm_off(kr, b, h) + w * 8);
        const v4u vv = *(const GAS v4u*)(Vb + hm_off(vr, b, h) + (w >> 2) * 32 + (lane & 3) * 8);
        *(LAS v4u*)(lds + L_K + t * 8192 + w * 1024 + lane * 16) = kv;
        *(LAS v4u*)(lds + L_V + t * 8192 + w * 1024 + lane * 16) = vv;
    }
}
__device__ __forceinline__ void build_lut(LAS unsigned char* lds, const GAS float* rel_bias, int h, int tid) {
    for (int i = tid; i < LUTN; i += NWAVES * 64) ((LAS float*)(lds + L_LUT))[i] = (i <= 2047) ? rel_bias[t5_bucket(2047 - i) * NH + h] * LOG2E : 0.f;
}
__device__ __forceinline__ void qk_tile(f32x16& p0, f32x16& p1, lds_cptr Kt, const bf16x8* qr, const f32x16& cinit, int r32, int hi) {
    const unsigned kb0 = (unsigned)(r32 * 128 + ((hi ^ ((r32 >> 1) & 7)) * 16));
#pragma unroll
    for (int d0 = 0; d0 < 4; ++d0) {
        const bf16x8 b0 = *(LAS const bf16x8*)(Kt + (kb0 ^ (unsigned)(d0 * 32))), b1 = *(LAS const bf16x8*)(Kt + (kb0 ^ (unsigned)(d0 * 32)) + 4096);
        if (d0 == 0) { p0 = __builtin_amdgcn_mfma_f32_32x32x16_bf16(b0, qr[0], cinit, 0, 0, 0); p1 = __builtin_amdgcn_mfma_f32_32x32x16_bf16(b1, qr[0], cinit, 0, 0, 0); }
        else { p0 = __builtin_amdgcn_mfma_f32_32x32x16_bf16(b0, qr[d0], p0, 0, 0, 0); p1 = __builtin_amdgcn_mfma_f32_32x32x16_bf16(b1, qr[d0], p1, 0, 0, 0); }
    }
}
template <bool BIAS, bool MASK>
__device__ __forceinline__ void softmax_tile(f32x16& p0, f32x16& p1, LAS const float* lutp, int jt, int qrel, int hi, float& l, v4u* pa) {
#pragma unroll
    for (int r = 0; r < 16; ++r) { const int ko = 64 * jt + (r & 3) + 8 * (r >> 2);
        if (BIAS) { p0[r] += lutp[ko]; p1[r] += lutp[ko + 32]; }
        if (MASK) { const int kv = ko + 4 * hi; if (kv > qrel) p0[r] = -INFINITY; if (kv + 32 > qrel) p1[r] = -INFINITY; }
        p0[r] = __builtin_amdgcn_exp2f(p0[r]); p1[r] = __builtin_amdgcn_exp2f(p1[r]); }
    float s = 0.f;
#pragma unroll
    for (int r = 0; r < 16; ++r) s += p0[r] + p1[r];
    l += s;
    pa[0] = (v4u){cvtpk(p0[0], p0[1]), cvtpk(p0[2], p0[3]), cvtpk(p0[4], p0[5]), cvtpk(p0[6], p0[7])};
    pa[1] = (v4u){cvtpk(p0[8], p0[9]), cvtpk(p0[10], p0[11]), cvtpk(p0[12], p0[13]), cvtpk(p0[14], p0[15])};
    pa[2] = (v4u){cvtpk(p1[0], p1[1]), cvtpk(p1[2], p1[3]), cvtpk(p1[4], p1[5]), cvtpk(p1[6], p1[7])};
    pa[3] = (v4u){cvtpk(p1[8], p1[9]), cvtpk(p1[10], p1[11]), cvtpk(p1[12], p1[13]), cvtpk(p1[14], p1[15])};
}
__device__ __forceinline__ void pv_tile(f32x16* o, lds_cptr Vt, unsigned vo0, const v4u* pa) {
#pragma unroll
    for (int d0 = 0; d0 < 2; ++d0)
#pragma unroll
        for (int ks = 0; ks < 4; ++ks) { const s16x4 lo = vtr(Vt + (vo0 ^ (unsigned)(d0 * 64)) + ks * 2048), hi = vtr(Vt + (vo0 ^ (unsigned)(d0 * 64)) + ks * 2048 + 1024);
            const bf16x8 vf = (bf16x8){lo[0], lo[1], lo[2], lo[3], hi[0], hi[1], hi[2], hi[3]};
            o[d0] = __builtin_amdgcn_mfma_f32_32x32x16_bf16(vf, __builtin_bit_cast(bf16x8, pa[ks]), o[d0], 0, 0, 0); }
}
__device__ __forceinline__ void qk_half(f32x16& p, lds_cptr Kt, int s, const bf16x8* qr, const f32x16& cinit, int r32, int hi) {
    lds_cptr kb = Kt + hi * 1024 + r32 * 16 + s * 512;
#pragma unroll
    for (int d0 = 0; d0 < 4; ++d0) { const bf16x8 b0 = *(LAS const bf16x8*)(kb + d0 * 2048);
        if (d0 == 0) p = __builtin_amdgcn_mfma_f32_32x32x16_bf16(b0, qr[0], cinit, 0, 0, 0); else p = __builtin_amdgcn_mfma_f32_32x32x16_bf16(b0, qr[d0], p, 0, 0, 0); }
}
template <bool BIAS>
__device__ __forceinline__ void softmax_half(f32x16& p, LAS const float* lutp, int jt, int s, float& l, v4u& pa0, v4u& pa1) {
#pragma unroll
    for (int r = 0; r < 16; ++r) { const int ko = 64 * jt + 32 * s + (r & 3) + 8 * (r >> 2);
        if (BIAS) p[r] += lutp[ko];
        p[r] = __builtin_amdgcn_exp2f(p[r]); }
    float sm = 0.f;
#pragma unroll
    for (int r = 0; r < 16; ++r) sm += p[r];
    l += sm;
    pa0 = (v4u){cvtpk(p[0], p[1]), cvtpk(p[2], p[3]), cvtpk(p[4], p[5]), cvtpk(p[6], p[7])};
    pa1 = (v4u){cvtpk(p[8], p[9]), cvtpk(p[10], p[11]), cvtpk(p[12], p[13]), cvtpk(p[14], p[15])};
}
__device__ __forceinline__ void pv_half(f32x16* o, lds_cptr vp, int s, const v4u& pa0, const v4u& pa1) {
#pragma unroll
    for (int d0 = 0; d0 < 2; ++d0)
#pragma unroll
        for (int kk = 0; kk < 2; ++kk) { const int ks = 2 * s + kk; const s16x4 lo = vtr(vp + d0 * 4096 + ks * 1024), hi = vtr(vp + d0 * 4096 + ks * 1024 + 512);
            const bf16x8 vf = (bf16x8){lo[0], lo[1], lo[2], lo[3], hi[0], hi[1], hi[2], hi[3]};
            o[d0] = __builtin_amdgcn_mfma_f32_32x32x16_bf16(vf, __builtin_bit_cast(bf16x8, kk ? pa1 : pa0), o[d0], 0, 0, 0); }
}
struct SlotD { int kind, t, idx; };
__device__ __forceinline__ constexpr SlotD slot_desc(int g) {
    if (g < 4) return SlotD{0, 0, g};
    if (g < 8) return SlotD{0, 1, g - 4};
    if (g < 56) { const int tt = (g - 8) / 8 + 1, i = (g - 8) % 8; return (i & 1) ? SlotD{1, tt - 1, i >> 1} : SlotD{0, tt + 1, i >> 1}; }
    if (g < 60) return SlotD{1, 6, g - 56};
    return SlotD{1, 7, g - 60};
}
template <bool BIAS>
struct TileMath {
    f32x16 P[2]; unsigned pk[2][8]; v4u fr[3]; f32x2_t lv[4]; float e0, e1, l0, l1;
    f32x16* o; lds_cptr Kl, Vl; unsigned kb0, vo0; const bf16x8* qr; const f32x16* cinit; LAS const float* lutp;
    template <int G> __device__ __forceinline__ v4u load_frag() { constexpr SlotD d = slot_desc(G);
        if (d.kind == 0) return *(LAS const v4u*)(Kl + (kb0 ^ (unsigned)(d.idx * 32)) + (d.t >> 1) * 8192 + (d.t & 1) * 4096);
        constexpr int d0 = d.idx >> 1, ks = 2 * (d.t & 1) + (d.idx & 1); lds_cptr vp = Vl + (vo0 ^ (unsigned)(d0 * 64)) + (d.t >> 1) * 8192 + ks * 2048;
        const s16x4 a = vtr(vp), c = vtr(vp + 1024); return __builtin_bit_cast(v4u, (bf16x8){a[0], a[1], a[2], a[3], c[0], c[1], c[2], c[3]}); }
    template <int Q> __device__ __forceinline__ f32x2_t lut_pair() { constexpr int t = Q >> 3, r0 = 2 * (Q & 7), ko = 64 * (t >> 1) + 32 * (t & 1) + (r0 & 3) + 8 * (r0 >> 2); return (f32x2_t){lutp[ko], lutp[ko + 1]}; }
    template <int Q> __device__ __forceinline__ void chunk() { constexpr int t = Q >> 3, c = Q & 7;
        if constexpr (Q > 0) { l0 += e0; l1 += e1; pk[((Q - 1) >> 3) & 1][(Q - 1) & 7] = cvtpk(e0, e1); }
        float x0 = P[t & 1][2 * c], x1 = P[t & 1][2 * c + 1];
        if constexpr (BIAS) { x0 += lv[Q & 3][0]; x1 += lv[Q & 3][1]; if constexpr (Q + 3 < 64) lv[(Q + 3) & 3] = lut_pair<Q + 3>(); }
        e0 = __builtin_amdgcn_exp2f(x0); e1 = __builtin_amdgcn_exp2f(x1); }
    template <int G> __device__ __forceinline__ void slot() {
        if constexpr (G + 2 < 64) fr[(G + 2) % 3] = load_frag<G + 2>();
        { constexpr SlotD d = slot_desc(G); const bf16x8 a = __builtin_bit_cast(bf16x8, fr[G % 3]);
          if constexpr (d.kind == 0) { if constexpr (d.idx == 0) P[d.t & 1] = __builtin_amdgcn_mfma_f32_32x32x16_bf16(a, qr[0], *cinit, 0, 0, 0); else P[d.t & 1] = __builtin_amdgcn_mfma_f32_32x32x16_bf16(a, qr[d.idx], P[d.t & 1], 0, 0, 0); }
          else { constexpr int d0 = d.idx >> 1, kk = d.idx & 1;
              o[d0] = __builtin_amdgcn_mfma_f32_32x32x16_bf16(a, __builtin_bit_cast(bf16x8, (v4u){pk[d.t & 1][4 * kk], pk[d.t & 1][4 * kk + 1], pk[d.t & 1][4 * kk + 2], pk[d.t & 1][4 * kk + 3]}), o[d0], 0, 0, 0); } }
        if constexpr (G >= 4 && G < 8) { chunk<2 * (G - 4)>(); chunk<2 * (G - 4) + 1>(); }
        else if constexpr (G >= 8 && G < 56) chunk<G>();
        else if constexpr (G >= 56 && G < 60) { chunk<56 + 2 * (G - 56)>(); chunk<56 + 2 * (G - 56) + 1>(); if constexpr (G == 59) { l0 += e0; l1 += e1; pk[1][7] = cvtpk(e0, e1); } }
        __builtin_amdgcn_sched_barrier(0);
    }
    template <int... G> __device__ __forceinline__ void run(std::integer_sequence<int, G...>) { (slot<G>(), ...); }
};
template <bool BIAS>
__device__ __forceinline__ void tile_math(f32x16* o, float& l, lds_cptr Kl, lds_cptr Vl, unsigned vo0, const bf16x8* qr, const f32x16& cinit, LAS const float* lutp, int r32, int hi) {
    TileMath<BIAS> T; T.o = o; T.Kl = Kl; T.kb0 = (unsigned)(r32 * 128 + ((hi ^ ((r32 >> 1) & 7)) * 16)); T.Vl = Vl; T.vo0 = vo0; T.qr = qr; T.cinit = &cinit; T.lutp = lutp; T.e0 = T.e1 = T.l0 = T.l1 = 0.f;
    if constexpr (BIAS) { T.lv[0] = T.template lut_pair<0>(); T.lv[1] = T.template lut_pair<1>(); T.lv[2] = T.template lut_pair<2>(); }
    T.fr[0] = T.template load_frag<0>(); T.fr[1] = T.template load_frag<1>();
    __builtin_amdgcn_sched_barrier(0);
    T.run(std::make_integer_sequence<int, 64>{});
    l += T.l0 + T.l1;
}
__device__ __forceinline__ void load_q_raw(bf16x8* qr, const GAS bf16* Qb, size_t qrow, int b, int h, int hi) {
#pragma unroll
    for (int d0 = 0; d0 < 4; ++d0) { const v4u v = *(const GAS v4u*)(Qb + hm_off(qrow, b, h) + d0 * 16 + hi * 8); qr[d0] = __builtin_bit_cast(bf16x8, v); }
}
__device__ __forceinline__ float q_norm2(const bf16x8* qr) {
    float q2 = 0.f;
#pragma unroll
    for (int d0 = 0; d0 < 4; ++d0) { const v4u v = __builtin_bit_cast(v4u, qr[d0]);
#pragma unroll
        for (int j = 0; j < 4; ++j) { const float a = __builtin_bit_cast(float, v[j] << 16), c = __builtin_bit_cast(float, v[j] & 0xffff0000u); q2 += a * a + c * c; } }
    return swap_add(q2);
}

__device__ __forceinline__ float ref_exponent(float q2, float kmax2, float bmax) { return __builtin_sqrtf(q2 * kmax2) * 1.002f + bmax + 0.01f; }
__device__ __forceinline__ void head_bounds(const GAS float* KBM, const GAS float* rel_bias, int bh, int h, int lane, float& kmax2, float& bmax) {
    float k = KBM[bh * 32 + (lane & 31)], bb = rel_bias[(lane & 31) * NH + h] * LOG2E;
#pragma unroll
    for (int o = 1; o < 32; o <<= 1) { k = fmaxf(k, shx(k, o, lane)); bb = fmaxf(bb, shx(bb, o, lane)); }
    kmax2 = k; bmax = bb;
}
__device__ __forceinline__ void store_row(GAS bf16* rowp, const f32x16* o, float scale, int hi, bool act) {
    unsigned w0[8], w1[8];
#pragma unroll
    for (int k = 0; k < 4; ++k) { w0[2 * k] = cvtpk(o[0][4 * k] * scale, o[0][4 * k + 1] * scale); w0[2 * k + 1] = cvtpk(o[0][4 * k + 2] * scale, o[0][4 * k + 3] * scale);
        w1[2 * k] = cvtpk(o[1][4 * k] * scale, o[1][4 * k + 1] * scale); w1[2 * k + 1] = cvtpk(o[1][4 * k + 2] * scale, o[1][4 * k + 3] * scale); }
#pragma unroll
    for (int i = 0; i < 8; ++i) { auto r = __builtin_amdgcn_permlane32_swap(w0[i], w1[i], false, false); w0[i] = r[0]; w1[i] = r[1]; }
    if (act) {
#pragma unroll
        for (int k = 0; k < 4; ++k) *(GAS v4u*)(rowp + 32 * hi + 8 * k) = (v4u){w0[2 * k], w0[2 * k + 1], w1[2 * k], w1[2 * k + 1]}; }
}
__device__ __forceinline__ void add_row(f32x16* o, const GAS bf16* rowp, int hi) {
    v4u v[4];
#pragma unroll
    for (int k = 0; k < 4; ++k) v[k] = *(const GAS v4u*)(rowp + 32 * hi + 8 * k);
#pragma unroll
    for (int k = 0; k < 4; ++k) { auto r0 = __builtin_amdgcn_permlane32_swap(v[k][0], v[k][2], false, false); auto r1 = __builtin_amdgcn_permlane32_swap(v[k][1], v[k][3], false, false);
        o[0][4 * k] += __builtin_bit_cast(float, r0[0] << 16); o[0][4 * k + 1] += __builtin_bit_cast(float, r0[0] & 0xffff0000u);
        o[0][4 * k + 2] += __builtin_bit_cast(float, r1[0] << 16); o[0][4 * k + 3] += __builtin_bit_cast(float, r1[0] & 0xffff0000u);
        o[1][4 * k] += __builtin_bit_cast(float, r0[1] << 16); o[1][4 * k + 1] += __builtin_bit_cast(float, r0[1] & 0xffff0000u);
        o[1][4 * k + 2] += __builtin_bit_cast(float, r1[1] << 16); o[1][4 * k + 3] += __builtin_bit_cast(float, r1[1] & 0xffff0000u); }
}
__device__ __forceinline__ GAS bf16* po_row(GAS unsigned char* ws, GAS float* outbuf, int b, int h, int t, int slot) {
    return (b < 2 ? (GAS bf16*)outbuf : (GAS bf16*)(ws + WS_POB)) + ((((size_t)((b & 1) * 16 + h) * SEQ + t) * 3 + slot) * 64);
}

__device__ __forceinline__ void glds16(const GAS void* gsrc, unsigned lds_dst) {
    unsigned keep;
    asm volatile("s_mov_b32 %0, m0\n\ts_mov_b32 m0, %2\n\ts_nop 0\n\tglobal_load_lds_dwordx4 %1, off\n\ts_mov_b32 m0, %0" : "=&s"(keep) : "v"(gsrc), "s"(lds_dst) : "memory");
}
struct Top3 { float g1, g2, g3; int i1, i2, i3; };
__device__ __forceinline__ void top3_insert(Top3& T, float g, int n) {
    const bool c1 = g > T.g1, c2 = g > T.g2, c3 = g > T.g3;
    T.g3 = c2 ? T.g2 : (c3 ? g : T.g3); T.i3 = c2 ? T.i2 : (c3 ? n : T.i3);
    T.g2 = c1 ? T.g1 : (c2 ? g : T.g2); T.i2 = c1 ? T.i1 : (c2 ? n : T.i2);
    T.g1 = c1 ? g : T.g1;               T.i1 = c1 ? n : T.i1;
}
__device__ __forceinline__ void top3_insert_tie(Top3& T, float g, int n) {
    const bool ok = n >= 0;
    const bool c1 = ok && (g > T.g1 || (g == T.g1 && n < T.i1) || T.i1 < 0), c2 = ok && (g > T.g2 || (g == T.g2 && n < T.i2) || T.i2 < 0), c3 = ok && (g > T.g3 || (g == T.g3 && n < T.i3) || T.i3 < 0);
    T.g3 = c2 ? T.g2 : (c3 ? g : T.g3); T.i3 = c2 ? T.i2 : (c3 ? n : T.i3);
    T.g2 = c1 ? T.g1 : (c2 ? g : T.g2); T.i2 = c1 ? T.i1 : (c2 ? n : T.i2);
    T.g1 = c1 ? g : T.g1;               T.i1 = c1 ? n : T.i1;
}
__device__ __forceinline__ void route(Frame& F) {
    GAS unsigned char* ws = F.ws;
    const GAS bf16* Qb = (const GAS bf16*)(ws + WS_Q); const GAS bf16* Kb = (const GAS bf16*)(ws + WS_K);
    const GAS float* KMP = (const GAS float*)(ws + WS_KMP);
    GAS unsigned short* SEG = (GAS unsigned short*)(ws + WS_SEG); GAS unsigned* CNT = (GAS unsigned*)(ws + WS_CNT); GAS unsigned* TOT = (GAS unsigned*)(ws + WS_CTL) + CW_TOT;
    GAS float* KBM = (GAS float*)(ws + WS_KBM);
    int tid = F.wave * 64 + lane_id(); asm volatile("" : "+v"(tid));
    const int hf = tid >> 8, t = tid & 255, lane = tid & 63, w4 = __builtin_amdgcn_readfirstlane((tid >> 6) & 3), r32 = lane & 31, hi = lane >> 5;
    constexpr int HS = 20480;
    LAS unsigned char* hb = F.lds + __builtin_amdgcn_readfirstlane(hf) * HS;
    LAS unsigned* cntw = (LAS unsigned*)(hb + 16384);
    LAS float* kbw = (LAS float*)(hb + 16384 + 512);
    const int ua = (F.vcu * 2 + hf) >> 6, bh = (F.vcu * 2 + hf) & 63, b = bh >> 4, h = bh & 15;
    auto own_of = [&](int it) -> int { return it == 0 ? ua : it == 1 ? 31 - ua : it == 2 ? 8 + ua : 23 - ua; };
    v4u kreg[8]; float kmreg[8]; bf16x8 qf[2][4];
    auto prefetch = [&](int own) {
        const size_t row0 = (size_t)b * SEQ + own * BLK + 64 * w4;
#pragma unroll
        for (int tq = 0; tq < 2; ++tq)
#pragma unroll
            for (int d0 = 0; d0 < 4; ++d0) qf[tq][d0] = __builtin_bit_cast(bf16x8, *(const GAS v4u*)(Qb + hm_off(row0 + 32 * tq + r32, b, h) + d0 * 16 + hi * 8));
#pragma unroll
        for (int i = 0; i < 8; ++i) kreg[i] = *(const GAS v4u*)(Kb + hm_off(row0 + 8 * i, b, h) + lane * 8);
#pragma unroll
        for (int j = 0; j < 8; ++j) { const int i = t + 256 * j, n = i >> 6, d = i & 63; const size_t o = ((size_t)(b * 32 + n) * 2) * 1024 + h * 64 + d; kmreg[j] = (KMP[o] + KMP[o + 1024]) * (1.0f / 256.0f); }
    };
    prefetch(own_of(0));
    const unsigned fro = (unsigned)(r32 * 128), swz = (unsigned)((r32 >> 1) & 7);
#pragma unroll 1
    for (int it = 0; it < 4; ++it) {
        const int own = own_of(it);
        LAS unsigned char* kmh = hb + (it & 1) * 8192; LAS unsigned char* kml = kmh + 4096;
#pragma unroll
        for (int j = 0; j < 8; ++j) { const int i = t + 256 * j, n = i >> 6, d = i & 63; const float x = kmreg[j];
            const unsigned xb = __builtin_bit_cast(unsigned, x), hb16 = (xb + 0x7fffu + ((xb >> 16) & 1u)) >> 16; const float xh = __builtin_bit_cast(float, hb16 << 16), xl = x - xh;
            const unsigned lb = __builtin_bit_cast(unsigned, xl), lb16 = (lb + 0x7fffu + ((lb >> 16) & 1u)) >> 16;
            const int pos = n * 128 + (((d >> 3) ^ ((n >> 1) & 7)) * 16) + (d & 7) * 2;
            *(LAS unsigned short*)(kmh + pos) = (unsigned short)hb16; *(LAS unsigned short*)(kml + pos) = (unsigned short)lb16; }
        { float k2 = 0.f;
#pragma unroll
          for (int i = 0; i < 8; ++i) { float r2 = 0.f;
#pragma unroll
              for (int j = 0; j < 4; ++j) { const float a = __builtin_bit_cast(float, kreg[i][j] << 16), c = __builtin_bit_cast(float, kreg[i][j] & 0xffff0000u); r2 += a * a + c * c; }
              r2 += shx(r2, 1, lane); r2 += shx(r2, 2, lane); r2 += shx(r2, 4, lane); k2 = fmaxf(k2, r2); }
          k2 = fmaxf(k2, shx(k2, 8, lane)); k2 = fmaxf(k2, shx(k2, 16, lane)); k2 = fmaxf(k2, shx(k2, 32, lane));
          if (lane == 0) kbw[(it & 1) * 4 + w4] = k2; }
        bf16x8 qc[2][4];
#pragma unroll
        for (int tq = 0; tq < 2; ++tq)
#pragma unroll
            for (int d0 = 0; d0 < 4; ++d0) qc[tq][d0] = qf[tq][d0];
        __syncthreads();
        if (it < 3) prefetch(own_of(it + 1));
        f32x16 acc[2]; acc[0] = f32x16{}; acc[1] = f32x16{};
#pragma unroll
        for (int d0 = 0; d0 < 4; ++d0) { const unsigned co = ((unsigned)(2 * d0 + hi) ^ swz) * 16;
            const bf16x8 ah = *(const LAS bf16x8*)(kmh + fro + co), al = *(const LAS bf16x8*)(kml + fro + co);
#pragma unroll
            for (int tq = 0; tq < 2; ++tq) { acc[tq] = __builtin_amdgcn_mfma_f32_32x32x16_bf16(ah, qc[tq][d0], acc[tq], 0, 0, 0); acc[tq] = __builtin_amdgcn_mfma_f32_32x32x16_bf16(al, qc[tq][d0], acc[tq], 0, 0, 0); } }
        Top3 R;
#pragma unroll
        for (int tq = 0; tq < 2; ++tq) { Top3 T{-INFINITY, -INFINITY, -INFINITY, -1, -1, -1};
#pragma unroll
            for (int r = 0; r < 16; ++r) { const int n = crow(r, hi); const float g = acc[tq][r]; top3_insert(T, n < own ? g : -INFINITY, n < own ? n : -1); }
            Top3 P; { auto x1 = __builtin_amdgcn_permlane32_swap(__float_as_uint(T.g1), __float_as_uint(T.g1), false, false); P.g1 = __uint_as_float(hi ? x1[0] : x1[1]);
                      auto x2 = __builtin_amdgcn_permlane32_swap(__float_as_uint(T.g2), __float_as_uint(T.g2), false, false); P.g2 = __uint_as_float(hi ? x2[0] : x2[1]);
                      auto x3 = __builtin_amdgcn_permlane32_swap(__float_as_uint(T.g3), __float_as_uint(T.g3), false, false); P.g3 = __uint_as_float(hi ? x3[0] : x3[1]);
                      auto y1 = __builtin_amdgcn_permlane32_swap((unsigned)T.i1, (unsigned)T.i1, false, false); P.i1 = (int)(hi ? y1[0] : y1[1]);
                      auto y2 = __builtin_amdgcn_permlane32_swap((unsigned)T.i2, (unsigned)T.i2, false, false); P.i2 = (int)(hi ? y2[0] : y2[1]);
                      auto y3 = __builtin_amdgcn_permlane32_swap((unsigned)T.i3, (unsigned)T.i3, false, false); P.i3 = (int)(hi ? y3[0] : y3[1]); }
            top3_insert_tie(T, P.g1, P.i1); top3_insert_tie(T, P.g2, P.i2); top3_insert_tie(T, P.g3, P.i3);
            if (tq == hi) R = T; }
        const int i1 = R.i1, i2 = R.i2, i3 = R.i3;
        unsigned rk1 = 0, rk2 = 0, rk3 = 0;
        for (int n = 0; n < own; ++n) { const bool h1 = i1 == n, h2 = i2 == n, h3 = i3 == n; const unsigned long long mm = __ballot(h1 || h2 || h3);
            const unsigned rank = __builtin_amdgcn_mbcnt_hi((unsigned)(mm >> 32), __builtin_amdgcn_mbcnt_lo((unsigned)mm, 0u));
            rk1 = h1 ? rank : rk1; rk2 = h2 ? rank : rk2; rk3 = h3 ? rank : rk3;
            if (lane == 0) cntw[w4 * 32 + n] = (unsigned)__popcll(mm); }
        __syncthreads();
#pragma unroll
        for (int sl = 0; sl < 3; ++sl) { const int n = sl == 0 ? i1 : sl == 1 ? i2 : i3; const unsigned rk = sl == 0 ? rk1 : sl == 1 ? rk2 : rk3;
            const int nn = n & 31; unsigned base = 0;
#pragma unroll
            for (int w = 0; w < 3; ++w) { const unsigned v = cntw[w * 32 + nn]; base += (w < w4) ? v : 0u; }
            if (n >= 0) SEG[(((size_t)bh * 32 + own) * 32 + n) * 256 + base + rk] = (unsigned short)(t | (sl << 8)); }
        if (t < own) { const unsigned c = cntw[t] + cntw[32 + t] + cntw[64 + t] + cntw[96 + t]; CNT[((size_t)bh * 32 + own) * 32 + t] = c; (void)__hip_atomic_fetch_add(TOT + bh * 31 + t, c, RLX_AGENT); }
        if (t == 0) KBM[bh * 32 + own] = fmaxf(fmaxf(kbw[(it & 1) * 4], kbw[(it & 1) * 4 + 1]), fmaxf(kbw[(it & 1) * 4 + 2], kbw[(it & 1) * 4 + 3]));
    }
    asm volatile("s_waitcnt vmcnt(0)" ::: "memory");
    __syncthreads();
}

struct GTile { unsigned info; bf16x8 qr[4]; };
struct GRun { int e, c0, c1; };
__device__ __forceinline__ void dma_kv(LAS unsigned char* kv, const GAS bf16* Kb, const GAS bf16* Vb, int b, int h, int n, int w, int lane) {
#pragma unroll
    for (int t = 0; t < 4; ++t) {
        const size_t kr = (size_t)b * SEQ + n * BLK + 64 * t + 8 * w + (lane >> 3), vr = (size_t)b * SEQ + n * BLK + 64 * t + 16 * (w & 3) + (lane >> 2);
        __builtin_amdgcn_global_load_lds((const GAS unsigned*)(Kb + hm_off(kr, b, h) + (((lane & 7) ^ ((4 * w + (lane >> 4)) & 7)) * 8)), (LAS unsigned*)(kv + L_K + t * 8192 + w * 1024), 16, 0, 0);
        __builtin_amdgcn_global_load_lds((const GAS unsigned*)(Vb + hm_off(kr, b, h) + ((((lane >> 2) & 1) ^ ((lane >> 4) & 1)) * 32) + (lane & 3) * 8), (LAS unsigned*)(kv + L_V + t * 8192 + w * 1024), 16, 0, 0);
    }
}
__device__ __forceinline__ void gather(Frame& F) {
    GAS unsigned char* ws = F.ws;
    const GAS bf16* Qb = (const GAS bf16*)(ws + WS_Q); const GAS bf16* Kb = (const GAS bf16*)(ws + WS_K); const GAS bf16* Vb = (const GAS bf16*)(ws + WS_V);
    const GAS unsigned short* SEG = (const GAS unsigned short*)(ws + WS_SEG); const GAS unsigned* CNT = (const GAS unsigned*)(ws + WS_CNT); const GAS unsigned* TOT = (const GAS unsigned*)(ws + WS_CTL) + CW_TOT;
    const GAS float* KBM = (const GAS float*)(ws + WS_KBM); GAS float* PL = (GAS float*)(ws + WS_PL);
    int tid = F.wave * 64 + lane_id(); asm volatile("" : "+v"(tid));
    const int lane = tid & 63, w = __builtin_amdgcn_readfirstlane(tid >> 6), r32 = lane & 31, hi = lane >> 5;
    LAS unsigned* pre = (LAS unsigned*)(F.lds + L_PRE);
    __syncthreads();
    if (w == 0) { unsigned loc = 0;
        for (int i = 0; i < 31; ++i) { const unsigned nc = (TOT[31 * lane + i] + 255u) >> 8; loc += nc + (nc ? 1u : 0u); }
        unsigned inc = loc;
#pragma unroll
        for (int o = 1; o < 64; o <<= 1) { const unsigned v = shup(inc, o, lane); if (lane >= o) inc += v; }
        unsigned run = inc - loc;
        for (int i = 0; i < 31; ++i) { pre[31 * lane + i] = run; const unsigned nc = (TOT[31 * lane + i] + 255u) >> 8; run += nc + (nc ? 1u : 0u); }
        if (lane == 63) pre[1984] = run; }
    __syncthreads();
    const int U = (int)pre[1984];
    int p = (int)(((long)F.vcu * U) / F.G); const int phi = (int)(((long)(F.vcu + 1) * U) / F.G);
    int e = 0; { int lo = 0, hi2 = 1984; while (hi2 - lo > 1) { const int mid = (lo + hi2) >> 1; if ((int)pre[mid] <= p) lo = mid; else hi2 = mid; } e = lo; }
    auto next_run = [&](GRun& R) -> bool {
        while (p < phi) {
            while (p >= (int)pre[e + 1]) ++e;
            const int k = p - (int)pre[e], nch = (int)pre[e + 1] - (int)pre[e] - 1;
            const int c0 = k > 0 ? k - 1 : 0; int c1 = phi - (int)pre[e] - 1; c1 = c1 < nch ? c1 : nch;
            p = (int)pre[e] + 1 + c1;
            if (c1 > c0) { R.e = e; R.c0 = c0; R.c1 = c1; return true; }
        }
        return false;
    };
    auto scan_cnt = [&](unsigned v) -> unsigned { unsigned inc = v;
#pragma unroll
        for (int o = 1; o < 32; o <<= 1) { const unsigned t2 = shup(inc, o, lane); if ((lane & 31) >= o) inc += t2; }
        return inc; };
    int cur_h = -1, cur_bh = -1, rb = 0; float kmax2 = 0.f, bmax = 0.f, rb31 = 0.f;
    GRun cur, nxt; bool hc = next_run(cur);
    unsigned cntN = 0, totN = 0, cumv = 0, tot = 0;
    if (hc) { const int bh = cur.e / 31, n = cur.e - bh * 31; dma_kv(F.lds, Kb, Vb, bh >> 4, bh & 15, n, w, lane);
        cntN = ((lane & 31) > n) ? CNT[((size_t)bh * 32 + (lane & 31)) * 32 + n] : 0u; totN = TOT[cur.e]; }
    GTile tcur, tnxt; unsigned ownB = 0, entB = 0xffffffffu; bool mine = false;
    auto fetch_ent = [&](int c, bool valid, int n, const GAS unsigned short* segb, unsigned cv, unsigned tt, unsigned& own_o) -> unsigned {
        const unsigned g0 = 256u * c + 32u * w, g = g0 + r32;
        const bool tile_ok = valid && g0 < tt;
        unsigned own = (unsigned)(n + 1), base = 0u;
        if (tile_ok) {
            int lo = n + 1, hi2 = 32;
            while (hi2 - lo > 1) { const int mid = (lo + hi2) >> 1; if (__builtin_amdgcn_readlane(cv, mid - 1) <= g0) lo = mid; else hi2 = mid; }
            own = (unsigned)lo; base = (lo == n + 1) ? 0u : __builtin_amdgcn_readlane(cv, lo - 1);
            for (int o = lo + 1; o < 32; ++o) { const unsigned s2 = __builtin_amdgcn_readlane(cv, o - 1); if (s2 > g0 + 31u) break; if (s2 <= g) { own = (unsigned)o; base = s2; } }
        }
        const bool lane_ok = tile_ok && g < tt;
        const unsigned idx = lane_ok ? (g - base) : 0u;
        const unsigned v = (unsigned)segb[(size_t)own * 32 * 256 + idx];
        own_o = own;
        return lane_ok ? v : 0xffffffffu;
    };
    auto make_tile = [&](unsigned ent, unsigned own, int b, int h, int n, GTile& T) {
        const bool act = ent != 0xffffffffu;
        const int tq = act ? (int)(own * BLK + (ent & 255u)) : SEQ - 1;
        T.info = (unsigned)tq | (act ? (((ent >> 8) & 3u) << 16) | (1u << 18) | ((own - n <= 4) ? (1u << 19) : 0u) : 0u);
        load_q_raw(T.qr, Qb, (size_t)b * SEQ + tq, b, h, hi);
    };
    auto start_run = [&](const GRun& R) {
        const int bh = R.e / 31, n = R.e - bh * 31; const GAS unsigned short* segb = SEG + ((size_t)bh * 32 * 32 + n) * 256;
        cumv = scan_cnt(cntN); tot = totN;
        mine = (unsigned)(256 * R.c0 + 32 * w) < tot;
        entB = 0xffffffffu; ownB = 0;
        if (mine) { unsigned ownA; const unsigned entA = fetch_ent(R.c0, true, n, segb, cumv, tot, ownA); make_tile(entA, ownA, bh >> 4, bh & 15, n, tcur);
            entB = fetch_ent(R.c0 + 1, R.c0 + 1 < R.c1, n, segb, cumv, tot, ownB); }
    };
    if (hc) start_run(cur);
    while (hc) {
        const bool hn = next_run(nxt);
        const int c0 = cur.c0, c1 = cur.c1, bh = cur.e / 31, n = cur.e - bh * 31, b = bh >> 4, h = bh & 15;
        const GAS unsigned short* segb = SEG + ((size_t)bh * 32 * 32 + n) * 256;
        LAS unsigned char* kv = F.lds + rb * 65536;
        __builtin_amdgcn_s_waitcnt(0x0F70);
        __syncthreads();
        if (hn) { const int bh2 = nxt.e / 31, n2 = nxt.e - bh2 * 31;
            cntN = ((lane & 31) > n2) ? CNT[((size_t)bh2 * 32 + (lane & 31)) * 32 + n2] : 0u; totN = TOT[nxt.e]; }
        if (bh != cur_bh) { head_bounds(KBM, F.rel_bias, bh, h, lane, kmax2, bmax); rb31 = F.rel_bias[31 * NH + h] * LOG2E; cur_bh = bh;
            if (h != cur_h) { build_lut(F.lds, F.rel_bias, h, tid); cur_h = h; __syncthreads(); } }
        const lds_cptr Kl = (lds_cptr)(kv + L_K), Vl = (lds_cptr)(kv + L_V); const int vrl = 4 * hi + ((lane & 15) >> 2); const unsigned vo0 = (unsigned)(vrl * 128 + ((vrl >> 1) & 1) * 64 + ((lane >> 4) & 1) * 32 + (lane & 3) * 8);
        if (mine) for (int c = c0; c < c1; ++c) {
            if ((unsigned)(256 * c + 32 * w) >= tot) break;
            make_tile(entB, ownB, b, h, n, tnxt);
            entB = fetch_ent(c + 2, c + 2 < c1, n, segb, cumv, tot, ownB);
            const unsigned info = tcur.info; const int tq = (int)(info & 0xffffu); const bool near = (info >> 19) & 1u;
            const float mref = ref_exponent(q_norm2(tcur.qr), kmax2, bmax);
            const bool anynear = __any(near);
            const int tqrel = near ? (tq - n * BLK) : 1755;
            LAS const float* lutp = (LAS const float*)(F.lds + L_LUT) + (2047 - tqrel + 4 * hi);
            f32x16 cinit; { const float cc = anynear ? -mref : (rb31 - mref);
#pragma unroll
                for (int r = 0; r < 16; ++r) cinit[r] = cc; }
            f32x16 o[2]; o[0] = f32x16{}; o[1] = f32x16{}; float l = 0.f;
            if (anynear) tile_math<true>(o, l, Kl, Vl, vo0, tcur.qr, cinit, lutp, r32, hi); else tile_math<false>(o, l, Kl, Vl, vo0, tcur.qr, cinit, lutp, r32, hi);
            l = swap_add(l);
            { const bool act = (info >> 18) & 1u; const int slot = (int)((info >> 16) & 3u);
              GAS bf16* dump = (GAS bf16*)(ws + WS_DUMP) + (size_t)F.vcu * 4096 + lane * 64;
              store_row(act ? po_row(ws, F.out, b, h, tq, slot) : dump - 32 * hi, o, 1.0f, hi, true);
              GAS float* plp = act ? PL + (((size_t)bh * SEQ + tq) * 3) + slot : (GAS float*)dump;
              *plp = l; }
            tcur = tnxt;
        }
        if (hn) { start_run(nxt);
            const int bh2 = nxt.e / 31, n2 = nxt.e - bh2 * 31; dma_kv(F.lds + (rb ^ 1) * 65536, Kb, Vb, bh2 >> 4, bh2 & 15, n2, w, lane); }
        cur = nxt; hc = hn; rb ^= 1;
    }
    asm volatile("s_waitcnt vmcnt(0)" ::: "memory");
    __syncthreads();
}

__device__ __forceinline__ void own_block(Frame& F) {
    GAS unsigned char* ws = F.ws;
    const GAS bf16* Qb = (const GAS bf16*)(ws + WS_Q); const GAS bf16* Kb = (const GAS bf16*)(ws + WS_K); const GAS bf16* Vb = (const GAS bf16*)(ws + WS_V); GAS bf16* Ob = (GAS bf16*)(ws + WS_O);
    const GAS float* KBM = (const GAS float*)(ws + WS_KBM); const GAS float* PL = (const GAS float*)(ws + WS_PL);
    int tid = F.wave * 64 + lane_id(); asm volatile("" : "+v"(tid));
    const int lane = tid & 63, w = __builtin_amdgcn_readfirstlane(tid >> 6), r32 = lane & 31, hi = lane >> 5;
    const int bh = F.vcu & 63, b = bh >> 4, h = bh & 15, own0 = F.vcu >> 6, nun = (NBLK - own0 + 3) / 4;
    __syncthreads();
    build_lut(F.lds, F.rel_bias, h, tid);
    float kmax2, bmax; head_bounds(KBM, F.rel_bias, bh, h, lane, kmax2, bmax);
    const int qrel = 32 * w + r32;
    LAS const float* lutp = (LAS const float*)(F.lds + L_LUT) + (2047 - qrel + 4 * hi);
    const int jd = w >> 1;
    bf16x8 qn[4];
    dma_kv(F.lds, Kb, Vb, b, h, own0, w, lane);
    load_q_raw(qn, Qb, (size_t)b * SEQ + own0 * BLK + qrel, b, h, hi);
    for (int i = 0; i < nun; ++i) {
        const int own = own0 + 4 * i; const size_t qrow = (size_t)b * SEQ + own * BLK + qrel;
        LAS unsigned char* kv = F.lds + (i & 1) * 65536;
        bf16x8 qr[4];
#pragma unroll
        for (int d0 = 0; d0 < 4; ++d0) qr[d0] = qn[d0];
        asm volatile("s_waitcnt vmcnt(0)" ::: "memory");
        __syncthreads();
        if (i + 1 < nun) { dma_kv(F.lds + ((i + 1) & 1) * 65536, Kb, Vb, b, h, own + 4, w, lane); load_q_raw(qn, Qb, qrow + 4 * BLK, b, h, hi); }
        const float mref = ref_exponent(q_norm2(qr), kmax2, bmax);
        f32x16 cinit;
#pragma unroll
        for (int r = 0; r < 16; ++r) cinit[r] = -mref;
        f32x16 o[2]; o[0] = f32x16{}; o[1] = f32x16{}; float l = 0.f;
        const lds_cptr Kl = (lds_cptr)(kv + L_K), Vl = (lds_cptr)(kv + L_V); const int vrl = 4 * hi + ((lane & 15) >> 2); const unsigned vo0 = (unsigned)(vrl * 128 + ((vrl >> 1) & 1) * 64 + ((lane >> 4) & 1) * 32 + (lane & 3) * 8);
        for (int j = 0; j <= jd; ++j) { f32x16 p0, p1; v4u pa[4];
            qk_tile(p0, p1, Kl + j * 8192, qr, cinit, r32, hi);
            if (j == jd) softmax_tile<true, true>(p0, p1, lutp, j, qrel, hi, l, pa); else softmax_tile<true, false>(p0, p1, lutp, j, qrel, hi, l, pa);
            pv_tile(o, Vl + j * 8192, vo0, pa); }
        l = swap_add(l);
        const int nsl = own < 3 ? own : 3; const int tq = own * BLK + qrel;
        for (int sl = 0; sl < nsl; ++sl) { add_row(o, po_row(ws, F.out, b, h, tq, sl), hi); l += PL[(((size_t)bh * SEQ + tq) * 3) + sl]; }
        store_row(Ob + qrow * D + h * 64, o, 1.0f / l, hi, true);
    }
    asm volatile("s_waitcnt vmcnt(0)" ::: "memory");
    __syncthreads();
}
}

__device__ __forceinline__ void final_norm(Frame& Fr) {
    struct { int lane, vcu, wave, G; const GAS float* norm_final; GAS float* out; } F{Fr.wave * 64 + lane_id(), Fr.vcu, Fr.wave, Fr.G, Fr.norm_final, Fr.out};
    asm volatile("" : "+v"(F.lane)); F.lane &= 63;
    const int gw = F.vcu * NWAVES + F.wave, NGW = F.G * NWAVES;
    f32x4 gam[4];
#pragma unroll
    for (int j = 0; j < 4; ++j) gam[j] = *(const GAS f32x4*)(F.norm_final + 4 * (F.lane + 64 * j));
    for (int row = gw; row < M; row += NGW) { GAS float* xr = F.out + (size_t)row * D; f32x4 v[4]; float ss = 0.f;
#pragma unroll
        for (int j = 0; j < 4; ++j) { v[j] = *(const GAS f32x4*)(xr + 4 * (F.lane + 64 * j)); ss += (v[j][0] * v[j][0] + v[j][1] * v[j][1]) + (v[j][2] * v[j][2] + v[j][3] * v[j][3]); }
#pragma unroll
        for (int o = 1; o < 64; o <<= 1) ss += shx(ss, o, F.lane);
        const float rstd = rsqrtf(ss * (1.0f / D) + EPS);
#pragma unroll
        for (int j = 0; j < 4; ++j) *(GAS f32x4*)(xr + 4 * (F.lane + 64 * j)) = v[j] * rstd * gam[j]; }
}

__global__ void __launch_bounds__(NWAVES * 64, 2) fwd_megakernel(Args args) {
    __shared__ __attribute__((aligned(16))) unsigned char lds[LDS_BYTES];
    Frame F;
    F.lds = (LAS unsigned char*)lds;
    F.tid = threadIdx.x; F.lane = F.tid & 63; F.wave = __builtin_amdgcn_readfirstlane(F.tid >> 6);
    F.G = gridDim.x; { const int bx = blockIdx.x; F.vcu = (F.G % 8 == 0) ? (bx % 8) * (F.G / 8) + bx / 8 : bx; }
    F.x = args.in[0]; F.c = args.in[1]; F.rel_bias = args.in[2]; F.w_mod = args.in[3]; F.b_mod = args.in[4]; F.norm_mix = args.in[5]; F.norm_mlp = args.in[6];
    F.w_pool = args.in[7]; F.pool_scale = args.in[8]; F.w_qkv = args.in[9]; F.w_o = args.in[10]; F.w_up = args.in[11]; F.w_down = args.in[12]; F.norm_final = args.in[13];
    F.out = args.out; F.ws = args.ws;
    volatile LAS unsigned* MISC = (volatile LAS unsigned*)(F.lds + MISC_OFF);
    for (int u = F.tid; u < (LDS_BYTES - LDSCTL_OFF) / 4; u += NWAVES * 64) ((LAS unsigned*)(F.lds + LDSCTL_OFF))[u] = 0u;
    __syncthreads();
    gu32* ctl = (gu32*)(F.ws + WS_CTL);
    XcdBarrier bar = xcd_barrier_post((GAS unsigned*)(ctl + CW_BAR), MISC + 8); bar.wave = F.wave;
    GAS unsigned char* ws = F.ws;
#define WSB(off) ((GAS bf16*)(ws + (off)))
#define WSF(off) ((GAS float*)(ws + (off)))

    p0_prologue(F);
    xcd_barrier(bar);
    p1_bias(F); p1_pool(F);
    xcd_barrier(bar);

    for (int ph = 0; ph < 10; ++ph) {
        asm volatile("" : "+s"(ws));
        const GAS float* MOD = WSF(WS_MOD); GAS float* SS = WSF(WS_SS);
        const int kind = (ph == 0 || ph == 2 || ph == 7) ? 0 : (ph == 1 || ph == 8) ? 1 : (ph == 3) ? 2 : (ph == 4) ? 3 : (ph == 5) ? 4 : (ph == 6) ? 5 : 7;
        if (kind == 0) {
            pg8::Gemm g; pg8::EpiRes E;
            if (ph == 0) { g = pg8::Gemm{WSB(WS_XNA), WSB(WS_WPOOL), M, D, 256, D, 256, 512};
                E = pg8::EpiRes{WSB(WS_XR), WSB(WS_XR), MOD + 2048, F.pool_scale, F.norm_mlp, MOD + 4096, WSB(WS_XNB), SS}; }
            else if (ph == 2) { g = pg8::Gemm{WSB(WS_HB), WSB(WS_WDN0), M, D, FF, 256, 0, 131072};
                E = pg8::EpiRes{WSB(WS_XR), WSB(WS_XR), MOD + 5120, nullptr, F.norm_mix + D, MOD + 4 * 6144 + 1024, WSB(WS_XNA), SS}; }
            else { g = pg8::Gemm{WSB(WS_O), WSB(WS_WO), M, D, D, D, 0, 512};
                E = pg8::EpiRes{WSB(WS_XR), WSB(WS_XR), MOD + 4 * 6144 + 2048, nullptr, F.norm_mlp + D, MOD + 4 * 6144 + 4096, WSB(WS_XNB), SS}; }
            pg8::StaticOrder S; S.init(M, D, F.G, (int)blockIdx.x);
            pg8::gemm_phase<pg8::EpiRes, pg8::StaticOrder, true>(F.lds + RING_OFF, g, S, E, F.wave);
        } else if (kind == 1) {
            const pg8::Gemm g{WSB(WS_XNB), WSB(ph == 1 ? WS_WUP0 : WS_WUP1), M, FF, D, 256, 0, 131072};
            const pg8::EpiUp E{SS, WSF(ph == 1 ? WS_BIAS_UP0 : WS_BIAS_UP1), WSB(WS_HB), FF, F.lds, 0};
            pg8::StaticOrder S; S.init(M, FF, F.G, (int)blockIdx.x);
            pg8::gemm_phase<pg8::EpiUp, pg8::StaticOrder, true>(F.lds + RING_OFF, g, S, E, F.wave);
        } else if (kind == 2) {
            const pg8::Gemm g{WSB(WS_XNA), WSB(WS_WQKV), M, NQKV, D, 256, 0, 131072};
            const pg8::EpiQKV E{SS, WSF(WS_BIAS_QKV), WSB(WS_Q), (size_t)(WS_K - WS_Q) / 2, WSF(WS_KMP), F.lds, 0};
            pg8::StaticOrder S; S.init(M, NQKV, F.G, (int)blockIdx.x);
            pg8::gemm_phase<pg8::EpiQKV, pg8::StaticOrder, true>(F.lds + RING_OFF, g, S, E, F.wave);
        } else if (kind == 3) { F.ws = ws; att::route(F);
        } else if (kind == 4) { F.ws = ws; att::gather(F);
        } else if (kind == 5) { F.ws = ws; att::own_block(F);
        } else {
            const pg8::Gemm g{WSB(WS_HB), WSB(WS_WDN1), M, D, FF, 256, 0, 131072};
            const pg8::EpiFinal E{WSB(WS_XR), F.out, MOD + 4 * 6144 + 5120, F.norm_final, SS, (GAS unsigned*)(ws + WS_CTL) + CW_FIN};
            pg8::StaticOrder S; S.init(M, D, F.G, (int)blockIdx.x);
            pg8::gemm_phase<pg8::EpiFinal, pg8::StaticOrder, true>(F.lds + RING_OFF, g, S, E, F.wave);
            break;
        }
        xcd_barrier(bar);
    }
}

extern "C" void kernel_launch(void* const* d_in, const int* in_sizes, int n_in, void* d_out, int out_size, void* d_ws, size_t ws_size, hipStream_t stream) {
    static int grid = 0;
    if (grid == 0) {
        if (n_in != 14 || in_sizes[0] != M * D || out_size != M * D || ws_size < WS_END) { fprintf(stderr, "kernel_launch: unexpected shapes / workspace (n_in %d, in0 %d, out %d, ws %zu)\n", n_in, n_in > 0 ? in_sizes[0] : -1, out_size, ws_size); grid = -1; return; }
        int dev = 0, cus = 0, per_cu = 0;
        if (hipGetDevice(&dev) != hipSuccess || hipDeviceGetAttribute(&cus, hipDeviceAttributeMultiprocessorCount, dev) != hipSuccess) { grid = -1; return; }
        if (hipOccupancyMaxActiveBlocksPerMultiprocessor(&per_cu, (const void*)fwd_megakernel, NWAVES * 64, 0) != hipSuccess || per_cu < 1) { fprintf(stderr, "kernel_launch: occupancy query says %d blocks per CU\n", per_cu); }
        (void)hipGetLastError();
        grid = cus;
    }
    if (grid < 0) return;
    if (hipMemsetAsync((char*)d_ws + WS_CTL, 0, CTL_ZERO_BYTES, stream) != hipSuccess) return;
    Args a{};
    for (int i = 0; i < 14; ++i) a.in[i] = (const GAS float*)d_in[i];
    a.out = (GAS float*)d_out; a.ws = (GAS unsigned char*)d_ws;
    hipLaunchKernelGGL(fwd_megakernel, dim3(grid), dim3(NWAVES * 64), 0, stream, a);
}
```

```cpp
#include <hip/hip_runtime.h>
#include <utility>
#include <cstdio>
#include <cstdint>

__device__ __forceinline__ float shx(float v, int m, int lane) { return __builtin_bit_cast(float, __builtin_amdgcn_ds_bpermute((lane ^ m) << 2, __builtin_bit_cast(int, v))); }
__device__ __forceinline__ unsigned shup(unsigned v, int o, int lane) { return (unsigned)__builtin_amdgcn_ds_bpermute(((lane - o) & 63) << 2, (int)v); }
__device__ __forceinline__ size_t hm_off(size_t row, int b, int h) { return (row + (size_t)(15 * b + h) * 8192) * 64; }
__device__ __forceinline__ int lane_id() { unsigned z = 0u; asm volatile("" : "+s"(z)); return (int)__builtin_amdgcn_mbcnt_hi(~0u, __builtin_amdgcn_mbcnt_lo(~0u, z)); }

namespace pg8 {
#define PG8_LAS __attribute__((address_space(3)))
#define PG8_GAS __attribute__((address_space(1)))
typedef unsigned short bf16_t;
typedef short bf16x8 __attribute__((ext_vector_type(8)));
typedef float f32x4 __attribute__((ext_vector_type(4)));
typedef unsigned u32x4 __attribute__((ext_vector_type(4)));
constexpr int BM = 256, BK = 64, HALF = 128, HTB = HALF * BK * 2, STAGE_BYTES = 8 * HTB, NXCD = 8, WGM = 8;

__host__ __device__ __forceinline__ int lds_byte(int r, int c) { const int st = (r >> 4) * 2 + (c >> 5), rr = r & 15, cc = c & 31, ob = rr * 64 + cc * 2; return st * 1024 + (ob ^ (((ob >> 9) & 1) << 5)); }
__host__ __device__ __forceinline__ void stage_rc(int b, int& R, int& C) { const int st = b / 1024, sb = b % 1024, swz = sb ^ (((sb >> 9) & 1) << 5); R = (st >> 1) * 16 + swz / 64; C = (st & 1) * 32 + (swz % 64) / 2; }
__host__ __device__ __forceinline__ int perm32(int rho) { const int n = rho >> 4, i = rho & 15; return 8 * (i >> 2) + 4 * n + (i & 3); }

struct Unit { int pm, pn; };
struct Gemm { const PG8_GAS bf16_t* A; const PG8_GAS bf16_t* Bt; int M, N, K, lda, a_pn_off, a_tileb; size_t b_bstride = 0; };

struct StaticOrder {
    int nM, nN, nwg, G, c;
    __host__ __device__ void init(int M, int N, int G_, int c_) { nM = M / BM; nN = N / BM; nwg = nM * nN; G = G_; c = c_; }
    __host__ __device__ bool next(int i, Unit& u) const {
        const long L = (long)i * G + c; if (L >= nwg) return false;
        int wgid = (int)L; { const int q = nwg / NXCD, r = nwg % NXCD, xcd = wgid % NXCD, off = wgid / NXCD; wgid = (xcd < r ? xcd * (q + 1) : r * (q + 1) + (xcd - r) * q) + off; }
        const int nig = WGM * nN, gid = wgid / nig, fm = gid * WGM, gsz = (nM - fm) < WGM ? (nM - fm) : WGM;
        u.pm = fm + ((wgid % nig) % gsz); u.pn = (wgid % nig) / gsz; return true;
    }
};

__device__ __forceinline__ unsigned cvt_pk_bf16(float lo, float hi) { unsigned r; asm volatile("v_cvt_pk_bf16_f32 %0, %1, %2" : "=v"(r) : "v"(lo), "v"(hi)); return r; }

constexpr int SEQ_ = 8192;
constexpr float EPS_ = 1e-6f;
constexpr float C2_ = 0.125f * 1.4426950408889634f;


__device__ __forceinline__ float row_rstd(const PG8_GAS float* SS, int row, int fq, int fr) {
    const f32x4 s4 = *(const PG8_GAS f32x4*)(SS + (size_t)row * 16 + 4 * fq);
    float s = (s4[0] + s4[1]) + (s4[2] + s4[3]);
    const int ln = fq * 16 + fr; s += shx(s, 16, ln); s += shx(s, 32, ln);
    return rsqrtf(s * (1.0f / 1024.0f) + EPS_);
}

constexpr int RSTD_TAB_OFF = 132096;
__device__ __forceinline__ void fill_rstd_tab(PG8_LAS unsigned char* ldsbase, int par, const PG8_GAS float* SS, int pm, int wid, int lane) {
    if (lane < 32) { const int r = wid * 32 + lane; const PG8_GAS f32x4* p = (const PG8_GAS f32x4*)(SS + (size_t)(pm * BM + r) * 16);
        const f32x4 a = p[0], b = p[1], c = p[2], d = p[3];
        const float g0 = (a[0] + a[1]) + (a[2] + a[3]), g1 = (b[0] + b[1]) + (b[2] + b[3]), g2 = (c[0] + c[1]) + (c[2] + c[3]), g3 = (d[0] + d[1]) + (d[2] + d[3]);
        ((PG8_LAS float*)(ldsbase + RSTD_TAB_OFF + par * 1024))[r] = rsqrtf(((g0 + g1) + (g2 + g3)) * (1.0f / 1024.0f) + EPS_); }
}
__device__ __forceinline__ f32x4 bf_lo4(const u32x4& w) { return (f32x4){__builtin_bit_cast(float, w.x << 16), __builtin_bit_cast(float, w.x & 0xffff0000u), __builtin_bit_cast(float, w.y << 16), __builtin_bit_cast(float, w.y & 0xffff0000u)}; }
__device__ __forceinline__ f32x4 bf_hi4(const u32x4& w) { return (f32x4){__builtin_bit_cast(float, w.z << 16), __builtin_bit_cast(float, w.z & 0xffff0000u), __builtin_bit_cast(float, w.w << 16), __builtin_bit_cast(float, w.w & 0xffff0000u)}; }
struct EpiRes {
    static constexpr bool PERM = true, NEEDS_RSTD = false;
    const PG8_GAS bf16_t* Rb; PG8_GAS bf16_t* Xb; const PG8_GAS float* gate; const PG8_GAS float* cscale; PG8_GAS float* SS;
    __device__ __forceinline__ void operator()(f32x4 (&acc)[2][2][4][2], const Unit& u, int wr, int wc, int fr, int fq) const {
        const int b = u.pm >> 5, colb = u.pn * BM + wc * 32 + 8 * fq, row0 = u.pm * BM + wr * 64 + fr;
        float ssq[2][4];
#pragma unroll
        for (int bj = 0; bj < 2; ++bj) {
            f32x4 gt[2];
#pragma unroll
            for (int n = 0; n < 2; ++n) { const int col = colb + bj * HALF + 4 * n;
                f32x4 gv = *(const PG8_GAS f32x4*)(gate + b * 6144 + col); if (cscale) gv = gv * *(const PG8_GAS f32x4*)(cscale + col); gt[n] = gv; }
#pragma unroll
            for (int ai = 0; ai < 2; ++ai)
#pragma unroll
                for (int m = 0; m < 4; ++m) { const size_t off = ((size_t)(u.pm * 4 + u.pn) * 256 + (wr * 64 + fr + ai * HALF + m * 16)) * 256 + (wc * 32 + 8 * fq + bj * HALF);
                    const u32x4 rw = *(const PG8_GAS u32x4*)(Rb + off); const f32x4 r0 = bf_lo4(rw), r1 = bf_hi4(rw);
                    const f32x4 y0 = r0 + gt[0] * acc[ai][bj][m][0], y1 = r1 + gt[1] * acc[ai][bj][m][1];
                    u32x4 xw; xw.x = cvt_pk_bf16(y0[0], y0[1]); xw.y = cvt_pk_bf16(y0[2], y0[3]); xw.z = cvt_pk_bf16(y1[0], y1[1]); xw.w = cvt_pk_bf16(y1[2], y1[3]);
                    *(PG8_GAS u32x4*)(Xb + off) = xw;
                    const f32x4 x0 = bf_lo4(xw), x1 = bf_hi4(xw);
                    const float q = (x0[0] * x0[0] + x0[1] * x0[1]) + (x0[2] * x0[2] + x0[3] * x0[3]) + (x1[0] * x1[0] + x1[1] * x1[1]) + (x1[2] * x1[2] + x1[3] * x1[3]);
                    ssq[ai][m] = (bj == 0) ? q : ssq[ai][m] + q;
                }
        }
#pragma unroll
        for (int ai = 0; ai < 2; ++ai)
#pragma unroll
            for (int m = 0; m < 4; ++m) { float q = ssq[ai][m]; q += shx(q, 16, fq * 16 + fr); q += shx(q, 32, fq * 16 + fr); if (fq == 0) SS[(size_t)(row0 + ai * HALF + m * 16) * 16 + u.pn * 4 + wc] = q; }
    }
};

struct EpiFinal {
    static constexpr bool PERM = true, NEEDS_RSTD = false;
    const PG8_GAS bf16_t* R; PG8_GAS float* OUT; const PG8_GAS float* gate; const PG8_GAS float* gfin; PG8_GAS float* SS; PG8_GAS unsigned* cnt;
    __device__ __forceinline__ void operator()(f32x4 (&acc)[2][2][4][2], const Unit& u, int wr, int wc, int fr_, int fq_) const {
        int fr = fr_, fq = fq_; asm volatile("" : "+v"(fr), "+v"(fq));
        const int b = u.pm >> 5, colb = u.pn * BM + wc * 32 + 8 * fq, row0 = u.pm * BM + wr * 64 + fr, ln = fq * 16 + fr;
        float ssq[2][4];
#pragma unroll
        for (int bj = 0; bj < 2; ++bj) {
            const f32x4 gt0 = *(const PG8_GAS f32x4*)(gate + b * 6144 + colb + bj * HALF), gt1 = *(const PG8_GAS f32x4*)(gate + b * 6144 + colb + bj * HALF + 4);
#pragma unroll
            for (int ai = 0; ai < 2; ++ai)
#pragma unroll
                for (int m = 0; m < 4; ++m) { const size_t off = (size_t)(row0 + ai * HALF + m * 16) * 1024 + colb + bj * HALF;
                    const u32x4 rw = *(const PG8_GAS u32x4*)(R + ((size_t)(u.pm * 4 + u.pn) * 256 + (wr * 64 + fr + ai * HALF + m * 16)) * 256 + (wc * 32 + 8 * fq + bj * HALF));
                    const f32x4 x0 = bf_lo4(rw) + gt0 * acc[ai][bj][m][0], x1 = bf_hi4(rw) + gt1 * acc[ai][bj][m][1];
                    acc[ai][bj][m][0] = x0; acc[ai][bj][m][1] = x1;
                    const float q = (x0[0] * x0[0] + x0[1] * x0[1]) + (x0[2] * x0[2] + x0[3] * x0[3]) + (x1[0] * x1[0] + x1[1] * x1[1]) + (x1[2] * x1[2] + x1[3] * x1[3]);
                    ssq[ai][m] = (bj == 0) ? q : ssq[ai][m] + q;
                    asm volatile("" : "+v"(acc[ai][bj][m][0]), "+v"(acc[ai][bj][m][1]), "+v"(ssq[ai][m]));
                    if (m & 1) asm volatile("" ::: "memory"); }
        }
#pragma unroll
        for (int ai = 0; ai < 2; ++ai)
#pragma unroll
            for (int m = 0; m < 4; ++m) { float q = ssq[ai][m]; q += shx(q, 16, ln); q += shx(q, 32, ln);
                if (fq == 0) __hip_atomic_store(SS + (size_t)(row0 + ai * HALF + m * 16) * 16 + u.pn * 4 + wc, q, __ATOMIC_RELAXED, __HIP_MEMORY_SCOPE_AGENT); }
        asm volatile("s_waitcnt vmcnt(0)" ::: "memory");
        PG8_GAS unsigned* c = cnt + 64 * u.pm;
        if (ln == 0) (void)__hip_atomic_fetch_add(c, 1u, __ATOMIC_RELAXED, __HIP_MEMORY_SCOPE_AGENT);
        for (unsigned sp = 0; sp < (1u << 22); ++sp) { if ((unsigned)__builtin_amdgcn_readfirstlane((int)__hip_atomic_load(c, __ATOMIC_RELAXED, __HIP_MEMORY_SCOPE_AGENT)) >= 32u) break; __builtin_amdgcn_s_sleep(2); }
        int row1 = row0, colc = colb; asm volatile("" : "+v"(row1), "+v"(colc));
        float rs[2][4];
#pragma unroll
        for (int ai = 0; ai < 2; ++ai)
#pragma unroll
            for (int m = 0; m < 4; ++m) { const PG8_GAS float* sp4 = SS + (size_t)(row1 + ai * HALF + m * 16) * 16 + 4 * fq;
                float t = (__hip_atomic_load(sp4, __ATOMIC_RELAXED, __HIP_MEMORY_SCOPE_AGENT) + __hip_atomic_load(sp4 + 1, __ATOMIC_RELAXED, __HIP_MEMORY_SCOPE_AGENT))
                        + (__hip_atomic_load(sp4 + 2, __ATOMIC_RELAXED, __HIP_MEMORY_SCOPE_AGENT) + __hip_atomic_load(sp4 + 3, __ATOMIC_RELAXED, __HIP_MEMORY_SCOPE_AGENT));
                t += shx(t, 16, ln); t += shx(t, 32, ln); rs[ai][m] = rsqrtf(t * (1.0f / 1024.0f) + EPS_); }
#pragma unroll
        for (int bj = 0; bj < 2; ++bj) {
            const f32x4 g0 = *(const PG8_GAS f32x4*)(gfin + colc + bj * HALF), g1 = *(const PG8_GAS f32x4*)(gfin + colc + bj * HALF + 4);
#pragma unroll
            for (int ai = 0; ai < 2; ++ai)
#pragma unroll
                for (int m = 0; m < 4; ++m) { const size_t off = (size_t)(row1 + ai * HALF + m * 16) * 1024 + colc + bj * HALF;
                    *(PG8_GAS f32x4*)(OUT + off) = acc[ai][bj][m][0] * rs[ai][m] * g0; *(PG8_GAS f32x4*)(OUT + off + 4) = acc[ai][bj][m][1] * rs[ai][m] * g1; }
        }
    }
};

struct EpiUp {
    static constexpr bool PERM = true;
    static constexpr bool NEEDS_RSTD = true;
    const PG8_GAS float* SS; const PG8_GAS float* bias; PG8_GAS bf16_t* O; int ldc; PG8_LAS unsigned char* ldsb; int par;
    __device__ __forceinline__ void operator()(f32x4 (&acc)[2][2][4][2], const Unit& u, int wr, int wc, int fr, int fq) const {
        const int b = u.pm >> 5, colb = u.pn * BM + wc * 32 + 8 * fq, row0 = u.pm * BM + wr * 64 + fr;
        float rs[2][4];
#pragma unroll
        for (int ai = 0; ai < 2; ++ai)
#pragma unroll
            for (int m = 0; m < 4; ++m) rs[ai][m] = ((const PG8_LAS float*)(ldsb + RSTD_TAB_OFF + par * 1024))[wr * 64 + fr + ai * HALF + m * 16];
#pragma unroll
        for (int bj = 0; bj < 2; ++bj) {
            const f32x4 bv0 = *(const PG8_GAS f32x4*)(bias + (size_t)b * ldc + colb + bj * HALF), bv1 = *(const PG8_GAS f32x4*)(bias + (size_t)b * ldc + colb + bj * HALF + 4);
#pragma unroll
            for (int ai = 0; ai < 2; ++ai)
#pragma unroll
                for (int m = 0; m < 4; ++m) { f32x4 v0 = acc[ai][bj][m][0] * rs[ai][m] + bv0, v1 = acc[ai][bj][m][1] * rs[ai][m] + bv1;
#pragma unroll
                    for (int j = 0; j < 4; ++j) { v0[j] = fmaxf(v0[j], 0.f); v1[j] = fmaxf(v1[j], 0.f); }
                    v0 = v0 * v0; v1 = v1 * v1;
                    u32x4 w; w.x = cvt_pk_bf16(v0[0], v0[1]); w.y = cvt_pk_bf16(v0[2], v0[3]); w.z = cvt_pk_bf16(v1[0], v1[1]); w.w = cvt_pk_bf16(v1[2], v1[3]);
                    *(PG8_GAS u32x4*)(O + ((size_t)(u.pm * 16 + u.pn) * 256 + (wr * 64 + fr + ai * HALF + m * 16)) * 256 + (wc * 32 + 8 * fq + bj * HALF)) = w; }
        }
    }
};

struct EpiQKV {
    static constexpr bool PERM = true;
    static constexpr bool NEEDS_RSTD = true;
    const PG8_GAS float* SS; const PG8_GAS float* bias; PG8_GAS bf16_t* Q; size_t split_stride; PG8_GAS float* KMP; PG8_LAS unsigned char* ldsb; int par;
    __device__ __forceinline__ void operator()(f32x4 (&acc)[2][2][4][2], const Unit& u, int wr, int wc, int fr, int fq) const {
        const int b = u.pm >> 5, t = u.pn >> 2, colt = (u.pn & 3) * BM + wc * 32 + 8 * fq, colb = u.pn * BM + wc * 32 + 8 * fq, row0 = u.pm * BM + wr * 64 + fr;
        PG8_GAS bf16_t* base = Q + (size_t)t * split_stride; const float sc = (t == 0) ? C2_ : 1.0f;
        float rs[2][4];
#pragma unroll
        for (int ai = 0; ai < 2; ++ai)
#pragma unroll
            for (int m = 0; m < 4; ++m) rs[ai][m] = ((const PG8_LAS float*)(ldsb + RSTD_TAB_OFF + par * 1024))[wr * 64 + fr + ai * HALF + m * 16];
#pragma unroll
        for (int bj = 0; bj < 2; ++bj) {
            const f32x4 bv0 = *(const PG8_GAS f32x4*)(bias + (size_t)b * 3072 + colb + bj * HALF), bv1 = *(const PG8_GAS f32x4*)(bias + (size_t)b * 3072 + colb + bj * HALF + 4);
            f32x4 cs0 = {0.f, 0.f, 0.f, 0.f}, cs1 = cs0;
#pragma unroll
            for (int ai = 0; ai < 2; ++ai)
#pragma unroll
                for (int m = 0; m < 4; ++m) { f32x4 v0 = acc[ai][bj][m][0] * rs[ai][m] + bv0, v1 = acc[ai][bj][m][1] * rs[ai][m] + bv1;
                    cs0 += v0; cs1 += v1; v0 = v0 * sc; v1 = v1 * sc;
                    u32x4 w; w.x = cvt_pk_bf16(v0[0], v0[1]); w.y = cvt_pk_bf16(v0[2], v0[3]); w.z = cvt_pk_bf16(v1[0], v1[1]); w.w = cvt_pk_bf16(v1[2], v1[3]);
                    *(PG8_GAS u32x4*)(base + hm_off((size_t)(row0 + ai * HALF + m * 16), b, (colt + bj * HALF) >> 6) + ((colt + bj * HALF) & 63)) = w; }
            if (t == 1) {
#pragma unroll
                for (int o = 1; o < 16; o <<= 1) {
#pragma unroll
                    for (int j = 0; j < 4; ++j) { cs0[j] += shx(cs0[j], o, fq * 16 + fr); cs1[j] += shx(cs1[j], o, fq * 16 + fr); } }
                if (fr == 0) { PG8_GAS float* kp = KMP + ((size_t)u.pm * 2 + wr) * 1024 + colt + bj * HALF; *(f32x4*)kp = cs0; *(PG8_GAS f32x4*)(kp + 4) = cs1; }
            }
        }
    }
};

template <class Epi, class Sched, bool ALIGN_EPI>
__device__ __forceinline__ void gemm_phase(PG8_LAS unsigned char* lds, const Gemm g, const Sched& S, const Epi& E_, int wave_id) {
    Epi E = E_;
    int tid = wave_id * 64 + lane_id(); asm volatile("" : "+v"(tid));
    const int wid = __builtin_amdgcn_readfirstlane(tid >> 6), lane = tid & 63, wr = wid >> 2, wc = wid & 3, fr = lane & 15, fq = lane >> 4;
    const int K = g.K, nt = K / BK, lda = g.lda;
    unsigned voffA[2], voffB[2];
#pragma unroll
    for (int i = 0; i < 2; ++i) { int R, C; stage_rc(tid * 16 + i * 8192, R, C); const int Rb = Epi::PERM ? ((R & ~31) + perm32(R & 31)) : R;
        voffA[i] = (unsigned)(R * lda + C) * 2u; voffB[i] = (unsigned)(Rb * K + C) * 2u; }
    const size_t kstep = (size_t)(BK * 2);
    const size_t hstepA = (size_t)HALF * lda * 2, tstepA = (g.a_tileb == 512) ? 2 * hstepA : (size_t)(K / 256) * g.a_tileb, hstepB = (size_t)HALF * K * 2, tstepB = 2 * hstepB;
    const size_t tileb = (size_t)g.a_tileb;
#define PG8_KOFF(t) ((size_t)((t) >> 2) * tileb + (size_t)((t) & 3) * 128)
    const unsigned ldsw = (unsigned)wid * 1024u;
    const int aoff = lds_byte(wr * 64 + fr, fq * 8), boff = lds_byte(wc * 32 + fr, fq * 8);
#define PG8_SA(b, h) (((b) * 2 + (h)) * HTB)
#define PG8_SB(b, h) ((4 + (b) * 2 + (h)) * HTB)
#define PG8_STAGE(bufoff, gbase, voff) do { _Pragma("unroll") for (int _i = 0; _i < 2; ++_i) \
        __builtin_amdgcn_global_load_lds((const PG8_GAS unsigned*)((const PG8_GAS char*)(gbase) + (voff)[_i]), (PG8_LAS unsigned*)(lds + (bufoff) + ldsw + _i * 8192), 16, 0, 0); } while (0)
#define PG8_LDA(dst, b, h) do { _Pragma("unroll") for (int m = 0; m < 4; ++m) _Pragma("unroll") for (int k = 0; k < 2; ++k) dst[m][k] = *(const PG8_LAS bf16x8*)(lds + PG8_SA(b, h) + aoff + m * 2048 + k * 1024); } while (0)
#define PG8_LDB(dst, b, h) do { _Pragma("unroll") for (int n = 0; n < 2; ++n) _Pragma("unroll") for (int k = 0; k < 2; ++k) dst[n][k] = *(const PG8_LAS bf16x8*)(lds + PG8_SB(b, h) + boff + n * 2048 + k * 1024); } while (0)
#define PG8_MMA(ai, bj, At, Bt) do { __builtin_amdgcn_s_setprio(1); _Pragma("unroll") for (int m = 0; m < 4; ++m) _Pragma("unroll") for (int n = 0; n < 2; ++n) _Pragma("unroll") for (int k = 0; k < 2; ++k) \
        acc[ai][bj][m][n] = __builtin_amdgcn_mfma_f32_16x16x32_bf16(Bt[n][k], At[m][k], acc[ai][bj][m][n], 0, 0, 0); __builtin_amdgcn_s_setprio(0); } while (0)
#define PG8_WAIT_V(n) asm volatile("s_waitcnt vmcnt(" #n ")" ::: "memory")
#define PG8_WAIT_L(n) asm volatile("s_waitcnt lgkmcnt(" #n ")" ::: "memory")
#define PG8_BAR __builtin_amdgcn_s_barrier()
#define PG8_SCHED __builtin_amdgcn_sched_barrier(0)
    Unit cur, nxt; int ui = 0;
    if (!S.next(0, cur)) return;
    int rpar = 0;
    if constexpr (Epi::NEEDS_RSTD) { fill_rstd_tab(lds, 0, E.SS, cur.pm, wid, lane); E.par = 0; }
    f32x4 acc[2][2][4][2];
#pragma unroll
    for (int a = 0; a < 2; ++a)
#pragma unroll
        for (int b = 0; b < 2; ++b)
#pragma unroll
            for (int m = 0; m < 4; ++m)
#pragma unroll
                for (int n = 0; n < 2; ++n) acc[a][b][m][n] = (f32x4){0.f, 0.f, 0.f, 0.f};
    bf16x8 At[4][2], B0[2][2], B1[2][2];
    const PG8_GAS char* cA = (const PG8_GAS char*)g.A + (size_t)cur.pm * tstepA + (size_t)cur.pn * g.a_pn_off * 2; const PG8_GAS char* cB = (const PG8_GAS char*)g.Bt + (size_t)cur.pn * tstepB + (size_t)(cur.pm >> 5) * g.b_bstride;
    PG8_STAGE(PG8_SB(0, 0), cB, voffB); PG8_STAGE(PG8_SB(0, 1), cB + hstepB, voffB); PG8_STAGE(PG8_SA(0, 0), cA, voffA); PG8_STAGE(PG8_SA(0, 1), cA + hstepA, voffA);
    if (wr == 1) PG8_BAR;
    PG8_WAIT_V(2); PG8_BAR;
    PG8_STAGE(PG8_SB(1, 0), cB + kstep, voffB); PG8_STAGE(PG8_SA(1, 0), cA + kstep, voffA); PG8_STAGE(PG8_SB(1, 1), cB + hstepB + kstep, voffB);
    PG8_WAIT_V(6); PG8_BAR;
    for (;;) {
        const bool has_next = S.next(ui + 1, nxt);
        const PG8_GAS char* nA = has_next ? (const PG8_GAS char*)g.A + (size_t)nxt.pm * tstepA + (size_t)nxt.pn * g.a_pn_off * 2 : cA; const PG8_GAS char* nB = has_next ? (const PG8_GAS char*)g.Bt + (size_t)nxt.pn * tstepB + (size_t)(nxt.pm >> 5) * g.b_bstride : cB;
        for (int t = 0; t < nt; t += 2) {
            const bool last = (t == nt - 2);
            const PG8_GAS char* a1 = cA + PG8_KOFF(t + 1);
            const PG8_GAS char* a2 = last ? nA : cA + PG8_KOFF(t + 2); const PG8_GAS char* b2 = last ? nB : cB + (size_t)(t + 2) * kstep;
            const PG8_GAS char* a3 = a2 + kstep; const PG8_GAS char* b3 = b2 + kstep;
            PG8_LDB(B0, 0, 0); PG8_LDB(B1, 0, 1); PG8_SCHED; PG8_LDA(At, 0, 0); PG8_STAGE(PG8_SA(1, 1), a1 + hstepA, voffA);
            PG8_WAIT_V(8); PG8_WAIT_L(0); PG8_BAR; PG8_MMA(0, 0, At, B0); PG8_MMA(0, 1, At, B1); PG8_BAR; PG8_SCHED;
            PG8_LDA(At, 0, 1); PG8_STAGE(PG8_SB(0, 0), b2, voffB); PG8_STAGE(PG8_SB(0, 1), b2 + hstepB, voffB); PG8_STAGE(PG8_SA(0, 0), a2, voffA);
            PG8_WAIT_V(8); PG8_WAIT_L(0); PG8_BAR; PG8_MMA(1, 0, At, B0); PG8_MMA(1, 1, At, B1); PG8_BAR; PG8_SCHED;
            PG8_LDB(B0, 1, 0); PG8_LDB(B1, 1, 1); PG8_SCHED; PG8_LDA(At, 1, 0); PG8_STAGE(PG8_SA(0, 1), a2 + hstepA, voffA);
            PG8_WAIT_V(8); PG8_WAIT_L(0); PG8_BAR; PG8_MMA(0, 0, At, B0); PG8_MMA(0, 1, At, B1); PG8_BAR; PG8_SCHED;
            PG8_LDA(At, 1, 1); PG8_STAGE(PG8_SB(1, 0), b3, voffB); PG8_STAGE(PG8_SB(1, 1), b3 + hstepB, voffB); PG8_STAGE(PG8_SA(1, 0), a3, voffA);
            PG8_WAIT_V(8); PG8_WAIT_L(0); PG8_BAR; PG8_MMA(1, 0, At, B0); PG8_MMA(1, 1, At, B1); PG8_BAR; PG8_SCHED;
        }
        if constexpr (ALIGN_EPI) { if (wr == 0) PG8_BAR; }
        if constexpr (Epi::NEEDS_RSTD) E.par = rpar;
        E(acc, cur, wr, wc, fr, fq);
        if constexpr (Epi::NEEDS_RSTD) { if (has_next && nxt.pm != cur.pm) { rpar ^= 1; fill_rstd_tab(lds, rpar, E.SS, nxt.pm, wid, lane); } }
        if (!has_next) break;
#pragma unroll
        for (int a = 0; a < 2; ++a)
#pragma unroll
            for (int b = 0; b < 2; ++b)
#pragma unroll
                for (int m = 0; m < 4; ++m)
#pragma unroll
                    for (int n = 0; n < 2; ++n) acc[a][b][m][n] = (f32x4){0.f, 0.f, 0.f, 0.f};
        cur = nxt; cA = nA; cB = nB; ++ui;
        if constexpr (ALIGN_EPI) { if (wr == 1) PG8_BAR; }
    }
    PG8_WAIT_V(0);
    if constexpr (!ALIGN_EPI) { if (wr == 0) PG8_BAR; }
    PG8_BAR;
#undef PG8_KOFF
#undef PG8_SA
#undef PG8_SB
#undef PG8_STAGE
#undef PG8_LDA
#undef PG8_LDB
#undef PG8_MMA
#undef PG8_WAIT_V
#undef PG8_WAIT_L
#undef PG8_BAR
#undef PG8_SCHED
}
}

constexpr int NWAVES = 8;
constexpr int BATCH = 4, SEQ = 8192, D = 1024, NH = 16, HD = 64, FF = 4096, M = BATCH * SEQ, NQKV = 3 * D, NBLK = 32, BLK = 256;
constexpr float EPS = 1e-6f;
constexpr float LOG2E = 1.4426950408889634f;

constexpr size_t MiB = 1u << 20;
constexpr size_t WS_CTL = 0, CTL_ZERO_BYTES = 1 * MiB;
constexpr size_t WS_MOD = 1 * MiB;
constexpr size_t WS_BIAS_UP0 = WS_MOD + 256 * 1024;
constexpr size_t WS_BIAS_QKV = WS_BIAS_UP0 + 64 * 1024;
constexpr size_t WS_BIAS_UP1 = WS_BIAS_QKV + 64 * 1024;
constexpr size_t WS_KMP = 2 * MiB;
constexpr size_t WS_SS = 3 * MiB;
constexpr size_t WS_WPOOL = 6 * MiB, WS_WQKV = 8 * MiB, WS_WO = 14 * MiB, WS_WUP0 = 16 * MiB, WS_WUP1 = 24 * MiB, WS_WDN0 = 32 * MiB, WS_WDN1 = 40 * MiB;
constexpr size_t WS_XNA = 48 * MiB, WS_XNB = 112 * MiB;
constexpr size_t WS_WSUP0 = 112 * MiB, WS_WSUP1 = 144 * MiB;
constexpr size_t OUT_WSQKV = 96 * MiB;
constexpr size_t WS_HB = 176 * MiB;
constexpr size_t WS_Q = 176 * MiB, WS_K = 240 * MiB, WS_V = 304 * MiB;
constexpr size_t WS_PL = 496 * MiB;
constexpr size_t WS_CNT = 503 * MiB;
constexpr size_t WS_KBM = 503 * MiB + 512 * 1024;
constexpr size_t WS_POB = 48 * MiB;
constexpr size_t WS_SEG = 368 * MiB;
constexpr size_t WS_XR = 432 * MiB;
constexpr size_t WS_O = 368 * MiB;
constexpr size_t WS_DUMP = 504 * MiB;
constexpr size_t WS_END = 506 * MiB;
constexpr int CW_BAR = 4096;
constexpr int CW_FIN = 24576;
constexpr int CW_TOT = 16384;

constexpr int RING_OFF = 0, RING_BYTES = 131072;
constexpr int LDSCTL_OFF = RING_BYTES, MISC_OFF = LDSCTL_OFF + 320;
constexpr int LDS_BYTES = 151552;

#define GAS __attribute__((address_space(1)))
#define LAS __attribute__((address_space(3)))
typedef unsigned short bf16;
typedef unsigned v4u __attribute__((ext_vector_type(4)));
typedef unsigned v2u __attribute__((ext_vector_type(2)));
typedef float f32x4 __attribute__((ext_vector_type(4)));
typedef GAS unsigned gu32;
#define RLX_AGENT __ATOMIC_RELAXED, __HIP_MEMORY_SCOPE_AGENT
#define LDS_WAIT() asm volatile("s_waitcnt lgkmcnt(0)" ::: "memory")
__device__ __forceinline__ unsigned f2bf(float f) { unsigned u = __builtin_bit_cast(unsigned, f); return (u + 0x7fffu + ((u >> 16) & 1u)) >> 16; }
__device__ __forceinline__ unsigned pk2(float lo, float hi) { return f2bf(lo) | (f2bf(hi) << 16); }
__device__ __forceinline__ float bf2f(unsigned short v) { return __builtin_bit_cast(float, (unsigned)v << 16); }

#define XB_TMO      128
#define XB_XCNT(j)  (256  + 64 * (j))
#define XB_XSUB(j)  (1280 + 64 * (j))
#define XB_XGEN(j)  (2304 + 64 * (j))
#define XB_TOP      3328
#define XB_TOPGEN   3392
#define XCD_BAR_WORDS 3456
#define XB_SPIN_CAP (1u << 18)
__device__ __forceinline__ unsigned xb_ld(GAS unsigned* p)              { return __hip_atomic_load(p, __ATOMIC_RELAXED, __HIP_MEMORY_SCOPE_AGENT); }
__device__ __forceinline__ unsigned xb_add(GAS unsigned* p, unsigned v) { return __hip_atomic_fetch_add(p, v, __ATOMIC_RELAXED, __HIP_MEMORY_SCOPE_AGENT); }
__device__ __forceinline__ unsigned xb_xcc_id() { return (unsigned)__builtin_amdgcn_s_getreg((3 << 11) | 20) & 0xFu; }
#define XB_SPIN(cond, bar) do { unsigned _sp = 0; while (cond) { __builtin_amdgcn_s_sleep(1); \
    if ((++_sp & 255u) == 0u) { if (xb_ld(&(bar)[XB_TMO])) break; if (_sp > XB_SPIN_CAP) { (void)xb_add(&(bar)[XB_TMO], 1u); break; } } } } while (0)
struct XcdBarrier { GAS unsigned* bar; unsigned x; volatile LAS unsigned* st; int wave; };
__device__ __forceinline__ XcdBarrier xcd_barrier_post(GAS unsigned* bar, volatile LAS unsigned* st) {
    XcdBarrier b; b.bar = bar; b.x = xb_xcc_id(); b.st = st;
    if (threadIdx.x == 0) (void)xb_add(&bar[XB_XCNT(b.x)], 1u);
    return b;
}
__device__ __forceinline__ void xcd_barrier_complete(GAS unsigned* bar, unsigned x, unsigned& nloc, unsigned& nx) {
    const unsigned G = gridDim.x * gridDim.y * gridDim.z;
    unsigned sum, cnt, mine, sp = 0u;
    for (;;) {
        sum = 0u; cnt = 0u; mine = 0u;
#pragma unroll
        for (unsigned j = 0; j < 16; ++j) { const unsigned c = xb_ld(&bar[XB_XCNT(j)]); sum += c; cnt += (c > 0u) ? 1u : 0u; mine = (j == x) ? c : mine; }
        if (sum == G) break;
        __builtin_amdgcn_s_sleep(1);
        if ((++sp & 255u) == 0u) { if (xb_ld(&bar[XB_TMO])) break; if (sp > XB_SPIN_CAP) { (void)xb_add(&bar[XB_TMO], 1u); break; } }
    }
    nloc = mine > 0u ? mine : 1u; nx = cnt > 0u ? cnt : 1u;
}
__device__ __forceinline__ void xcd_barrier(const XcdBarrier& b) {
    asm volatile("s_waitcnt vmcnt(0)" ::: "memory");
    __syncthreads();
    if (b.wave == 0 && lane_id() == 0) {
        GAS unsigned* bar = b.bar; asm volatile("" : "+s"(bar));
        const unsigned bx = xb_xcc_id();
        __builtin_amdgcn_s_waitcnt(0);
        unsigned nloc = b.st[0], nx = b.st[1];
        if (nloc == 0u) { xcd_barrier_complete(bar, bx, nloc, nx); b.st[0] = nloc; b.st[1] = nx; }
        const unsigned old = xb_add(&bar[XB_XSUB(bx)], 1u);
        const unsigned gen = old / nloc;
        if (old + 1u == (gen + 1u) * nloc) {
            __builtin_amdgcn_fence(__ATOMIC_RELEASE, "agent");
            asm volatile("s_waitcnt vmcnt(0)" ::: "memory");
            const unsigned og = xb_add(&bar[XB_TOP], 1u);
            const unsigned tg = og / nx;
            if (og + 1u == (tg + 1u) * nx) xb_add(&bar[XB_TOPGEN], 1u);
            else XB_SPIN(xb_ld(&bar[XB_TOPGEN]) == tg, bar);
            __builtin_amdgcn_fence(__ATOMIC_ACQUIRE, "agent");
            xb_add(&bar[XB_XGEN(bx)], 1u);
            asm volatile("s_waitcnt vmcnt(0)" ::: "memory");
        } else {
            XB_SPIN(xb_ld(&bar[XB_XGEN(bx)]) == gen, bar);
            __builtin_amdgcn_fence(__ATOMIC_ACQUIRE, "agent");
            asm volatile("s_waitcnt vmcnt(0)" ::: "memory");
        }
    }
    __syncthreads();
}

struct Args { const GAS float* in[14]; GAS float* out; GAS unsigned char* ws; };
struct Frame {
    LAS unsigned char* lds; int tid, lane, wave, vcu, G;
    const GAS float *x, *c, *rel_bias, *w_mod, *b_mod, *norm_mix, *norm_mlp, *w_pool, *pool_scale, *w_qkv, *w_o, *w_up, *w_down, *norm_final;
    GAS float* out; GAS unsigned char* ws;
};
__device__ __forceinline__ float wave_sum(float v) {
#pragma unroll
    for (int o = 1; o < 64; o <<= 1) v += __shfl_xor(v, o);
    return v;
}

struct TItem { const GAS float* W; GAS bf16* WT; int K, N, row_off, item; };
__device__ __forceinline__ void tload(const TItem& I, f32x4 (&t)[8], int lane) {
    const int nblk = I.N / 32, kb = I.item / nblk, nb = I.item % nblk, k0 = 64 * kb, n0 = 32 * nb;
#pragma unroll
    for (int i = 0; i < 8; ++i) t[i] = *(const GAS f32x4*)(I.W + (size_t)(k0 + 8 * i + (lane >> 3)) * I.N + n0 + 4 * (lane & 7));
}
__device__ __forceinline__ void tstore(const TItem& I, const f32x4 (&t)[8], LAS float* scr, int lane) {
    const int nblk = I.N / 32, kb = I.item / nblk, nb = I.item % nblk, k0 = 64 * kb, n0 = 32 * nb;
#pragma unroll
    for (int i = 0; i < 8; ++i) { LAS float* d = scr + (8 * i + (lane >> 3)) * 33 + 4 * (lane & 7); d[0] = t[i][0]; d[1] = t[i][1]; d[2] = t[i][2]; d[3] = t[i][3]; }
    LDS_WAIT(); asm volatile("" ::: "memory");
    const int c = lane & 7;
#pragma unroll
    for (int j = 0; j < 4; ++j) { const int n = (lane >> 3) + 8 * j; const LAS float* s = scr + (8 * c) * 33 + n;
        v4u o; o.x = pk2(s[0 * 33], s[1 * 33]); o.y = pk2(s[2 * 33], s[3 * 33]); o.z = pk2(s[4 * 33], s[5 * 33]); o.w = pk2(s[6 * 33], s[7 * 33]);
        *(GAS v4u*)(I.WT + (size_t)(I.row_off + n0 + n) * I.K + k0 + 8 * c) = o; }
    LDS_WAIT(); asm volatile("" ::: "memory");
}
__device__ __forceinline__ void p0_prologue(Frame& F) {
    if (F.vcu < 192) {
        LAS float* cact = (LAS float*)(F.lds + 67584);
        LAS float* red = (LAS float*)(F.lds + 67584 + 16384);
        const int l = F.vcu / 96, j0 = (F.vcu % 96) * 64;
        for (int i = F.tid; i < 4096; i += NWAVES * 64) { const float v = F.c[i]; cact[i] = v / (1.f + __expf(-v)); }
        __syncthreads();
        const int sub = F.lane >> 4, c4 = F.lane & 15;
        f32x4 a0 = {0.f, 0.f, 0.f, 0.f}, a1 = a0, a2 = a0, a3 = a0;
        const GAS float* wb = F.w_mod + (size_t)l * 1024 * 6144 + j0 + 4 * c4;
#pragma unroll 4
        for (int it = 0; it < 32; ++it) { const int k = 32 * it + 4 * F.wave + sub; const f32x4 wv = *(const GAS f32x4*)(wb + (size_t)k * 6144);
            a0 += wv * cact[k]; a1 += wv * cact[1024 + k]; a2 += wv * cact[2048 + k]; a3 += wv * cact[3072 + k]; }
#pragma unroll
        for (int j = 0; j < 4; ++j) { a0[j] += __shfl_xor(a0[j], 16); a0[j] += __shfl_xor(a0[j], 32); a1[j] += __shfl_xor(a1[j], 16); a1[j] += __shfl_xor(a1[j], 32);
            a2[j] += __shfl_xor(a2[j], 16); a2[j] += __shfl_xor(a2[j], 32); a3[j] += __shfl_xor(a3[j], 16); a3[j] += __shfl_xor(a3[j], 32); }
        if (sub == 0) { LAS f32x4* r4 = (LAS f32x4*)(red + F.wave * 256); r4[0 * 16 + c4] = a0; r4[1 * 16 + c4] = a1; r4[2 * 16 + c4] = a2; r4[3 * 16 + c4] = a3; }
        __syncthreads();
        if (F.tid < 256) { const int b = F.tid >> 6, col = F.tid & 63; float s = 0.f;
#pragma unroll
            for (int w = 0; w < 8; ++w) s += red[w * 256 + b * 64 + col];
            ((GAS float*)(F.ws + WS_MOD))[(l * 4 + b) * 6144 + j0 + col] = s + F.b_mod[l * 6144 + j0 + col]; }
    }
    LAS float* scr = (LAS float*)(F.lds + RING_OFF + F.wave * 8448);
    const int gw = F.vcu * NWAVES + F.wave, NGW = F.G * NWAVES;
    constexpr int I_POOL = 4 * 32, I_QKV = 16 * 96, I_O = 16 * 32, I_UP = 16 * 128, I_DN = 64 * 32;
    constexpr int NITEMS = I_POOL + I_QKV + I_O + 2 * I_UP + 2 * I_DN;
    auto desc = [&](int it) -> TItem {
        int r = it;
        if (r < I_POOL) { const int g = r / 32; return TItem{F.w_pool + (size_t)g * 65536, (GAS bf16*)(F.ws + WS_WPOOL), 256, 256, g * 256, r % 32}; } r -= I_POOL;
        if (r < I_QKV) return TItem{F.w_qkv, (GAS bf16*)(F.ws + WS_WQKV), D, NQKV, 0, r}; r -= I_QKV;
        if (r < I_O) return TItem{F.w_o, (GAS bf16*)(F.ws + WS_WO), D, D, 0, r}; r -= I_O;
        if (r < 2 * I_UP) { const int l = r / I_UP; return TItem{F.w_up + (size_t)l * D * FF, (GAS bf16*)(F.ws + (l ? WS_WUP1 : WS_WUP0)), D, FF, 0, r % I_UP}; } r -= 2 * I_UP;
        const int l = r / I_DN; return TItem{F.w_down + (size_t)l * FF * D, (GAS bf16*)(F.ws + (l ? WS_WDN1 : WS_WDN0)), FF, D, 0, r % I_DN};
    };
    f32x4 ta[8], tb[8];
    int it = gw;
    if (it < NITEMS) { TItem cur = desc(it); tload(cur, ta, F.lane);
        for (;;) {
            const int itn = it + NGW; const bool hn = itn < NITEMS; TItem nxt = cur;
            if (hn) { nxt = desc(itn); tload(nxt, tb, F.lane); }
            tstore(cur, ta, scr, F.lane);
            if (!hn) break;
#pragma unroll
            for (int i = 0; i < 8; ++i) ta[i] = tb[i];
            cur = nxt; it = itn;
        } }
}

__device__ __forceinline__ void p1_bias(Frame& F) {
    const int gw = F.vcu * NWAVES + F.wave, NGW = F.G * NWAVES;
    const GAS float* MOD = (const GAS float*)(F.ws + WS_MOD);
    for (int it = gw; it < 4096 + 3072 + 4096; it += NGW) {
        const GAS bf16* wt; const GAS float* sh; GAS float* dst; int n, N; GAS bf16* wsc; const GAS float* gam;
        if (it < 4096) { n = it; N = 4096; wt = (const GAS bf16*)(F.ws + WS_WUP0); sh = MOD + 3072; dst = (GAS float*)(F.ws + WS_BIAS_UP0); wsc = (GAS bf16*)(F.ws + WS_WSUP0); gam = F.norm_mlp; }
        else if (it < 4096 + 3072) { n = it - 4096; N = 3072; wt = (const GAS bf16*)(F.ws + WS_WQKV); sh = MOD + 4 * 6144; dst = (GAS float*)(F.ws + WS_BIAS_QKV); wsc = (GAS bf16*)((GAS unsigned char*)F.out + OUT_WSQKV); gam = F.norm_mix + D; }
        else { n = it - 7168; N = 4096; wt = (const GAS bf16*)(F.ws + WS_WUP1); sh = MOD + 4 * 6144 + 3072; dst = (GAS float*)(F.ws + WS_BIAS_UP1); wsc = (GAS bf16*)(F.ws + WS_WSUP1); gam = F.norm_mlp + D; }
        const v4u w0 = *(const GAS v4u*)(wt + (size_t)n * 1024 + F.lane * 16), w1 = *(const GAS v4u*)(wt + (size_t)n * 1024 + F.lane * 16 + 8);
        float wf[16];
#pragma unroll
        for (int j = 0; j < 4; ++j) { wf[2 * j] = __builtin_bit_cast(float, w0[j] << 16); wf[2 * j + 1] = __builtin_bit_cast(float, w0[j] & 0xffff0000u);
            wf[8 + 2 * j] = __builtin_bit_cast(float, w1[j] << 16); wf[8 + 2 * j + 1] = __builtin_bit_cast(float, w1[j] & 0xffff0000u); }
#pragma unroll
        for (int b = 0; b < 4; ++b) { const GAS f32x4* sp = (const GAS f32x4*)(sh + b * 6144 + F.lane * 16); float s = 0.f;
#pragma unroll
            for (int j = 0; j < 4; ++j) { const f32x4 sv = sp[j]; s += wf[4 * j] * sv[0] + wf[4 * j + 1] * sv[1] + wf[4 * j + 2] * sv[2] + wf[4 * j + 3] * sv[3]; }
            s = wave_sum(s); if (F.lane == 0) dst[b * N + n] = s;
            const GAS f32x4* cp = (const GAS f32x4*)(sh + 1024 + b * 6144 + F.lane * 16); const GAS f32x4* gp = (const GAS f32x4*)(gam + F.lane * 16); unsigned pk[8];
#pragma unroll
            for (int j = 0; j < 4; ++j) { const f32x4 sv = cp[j], gv = gp[j];
                pk[2 * j] = pg8::cvt_pk_bf16(wf[4 * j] * (gv[0] * (1.0f + sv[0])), wf[4 * j + 1] * (gv[1] * (1.0f + sv[1]))); pk[2 * j + 1] = pg8::cvt_pk_bf16(wf[4 * j + 2] * (gv[2] * (1.0f + sv[2])), wf[4 * j + 3] * (gv[3] * (1.0f + sv[3]))); }
            GAS v4u* wp = (GAS v4u*)(wsc + ((size_t)b * N + n) * 1024 + F.lane * 16); wp[0] = (v4u){pk[0], pk[1], pk[2], pk[3]}; wp[1] = (v4u){pk[4], pk[5], pk[6], pk[7]}; }
    }
}
__device__ __forceinline__ void p1_pool(Frame& F) {
    LAS float* ring = (LAS float*)(F.lds + RING_OFF);
    const GAS float* MOD = (const GAS float*)(F.ws + WS_MOD); GAS bf16* XN = (GAS bf16*)(F.ws + WS_XNA); GAS bf16* XR = (GAS bf16*)(F.ws + WS_XR);
    for (int run = F.vcu; run < M / 128; run += F.G) {
        const int t0 = run * 128, s0 = t0 % SEQ, b = t0 / SEQ;
        f32x4 gam[4];
#pragma unroll
        for (int j = 0; j < 4; ++j) gam[j] = *(const GAS f32x4*)(F.norm_mix + 4 * (F.lane + 64 * j));
        const int c4 = F.tid & 255, rh = F.tid >> 8, gi = c4 >> 6, w = 2 << gi;
        const f32x4 sc1 = *(const GAS f32x4*)(MOD + b * 6144 + 1024 + 4 * c4) + 1.0f;
        f32x4 v[2][4];
        const GAS float* xb = F.x + (size_t)b * SEQ * D + 4 * F.lane;
        int st = (s0 > 0 ? -1 : 0);
#pragma unroll
        for (int rr = 0; rr < 2; ++rr)
#pragma unroll
            for (int j = 0; j < 4; ++j) v[rr][j] = *(const GAS f32x4*)(xb + (size_t)(s0 + 16 * st + 2 * F.wave + rr) * D + 256 * j);
        for (; st < 8; ++st) {
            if (st >= 0) {
#pragma unroll
                for (int rr = 0; rr < 2; ++rr)
#pragma unroll
                    for (int j = 0; j < 4; ++j) { v2u o2; o2.x = pk2(v[rr][j][0], v[rr][j][1]); o2.y = pk2(v[rr][j][2], v[rr][j][3]);
                        { const size_t trow = (size_t)b * SEQ + s0 + 16 * st + 2 * F.wave + rr; *(GAS v2u*)(XR + (((trow >> 8) * 4 + j) * 256 + (trow & 255)) * 256 + 4 * F.lane) = o2; } } }
            float ss0 = 0.f, ss1 = 0.f;
#pragma unroll
            for (int j = 0; j < 4; ++j) { ss0 += (v[0][j][0] * v[0][j][0] + v[0][j][1] * v[0][j][1]) + (v[0][j][2] * v[0][j][2] + v[0][j][3] * v[0][j][3]);
                ss1 += (v[1][j][0] * v[1][j][0] + v[1][j][1] * v[1][j][1]) + (v[1][j][2] * v[1][j][2] + v[1][j][3] * v[1][j][3]); }
#pragma unroll
            for (int o = 1; o < 64; o <<= 1) { ss0 += __shfl_xor(ss0, o); ss1 += __shfl_xor(ss1, o); }
            const float rs0 = rsqrtf(ss0 * (1.0f / D) + EPS), rs1 = rsqrtf(ss1 * (1.0f / D) + EPS);
            { const int sr = s0 + 16 * st + 2 * F.wave;
#pragma unroll
              for (int j = 0; j < 4; ++j) { *(LAS f32x4*)(ring + (sr & 31) * 1024 + 4 * (F.lane + 64 * j)) = v[0][j] * rs0 * gam[j]; *(LAS f32x4*)(ring + ((sr + 1) & 31) * 1024 + 4 * (F.lane + 64 * j)) = v[1][j] * rs1 * gam[j]; } }
            if (st + 1 < 8) {
#pragma unroll
                for (int rr = 0; rr < 2; ++rr)
#pragma unroll
                    for (int j = 0; j < 4; ++j) v[rr][j] = *(const GAS f32x4*)(xb + (size_t)(s0 + 16 * (st + 1) + 2 * F.wave + rr) * D + 256 * j); }
            __syncthreads();
            if (st >= 0) {
                const int sA = s0 + 16 * st + 8 * rh;
                f32x4 sum = {0.f, 0.f, 0.f, 0.f};
                { const int cnt0 = (sA < w) ? sA : w; for (int i = 1; i <= cnt0; ++i) sum += *(const LAS f32x4*)(ring + ((sA - i) & 31) * 1024 + 4 * c4); }
#pragma unroll
                for (int r = 0; r < 8; ++r) { const int s = sA + r; const f32x4 cur = *(const LAS f32x4*)(ring + (s & 31) * 1024 + 4 * c4);
                    sum += cur; if (s >= w) sum -= *(const LAS f32x4*)(ring + ((s - w) & 31) * 1024 + 4 * c4);
                    const float inv = 1.0f / (float)((s + 1 < w) ? s + 1 : w);
                    const f32x4 p = (sum * inv - cur) * sc1;
                    v2u o; o.x = pk2(p[0], p[1]); o.y = pk2(p[2], p[3]);
                    *(GAS v2u*)(XN + ((size_t)b * SEQ + s) * D + 4 * c4) = o; }
            }
            __syncthreads();
        }
    }
}

__device__ __forceinline__ int t5_bucket(int dist) {
    if (dist < 16) return dist;
    int b = 16;
    b += (dist >= 21); b += (dist >= 27); b += (dist >= 35); b += (dist >= 46); b += (dist >= 59); b += (dist >= 77); b += (dist >= 99); b += (dist >= 128);
    b += (dist >= 166); b += (dist >= 216); b += (dist >= 280); b += (dist >= 363); b += (dist >= 470); b += (dist >= 609); b += (dist >= 790);
    return b;
}
namespace att {
typedef short bf16x8 __attribute__((ext_vector_type(8)));
typedef short s16x4 __attribute__((ext_vector_type(4)));
typedef short v4i16_t __attribute__((ext_vector_type(4)));
typedef float f32x16 __attribute__((ext_vector_type(16)));
typedef float f32x2_t __attribute__((ext_vector_type(2)));
typedef __bf16 bf16x2_t __attribute__((ext_vector_type(2)));
typedef LAS const char* lds_cptr;
constexpr int L_K = 0, L_V = 32768, L_LUT = 132096, L_QI = 141312, L_CUM = 142336, L_PRE = 142592;
constexpr int LUTN = 2304;
__device__ __forceinline__ int crow(int r, int hi) { return (r & 3) + 8 * (r >> 2) + 4 * hi; }
__device__ __forceinline__ unsigned cvtpk(float lo, float hi) { f32x2_t v = {lo, hi}; bf16x2_t b = __builtin_convertvector(v, bf16x2_t); return __builtin_bit_cast(unsigned, b); }
__device__ __forceinline__ s16x4 vtr(lds_cptr p) { return __builtin_bit_cast(s16x4, __builtin_amdgcn_ds_read_tr16_b64_v4i16((LAS v4i16_t*)p)); }
__device__ __forceinline__ float swap_add(float v) { auto rr = __builtin_amdgcn_permlane32_swap(__float_as_uint(v), __float_as_uint(v), false, false); return __uint_as_float(rr[0]) + __uint_as_float(rr[1]); }

__device__ __forceinline__ void load_kv(LAS unsigned char* lds, const GAS bf16* Kb, const GAS bf16* Vb, int b, int h, int n, int w, int lane) {
#pragma unroll
    for (int t = 0; t < 4; ++t) {
        const size_t kr = (size_t)b * SEQ + n * BLK + 64 * t + lane, vr = (size_t)b * SEQ + n * BLK + 64 * t + 16 * (w & 3) + (lane >> 2);
        const v4u kv = *(const GAS v4u*)(Kb + hm_off(kr, b, h) + w * 8);
        const v4u vv = *(const GAS v4u*)(Vb + hm_off(vr, b, h) + (w >> 2) * 32 + (lane & 3) * 8);
        *(LAS v4u*)(lds + L_K + t * 8192 + w * 1024 + lane * 16) = kv;
        *(LAS v4u*)(lds + L_V + t * 8192 + w * 1024 + lane * 16) = vv;
    }
}
__device__ __forceinline__ void build_lut(LAS unsigned char* lds, const GAS float* rel_bias, int h, int tid) {
    for (int i = tid; i < LUTN; i += NWAVES * 64) ((LAS float*)(lds + L_LUT))[i] = (i <= 2047) ? rel_bias[t5_bucket(2047 - i) * NH + h] * LOG2E : 0.f;
}
__device__ __forceinline__ void qk_tile(f32x16& p0, f32x16& p1, lds_cptr Kt, const bf16x8* qr, const f32x16& cinit, int r32, int hi) {
    const unsigned kb0 = (unsigned)(r32 * 128 + ((hi ^ ((r32 >> 1) & 7)) * 16));
#pragma unroll
    for (int d0 = 0; d0 < 4; ++d0) {
        const bf16x8 b0 = *(LAS const bf16x8*)(Kt + (kb0 ^ (unsigned)(d0 * 32))), b1 = *(LAS const bf16x8*)(Kt + (kb0 ^ (unsigned)(d0 * 32)) + 4096);
        if (d0 == 0) { p0 = __builtin_amdgcn_mfma_f32_32x32x16_bf16(b0, qr[0], cinit, 0, 0, 0); p1 = __builtin_amdgcn_mfma_f32_32x32x16_bf16(b1, qr[0], cinit, 0, 0, 0); }
        else { p0 = __builtin_amdgcn_mfma_f32_32x32x16_bf16(b0, qr[d0], p0, 0, 0, 0); p1 = __builtin_amdgcn_mfma_f32_32x32x16_bf16(b1, qr[d0], p1, 0, 0, 0); }
    }
}
template <bool BIAS, bool MASK>
__device__ __forceinline__ void softmax_tile(f32x16& p0, f32x16& p1, LAS const float* lutp, int jt, int qrel, int hi, float& l, v4u* pa) {
#pragma unroll
    for (int r = 0; r < 16; ++r) { const int ko = 64 * jt + (r & 3) + 8 * (r >> 2);
        if (BIAS) { p0[r] += lutp[ko]; p1[r] += lutp[ko + 32]; }
        if (MASK) { const int kv = ko + 4 * hi; if (kv > qrel) p0[r] = -INFINITY; if (kv + 32 > qrel) p1[r] = -INFINITY; }
        p0[r] = __builtin_amdgcn_exp2f(p0[r]); p1[r] = __builtin_amdgcn_exp2f(p1[r]); }
    float s = 0.f;
#pragma unroll
    for (int r = 0; r < 16; ++r) s += p0[r] + p1[r];
    l += s;
    pa[0] = (v4u){cvtpk(p0[0], p0[1]), cvtpk(p0[2], p0[3]), cvtpk(p0[4], p0[5]), cvtpk(p0[6], p0[7])};
    pa[1] = (v4u){cvtpk(p0[8], p0[9]), cvtpk(p0[10], p0[11]), cvtpk(p0[12], p0[13]), cvtpk(p0[14], p0[15])};
    pa[2] = (v4u){cvtpk(p1[0], p1[1]), cvtpk(p1[2], p1[3]), cvtpk(p1[4], p1[5]), cvtpk(p1[6], p1[7])};
    pa[3] = (v4u){cvtpk(p1[8], p1[9]), cvtpk(p1[10], p1[11]), cvtpk(p1[12], p1[13]), cvtpk(p1[14], p1[15])};
}
__device__ __forceinline__ void pv_tile(f32x16* o, lds_cptr Vt, unsigned vo0, const v4u* pa) {
#pragma unroll
    for (int d0 = 0; d0 < 2; ++d0)
#pragma unroll
        for (int ks = 0; ks < 4; ++ks) { const s16x4 lo = vtr(Vt + (vo0 ^ (unsigned)(d0 * 64)) + ks * 2048), hi = vtr(Vt + (vo0 ^ (unsigned)(d0 * 64)) + ks * 2048 + 1024);
            const bf16x8 vf = (bf16x8){lo[0], lo[1], lo[2], lo[3], hi[0], hi[1], hi[2], hi[3]};
            o[d0] = __builtin_amdgcn_mfma_f32_32x32x16_bf16(vf, __builtin_bit_cast(bf16x8, pa[ks]), o[d0], 0, 0, 0); }
}
__device__ __forceinline__ void qk_half(f32x16& p, lds_cptr Kt, int s, const bf16x8* qr, const f32x16& cinit, int r32, int hi) {
    lds_cptr kb = Kt + hi * 1024 + r32 * 16 + s * 512;
#pragma unroll
    for (int d0 = 0; d0 < 4; ++d0) { const bf16x8 b0 = *(LAS const bf16x8*)(kb + d0 * 2048);
        if (d0 == 0) p = __builtin_amdgcn_mfma_f32_32x32x16_bf16(b0, qr[0], cinit, 0, 0, 0); else p = __builtin_amdgcn_mfma_f32_32x32x16_bf16(b0, qr[d0], p, 0, 0, 0); }
}
template <bool BIAS>
__device__ __forceinline__ void softmax_half(f32x16& p, LAS const float* lutp, int jt, int s, float& l, v4u& pa0, v4u& pa1) {
#pragma unroll
    for (int r = 0; r < 16; ++r) { const int ko = 64 * jt + 32 * s + (r & 3) + 8 * (r >> 2);
        if (BIAS) p[r] += lutp[ko];
        p[r] = __builtin_amdgcn_exp2f(p[r]); }
    float sm = 0.f;
#pragma unroll
    for (int r = 0; r < 16; ++r) sm += p[r];
    l += sm;
    pa0 = (v4u){cvtpk(p[0], p[1]), cvtpk(p[2], p[3]), cvtpk(p[4], p[5]), cvtpk(p[6], p[7])};
    pa1 = (v4u){cvtpk(p[8], p[9]), cvtpk(p[10], p[11]), cvtpk(p[12], p[13]), cvtpk(p[14], p[15])};
}
__device__ __forceinline__ void pv_half(f32x16* o, lds_cptr vp, int s, const v4u& pa0, const v4u& pa1) {
#pragma unroll
    for (int d0 = 0; d0 < 2; ++d0)
#pragma unroll
        for (int kk = 0; kk < 2; ++kk) { const int ks = 2 * s + kk; const s16x4 lo = vtr(vp + d0 * 4096 + ks * 1024), hi = vtr(vp + d0 * 4096 + ks * 1024 + 512);
            const bf16x8 vf = (bf16x8){lo[0], lo[1], lo[2], lo[3], hi[0], hi[1], hi[2], hi[3]};
            o[d0] = __builtin_amdgcn_mfma_f32_32x32x16_bf16(vf, __builtin_bit_cast(bf16x8, kk ? pa1 : pa0), o[d0], 0, 0, 0); }
}
struct SlotD { int kind, t, idx; };
__device__ __forceinline__ constexpr SlotD slot_desc(int g) {
    if (g < 4) return SlotD{0, 0, g};
    if (g < 8) return SlotD{0, 1, g - 4};
    if (g < 56) { const int tt = (g - 8) / 8 + 1, i = (g - 8) % 8; return (i & 1) ? SlotD{1, tt - 1, i >> 1} : SlotD{0, tt + 1, i >> 1}; }
    if (g < 60) return SlotD{1, 6, g - 56};
    return SlotD{1, 7, g - 60};
}
template <bool BIAS>
struct TileMath {
    f32x16 P[2]; unsigned pk[2][8]; v4u fr[3]; f32x2_t lv[4]; float e0, e1, l0, l1;
    f32x16* o; lds_cptr Kl, Vl; unsigned kb0, vo0; const bf16x8* qr; const f32x16* cinit; LAS const float* lutp;
    template <int G> __device__ __forceinline__ v4u load_frag() { constexpr SlotD d = slot_desc(G);
        if (d.kind == 0) return *(LAS const v4u*)(Kl + (kb0 ^ (unsigned)(d.idx * 32)) + (d.t >> 1) * 8192 + (d.t & 1) * 4096);
        constexpr int d0 = d.idx >> 1, ks = 2 * (d.t & 1) + (d.idx & 1); lds_cptr vp = Vl + (vo0 ^ (unsigned)(d0 * 64)) + (d.t >> 1) * 8192 + ks * 2048;
        const s16x4 a = vtr(vp), c = vtr(vp + 1024); return __builtin_bit_cast(v4u, (bf16x8){a[0], a[1], a[2], a[3], c[0], c[1], c[2], c[3]}); }
    template <int Q> __device__ __forceinline__ f32x2_t lut_pair() { constexpr int t = Q >> 3, r0 = 2 * (Q & 7), ko = 64 * (t >> 1) + 32 * (t & 1) + (r0 & 3) + 8 * (r0 >> 2); return (f32x2_t){lutp[ko], lutp[ko + 1]}; }
    template <int Q> __device__ __forceinline__ void chunk() { constexpr int t = Q >> 3, c = Q & 7;
        if constexpr (Q > 0) { l0 += e0; l1 += e1; pk[((Q - 1) >> 3) & 1][(Q - 1) & 7] = cvtpk(e0, e1); }
        float x0 = P[t & 1][2 * c], x1 = P[t & 1][2 * c + 1];
        if constexpr (BIAS) { x0 += lv[Q & 3][0]; x1 += lv[Q & 3][1]; if constexpr (Q + 3 < 64) lv[(Q + 3) & 3] = lut_pair<Q + 3>(); }
        e0 = __builtin_amdgcn_exp2f(x0); e1 = __builtin_amdgcn_exp2f(x1); }
    template <int G> __device__ __forceinline__ void slot() {
        if constexpr (G + 2 < 64) fr[(G + 2) % 3] = load_frag<G + 2>();
        { constexpr SlotD d = slot_desc(G); const bf16x8 a = __builtin_bit_cast(bf16x8, fr[G % 3]);
          if constexpr (d.kind == 0) { if constexpr (d.idx == 0) P[d.t & 1] = __builtin_amdgcn_mfma_f32_32x32x16_bf16(a, qr[0], *cinit, 0, 0, 0); else P[d.t & 1] = __builtin_amdgcn_mfma_f32_32x32x16_bf16(a, qr[d.idx], P[d.t & 1], 0, 0, 0); }
          else { constexpr int d0 = d.idx >> 1, kk = d.idx & 1;
              o[d0] = __builtin_amdgcn_mfma_f32_32x32x16_bf16(a, __builtin_bit_cast(bf16x8, (v4u){pk[d.t & 1][4 * kk], pk[d.t & 1][4 * kk + 1], pk[d.t & 1][4 * kk + 2], pk[d.t & 1][4 * kk + 3]}), o[d0], 0, 0, 0); } }
        if constexpr (G >= 4 && G < 8) { chunk<2 * (G - 4)>(); chunk<2 * (G - 4) + 1>(); }
        else if constexpr (G >= 8 && G < 56) chunk<G>();
        else if constexpr (G >= 56 && G < 60) { chunk<56 + 2 * (G - 56)>(); chunk<56 + 2 * (G - 56) + 1>(); if constexpr (G == 59) { l0 += e0; l1 += e1; pk[1][7] = cvtpk(e0, e1); } }
        __builtin_amdgcn_sched_barrier(0);
    }
    template <int... G> __device__ __forceinline__ void run(std::integer_sequence<int, G...>) { (slot<G>(), ...); }
};
template <bool BIAS>
__device__ __forceinline__ void tile_math(f32x16* o, float& l, lds_cptr Kl, lds_cptr Vl, unsigned vo0, const bf16x8* qr, const f32x16& cinit, LAS const float* lutp, int r32, int hi) {
    TileMath<BIAS> T; T.o = o; T.Kl = Kl; T.kb0 = (unsigned)(r32 * 128 + ((hi ^ ((r32 >> 1) & 7)) * 16)); T.Vl = Vl; T.vo0 = vo0; T.qr = qr; T.cinit = &cinit; T.lutp = lutp; T.e0 = T.e1 = T.l0 = T.l1 = 0.f;
    if constexpr (BIAS) { T.lv[0] = T.template lut_pair<0>(); T.lv[1] = T.template lut_pair<1>(); T.lv[2] = T.template lut_pair<2>(); }
    T.fr[0] = T.template load_frag<0>(); T.fr[1] = T.template load_frag<1>();
    __builtin_amdgcn_sched_barrier(0);
    T.run(std::make_integer_sequence<int, 64>{});
    l += T.l0 + T.l1;
}
__device__ __forceinline__ void load_q_raw(bf16x8* qr, const GAS bf16* Qb, size_t qrow, int b, int h, int hi) {
#pragma unroll
    for (int d0 = 0; d0 < 4; ++d0) { const v4u v = *(const GAS v4u*)(Qb + hm_off(qrow, b, h) + d0 * 16 + hi * 8); qr[d0] = __builtin_bit_cast(bf16x8, v); }
}
__device__ __forceinline__ float q_norm2(const bf16x8* qr) {
    float q2 = 0.f;
#pragma unroll
    for (int d0 = 0; d0 < 4; ++d0) { const v4u v = __builtin_bit_cast(v4u, qr[d0]);
#pragma unroll
        for (int j = 0; j < 4; ++j) { const float a = __builtin_bit_cast(float, v[j] << 16), c = __builtin_bit_cast(float, v[j] & 0xffff0000u); q2 += a * a + c * c; } }
    return swap_add(q2);
}

__device__ __forceinline__ float ref_exponent(float q2, float kmax2, float bmax) { return __builtin_sqrtf(q2 * kmax2) * 1.002f + bmax + 0.01f; }
__device__ __forceinline__ void head_bounds(const GAS float* KBM, const GAS float* rel_bias, int bh, int h, int lane, float& kmax2, float& bmax) {
    float k = KBM[bh * 32 + (lane & 31)], bb = rel_bias[(lane & 31) * NH + h] * LOG2E;
#pragma unroll
    for (int o = 1; o < 32; o <<= 1) { k = fmaxf(k, shx(k, o, lane)); bb = fmaxf(bb, shx(bb, o, lane)); }
    kmax2 = k; bmax = bb;
}
__device__ __forceinline__ void store_row(GAS bf16* rowp, const f32x16* o, float scale, int hi, bool act) {
    unsigned w0[8], w1[8];
#pragma unroll
    for (int k = 0; k < 4; ++k) { w0[2 * k] = cvtpk(o[0][4 * k] * scale, o[0][4 * k + 1] * scale); w0[2 * k + 1] = cvtpk(o[0][4 * k + 2] * scale, o[0][4 * k + 3] * scale);
        w1[2 * k] = cvtpk(o[1][4 * k] * scale, o[1][4 * k + 1] * scale); w1[2 * k + 1] = cvtpk(o[1][4 * k + 2] * scale, o[1][4 * k + 3] * scale); }
#pragma unroll
    for (int i = 0; i < 8; ++i) { auto r = __builtin_amdgcn_permlane32_swap(w0[i], w1[i], false, false); w0[i] = r[0]; w1[i] = r[1]; }
    if (act) {
#pragma unroll
        for (int k = 0; k < 4; ++k) *(GAS v4u*)(rowp + 32 * hi + 8 * k) = (v4u){w0[2 * k], w0[2 * k + 1], w1[2 * k], w1[2 * k + 1]}; }
}
__device__ __forceinline__ void add_row(f32x16* o, const GAS bf16* rowp, int hi) {
    v4u v[4];
#pragma unroll
    for (int k = 0; k < 4; ++k) v[k] = *(const GAS v4u*)(rowp + 32 * hi + 8 * k);
#pragma unroll
    for (int k = 0; k < 4; ++k) { auto r0 = __builtin_amdgcn_permlane32_swap(v[k][0], v[k][2], false, false); auto r1 = __builtin_amdgcn_permlane32_swap(v[k][1], v[k][3], false, false);
        o[0][4 * k] += __builtin_bit_cast(float, r0[0] << 16); o[0][4 * k + 1] += __builtin_bit_cast(float, r0[0] & 0xffff0000u);
        o[0][4 * k + 2] += __builtin_bit_cast(float, r1[0] << 16); o[0][4 * k + 3] += __builtin_bit_cast(float, r1[0] & 0xffff0000u);
        o[1][4 * k] += __builtin_bit_cast(float, r0[1] << 16); o[1][4 * k + 1] += __builtin_bit_cast(float, r0[1] & 0xffff0000u);
        o[1][4 * k + 2] += __builtin_bit_cast(float, r1[1] << 16); o[1][4 * k + 3] += __builtin_bit_cast(float, r1[1] & 0xffff0000u); }
}
__device__ __forceinline__ GAS bf16* po_row(GAS unsigned char* ws, GAS float* outbuf, int b, int h, int t, int slot) {
    return (b < 2 ? (GAS bf16*)outbuf : (GAS bf16*)(ws + WS_POB)) + ((((size_t)((b & 1) * 16 + h) * SEQ + t) * 3 + slot) * 64);
}

__device__ __forceinline__ void glds16(const GAS void* gsrc, unsigned lds_dst) {
    unsigned keep;
    asm volatile("s_mov_b32 %0, m0\n\ts_mov_b32 m0, %2\n\ts_nop 0\n\tglobal_load_lds_dwordx4 %1, off\n\ts_mov_b32 m0, %0" : "=&s"(keep) : "v"(gsrc), "s"(lds_dst) : "memory");
}
struct Top3 { float g1, g2, g3; int i1, i2, i3; };
__device__ __forceinline__ void top3_insert(Top3& T, float g, int n) {
    const bool c1 = g > T.g1, c2 = g > T.g2, c3 = g > T.g3;
    T.g3 = c2 ? T.g2 : (c3 ? g : T.g3); T.i3 = c2 ? T.i2 : (c3 ? n : T.i3);
    T.g2 = c1 ? T.g1 : (c2 ? g : T.g2); T.i2 = c1 ? T.i1 : (c2 ? n : T.i2);
    T.g1 = c1 ? g : T.g1;               T.i1 = c1 ? n : T.i1;
}
__device__ __forceinline__ void top3_insert_tie(Top3& T, float g, int n) {
    const bool ok = n >= 0;
    const bool c1 = ok && (g > T.g1 || (g == T.g1 && n < T.i1) || T.i1 < 0), c2 = ok && (g > T.g2 || (g == T.g2 && n < T.i2) || T.i2 < 0), c3 = ok && (g > T.g3 || (g == T.g3 && n < T.i3) || T.i3 < 0);
    T.g3 = c2 ? T.g2 : (c3 ? g : T.g3); T.i3 = c2 ? T.i2 : (c3 ? n : T.i3);
    T.g2 = c1 ? T.g1 : (c2 ? g : T.g2); T.i2 = c1 ? T.i1 : (c2 ? n : T.i2);
    T.g1 = c1 ? g : T.g1;               T.i1 = c1 ? n : T.i1;
}
__device__ __forceinline__ void route(Frame& F) {
    GAS unsigned char* ws = F.ws;
    const GAS bf16* Qb = (const GAS bf16*)(ws + WS_Q); const GAS bf16* Kb = (const GAS bf16*)(ws + WS_K);
    const GAS float* KMP = (const GAS float*)(ws + WS_KMP);
    GAS unsigned short* SEG = (GAS unsigned short*)(ws + WS_SEG); GAS unsigned* CNT = (GAS unsigned*)(ws + WS_CNT); GAS unsigned* TOT = (GAS unsigned*)(ws + WS_CTL) + CW_TOT;
    GAS float* KBM = (GAS float*)(ws + WS_KBM);
    int tid = F.wave * 64 + lane_id(); asm volatile("" : "+v"(tid));
    const int hf = tid >> 8, t = tid & 255, lane = tid & 63, w4 = __builtin_amdgcn_readfirstlane((tid >> 6) & 3), r32 = lane & 31, hi = lane >> 5;
    constexpr int HS = 20480;
    LAS unsigned char* hb = F.lds + __builtin_amdgcn_readfirstlane(hf) * HS;
    LAS unsigned* cntw = (LAS unsigned*)(hb + 16384);
    LAS float* kbw = (LAS float*)(hb + 16384 + 512);
    const int ua = (F.vcu * 2 + hf) >> 6, bh = (F.vcu * 2 + hf) & 63, b = bh >> 4, h = bh & 15;
    auto own_of = [&](int it) -> int { return it == 0 ? ua : it == 1 ? 31 - ua : it == 2 ? 8 + ua : 23 - ua; };
    v4u kreg[8]; float kmreg[8]; bf16x8 qf[2][4];
    auto prefetch = [&](int own) {
        const size_t row0 = (size_t)b * SEQ + own * BLK + 64 * w4;
#pragma unroll
        for (int tq = 0; tq < 2; ++tq)
#pragma unroll
            for (int d0 = 0; d0 < 4; ++d0) qf[tq][d0] = __builtin_bit_cast(bf16x8, *(const GAS v4u*)(Qb + hm_off(row0 + 32 * tq + r32, b, h) + d0 * 16 + hi * 8));
#pragma unroll
        for (int i = 0; i < 8; ++i) kreg[i] = *(const GAS v4u*)(Kb + hm_off(row0 + 8 * i, b, h) + lane * 8);
#pragma unroll
        for (int j = 0; j < 8; ++j) { const int i = t + 256 * j, n = i >> 6, d = i & 63; const size_t o = ((size_t)(b * 32 + n) * 2) * 1024 + h * 64 + d; kmreg[j] = (KMP[o] + KMP[o + 1024]) * (1.0f / 256.0f); }
    };
    prefetch(own_of(0));
    const unsigned fro = (unsigned)(r32 * 128), swz = (unsigned)((r32 >> 1) & 7);
#pragma unroll 1
    for (int it = 0; it < 4; ++it) {
        const int own = own_of(it);
        LAS unsigned char* kmh = hb + (it & 1) * 8192; LAS unsigned char* kml = kmh + 4096;
#pragma unroll
        for (int j = 0; j < 8; ++j) { const int i = t + 256 * j, n = i >> 6, d = i & 63; const float x = kmreg[j];
            const unsigned xb = __builtin_bit_cast(unsigned, x), hb16 = (xb + 0x7fffu + ((xb >> 16) & 1u)) >> 16; const float xh = __builtin_bit_cast(float, hb16 << 16), xl = x - xh;
            const unsigned lb = __builtin_bit_cast(unsigned, xl), lb16 = (lb + 0x7fffu + ((lb >> 16) & 1u)) >> 16;
            const int pos = n * 128 + (((d >> 3) ^ ((n >> 1) & 7)) * 16) + (d & 7) * 2;
            *(LAS unsigned short*)(kmh + pos) = (unsigned short)hb16; *(LAS unsigned short*)(kml + pos) = (unsigned short)lb16; }
        { float k2 = 0.f;
#pragma unroll
          for (int i = 0; i < 8; ++i) { float r2 = 0.f;
#pragma unroll
              for (int j = 0; j < 4; ++j) { const float a = __builtin_bit_cast(float, kreg[i][j] << 16), c = __builtin_bit_cast(float, kreg[i][j] & 0xffff0000u); r2 += a * a + c * c; }
              r2 += shx(r2, 1, lane); r2 += shx(r2, 2, lane); r2 += shx(r2, 4, lane); k2 = fmaxf(k2, r2); }
          k2 = fmaxf(k2, shx(k2, 8, lane)); k2 = fmaxf(k2, shx(k2, 16, lane)); k2 = fmaxf(k2, shx(k2, 32, lane));
          if (lane == 0) kbw[(it & 1) * 4 + w4] = k2; }
        bf16x8 qc[2][4];
#pragma unroll
        for (int tq = 0; tq < 2; ++tq)
#pragma unroll
            for (int d0 = 0; d0 < 4; ++d0) qc[tq][d0] = qf[tq][d0];
        __syncthreads();
        if (it < 3) prefetch(own_of(it + 1));
        f32x16 acc[2]; acc[0] = f32x16{}; acc[1] = f32x16{};
#pragma unroll
        for (int d0 = 0; d0 < 4; ++d0) { const unsigned co = ((unsigned)(2 * d0 + hi) ^ swz) * 16;
            const bf16x8 ah = *(const LAS bf16x8*)(kmh + fro + co), al = *(const LAS bf16x8*)(kml + fro + co);
#pragma unroll
            for (int tq = 0; tq < 2; ++tq) { acc[tq] = __builtin_amdgcn_mfma_f32_32x32x16_bf16(ah, qc[tq][d0], acc[tq], 0, 0, 0); acc[tq] = __builtin_amdgcn_mfma_f32_32x32x16_bf16(al, qc[tq][d0], acc[tq], 0, 0, 0); } }
        Top3 R;
#pragma unroll
        for (int tq = 0; tq < 2; ++tq) { Top3 T{-INFINITY, -INFINITY, -INFINITY, -1, -1, -1};
#pragma unroll
            for (int r = 0; r < 16; ++r) { const int n = crow(r, hi); const float g = acc[tq][r]; top3_insert(T, n < own ? g : -INFINITY, n < own ? n : -1); }
            Top3 P; { auto x1 = __builtin_amdgcn_permlane32_swap(__float_as_uint(T.g1), __float_as_uint(T.g1), false, false); P.g1 = __uint_as_float(hi ? x1[0] : x1[1]);
                      auto x2 = __builtin_amdgcn_permlane32_swap(__float_as_uint(T.g2), __float_as_uint(T.g2), false, false); P.g2 = __uint_as_float(hi ? x2[0] : x2[1]);
                      auto x3 = __builtin_amdgcn_permlane32_swap(__float_as_uint(T.g3), __float_as_uint(T.g3), false, false); P.g3 = __uint_as_float(hi ? x3[0] : x3[1]);
                      auto y1 = __builtin_amdgcn_permlane32_swap((unsigned)T.i1, (unsigned)T.i1, false, false); P.i1 = (int)(hi ? y1[0] : y1[1]);
                      auto y2 = __builtin_amdgcn_permlane32_swap((unsigned)T.i2, (unsigned)T.i2, false, false); P.i2 = (int)(hi ? y2[0] : y2[1]);
                      auto y3 = __builtin_amdgcn_permlane32_swap((unsigned)T.i3, (unsigned)T.i3, false, false); P.i3 = (int)(hi ? y3[0] : y3[1]); }
            top3_insert_tie(T, P.g1, P.i1); top3_insert_tie(T, P.g2, P.i2); top3_insert_tie(T, P.g3, P.i3);
            if (tq == hi) R = T; }
        const int i1 = R.i1, i2 = R.i2, i3 = R.i3;
        unsigned rk1 = 0, rk2 = 0, rk3 = 0;
        for (int n = 0; n < own; ++n) { const bool h1 = i1 == n, h2 = i2 == n, h3 = i3 == n; const unsigned long long mm = __ballot(h1 || h2 || h3);
            const unsigned rank = __builtin_amdgcn_mbcnt_hi((unsigned)(mm >> 32), __builtin_amdgcn_mbcnt_lo((unsigned)mm, 0u));
            rk1 = h1 ? rank : rk1; rk2 = h2 ? rank : rk2; rk3 = h3 ? rank : rk3;
            if (lane == 0) cntw[w4 * 32 + n] = (unsigned)__popcll(mm); }
        __syncthreads();
#pragma unroll
        for (int sl = 0; sl < 3; ++sl) { const int n = sl == 0 ? i1 : sl == 1 ? i2 : i3; const unsigned rk = sl == 0 ? rk1 : sl == 1 ? rk2 : rk3;
            const int nn = n & 31; unsigned base = 0;
#pragma unroll
            for (int w = 0; w < 3; ++w) { const unsigned v = cntw[w * 32 + nn]; base += (w < w4) ? v : 0u; }
            if (n >= 0) SEG[(((size_t)bh * 32 + own) * 32 + n) * 256 + base + rk] = (unsigned short)(t | (sl << 8)); }
        if (t < own) { const unsigned c = cntw[t] + cntw[32 + t] + cntw[64 + t] + cntw[96 + t]; CNT[((size_t)bh * 32 + own) * 32 + t] = c; (void)__hip_atomic_fetch_add(TOT + bh * 31 + t, c, RLX_AGENT); }
        if (t == 0) KBM[bh * 32 + own] = fmaxf(fmaxf(kbw[(it & 1) * 4], kbw[(it & 1) * 4 + 1]), fmaxf(kbw[(it & 1) * 4 + 2], kbw[(it & 1) * 4 + 3]));
    }
    asm volatile("s_waitcnt vmcnt(0)" ::: "memory");
    __syncthreads();
}

struct GTile { unsigned info; bf16x8 qr[4]; };
struct GRun { int e, c0, c1; };
__device__ __forceinline__ void dma_kv(LAS unsigned char* kv, const GAS bf16* Kb, const GAS bf16* Vb, int b, int h, int n, int w, int lane) {
#pragma unroll
    for (int t = 0; t < 4; ++t) {
        const size_t kr = (size_t)b * SEQ + n * BLK + 64 * t + 8 * w + (lane >> 3), vr = (size_t)b * SEQ + n * BLK + 64 * t + 16 * (w & 3) + (lane >> 2);
        __builtin_amdgcn_global_load_lds((const GAS unsigned*)(Kb + hm_off(kr, b, h) + (((lane & 7) ^ ((4 * w + (lane >> 4)) & 7)) * 8)), (LAS unsigned*)(kv + L_K + t * 8192 + w * 1024), 16, 0, 0);
        __builtin_amdgcn_global_load_lds((const GAS unsigned*)(Vb + hm_off(kr, b, h) + ((((lane >> 2) & 1) ^ ((lane >> 4) & 1)) * 32) + (lane & 3) * 8), (LAS unsigned*)(kv + L_V + t * 8192 + w * 1024), 16, 0, 0);
    }
}
__device__ __forceinline__ void gather(Frame& F) {
    GAS unsigned char* ws = F.ws;
    const GAS bf16* Qb = (const GAS bf16*)(ws + WS_Q); const GAS bf16* Kb = (const GAS bf16*)(ws + WS_K); const GAS bf16* Vb = (const GAS bf16*)(ws + WS_V);
    const GAS unsigned short* SEG = (const GAS unsigned short*)(ws + WS_SEG); const GAS unsigned* CNT = (const GAS unsigned*)(ws + WS_CNT); const GAS unsigned* TOT = (const GAS unsigned*)(ws + WS_CTL) + CW_TOT;
    const GAS float* KBM = (const GAS float*)(ws + WS_KBM); GAS float* PL = (GAS float*)(ws + WS_PL);
    int tid = F.wave * 64 + lane_id(); asm volatile("" : "+v"(tid));
    const int lane = tid & 63, w = __builtin_amdgcn_readfirstlane(tid >> 6), r32 = lane & 31, hi = lane >> 5;
    LAS unsigned* pre = (LAS unsigned*)(F.lds + L_PRE);
    __syncthreads();
    if (w == 0) { unsigned loc = 0;
        for (int i = 0; i < 31; ++i) { const unsigned nc = (TOT[31 * lane + i] + 255u) >> 8; loc += nc + (nc ? 1u : 0u); }
        unsigned inc = loc;
#pragma unroll
        for (int o = 1; o < 64; o <<= 1) { const unsigned v = shup(inc, o, lane); if (lane >= o) inc += v; }
        unsigned run = inc - loc;
        for (int i = 0; i < 31; ++i) { pre[31 * lane + i] = run; const unsigned nc = (TOT[31 * lane + i] + 255u) >> 8; run += nc + (nc ? 1u : 0u); }
        if (lane == 63) pre[1984] = run; }
    __syncthreads();
    const int U = (int)pre[1984];
    int p = (int)(((long)F.vcu * U) / F.G); const int phi = (int)(((long)(F.vcu + 1) * U) / F.G);
    int e = 0; { int lo = 0, hi2 = 1984; while (hi2 - lo > 1) { const int mid = (lo + hi2) >> 1; if ((int)pre[mid] <= p) lo = mid; else hi2 = mid; } e = lo; }
    auto next_run = [&](GRun& R) -> bool {
        while (p < phi) {
            while (p >= (int)pre[e + 1]) ++e;
            const int k = p - (int)pre[e], nch = (int)pre[e + 1] - (int)pre[e] - 1;
            const int c0 = k > 0 ? k - 1 : 0; int c1 = phi - (int)pre[e] - 1; c1 = c1 < nch ? c1 : nch;
            p = (int)pre[e] + 1 + c1;
            if (c1 > c0) { R.e = e; R.c0 = c0; R.c1 = c1; return true; }
        }
        return false;
    };
    auto scan_cnt = [&](unsigned v) -> unsigned { unsigned inc = v;
#pragma unroll
        for (int o = 1; o < 32; o <<= 1) { const unsigned t2 = shup(inc, o, lane); if ((lane & 31) >= o) inc += t2; }
        return inc; };
    int cur_h = -1, cur_bh = -1, rb = 0; float kmax2 = 0.f, bmax = 0.f, rb31 = 0.f;
    GRun cur, nxt; bool hc = next_run(cur);
    unsigned cntN = 0, totN = 0, cumv = 0, tot = 0;
    if (hc) { const int bh = cur.e / 31, n = cur.e - bh * 31; dma_kv(F.lds, Kb, Vb, bh >> 4, bh & 15, n, w, lane);
        cntN = ((lane & 31) > n) ? CNT[((size_t)bh * 32 + (lane & 31)) * 32 + n] : 0u; totN = TOT[cur.e]; }
    GTile tcur, tnxt; unsigned ownB = 0, entB = 0xffffffffu; bool mine = false;
    auto fetch_ent = [&](int c, bool valid, int n, const GAS unsigned short* segb, unsigned cv, unsigned tt, unsigned& own_o) -> unsigned {
        const unsigned g0 = 256u * c + 32u * w, g = g0 + r32;
        const bool tile_ok = valid && g0 < tt;
        unsigned own = (unsigned)(n + 1), base = 0u;
        if (tile_ok) {
            int lo = n + 1, hi2 = 32;
            while (hi2 - lo > 1) { const int mid = (lo + hi2) >> 1; if (__builtin_amdgcn_readlane(cv, mid - 1) <= g0) lo = mid; else hi2 = mid; }
            own = (unsigned)lo; base = (lo == n + 1) ? 0u : __builtin_amdgcn_readlane(cv, lo - 1);
            for (int o = lo + 1; o < 32; ++o) { const unsigned s2 = __builtin_amdgcn_readlane(cv, o - 1); if (s2 > g0 + 31u) break; if (s2 <= g) { own = (unsigned)o; base = s2; } }
        }
        const bool lane_ok = tile_ok && g < tt;
        const unsigned idx = lane_ok ? (g - base) : 0u;
        const unsigned v = (unsigned)segb[(size_t)own * 32 * 256 + idx];
        own_o = own;
        return lane_ok ? v : 0xffffffffu;
    };
    auto make_tile = [&](unsigned ent, unsigned own, int b, int h, int n, GTile& T) {
        const bool act = ent != 0xffffffffu;
        const int tq = act ? (int)(own * BLK + (ent & 255u)) : SEQ - 1;
        T.info = (unsigned)tq | (act ? (((ent >> 8) & 3u) << 16) | (1u << 18) | ((own - n <= 4) ? (1u << 19) : 0u) : 0u);
        load_q_raw(T.qr, Qb, (size_t)b * SEQ + tq, b, h, hi);
    };
    auto start_run = [&](const GRun& R) {
        const int bh = R.e / 31, n = R.e - bh * 31; const GAS unsigned short* segb = SEG + ((size_t)bh * 32 * 32 + n) * 256;
        cumv = scan_cnt(cntN); tot = totN;
        mine = (unsigned)(256 * R.c0 + 32 * w) < tot;
        entB = 0xffffffffu; ownB = 0;
        if (mine) { unsigned ownA; const unsigned entA = fetch_ent(R.c0, true, n, segb, cumv, tot, ownA); make_tile(entA, ownA, bh >> 4, bh & 15, n, tcur);
            entB = fetch_ent(R.c0 + 1, R.c0 + 1 < R.c1, n, segb, cumv, tot, ownB); }
    };
    if (hc) start_run(cur);
    while (hc) {
        const bool hn = next_run(nxt);
        const int c0 = cur.c0, c1 = cur.c1, bh = cur.e / 31, n = cur.e - bh * 31, b = bh >> 4, h = bh & 15;
        const GAS unsigned short* segb = SEG + ((size_t)bh * 32 * 32 + n) * 256;
        LAS unsigned char* kv = F.lds + rb * 65536;
        __builtin_amdgcn_s_waitcnt(0x0F70);
        __syncthreads();
        if (hn) { const int bh2 = nxt.e / 31, n2 = nxt.e - bh2 * 31;
            cntN = ((lane & 31) > n2) ? CNT[((size_t)bh2 * 32 + (lane & 31)) * 32 + n2] : 0u; totN = TOT[nxt.e]; }
        if (bh != cur_bh) { head_bounds(KBM, F.rel_bias, bh, h, lane, kmax2, bmax); rb31 = F.rel_bias[31 * NH + h] * LOG2E; cur_bh = bh;
            if (h != cur_h) { build_lut(F.lds, F.rel_bias, h, tid); cur_h = h; __syncthreads(); } }
        const lds_cptr Kl = (lds_cptr)(kv + L_K), Vl = (lds_cptr)(kv + L_V); const int vrl = 4 * hi + ((lane & 15) >> 2); const unsigned vo0 = (unsigned)(vrl * 128 + ((vrl >> 1) & 1) * 64 + ((lane >> 4) & 1) * 32 + (lane & 3) * 8);
        if (mine) for (int c = c0; c < c1; ++c) {
            if ((unsigned)(256 * c + 32 * w) >= tot) break;
            make_tile(entB, ownB, b, h, n, tnxt);
            entB = fetch_ent(c + 2, c + 2 < c1, n, segb, cumv, tot, ownB);
            const unsigned info = tcur.info; const int tq = (int)(info & 0xffffu); const bool near = (info >> 19) & 1u;
            const float mref = ref_exponent(q_norm2(tcur.qr), kmax2, bmax);
            const bool anynear = __any(near);
            const int tqrel = near ? (tq - n * BLK) : 1755;
            LAS const float* lutp = (LAS const float*)(F.lds + L_LUT) + (2047 - tqrel + 4 * hi);
            f32x16 cinit; { const float cc = anynear ? -mref : (rb31 - mref);
#pragma unroll
                for (int r = 0; r < 16; ++r) cinit[r] = cc; }
            f32x16 o[2]; o[0] = f32x16{}; o[1] = f32x16{}; float l = 0.f;
            if (anynear) tile_math<true>(o, l, Kl, Vl, vo0, tcur.qr, cinit, lutp, r32, hi); else tile_math<false>(o, l, Kl, Vl, vo0, tcur.qr, cinit, lutp, r32, hi);
            l = swap_add(l);
            { const bool act = (info >> 18) & 1u; const int slot = (int)((info >> 16) & 3u);
              GAS bf16* dump = (GAS bf16*)(ws + WS_DUMP) + (size_t)F.vcu * 4096 + lane * 64;
              store_row(act ? po_row(ws, F.out, b, h, tq, slot) : dump - 32 * hi, o, 1.0f, hi, true);
              GAS float* plp = act ? PL + (((size_t)bh * SEQ + tq) * 3) + slot : (GAS float*)dump;
              *plp = l; }
            tcur = tnxt;
        }
        if (hn) { start_run(nxt);
            const int bh2 = nxt.e / 31, n2 = nxt.e - bh2 * 31; dma_kv(F.lds + (rb ^ 1) * 65536, Kb, Vb, bh2 >> 4, bh2 & 15, n2, w, lane); }
        cur = nxt; hc = hn; rb ^= 1;
    }
    asm volatile("s_waitcnt vmcnt(0)" ::: "memory");
    __syncthreads();
}

__device__ __forceinline__ void own_block(Frame& F) {
    GAS unsigned char* ws = F.ws;
    const GAS bf16* Qb = (const GAS bf16*)(ws + WS_Q); const GAS bf16* Kb = (const GAS bf16*)(ws + WS_K); const GAS bf16* Vb = (const GAS bf16*)(ws + WS_V); GAS bf16* Ob = (GAS bf16*)(ws + WS_O);
    const GAS float* KBM = (const GAS float*)(ws + WS_KBM); const GAS float* PL = (const GAS float*)(ws + WS_PL);
    int tid = F.wave * 64 + lane_id(); asm volatile("" : "+v"(tid));
    const int lane = tid & 63, w = __builtin_amdgcn_readfirstlane(tid >> 6), r32 = lane & 31, hi = lane >> 5;
    const int bh = F.vcu & 63, b = bh >> 4, h = bh & 15, own0 = F.vcu >> 6, nun = (NBLK - own0 + 3) / 4;
    __syncthreads();
    build_lut(F.lds, F.rel_bias, h, tid);
    float kmax2, bmax; head_bounds(KBM, F.rel_bias, bh, h, lane, kmax2, bmax);
    const int qrel = 32 * w + r32;
    LAS const float* lutp = (LAS const float*)(F.lds + L_LUT) + (2047 - qrel + 4 * hi);
    const int jd = w >> 1;
    bf16x8 qn[4];
    dma_kv(F.lds, Kb, Vb, b, h, own0, w, lane);
    load_q_raw(qn, Qb, (size_t)b * SEQ + own0 * BLK + qrel, b, h, hi);
    for (int i = 0; i < nun; ++i) {
        const int own = own0 + 4 * i; const size_t qrow = (size_t)b * SEQ + own * BLK + qrel;
        LAS unsigned char* kv = F.lds + (i & 1) * 65536;
        bf16x8 qr[4];
#pragma unroll
        for (int d0 = 0; d0 < 4; ++d0) qr[d0] = qn[d0];
        asm volatile("s_waitcnt vmcnt(0)" ::: "memory");
        __syncthreads();
        if (i + 1 < nun) { dma_kv(F.lds + ((i + 1) & 1) * 65536, Kb, Vb, b, h, own + 4, w, lane); load_q_raw(qn, Qb, qrow + 4 * BLK, b, h, hi); }
        const float mref = ref_exponent(q_norm2(qr), kmax2, bmax);
        f32x16 cinit;
#pragma unroll
        for (int r = 0; r < 16; ++r) cinit[r] = -mref;
        f32x16 o[2]; o[0] = f32x16{}; o[1] = f32x16{}; float l = 0.f;
        const lds_cptr Kl = (lds_cptr)(kv + L_K), Vl = (lds_cptr)(kv + L_V); const int vrl = 4 * hi + ((lane & 15) >> 2); const unsigned vo0 = (unsigned)(vrl * 128 + ((vrl >> 1) & 1) * 64 + ((lane >> 4) & 1) * 32 + (lane & 3) * 8);
        for (int j = 0; j <= jd; ++j) { f32x16 p0, p1; v4u pa[4];
            qk_tile(p0, p1, Kl + j * 8192, qr, cinit, r32, hi);
            if (j == jd) softmax_tile<true, true>(p0, p1, lutp, j, qrel, hi, l, pa); else softmax_tile<true, false>(p0, p1, lutp, j, qrel, hi, l, pa);
            pv_tile(o, Vl + j * 8192, vo0, pa); }
        l = swap_add(l);
        const int nsl = own < 3 ? own : 3; const int tq = own * BLK + qrel;
        for (int sl = 0; sl < nsl; ++sl) { add_row(o, po_row(ws, F.out, b, h, tq, sl), hi); l += PL[(((size_t)bh * SEQ + tq) * 3) + sl]; }
        store_row(Ob + qrow * D + h * 64, o, 1.0f / l, hi, true);
    }
    asm volatile("s_waitcnt vmcnt(0)" ::: "memory");
    __syncthreads();
}
}

__device__ __forceinline__ void final_norm(Frame& Fr) {
    struct { int lane, vcu, wave, G; const GAS float* norm_final; GAS float* out; } F{Fr.wave * 64 + lane_id(), Fr.vcu, Fr.wave, Fr.G, Fr.norm_final, Fr.out};
    asm volatile("" : "+v"(F.lane)); F.lane &= 63;
    const int gw = F.vcu * NWAVES + F.wave, NGW = F.G * NWAVES;
    f32x4 gam[4];
#pragma unroll
    for (int j = 0; j < 4; ++j) gam[j] = *(const GAS f32x4*)(F.norm_final + 4 * (F.lane + 64 * j));
    for (int row = gw; row < M; row += NGW) { GAS float* xr = F.out + (size_t)row * D; f32x4 v[4]; float ss = 0.f;
#pragma unroll
        for (int j = 0; j < 4; ++j) { v[j] = *(const GAS f32x4*)(xr + 4 * (F.lane + 64 * j)); ss += (v[j][0] * v[j][0] + v[j][1] * v[j][1]) + (v[j][2] * v[j][2] + v[j][3] * v[j][3]); }
#pragma unroll
        for (int o = 1; o < 64; o <<= 1) ss += shx(ss, o, F.lane);
        const float rstd = rsqrtf(ss * (1.0f / D) + EPS);
#pragma unroll
        for (int j = 0; j < 4; ++j) *(GAS f32x4*)(xr + 4 * (F.lane + 64 * j)) = v[j] * rstd * gam[j]; }
}

__global__ void __launch_bounds__(NWAVES * 64, 2) fwd_megakernel(Args args) {
    __shared__ __attribute__((aligned(16))) unsigned char lds[LDS_BYTES];
    Frame F;
    F.lds = (LAS unsigned char*)lds;
    F.tid = threadIdx.x; F.lane = F.tid & 63; F.wave = __builtin_amdgcn_readfirstlane(F.tid >> 6);
    F.G = gridDim.x; { const int bx = blockIdx.x; F.vcu = (F.G % 8 == 0) ? (bx % 8) * (F.G / 8) + bx / 8 : bx; }
    F.x = args.in[0]; F.c = args.in[1]; F.rel_bias = args.in[2]; F.w_mod = args.in[3]; F.b_mod = args.in[4]; F.norm_mix = args.in[5]; F.norm_mlp = args.in[6];
    F.w_pool = args.in[7]; F.pool_scale = args.in[8]; F.w_qkv = args.in[9]; F.w_o = args.in[10]; F.w_up = args.in[11]; F.w_down = args.in[12]; F.norm_final = args.in[13];
    F.out = args.out; F.ws = args.ws;
    volatile LAS unsigned* MISC = (volatile LAS unsigned*)(F.lds + MISC_OFF);
    for (int u = F.tid; u < (LDS_BYTES - LDSCTL_OFF) / 4; u += NWAVES * 64) ((LAS unsigned*)(F.lds + LDSCTL_OFF))[u] = 0u;
    __syncthreads();
    gu32* ctl = (gu32*)(F.ws + WS_CTL);
    XcdBarrier bar = xcd_barrier_post((GAS unsigned*)(ctl + CW_BAR), MISC + 8); bar.wave = F.wave;
    GAS unsigned char* ws = F.ws;
#define WSB(off) ((GAS bf16*)(ws + (off)))
#define WSF(off) ((GAS float*)(ws + (off)))

    p0_prologue(F);
    xcd_barrier(bar);
    p1_bias(F); p1_pool(F);
    xcd_barrier(bar);

    for (int ph = 0; ph < 10; ++ph) {
        asm volatile("" : "+s"(ws));
        const GAS float* MOD = WSF(WS_MOD); GAS float* SS = WSF(WS_SS);
        const int kind = (ph == 0 || ph == 2 || ph == 7) ? 0 : (ph == 1 || ph == 8) ? 1 : (ph == 3) ? 2 : (ph == 4) ? 3 : (ph == 5) ? 4 : (ph == 6) ? 5 : 7;
        if (kind == 0) {
            pg8::Gemm g; pg8::EpiRes E;
            if (ph == 0) { g = pg8::Gemm{WSB(WS_XNA), WSB(WS_WPOOL), M, D, 256, D, 256, 512};
                E = pg8::EpiRes{WSB(WS_XR), WSB(WS_XR), MOD + 2048, F.pool_scale, SS}; }
            else if (ph == 2) { g = pg8::Gemm{WSB(WS_HB), WSB(WS_WDN0), M, D, FF, 256, 0, 131072};
                E = pg8::EpiRes{WSB(WS_XR), WSB(WS_XR), MOD + 5120, nullptr, SS}; }
            else { g = pg8::Gemm{WSB(WS_O), WSB(WS_WO), M, D, D, D, 0, 512};
                E = pg8::EpiRes{WSB(WS_XR), WSB(WS_XR), MOD + 4 * 6144 + 2048, nullptr, SS}; }
            pg8::StaticOrder S; S.init(M, D, F.G, (int)blockIdx.x);
            pg8::gemm_phase<pg8::EpiRes, pg8::StaticOrder, true>(F.lds + RING_OFF, g, S, E, F.wave);
        } else if (kind == 1) {
            const pg8::Gemm g{WSB(WS_XR), WSB(ph == 1 ? WS_WSUP0 : WS_WSUP1), M, FF, D, 256, 0, 131072, (size_t)FF * D * 2};
            const pg8::EpiUp E{SS, WSF(ph == 1 ? WS_BIAS_UP0 : WS_BIAS_UP1), WSB(WS_HB), FF, F.lds, 0};
            pg8::StaticOrder S; S.init(M, FF, F.G, (int)blockIdx.x);
            pg8::gemm_phase<pg8::EpiUp, pg8::StaticOrder, true>(F.lds + RING_OFF, g, S, E, F.wave);
        } else if (kind == 2) {
            const pg8::Gemm g{WSB(WS_XR), (const GAS bf16*)((GAS unsigned char*)F.out + OUT_WSQKV), M, NQKV, D, 256, 0, 131072, (size_t)NQKV * D * 2};
            const pg8::EpiQKV E{SS, WSF(WS_BIAS_QKV), WSB(WS_Q), (size_t)(WS_K - WS_Q) / 2, WSF(WS_KMP), F.lds, 0};
            pg8::StaticOrder S; S.init(M, NQKV, F.G, (int)blockIdx.x);
            pg8::gemm_phase<pg8::EpiQKV, pg8::StaticOrder, true>(F.lds + RING_OFF, g, S, E, F.wave);
        } else if (kind == 3) { F.ws = ws; att::route(F);
        } else if (kind == 4) { F.ws = ws; att::gather(F);
        } else if (kind == 5) { F.ws = ws; att::own_block(F);
        } else {
            const pg8::Gemm g{WSB(WS_HB), WSB(WS_WDN1), M, D, FF, 256, 0, 131072};
            const pg8::EpiFinal E{WSB(WS_XR), F.out, MOD + 4 * 6144 + 5120, F.norm_final, SS, (GAS unsigned*)(ws + WS_CTL) + CW_FIN};
            pg8::StaticOrder S; S.init(M, D, F.G, (int)blockIdx.x);
            pg8::gemm_phase<pg8::EpiFinal, pg8::StaticOrder, true>(F.lds + RING_OFF, g, S, E, F.wave);
            break;
        }
        xcd_barrier(bar);
    }
}

extern "C" void kernel_launch(void* const* d_in, const int* in_sizes, int n_in, void* d_out, int out_size, void* d_ws, size_t ws_size, hipStream_t stream) {
    static int grid = 0;
    if (grid == 0) {
        if (n_in != 14 || in_sizes[0] != M * D || out_size != M * D || ws_size < WS_END) { fprintf(stderr, "kernel_launch: unexpected shapes / workspace (n_in %d, in0 %d, out %d, ws %zu)\n", n_in, n_in > 0 ? in_sizes[0] : -1, out_size, ws_size); grid = -1; return; }
        int dev = 0, cus = 0, per_cu = 0;
        if (hipGetDevice(&dev) != hipSuccess || hipDeviceGetAttribute(&cus, hipDeviceAttributeMultiprocessorCount, dev) != hipSuccess) { grid = -1; return; }
        if (hipOccupancyMaxActiveBlocksPerMultiprocessor(&per_cu, (const void*)fwd_megakernel, NWAVES * 64, 0) != hipSuccess || per_cu < 1) { fprintf(stderr, "kernel_launch: occupancy query says %d blocks per CU\n", per_cu); }
        (void)hipGetLastError();
        grid = cus;
    }
    if (grid < 0) return;
    if (hipMemsetAsync((char*)d_ws + WS_CTL, 0, CTL_ZERO_BYTES, stream) != hipSuccess) return;
    Args a{};
    for (int i = 0; i < 14; ++i) a.in[i] = (const GAS float*)d_in[i];
    a.out = (GAS float*)d_out; a.ws = (GAS unsigned char*)d_ws;
    hipLaunchKernelGGL(fwd_megakernel, dim3(grid), dim3(NWAVES * 64), 0, stream, a);
}
```

```cpp
#include <hip/hip_runtime.h>
#include <utility>
#include <cstdio>
#include <cstdint>

__device__ __forceinline__ float shx(float v, int m, int lane) { return __builtin_bit_cast(float, __builtin_amdgcn_ds_bpermute((lane ^ m) << 2, __builtin_bit_cast(int, v))); }
__device__ __forceinline__ unsigned shup(unsigned v, int o, int lane) { return (unsigned)__builtin_amdgcn_ds_bpermute(((lane - o) & 63) << 2, (int)v); }
__device__ __forceinline__ size_t hm_off(size_t row, int b, int h) { return (row + (size_t)(15 * b + h) * 8192) * 64; }
__device__ __forceinline__ int lane_id() { unsigned z = 0u; asm volatile("" : "+s"(z)); return (int)__builtin_amdgcn_mbcnt_hi(~0u, __builtin_amdgcn_mbcnt_lo(~0u, z)); }

namespace pg8 {
#define PG8_LAS __attribute__((address_space(3)))
#define PG8_GAS __attribute__((address_space(1)))
typedef unsigned short bf16_t;
typedef short bf16x8 __attribute__((ext_vector_type(8)));
typedef float f32x4 __attribute__((ext_vector_type(4)));
typedef unsigned u32x4 __attribute__((ext_vector_type(4)));
constexpr int BM = 256, BK = 64, HALF = 128, HTB = HALF * BK * 2, STAGE_BYTES = 8 * HTB, NXCD = 8, WGM = 8;

__host__ __device__ __forceinline__ int lds_byte(int r, int c) { const int st = (r >> 4) * 2 + (c >> 5), rr = r & 15, cc = c & 31, ob = rr * 64 + cc * 2; return st * 1024 + (ob ^ (((ob >> 9) & 1) << 5)); }
__host__ __device__ __forceinline__ void stage_rc(int b, int& R, int& C) { const int st = b / 1024, sb = b % 1024, swz = sb ^ (((sb >> 9) & 1) << 5); R = (st >> 1) * 16 + swz / 64; C = (st & 1) * 32 + (swz % 64) / 2; }
__host__ __device__ __forceinline__ int perm32(int rho) { const int n = rho >> 4, i = rho & 15; return 8 * (i >> 2) + 4 * n + (i & 3); }

struct Unit { int pm, pn; };
struct Gemm { const PG8_GAS bf16_t* A; const PG8_GAS bf16_t* Bt; int M, N, K, lda, a_pn_off, a_tileb; size_t b_bstride = 0; };

struct StaticOrder {
    int nM, nN, nwg, G, c;
    __host__ __device__ void init(int M, int N, int G_, int c_) { nM = M / BM; nN = N / BM; nwg = nM * nN; G = G_; c = c_; }
    __host__ __device__ bool next(int i, Unit& u) const {
        const long L = (long)i * G + c; if (L >= nwg) return false;
        int wgid = (int)L; { const int q = nwg / NXCD, r = nwg % NXCD, xcd = wgid % NXCD, off = wgid / NXCD; wgid = (xcd < r ? xcd * (q + 1) : r * (q + 1) + (xcd - r) * q) + off; }
        const int nig = WGM * nN, gid = wgid / nig, fm = gid * WGM, gsz = (nM - fm) < WGM ? (nM - fm) : WGM;
        u.pm = fm + ((wgid % nig) % gsz); u.pn = (wgid % nig) / gsz; return true;
    }
};

__device__ __forceinline__ unsigned cvt_pk_bf16(float lo, float hi) { unsigned r; asm volatile("v_cvt_pk_bf16_f32 %0, %1, %2" : "=v"(r) : "v"(lo), "v"(hi)); return r; }

constexpr int SEQ_ = 8192;
constexpr float EPS_ = 1e-6f;
constexpr float C2_ = 0.125f * 1.4426950408889634f;


__device__ __forceinline__ float row_rstd(const PG8_GAS float* SS, int row, int fq, int fr) {
    const f32x4 s4 = *(const PG8_GAS f32x4*)(SS + (size_t)row * 16 + 4 * fq);
    float s = (s4[0] + s4[1]) + (s4[2] + s4[3]);
    const int ln = fq * 16 + fr; s += shx(s, 16, ln); s += shx(s, 32, ln);
    return rsqrtf(s * (1.0f / 1024.0f) + EPS_);
}

constexpr int RSTD_TAB_OFF = 132096;
__device__ __forceinline__ void fill_rstd_tab(PG8_LAS unsigned char* ldsbase, int par, const PG8_GAS float* SS, int pm, int wid, int lane) {
    if (lane < 32) { const int r = wid * 32 + lane; const PG8_GAS f32x4* p = (const PG8_GAS f32x4*)(SS + (size_t)(pm * BM + r) * 16);
        const f32x4 a = p[0], b = p[1], c = p[2], d = p[3];
        const float g0 = (a[0] + a[1]) + (a[2] + a[3]), g1 = (b[0] + b[1]) + (b[2] + b[3]), g2 = (c[0] + c[1]) + (c[2] + c[3]), g3 = (d[0] + d[1]) + (d[2] + d[3]);
        ((PG8_LAS float*)(ldsbase + RSTD_TAB_OFF + par * 1024))[r] = rsqrtf(((g0 + g1) + (g2 + g3)) * (1.0f / 1024.0f) + EPS_); }
}
__device__ __forceinline__ f32x4 bf_lo4(const u32x4& w) { return (f32x4){__builtin_bit_cast(float, w.x << 16), __builtin_bit_cast(float, w.x & 0xffff0000u), __builtin_bit_cast(float, w.y << 16), __builtin_bit_cast(float, w.y & 0xffff0000u)}; }
__device__ __forceinline__ f32x4 bf_hi4(const u32x4& w) { return (f32x4){__builtin_bit_cast(float, w.z << 16), __builtin_bit_cast(float, w.z & 0xffff0000u), __builtin_bit_cast(float, w.w << 16), __builtin_bit_cast(float, w.w & 0xffff0000u)}; }
struct EpiRes {
    static constexpr bool PERM = true, NEEDS_RSTD = false;
    const PG8_GAS bf16_t* Rb; PG8_GAS bf16_t* Xb; const PG8_GAS float* gate; const PG8_GAS float* cscale; PG8_GAS float* SS;
    __device__ __forceinline__ void operator()(f32x4 (&acc)[2][2][4][2], const Unit& u, int wr, int wc, int fr, int fq) const {
        const int b = u.pm >> 5, colb = u.pn * BM + wc * 32 + 8 * fq, row0 = u.pm * BM + wr * 64 + fr;
        float ssq[2][4];
#pragma unroll
        for (int bj = 0; bj < 2; ++bj) {
            f32x4 gt[2];
#pragma unroll
            for (int n = 0; n < 2; ++n) { const int col = colb + bj * HALF + 4 * n;
                f32x4 gv = *(const PG8_GAS f32x4*)(gate + b * 6144 + col); if (cscale) gv = gv * *(const PG8_GAS f32x4*)(cscale + col); gt[n] = gv; }
#pragma unroll
            for (int ai = 0; ai < 2; ++ai)
#pragma unroll
                for (int m = 0; m < 4; ++m) { const size_t off = ((size_t)(u.pm * 4 + u.pn) * 256 + (wr * 64 + fr + ai * HALF + m * 16)) * 256 + (wc * 32 + 8 * fq + bj * HALF);
                    const u32x4 rw = *(const PG8_GAS u32x4*)(Rb + off); const f32x4 r0 = bf_lo4(rw), r1 = bf_hi4(rw);
                    const f32x4 y0 = r0 + gt[0] * acc[ai][bj][m][0], y1 = r1 + gt[1] * acc[ai][bj][m][1];
                    u32x4 xw; xw.x = cvt_pk_bf16(y0[0], y0[1]); xw.y = cvt_pk_bf16(y0[2], y0[3]); xw.z = cvt_pk_bf16(y1[0], y1[1]); xw.w = cvt_pk_bf16(y1[2], y1[3]);
                    *(PG8_GAS u32x4*)(Xb + off) = xw;
                    const f32x4 x0 = bf_lo4(xw), x1 = bf_hi4(xw);
                    const float q = (x0[0] * x0[0] + x0[1] * x0[1]) + (x0[2] * x0[2] + x0[3] * x0[3]) + (x1[0] * x1[0] + x1[1] * x1[1]) + (x1[2] * x1[2] + x1[3] * x1[3]);
                    ssq[ai][m] = (bj == 0) ? q : ssq[ai][m] + q;
                }
        }
#pragma unroll
        for (int ai = 0; ai < 2; ++ai)
#pragma unroll
            for (int m = 0; m < 4; ++m) { float q = ssq[ai][m]; q += shx(q, 16, fq * 16 + fr); q += shx(q, 32, fq * 16 + fr); if (fq == 0) SS[(size_t)(row0 + ai * HALF + m * 16) * 16 + u.pn * 4 + wc] = q; }
    }
};

struct EpiFinal {
    static constexpr bool PERM = true, NEEDS_RSTD = false;
    const PG8_GAS bf16_t* R; PG8_GAS float* OUT; const PG8_GAS float* gate; const PG8_GAS float* gfin; PG8_GAS float* SS; PG8_GAS unsigned* cnt;
    __device__ __forceinline__ void operator()(f32x4 (&acc)[2][2][4][2], const Unit& u, int wr, int wc, int fr_, int fq_) const {
        int fr = fr_, fq = fq_; asm volatile("" : "+v"(fr), "+v"(fq));
        const int b = u.pm >> 5, colb = u.pn * BM + wc * 32 + 8 * fq, row0 = u.pm * BM + wr * 64 + fr, ln = fq * 16 + fr;
        float ssq[2][4];
#pragma unroll
        for (int bj = 0; bj < 2; ++bj) {
            const f32x4 gt0 = *(const PG8_GAS f32x4*)(gate + b * 6144 + colb + bj * HALF), gt1 = *(const PG8_GAS f32x4*)(gate + b * 6144 + colb + bj * HALF + 4);
#pragma unroll
            for (int ai = 0; ai < 2; ++ai)
#pragma unroll
                for (int m = 0; m < 4; ++m) { const size_t off = (size_t)(row0 + ai * HALF + m * 16) * 1024 + colb + bj * HALF;
                    const u32x4 rw = *(const PG8_GAS u32x4*)(R + ((size_t)(u.pm * 4 + u.pn) * 256 + (wr * 64 + fr + ai * HALF + m * 16)) * 256 + (wc * 32 + 8 * fq + bj * HALF));
                    const f32x4 x0 = bf_lo4(rw) + gt0 * acc[ai][bj][m][0], x1 = bf_hi4(rw) + gt1 * acc[ai][bj][m][1];
                    acc[ai][bj][m][0] = x0; acc[ai][bj][m][1] = x1;
                    const float q = (x0[0] * x0[0] + x0[1] * x0[1]) + (x0[2] * x0[2] + x0[3] * x0[3]) + (x1[0] * x1[0] + x1[1] * x1[1]) + (x1[2] * x1[2] + x1[3] * x1[3]);
                    ssq[ai][m] = (bj == 0) ? q : ssq[ai][m] + q;
                    asm volatile("" : "+v"(acc[ai][bj][m][0]), "+v"(acc[ai][bj][m][1]), "+v"(ssq[ai][m]));
                    if (m & 1) asm volatile("" ::: "memory"); }
        }
#pragma unroll
        for (int ai = 0; ai < 2; ++ai)
#pragma unroll
            for (int m = 0; m < 4; ++m) { float q = ssq[ai][m]; q += shx(q, 16, ln); q += shx(q, 32, ln);
                if (fq == 0) __hip_atomic_store(SS + (size_t)(row0 + ai * HALF + m * 16) * 16 + u.pn * 4 + wc, q, __ATOMIC_RELAXED, __HIP_MEMORY_SCOPE_AGENT); }
        asm volatile("s_waitcnt vmcnt(0)" ::: "memory");
        PG8_GAS unsigned* c = cnt + 64 * u.pm;
        if (ln == 0) (void)__hip_atomic_fetch_add(c, 1u, __ATOMIC_RELAXED, __HIP_MEMORY_SCOPE_AGENT);
        for (unsigned sp = 0; sp < (1u << 22); ++sp) { if ((unsigned)__builtin_amdgcn_readfirstlane((int)__hip_atomic_load(c, __ATOMIC_RELAXED, __HIP_MEMORY_SCOPE_AGENT)) >= 32u) break; __builtin_amdgcn_s_sleep(2); }
        int row1 = row0, colc = colb; asm volatile("" : "+v"(row1), "+v"(colc));
        float rs[2][4];
#pragma unroll
        for (int ai = 0; ai < 2; ++ai)
#pragma unroll
            for (int m = 0; m < 4; ++m) { const PG8_GAS float* sp4 = SS + (size_t)(row1 + ai * HALF + m * 16) * 16 + 4 * fq;
                float t = (__hip_atomic_load(sp4, __ATOMIC_RELAXED, __HIP_MEMORY_SCOPE_AGENT) + __hip_atomic_load(sp4 + 1, __ATOMIC_RELAXED, __HIP_MEMORY_SCOPE_AGENT))
                        + (__hip_atomic_load(sp4 + 2, __ATOMIC_RELAXED, __HIP_MEMORY_SCOPE_AGENT) + __hip_atomic_load(sp4 + 3, __ATOMIC_RELAXED, __HIP_MEMORY_SCOPE_AGENT));
                t += shx(t, 16, ln); t += shx(t, 32, ln); rs[ai][m] = rsqrtf(t * (1.0f / 1024.0f) + EPS_); }
#pragma unroll
        for (int bj = 0; bj < 2; ++bj) {
            const f32x4 g0 = *(const PG8_GAS f32x4*)(gfin + colc + bj * HALF), g1 = *(const PG8_GAS f32x4*)(gfin + colc + bj * HALF + 4);
#pragma unroll
            for (int ai = 0; ai < 2; ++ai)
#pragma unroll
                for (int m = 0; m < 4; ++m) { const size_t off = (size_t)(row1 + ai * HALF + m * 16) * 1024 + colc + bj * HALF;
                    *(PG8_GAS f32x4*)(OUT + off) = acc[ai][bj][m][0] * rs[ai][m] * g0; *(PG8_GAS f32x4*)(OUT + off + 4) = acc[ai][bj][m][1] * rs[ai][m] * g1; }
        }
    }
};

struct EpiUp {
    static constexpr bool PERM = true;
    static constexpr bool NEEDS_RSTD = true;
    const PG8_GAS float* SS; const PG8_GAS float* bias; PG8_GAS bf16_t* O; int ldc; PG8_LAS unsigned char* ldsb; int par;
    __device__ __forceinline__ void operator()(f32x4 (&acc)[2][2][4][2], const Unit& u, int wr, int wc, int fr, int fq) const {
        const int b = u.pm >> 5, colb = u.pn * BM + wc * 32 + 8 * fq, row0 = u.pm * BM + wr * 64 + fr;
        float rs[2][4];
#pragma unroll
        for (int ai = 0; ai < 2; ++ai)
#pragma unroll
            for (int m = 0; m < 4; ++m) rs[ai][m] = ((const PG8_LAS float*)(ldsb + RSTD_TAB_OFF + par * 1024))[wr * 64 + fr + ai * HALF + m * 16];
#pragma unroll
        for (int bj = 0; bj < 2; ++bj) {
            const f32x4 bv0 = *(const PG8_GAS f32x4*)(bias + (size_t)b * ldc + colb + bj * HALF), bv1 = *(const PG8_GAS f32x4*)(bias + (size_t)b * ldc + colb + bj * HALF + 4);
#pragma unroll
            for (int ai = 0; ai < 2; ++ai)
#pragma unroll
                for (int m = 0; m < 4; ++m) { f32x4 v0 = acc[ai][bj][m][0] * rs[ai][m] + bv0, v1 = acc[ai][bj][m][1] * rs[ai][m] + bv1;
#pragma unroll
                    for (int j = 0; j < 4; ++j) { v0[j] = fmaxf(v0[j], 0.f); v1[j] = fmaxf(v1[j], 0.f); }
                    v0 = v0 * v0; v1 = v1 * v1;
                    u32x4 w; w.x = cvt_pk_bf16(v0[0], v0[1]); w.y = cvt_pk_bf16(v0[2], v0[3]); w.z = cvt_pk_bf16(v1[0], v1[1]); w.w = cvt_pk_bf16(v1[2], v1[3]);
                    *(PG8_GAS u32x4*)(O + ((size_t)(u.pm * 16 + u.pn) * 256 + (wr * 64 + fr + ai * HALF + m * 16)) * 256 + (wc * 32 + 8 * fq + bj * HALF)) = w; }
        }
    }
};

struct EpiQKV {
    static constexpr bool PERM = true;
    static constexpr bool NEEDS_RSTD = true;
    const PG8_GAS float* SS; const PG8_GAS float* bias; PG8_GAS bf16_t* Q; size_t split_stride; PG8_GAS float* KMP; PG8_LAS unsigned char* ldsb; int par;
    __device__ __forceinline__ void operator()(f32x4 (&acc)[2][2][4][2], const Unit& u, int wr, int wc, int fr, int fq) const {
        const int b = u.pm >> 5, t = u.pn >> 2, colt = (u.pn & 3) * BM + wc * 32 + 8 * fq, colb = u.pn * BM + wc * 32 + 8 * fq, row0 = u.pm * BM + wr * 64 + fr;
        PG8_GAS bf16_t* base = Q + (size_t)t * split_stride; const float sc = (t == 0) ? C2_ : 1.0f;
        float rs[2][4];
#pragma unroll
        for (int ai = 0; ai < 2; ++ai)
#pragma unroll
            for (int m = 0; m < 4; ++m) rs[ai][m] = ((const PG8_LAS float*)(ldsb + RSTD_TAB_OFF + par * 1024))[wr * 64 + fr + ai * HALF + m * 16];
#pragma unroll
        for (int bj = 0; bj < 2; ++bj) {
            const f32x4 bv0 = *(const PG8_GAS f32x4*)(bias + (size_t)b * 3072 + colb + bj * HALF), bv1 = *(const PG8_GAS f32x4*)(bias + (size_t)b * 3072 + colb + bj * HALF + 4);
            f32x4 cs0 = {0.f, 0.f, 0.f, 0.f}, cs1 = cs0;
#pragma unroll
            for (int ai = 0; ai < 2; ++ai)
#pragma unroll
                for (int m = 0; m < 4; ++m) { f32x4 v0 = acc[ai][bj][m][0] * rs[ai][m] + bv0, v1 = acc[ai][bj][m][1] * rs[ai][m] + bv1;
                    cs0 += v0; cs1 += v1; v0 = v0 * sc; v1 = v1 * sc;
                    u32x4 w; w.x = cvt_pk_bf16(v0[0], v0[1]); w.y = cvt_pk_bf16(v0[2], v0[3]); w.z = cvt_pk_bf16(v1[0], v1[1]); w.w = cvt_pk_bf16(v1[2], v1[3]);
                    *(PG8_GAS u32x4*)(base + hm_off((size_t)(row0 + ai * HALF + m * 16), b, (colt + bj * HALF) >> 6) + ((colt + bj * HALF) & 63)) = w; }
            if (t == 1) {
#pragma unroll
                for (int o = 1; o < 16; o <<= 1) {
#pragma unroll
                    for (int j = 0; j < 4; ++j) { cs0[j] += shx(cs0[j], o, fq * 16 + fr); cs1[j] += shx(cs1[j], o, fq * 16 + fr); } }
                if (fr == 0) { PG8_GAS float* kp = KMP + ((size_t)u.pm * 2 + wr) * 1024 + colt + bj * HALF; *(f32x4*)kp = cs0; *(PG8_GAS f32x4*)(kp + 4) = cs1; }
            }
        }
    }
};

template <class Epi, class Sched, bool ALIGN_EPI>
__device__ __forceinline__ void gemm_phase(PG8_LAS unsigned char* lds, const Gemm g, const Sched& S, const Epi& E_, int wave_id) {
    Epi E = E_;
    int tid = wave_id * 64 + lane_id(); asm volatile("" : "+v"(tid));
    const int wid = __builtin_amdgcn_readfirstlane(tid >> 6), lane = tid & 63, wr = wid >> 2, wc = wid & 3, fr = lane & 15, fq = lane >> 4;
    const int K = g.K, nt = K / BK, lda = g.lda;
    unsigned voffA[2], voffB[2];
#pragma unroll
    for (int i = 0; i < 2; ++i) { int R, C; stage_rc(tid * 16 + i * 8192, R, C); const int Rb = Epi::PERM ? ((R & ~31) + perm32(R & 31)) : R;
        voffA[i] = (unsigned)(R * lda + C) * 2u; voffB[i] = (unsigned)(Rb * K + C) * 2u; }
    const size_t kstep = (size_t)(BK * 2);
    const size_t hstepA = (size_t)HALF * lda * 2, tstepA = (g.a_tileb == 512) ? 2 * hstepA : (size_t)(K / 256) * g.a_tileb, hstepB = (size_t)HALF * K * 2, tstepB = 2 * hstepB;
    const size_t tileb = (size_t)g.a_tileb;
#define PG8_KOFF(t) ((size_t)((t) >> 2) * tileb + (size_t)((t) & 3) * 128)
    const unsigned ldsw = (unsigned)wid * 1024u;
    const int aoff = lds_byte(wr * 64 + fr, fq * 8), boff = lds_byte(wc * 32 + fr, fq * 8);
#define PG8_SA(b, h) (((b) * 2 + (h)) * HTB)
#define PG8_SB(b, h) ((4 + (b) * 2 + (h)) * HTB)
#define PG8_STAGE(bufoff, gbase, voff) do { _Pragma("unroll") for (int _i = 0; _i < 2; ++_i) \
        __builtin_amdgcn_global_load_lds((const PG8_GAS unsigned*)((const PG8_GAS char*)(gbase) + (voff)[_i]), (PG8_LAS unsigned*)(lds + (bufoff) + ldsw + _i * 8192), 16, 0, 0); } while (0)
#define PG8_LDA(dst, b, h) do { _Pragma("unroll") for (int m = 0; m < 4; ++m) _Pragma("unroll") for (int k = 0; k < 2; ++k) dst[m][k] = *(const PG8_LAS bf16x8*)(lds + PG8_SA(b, h) + aoff + m * 2048 + k * 1024); } while (0)
#define PG8_LDB(dst, b, h) do { _Pragma("unroll") for (int n = 0; n < 2; ++n) _Pragma("unroll") for (int k = 0; k < 2; ++k) dst[n][k] = *(const PG8_LAS bf16x8*)(lds + PG8_SB(b, h) + boff + n * 2048 + k * 1024); } while (0)
#define PG8_MMA(ai, bj, At, Bt) do { __builtin_amdgcn_s_setprio(1); _Pragma("unroll") for (int m = 0; m < 4; ++m) _Pragma("unroll") for (int n = 0; n < 2; ++n) _Pragma("unroll") for (int k = 0; k < 2; ++k) \
        acc[ai][bj][m][n] = __builtin_amdgcn_mfma_f32_16x16x32_bf16(Bt[n][k], At[m][k], acc[ai][bj][m][n], 0, 0, 0); __builtin_amdgcn_s_setprio(0); } while (0)
#define PG8_WAIT_V(n) asm volatile("s_waitcnt vmcnt(" #n ")" ::: "memory")
#define PG8_WAIT_L(n) asm volatile("s_waitcnt lgkmcnt(" #n ")" ::: "memory")
#define PG8_BAR __builtin_amdgcn_s_barrier()
#define PG8_SCHED __builtin_amdgcn_sched_barrier(0)
    Unit cur, nxt; int ui = 0;
    if (!S.next(0, cur)) return;
    int rpar = 0;
    if constexpr (Epi::NEEDS_RSTD) { fill_rstd_tab(lds, 0, E.SS, cur.pm, wid, lane); E.par = 0; }
    f32x4 acc[2][2][4][2];
#pragma unroll
    for (int a = 0; a < 2; ++a)
#pragma unroll
        for (int b = 0; b < 2; ++b)
#pragma unroll
            for (int m = 0; m < 4; ++m)
#pragma unroll
                for (int n = 0; n < 2; ++n) acc[a][b][m][n] = (f32x4){0.f, 0.f, 0.f, 0.f};
    bf16x8 At[4][2], B0[2][2], B1[2][2];
    const PG8_GAS char* cA = (const PG8_GAS char*)g.A + (size_t)cur.pm * tstepA + (size_t)cur.pn * g.a_pn_off * 2; const PG8_GAS char* cB = (const PG8_GAS char*)g.Bt + (size_t)cur.pn * tstepB + (size_t)(cur.pm >> 5) * g.b_bstride;
    PG8_STAGE(PG8_SB(0, 0), cB, voffB); PG8_STAGE(PG8_SB(0, 1), cB + hstepB, voffB); PG8_STAGE(PG8_SA(0, 0), cA, voffA); PG8_STAGE(PG8_SA(0, 1), cA + hstepA, voffA);
    if (wr == 1) PG8_BAR;
    PG8_WAIT_V(2); PG8_BAR;
    PG8_STAGE(PG8_SB(1, 0), cB + kstep, voffB); PG8_STAGE(PG8_SA(1, 0), cA + kstep, voffA); PG8_STAGE(PG8_SB(1, 1), cB + hstepB + kstep, voffB);
    PG8_WAIT_V(6); PG8_BAR;
    for (;;) {
        const bool has_next = S.next(ui + 1, nxt);
        const PG8_GAS char* nA = has_next ? (const PG8_GAS char*)g.A + (size_t)nxt.pm * tstepA + (size_t)nxt.pn * g.a_pn_off * 2 : cA; const PG8_GAS char* nB = has_next ? (const PG8_GAS char*)g.Bt + (size_t)nxt.pn * tstepB + (size_t)(nxt.pm >> 5) * g.b_bstride : cB;
        for (int t = 0; t < nt; t += 2) {
            const bool last = (t == nt - 2);
            const PG8_GAS char* a1 = cA + PG8_KOFF(t + 1);
            const PG8_GAS char* a2 = last ? nA : cA + PG8_KOFF(t + 2); const PG8_GAS char* b2 = last ? nB : cB + (size_t)(t + 2) * kstep;
            const PG8_GAS char* a3 = a2 + kstep; const PG8_GAS char* b3 = b2 + kstep;
            PG8_LDB(B0, 0, 0); PG8_LDB(B1, 0, 1); PG8_SCHED; PG8_LDA(At, 0, 0); PG8_STAGE(PG8_SA(1, 1), a1 + hstepA, voffA);
            PG8_WAIT_V(8); PG8_WAIT_L(0); PG8_BAR; PG8_MMA(0, 0, At, B0); PG8_MMA(0, 1, At, B1); PG8_BAR; PG8_SCHED;
            PG8_LDA(At, 0, 1); PG8_STAGE(PG8_SB(0, 0), b2, voffB); PG8_STAGE(PG8_SB(0, 1), b2 + hstepB, voffB); PG8_STAGE(PG8_SA(0, 0), a2, voffA);
            PG8_WAIT_V(8); PG8_WAIT_L(0); PG8_BAR; PG8_MMA(1, 0, At, B0); PG8_MMA(1, 1, At, B1); PG8_BAR; PG8_SCHED;
            PG8_LDB(B0, 1, 0); PG8_LDB(B1, 1, 1); PG8_SCHED; PG8_LDA(At, 1, 0); PG8_STAGE(PG8_SA(0, 1), a2 + hstepA, voffA);
            PG8_WAIT_V(8); PG8_WAIT_L(0); PG8_BAR; PG8_MMA(0, 0, At, B0); PG8_MMA(0, 1, At, B1); PG8_BAR; PG8_SCHED;
            PG8_LDA(At, 1, 1); PG8_STAGE(PG8_SB(1, 0), b3, voffB); PG8_STAGE(PG8_SB(1, 1), b3 + hstepB, voffB); PG8_STAGE(PG8_SA(1, 0), a3, voffA);
            PG8_WAIT_V(8); PG8_WAIT_L(0); PG8_BAR; PG8_MMA(1, 0, At, B0); PG8_MMA(1, 1, At, B1); PG8_BAR; PG8_SCHED;
        }
        if constexpr (ALIGN_EPI) { if (wr == 0) PG8_BAR; }
        if constexpr (Epi::NEEDS_RSTD) E.par = rpar;
        E(acc, cur, wr, wc, fr, fq);
        if constexpr (Epi::NEEDS_RSTD) { if (has_next && nxt.pm != cur.pm) { rpar ^= 1; fill_rstd_tab(lds, rpar, E.SS, nxt.pm, wid, lane); } }
        if (!has_next) break;
#pragma unroll
        for (int a = 0; a < 2; ++a)
#pragma unroll
            for (int b = 0; b < 2; ++b)
#pragma unroll
                for (int m = 0; m < 4; ++m)
#pragma unroll
                    for (int n = 0; n < 2; ++n) acc[a][b][m][n] = (f32x4){0.f, 0.f, 0.f, 0.f};
        cur = nxt; cA = nA; cB = nB; ++ui;
        if constexpr (ALIGN_EPI) { if (wr == 1) PG8_BAR; }
    }
    PG8_WAIT_V(0);
    if constexpr (!ALIGN_EPI) { if (wr == 0) PG8_BAR; }
    PG8_BAR;
#undef PG8_KOFF
#undef PG8_SA
#undef PG8_SB
#undef PG8_STAGE
#undef PG8_LDA
#undef PG8_LDB
#undef PG8_MMA
#undef PG8_WAIT_V
#undef PG8_WAIT_L
#undef PG8_BAR
#undef PG8_SCHED
}
}

constexpr int NWAVES = 8;
constexpr int BATCH = 4, SEQ = 8192, D = 1024, NH = 16, HD = 64, FF = 4096, M = BATCH * SEQ, NQKV = 3 * D, NBLK = 32, BLK = 256;
constexpr float EPS = 1e-6f;
constexpr float LOG2E = 1.4426950408889634f;

constexpr size_t MiB = 1u << 20;
constexpr size_t WS_CTL = 0, CTL_ZERO_BYTES = 1 * MiB;
constexpr size_t WS_MOD = 1 * MiB;
constexpr size_t WS_BIAS_UP0 = WS_MOD + 256 * 1024;
constexpr size_t WS_BIAS_QKV = WS_BIAS_UP0 + 64 * 1024;
constexpr size_t WS_BIAS_UP1 = WS_BIAS_QKV + 64 * 1024;
constexpr size_t WS_KMP = 2 * MiB;
constexpr size_t WS_SS = 3 * MiB;
constexpr size_t WS_WPOOL = 6 * MiB, WS_WQKV = 8 * MiB, WS_WO = 14 * MiB, WS_WUP0 = 16 * MiB, WS_WUP1 = 24 * MiB, WS_WDN0 = 32 * MiB, WS_WDN1 = 40 * MiB;
constexpr size_t WS_XNA = 48 * MiB, WS_XNB = 112 * MiB;
constexpr size_t WS_WSUP0 = 112 * MiB, WS_WSUP1 = 144 * MiB;
constexpr size_t OUT_WSQKV = 96 * MiB;
constexpr size_t WS_HB = 176 * MiB;
constexpr size_t WS_Q = 176 * MiB, WS_K = 240 * MiB, WS_V = 304 * MiB;
constexpr size_t WS_PL = 496 * MiB;
constexpr size_t WS_CNT = 503 * MiB;
constexpr size_t WS_KBM = 503 * MiB + 512 * 1024;
constexpr size_t WS_POB = 48 * MiB;
constexpr size_t WS_SEG = 368 * MiB;
constexpr size_t WS_XR = 432 * MiB;
constexpr size_t WS_O = 368 * MiB;
constexpr size_t WS_DUMP = 504 * MiB;
constexpr size_t WS_END = 506 * MiB;
constexpr int CW_BAR = 4096;
constexpr int CW_FIN = 24576;
constexpr int CW_TOT = 16384;

constexpr int RING_OFF = 0, RING_BYTES = 131072;
constexpr int LDSCTL_OFF = RING_BYTES, MISC_OFF = LDSCTL_OFF + 320;
constexpr int LDS_BYTES = 151552;

#define GAS __attribute__((address_space(1)))
#define LAS __attribute__((address_space(3)))
typedef unsigned short bf16;
typedef unsigned v4u __attribute__((ext_vector_type(4)));
typedef unsigned v2u __attribute__((ext_vector_type(2)));
typedef float f32x4 __attribute__((ext_vector_type(4)));
typedef GAS unsigned gu32;
#define RLX_AGENT __ATOMIC_RELAXED, __HIP_MEMORY_SCOPE_AGENT
#define LDS_WAIT() asm volatile("s_waitcnt lgkmcnt(0)" ::: "memory")
__device__ __forceinline__ unsigned f2bf(float f) { unsigned u = __builtin_bit_cast(unsigned, f); return (u + 0x7fffu + ((u >> 16) & 1u)) >> 16; }
__device__ __forceinline__ unsigned pk2(float lo, float hi) { return f2bf(lo) | (f2bf(hi) << 16); }
__device__ __forceinline__ float bf2f(unsigned short v) { return __builtin_bit_cast(float, (unsigned)v << 16); }

#define XB_TMO      128
#define XB_XCNT(j)  (256  + 64 * (j))
#define XB_XSUB(j)  (1280 + 64 * (j))
#define XB_XGEN(j)  (2304 + 64 * (j))
#define XB_TOP      3328
#define XB_TOPGEN   3392
#define XCD_BAR_WORDS 3456
#define XB_SPIN_CAP (1u << 18)
__device__ __forceinline__ unsigned xb_ld(GAS unsigned* p)              { return __hip_atomic_load(p, __ATOMIC_RELAXED, __HIP_MEMORY_SCOPE_AGENT); }
__device__ __forceinline__ unsigned xb_add(GAS unsigned* p, unsigned v) { return __hip_atomic_fetch_add(p, v, __ATOMIC_RELAXED, __HIP_MEMORY_SCOPE_AGENT); }
__device__ __forceinline__ unsigned xb_xcc_id() { return (unsigned)__builtin_amdgcn_s_getreg((3 << 11) | 20) & 0xFu; }
#define XB_SPIN(cond, bar) do { unsigned _sp = 0; while (cond) { __builtin_amdgcn_s_sleep(1); \
    if ((++_sp & 255u) == 0u) { if (xb_ld(&(bar)[XB_TMO])) break; if (_sp > XB_SPIN_CAP) { (void)xb_add(&(bar)[XB_TMO], 1u); break; } } } } while (0)
struct XcdBarrier { GAS unsigned* bar; unsigned x; volatile LAS unsigned* st; int wave; };
__device__ __forceinline__ XcdBarrier xcd_barrier_post(GAS unsigned* bar, volatile LAS unsigned* st) {
    XcdBarrier b; b.bar = bar; b.x = xb_xcc_id(); b.st = st;
    if (threadIdx.x == 0) (void)xb_add(&bar[XB_XCNT(b.x)], 1u);
    return b;
}
__device__ __forceinline__ void xcd_barrier_complete(GAS unsigned* bar, unsigned x, unsigned& nloc, unsigned& nx) {
    const unsigned G = gridDim.x * gridDim.y * gridDim.z;
    unsigned sum, cnt, mine, sp = 0u;
    for (;;) {
        sum = 0u; cnt = 0u; mine = 0u;
#pragma unroll
        for (unsigned j = 0; j < 16; ++j) { const unsigned c = xb_ld(&bar[XB_XCNT(j)]); sum += c; cnt += (c > 0u) ? 1u : 0u; mine = (j == x) ? c : mine; }
        if (sum == G) break;
        __builtin_amdgcn_s_sleep(1);
        if ((++sp & 255u) == 0u) { if (xb_ld(&bar[XB_TMO])) break; if (sp > XB_SPIN_CAP) { (void)xb_add(&bar[XB_TMO], 1u); break; } }
    }
    nloc = mine > 0u ? mine : 1u; nx = cnt > 0u ? cnt : 1u;
}
__device__ __forceinline__ void xcd_barrier(const XcdBarrier& b) {
    asm volatile("s_waitcnt vmcnt(0)" ::: "memory");
    __syncthreads();
    if (b.wave == 0 && lane_id() == 0) {
        GAS unsigned* bar = b.bar; asm volatile("" : "+s"(bar));
        const unsigned bx = xb_xcc_id();
        __builtin_amdgcn_s_waitcnt(0);
        unsigned nloc = b.st[0], nx = b.st[1];
        if (nloc == 0u) { xcd_barrier_complete(bar, bx, nloc, nx); b.st[0] = nloc; b.st[1] = nx; }
        const unsigned old = xb_add(&bar[XB_XSUB(bx)], 1u);
        const unsigned gen = old / nloc;
        if (old + 1u == (gen + 1u) * nloc) {
            __builtin_amdgcn_fence(__ATOMIC_RELEASE, "agent");
            asm volatile("s_waitcnt vmcnt(0)" ::: "memory");
            const unsigned og = xb_add(&bar[XB_TOP], 1u);
            const unsigned tg = og / nx;
            if (og + 1u == (tg + 1u) * nx) xb_add(&bar[XB_TOPGEN], 1u);
            else XB_SPIN(xb_ld(&bar[XB_TOPGEN]) == tg, bar);
            __builtin_amdgcn_fence(__ATOMIC_ACQUIRE, "agent");
            xb_add(&bar[XB_XGEN(bx)], 1u);
            asm volatile("s_waitcnt vmcnt(0)" ::: "memory");
        } else {
            XB_SPIN(xb_ld(&bar[XB_XGEN(bx)]) == gen, bar);
            __builtin_amdgcn_fence(__ATOMIC_ACQUIRE, "agent");
            asm volatile("s_waitcnt vmcnt(0)" ::: "memory");
        }
    }
    __syncthreads();
}

struct Args { const GAS float* in[14]; GAS float* out; GAS unsigned char* ws; };
struct Frame {
    LAS unsigned char* lds; int tid, lane, wave, vcu, G;
    const GAS float *x, *c, *rel_bias, *w_mod, *b_mod, *norm_mix, *norm_mlp, *w_pool, *pool_scale, *w_qkv, *w_o, *w_up, *w_down, *norm_final;
    GAS float* out; GAS unsigned char* ws;
};
__device__ __forceinline__ float wave_sum(float v) {
#pragma unroll
    for (int o = 1; o < 64; o <<= 1) v += __shfl_xor(v, o);
    return v;
}

struct TItem { const GAS float* W; GAS bf16* WT; int K, N, row_off, item; };
__device__ __forceinline__ void tload(const TItem& I, f32x4 (&t)[8], int lane) {
    const int nblk = I.N / 32, kb = I.item / nblk, nb = I.item % nblk, k0 = 64 * kb, n0 = 32 * nb;
#pragma unroll
    for (int i = 0; i < 8; ++i) t[i] = *(const GAS f32x4*)(I.W + (size_t)(k0 + 8 * i + (lane >> 3)) * I.N + n0 + 4 * (lane & 7));
}
__device__ __forceinline__ void tstore(const TItem& I, const f32x4 (&t)[8], LAS float* scr, int lane) {
    const int nblk = I.N / 32, kb = I.item / nblk, nb = I.item % nblk, k0 = 64 * kb, n0 = 32 * nb;
#pragma unroll
    for (int i = 0; i < 8; ++i) { LAS float* d = scr + (8 * i + (lane >> 3)) * 33 + 4 * (lane & 7); d[0] = t[i][0]; d[1] = t[i][1]; d[2] = t[i][2]; d[3] = t[i][3]; }
    LDS_WAIT(); asm volatile("" ::: "memory");
    const int c = lane & 7;
#pragma unroll
    for (int j = 0; j < 4; ++j) { const int n = (lane >> 3) + 8 * j; const LAS float* s = scr + (8 * c) * 33 + n;
        v4u o; o.x = pk2(s[0 * 33], s[1 * 33]); o.y = pk2(s[2 * 33], s[3 * 33]); o.z = pk2(s[4 * 33], s[5 * 33]); o.w = pk2(s[6 * 33], s[7 * 33]);
        *(GAS v4u*)(I.WT + (size_t)(I.row_off + n0 + n) * I.K + k0 + 8 * c) = o; }
    LDS_WAIT(); asm volatile("" ::: "memory");
}
__device__ __forceinline__ void p0_prologue(Frame& F) {
    if (F.vcu < 192) {
        LAS float* cact = (LAS float*)(F.lds + 67584);
        LAS float* red = (LAS float*)(F.lds + 67584 + 16384);
        const int l = F.vcu / 96, j0 = (F.vcu % 96) * 64;
        for (int i = F.tid; i < 4096; i += NWAVES * 64) { const float v = F.c[i]; cact[i] = v / (1.f + __expf(-v)); }
        __syncthreads();
        const int sub = F.lane >> 4, c4 = F.lane & 15;
        f32x4 a0 = {0.f, 0.f, 0.f, 0.f}, a1 = a0, a2 = a0, a3 = a0;
        const GAS float* wb = F.w_mod + (size_t)l * 1024 * 6144 + j0 + 4 * c4;
#pragma unroll 4
        for (int it = 0; it < 32; ++it) { const int k = 32 * it + 4 * F.wave + sub; const f32x4 wv = *(const GAS f32x4*)(wb + (size_t)k * 6144);
            a0 += wv * cact[k]; a1 += wv * cact[1024 + k]; a2 += wv * cact[2048 + k]; a3 += wv * cact[3072 + k]; }
#pragma unroll
        for (int j = 0; j < 4; ++j) { a0[j] += __shfl_xor(a0[j], 16); a0[j] += __shfl_xor(a0[j], 32); a1[j] += __shfl_xor(a1[j], 16); a1[j] += __shfl_xor(a1[j], 32);
            a2[j] += __shfl_xor(a2[j], 16); a2[j] += __shfl_xor(a2[j], 32); a3[j] += __shfl_xor(a3[j], 16); a3[j] += __shfl_xor(a3[j], 32); }
        if (sub == 0) { LAS f32x4* r4 = (LAS f32x4*)(red + F.wave * 256); r4[0 * 16 + c4] = a0; r4[1 * 16 + c4] = a1; r4[2 * 16 + c4] = a2; r4[3 * 16 + c4] = a3; }
        __syncthreads();
        if (F.tid < 256) { const int b = F.tid >> 6, col = F.tid & 63; float s = 0.f;
#pragma unroll
            for (int w = 0; w < 8; ++w) s += red[w * 256 + b * 64 + col];
            ((GAS float*)(F.ws + WS_MOD))[(l * 4 + b) * 6144 + j0 + col] = s + F.b_mod[l * 6144 + j0 + col]; }
    }
    LAS float* scr = (LAS float*)(F.lds + RING_OFF + F.wave * 8448);
    const int gw = F.vcu * NWAVES + F.wave, NGW = F.G * NWAVES;
    constexpr int I_POOL = 4 * 32, I_QKV = 16 * 96, I_O = 16 * 32, I_UP = 16 * 128, I_DN = 64 * 32;
    constexpr int NITEMS = I_POOL + I_QKV + I_O + 2 * I_UP + 2 * I_DN;
    auto desc = [&](int it) -> TItem {
        int r = it;
        if (r < I_POOL) { const int g = r / 32; return TItem{F.w_pool + (size_t)g * 65536, (GAS bf16*)(F.ws + WS_WPOOL), 256, 256, g * 256, r % 32}; } r -= I_POOL;
        if (r < I_QKV) return TItem{F.w_qkv, (GAS bf16*)(F.ws + WS_WQKV), D, NQKV, 0, r}; r -= I_QKV;
        if (r < I_O) return TItem{F.w_o, (GAS bf16*)(F.ws + WS_WO), D, D, 0, r}; r -= I_O;
        if (r < 2 * I_UP) { const int l = r / I_UP; return TItem{F.w_up + (size_t)l * D * FF, (GAS bf16*)(F.ws + (l ? WS_WUP1 : WS_WUP0)), D, FF, 0, r % I_UP}; } r -= 2 * I_UP;
        const int l = r / I_DN; return TItem{F.w_down + (size_t)l * FF * D, (GAS bf16*)(F.ws + (l ? WS_WDN1 : WS_WDN0)), FF, D, 0, r % I_DN};
    };
    f32x4 ta[8], tb[8];
    int it = gw;
    if (it < NITEMS) { TItem cur = desc(it); tload(cur, ta, F.lane);
        for (;;) {
            const int itn = it + NGW; const bool hn = itn < NITEMS; TItem nxt = cur;
            if (hn) { nxt = desc(itn); tload(nxt, tb, F.lane); }
            tstore(cur, ta, scr, F.lane);
            if (!hn) break;
#pragma unroll
            for (int i = 0; i < 8; ++i) ta[i] = tb[i];
            cur = nxt; it = itn;
        } }
}

__device__ __forceinline__ void p1_bias(Frame& F) {
    const int gw = F.vcu * NWAVES + F.wave, NGW = F.G * NWAVES;
    const GAS float* MOD = (const GAS float*)(F.ws + WS_MOD);
#pragma unroll 1
    for (int seg = 0; seg < 3; ++seg) {
        const GAS bf16* wt; const GAS float* sh; GAS float* dst; int N; GAS bf16* wsc; const GAS float* gam;
        if (seg == 0) { N = 4096; wt = (const GAS bf16*)(F.ws + WS_WUP0); sh = MOD + 3072; dst = (GAS float*)(F.ws + WS_BIAS_UP0); wsc = (GAS bf16*)(F.ws + WS_WSUP0); gam = F.norm_mlp; }
        else if (seg == 1) { N = 3072; wt = (const GAS bf16*)(F.ws + WS_WQKV); sh = MOD + 4 * 6144; dst = (GAS float*)(F.ws + WS_BIAS_QKV); wsc = (GAS bf16*)((GAS unsigned char*)F.out + OUT_WSQKV); gam = F.norm_mix + D; }
        else { N = 4096; wt = (const GAS bf16*)(F.ws + WS_WUP1); sh = MOD + 4 * 6144 + 3072; dst = (GAS float*)(F.ws + WS_BIAS_UP1); wsc = (GAS bf16*)(F.ws + WS_WSUP1); gam = F.norm_mlp + D; }
        int n = gw; if (n >= N) continue;
        float shv[4][16], gv[4][16];
#pragma unroll
        for (int b = 0; b < 4; ++b) { const GAS f32x4* sp = (const GAS f32x4*)(sh + b * 6144 + F.lane * 16); const GAS f32x4* cp = (const GAS f32x4*)(sh + 1024 + b * 6144 + F.lane * 16); const GAS f32x4* gp = (const GAS f32x4*)(gam + F.lane * 16);
#pragma unroll
            for (int j = 0; j < 4; ++j) { const f32x4 sv = sp[j], cv = cp[j], g4 = gp[j];
#pragma unroll
                for (int i = 0; i < 4; ++i) { shv[b][4 * j + i] = sv[i]; gv[b][4 * j + i] = g4[i] * (1.0f + cv[i]); } } }
        v4u w0 = *(const GAS v4u*)(wt + (size_t)n * 1024 + F.lane * 16), w1 = *(const GAS v4u*)(wt + (size_t)n * 1024 + F.lane * 16 + 8);
        for (;;) {
            const int nn = n + NGW; const bool hn = nn < N; v4u x0 = w0, x1 = w1;
            if (hn) { x0 = *(const GAS v4u*)(wt + (size_t)nn * 1024 + F.lane * 16); x1 = *(const GAS v4u*)(wt + (size_t)nn * 1024 + F.lane * 16 + 8); }
            float wf[16];
#pragma unroll
            for (int j = 0; j < 4; ++j) { wf[2 * j] = __builtin_bit_cast(float, w0[j] << 16); wf[2 * j + 1] = __builtin_bit_cast(float, w0[j] & 0xffff0000u);
                wf[8 + 2 * j] = __builtin_bit_cast(float, w1[j] << 16); wf[8 + 2 * j + 1] = __builtin_bit_cast(float, w1[j] & 0xffff0000u); }
#pragma unroll
            for (int b = 0; b < 4; ++b) { float s = 0.f;
#pragma unroll
                for (int i = 0; i < 16; ++i) s += wf[i] * shv[b][i];
                s = wave_sum(s); if (F.lane == 0) dst[b * N + n] = s;
                unsigned pk[8];
#pragma unroll
                for (int i = 0; i < 8; ++i) pk[i] = pg8::cvt_pk_bf16(wf[2 * i] * gv[b][2 * i], wf[2 * i + 1] * gv[b][2 * i + 1]);
                GAS v4u* wp = (GAS v4u*)(wsc + ((size_t)b * N + n) * 1024 + F.lane * 16); wp[0] = (v4u){pk[0], pk[1], pk[2], pk[3]}; wp[1] = (v4u){pk[4], pk[5], pk[6], pk[7]}; }
            if (!hn) break;
            w0 = x0; w1 = x1; n = nn;
        }
    }
}
__device__ __forceinline__ void p1_pool(Frame& F) {
    LAS float* ring = (LAS float*)(F.lds + RING_OFF);
    const GAS float* MOD = (const GAS float*)(F.ws + WS_MOD); GAS bf16* XN = (GAS bf16*)(F.ws + WS_XNA); GAS bf16* XR = (GAS bf16*)(F.ws + WS_XR);
    for (int run = F.vcu; run < M / 128; run += F.G) {
        const int t0 = run * 128, s0 = t0 % SEQ, b = t0 / SEQ;
        f32x4 gam[4];
#pragma unroll
        for (int j = 0; j < 4; ++j) gam[j] = *(const GAS f32x4*)(F.norm_mix + 4 * (F.lane + 64 * j));
        const int c4 = F.tid & 255, rh = F.tid >> 8, gi = c4 >> 6, w = 2 << gi;
        const f32x4 sc1 = *(const GAS f32x4*)(MOD + b * 6144 + 1024 + 4 * c4) + 1.0f;
        f32x4 v[2][4];
        const GAS float* xb = F.x + (size_t)b * SEQ * D + 4 * F.lane;
        int st = (s0 > 0 ? -1 : 0);
#pragma unroll
        for (int rr = 0; rr < 2; ++rr)
#pragma unroll
            for (int j = 0; j < 4; ++j) v[rr][j] = *(const GAS f32x4*)(xb + (size_t)(s0 + 16 * st + 2 * F.wave + rr) * D + 256 * j);
        for (; st < 8; ++st) {
            if (st >= 0) {
#pragma unroll
                for (int rr = 0; rr < 2; ++rr)
#pragma unroll
                    for (int j = 0; j < 4; ++j) { v2u o2; o2.x = pk2(v[rr][j][0], v[rr][j][1]); o2.y = pk2(v[rr][j][2], v[rr][j][3]);
                        { const size_t trow = (size_t)b * SEQ + s0 + 16 * st + 2 * F.wave + rr; *(GAS v2u*)(XR + (((trow >> 8) * 4 + j) * 256 + (trow & 255)) * 256 + 4 * F.lane) = o2; } } }
            float ss0 = 0.f, ss1 = 0.f;
#pragma unroll
            for (int j = 0; j < 4; ++j) { ss0 += (v[0][j][0] * v[0][j][0] + v[0][j][1] * v[0][j][1]) + (v[0][j][2] * v[0][j][2] + v[0][j][3] * v[0][j][3]);
                ss1 += (v[1][j][0] * v[1][j][0] + v[1][j][1] * v[1][j][1]) + (v[1][j][2] * v[1][j][2] + v[1][j][3] * v[1][j][3]); }
#pragma unroll
            for (int o = 1; o < 64; o <<= 1) { ss0 += __shfl_xor(ss0, o); ss1 += __shfl_xor(ss1, o); }
            const float rs0 = rsqrtf(ss0 * (1.0f / D) + EPS), rs1 = rsqrtf(ss1 * (1.0f / D) + EPS);
            { const int sr = s0 + 16 * st + 2 * F.wave;
#pragma unroll
              for (int j = 0; j < 4; ++j) { *(LAS f32x4*)(ring + (sr & 31) * 1024 + 4 * (F.lane + 64 * j)) = v[0][j] * rs0 * gam[j]; *(LAS f32x4*)(ring + ((sr + 1) & 31) * 1024 + 4 * (F.lane + 64 * j)) = v[1][j] * rs1 * gam[j]; } }
            if (st + 1 < 8) {
#pragma unroll
                for (int rr = 0; rr < 2; ++rr)
#pragma unroll
                    for (int j = 0; j < 4; ++j) v[rr][j] = *(const GAS f32x4*)(xb + (size_t)(s0 + 16 * (st + 1) + 2 * F.wave + rr) * D + 256 * j); }
            __syncthreads();
            if (st >= 0) {
                const int sA = s0 + 16 * st + 8 * rh;
                f32x4 sum = {0.f, 0.f, 0.f, 0.f};
                { const int cnt0 = (sA < w) ? sA : w; for (int i = 1; i <= cnt0; ++i) sum += *(const LAS f32x4*)(ring + ((sA - i) & 31) * 1024 + 4 * c4); }
#pragma unroll
                for (int r = 0; r < 8; ++r) { const int s = sA + r; const f32x4 cur = *(const LAS f32x4*)(ring + (s & 31) * 1024 + 4 * c4);
                    sum += cur; if (s >= w) sum -= *(const LAS f32x4*)(ring + ((s - w) & 31) * 1024 + 4 * c4);
                    const float inv = 1.0f / (float)((s + 1 < w) ? s + 1 : w);
                    const f32x4 p = (sum * inv - cur) * sc1;
                    v2u o; o.x = pk2(p[0], p[1]); o.y = pk2(p[2], p[3]);
                    *(GAS v2u*)(XN + ((size_t)b * SEQ + s) * D + 4 * c4) = o; }
            }
            __syncthreads();
        }
    }
}

__device__ __forceinline__ int t5_bucket(int dist) {
    if (dist < 16) return dist;
    int b = 16;
    b += (dist >= 21); b += (dist >= 27); b += (dist >= 35); b += (dist >= 46); b += (dist >= 59); b += (dist >= 77); b += (dist >= 99); b += (dist >= 128);
    b += (dist >= 166); b += (dist >= 216); b += (dist >= 280); b += (dist >= 363); b += (dist >= 470); b += (dist >= 609); b += (dist >= 790);
    return b;
}
namespace att {
typedef short bf16x8 __attribute__((ext_vector_type(8)));
typedef short s16x4 __attribute__((ext_vector_type(4)));
typedef short v4i16_t __attribute__((ext_vector_type(4)));
typedef float f32x16 __attribute__((ext_vector_type(16)));
typedef float f32x2_t __attribute__((ext_vector_type(2)));
typedef __bf16 bf16x2_t __attribute__((ext_vector_type(2)));
typedef LAS const char* lds_cptr;
constexpr int L_K = 0, L_V = 32768, L_LUT = 132096, L_QI = 141312, L_CUM = 142336, L_PRE = 142592;
constexpr int LUTN = 2304;
__device__ __forceinline__ int crow(int r, int hi) { return (r & 3) + 8 * (r >> 2) + 4 * hi; }
__device__ __forceinline__ unsigned cvtpk(float lo, float hi) { f32x2_t v = {lo, hi}; bf16x2_t b = __builtin_convertvector(v, bf16x2_t); return __builtin_bit_cast(unsigned, b); }
__device__ __forceinline__ s16x4 vtr(lds_cptr p) { return __builtin_bit_cast(s16x4, __builtin_amdgcn_ds_read_tr16_b64_v4i16((LAS v4i16_t*)p)); }
__device__ __forceinline__ float swap_add(float v) { auto rr = __builtin_amdgcn_permlane32_swap(__float_as_uint(v), __float_as_uint(v), false, false); return __uint_as_float(rr[0]) + __uint_as_float(rr[1]); }

__device__ __forceinline__ void load_kv(LAS unsigned char* lds, const GAS bf16* Kb, const GAS bf16* Vb, int b, int h, int n, int w, int lane) {
#pragma unroll
    for (int t = 0; t < 4; ++t) {
        const size_t kr = (size_t)b * SEQ + n * BLK + 64 * t + lane, vr = (size_t)b * SEQ + n * BLK + 64 * t + 16 * (w & 3) + (lane >> 2);
        const v4u kv = *(const GAS v4u*)(Kb + hm_off(kr, b, h) + w * 8);
        const v4u vv = *(const GAS v4u*)(Vb + hm_off(vr, b, h) + (w >> 2) * 32 + (lane & 3) * 8);
        *(LAS v4u*)(lds + L_K + t * 8192 + w * 1024 + lane * 16) = kv;
        *(LAS v4u*)(lds + L_V + t * 8192 + w * 1024 + lane * 16) = vv;
    }
}
__device__ __forceinline__ void build_lut(LAS unsigned char* lds, const GAS float* rel_bias, int h, int tid) {
    for (int i = tid; i < LUTN; i += NWAVES * 64) ((LAS float*)(lds + L_LUT))[i] = (i <= 2047) ? rel_bias[t5_bucket(2047 - i) * NH + h] * LOG2E : 0.f;
}
__device__ __forceinline__ void qk_tile(f32x16& p0, f32x16& p1, lds_cptr Kt, const bf16x8* qr, const f32x16& cinit, int r32, int hi) {
    const unsigned kb0 = (unsigned)(r32 * 128 + ((hi ^ ((r32 >> 1) & 7)) * 16));
#pragma unroll
    for (int d0 = 0; d0 < 4; ++d0) {
        const bf16x8 b0 = *(LAS const bf16x8*)(Kt + (kb0 ^ (unsigned)(d0 * 32))), b1 = *(LAS const bf16x8*)(Kt + (kb0 ^ (unsigned)(d0 * 32)) + 4096);
        if (d0 == 0) { p0 = __builtin_amdgcn_mfma_f32_32x32x16_bf16(b0, qr[0], cinit, 0, 0, 0); p1 = __builtin_amdgcn_mfma_f32_32x32x16_bf16(b1, qr[0], cinit, 0, 0, 0); }
        else { p0 = __builtin_amdgcn_mfma_f32_32x32x16_bf16(b0, qr[d0], p0, 0, 0, 0); p1 = __builtin_amdgcn_mfma_f32_32x32x16_bf16(b1, qr[d0], p1, 0, 0, 0); }
    }
}
template <bool BIAS, bool MASK>
__device__ __forceinline__ void softmax_tile(f32x16& p0, f32x16& p1, LAS const float* lutp, int jt, int qrel, int hi, float& l, v4u* pa) {
#pragma unroll
    for (int r = 0; r < 16; ++r) { const int ko = 64 * jt + (r & 3) + 8 * (r >> 2);
        if (BIAS) { p0[r] += lutp[ko]; p1[r] += lutp[ko + 32]; }
        if (MASK) { const int kv = ko + 4 * hi; if (kv > qrel) p0[r] = -INFINITY; if (kv + 32 > qrel) p1[r] = -INFINITY; }
        p0[r] = __builtin_amdgcn_exp2f(p0[r]); p1[r] = __builtin_amdgcn_exp2f(p1[r]); }
    float s = 0.f;
#pragma unroll
    for (int r = 0; r < 16; ++r) s += p0[r] + p1[r];
    l += s;
    pa[0] = (v4u){cvtpk(p0[0], p0[1]), cvtpk(p0[2], p0[3]), cvtpk(p0[4], p0[5]), cvtpk(p0[6], p0[7])};
    pa[1] = (v4u){cvtpk(p0[8], p0[9]), cvtpk(p0[10], p0[11]), cvtpk(p0[12], p0[13]), cvtpk(p0[14], p0[15])};
    pa[2] = (v4u){cvtpk(p1[0], p1[1]), cvtpk(p1[2], p1[3]), cvtpk(p1[4], p1[5]), cvtpk(p1[6], p1[7])};
    pa[3] = (v4u){cvtpk(p1[8], p1[9]), cvtpk(p1[10], p1[11]), cvtpk(p1[12], p1[13]), cvtpk(p1[14], p1[15])};
}
__device__ __forceinline__ void pv_tile(f32x16* o, lds_cptr Vt, unsigned vo0, const v4u* pa) {
#pragma unroll
    for (int d0 = 0; d0 < 2; ++d0)
#pragma unroll
        for (int ks = 0; ks < 4; ++ks) { const s16x4 lo = vtr(Vt + (vo0 ^ (unsigned)(d0 * 64)) + ks * 2048), hi = vtr(Vt + (vo0 ^ (unsigned)(d0 * 64)) + ks * 2048 + 1024);
            const bf16x8 vf = (bf16x8){lo[0], lo[1], lo[2], lo[3], hi[0], hi[1], hi[2], hi[3]};
            o[d0] = __builtin_amdgcn_mfma_f32_32x32x16_bf16(vf, __builtin_bit_cast(bf16x8, pa[ks]), o[d0], 0, 0, 0); }
}
__device__ __forceinline__ void qk_half(f32x16& p, lds_cptr Kt, int s, const bf16x8* qr, const f32x16& cinit, int r32, int hi) {
    lds_cptr kb = Kt + hi * 1024 + r32 * 16 + s * 512;
#pragma unroll
    for (int d0 = 0; d0 < 4; ++d0) { const bf16x8 b0 = *(LAS const bf16x8*)(kb + d0 * 2048);
        if (d0 == 0) p = __builtin_amdgcn_mfma_f32_32x32x16_bf16(b0, qr[0], cinit, 0, 0, 0); else p = __builtin_amdgcn_mfma_f32_32x32x16_bf16(b0, qr[d0], p, 0, 0, 0); }
}
template <bool BIAS>
__device__ __forceinline__ void softmax_half(f32x16& p, LAS const float* lutp, int jt, int s, float& l, v4u& pa0, v4u& pa1) {
#pragma unroll
    for (int r = 0; r < 16; ++r) { const int ko = 64 * jt + 32 * s + (r & 3) + 8 * (r >> 2);
        if (BIAS) p[r] += lutp[ko];
        p[r] = __builtin_amdgcn_exp2f(p[r]); }
    float sm = 0.f;
#pragma unroll
    for (int r = 0; r < 16; ++r) sm += p[r];
    l += sm;
    pa0 = (v4u){cvtpk(p[0], p[1]), cvtpk(p[2], p[3]), cvtpk(p[4], p[5]), cvtpk(p[6], p[7])};
    pa1 = (v4u){cvtpk(p[8], p[9]), cvtpk(p[10], p[11]), cvtpk(p[12], p[13]), cvtpk(p[14], p[15])};
}
__device__ __forceinline__ void pv_half(f32x16* o, lds_cptr vp, int s, const v4u& pa0, const v4u& pa1) {
#pragma unroll
    for (int d0 = 0; d0 < 2; ++d0)
#pragma unroll
        for (int kk = 0; kk < 2; ++kk) { const int ks = 2 * s + kk; const s16x4 lo = vtr(vp + d0 * 4096 + ks * 1024), hi = vtr(vp + d0 * 4096 + ks * 1024 + 512);
            const bf16x8 vf = (bf16x8){lo[0], lo[1], lo[2], lo[3], hi[0], hi[1], hi[2], hi[3]};
            o[d0] = __builtin_amdgcn_mfma_f32_32x32x16_bf16(vf, __builtin_bit_cast(bf16x8, kk ? pa1 : pa0), o[d0], 0, 0, 0); }
}
struct SlotD { int kind, t, idx; };
__device__ __forceinline__ constexpr SlotD slot_desc(int g) {
    if (g < 4) return SlotD{0, 0, g};
    if (g < 8) return SlotD{0, 1, g - 4};
    if (g < 56) { const int tt = (g - 8) / 8 + 1, i = (g - 8) % 8; return (i & 1) ? SlotD{1, tt - 1, i >> 1} : SlotD{0, tt + 1, i >> 1}; }
    if (g < 60) return SlotD{1, 6, g - 56};
    return SlotD{1, 7, g - 60};
}
template <bool BIAS>
struct TileMath {
    f32x16 P[2]; unsigned pk[2][8]; v4u fr[3]; f32x2_t lv[4]; float e0, e1, l0, l1;
    f32x16* o; lds_cptr Kl, Vl; unsigned kb0, vo0; const bf16x8* qr; const f32x16* cinit; LAS const float* lutp;
    template <int G> __device__ __forceinline__ v4u load_frag() { constexpr SlotD d = slot_desc(G);
        if (d.kind == 0) return *(LAS const v4u*)(Kl + (kb0 ^ (unsigned)(d.idx * 32)) + (d.t >> 1) * 8192 + (d.t & 1) * 4096);
        constexpr int d0 = d.idx >> 1, ks = 2 * (d.t & 1) + (d.idx & 1); lds_cptr vp = Vl + (vo0 ^ (unsigned)(d0 * 64)) + (d.t >> 1) * 8192 + ks * 2048;
        const s16x4 a = vtr(vp), c = vtr(vp + 1024); return __builtin_bit_cast(v4u, (bf16x8){a[0], a[1], a[2], a[3], c[0], c[1], c[2], c[3]}); }
    template <int Q> __device__ __forceinline__ f32x2_t lut_pair() { constexpr int t = Q >> 3, r0 = 2 * (Q & 7), ko = 64 * (t >> 1) + 32 * (t & 1) + (r0 & 3) + 8 * (r0 >> 2); return (f32x2_t){lutp[ko], lutp[ko + 1]}; }
    template <int Q> __device__ __forceinline__ void chunk() { constexpr int t = Q >> 3, c = Q & 7;
        if constexpr (Q > 0) { l0 += e0; l1 += e1; pk[((Q - 1) >> 3) & 1][(Q - 1) & 7] = cvtpk(e0, e1); }
        float x0 = P[t & 1][2 * c], x1 = P[t & 1][2 * c + 1];
        if constexpr (BIAS) { x0 += lv[Q & 3][0]; x1 += lv[Q & 3][1]; if constexpr (Q + 3 < 64) lv[(Q + 3) & 3] = lut_pair<Q + 3>(); }
        e0 = __builtin_amdgcn_exp2f(x0); e1 = __builtin_amdgcn_exp2f(x1); }
    template <int G> __device__ __forceinline__ void slot() {
        if constexpr (G + 2 < 64) fr[(G + 2) % 3] = load_frag<G + 2>();
        { constexpr SlotD d = slot_desc(G); const bf16x8 a = __builtin_bit_cast(bf16x8, fr[G % 3]);
          if constexpr (d.kind == 0) { if constexpr (d.idx == 0) P[d.t & 1] = __builtin_amdgcn_mfma_f32_32x32x16_bf16(a, qr[0], *cinit, 0, 0, 0); else P[d.t & 1] = __builtin_amdgcn_mfma_f32_32x32x16_bf16(a, qr[d.idx], P[d.t & 1], 0, 0, 0); }
          else { constexpr int d0 = d.idx >> 1, kk = d.idx & 1;
              o[d0] = __builtin_amdgcn_mfma_f32_32x32x16_bf16(a, __builtin_bit_cast(bf16x8, (v4u){pk[d.t & 1][4 * kk], pk[d.t & 1][4 * kk + 1], pk[d.t & 1][4 * kk + 2], pk[d.t & 1][4 * kk + 3]}), o[d0], 0, 0, 0); } }
        if constexpr (G >= 4 && G < 8) { chunk<2 * (G - 4)>(); chunk<2 * (G - 4) + 1>(); }
        else if constexpr (G >= 8 && G < 56) chunk<G>();
        else if constexpr (G >= 56 && G < 60) { chunk<56 + 2 * (G - 56)>(); chunk<56 + 2 * (G - 56) + 1>(); if constexpr (G == 59) { l0 += e0; l1 += e1; pk[1][7] = cvtpk(e0, e1); } }
        __builtin_amdgcn_sched_barrier(0);
    }
    template <int... G> __device__ __forceinline__ void run(std::integer_sequence<int, G...>) { (slot<G>(), ...); }
};
template <bool BIAS>
__device__ __forceinline__ void tile_math(f32x16* o, float& l, lds_cptr Kl, lds_cptr Vl, unsigned vo0, const bf16x8* qr, const f32x16& cinit, LAS const float* lutp, int r32, int hi) {
    TileMath<BIAS> T; T.o = o; T.Kl = Kl; T.kb0 = (unsigned)(r32 * 128 + ((hi ^ ((r32 >> 1) & 7)) * 16)); T.Vl = Vl; T.vo0 = vo0; T.qr = qr; T.cinit = &cinit; T.lutp = lutp; T.e0 = T.e1 = T.l0 = T.l1 = 0.f;
    if constexpr (BIAS) { T.lv[0] = T.template lut_pair<0>(); T.lv[1] = T.template lut_pair<1>(); T.lv[2] = T.template lut_pair<2>(); }
    T.fr[0] = T.template load_frag<0>(); T.fr[1] = T.template load_frag<1>();
    __builtin_amdgcn_sched_barrier(0);
    T.run(std::make_integer_sequence<int, 64>{});
    l += T.l0 + T.l1;
}
__device__ __forceinline__ void load_q_raw(bf16x8* qr, const GAS bf16* Qb, size_t qrow, int b, int h, int hi) {
#pragma unroll
    for (int d0 = 0; d0 < 4; ++d0) { const v4u v = *(const GAS v4u*)(Qb + hm_off(qrow, b, h) + d0 * 16 + hi * 8); qr[d0] = __builtin_bit_cast(bf16x8, v); }
}
__device__ __forceinline__ float q_norm2(const bf16x8* qr) {
    float q2 = 0.f;
#pragma unroll
    for (int d0 = 0; d0 < 4; ++d0) { const v4u v = __builtin_bit_cast(v4u, qr[d0]);
#pragma unroll
        for (int j = 0; j < 4; ++j) { const float a = __builtin_bit_cast(float, v[j] << 16), c = __builtin_bit_cast(float, v[j] & 0xffff0000u); q2 += a * a + c * c; } }
    return swap_add(q2);
}

__device__ __forceinline__ float ref_exponent(float q2, float kmax2, float bmax) { return __builtin_sqrtf(q2 * kmax2) * 1.002f + bmax + 0.01f; }
__device__ __forceinline__ void head_bounds(const GAS float* KBM, const GAS float* rel_bias, int bh, int h, int lane, float& kmax2, float& bmax) {
    float k = KBM[bh * 32 + (lane & 31)], bb = rel_bias[(lane & 31) * NH + h] * LOG2E;
#pragma unroll
    for (int o = 1; o < 32; o <<= 1) { k = fmaxf(k, shx(k, o, lane)); bb = fmaxf(bb, shx(bb, o, lane)); }
    kmax2 = k; bmax = bb;
}
__device__ __forceinline__ void store_row(GAS bf16* rowp, const f32x16* o, float scale, int hi, bool act) {
    unsigned w0[8], w1[8];
#pragma unroll
    for (int k = 0; k < 4; ++k) { w0[2 * k] = cvtpk(o[0][4 * k] * scale, o[0][4 * k + 1] * scale); w0[2 * k + 1] = cvtpk(o[0][4 * k + 2] * scale, o[0][4 * k + 3] * scale);
        w1[2 * k] = cvtpk(o[1][4 * k] * scale, o[1][4 * k + 1] * scale); w1[2 * k + 1] = cvtpk(o[1][4 * k + 2] * scale, o[1][4 * k + 3] * scale); }
#pragma unroll
    for (int i = 0; i < 8; ++i) { auto r = __builtin_amdgcn_permlane32_swap(w0[i], w1[i], false, false); w0[i] = r[0]; w1[i] = r[1]; }
    if (act) {
#pragma unroll
        for (int k = 0; k < 4; ++k) *(GAS v4u*)(rowp + 32 * hi + 8 * k) = (v4u){w0[2 * k], w0[2 * k + 1], w1[2 * k], w1[2 * k + 1]}; }
}
__device__ __forceinline__ void add_row(f32x16* o, const GAS bf16* rowp, int hi) {
    v4u v[4];
#pragma unroll
    for (int k = 0; k < 4; ++k) v[k] = *(const GAS v4u*)(rowp + 32 * hi + 8 * k);
#pragma unroll
    for (int k = 0; k < 4; ++k) { auto r0 = __builtin_amdgcn_permlane32_swap(v[k][0], v[k][2], false, false); auto r1 = __builtin_amdgcn_permlane32_swap(v[k][1], v[k][3], false, false);
        o[0][4 * k] += __builtin_bit_cast(float, r0[0] << 16); o[0][4 * k + 1] += __builtin_bit_cast(float, r0[0] & 0xffff0000u);
        o[0][4 * k + 2] += __builtin_bit_cast(float, r1[0] << 16); o[0][4 * k + 3] += __builtin_bit_cast(float, r1[0] & 0xffff0000u);
        o[1][4 * k] += __builtin_bit_cast(float, r0[1] << 16); o[1][4 * k + 1] += __builtin_bit_cast(float, r0[1] & 0xffff0000u);
        o[1][4 * k + 2] += __builtin_bit_cast(float, r1[1] << 16); o[1][4 * k + 3] += __builtin_bit_cast(float, r1[1] & 0xffff0000u); }
}
__device__ __forceinline__ GAS bf16* po_row(GAS unsigned char* ws, GAS float* outbuf, int b, int h, int t, int slot) {
    return (b < 2 ? (GAS bf16*)outbuf : (GAS bf16*)(ws + WS_POB)) + ((((size_t)((b & 1) * 16 + h) * SEQ + t) * 3 + slot) * 64);
}

__device__ __forceinline__ void glds16(const GAS void* gsrc, unsigned lds_dst) {
    unsigned keep;
    asm volatile("s_mov_b32 %0, m0\n\ts_mov_b32 m0, %2\n\ts_nop 0\n\tglobal_load_lds_dwordx4 %1, off\n\ts_mov_b32 m0, %0" : "=&s"(keep) : "v"(gsrc), "s"(lds_dst) : "memory");
}
struct Top3 { float g1, g2, g3; int i1, i2, i3; };
__device__ __forceinline__ void top3_insert(Top3& T, float g, int n) {
    const bool c1 = g > T.g1, c2 = g > T.g2, c3 = g > T.g3;
    T.g3 = c2 ? T.g2 : (c3 ? g : T.g3); T.i3 = c2 ? T.i2 : (c3 ? n : T.i3);
    T.g2 = c1 ? T.g1 : (c2 ? g : T.g2); T.i2 = c1 ? T.i1 : (c2 ? n : T.i2);
    T.g1 = c1 ? g : T.g1;               T.i1 = c1 ? n : T.i1;
}
__device__ __forceinline__ void top3_insert_tie(Top3& T, float g, int n) {
    const bool ok = n >= 0;
    const bool c1 = ok && (g > T.g1 || (g == T.g1 && n < T.i1) || T.i1 < 0), c2 = ok && (g > T.g2 || (g == T.g2 && n < T.i2) || T.i2 < 0), c3 = ok && (g > T.g3 || (g == T.g3 && n < T.i3) || T.i3 < 0);
    T.g3 = c2 ? T.g2 : (c3 ? g : T.g3); T.i3 = c2 ? T.i2 : (c3 ? n : T.i3);
    T.g2 = c1 ? T.g1 : (c2 ? g : T.g2); T.i2 = c1 ? T.i1 : (c2 ? n : T.i2);
    T.g1 = c1 ? g : T.g1;               T.i1 = c1 ? n : T.i1;
}
__device__ __forceinline__ void route(Frame& F) {
    GAS unsigned char* ws = F.ws;
    const GAS bf16* Qb = (const GAS bf16*)(ws + WS_Q); const GAS bf16* Kb = (const GAS bf16*)(ws + WS_K);
    const GAS float* KMP = (const GAS float*)(ws + WS_KMP);
    GAS unsigned short* SEG = (GAS unsigned short*)(ws + WS_SEG); GAS unsigned* CNT = (GAS unsigned*)(ws + WS_CNT); GAS unsigned* TOT = (GAS unsigned*)(ws + WS_CTL) + CW_TOT;
    GAS float* KBM = (GAS float*)(ws + WS_KBM);
    int tid = F.wave * 64 + lane_id(); asm volatile("" : "+v"(tid));
    const int hf = tid >> 8, t = tid & 255, lane = tid & 63, w4 = __builtin_amdgcn_readfirstlane((tid >> 6) & 3), r32 = lane & 31, hi = lane >> 5;
    constexpr int HS = 20480;
    LAS unsigned char* hb = F.lds + __builtin_amdgcn_readfirstlane(hf) * HS;
    LAS unsigned* cntw = (LAS unsigned*)(hb + 16384);
    LAS float* kbw = (LAS float*)(hb + 16384 + 512);
    const int ua = (F.vcu * 2 + hf) >> 6, bh = (F.vcu * 2 + hf) & 63, b = bh >> 4, h = bh & 15;
    auto own_of = [&](int it) -> int { return it == 0 ? ua : it == 1 ? 31 - ua : it == 2 ? 8 + ua : 23 - ua; };
    v4u kreg[8]; float kmreg[8]; bf16x8 qf[2][4];
    auto prefetch = [&](int own) {
        const size_t row0 = (size_t)b * SEQ + own * BLK + 64 * w4;
#pragma unroll
        for (int tq = 0; tq < 2; ++tq)
#pragma unroll
            for (int d0 = 0; d0 < 4; ++d0) qf[tq][d0] = __builtin_bit_cast(bf16x8, *(const GAS v4u*)(Qb + hm_off(row0 + 32 * tq + r32, b, h) + d0 * 16 + hi * 8));
#pragma unroll
        for (int i = 0; i < 8; ++i) kreg[i] = *(const GAS v4u*)(Kb + hm_off(row0 + 8 * i, b, h) + lane * 8);
#pragma unroll
        for (int j = 0; j < 8; ++j) { const int i = t + 256 * j, n = i >> 6, d = i & 63; const size_t o = ((size_t)(b * 32 + n) * 2) * 1024 + h * 64 + d; kmreg[j] = (KMP[o] + KMP[o + 1024]) * (1.0f / 256.0f); }
    };
    prefetch(own_of(0));
    const unsigned fro = (unsigned)(r32 * 128), swz = (unsigned)((r32 >> 1) & 7);
#pragma unroll 1
    for (int it = 0; it < 4; ++it) {
        const int own = own_of(it);
        LAS unsigned char* kmh = hb + (it & 1) * 8192; LAS unsigned char* kml = kmh + 4096;
#pragma unroll
        for (int j = 0; j < 8; ++j) { const int i = t + 256 * j, n = i >> 6, d = i & 63; const float x = kmreg[j];
            const unsigned xb = __builtin_bit_cast(unsigned, x), hb16 = (xb + 0x7fffu + ((xb >> 16) & 1u)) >> 16; const float xh = __builtin_bit_cast(float, hb16 << 16), xl = x - xh;
            const unsigned lb = __builtin_bit_cast(unsigned, xl), lb16 = (lb + 0x7fffu + ((lb >> 16) & 1u)) >> 16;
            const int pos = n * 128 + (((d >> 3) ^ ((n >> 1) & 7)) * 16) + (d & 7) * 2;
            *(LAS unsigned short*)(kmh + pos) = (unsigned short)hb16; *(LAS unsigned short*)(kml + pos) = (unsigned short)lb16; }
        { float k2 = 0.f;
#pragma unroll
          for (int i = 0; i < 8; ++i) { float r2 = 0.f;
#pragma unroll
              for (int j = 0; j < 4; ++j) { const float a = __builtin_bit_cast(float, kreg[i][j] << 16), c = __builtin_bit_cast(float, kreg[i][j] & 0xffff0000u); r2 += a * a + c * c; }
              r2 += shx(r2, 1, lane); r2 += shx(r2, 2, lane); r2 += shx(r2, 4, lane); k2 = fmaxf(k2, r2); }
          k2 = fmaxf(k2, shx(k2, 8, lane)); k2 = fmaxf(k2, shx(k2, 16, lane)); k2 = fmaxf(k2, shx(k2, 32, lane));
          if (lane == 0) kbw[(it & 1) * 4 + w4] = k2; }
        bf16x8 qc[2][4];
#pragma unroll
        for (int tq = 0; tq < 2; ++tq)
#pragma unroll
            for (int d0 = 0; d0 < 4; ++d0) qc[tq][d0] = qf[tq][d0];
        __syncthreads();
        if (it < 3) prefetch(own_of(it + 1));
        f32x16 acc[2]; acc[0] = f32x16{}; acc[1] = f32x16{};
#pragma unroll
        for (int d0 = 0; d0 < 4; ++d0) { const unsigned co = ((unsigned)(2 * d0 + hi) ^ swz) * 16;
            const bf16x8 ah = *(const LAS bf16x8*)(kmh + fro + co), al = *(const LAS bf16x8*)(kml + fro + co);
#pragma unroll
            for (int tq = 0; tq < 2; ++tq) { acc[tq] = __builtin_amdgcn_mfma_f32_32x32x16_bf16(ah, qc[tq][d0], acc[tq], 0, 0, 0); acc[tq] = __builtin_amdgcn_mfma_f32_32x32x16_bf16(al, qc[tq][d0], acc[tq], 0, 0, 0); } }
        Top3 R;
#pragma unroll
        for (int tq = 0; tq < 2; ++tq) { Top3 T{-INFINITY, -INFINITY, -INFINITY, -1, -1, -1};
#pragma unroll
            for (int r = 0; r < 16; ++r) { const int n = crow(r, hi); const float g = acc[tq][r]; top3_insert(T, n < own ? g : -INFINITY, n < own ? n : -1); }
            Top3 P; { auto x1 = __builtin_amdgcn_permlane32_swap(__float_as_uint(T.g1), __float_as_uint(T.g1), false, false); P.g1 = __uint_as_float(hi ? x1[0] : x1[1]);
                      auto x2 = __builtin_amdgcn_permlane32_swap(__float_as_uint(T.g2), __float_as_uint(T.g2), false, false); P.g2 = __uint_as_float(hi ? x2[0] : x2[1]);
                      auto x3 = __builtin_amdgcn_permlane32_swap(__float_as_uint(T.g3), __float_as_uint(T.g3), false, false); P.g3 = __uint_as_float(hi ? x3[0] : x3[1]);
                      auto y1 = __builtin_amdgcn_permlane32_swap((unsigned)T.i1, (unsigned)T.i1, false, false); P.i1 = (int)(hi ? y1[0] : y1[1]);
                      auto y2 = __builtin_amdgcn_permlane32_swap((unsigned)T.i2, (unsigned)T.i2, false, false); P.i2 = (int)(hi ? y2[0] : y2[1]);
                      auto y3 = __builtin_amdgcn_permlane32_swap((unsigned)T.i3, (unsigned)T.i3, false, false); P.i3 = (int)(hi ? y3[0] : y3[1]); }
            top3_insert_tie(T, P.g1, P.i1); top3_insert_tie(T, P.g2, P.i2); top3_insert_tie(T, P.g3, P.i3);
            if (tq == hi) R = T; }
        const int i1 = R.i1, i2 = R.i2, i3 = R.i3;
        unsigned rk1 = 0, rk2 = 0, rk3 = 0;
        for (int n = 0; n < own; ++n) { const bool h1 = i1 == n, h2 = i2 == n, h3 = i3 == n; const unsigned long long mm = __ballot(h1 || h2 || h3);
            const unsigned rank = __builtin_amdgcn_mbcnt_hi((unsigned)(mm >> 32), __builtin_amdgcn_mbcnt_lo((unsigned)mm, 0u));
            rk1 = h1 ? rank : rk1; rk2 = h2 ? rank : rk2; rk3 = h3 ? rank : rk3;
            if (lane == 0) cntw[w4 * 32 + n] = (unsigned)__popcll(mm); }
        __syncthreads();
#pragma unroll
        for (int sl = 0; sl < 3; ++sl) { const int n = sl == 0 ? i1 : sl == 1 ? i2 : i3; const unsigned rk = sl == 0 ? rk1 : sl == 1 ? rk2 : rk3;
            const int nn = n & 31; unsigned base = 0;
#pragma unroll
            for (int w = 0; w < 3; ++w) { const unsigned v = cntw[w * 32 + nn]; base += (w < w4) ? v : 0u; }
            if (n >= 0) SEG[(((size_t)bh * 32 + own) * 32 + n) * 256 + base + rk] = (unsigned short)(t | (sl << 8)); }
        if (t < own) { const unsigned c = cntw[t] + cntw[32 + t] + cntw[64 + t] + cntw[96 + t]; CNT[((size_t)bh * 32 + own) * 32 + t] = c; (void)__hip_atomic_fetch_add(TOT + bh * 31 + t, c, RLX_AGENT); }
        if (t == 0) KBM[bh * 32 + own] = fmaxf(fmaxf(kbw[(it & 1) * 4], kbw[(it & 1) * 4 + 1]), fmaxf(kbw[(it & 1) * 4 + 2], kbw[(it & 1) * 4 + 3]));
    }
    asm volatile("s_waitcnt vmcnt(0)" ::: "memory");
    __syncthreads();
}

struct GTile { unsigned info; bf16x8 qr[4]; };
struct GRun { int e, c0, c1; };
__device__ __forceinline__ void dma_kv(LAS unsigned char* kv, const GAS bf16* Kb, const GAS bf16* Vb, int b, int h, int n, int w, int lane) {
#pragma unroll
    for (int t = 0; t < 4; ++t) {
        const size_t kr = (size_t)b * SEQ + n * BLK + 64 * t + 8 * w + (lane >> 3), vr = (size_t)b * SEQ + n * BLK + 64 * t + 16 * (w & 3) + (lane >> 2);
        __builtin_amdgcn_global_load_lds((const GAS unsigned*)(Kb + hm_off(kr, b, h) + (((lane & 7) ^ ((4 * w + (lane >> 4)) & 7)) * 8)), (LAS unsigned*)(kv + L_K + t * 8192 + w * 1024), 16, 0, 0);
        __builtin_amdgcn_global_load_lds((const GAS unsigned*)(Vb + hm_off(kr, b, h) + ((((lane >> 2) & 1) ^ ((lane >> 4) & 1)) * 32) + (lane & 3) * 8), (LAS unsigned*)(kv + L_V + t * 8192 + w * 1024), 16, 0, 0);
    }
}
__device__ __forceinline__ void gather(Frame& F) {
    GAS unsigned char* ws = F.ws;
    const GAS bf16* Qb = (const GAS bf16*)(ws + WS_Q); const GAS bf16* Kb = (const GAS bf16*)(ws + WS_K); const GAS bf16* Vb = (const GAS bf16*)(ws + WS_V);
    const GAS unsigned short* SEG = (const GAS unsigned short*)(ws + WS_SEG); const GAS unsigned* CNT = (const GAS unsigned*)(ws + WS_CNT); const GAS unsigned* TOT = (const GAS unsigned*)(ws + WS_CTL) + CW_TOT;
    const GAS float* KBM = (const GAS float*)(ws + WS_KBM); GAS float* PL = (GAS float*)(ws + WS_PL);
    int tid = F.wave * 64 + lane_id(); asm volatile("" : "+v"(tid));
    const int lane = tid & 63, w = __builtin_amdgcn_readfirstlane(tid >> 6), r32 = lane & 31, hi = lane >> 5;
    LAS unsigned* pre = (LAS unsigned*)(F.lds + L_PRE);
    __syncthreads();
    if (w == 0) { unsigned loc = 0;
        for (int i = 0; i < 31; ++i) { const unsigned nc = (TOT[31 * lane + i] + 255u) >> 8; loc += nc + (nc ? 1u : 0u); }
        unsigned inc = loc;
#pragma unroll
        for (int o = 1; o < 64; o <<= 1) { const unsigned v = shup(inc, o, lane); if (lane >= o) inc += v; }
        unsigned run = inc - loc;
        for (int i = 0; i < 31; ++i) { pre[31 * lane + i] = run; const unsigned nc = (TOT[31 * lane + i] + 255u) >> 8; run += nc + (nc ? 1u : 0u); }
        if (lane == 63) pre[1984] = run; }
    __syncthreads();
    const int U = (int)pre[1984];
    int p = (int)(((long)F.vcu * U) / F.G); const int phi = (int)(((long)(F.vcu + 1) * U) / F.G);
    int e = 0; { int lo = 0, hi2 = 1984; while (hi2 - lo > 1) { const int mid = (lo + hi2) >> 1; if ((int)pre[mid] <= p) lo = mid; else hi2 = mid; } e = lo; }
    auto next_run = [&](GRun& R) -> bool {
        while (p < phi) {
            while (p >= (int)pre[e + 1]) ++e;
            const int k = p - (int)pre[e], nch = (int)pre[e + 1] - (int)pre[e] - 1;
            const int c0 = k > 0 ? k - 1 : 0; int c1 = phi - (int)pre[e] - 1; c1 = c1 < nch ? c1 : nch;
            p = (int)pre[e] + 1 + c1;
            if (c1 > c0) { R.e = e; R.c0 = c0; R.c1 = c1; return true; }
        }
        return false;
    };
    auto scan_cnt = [&](unsigned v) -> unsigned { unsigned inc = v;
#pragma unroll
        for (int o = 1; o < 32; o <<= 1) { const unsigned t2 = shup(inc, o, lane); if ((lane & 31) >= o) inc += t2; }
        return inc; };
    int cur_h = -1, cur_bh = -1, rb = 0; float kmax2 = 0.f, bmax = 0.f, rb31 = 0.f;
    GRun cur, nxt; bool hc = next_run(cur);
    unsigned cntN = 0, totN = 0, cumv = 0, tot = 0;
    if (hc) { const int bh = cur.e / 31, n = cur.e - bh * 31; dma_kv(F.lds, Kb, Vb, bh >> 4, bh & 15, n, w, lane);
        cntN = ((lane & 31) > n) ? CNT[((size_t)bh * 32 + (lane & 31)) * 32 + n] : 0u; totN = TOT[cur.e]; }
    GTile tcur, tnxt; unsigned ownB = 0, entB = 0xffffffffu; bool mine = false;
    auto fetch_ent = [&](int c, bool valid, int n, const GAS unsigned short* segb, unsigned cv, unsigned tt, unsigned& own_o) -> unsigned {
        const unsigned g0 = 256u * c + 32u * w, g = g0 + r32;
        const bool tile_ok = valid && g0 < tt;
        unsigned own = (unsigned)(n + 1), base = 0u;
        if (tile_ok) {
            int lo = n + 1, hi2 = 32;
            while (hi2 - lo > 1) { const int mid = (lo + hi2) >> 1; if (__builtin_amdgcn_readlane(cv, mid - 1) <= g0) lo = mid; else hi2 = mid; }
            own = (unsigned)lo; base = (lo == n + 1) ? 0u : __builtin_amdgcn_readlane(cv, lo - 1);
            for (int o = lo + 1; o < 32; ++o) { const unsigned s2 = __builtin_amdgcn_readlane(cv, o - 1); if (s2 > g0 + 31u) break; if (s2 <= g) { own = (unsigned)o; base = s2; } }
        }
        const bool lane_ok = tile_ok && g < tt;
        const unsigned idx = lane_ok ? (g - base) : 0u;
        const unsigned v = (unsigned)segb[(size_t)own * 32 * 256 + idx];
        own_o = own;
        return lane_ok ? v : 0xffffffffu;
    };
    auto make_tile = [&](unsigned ent, unsigned own, int b, int h, int n, GTile& T) {
        const bool act = ent != 0xffffffffu;
        const int tq = act ? (int)(own * BLK + (ent & 255u)) : SEQ - 1;
        T.info = (unsigned)tq | (act ? (((ent >> 8) & 3u) << 16) | (1u << 18) | ((own - n <= 4) ? (1u << 19) : 0u) : 0u);
        load_q_raw(T.qr, Qb, (size_t)b * SEQ + tq, b, h, hi);
    };
    auto start_run = [&](const GRun& R) {
        const int bh = R.e / 31, n = R.e - bh * 31; const GAS unsigned short* segb = SEG + ((size_t)bh * 32 * 32 + n) * 256;
        cumv = scan_cnt(cntN); tot = totN;
        mine = (unsigned)(256 * R.c0 + 32 * w) < tot;
        entB = 0xffffffffu; ownB = 0;
        if (mine) { unsigned ownA; const unsigned entA = fetch_ent(R.c0, true, n, segb, cumv, tot, ownA); make_tile(entA, ownA, bh >> 4, bh & 15, n, tcur);
            entB = fetch_ent(R.c0 + 1, R.c0 + 1 < R.c1, n, segb, cumv, tot, ownB); }
    };
    if (hc) start_run(cur);
    while (hc) {
        const bool hn = next_run(nxt);
        const int c0 = cur.c0, c1 = cur.c1, bh = cur.e / 31, n = cur.e - bh * 31, b = bh >> 4, h = bh & 15;
        const GAS unsigned short* segb = SEG + ((size_t)bh * 32 * 32 + n) * 256;
        LAS unsigned char* kv = F.lds + rb * 65536;
        __builtin_amdgcn_s_waitcnt(0x0F70);
        __syncthreads();
        if (hn) { const int bh2 = nxt.e / 31, n2 = nxt.e - bh2 * 31;
            cntN = ((lane & 31) > n2) ? CNT[((size_t)bh2 * 32 + (lane & 31)) * 32 + n2] : 0u; totN = TOT[nxt.e]; }
        if (bh != cur_bh) { head_bounds(KBM, F.rel_bias, bh, h, lane, kmax2, bmax); rb31 = F.rel_bias[31 * NH + h] * LOG2E; cur_bh = bh;
            if (h != cur_h) { build_lut(F.lds, F.rel_bias, h, tid); cur_h = h; __syncthreads(); } }
        const lds_cptr Kl = (lds_cptr)(kv + L_K), Vl = (lds_cptr)(kv + L_V); const int vrl = 4 * hi + ((lane & 15) >> 2); const unsigned vo0 = (unsigned)(vrl * 128 + ((vrl >> 1) & 1) * 64 + ((lane >> 4) & 1) * 32 + (lane & 3) * 8);
        if (mine) for (int c = c0; c < c1; ++c) {
            if ((unsigned)(256 * c + 32 * w) >= tot) break;
            make_tile(entB, ownB, b, h, n, tnxt);
            entB = fetch_ent(c + 2, c + 2 < c1, n, segb, cumv, tot, ownB);
            const unsigned info = tcur.info; const int tq = (int)(info & 0xffffu); const bool near = (info >> 19) & 1u;
            const float mref = ref_exponent(q_norm2(tcur.qr), kmax2, bmax);
            const bool anynear = __any(near);
            const int tqrel = near ? (tq - n * BLK) : 1755;
            LAS const float* lutp = (LAS const float*)(F.lds + L_LUT) + (2047 - tqrel + 4 * hi);
            f32x16 cinit; { const float cc = anynear ? -mref : (rb31 - mref);
#pragma unroll
                for (int r = 0; r < 16; ++r) cinit[r] = cc; }
            f32x16 o[2]; o[0] = f32x16{}; o[1] = f32x16{}; float l = 0.f;
            if (anynear) tile_math<true>(o, l, Kl, Vl, vo0, tcur.qr, cinit, lutp, r32, hi); else tile_math<false>(o, l, Kl, Vl, vo0, tcur.qr, cinit, lutp, r32, hi);
            l = swap_add(l);
            { const bool act = (info >> 18) & 1u; const int slot = (int)((info >> 16) & 3u);
              GAS bf16* dump = (GAS bf16*)(ws + WS_DUMP) + (size_t)F.vcu * 4096 + lane * 64;
              store_row(act ? po_row(ws, F.out, b, h, tq, slot) : dump - 32 * hi, o, 1.0f, hi, true);
              GAS float* plp = act ? PL + (((size_t)bh * SEQ + tq) * 3) + slot : (GAS float*)dump;
              *plp = l; }
            tcur = tnxt;
        }
        if (hn) { start_run(nxt);
            const int bh2 = nxt.e / 31, n2 = nxt.e - bh2 * 31; dma_kv(F.lds + (rb ^ 1) * 65536, Kb, Vb, bh2 >> 4, bh2 & 15, n2, w, lane); }
        cur = nxt; hc = hn; rb ^= 1;
    }
    asm volatile("s_waitcnt vmcnt(0)" ::: "memory");
    __syncthreads();
}

__device__ __forceinline__ void own_block(Frame& F) {
    GAS unsigned char* ws = F.ws;
    const GAS bf16* Qb = (const GAS bf16*)(ws + WS_Q); const GAS bf16* Kb = (const GAS bf16*)(ws + WS_K); const GAS bf16* Vb = (const GAS bf16*)(ws + WS_V); GAS bf16* Ob = (GAS bf16*)(ws + WS_O);
    const GAS float* KBM = (const GAS float*)(ws + WS_KBM); const GAS float* PL = (const GAS float*)(ws + WS_PL);
    int tid = F.wave * 64 + lane_id(); asm volatile("" : "+v"(tid));
    const int lane = tid & 63, w = __builtin_amdgcn_readfirstlane(tid >> 6), r32 = lane & 31, hi = lane >> 5;
    const int bh = F.vcu & 63, b = bh >> 4, h = bh & 15, own0 = F.vcu >> 6, nun = (NBLK - own0 + 3) / 4;
    __syncthreads();
    build_lut(F.lds, F.rel_bias, h, tid);
    float kmax2, bmax; head_bounds(KBM, F.rel_bias, bh, h, lane, kmax2, bmax);
    const int qrel = 32 * w + r32;
    LAS const float* lutp = (LAS const float*)(F.lds + L_LUT) + (2047 - qrel + 4 * hi);
    const int jd = w >> 1;
    bf16x8 qn[4];
    dma_kv(F.lds, Kb, Vb, b, h, own0, w, lane);
    load_q_raw(qn, Qb, (size_t)b * SEQ + own0 * BLK + qrel, b, h, hi);
    for (int i = 0; i < nun; ++i) {
        const int own = own0 + 4 * i; const size_t qrow = (size_t)b * SEQ + own * BLK + qrel;
        LAS unsigned char* kv = F.lds + (i & 1) * 65536;
        bf16x8 qr[4];
#pragma unroll
        for (int d0 = 0; d0 < 4; ++d0) qr[d0] = qn[d0];
        asm volatile("s_waitcnt vmcnt(0)" ::: "memory");
        __syncthreads();
        if (i + 1 < nun) { dma_kv(F.lds + ((i + 1) & 1) * 65536, Kb, Vb, b, h, own + 4, w, lane); load_q_raw(qn, Qb, qrow + 4 * BLK, b, h, hi); }
        const float mref = ref_exponent(q_norm2(qr), kmax2, bmax);
        f32x16 cinit;
#pragma unroll
        for (int r = 0; r < 16; ++r) cinit[r] = -mref;
        f32x16 o[2]; o[0] = f32x16{}; o[1] = f32x16{}; float l = 0.f;
        const lds_cptr Kl = (lds_cptr)(kv + L_K), Vl = (lds_cptr)(kv + L_V); const int vrl = 4 * hi + ((lane & 15) >> 2); const unsigned vo0 = (unsigned)(vrl * 128 + ((vrl >> 1) & 1) * 64 + ((lane >> 4) & 1) * 32 + (lane & 3) * 8);
        for (int j = 0; j <= jd; ++j) { f32x16 p0, p1; v4u pa[4];
            qk_tile(p0, p1, Kl + j * 8192, qr, cinit, r32, hi);
            if (j == jd) softmax_tile<true, true>(p0, p1, lutp, j, qrel, hi, l, pa); else softmax_tile<true, false>(p0, p1, lutp, j, qrel, hi, l, pa);
            pv_tile(o, Vl + j * 8192, vo0, pa); }
        l = swap_add(l);
        const int nsl = own < 3 ? own : 3; const int tq = own * BLK + qrel;
        for (int sl = 0; sl < nsl; ++sl) { add_row(o, po_row(ws, F.out, b, h, tq, sl), hi); l += PL[(((size_t)bh * SEQ + tq) * 3) + sl]; }
        store_row(Ob + qrow * D + h * 64, o, 1.0f / l, hi, true);
    }
    asm volatile("s_waitcnt vmcnt(0)" ::: "memory");
    __syncthreads();
}
}

__device__ __forceinline__ void final_norm(Frame& Fr) {
    struct { int lane, vcu, wave, G; const GAS float* norm_final; GAS float* out; } F{Fr.wave * 64 + lane_id(), Fr.vcu, Fr.wave, Fr.G, Fr.norm_final, Fr.out};
    asm volatile("" : "+v"(F.lane)); F.lane &= 63;
    const int gw = F.vcu * NWAVES + F.wave, NGW = F.G * NWAVES;
    f32x4 gam[4];
#pragma unroll
    for (int j = 0; j < 4; ++j) gam[j] = *(const GAS f32x4*)(F.norm_final + 4 * (F.lane + 64 * j));
    for (int row = gw; row < M; row += NGW) { GAS float* xr = F.out + (size_t)row * D; f32x4 v[4]; float ss = 0.f;
#pragma unroll
        for (int j = 0; j < 4; ++j) { v[j] = *(const GAS f32x4*)(xr + 4 * (F.lane + 64 * j)); ss += (v[j][0] * v[j][0] + v[j][1] * v[j][1]) + (v[j][2] * v[j][2] + v[j][3] * v[j][3]); }
#pragma unroll
        for (int o = 1; o < 64; o <<= 1) ss += shx(ss, o, F.lane);
        const float rstd = rsqrtf(ss * (1.0f / D) + EPS);
#pragma unroll
        for (int j = 0; j < 4; ++j) *(GAS f32x4*)(xr + 4 * (F.lane + 64 * j)) = v[j] * rstd * gam[j]; }
}

__global__ void __launch_bounds__(NWAVES * 64, 2) fwd_megakernel(Args args) {
    __shared__ __attribute__((aligned(16))) unsigned char lds[LDS_BYTES];
    Frame F;
    F.lds = (LAS unsigned char*)lds;
    F.tid = threadIdx.x; F.lane = F.tid & 63; F.wave = __builtin_amdgcn_readfirstlane(F.tid >> 6);
    F.G = gridDim.x; { const int bx = blockIdx.x; F.vcu = (F.G % 8 == 0) ? (bx % 8) * (F.G / 8) + bx / 8 : bx; }
    F.x = args.in[0]; F.c = args.in[1]; F.rel_bias = args.in[2]; F.w_mod = args.in[3]; F.b_mod = args.in[4]; F.norm_mix = args.in[5]; F.norm_mlp = args.in[6];
    F.w_pool = args.in[7]; F.pool_scale = args.in[8]; F.w_qkv = args.in[9]; F.w_o = args.in[10]; F.w_up = args.in[11]; F.w_down = args.in[12]; F.norm_final = args.in[13];
    F.out = args.out; F.ws = args.ws;
    volatile LAS unsigned* MISC = (volatile LAS unsigned*)(F.lds + MISC_OFF);
    for (int u = F.tid; u < (LDS_BYTES - LDSCTL_OFF) / 4; u += NWAVES * 64) ((LAS unsigned*)(F.lds + LDSCTL_OFF))[u] = 0u;
    __syncthreads();
    gu32* ctl = (gu32*)(F.ws + WS_CTL);
    XcdBarrier bar = xcd_barrier_post((GAS unsigned*)(ctl + CW_BAR), MISC + 8); bar.wave = F.wave;
    GAS unsigned char* ws = F.ws;
#define WSB(off) ((GAS bf16*)(ws + (off)))
#define WSF(off) ((GAS float*)(ws + (off)))

    p0_prologue(F);
    xcd_barrier(bar);
    p1_bias(F); p1_pool(F);
    xcd_barrier(bar);

    for (int ph = 0; ph < 10; ++ph) {
        asm volatile("" : "+s"(ws));
        const GAS float* MOD = WSF(WS_MOD); GAS float* SS = WSF(WS_SS);
        const int kind = (ph == 0 || ph == 2 || ph == 7) ? 0 : (ph == 1 || ph == 8) ? 1 : (ph == 3) ? 2 : (ph == 4) ? 3 : (ph == 5) ? 4 : (ph == 6) ? 5 : 7;
        if (kind == 0) {
            pg8::Gemm g; pg8::EpiRes E;
            if (ph == 0) { g = pg8::Gemm{WSB(WS_XNA), WSB(WS_WPOOL), M, D, 256, D, 256, 512};
                E = pg8::EpiRes{WSB(WS_XR), WSB(WS_XR), MOD + 2048, F.pool_scale, SS}; }
            else if (ph == 2) { g = pg8::Gemm{WSB(WS_HB), WSB(WS_WDN0), M, D, FF, 256, 0, 131072};
                E = pg8::EpiRes{WSB(WS_XR), WSB(WS_XR), MOD + 5120, nullptr, SS}; }
            else { g = pg8::Gemm{WSB(WS_O), WSB(WS_WO), M, D, D, D, 0, 512};
                E = pg8::EpiRes{WSB(WS_XR), WSB(WS_XR), MOD + 4 * 6144 + 2048, nullptr, SS}; }
            pg8::StaticOrder S; S.init(M, D, F.G, (int)blockIdx.x);
            pg8::gemm_phase<pg8::EpiRes, pg8::StaticOrder, true>(F.lds + RING_OFF, g, S, E, F.wave);
        } else if (kind == 1) {
            const pg8::Gemm g{WSB(WS_XR), WSB(ph == 1 ? WS_WSUP0 : WS_WSUP1), M, FF, D, 256, 0, 131072, (size_t)FF * D * 2};
            const pg8::EpiUp E{SS, WSF(ph == 1 ? WS_BIAS_UP0 : WS_BIAS_UP1), WSB(WS_HB), FF, F.lds, 0};
            pg8::StaticOrder S; S.init(M, FF, F.G, (int)blockIdx.x);
            pg8::gemm_phase<pg8::EpiUp, pg8::StaticOrder, true>(F.lds + RING_OFF, g, S, E, F.wave);
        } else if (kind == 2) {
            const pg8::Gemm g{WSB(WS_XR), (const GAS bf16*)((GAS unsigned char*)F.out + OUT_WSQKV), M, NQKV, D, 256, 0, 131072, (size_t)NQKV * D * 2};
            const pg8::EpiQKV E{SS, WSF(WS_BIAS_QKV), WSB(WS_Q), (size_t)(WS_K - WS_Q) / 2, WSF(WS_KMP), F.lds, 0};
            pg8::StaticOrder S; S.init(M, NQKV, F.G, (int)blockIdx.x);
            pg8::gemm_phase<pg8::EpiQKV, pg8::StaticOrder, true>(F.lds + RING_OFF, g, S, E, F.wave);
        } else if (kind == 3) { F.ws = ws; att::route(F);
        } else if (kind == 4) { F.ws = ws; att::gather(F);
        } else if (kind == 5) { F.ws = ws; att::own_block(F);
        } else {
            const pg8::Gemm g{WSB(WS_HB), WSB(WS_WDN1), M, D, FF, 256, 0, 131072};
            const pg8::EpiFinal E{WSB(WS_XR), F.out, MOD + 4 * 6144 + 5120, F.norm_final, SS, (GAS unsigned*)(ws + WS_CTL) + CW_FIN};
            pg8::StaticOrder S; S.init(M, D, F.G, (int)blockIdx.x);
            pg8::gemm_phase<pg8::EpiFinal, pg8::StaticOrder, true>(F.lds + RING_OFF, g, S, E, F.wave);
            break;
        }
        xcd_barrier(bar);
    }
}

extern "C" void kernel_launch(void* const* d_in, const int* in_sizes, int n_in, void* d_out, int out_size, void* d_ws, size_t ws_size, hipStream_t stream) {
    static int grid = 0;
    if (grid == 0) {
        if (n_in != 14 || in_sizes[0] != M * D || out_size != M * D || ws_size < WS_END) { fprintf(stderr, "kernel_launch: unexpected shapes / workspace (n_in %d, in0 %d, out %d, ws %zu)\n", n_in, n_in > 0 ? in_sizes[0] : -1, out_size, ws_size); grid = -1; return; }
        int dev = 0, cus = 0, per_cu = 0;
        if (hipGetDevice(&dev) != hipSuccess || hipDeviceGetAttribute(&cus, hipDeviceAttributeMultiprocessorCount, dev) != hipSuccess) { grid = -1; return; }
        if (hipOccupancyMaxActiveBlocksPerMultiprocessor(&per_cu, (const void*)fwd_megakernel, NWAVES * 64, 0) != hipSuccess || per_cu < 1) { fprintf(stderr, "kernel_launch: occupancy query says %d blocks per CU\n", per_cu); }
        (void)hipGetLastError();
        grid = cus;
    }
    if (grid < 0) return;
    if (hipMemsetAsync((char*)d_ws + WS_CTL, 0, CTL_ZERO_BYTES, stream) != hipSuccess) return;
    Args a{};
    for (int i = 0; i < 14; ++i) a.in[i] = (const GAS float*)d_in[i];
    a.out = (GAS float*)d_out; a.ws = (GAS unsigned char*)d_ws;
    hipLaunchKernelGGL(fwd_megakernel, dim3(grid), dim3(NWAVES * 64), 0, stream, a);
}
```

```cpp
#include <hip/hip_runtime.h>
#include <utility>
#include <cstdio>
#include <cstdint>

__device__ __forceinline__ float shx(float v, int m, int lane) { return __builtin_bit_cast(float, __builtin_amdgcn_ds_bpermute((lane ^ m) << 2, __builtin_bit_cast(int, v))); }
__device__ __forceinline__ unsigned shup(unsigned v, int o, int lane) { return (unsigned)__builtin_amdgcn_ds_bpermute(((lane - o) & 63) << 2, (int)v); }
__device__ __forceinline__ size_t hm_off(size_t row, int b, int h) { return (row + (size_t)(15 * b + h) * 8192) * 64; }
__device__ __forceinline__ int lane_id() { unsigned z = 0u; asm volatile("" : "+s"(z)); return (int)__builtin_amdgcn_mbcnt_hi(~0u, __builtin_amdgcn_mbcnt_lo(~0u, z)); }

namespace pg8 {
#define PG8_LAS __attribute__((address_space(3)))
#define PG8_GAS __attribute__((address_space(1)))
typedef unsigned short bf16_t;
typedef short bf16x8 __attribute__((ext_vector_type(8)));
typedef float f32x4 __attribute__((ext_vector_type(4)));
typedef unsigned u32x4 __attribute__((ext_vector_type(4)));
constexpr int BM = 256, BK = 64, HALF = 128, HTB = HALF * BK * 2, STAGE_BYTES = 8 * HTB, NXCD = 8, WGM = 8;

__host__ __device__ __forceinline__ int lds_byte(int r, int c) { const int st = (r >> 4) * 2 + (c >> 5), rr = r & 15, cc = c & 31, ob = rr * 64 + cc * 2; return st * 1024 + (ob ^ (((ob >> 9) & 1) << 5)); }
__host__ __device__ __forceinline__ void stage_rc(int b, int& R, int& C) { const int st = b / 1024, sb = b % 1024, swz = sb ^ (((sb >> 9) & 1) << 5); R = (st >> 1) * 16 + swz / 64; C = (st & 1) * 32 + (swz % 64) / 2; }
__host__ __device__ __forceinline__ int perm32(int rho) { const int n = rho >> 4, i = rho & 15; return 8 * (i >> 2) + 4 * n + (i & 3); }

struct Unit { int pm, pn; };
struct Gemm { const PG8_GAS bf16_t* A; const PG8_GAS bf16_t* Bt; int M, N, K, lda, a_pn_off, a_tileb; size_t b_bstride = 0; };

struct StaticOrder {
    int nM, nN, nwg, G, c;
    __host__ __device__ void init(int M, int N, int G_, int c_) { nM = M / BM; nN = N / BM; nwg = nM * nN; G = G_; c = c_; }
    __host__ __device__ bool next(int i, Unit& u) const {
        const long L = (long)i * G + c; if (L >= nwg) return false;
        int wgid = (int)L; { const int q = nwg / NXCD, r = nwg % NXCD, xcd = wgid % NXCD, off = wgid / NXCD; wgid = (xcd < r ? xcd * (q + 1) : r * (q + 1) + (xcd - r) * q) + off; }
        const int nig = WGM * nN, gid = wgid / nig, fm = gid * WGM, gsz = (nM - fm) < WGM ? (nM - fm) : WGM;
        u.pm = fm + ((wgid % nig) % gsz); u.pn = (wgid % nig) / gsz; return true;
    }
};

__device__ __forceinline__ unsigned cvt_pk_bf16(float lo, float hi) { unsigned r; asm volatile("v_cvt_pk_bf16_f32 %0, %1, %2" : "=v"(r) : "v"(lo), "v"(hi)); return r; }

constexpr int SEQ_ = 8192;
constexpr float EPS_ = 1e-6f;
constexpr float C2_ = 0.125f * 1.4426950408889634f;


__device__ __forceinline__ float row_rstd(const PG8_GAS float* SS, int row, int fq, int fr) {
    const f32x4 s4 = *(const PG8_GAS f32x4*)(SS + (size_t)row * 16 + 4 * fq);
    float s = (s4[0] + s4[1]) + (s4[2] + s4[3]);
    const int ln = fq * 16 + fr; s += shx(s, 16, ln); s += shx(s, 32, ln);
    return rsqrtf(s * (1.0f / 1024.0f) + EPS_);
}

constexpr int RSTD_TAB_OFF = 132096;
__device__ __forceinline__ void fill_rstd_tab(PG8_LAS unsigned char* ldsbase, int par, const PG8_GAS float* SS, int pm, int wid, int lane) {
    if (lane < 32) { const int r = wid * 32 + lane; const PG8_GAS f32x4* p = (const PG8_GAS f32x4*)(SS + (size_t)(pm * BM + r) * 16);
        const f32x4 a = p[0], b = p[1], c = p[2], d = p[3];
        const float g0 = (a[0] + a[1]) + (a[2] + a[3]), g1 = (b[0] + b[1]) + (b[2] + b[3]), g2 = (c[0] + c[1]) + (c[2] + c[3]), g3 = (d[0] + d[1]) + (d[2] + d[3]);
        ((PG8_LAS float*)(ldsbase + RSTD_TAB_OFF + par * 1024))[r] = rsqrtf(((g0 + g1) + (g2 + g3)) * (1.0f / 1024.0f) + EPS_); }
}
__device__ __forceinline__ f32x4 bf_lo4(const u32x4& w) { return (f32x4){__builtin_bit_cast(float, w.x << 16), __builtin_bit_cast(float, w.x & 0xffff0000u), __builtin_bit_cast(float, w.y << 16), __builtin_bit_cast(float, w.y & 0xffff0000u)}; }
__device__ __forceinline__ f32x4 bf_hi4(const u32x4& w) { return (f32x4){__builtin_bit_cast(float, w.z << 16), __builtin_bit_cast(float, w.z & 0xffff0000u), __builtin_bit_cast(float, w.w << 16), __builtin_bit_cast(float, w.w & 0xffff0000u)}; }
struct EpiRes {
    static constexpr bool PERM = true, NEEDS_RSTD = false;
    const PG8_GAS bf16_t* Rb; PG8_GAS bf16_t* Xb; const PG8_GAS float* gate; const PG8_GAS float* cscale; PG8_GAS float* SS;
    __device__ __forceinline__ void operator()(f32x4 (&acc)[2][2][4][2], const Unit& u, int wr, int wc, int fr, int fq) const {
        const int b = u.pm >> 5, colb = u.pn * BM + wc * 32 + 8 * fq, row0 = u.pm * BM + wr * 64 + fr;
        float ssq[2][4];
#pragma unroll
        for (int bj = 0; bj < 2; ++bj) {
            f32x4 gt[2];
#pragma unroll
            for (int n = 0; n < 2; ++n) { const int col = colb + bj * HALF + 4 * n;
                f32x4 gv = *(const PG8_GAS f32x4*)(gate + b * 6144 + col); if (cscale) gv = gv * *(const PG8_GAS f32x4*)(cscale + col); gt[n] = gv; }
#pragma unroll
            for (int ai = 0; ai < 2; ++ai)
#pragma unroll
                for (int m = 0; m < 4; ++m) { const size_t off = ((size_t)(u.pm * 4 + u.pn) * 256 + (wr * 64 + fr + ai * HALF + m * 16)) * 256 + (wc * 32 + 8 * fq + bj * HALF);
                    const u32x4 rw = *(const PG8_GAS u32x4*)(Rb + off); const f32x4 r0 = bf_lo4(rw), r1 = bf_hi4(rw);
                    const f32x4 y0 = r0 + gt[0] * acc[ai][bj][m][0], y1 = r1 + gt[1] * acc[ai][bj][m][1];
                    u32x4 xw; xw.x = cvt_pk_bf16(y0[0], y0[1]); xw.y = cvt_pk_bf16(y0[2], y0[3]); xw.z = cvt_pk_bf16(y1[0], y1[1]); xw.w = cvt_pk_bf16(y1[2], y1[3]);
                    *(PG8_GAS u32x4*)(Xb + off) = xw;
                    const f32x4 x0 = bf_lo4(xw), x1 = bf_hi4(xw);
                    const float q = (x0[0] * x0[0] + x0[1] * x0[1]) + (x0[2] * x0[2] + x0[3] * x0[3]) + (x1[0] * x1[0] + x1[1] * x1[1]) + (x1[2] * x1[2] + x1[3] * x1[3]);
                    ssq[ai][m] = (bj == 0) ? q : ssq[ai][m] + q;
                }
        }
#pragma unroll
        for (int ai = 0; ai < 2; ++ai)
#pragma unroll
            for (int m = 0; m < 4; ++m) { float q = ssq[ai][m]; q += shx(q, 16, fq * 16 + fr); q += shx(q, 32, fq * 16 + fr); if (fq == 0) SS[(size_t)(row0 + ai * HALF + m * 16) * 16 + u.pn * 4 + wc] = q; }
    }
};

struct EpiFinal {
    static constexpr bool PERM = true, NEEDS_RSTD = false;
    const PG8_GAS bf16_t* R; PG8_GAS float* OUT; const PG8_GAS float* gate; const PG8_GAS float* gfin; PG8_GAS float* SS; PG8_GAS unsigned* cnt;
    __device__ __forceinline__ void operator()(f32x4 (&acc)[2][2][4][2], const Unit& u, int wr, int wc, int fr_, int fq_) const {
        int fr = fr_, fq = fq_; asm volatile("" : "+v"(fr), "+v"(fq));
        const int b = u.pm >> 5, colb = u.pn * BM + wc * 32 + 8 * fq, row0 = u.pm * BM + wr * 64 + fr, ln = fq * 16 + fr;
        float ssq[2][4];
#pragma unroll
        for (int bj = 0; bj < 2; ++bj) {
            const f32x4 gt0 = *(const PG8_GAS f32x4*)(gate + b * 6144 + colb + bj * HALF), gt1 = *(const PG8_GAS f32x4*)(gate + b * 6144 + colb + bj * HALF + 4);
#pragma unroll
            for (int ai = 0; ai < 2; ++ai)
#pragma unroll
                for (int m = 0; m < 4; ++m) { const size_t off = (size_t)(row0 + ai * HALF + m * 16) * 1024 + colb + bj * HALF;
                    const u32x4 rw = *(const PG8_GAS u32x4*)(R + ((size_t)(u.pm * 4 + u.pn) * 256 + (wr * 64 + fr + ai * HALF + m * 16)) * 256 + (wc * 32 + 8 * fq + bj * HALF));
                    const f32x4 x0 = bf_lo4(rw) + gt0 * acc[ai][bj][m][0], x1 = bf_hi4(rw) + gt1 * acc[ai][bj][m][1];
                    acc[ai][bj][m][0] = x0; acc[ai][bj][m][1] = x1;
                    const float q = (x0[0] * x0[0] + x0[1] * x0[1]) + (x0[2] * x0[2] + x0[3] * x0[3]) + (x1[0] * x1[0] + x1[1] * x1[1]) + (x1[2] * x1[2] + x1[3] * x1[3]);
                    ssq[ai][m] = (bj == 0) ? q : ssq[ai][m] + q;
                    asm volatile("" : "+v"(acc[ai][bj][m][0]), "+v"(acc[ai][bj][m][1]), "+v"(ssq[ai][m]));
                    if (m & 1) asm volatile("" ::: "memory"); }
        }
#pragma unroll
        for (int ai = 0; ai < 2; ++ai)
#pragma unroll
            for (int m = 0; m < 4; ++m) { float q = ssq[ai][m]; q += shx(q, 16, ln); q += shx(q, 32, ln);
                if (fq == 0) __hip_atomic_store(SS + (size_t)(row0 + ai * HALF + m * 16) * 16 + u.pn * 4 + wc, q, __ATOMIC_RELAXED, __HIP_MEMORY_SCOPE_AGENT); }
        asm volatile("s_waitcnt vmcnt(0)" ::: "memory");
        PG8_GAS unsigned* c = cnt + 64 * u.pm;
        if (ln == 0) (void)__hip_atomic_fetch_add(c, 1u, __ATOMIC_RELAXED, __HIP_MEMORY_SCOPE_AGENT);
        for (unsigned sp = 0; sp < (1u << 22); ++sp) { if ((unsigned)__builtin_amdgcn_readfirstlane((int)__hip_atomic_load(c, __ATOMIC_RELAXED, __HIP_MEMORY_SCOPE_AGENT)) >= 32u) break; __builtin_amdgcn_s_sleep(2); }
        int row1 = row0, colc = colb; asm volatile("" : "+v"(row1), "+v"(colc));
        float rs[2][4];
#pragma unroll
        for (int ai = 0; ai < 2; ++ai)
#pragma unroll
            for (int m = 0; m < 4; ++m) { const PG8_GAS float* sp4 = SS + (size_t)(row1 + ai * HALF + m * 16) * 16 + 4 * fq;
                float t = (__hip_atomic_load(sp4, __ATOMIC_RELAXED, __HIP_MEMORY_SCOPE_AGENT) + __hip_atomic_load(sp4 + 1, __ATOMIC_RELAXED, __HIP_MEMORY_SCOPE_AGENT))
                        + (__hip_atomic_load(sp4 + 2, __ATOMIC_RELAXED, __HIP_MEMORY_SCOPE_AGENT) + __hip_atomic_load(sp4 + 3, __ATOMIC_RELAXED, __HIP_MEMORY_SCOPE_AGENT));
                t += shx(t, 16, ln); t += shx(t, 32, ln); rs[ai][m] = rsqrtf(t * (1.0f / 1024.0f) + EPS_); }
#pragma unroll
        for (int bj = 0; bj < 2; ++bj) {
            const f32x4 g0 = *(const PG8_GAS f32x4*)(gfin + colc + bj * HALF), g1 = *(const PG8_GAS f32x4*)(gfin + colc + bj * HALF + 4);
#pragma unroll
            for (int ai = 0; ai < 2; ++ai)
#pragma unroll
                for (int m = 0; m < 4; ++m) { const size_t off = (size_t)(row1 + ai * HALF + m * 16) * 1024 + colc + bj * HALF;
                    *(PG8_GAS f32x4*)(OUT + off) = acc[ai][bj][m][0] * rs[ai][m] * g0; *(PG8_GAS f32x4*)(OUT + off + 4) = acc[ai][bj][m][1] * rs[ai][m] * g1; }
        }
    }
};

struct EpiUp {
    static constexpr bool PERM = true;
    static constexpr bool NEEDS_RSTD = true;
    const PG8_GAS float* SS; const PG8_GAS float* bias; PG8_GAS bf16_t* O; int ldc; PG8_LAS unsigned char* ldsb; int par;
    __device__ __forceinline__ void operator()(f32x4 (&acc)[2][2][4][2], const Unit& u, int wr, int wc, int fr, int fq) const {
        const int b = u.pm >> 5, colb = u.pn * BM + wc * 32 + 8 * fq, row0 = u.pm * BM + wr * 64 + fr;
        float rs[2][4];
#pragma unroll
        for (int ai = 0; ai < 2; ++ai)
#pragma unroll
            for (int m = 0; m < 4; ++m) rs[ai][m] = ((const PG8_LAS float*)(ldsb + RSTD_TAB_OFF + par * 1024))[wr * 64 + fr + ai * HALF + m * 16];
#pragma unroll
        for (int bj = 0; bj < 2; ++bj) {
            const f32x4 bv0 = *(const PG8_GAS f32x4*)(bias + (size_t)b * ldc + colb + bj * HALF), bv1 = *(const PG8_GAS f32x4*)(bias + (size_t)b * ldc + colb + bj * HALF + 4);
#pragma unroll
            for (int ai = 0; ai < 2; ++ai)
#pragma unroll
                for (int m = 0; m < 4; ++m) { f32x4 v0 = acc[ai][bj][m][0] * rs[ai][m] + bv0, v1 = acc[ai][bj][m][1] * rs[ai][m] + bv1;
#pragma unroll
                    for (int j = 0; j < 4; ++j) { v0[j] = fmaxf(v0[j], 0.f); v1[j] = fmaxf(v1[j], 0.f); }
                    v0 = v0 * v0; v1 = v1 * v1;
                    u32x4 w; w.x = cvt_pk_bf16(v0[0], v0[1]); w.y = cvt_pk_bf16(v0[2], v0[3]); w.z = cvt_pk_bf16(v1[0], v1[1]); w.w = cvt_pk_bf16(v1[2], v1[3]);
                    *(PG8_GAS u32x4*)(O + ((size_t)(u.pm * 16 + u.pn) * 256 + (wr * 64 + fr + ai * HALF + m * 16)) * 256 + (wc * 32 + 8 * fq + bj * HALF)) = w; }
        }
    }
};

struct EpiQKV {
    static constexpr bool PERM = true;
    static constexpr bool NEEDS_RSTD = true;
    const PG8_GAS float* SS; const PG8_GAS float* bias; PG8_GAS bf16_t* Q; size_t split_stride; PG8_GAS float* KMP; PG8_LAS unsigned char* ldsb; int par;
    __device__ __forceinline__ void operator()(f32x4 (&acc)[2][2][4][2], const Unit& u, int wr, int wc, int fr, int fq) const {
        const int b = u.pm >> 5, t = u.pn >> 2, colt = (u.pn & 3) * BM + wc * 32 + 8 * fq, colb = u.pn * BM + wc * 32 + 8 * fq, row0 = u.pm * BM + wr * 64 + fr;
        PG8_GAS bf16_t* base = Q + (size_t)t * split_stride; const float sc = (t == 0) ? C2_ : 1.0f;
        float rs[2][4];
#pragma unroll
        for (int ai = 0; ai < 2; ++ai)
#pragma unroll
            for (int m = 0; m < 4; ++m) rs[ai][m] = ((const PG8_LAS float*)(ldsb + RSTD_TAB_OFF + par * 1024))[wr * 64 + fr + ai * HALF + m * 16];
#pragma unroll
        for (int bj = 0; bj < 2; ++bj) {
            const f32x4 bv0 = *(const PG8_GAS f32x4*)(bias + (size_t)b * 3072 + colb + bj * HALF), bv1 = *(const PG8_GAS f32x4*)(bias + (size_t)b * 3072 + colb + bj * HALF + 4);
            f32x4 cs0 = {0.f, 0.f, 0.f, 0.f}, cs1 = cs0;
#pragma unroll
            for (int ai = 0; ai < 2; ++ai)
#pragma unroll
                for (int m = 0; m < 4; ++m) { f32x4 v0 = acc[ai][bj][m][0] * rs[ai][m] + bv0, v1 = acc[ai][bj][m][1] * rs[ai][m] + bv1;
                    cs0 += v0; cs1 += v1; v0 = v0 * sc; v1 = v1 * sc;
                    u32x4 w; w.x = cvt_pk_bf16(v0[0], v0[1]); w.y = cvt_pk_bf16(v0[2], v0[3]); w.z = cvt_pk_bf16(v1[0], v1[1]); w.w = cvt_pk_bf16(v1[2], v1[3]);
                    *(PG8_GAS u32x4*)(base + hm_off((size_t)(row0 + ai * HALF + m * 16), b, (colt + bj * HALF) >> 6) + ((colt + bj * HALF) & 63)) = w; }
            if (t == 1) {
#pragma unroll
                for (int o = 1; o < 16; o <<= 1) {
#pragma unroll
                    for (int j = 0; j < 4; ++j) { cs0[j] += shx(cs0[j], o, fq * 16 + fr); cs1[j] += shx(cs1[j], o, fq * 16 + fr); } }
                if (fr == 0) { PG8_GAS float* kp = KMP + ((size_t)u.pm * 2 + wr) * 1024 + colt + bj * HALF; *(f32x4*)kp = cs0; *(PG8_GAS f32x4*)(kp + 4) = cs1; }
            }
        }
    }
};

template <class Epi, class Sched, bool ALIGN_EPI>
__device__ __forceinline__ void gemm_phase(PG8_LAS unsigned char* lds, const Gemm g, const Sched& S, const Epi& E_, int wave_id) {
    Epi E = E_;
    int tid = wave_id * 64 + lane_id(); asm volatile("" : "+v"(tid));
    const int wid = __builtin_amdgcn_readfirstlane(tid >> 6), lane = tid & 63, wr = wid >> 2, wc = wid & 3, fr = lane & 15, fq = lane >> 4;
    const int K = g.K, nt = K / BK, lda = g.lda;
    unsigned voffA[2], voffB[2];
#pragma unroll
    for (int i = 0; i < 2; ++i) { int R, C; stage_rc(tid * 16 + i * 8192, R, C); const int Rb = Epi::PERM ? ((R & ~31) + perm32(R & 31)) : R;
        voffA[i] = (unsigned)(R * lda + C) * 2u; voffB[i] = (unsigned)(Rb * K + C) * 2u; }
    const size_t kstep = (size_t)(BK * 2);
    const size_t hstepA = (size_t)HALF * lda * 2, tstepA = (g.a_tileb == 512) ? 2 * hstepA : (size_t)(K / 256) * g.a_tileb, hstepB = (size_t)HALF * K * 2, tstepB = 2 * hstepB;
    const size_t tileb = (size_t)g.a_tileb;
#define PG8_KOFF(t) ((size_t)((t) >> 2) * tileb + (size_t)((t) & 3) * 128)
    const unsigned ldsw = (unsigned)wid * 1024u;
    const int aoff = lds_byte(wr * 64 + fr, fq * 8), boff = lds_byte(wc * 32 + fr, fq * 8);
#define PG8_SA(b, h) (((b) * 2 + (h)) * HTB)
#define PG8_SB(b, h) ((4 + (b) * 2 + (h)) * HTB)
#define PG8_STAGE(bufoff, gbase, voff) do { _Pragma("unroll") for (int _i = 0; _i < 2; ++_i) \
        __builtin_amdgcn_global_load_lds((const PG8_GAS unsigned*)((const PG8_GAS char*)(gbase) + (voff)[_i]), (PG8_LAS unsigned*)(lds + (bufoff) + ldsw + _i * 8192), 16, 0, 0); } while (0)
#define PG8_LDA(dst, b, h) do { _Pragma("unroll") for (int m = 0; m < 4; ++m) _Pragma("unroll") for (int k = 0; k < 2; ++k) dst[m][k] = *(const PG8_LAS bf16x8*)(lds + PG8_SA(b, h) + aoff + m * 2048 + k * 1024); } while (0)
#define PG8_LDB(dst, b, h) do { _Pragma("unroll") for (int n = 0; n < 2; ++n) _Pragma("unroll") for (int k = 0; k < 2; ++k) dst[n][k] = *(const PG8_LAS bf16x8*)(lds + PG8_SB(b, h) + boff + n * 2048 + k * 1024); } while (0)
#define PG8_MMA(ai, bj, At, Bt) do { __builtin_amdgcn_s_setprio(1); _Pragma("unroll") for (int m = 0; m < 4; ++m) _Pragma("unroll") for (int n = 0; n < 2; ++n) _Pragma("unroll") for (int k = 0; k < 2; ++k) \
        acc[ai][bj][m][n] = __builtin_amdgcn_mfma_f32_16x16x32_bf16(Bt[n][k], At[m][k], acc[ai][bj][m][n], 0, 0, 0); __builtin_amdgcn_s_setprio(0); } while (0)
#define PG8_WAIT_V(n) asm volatile("s_waitcnt vmcnt(" #n ")" ::: "memory")
#define PG8_WAIT_L(n) asm volatile("s_waitcnt lgkmcnt(" #n ")" ::: "memory")
#define PG8_BAR __builtin_amdgcn_s_barrier()
#define PG8_SCHED __builtin_amdgcn_sched_barrier(0)
    Unit cur, nxt; int ui = 0;
    if (!S.next(0, cur)) return;
    int rpar = 0;
    if constexpr (Epi::NEEDS_RSTD) { fill_rstd_tab(lds, 0, E.SS, cur.pm, wid, lane); E.par = 0; }
    f32x4 acc[2][2][4][2];
#pragma unroll
    for (int a = 0; a < 2; ++a)
#pragma unroll
        for (int b = 0; b < 2; ++b)
#pragma unroll
            for (int m = 0; m < 4; ++m)
#pragma unroll
                for (int n = 0; n < 2; ++n) acc[a][b][m][n] = (f32x4){0.f, 0.f, 0.f, 0.f};
    bf16x8 At[4][2], B0[2][2], B1[2][2];
    const PG8_GAS char* cA = (const PG8_GAS char*)g.A + (size_t)cur.pm * tstepA + (size_t)cur.pn * g.a_pn_off * 2; const PG8_GAS char* cB = (const PG8_GAS char*)g.Bt + (size_t)cur.pn * tstepB + (size_t)(cur.pm >> 5) * g.b_bstride;
    PG8_STAGE(PG8_SB(0, 0), cB, voffB); PG8_STAGE(PG8_SB(0, 1), cB + hstepB, voffB); PG8_STAGE(PG8_SA(0, 0), cA, voffA); PG8_STAGE(PG8_SA(0, 1), cA + hstepA, voffA);
    if (wr == 1) PG8_BAR;
    PG8_WAIT_V(2); PG8_BAR;
    PG8_STAGE(PG8_SB(1, 0), cB + kstep, voffB); PG8_STAGE(PG8_SA(1, 0), cA + kstep, voffA); PG8_STAGE(PG8_SB(1, 1), cB + hstepB + kstep, voffB);
    PG8_WAIT_V(6); PG8_BAR;
    for (;;) {
        const bool has_next = S.next(ui + 1, nxt);
        const PG8_GAS char* nA = has_next ? (const PG8_GAS char*)g.A + (size_t)nxt.pm * tstepA + (size_t)nxt.pn * g.a_pn_off * 2 : cA; const PG8_GAS char* nB = has_next ? (const PG8_GAS char*)g.Bt + (size_t)nxt.pn * tstepB + (size_t)(nxt.pm >> 5) * g.b_bstride : cB;
        for (int t = 0; t < nt; t += 2) {
            const bool last = (t == nt - 2);
            const PG8_GAS char* a1 = cA + PG8_KOFF(t + 1);
            const PG8_GAS char* a2 = last ? nA : cA + PG8_KOFF(t + 2); const PG8_GAS char* b2 = last ? nB : cB + (size_t)(t + 2) * kstep;
            const PG8_GAS char* a3 = a2 + kstep; const PG8_GAS char* b3 = b2 + kstep;
            PG8_LDB(B0, 0, 0); PG8_LDB(B1, 0, 1); PG8_SCHED; PG8_LDA(At, 0, 0); PG8_STAGE(PG8_SA(1, 1), a1 + hstepA, voffA);
            PG8_WAIT_V(8); PG8_WAIT_L(0); PG8_BAR; PG8_MMA(0, 0, At, B0); PG8_MMA(0, 1, At, B1); PG8_BAR; PG8_SCHED;
            PG8_LDA(At, 0, 1); PG8_STAGE(PG8_SB(0, 0), b2, voffB); PG8_STAGE(PG8_SB(0, 1), b2 + hstepB, voffB); PG8_STAGE(PG8_SA(0, 0), a2, voffA);
            PG8_WAIT_V(8); PG8_WAIT_L(0); PG8_BAR; PG8_MMA(1, 0, At, B0); PG8_MMA(1, 1, At, B1); PG8_BAR; PG8_SCHED;
            PG8_LDB(B0, 1, 0); PG8_LDB(B1, 1, 1); PG8_SCHED; PG8_LDA(At, 1, 0); PG8_STAGE(PG8_SA(0, 1), a2 + hstepA, voffA);
            PG8_WAIT_V(8); PG8_WAIT_L(0); PG8_BAR; PG8_MMA(0, 0, At, B0); PG8_MMA(0, 1, At, B1); PG8_BAR; PG8_SCHED;
            PG8_LDA(At, 1, 1); PG8_STAGE(PG8_SB(1, 0), b3, voffB); PG8_STAGE(PG8_SB(1, 1), b3 + hstepB, voffB); PG8_STAGE(PG8_SA(1, 0), a3, voffA);
            PG8_WAIT_V(8); PG8_WAIT_L(0); PG8_BAR; PG8_MMA(1, 0, At, B0); PG8_MMA(1, 1, At, B1); PG8_BAR; PG8_SCHED;
        }
        if constexpr (ALIGN_EPI) { if (wr == 0) PG8_BAR; }
        if constexpr (Epi::NEEDS_RSTD) E.par = rpar;
        E(acc, cur, wr, wc, fr, fq);
        if constexpr (Epi::NEEDS_RSTD) { if (has_next && nxt.pm != cur.pm) { rpar ^= 1; fill_rstd_tab(lds, rpar, E.SS, nxt.pm, wid, lane); } }
        if (!has_next) break;
#pragma unroll
        for (int a = 0; a < 2; ++a)
#pragma unroll
            for (int b = 0; b < 2; ++b)
#pragma unroll
                for (int m = 0; m < 4; ++m)
#pragma unroll
                    for (int n = 0; n < 2; ++n) acc[a][b][m][n] = (f32x4){0.f, 0.f, 0.f, 0.f};
        cur = nxt; cA = nA; cB = nB; ++ui;
        if constexpr (ALIGN_EPI) { if (wr == 1) PG8_BAR; }
    }
    PG8_WAIT_V(0);
    if constexpr (!ALIGN_EPI) { if (wr == 0) PG8_BAR; }
    PG8_BAR;
#undef PG8_KOFF
#undef PG8_SA
#undef PG8_SB
#undef PG8_STAGE
#undef PG8_LDA
#undef PG8_LDB
#undef PG8_MMA
#undef PG8_WAIT_V
#undef PG8_WAIT_L
#undef PG8_BAR
#undef PG8_SCHED
}
}

constexpr int NWAVES = 8;
constexpr int BATCH = 4, SEQ = 8192, D = 1024, NH = 16, HD = 64, FF = 4096, M = BATCH * SEQ, NQKV = 3 * D, NBLK = 32, BLK = 256;
constexpr float EPS = 1e-6f;
constexpr float LOG2E = 1.4426950408889634f;

constexpr size_t MiB = 1u << 20;
constexpr size_t WS_CTL = 0, CTL_ZERO_BYTES = 1 * MiB;
constexpr size_t WS_MOD = 1 * MiB;
constexpr size_t WS_BIAS_UP0 = WS_MOD + 256 * 1024;
constexpr size_t WS_BIAS_QKV = WS_BIAS_UP0 + 64 * 1024;
constexpr size_t WS_BIAS_UP1 = WS_BIAS_QKV + 64 * 1024;
constexpr size_t WS_KMP = 2 * MiB;
constexpr size_t WS_SS = 3 * MiB;
constexpr size_t WS_WPOOL = 6 * MiB, WS_WQKV = 8 * MiB, WS_WO = 14 * MiB, WS_WUP0 = 16 * MiB, WS_WUP1 = 24 * MiB, WS_WDN0 = 32 * MiB, WS_WDN1 = 40 * MiB;
constexpr size_t WS_XNA = 48 * MiB, WS_XNB = 112 * MiB;
constexpr size_t WS_WSUP0 = 112 * MiB, WS_WSUP1 = 144 * MiB;
constexpr size_t OUT_WSQKV = 96 * MiB;
constexpr size_t WS_HB = 176 * MiB;
constexpr size_t WS_Q = 176 * MiB, WS_K = 240 * MiB, WS_V = 304 * MiB;
constexpr size_t WS_PL = 496 * MiB;
constexpr size_t WS_CNT = 503 * MiB;
constexpr size_t WS_KBM = 503 * MiB + 512 * 1024;
constexpr size_t WS_POB = 48 * MiB;
constexpr size_t WS_SEG = 368 * MiB;
constexpr size_t WS_XR = 432 * MiB;
constexpr size_t WS_O = 368 * MiB;
constexpr size_t WS_DUMP = 504 * MiB;
constexpr size_t WS_END = 506 * MiB;
constexpr int CW_BAR = 4096;
constexpr int CW_FIN = 24576;
constexpr int CW_TOT = 16384;

constexpr int RING_OFF = 0, RING_BYTES = 131072;
constexpr int LDSCTL_OFF = RING_BYTES, MISC_OFF = LDSCTL_OFF + 320;
constexpr int LDS_BYTES = 151552;

#define GAS __attribute__((address_space(1)))
#define LAS __attribute__((address_space(3)))
typedef unsigned short bf16;
typedef unsigned v4u __attribute__((ext_vector_type(4)));
typedef unsigned v2u __attribute__((ext_vector_type(2)));
typedef float f32x4 __attribute__((ext_vector_type(4)));
typedef GAS unsigned gu32;
#define RLX_AGENT __ATOMIC_RELAXED, __HIP_MEMORY_SCOPE_AGENT
#define LDS_WAIT() asm volatile("s_waitcnt lgkmcnt(0)" ::: "memory")
__device__ __forceinline__ unsigned f2bf(float f) { unsigned u = __builtin_bit_cast(unsigned, f); return (u + 0x7fffu + ((u >> 16) & 1u)) >> 16; }
__device__ __forceinline__ unsigned pk2(float lo, float hi) { return f2bf(lo) | (f2bf(hi) << 16); }
__device__ __forceinline__ float bf2f(unsigned short v) { return __builtin_bit_cast(float, (unsigned)v << 16); }

#define XB_TMO      128
#define XB_XCNT(j)  (256  + 64 * (j))
#define XB_XSUB(j)  (1280 + 64 * (j))
#define XB_XGEN(j)  (2304 + 64 * (j))
#define XB_TOP      3328
#define XB_TOPGEN   3392
#define XCD_BAR_WORDS 3456
#define XB_SPIN_CAP (1u << 18)
__device__ __forceinline__ unsigned xb_ld(GAS unsigned* p)              { return __hip_atomic_load(p, __ATOMIC_RELAXED, __HIP_MEMORY_SCOPE_AGENT); }
__device__ __forceinline__ unsigned xb_add(GAS unsigned* p, unsigned v) { return __hip_atomic_fetch_add(p, v, __ATOMIC_RELAXED, __HIP_MEMORY_SCOPE_AGENT); }
__device__ __forceinline__ unsigned xb_xcc_id() { return (unsigned)__builtin_amdgcn_s_getreg((3 << 11) | 20) & 0xFu; }
#define XB_SPIN(cond, bar) do { unsigned _sp = 0; while (cond) { __builtin_amdgcn_s_sleep(1); \
    if ((++_sp & 255u) == 0u) { if (xb_ld(&(bar)[XB_TMO])) break; if (_sp > XB_SPIN_CAP) { (void)xb_add(&(bar)[XB_TMO], 1u); break; } } } } while (0)
struct XcdBarrier { GAS unsigned* bar; unsigned x; volatile LAS unsigned* st; int wave; };
__device__ __forceinline__ XcdBarrier xcd_barrier_post(GAS unsigned* bar, volatile LAS unsigned* st) {
    XcdBarrier b; b.bar = bar; b.x = xb_xcc_id(); b.st = st;
    if (threadIdx.x == 0) (void)xb_add(&bar[XB_XCNT(b.x)], 1u);
    return b;
}
__device__ __forceinline__ void xcd_barrier_complete(GAS unsigned* bar, unsigned x, unsigned& nloc, unsigned& nx) {
    const unsigned G = gridDim.x * gridDim.y * gridDim.z;
    unsigned sum, cnt, mine, sp = 0u;
    for (;;) {
        sum = 0u; cnt = 0u; mine = 0u;
#pragma unroll
        for (unsigned j = 0; j < 16; ++j) { const unsigned c = xb_ld(&bar[XB_XCNT(j)]); sum += c; cnt += (c > 0u) ? 1u : 0u; mine = (j == x) ? c : mine; }
        if (sum == G) break;
        __builtin_amdgcn_s_sleep(1);
        if ((++sp & 255u) == 0u) { if (xb_ld(&bar[XB_TMO])) break; if (sp > XB_SPIN_CAP) { (void)xb_add(&bar[XB_TMO], 1u); break; } }
    }
    nloc = mine > 0u ? mine : 1u; nx = cnt > 0u ? cnt : 1u;
}
__device__ __forceinline__ void xcd_barrier(const XcdBarrier& b) {
    asm volatile("s_waitcnt vmcnt(0)" ::: "memory");
    __syncthreads();
    if (b.wave == 0 && lane_id() == 0) {
        GAS unsigned* bar = b.bar; asm volatile("" : "+s"(bar));
        const unsigned bx = xb_xcc_id();
        __builtin_amdgcn_s_waitcnt(0);
        unsigned nloc = b.st[0], nx = b.st[1];
        if (nloc == 0u) { xcd_barrier_complete(bar, bx, nloc, nx); b.st[0] = nloc; b.st[1] = nx; }
        const unsigned old = xb_add(&bar[XB_XSUB(bx)], 1u);
        const unsigned gen = old / nloc;
        if (old + 1u == (gen + 1u) * nloc) {
            __builtin_amdgcn_fence(__ATOMIC_RELEASE, "agent");
            asm volatile("s_waitcnt vmcnt(0)" ::: "memory");
            const unsigned og = xb_add(&bar[XB_TOP], 1u);
            const unsigned tg = og / nx;
            if (og + 1u == (tg + 1u) * nx) xb_add(&bar[XB_TOPGEN], 1u);
            else XB_SPIN(xb_ld(&bar[XB_TOPGEN]) == tg, bar);
            __builtin_amdgcn_fence(__ATOMIC_ACQUIRE, "agent");
            xb_add(&bar[XB_XGEN(bx)], 1u);
            asm volatile("s_waitcnt vmcnt(0)" ::: "memory");
        } else {
            XB_SPIN(xb_ld(&bar[XB_XGEN(bx)]) == gen, bar);
            __builtin_amdgcn_fence(__ATOMIC_ACQUIRE, "agent");
            asm volatile("s_waitcnt vmcnt(0)" ::: "memory");
        }
    }
    __syncthreads();
}

struct Args { const GAS float* in[14]; GAS float* out; GAS unsigned char* ws; };
struct Frame {
    LAS unsigned char* lds; int tid, lane, wave, vcu, G;
    const GAS float *x, *c, *rel_bias, *w_mod, *b_mod, *norm_mix, *norm_mlp, *w_pool, *pool_scale, *w_qkv, *w_o, *w_up, *w_down, *norm_final;
    GAS float* out; GAS unsigned char* ws;
};
__device__ __forceinline__ float wave_sum(float v) {
#pragma unroll
    for (int o = 1; o < 64; o <<= 1) v += __shfl_xor(v, o);
    return v;
}

struct TItem { const GAS float* W; GAS bf16* WT; int K, N, row_off, item; };
__device__ __forceinline__ void tload(const TItem& I, f32x4 (&t)[8], int lane) {
    const int nblk = I.N / 32, kb = I.item / nblk, nb = I.item % nblk, k0 = 64 * kb, n0 = 32 * nb;
#pragma unroll
    for (int i = 0; i < 8; ++i) t[i] = *(const GAS f32x4*)(I.W + (size_t)(k0 + 8 * i + (lane >> 3)) * I.N + n0 + 4 * (lane & 7));
}
__device__ __forceinline__ void tstore(const TItem& I, const f32x4 (&t)[8], LAS float* scr, int lane) {
    const int nblk = I.N / 32, kb = I.item / nblk, nb = I.item % nblk, k0 = 64 * kb, n0 = 32 * nb;
#pragma unroll
    for (int i = 0; i < 8; ++i) { LAS float* d = scr + (8 * i + (lane >> 3)) * 33 + 4 * (lane & 7); d[0] = t[i][0]; d[1] = t[i][1]; d[2] = t[i][2]; d[3] = t[i][3]; }
    LDS_WAIT(); asm volatile("" ::: "memory");
    const int c = lane & 7;
#pragma unroll
    for (int j = 0; j < 4; ++j) { const int n = (lane >> 3) + 8 * j; const LAS float* s = scr + (8 * c) * 33 + n;
        v4u o; o.x = pk2(s[0 * 33], s[1 * 33]); o.y = pk2(s[2 * 33], s[3 * 33]); o.z = pk2(s[4 * 33], s[5 * 33]); o.w = pk2(s[6 * 33], s[7 * 33]);
        *(GAS v4u*)(I.WT + (size_t)(I.row_off + n0 + n) * I.K + k0 + 8 * c) = o; }
    LDS_WAIT(); asm volatile("" ::: "memory");
}
__device__ __forceinline__ void p0_prologue(Frame& F) {
    if (F.vcu < 192) {
        LAS float* cact = (LAS float*)(F.lds + 67584);
        LAS float* red = (LAS float*)(F.lds + 67584 + 16384);
        const int l = F.vcu / 96, j0 = (F.vcu % 96) * 64;
        for (int i = F.tid; i < 4096; i += NWAVES * 64) { const float v = F.c[i]; cact[i] = v / (1.f + __expf(-v)); }
        __syncthreads();
        const int sub = F.lane >> 4, c4 = F.lane & 15;
        f32x4 a0 = {0.f, 0.f, 0.f, 0.f}, a1 = a0, a2 = a0, a3 = a0;
        const GAS float* wb = F.w_mod + (size_t)l * 1024 * 6144 + j0 + 4 * c4;
#pragma unroll
        for (int it = 0; it < 32; ++it) { const int k = 32 * it + 4 * F.wave + sub; const f32x4 wv = *(const GAS f32x4*)(wb + (size_t)k * 6144);
            a0 += wv * cact[k]; a1 += wv * cact[1024 + k]; a2 += wv * cact[2048 + k]; a3 += wv * cact[3072 + k]; }
#pragma unroll
        for (int j = 0; j < 4; ++j) { a0[j] += __shfl_xor(a0[j], 16); a0[j] += __shfl_xor(a0[j], 32); a1[j] += __shfl_xor(a1[j], 16); a1[j] += __shfl_xor(a1[j], 32);
            a2[j] += __shfl_xor(a2[j], 16); a2[j] += __shfl_xor(a2[j], 32); a3[j] += __shfl_xor(a3[j], 16); a3[j] += __shfl_xor(a3[j], 32); }
        if (sub == 0) { LAS f32x4* r4 = (LAS f32x4*)(red + F.wave * 256); r4[0 * 16 + c4] = a0; r4[1 * 16 + c4] = a1; r4[2 * 16 + c4] = a2; r4[3 * 16 + c4] = a3; }
        __syncthreads();
        if (F.tid < 256) { const int b = F.tid >> 6, col = F.tid & 63; float s = 0.f;
#pragma unroll
            for (int w = 0; w < 8; ++w) s += red[w * 256 + b * 64 + col];
            ((GAS float*)(F.ws + WS_MOD))[(l * 4 + b) * 6144 + j0 + col] = s + F.b_mod[l * 6144 + j0 + col]; }
    }
    LAS float* scr = (LAS float*)(F.lds + RING_OFF + F.wave * 8448);
    const int gw = F.vcu * NWAVES + F.wave, NGW = F.G * NWAVES;
    constexpr int I_POOL = 4 * 32, I_QKV = 16 * 96, I_O = 16 * 32, I_UP = 16 * 128, I_DN = 64 * 32;
    constexpr int NITEMS = I_POOL + I_QKV + I_O + 2 * I_UP + 2 * I_DN;
    auto desc = [&](int it) -> TItem {
        int r = it;
        if (r < I_POOL) { const int g = r / 32; return TItem{F.w_pool + (size_t)g * 65536, (GAS bf16*)(F.ws + WS_WPOOL), 256, 256, g * 256, r % 32}; } r -= I_POOL;
        if (r < I_QKV) return TItem{F.w_qkv, (GAS bf16*)(F.ws + WS_WQKV), D, NQKV, 0, r}; r -= I_QKV;
        if (r < I_O) return TItem{F.w_o, (GAS bf16*)(F.ws + WS_WO), D, D, 0, r}; r -= I_O;
        if (r < 2 * I_UP) { const int l = r / I_UP; return TItem{F.w_up + (size_t)l * D * FF, (GAS bf16*)(F.ws + (l ? WS_WUP1 : WS_WUP0)), D, FF, 0, r % I_UP}; } r -= 2 * I_UP;
        const int l = r / I_DN; return TItem{F.w_down + (size_t)l * FF * D, (GAS bf16*)(F.ws + (l ? WS_WDN1 : WS_WDN0)), FF, D, 0, r % I_DN};
    };
    f32x4 ta[8], tb[8], tc[8], td[8];
    int it = gw;
    if (it < NITEMS) { TItem c0 = desc(it), c1 = c0; bool h1 = it + NGW < NITEMS; tload(c0, ta, F.lane); if (h1) { c1 = desc(it + NGW); tload(c1, tb, F.lane); }
        for (;;) {
            const int i2 = it + 2 * NGW, i3 = it + 3 * NGW; const bool h2 = i2 < NITEMS, h3 = i3 < NITEMS; TItem n0 = c0, n1 = c1;
            if (h2) { n0 = desc(i2); tload(n0, tc, F.lane); }
            if (h3) { n1 = desc(i3); tload(n1, td, F.lane); }
            tstore(c0, ta, scr, F.lane);
            if (h1) tstore(c1, tb, scr, F.lane);
            if (!h2) break;
#pragma unroll
            for (int i = 0; i < 8; ++i) { ta[i] = tc[i]; tb[i] = td[i]; }
            c0 = n0; c1 = n1; h1 = h3; it = i2;
        } }
}

__device__ __forceinline__ void p1_bias(Frame& F) {
    const int gw = F.vcu * NWAVES + F.wave, NGW = F.G * NWAVES;
    const GAS float* MOD = (const GAS float*)(F.ws + WS_MOD);
#pragma unroll 1
    for (int seg = 0; seg < 3; ++seg) {
        const GAS bf16* wt; const GAS float* sh; GAS float* dst; int N; GAS bf16* wsc; const GAS float* gam;
        if (seg == 0) { N = 4096; wt = (const GAS bf16*)(F.ws + WS_WUP0); sh = MOD + 3072; dst = (GAS float*)(F.ws + WS_BIAS_UP0); wsc = (GAS bf16*)(F.ws + WS_WSUP0); gam = F.norm_mlp; }
        else if (seg == 1) { N = 3072; wt = (const GAS bf16*)(F.ws + WS_WQKV); sh = MOD + 4 * 6144; dst = (GAS float*)(F.ws + WS_BIAS_QKV); wsc = (GAS bf16*)((GAS unsigned char*)F.out + OUT_WSQKV); gam = F.norm_mix + D; }
        else { N = 4096; wt = (const GAS bf16*)(F.ws + WS_WUP1); sh = MOD + 4 * 6144 + 3072; dst = (GAS float*)(F.ws + WS_BIAS_UP1); wsc = (GAS bf16*)(F.ws + WS_WSUP1); gam = F.norm_mlp + D; }
        int n = gw; if (n >= N) continue;
        float shv[4][16], gv[4][16];
#pragma unroll
        for (int b = 0; b < 4; ++b) { const GAS f32x4* sp = (const GAS f32x4*)(sh + b * 6144 + F.lane * 16); const GAS f32x4* cp = (const GAS f32x4*)(sh + 1024 + b * 6144 + F.lane * 16); const GAS f32x4* gp = (const GAS f32x4*)(gam + F.lane * 16);
#pragma unroll
            for (int j = 0; j < 4; ++j) { const f32x4 sv = sp[j], cv = cp[j], g4 = gp[j];
#pragma unroll
                for (int i = 0; i < 4; ++i) { shv[b][4 * j + i] = sv[i]; gv[b][4 * j + i] = g4[i] * (1.0f + cv[i]); } } }
        v4u w0 = *(const GAS v4u*)(wt + (size_t)n * 1024 + F.lane * 16), w1 = *(const GAS v4u*)(wt + (size_t)n * 1024 + F.lane * 16 + 8);
        for (;;) {
            const int nn = n + NGW; const bool hn = nn < N; v4u x0 = w0, x1 = w1;
            if (hn) { x0 = *(const GAS v4u*)(wt + (size_t)nn * 1024 + F.lane * 16); x1 = *(const GAS v4u*)(wt + (size_t)nn * 1024 + F.lane * 16 + 8); }
            float wf[16];
#pragma unroll
            for (int j = 0; j < 4; ++j) { wf[2 * j] = __builtin_bit_cast(float, w0[j] << 16); wf[2 * j + 1] = __builtin_bit_cast(float, w0[j] & 0xffff0000u);
                wf[8 + 2 * j] = __builtin_bit_cast(float, w1[j] << 16); wf[8 + 2 * j + 1] = __builtin_bit_cast(float, w1[j] & 0xffff0000u); }
#pragma unroll
            for (int b = 0; b < 4; ++b) { float s = 0.f;
#pragma unroll
                for (int i = 0; i < 16; ++i) s += wf[i] * shv[b][i];
                s = wave_sum(s); if (F.lane == 0) dst[b * N + n] = s;
                unsigned pk[8];
#pragma unroll
                for (int i = 0; i < 8; ++i) pk[i] = pg8::cvt_pk_bf16(wf[2 * i] * gv[b][2 * i], wf[2 * i + 1] * gv[b][2 * i + 1]);
                GAS v4u* wp = (GAS v4u*)(wsc + ((size_t)b * N + n) * 1024 + F.lane * 16); wp[0] = (v4u){pk[0], pk[1], pk[2], pk[3]}; wp[1] = (v4u){pk[4], pk[5], pk[6], pk[7]}; }
            if (!hn) break;
            w0 = x0; w1 = x1; n = nn;
        }
    }
}
__device__ __forceinline__ void p1_pool(Frame& F) {
    LAS float* ring = (LAS float*)(F.lds + RING_OFF);
    const GAS float* MOD = (const GAS float*)(F.ws + WS_MOD); GAS bf16* XN = (GAS bf16*)(F.ws + WS_XNA); GAS bf16* XR = (GAS bf16*)(F.ws + WS_XR);
    for (int run = F.vcu; run < M / 128; run += F.G) {
        const int t0 = run * 128, s0 = t0 % SEQ, b = t0 / SEQ;
        f32x4 gam[4];
#pragma unroll
        for (int j = 0; j < 4; ++j) gam[j] = *(const GAS f32x4*)(F.norm_mix + 4 * (F.lane + 64 * j));
        const int c4 = F.tid & 255, rh = F.tid >> 8, gi = c4 >> 6, w = 2 << gi;
        const f32x4 sc1 = *(const GAS f32x4*)(MOD + b * 6144 + 1024 + 4 * c4) + 1.0f;
        f32x4 v[2][4];
        const GAS float* xb = F.x + (size_t)b * SEQ * D + 4 * F.lane;
        int st = (s0 > 0 ? -1 : 0);
#pragma unroll
        for (int rr = 0; rr < 2; ++rr)
#pragma unroll
            for (int j = 0; j < 4; ++j) v[rr][j] = *(const GAS f32x4*)(xb + (size_t)(s0 + 16 * st + 2 * F.wave + rr) * D + 256 * j);
        for (; st < 8; ++st) {
            if (st >= 0) {
#pragma unroll
                for (int rr = 0; rr < 2; ++rr)
#pragma unroll
                    for (int j = 0; j < 4; ++j) { v2u o2; o2.x = pk2(v[rr][j][0], v[rr][j][1]); o2.y = pk2(v[rr][j][2], v[rr][j][3]);
                        { const size_t trow = (size_t)b * SEQ + s0 + 16 * st + 2 * F.wave + rr; *(GAS v2u*)(XR + (((trow >> 8) * 4 + j) * 256 + (trow & 255)) * 256 + 4 * F.lane) = o2; } } }
            float ss0 = 0.f, ss1 = 0.f;
#pragma unroll
            for (int j = 0; j < 4; ++j) { ss0 += (v[0][j][0] * v[0][j][0] + v[0][j][1] * v[0][j][1]) + (v[0][j][2] * v[0][j][2] + v[0][j][3] * v[0][j][3]);
                ss1 += (v[1][j][0] * v[1][j][0] + v[1][j][1] * v[1][j][1]) + (v[1][j][2] * v[1][j][2] + v[1][j][3] * v[1][j][3]); }
#pragma unroll
            for (int o = 1; o < 64; o <<= 1) { ss0 += __shfl_xor(ss0, o); ss1 += __shfl_xor(ss1, o); }
            const float rs0 = rsqrtf(ss0 * (1.0f / D) + EPS), rs1 = rsqrtf(ss1 * (1.0f / D) + EPS);
            { const int sr = s0 + 16 * st + 2 * F.wave;
#pragma unroll
              for (int j = 0; j < 4; ++j) { *(LAS f32x4*)(ring + (sr & 31) * 1024 + 4 * (F.lane + 64 * j)) = v[0][j] * rs0 * gam[j]; *(LAS f32x4*)(ring + ((sr + 1) & 31) * 1024 + 4 * (F.lane + 64 * j)) = v[1][j] * rs1 * gam[j]; } }
            if (st + 1 < 8) {
#pragma unroll
                for (int rr = 0; rr < 2; ++rr)
#pragma unroll
                    for (int j = 0; j < 4; ++j) v[rr][j] = *(const GAS f32x4*)(xb + (size_t)(s0 + 16 * (st + 1) + 2 * F.wave + rr) * D + 256 * j); }
            __syncthreads();
            if (st >= 0) {
                const int sA = s0 + 16 * st + 8 * rh;
                f32x4 sum = {0.f, 0.f, 0.f, 0.f};
                { const int cnt0 = (sA < w) ? sA : w; for (int i = 1; i <= cnt0; ++i) sum += *(const LAS f32x4*)(ring + ((sA - i) & 31) * 1024 + 4 * c4); }
#pragma unroll
                for (int r = 0; r < 8; ++r) { const int s = sA + r; const f32x4 cur = *(const LAS f32x4*)(ring + (s & 31) * 1024 + 4 * c4);
                    sum += cur; if (s >= w) sum -= *(const LAS f32x4*)(ring + ((s - w) & 31) * 1024 + 4 * c4);
                    const float inv = 1.0f / (float)((s + 1 < w) ? s + 1 : w);
                    const f32x4 p = (sum * inv - cur) * sc1;
                    v2u o; o.x = pk2(p[0], p[1]); o.y = pk2(p[2], p[3]);
                    *(GAS v2u*)(XN + ((size_t)b * SEQ + s) * D + 4 * c4) = o; }
            }
            __syncthreads();
        }
    }
}

__device__ __forceinline__ int t5_bucket(int dist) {
    if (dist < 16) return dist;
    int b = 16;
    b += (dist >= 21); b += (dist >= 27); b += (dist >= 35); b += (dist >= 46); b += (dist >= 59); b += (dist >= 77); b += (dist >= 99); b += (dist >= 128);
    b += (dist >= 166); b += (dist >= 216); b += (dist >= 280); b += (dist >= 363); b += (dist >= 470); b += (dist >= 609); b += (dist >= 790);
    return b;
}
namespace att {
typedef short bf16x8 __attribute__((ext_vector_type(8)));
typedef short s16x4 __attribute__((ext_vector_type(4)));
typedef short v4i16_t __attribute__((ext_vector_type(4)));
typedef float f32x16 __attribute__((ext_vector_type(16)));
typedef float f32x2_t __attribute__((ext_vector_type(2)));
typedef __bf16 bf16x2_t __attribute__((ext_vector_type(2)));
typedef LAS const char* lds_cptr;
constexpr int L_K = 0, L_V = 32768, L_LUT = 132096, L_QI = 141312, L_CUM = 142336, L_PRE = 142592;
constexpr int LUTN = 2304;
__device__ __forceinline__ int crow(int r, int hi) { return (r & 3) + 8 * (r >> 2) + 4 * hi; }
__device__ __forceinline__ unsigned cvtpk(float lo, float hi) { f32x2_t v = {lo, hi}; bf16x2_t b = __builtin_convertvector(v, bf16x2_t); return __builtin_bit_cast(unsigned, b); }
__device__ __forceinline__ s16x4 vtr(lds_cptr p) { return __builtin_bit_cast(s16x4, __builtin_amdgcn_ds_read_tr16_b64_v4i16((LAS v4i16_t*)p)); }
__device__ __forceinline__ float swap_add(float v) { auto rr = __builtin_amdgcn_permlane32_swap(__float_as_uint(v), __float_as_uint(v), false, false); return __uint_as_float(rr[0]) + __uint_as_float(rr[1]); }

__device__ __forceinline__ void load_kv(LAS unsigned char* lds, const GAS bf16* Kb, const GAS bf16* Vb, int b, int h, int n, int w, int lane) {
#pragma unroll
    for (int t = 0; t < 4; ++t) {
        const size_t kr = (size_t)b * SEQ + n * BLK + 64 * t + lane, vr = (size_t)b * SEQ + n * BLK + 64 * t + 16 * (w & 3) + (lane >> 2);
        const v4u kv = *(const GAS v4u*)(Kb + hm_off(kr, b, h) + w * 8);
        const v4u vv = *(const GAS v4u*)(Vb + hm_off(vr, b, h) + (w >> 2) * 32 + (lane & 3) * 8);
        *(LAS v4u*)(lds + L_K + t * 8192 + w * 1024 + lane * 16) = kv;
        *(LAS v4u*)(lds + L_V + t * 8192 + w * 1024 + lane * 16) = vv;
    }
}
__device__ __forceinline__ void build_lut(LAS unsigned char* lds, const GAS float* rel_bias, int h, int tid) {
    for (int i = tid; i < LUTN; i += NWAVES * 64) ((LAS float*)(lds + L_LUT))[i] = (i <= 2047) ? rel_bias[t5_bucket(2047 - i) * NH + h] * LOG2E : 0.f;
}
__device__ __forceinline__ void qk_tile(f32x16& p0, f32x16& p1, lds_cptr Kt, const bf16x8* qr, const f32x16& cinit, int r32, int hi) {
    const unsigned kb0 = (unsigned)(r32 * 128 + ((hi ^ ((r32 >> 1) & 7)) * 16));
#pragma unroll
    for (int d0 = 0; d0 < 4; ++d0) {
        const bf16x8 b0 = *(LAS const bf16x8*)(Kt + (kb0 ^ (unsigned)(d0 * 32))), b1 = *(LAS const bf16x8*)(Kt + (kb0 ^ (unsigned)(d0 * 32)) + 4096);
        if (d0 == 0) { p0 = __builtin_amdgcn_mfma_f32_32x32x16_bf16(b0, qr[0], cinit, 0, 0, 0); p1 = __builtin_amdgcn_mfma_f32_32x32x16_bf16(b1, qr[0], cinit, 0, 0, 0); }
        else { p0 = __builtin_amdgcn_mfma_f32_32x32x16_bf16(b0, qr[d0], p0, 0, 0, 0); p1 = __builtin_amdgcn_mfma_f32_32x32x16_bf16(b1, qr[d0], p1, 0, 0, 0); }
    }
}
template <bool BIAS, bool MASK>
__device__ __forceinline__ void softmax_tile(f32x16& p0, f32x16& p1, LAS const float* lutp, int jt, int qrel, int hi, float& l, v4u* pa) {
#pragma unroll
    for (int r = 0; r < 16; ++r) { const int ko = 64 * jt + (r & 3) + 8 * (r >> 2);
        if (BIAS) { p0[r] += lutp[ko]; p1[r] += lutp[ko + 32]; }
        if (MASK) { const int kv = ko + 4 * hi; if (kv > qrel) p0[r] = -INFINITY; if (kv + 32 > qrel) p1[r] = -INFINITY; }
        p0[r] = __builtin_amdgcn_exp2f(p0[r]); p1[r] = __builtin_amdgcn_exp2f(p1[r]); }
    float s = 0.f;
#pragma unroll
    for (int r = 0; r < 16; ++r) s += p0[r] + p1[r];
    l += s;
    pa[0] = (v4u){cvtpk(p0[0], p0[1]), cvtpk(p0[2], p0[3]), cvtpk(p0[4], p0[5]), cvtpk(p0[6], p0[7])};
    pa[1] = (v4u){cvtpk(p0[8], p0[9]), cvtpk(p0[10], p0[11]), cvtpk(p0[12], p0[13]), cvtpk(p0[14], p0[15])};
    pa[2] = (v4u){cvtpk(p1[0], p1[1]), cvtpk(p1[2], p1[3]), cvtpk(p1[4], p1[5]), cvtpk(p1[6], p1[7])};
    pa[3] = (v4u){cvtpk(p1[8], p1[9]), cvtpk(p1[10], p1[11]), cvtpk(p1[12], p1[13]), cvtpk(p1[14], p1[15])};
}
__device__ __forceinline__ void pv_tile(f32x16* o, lds_cptr Vt, unsigned vo0, const v4u* pa) {
#pragma unroll
    for (int d0 = 0; d0 < 2; ++d0)
#pragma unroll
        for (int ks = 0; ks < 4; ++ks) { const s16x4 lo = vtr(Vt + (vo0 ^ (unsigned)(d0 * 64)) + ks * 2048), hi = vtr(Vt + (vo0 ^ (unsigned)(d0 * 64)) + ks * 2048 + 1024);
            const bf16x8 vf = (bf16x8){lo[0], lo[1], lo[2], lo[3], hi[0], hi[1], hi[2], hi[3]};
            o[d0] = __builtin_amdgcn_mfma_f32_32x32x16_bf16(vf, __builtin_bit_cast(bf16x8, pa[ks]), o[d0], 0, 0, 0); }
}
__device__ __forceinline__ void qk_half(f32x16& p, lds_cptr Kt, int s, const bf16x8* qr, const f32x16& cinit, int r32, int hi) {
    lds_cptr kb = Kt + hi * 1024 + r32 * 16 + s * 512;
#pragma unroll
    for (int d0 = 0; d0 < 4; ++d0) { const bf16x8 b0 = *(LAS const bf16x8*)(kb + d0 * 2048);
        if (d0 == 0) p = __builtin_amdgcn_mfma_f32_32x32x16_bf16(b0, qr[0], cinit, 0, 0, 0); else p = __builtin_amdgcn_mfma_f32_32x32x16_bf16(b0, qr[d0], p, 0, 0, 0); }
}
template <bool BIAS>
__device__ __forceinline__ void softmax_half(f32x16& p, LAS const float* lutp, int jt, int s, float& l, v4u& pa0, v4u& pa1) {
#pragma unroll
    for (int r = 0; r < 16; ++r) { const int ko = 64 * jt + 32 * s + (r & 3) + 8 * (r >> 2);
        if (BIAS) p[r] += lutp[ko];
        p[r] = __builtin_amdgcn_exp2f(p[r]); }
    float sm = 0.f;
#pragma unroll
    for (int r = 0; r < 16; ++r) sm += p[r];
    l += sm;
    pa0 = (v4u){cvtpk(p[0], p[1]), cvtpk(p[2], p[3]), cvtpk(p[4], p[5]), cvtpk(p[6], p[7])};
    pa1 = (v4u){cvtpk(p[8], p[9]), cvtpk(p[10], p[11]), cvtpk(p[12], p[13]), cvtpk(p[14], p[15])};
}
__device__ __forceinline__ void pv_half(f32x16* o, lds_cptr vp, int s, const v4u& pa0, const v4u& pa1) {
#pragma unroll
    for (int d0 = 0; d0 < 2; ++d0)
#pragma unroll
        for (int kk = 0; kk < 2; ++kk) { const int ks = 2 * s + kk; const s16x4 lo = vtr(vp + d0 * 4096 + ks * 1024), hi = vtr(vp + d0 * 4096 + ks * 1024 + 512);
            const bf16x8 vf = (bf16x8){lo[0], lo[1], lo[2], lo[3], hi[0], hi[1], hi[2], hi[3]};
            o[d0] = __builtin_amdgcn_mfma_f32_32x32x16_bf16(vf, __builtin_bit_cast(bf16x8, kk ? pa1 : pa0), o[d0], 0, 0, 0); }
}
struct SlotD { int kind, t, idx; };
__device__ __forceinline__ constexpr SlotD slot_desc(int g) {
    if (g < 4) return SlotD{0, 0, g};
    if (g < 8) return SlotD{0, 1, g - 4};
    if (g < 56) { const int tt = (g - 8) / 8 + 1, i = (g - 8) % 8; return (i & 1) ? SlotD{1, tt - 1, i >> 1} : SlotD{0, tt + 1, i >> 1}; }
    if (g < 60) return SlotD{1, 6, g - 56};
    return SlotD{1, 7, g - 60};
}
template <bool BIAS>
struct TileMath {
    f32x16 P[2]; unsigned pk[2][8]; v4u fr[3]; f32x2_t lv[4]; float e0, e1, l0, l1;
    f32x16* o; lds_cptr Kl, Vl; unsigned kb0, vo0; const bf16x8* qr; const f32x16* cinit; LAS const float* lutp;
    template <int G> __device__ __forceinline__ v4u load_frag() { constexpr SlotD d = slot_desc(G);
        if (d.kind == 0) return *(LAS const v4u*)(Kl + (kb0 ^ (unsigned)(d.idx * 32)) + (d.t >> 1) * 8192 + (d.t & 1) * 4096);
        constexpr int d0 = d.idx >> 1, ks = 2 * (d.t & 1) + (d.idx & 1); lds_cptr vp = Vl + (vo0 ^ (unsigned)(d0 * 64)) + (d.t >> 1) * 8192 + ks * 2048;
        const s16x4 a = vtr(vp), c = vtr(vp + 1024); return __builtin_bit_cast(v4u, (bf16x8){a[0], a[1], a[2], a[3], c[0], c[1], c[2], c[3]}); }
    template <int Q> __device__ __forceinline__ f32x2_t lut_pair() { constexpr int t = Q >> 3, r0 = 2 * (Q & 7), ko = 64 * (t >> 1) + 32 * (t & 1) + (r0 & 3) + 8 * (r0 >> 2); return (f32x2_t){lutp[ko], lutp[ko + 1]}; }
    template <int Q> __device__ __forceinline__ void chunk() { constexpr int t = Q >> 3, c = Q & 7;
        if constexpr (Q > 0) { l0 += e0; l1 += e1; pk[((Q - 1) >> 3) & 1][(Q - 1) & 7] = cvtpk(e0, e1); }
        float x0 = P[t & 1][2 * c], x1 = P[t & 1][2 * c + 1];
        if constexpr (BIAS) { x0 += lv[Q & 3][0]; x1 += lv[Q & 3][1]; if constexpr (Q + 3 < 64) lv[(Q + 3) & 3] = lut_pair<Q + 3>(); }
        e0 = __builtin_amdgcn_exp2f(x0); e1 = __builtin_amdgcn_exp2f(x1); }
    template <int G> __device__ __forceinline__ void slot() {
        if constexpr (G + 2 < 64) fr[(G + 2) % 3] = load_frag<G + 2>();
        { constexpr SlotD d = slot_desc(G); const bf16x8 a = __builtin_bit_cast(bf16x8, fr[G % 3]);
          if constexpr (d.kind == 0) { if constexpr (d.idx == 0) P[d.t & 1] = __builtin_amdgcn_mfma_f32_32x32x16_bf16(a, qr[0], *cinit, 0, 0, 0); else P[d.t & 1] = __builtin_amdgcn_mfma_f32_32x32x16_bf16(a, qr[d.idx], P[d.t & 1], 0, 0, 0); }
          else { constexpr int d0 = d.idx >> 1, kk = d.idx & 1;
              o[d0] = __builtin_amdgcn_mfma_f32_32x32x16_bf16(a, __builtin_bit_cast(bf16x8, (v4u){pk[d.t & 1][4 * kk], pk[d.t & 1][4 * kk + 1], pk[d.t & 1][4 * kk + 2], pk[d.t & 1][4 * kk + 3]}), o[d0], 0, 0, 0); } }
        if constexpr (G >= 4 && G < 8) { chunk<2 * (G - 4)>(); chunk<2 * (G - 4) + 1>(); }
        else if constexpr (G >= 8 && G < 56) chunk<G>();
        else if constexpr (G >= 56 && G < 60) { chunk<56 + 2 * (G - 56)>(); chunk<56 + 2 * (G - 56) + 1>(); if constexpr (G == 59) { l0 += e0; l1 += e1; pk[1][7] = cvtpk(e0, e1); } }
        __builtin_amdgcn_sched_barrier(0);
    }
    template <int... G> __device__ __forceinline__ void run(std::integer_sequence<int, G...>) { (slot<G>(), ...); }
};
template <bool BIAS>
__device__ __forceinline__ void tile_math(f32x16* o, float& l, lds_cptr Kl, lds_cptr Vl, unsigned vo0, const bf16x8* qr, const f32x16& cinit, LAS const float* lutp, int r32, int hi) {
    TileMath<BIAS> T; T.o = o; T.Kl = Kl; T.kb0 = (unsigned)(r32 * 128 + ((hi ^ ((r32 >> 1) & 7)) * 16)); T.Vl = Vl; T.vo0 = vo0; T.qr = qr; T.cinit = &cinit; T.lutp = lutp; T.e0 = T.e1 = T.l0 = T.l1 = 0.f;
    if constexpr (BIAS) { T.lv[0] = T.template lut_pair<0>(); T.lv[1] = T.template lut_pair<1>(); T.lv[2] = T.template lut_pair<2>(); }
    T.fr[0] = T.template load_frag<0>(); T.fr[1] = T.template load_frag<1>();
    __builtin_amdgcn_sched_barrier(0);
    T.run(std::make_integer_sequence<int, 64>{});
    l += T.l0 + T.l1;
}
__device__ __forceinline__ void load_q_raw(bf16x8* qr, const GAS bf16* Qb, size_t qrow, int b, int h, int hi) {
#pragma unroll
    for (int d0 = 0; d0 < 4; ++d0) { const v4u v = *(const GAS v4u*)(Qb + hm_off(qrow, b, h) + d0 * 16 + hi * 8); qr[d0] = __builtin_bit_cast(bf16x8, v); }
}
__device__ __forceinline__ float q_norm2(const bf16x8* qr) {
    float q2 = 0.f;
#pragma unroll
    for (int d0 = 0; d0 < 4; ++d0) { const v4u v = __builtin_bit_cast(v4u, qr[d0]);
#pragma unroll
        for (int j = 0; j < 4; ++j) { const float a = __builtin_bit_cast(float, v[j] << 16), c = __builtin_bit_cast(float, v[j] & 0xffff0000u); q2 += a * a + c * c; } }
    return swap_add(q2);
}

__device__ __forceinline__ float ref_exponent(float q2, float kmax2, float bmax) { return __builtin_sqrtf(q2 * kmax2) * 1.002f + bmax + 0.01f; }
__device__ __forceinline__ void head_bounds(const GAS float* KBM, const GAS float* rel_bias, int bh, int h, int lane, float& kmax2, float& bmax) {
    float k = KBM[bh * 32 + (lane & 31)], bb = rel_bias[(lane & 31) * NH + h] * LOG2E;
#pragma unroll
    for (int o = 1; o < 32; o <<= 1) { k = fmaxf(k, shx(k, o, lane)); bb = fmaxf(bb, shx(bb, o, lane)); }
    kmax2 = k; bmax = bb;
}
__device__ __forceinline__ void store_row(GAS bf16* rowp, const f32x16* o, float scale, int hi, bool act) {
    unsigned w0[8], w1[8];
#pragma unroll
    for (int k = 0; k < 4; ++k) { w0[2 * k] = cvtpk(o[0][4 * k] * scale, o[0][4 * k + 1] * scale); w0[2 * k + 1] = cvtpk(o[0][4 * k + 2] * scale, o[0][4 * k + 3] * scale);
        w1[2 * k] = cvtpk(o[1][4 * k] * scale, o[1][4 * k + 1] * scale); w1[2 * k + 1] = cvtpk(o[1][4 * k + 2] * scale, o[1][4 * k + 3] * scale); }
#pragma unroll
    for (int i = 0; i < 8; ++i) { auto r = __builtin_amdgcn_permlane32_swap(w0[i], w1[i], false, false); w0[i] = r[0]; w1[i] = r[1]; }
    if (act) {
#pragma unroll
        for (int k = 0; k < 4; ++k) *(GAS v4u*)(rowp + 32 * hi + 8 * k) = (v4u){w0[2 * k], w0[2 * k + 1], w1[2 * k], w1[2 * k + 1]}; }
}
__device__ __forceinline__ void add_row(f32x16* o, const GAS bf16* rowp, int hi) {
    v4u v[4];
#pragma unroll
    for (int k = 0; k < 4; ++k) v[k] = *(const GAS v4u*)(rowp + 32 * hi + 8 * k);
#pragma unroll
    for (int k = 0; k < 4; ++k) { auto r0 = __builtin_amdgcn_permlane32_swap(v[k][0], v[k][2], false, false); auto r1 = __builtin_amdgcn_permlane32_swap(v[k][1], v[k][3], false, false);
        o[0][4 * k] += __builtin_bit_cast(float, r0[0] << 16); o[0][4 * k + 1] += __builtin_bit_cast(float, r0[0] & 0xffff0000u);
        o[0][4 * k + 2] += __builtin_bit_cast(float, r1[0] << 16); o[0][4 * k + 3] += __builtin_bit_cast(float, r1[0] & 0xffff0000u);
        o[1][4 * k] += __builtin_bit_cast(float, r0[1] << 16); o[1][4 * k + 1] += __builtin_bit_cast(float, r0[1] & 0xffff0000u);
        o[1][4 * k + 2] += __builtin_bit_cast(float, r1[1] << 16); o[1][4 * k + 3] += __builtin_bit_cast(float, r1[1] & 0xffff0000u); }
}
__device__ __forceinline__ GAS bf16* po_row(GAS unsigned char* ws, GAS float* outbuf, int b, int h, int t, int slot) {
    return (b < 2 ? (GAS bf16*)outbuf : (GAS bf16*)(ws + WS_POB)) + ((((size_t)((b & 1) * 16 + h) * SEQ + t) * 3 + slot) * 64);
}

__device__ __forceinline__ void glds16(const GAS void* gsrc, unsigned lds_dst) {
    unsigned keep;
    asm volatile("s_mov_b32 %0, m0\n\ts_mov_b32 m0, %2\n\ts_nop 0\n\tglobal_load_lds_dwordx4 %1, off\n\ts_mov_b32 m0, %0" : "=&s"(keep) : "v"(gsrc), "s"(lds_dst) : "memory");
}
struct Top3 { float g1, g2, g3; int i1, i2, i3; };
__device__ __forceinline__ void top3_insert(Top3& T, float g, int n) {
    const bool c1 = g > T.g1, c2 = g > T.g2, c3 = g > T.g3;
    T.g3 = c2 ? T.g2 : (c3 ? g : T.g3); T.i3 = c2 ? T.i2 : (c3 ? n : T.i3);
    T.g2 = c1 ? T.g1 : (c2 ? g : T.g2); T.i2 = c1 ? T.i1 : (c2 ? n : T.i2);
    T.g1 = c1 ? g : T.g1;               T.i1 = c1 ? n : T.i1;
}
__device__ __forceinline__ void top3_insert_tie(Top3& T, float g, int n) {
    const bool ok = n >= 0;
    const bool c1 = ok && (g > T.g1 || (g == T.g1 && n < T.i1) || T.i1 < 0), c2 = ok && (g > T.g2 || (g == T.g2 && n < T.i2) || T.i2 < 0), c3 = ok && (g > T.g3 || (g == T.g3 && n < T.i3) || T.i3 < 0);
    T.g3 = c2 ? T.g2 : (c3 ? g : T.g3); T.i3 = c2 ? T.i2 : (c3 ? n : T.i3);
    T.g2 = c1 ? T.g1 : (c2 ? g : T.g2); T.i2 = c1 ? T.i1 : (c2 ? n : T.i2);
    T.g1 = c1 ? g : T.g1;               T.i1 = c1 ? n : T.i1;
}
__device__ __forceinline__ void route(Frame& F) {
    GAS unsigned char* ws = F.ws;
    const GAS bf16* Qb = (const GAS bf16*)(ws + WS_Q); const GAS bf16* Kb = (const GAS bf16*)(ws + WS_K);
    const GAS float* KMP = (const GAS float*)(ws + WS_KMP);
    GAS unsigned short* SEG = (GAS unsigned short*)(ws + WS_SEG); GAS unsigned* CNT = (GAS unsigned*)(ws + WS_CNT); GAS unsigned* TOT = (GAS unsigned*)(ws + WS_CTL) + CW_TOT;
    GAS float* KBM = (GAS float*)(ws + WS_KBM);
    int tid = F.wave * 64 + lane_id(); asm volatile("" : "+v"(tid));
    const int hf = tid >> 8, t = tid & 255, lane = tid & 63, w4 = __builtin_amdgcn_readfirstlane((tid >> 6) & 3), r32 = lane & 31, hi = lane >> 5;
    constexpr int HS = 20480;
    LAS unsigned char* hb = F.lds + __builtin_amdgcn_readfirstlane(hf) * HS;
    LAS unsigned* cntw = (LAS unsigned*)(hb + 16384);
    LAS float* kbw = (LAS float*)(hb + 16384 + 512);
    const int ua = (F.vcu * 2 + hf) >> 6, bh = (F.vcu * 2 + hf) & 63, b = bh >> 4, h = bh & 15;
    auto own_of = [&](int it) -> int { return it == 0 ? ua : it == 1 ? 31 - ua : it == 2 ? 8 + ua : 23 - ua; };
    v4u kreg[8]; float kmreg[8]; bf16x8 qf[2][4];
    auto prefetch = [&](int own) {
        const size_t row0 = (size_t)b * SEQ + own * BLK + 64 * w4;
#pragma unroll
        for (int tq = 0; tq < 2; ++tq)
#pragma unroll
            for (int d0 = 0; d0 < 4; ++d0) qf[tq][d0] = __builtin_bit_cast(bf16x8, *(const GAS v4u*)(Qb + hm_off(row0 + 32 * tq + r32, b, h) + d0 * 16 + hi * 8));
#pragma unroll
        for (int i = 0; i < 8; ++i) kreg[i] = *(const GAS v4u*)(Kb + hm_off(row0 + 8 * i, b, h) + lane * 8);
#pragma unroll
        for (int j = 0; j < 8; ++j) { const int i = t + 256 * j, n = i >> 6, d = i & 63; const size_t o = ((size_t)(b * 32 + n) * 2) * 1024 + h * 64 + d; kmreg[j] = (KMP[o] + KMP[o + 1024]) * (1.0f / 256.0f); }
    };
    prefetch(own_of(0));
    const unsigned fro = (unsigned)(r32 * 128), swz = (unsigned)((r32 >> 1) & 7);
#pragma unroll 1
    for (int it = 0; it < 4; ++it) {
        const int own = own_of(it);
        LAS unsigned char* kmh = hb + (it & 1) * 8192; LAS unsigned char* kml = kmh + 4096;
#pragma unroll
        for (int j = 0; j < 8; ++j) { const int i = t + 256 * j, n = i >> 6, d = i & 63; const float x = kmreg[j];
            const unsigned xb = __builtin_bit_cast(unsigned, x), hb16 = (xb + 0x7fffu + ((xb >> 16) & 1u)) >> 16; const float xh = __builtin_bit_cast(float, hb16 << 16), xl = x - xh;
            const unsigned lb = __builtin_bit_cast(unsigned, xl), lb16 = (lb + 0x7fffu + ((lb >> 16) & 1u)) >> 16;
            const int pos = n * 128 + (((d >> 3) ^ ((n >> 1) & 7)) * 16) + (d & 7) * 2;
            *(LAS unsigned short*)(kmh + pos) = (unsigned short)hb16; *(LAS unsigned short*)(kml + pos) = (unsigned short)lb16; }
        { float k2 = 0.f;
#pragma unroll
          for (int i = 0; i < 8; ++i) { float r2 = 0.f;
#pragma unroll
              for (int j = 0; j < 4; ++j) { const float a = __builtin_bit_cast(float, kreg[i][j] << 16), c = __builtin_bit_cast(float, kreg[i][j] & 0xffff0000u); r2 += a * a + c * c; }
              r2 += shx(r2, 1, lane); r2 += shx(r2, 2, lane); r2 += shx(r2, 4, lane); k2 = fmaxf(k2, r2); }
          k2 = fmaxf(k2, shx(k2, 8, lane)); k2 = fmaxf(k2, shx(k2, 16, lane)); k2 = fmaxf(k2, shx(k2, 32, lane));
          if (lane == 0) kbw[(it & 1) * 4 + w4] = k2; }
        bf16x8 qc[2][4];
#pragma unroll
        for (int tq = 0; tq < 2; ++tq)
#pragma unroll
            for (int d0 = 0; d0 < 4; ++d0) qc[tq][d0] = qf[tq][d0];
        __syncthreads();
        if (it < 3) prefetch(own_of(it + 1));
        f32x16 acc[2]; acc[0] = f32x16{}; acc[1] = f32x16{};
#pragma unroll
        for (int d0 = 0; d0 < 4; ++d0) { const unsigned co = ((unsigned)(2 * d0 + hi) ^ swz) * 16;
            const bf16x8 ah = *(const LAS bf16x8*)(kmh + fro + co), al = *(const LAS bf16x8*)(kml + fro + co);
#pragma unroll
            for (int tq = 0; tq < 2; ++tq) { acc[tq] = __builtin_amdgcn_mfma_f32_32x32x16_bf16(ah, qc[tq][d0], acc[tq], 0, 0, 0); acc[tq] = __builtin_amdgcn_mfma_f32_32x32x16_bf16(al, qc[tq][d0], acc[tq], 0, 0, 0); } }
        Top3 R;
#pragma unroll
        for (int tq = 0; tq < 2; ++tq) { Top3 T{-INFINITY, -INFINITY, -INFINITY, -1, -1, -1};
#pragma unroll
            for (int r = 0; r < 16; ++r) { const int n = crow(r, hi); const float g = acc[tq][r]; top3_insert(T, n < own ? g : -INFINITY, n < own ? n : -1); }
            Top3 P; { auto x1 = __builtin_amdgcn_permlane32_swap(__float_as_uint(T.g1), __float_as_uint(T.g1), false, false); P.g1 = __uint_as_float(hi ? x1[0] : x1[1]);
                      auto x2 = __builtin_amdgcn_permlane32_swap(__float_as_uint(T.g2), __float_as_uint(T.g2), false, false); P.g2 = __uint_as_float(hi ? x2[0] : x2[1]);
                      auto x3 = __builtin_amdgcn_permlane32_swap(__float_as_uint(T.g3), __float_as_uint(T.g3), false, false); P.g3 = __uint_as_float(hi ? x3[0] : x3[1]);
                      auto y1 = __builtin_amdgcn_permlane32_swap((unsigned)T.i1, (unsigned)T.i1, false, false); P.i1 = (int)(hi ? y1[0] : y1[1]);
                      auto y2 = __builtin_amdgcn_permlane32_swap((unsigned)T.i2, (unsigned)T.i2, false, false); P.i2 = (int)(hi ? y2[0] : y2[1]);
                      auto y3 = __builtin_amdgcn_permlane32_swap((unsigned)T.i3, (unsigned)T.i3, false, false); P.i3 = (int)(hi ? y3[0] : y3[1]); }
            top3_insert_tie(T, P.g1, P.i1); top3_insert_tie(T, P.g2, P.i2); top3_insert_tie(T, P.g3, P.i3);
            if (tq == hi) R = T; }
        const int i1 = R.i1, i2 = R.i2, i3 = R.i3;
        unsigned rk1 = 0, rk2 = 0, rk3 = 0;
        for (int n = 0; n < own; ++n) { const bool h1 = i1 == n, h2 = i2 == n, h3 = i3 == n; const unsigned long long mm = __ballot(h1 || h2 || h3);
            const unsigned rank = __builtin_amdgcn_mbcnt_hi((unsigned)(mm >> 32), __builtin_amdgcn_mbcnt_lo((unsigned)mm, 0u));
            rk1 = h1 ? rank : rk1; rk2 = h2 ? rank : rk2; rk3 = h3 ? rank : rk3;
            if (lane == 0) cntw[w4 * 32 + n] = (unsigned)__popcll(mm); }
        __syncthreads();
#pragma unroll
        for (int sl = 0; sl < 3; ++sl) { const int n = sl == 0 ? i1 : sl == 1 ? i2 : i3; const unsigned rk = sl == 0 ? rk1 : sl == 1 ? rk2 : rk3;
            const int nn = n & 31; unsigned base = 0;
#pragma unroll
            for (int w = 0; w < 3; ++w) { const unsigned v = cntw[w * 32 + nn]; base += (w < w4) ? v : 0u; }
            if (n >= 0) SEG[(((size_t)bh * 32 + own) * 32 + n) * 256 + base + rk] = (unsigned short)(t | (sl << 8)); }
        if (t < own) { const unsigned c = cntw[t] + cntw[32 + t] + cntw[64 + t] + cntw[96 + t]; CNT[((size_t)bh * 32 + own) * 32 + t] = c; (void)__hip_atomic_fetch_add(TOT + bh * 31 + t, c, RLX_AGENT); }
        if (t == 0) KBM[bh * 32 + own] = fmaxf(fmaxf(kbw[(it & 1) * 4], kbw[(it & 1) * 4 + 1]), fmaxf(kbw[(it & 1) * 4 + 2], kbw[(it & 1) * 4 + 3]));
    }
    asm volatile("s_waitcnt vmcnt(0)" ::: "memory");
    __syncthreads();
}

struct GTile { unsigned info; bf16x8 qr[4]; };
struct GRun { int e, c0, c1; };
__device__ __forceinline__ void dma_kv(LAS unsigned char* kv, const GAS bf16* Kb, const GAS bf16* Vb, int b, int h, int n, int w, int lane) {
#pragma unroll
    for (int t = 0; t < 4; ++t) {
        const size_t kr = (size_t)b * SEQ + n * BLK + 64 * t + 8 * w + (lane >> 3), vr = (size_t)b * SEQ + n * BLK + 64 * t + 16 * (w & 3) + (lane >> 2);
        __builtin_amdgcn_global_load_lds((const GAS unsigned*)(Kb + hm_off(kr, b, h) + (((lane & 7) ^ ((4 * w + (lane >> 4)) & 7)) * 8)), (LAS unsigned*)(kv + L_K + t * 8192 + w * 1024), 16, 0, 0);
        __builtin_amdgcn_global_load_lds((const GAS unsigned*)(Vb + hm_off(kr, b, h) + ((((lane >> 2) & 1) ^ ((lane >> 4) & 1)) * 32) + (lane & 3) * 8), (LAS unsigned*)(kv + L_V + t * 8192 + w * 1024), 16, 0, 0);
    }
}
__device__ __forceinline__ void gather(Frame& F) {
    GAS unsigned char* ws = F.ws;
    const GAS bf16* Qb = (const GAS bf16*)(ws + WS_Q); const GAS bf16* Kb = (const GAS bf16*)(ws + WS_K); const GAS bf16* Vb = (const GAS bf16*)(ws + WS_V);
    const GAS unsigned short* SEG = (const GAS unsigned short*)(ws + WS_SEG); const GAS unsigned* CNT = (const GAS unsigned*)(ws + WS_CNT); const GAS unsigned* TOT = (const GAS unsigned*)(ws + WS_CTL) + CW_TOT;
    const GAS float* KBM = (const GAS float*)(ws + WS_KBM); GAS float* PL = (GAS float*)(ws + WS_PL);
    int tid = F.wave * 64 + lane_id(); asm volatile("" : "+v"(tid));
    const int lane = tid & 63, w = __builtin_amdgcn_readfirstlane(tid >> 6), r32 = lane & 31, hi = lane >> 5;
    LAS unsigned* pre = (LAS unsigned*)(F.lds + L_PRE);
    __syncthreads();
    if (w == 0) { unsigned loc = 0;
        for (int i = 0; i < 31; ++i) { const unsigned nc = (TOT[31 * lane + i] + 255u) >> 8; loc += nc + (nc ? 1u : 0u); }
        unsigned inc = loc;
#pragma unroll
        for (int o = 1; o < 64; o <<= 1) { const unsigned v = shup(inc, o, lane); if (lane >= o) inc += v; }
        unsigned run = inc - loc;
        for (int i = 0; i < 31; ++i) { pre[31 * lane + i] = run; const unsigned nc = (TOT[31 * lane + i] + 255u) >> 8; run += nc + (nc ? 1u : 0u); }
        if (lane == 63) pre[1984] = run; }
    __syncthreads();
    const int U = (int)pre[1984];
    int p = (int)(((long)F.vcu * U) / F.G); const int phi = (int)(((long)(F.vcu + 1) * U) / F.G);
    int e = 0; { int lo = 0, hi2 = 1984; while (hi2 - lo > 1) { const int mid = (lo + hi2) >> 1; if ((int)pre[mid] <= p) lo = mid; else hi2 = mid; } e = lo; }
    auto next_run = [&](GRun& R) -> bool {
        while (p < phi) {
            while (p >= (int)pre[e + 1]) ++e;
            const int k = p - (int)pre[e], nch = (int)pre[e + 1] - (int)pre[e] - 1;
            const int c0 = k > 0 ? k - 1 : 0; int c1 = phi - (int)pre[e] - 1; c1 = c1 < nch ? c1 : nch;
            p = (int)pre[e] + 1 + c1;
            if (c1 > c0) { R.e = e; R.c0 = c0; R.c1 = c1; return true; }
        }
        return false;
    };
    auto scan_cnt = [&](unsigned v) -> unsigned { unsigned inc = v;
#pragma unroll
        for (int o = 1; o < 32; o <<= 1) { const unsigned t2 = shup(inc, o, lane); if ((lane & 31) >= o) inc += t2; }
        return inc; };
    int cur_h = -1, cur_bh = -1, rb = 0; float kmax2 = 0.f, bmax = 0.f, rb31 = 0.f;
    GRun cur, nxt; bool hc = next_run(cur);
    unsigned cntN = 0, totN = 0, cumv = 0, tot = 0;
    if (hc) { const int bh = cur.e / 31, n = cur.e - bh * 31; dma_kv(F.lds, Kb, Vb, bh >> 4, bh & 15, n, w, lane);
        cntN = ((lane & 31) > n) ? CNT[((size_t)bh * 32 + (lane & 31)) * 32 + n] : 0u; totN = TOT[cur.e]; }
    GTile tcur, tnxt; unsigned ownB = 0, entB = 0xffffffffu; bool mine = false;
    auto fetch_ent = [&](int c, bool valid, int n, const GAS unsigned short* segb, unsigned cv, unsigned tt, unsigned& own_o) -> unsigned {
        const unsigned g0 = 256u * c + 32u * w, g = g0 + r32;
        const bool tile_ok = valid && g0 < tt;
        unsigned own = (unsigned)(n + 1), base = 0u;
        if (tile_ok) {
            int lo = n + 1, hi2 = 32;
            while (hi2 - lo > 1) { const int mid = (lo + hi2) >> 1; if (__builtin_amdgcn_readlane(cv, mid - 1) <= g0) lo = mid; else hi2 = mid; }
            own = (unsigned)lo; base = (lo == n + 1) ? 0u : __builtin_amdgcn_readlane(cv, lo - 1);
            for (int o = lo + 1; o < 32; ++o) { const unsigned s2 = __builtin_amdgcn_readlane(cv, o - 1); if (s2 > g0 + 31u) break; if (s2 <= g) { own = (unsigned)o; base = s2; } }
        }
        const bool lane_ok = tile_ok && g < tt;
        const unsigned idx = lane_ok ? (g - base) : 0u;
        const unsigned v = (unsigned)segb[(size_t)own * 32 * 256 + idx];
        own_o = own;
        return lane_ok ? v : 0xffffffffu;
    };
    auto make_tile = [&](unsigned ent, unsigned own, int b, int h, int n, GTile& T) {
        const bool act = ent != 0xffffffffu;
        const int tq = act ? (int)(own * BLK + (ent & 255u)) : SEQ - 1;
        T.info = (unsigned)tq | (act ? (((ent >> 8) & 3u) << 16) | (1u << 18) | ((own - n <= 4) ? (1u << 19) : 0u) : 0u);
        load_q_raw(T.qr, Qb, (size_t)b * SEQ + tq, b, h, hi);
    };
    auto start_run = [&](const GRun& R) {
        const int bh = R.e / 31, n = R.e - bh * 31; const GAS unsigned short* segb = SEG + ((size_t)bh * 32 * 32 + n) * 256;
        cumv = scan_cnt(cntN); tot = totN;
        mine = (unsigned)(256 * R.c0 + 32 * w) < tot;
        entB = 0xffffffffu; ownB = 0;
        if (mine) { unsigned ownA; const unsigned entA = fetch_ent(R.c0, true, n, segb, cumv, tot, ownA); make_tile(entA, ownA, bh >> 4, bh & 15, n, tcur);
            entB = fetch_ent(R.c0 + 1, R.c0 + 1 < R.c1, n, segb, cumv, tot, ownB); }
    };
    if (hc) start_run(cur);
    while (hc) {
        const bool hn = next_run(nxt);
        const int c0 = cur.c0, c1 = cur.c1, bh = cur.e / 31, n = cur.e - bh * 31, b = bh >> 4, h = bh & 15;
        const GAS unsigned short* segb = SEG + ((size_t)bh * 32 * 32 + n) * 256;
        LAS unsigned char* kv = F.lds + rb * 65536;
        __builtin_amdgcn_s_waitcnt(0x0F70);
        __syncthreads();
        if (hn) { const int bh2 = nxt.e / 31, n2 = nxt.e - bh2 * 31;
            cntN = ((lane & 31) > n2) ? CNT[((size_t)bh2 * 32 + (lane & 31)) * 32 + n2] : 0u; totN = TOT[nxt.e]; }
        if (bh != cur_bh) { head_bounds(KBM, F.rel_bias, bh, h, lane, kmax2, bmax); rb31 = F.rel_bias[31 * NH + h] * LOG2E; cur_bh = bh;
            if (h != cur_h) { build_lut(F.lds, F.rel_bias, h, tid); cur_h = h; __syncthreads(); } }
        const lds_cptr Kl = (lds_cptr)(kv + L_K), Vl = (lds_cptr)(kv + L_V); const int vrl = 4 * hi + ((lane & 15) >> 2); const unsigned vo0 = (unsigned)(vrl * 128 + ((vrl >> 1) & 1) * 64 + ((lane >> 4) & 1) * 32 + (lane & 3) * 8);
        if (mine) for (int c = c0; c < c1; ++c) {
            if ((unsigned)(256 * c + 32 * w) >= tot) break;
            make_tile(entB, ownB, b, h, n, tnxt);
            entB = fetch_ent(c + 2, c + 2 < c1, n, segb, cumv, tot, ownB);
            const unsigned info = tcur.info; const int tq = (int)(info & 0xffffu); const bool near = (info >> 19) & 1u;
            const float mref = ref_exponent(q_norm2(tcur.qr), kmax2, bmax);
            const bool anynear = __any(near);
            const int tqrel = near ? (tq - n * BLK) : 1755;
            LAS const float* lutp = (LAS const float*)(F.lds + L_LUT) + (2047 - tqrel + 4 * hi);
            f32x16 cinit; { const float cc = anynear ? -mref : (rb31 - mref);
#pragma unroll
                for (int r = 0; r < 16; ++r) cinit[r] = cc; }
            f32x16 o[2]; o[0] = f32x16{}; o[1] = f32x16{}; float l = 0.f;
            if (anynear) tile_math<true>(o, l, Kl, Vl, vo0, tcur.qr, cinit, lutp, r32, hi); else tile_math<false>(o, l, Kl, Vl, vo0, tcur.qr, cinit, lutp, r32, hi);
            l = swap_add(l);
            { const bool act = (info >> 18) & 1u; const int slot = (int)((info >> 16) & 3u);
              GAS bf16* dump = (GAS bf16*)(ws + WS_DUMP) + (size_t)F.vcu * 4096 + lane * 64;
              store_row(act ? po_row(ws, F.out, b, h, tq, slot) : dump - 32 * hi, o, 1.0f, hi, true);
              GAS float* plp = act ? PL + (((size_t)bh * SEQ + tq) * 3) + slot : (GAS float*)dump;
              *plp = l; }
            tcur = tnxt;
        }
        if (hn) { start_run(nxt);
            const int bh2 = nxt.e / 31, n2 = nxt.e - bh2 * 31; dma_kv(F.lds + (rb ^ 1) * 65536, Kb, Vb, bh2 >> 4, bh2 & 15, n2, w, lane); }
        cur = nxt; hc = hn; rb ^= 1;
    }
    asm volatile("s_waitcnt vmcnt(0)" ::: "memory");
    __syncthreads();
}

__device__ __forceinline__ void own_block(Frame& F) {
    GAS unsigned char* ws = F.ws;
    const GAS bf16* Qb = (const GAS bf16*)(ws + WS_Q); const GAS bf16* Kb = (const GAS bf16*)(ws + WS_K); const GAS bf16* Vb = (const GAS bf16*)(ws + WS_V); GAS bf16* Ob = (GAS bf16*)(ws + WS_O);
    const GAS float* KBM = (const GAS float*)(ws + WS_KBM); const GAS float* PL = (const GAS float*)(ws + WS_PL);
    int tid = F.wave * 64 + lane_id(); asm volatile("" : "+v"(tid));
    const int lane = tid & 63, w = __builtin_amdgcn_readfirstlane(tid >> 6), r32 = lane & 31, hi = lane >> 5;
    const int bh = F.vcu & 63, b = bh >> 4, h = bh & 15, own0 = F.vcu >> 6, nun = (NBLK - own0 + 3) / 4;
    __syncthreads();
    build_lut(F.lds, F.rel_bias, h, tid);
    float kmax2, bmax; head_bounds(KBM, F.rel_bias, bh, h, lane, kmax2, bmax);
    const int qrel = 32 * w + r32;
    LAS const float* lutp = (LAS const float*)(F.lds + L_LUT) + (2047 - qrel + 4 * hi);
    const int jd = w >> 1;
    bf16x8 qn[4];
    dma_kv(F.lds, Kb, Vb, b, h, own0, w, lane);
    load_q_raw(qn, Qb, (size_t)b * SEQ + own0 * BLK + qrel, b, h, hi);
    for (int i = 0; i < nun; ++i) {
        const int own = own0 + 4 * i; const size_t qrow = (size_t)b * SEQ + own * BLK + qrel;
        LAS unsigned char* kv = F.lds + (i & 1) * 65536;
        bf16x8 qr[4];
#pragma unroll
        for (int d0 = 0; d0 < 4; ++d0) qr[d0] = qn[d0];
        asm volatile("s_waitcnt vmcnt(0)" ::: "memory");
        __syncthreads();
        if (i + 1 < nun) { dma_kv(F.lds + ((i + 1) & 1) * 65536, Kb, Vb, b, h, own + 4, w, lane); load_q_raw(qn, Qb, qrow + 4 * BLK, b, h, hi); }
        const float mref = ref_exponent(q_norm2(qr), kmax2, bmax);
        f32x16 cinit;
#pragma unroll
        for (int r = 0; r < 16; ++r) cinit[r] = -mref;
        f32x16 o[2]; o[0] = f32x16{}; o[1] = f32x16{}; float l = 0.f;
        const lds_cptr Kl = (lds_cptr)(kv + L_K), Vl = (lds_cptr)(kv + L_V); const int vrl = 4 * hi + ((lane & 15) >> 2); const unsigned vo0 = (unsigned)(vrl * 128 + ((vrl >> 1) & 1) * 64 + ((lane >> 4) & 1) * 32 + (lane & 3) * 8);
        for (int j = 0; j <= jd; ++j) { f32x16 p0, p1; v4u pa[4];
            qk_tile(p0, p1, Kl + j * 8192, qr, cinit, r32, hi);
            if (j == jd) softmax_tile<true, true>(p0, p1, lutp, j, qrel, hi, l, pa); else softmax_tile<true, false>(p0, p1, lutp, j, qrel, hi, l, pa);
            pv_tile(o, Vl + j * 8192, vo0, pa); }
        l = swap_add(l);
        const int nsl = own < 3 ? own : 3; const int tq = own * BLK + qrel;
        for (int sl = 0; sl < nsl; ++sl) { add_row(o, po_row(ws, F.out, b, h, tq, sl), hi); l += PL[(((size_t)bh * SEQ + tq) * 3) + sl]; }
        store_row(Ob + qrow * D + h * 64, o, 1.0f / l, hi, true);
    }
    asm volatile("s_waitcnt vmcnt(0)" ::: "memory");
    __syncthreads();
}
}

__device__ __forceinline__ void final_norm(Frame& Fr) {
    struct { int lane, vcu, wave, G; const GAS float* norm_final; GAS float* out; } F{Fr.wave * 64 + lane_id(), Fr.vcu, Fr.wave, Fr.G, Fr.norm_final, Fr.out};
    asm volatile("" : "+v"(F.lane)); F.lane &= 63;
    const int gw = F.vcu * NWAVES + F.wave, NGW = F.G * NWAVES;
    f32x4 gam[4];
#pragma unroll
    for (int j = 0; j < 4; ++j) gam[j] = *(const GAS f32x4*)(F.norm_final + 4 * (F.lane + 64 * j));
    for (int row = gw; row < M; row += NGW) { GAS float* xr = F.out + (size_t)row * D; f32x4 v[4]; float ss = 0.f;
#pragma unroll
        for (int j = 0; j < 4; ++j) { v[j] = *(const GAS f32x4*)(xr + 4 * (F.lane + 64 * j)); ss += (v[j][0] * v[j][0] + v[j][1] * v[j][1]) + (v[j][2] * v[j][2] + v[j][3] * v[j][3]); }
#pragma unroll
        for (int o = 1; o < 64; o <<= 1) ss += shx(ss, o, F.lane);
        const float rstd = rsqrtf(ss * (1.0f / D) + EPS);
#pragma unroll
        for (int j = 0; j < 4; ++j) *(GAS f32x4*)(xr + 4 * (F.lane + 64 * j)) = v[j] * rstd * gam[j]; }
}

__global__ void __launch_bounds__(NWAVES * 64, 2) fwd_megakernel(Args args) {
    __shared__ __attribute__((aligned(16))) unsigned char lds[LDS_BYTES];
    Frame F;
    F.lds = (LAS unsigned char*)lds;
    F.tid = threadIdx.x; F.lane = F.tid & 63; F.wave = __builtin_amdgcn_readfirstlane(F.tid >> 6);
    F.G = gridDim.x; { const int bx = blockIdx.x; F.vcu = (F.G % 8 == 0) ? (bx % 8) * (F.G / 8) + bx / 8 : bx; }
    F.x = args.in[0]; F.c = args.in[1]; F.rel_bias = args.in[2]; F.w_mod = args.in[3]; F.b_mod = args.in[4]; F.norm_mix = args.in[5]; F.norm_mlp = args.in[6];
    F.w_pool = args.in[7]; F.pool_scale = args.in[8]; F.w_qkv = args.in[9]; F.w_o = args.in[10]; F.w_up = args.in[11]; F.w_down = args.in[12]; F.norm_final = args.in[13];
    F.out = args.out; F.ws = args.ws;
    volatile LAS unsigned* MISC = (volatile LAS unsigned*)(F.lds + MISC_OFF);
    for (int u = F.tid; u < (LDS_BYTES - LDSCTL_OFF) / 4; u += NWAVES * 64) ((LAS unsigned*)(F.lds + LDSCTL_OFF))[u] = 0u;
    __syncthreads();
    gu32* ctl = (gu32*)(F.ws + WS_CTL);
    XcdBarrier bar = xcd_barrier_post((GAS unsigned*)(ctl + CW_BAR), MISC + 8); bar.wave = F.wave;
    GAS unsigned char* ws = F.ws;
#define WSB(off) ((GAS bf16*)(ws + (off)))
#define WSF(off) ((GAS float*)(ws + (off)))

    p0_prologue(F);
    xcd_barrier(bar);
    p1_bias(F); p1_pool(F);
    xcd_barrier(bar);

    for (int ph = 0; ph < 10; ++ph) {
        asm volatile("" : "+s"(ws));
        const GAS float* MOD = WSF(WS_MOD); GAS float* SS = WSF(WS_SS);
        const int kind = (ph == 0 || ph == 2 || ph == 7) ? 0 : (ph == 1 || ph == 8) ? 1 : (ph == 3) ? 2 : (ph == 4) ? 3 : (ph == 5) ? 4 : (ph == 6) ? 5 : 7;
        if (kind == 0) {
            pg8::Gemm g; pg8::EpiRes E;
            if (ph == 0) { g = pg8::Gemm{WSB(WS_XNA), WSB(WS_WPOOL), M, D, 256, D, 256, 512};
                E = pg8::EpiRes{WSB(WS_XR), WSB(WS_XR), MOD + 2048, F.pool_scale, SS}; }
            else if (ph == 2) { g = pg8::Gemm{WSB(WS_HB), WSB(WS_WDN0), M, D, FF, 256, 0, 131072};
                E = pg8::EpiRes{WSB(WS_XR), WSB(WS_XR), MOD + 5120, nullptr, SS}; }
            else { g = pg8::Gemm{WSB(WS_O), WSB(WS_WO), M, D, D, D, 0, 512};
                E = pg8::EpiRes{WSB(WS_XR), WSB(WS_XR), MOD + 4 * 6144 + 2048, nullptr, SS}; }
            pg8::StaticOrder S; S.init(M, D, F.G, (int)blockIdx.x);
            pg8::gemm_phase<pg8::EpiRes, pg8::StaticOrder, true>(F.lds + RING_OFF, g, S, E, F.wave);
        } else if (kind == 1) {
            const pg8::Gemm g{WSB(WS_XR), WSB(ph == 1 ? WS_WSUP0 : WS_WSUP1), M, FF, D, 256, 0, 131072, (size_t)FF * D * 2};
            const pg8::EpiUp E{SS, WSF(ph == 1 ? WS_BIAS_UP0 : WS_BIAS_UP1), WSB(WS_HB), FF, F.lds, 0};
            pg8::StaticOrder S; S.init(M, FF, F.G, (int)blockIdx.x);
            pg8::gemm_phase<pg8::EpiUp, pg8::StaticOrder, true>(F.lds + RING_OFF, g, S, E, F.wave);
        } else if (kind == 2) {
            const pg8::Gemm g{WSB(WS_XR), (const GAS bf16*)((GAS unsigned char*)F.out + OUT_WSQKV), M, NQKV, D, 256, 0, 131072, (size_t)NQKV * D * 2};
            const pg8::EpiQKV E{SS, WSF(WS_BIAS_QKV), WSB(WS_Q), (size_t)(WS_K - WS_Q) / 2, WSF(WS_KMP), F.lds, 0};
            pg8::StaticOrder S; S.init(M, NQKV, F.G, (int)blockIdx.x);
            pg8::gemm_phase<pg8::EpiQKV, pg8::StaticOrder, true>(F.lds + RING_OFF, g, S, E, F.wave);
        } else if (kind == 3) { F.ws = ws; att::route(F);
        } else if (kind == 4) { F.ws = ws; att::gather(F);
        } else if (kind == 5) { F.ws = ws; att::own_block(F);
        } else {
            const pg8::Gemm g{WSB(WS_HB), WSB(WS_WDN1), M, D, FF, 256, 0, 131072};
            const pg8::EpiFinal E{WSB(WS_XR), F.out, MOD + 4 * 6144 + 5120, F.norm_final, SS, (GAS unsigned*)(ws + WS_CTL) + CW_FIN};
            pg8::StaticOrder S; S.init(M, D, F.G, (int)blockIdx.x);
            pg8::gemm_phase<pg8::EpiFinal, pg8::StaticOrder, true>(F.lds + RING_OFF, g, S, E, F.wave);
            break;
        }
        xcd_barrier(bar);
    }
}

extern "C" void kernel_launch(void* const* d_in, const int* in_sizes, int n_in, void* d_out, int out_size, void* d_ws, size_t ws_size, hipStream_t stream) {
    static int grid = 0;
    if (grid == 0) {
        if (n_in != 14 || in_sizes[0] != M * D || out_size != M * D || ws_size < WS_END) { fprintf(stderr, "kernel_launch: unexpected shapes / workspace (n_in %d, in0 %d, out %d, ws %zu)\n", n_in, n_in > 0 ? in_sizes[0] : -1, out_size, ws_size); grid = -1; return; }
        int dev = 0, cus = 0, per_cu = 0;
        if (hipGetDevice(&dev) != hipSuccess || hipDeviceGetAttribute(&cus, hipDeviceAttributeMultiprocessorCount, dev) != hipSuccess) { grid = -1; return; }
        if (hipOccupancyMaxActiveBlocksPerMultiprocessor(&per_cu, (const void*)fwd_megakernel, NWAVES * 64, 0) != hipSuccess || per_cu < 1) { fprintf(stderr, "kernel_launch: occupancy query says %d blocks per CU\n", per_cu); }
        (void)hipGetLastError();
        grid = cus;
    }
    if (grid < 0) return;
    if (hipMemsetAsync((char*)d_ws + WS_CTL, 0, CTL_ZERO_BYTES, stream) != hipSuccess) return;
    Args a{};
    for (int i = 0; i < 14; ++i) a.in[i] = (const GAS float*)d_in[i];
    a.out = (GAS float*)d_out; a.ws = (GAS unsigned char*)d_ws;
    hipLaunchKernelGGL(fwd_megakernel, dim3(grid), dim3(NWAVES * 64), 0, stream, a);
}
```

```cpp
#include <hip/hip_runtime.h>
#include <utility>
#include <cstdio>
#include <cstdint>

__device__ __forceinline__ float shx(float v, int m, int lane) { return __builtin_bit_cast(float, __builtin_amdgcn_ds_bpermute((lane ^ m) << 2, __builtin_bit_cast(int, v))); }
__device__ __forceinline__ unsigned shup(unsigned v, int o, int lane) { return (unsigned)__builtin_amdgcn_ds_bpermute(((lane - o) & 63) << 2, (int)v); }
__device__ __forceinline__ size_t hm_off(size_t row, int b, int h) { return (row + (size_t)(15 * b + h) * 8192) * 64; }
__device__ __forceinline__ int lane_id() { unsigned z = 0u; asm volatile("" : "+s"(z)); return (int)__builtin_amdgcn_mbcnt_hi(~0u, __builtin_amdgcn_mbcnt_lo(~0u, z)); }

namespace pg8 {
#define PG8_LAS __attribute__((address_space(3)))
#define PG8_GAS __attribute__((address_space(1)))
typedef unsigned short bf16_t;
typedef short bf16x8 __attribute__((ext_vector_type(8)));
typedef float f32x4 __attribute__((ext_vector_type(4)));
typedef unsigned u32x4 __attribute__((ext_vector_type(4)));
constexpr int BM = 256, BK = 64, HALF = 128, HTB = HALF * BK * 2, STAGE_BYTES = 8 * HTB, NXCD = 8, WGM = 8;

__host__ __device__ __forceinline__ int lds_byte(int r, int c) { const int st = (r >> 4) * 2 + (c >> 5), rr = r & 15, cc = c & 31, ob = rr * 64 + cc * 2; return st * 1024 + (ob ^ (((ob >> 9) & 1) << 5)); }
__host__ __device__ __forceinline__ void stage_rc(int b, int& R, int& C) { const int st = b / 1024, sb = b % 1024, swz = sb ^ (((sb >> 9) & 1) << 5); R = (st >> 1) * 16 + swz / 64; C = (st & 1) * 32 + (swz % 64) / 2; }
__host__ __device__ __forceinline__ int perm32(int rho) { const int n = rho >> 4, i = rho & 15; return 8 * (i >> 2) + 4 * n + (i & 3); }

struct Unit { int pm, pn; };
struct Gemm { const PG8_GAS bf16_t* A; const PG8_GAS bf16_t* Bt; int M, N, K, lda, a_pn_off, a_tileb; size_t b_bstride = 0; };

struct StaticOrder {
    int nM, nN, nwg, G, c;
    __host__ __device__ void init(int M, int N, int G_, int c_) { nM = M / BM; nN = N / BM; nwg = nM * nN; G = G_; c = c_; }
    __host__ __device__ bool next(int i, Unit& u) const {
        const long L = (long)i * G + c; if (L >= nwg) return false;
        int wgid = (int)L; { const int q = nwg / NXCD, r = nwg % NXCD, xcd = wgid % NXCD, off = wgid / NXCD; wgid = (xcd < r ? xcd * (q + 1) : r * (q + 1) + (xcd - r) * q) + off; }
        const int nig = WGM * nN, gid = wgid / nig, fm = gid * WGM, gsz = (nM - fm) < WGM ? (nM - fm) : WGM;
        u.pm = fm + ((wgid % nig) % gsz); u.pn = (wgid % nig) / gsz; return true;
    }
};

__device__ __forceinline__ unsigned cvt_pk_bf16(float lo, float hi) { unsigned r; asm volatile("v_cvt_pk_bf16_f32 %0, %1, %2" : "=v"(r) : "v"(lo), "v"(hi)); return r; }

constexpr int SEQ_ = 8192;
constexpr float EPS_ = 1e-6f;
constexpr float C2_ = 0.125f * 1.4426950408889634f;


__device__ __forceinline__ float row_rstd(const PG8_GAS float* SS, int row, int fq, int fr) {
    const f32x4 s4 = *(const PG8_GAS f32x4*)(SS + (size_t)row * 16 + 4 * fq);
    float s = (s4[0] + s4[1]) + (s4[2] + s4[3]);
    const int ln = fq * 16 + fr; s += shx(s, 16, ln); s += shx(s, 32, ln);
    return rsqrtf(s * (1.0f / 1024.0f) + EPS_);
}

constexpr int RSTD_TAB_OFF = 132096;
__device__ __forceinline__ void fill_rstd_tab(PG8_LAS unsigned char* ldsbase, int par, const PG8_GAS float* SS, int pm, int wid, int lane) {
    if (lane < 32) { const int r = wid * 32 + lane; const PG8_GAS f32x4* p = (const PG8_GAS f32x4*)(SS + (size_t)(pm * BM + r) * 16);
        const f32x4 a = p[0], b = p[1], c = p[2], d = p[3];
        const float g0 = (a[0] + a[1]) + (a[2] + a[3]), g1 = (b[0] + b[1]) + (b[2] + b[3]), g2 = (c[0] + c[1]) + (c[2] + c[3]), g3 = (d[0] + d[1]) + (d[2] + d[3]);
        ((PG8_LAS float*)(ldsbase + RSTD_TAB_OFF + par * 1024))[r] = rsqrtf(((g0 + g1) + (g2 + g3)) * (1.0f / 1024.0f) + EPS_); }
}
__device__ __forceinline__ f32x4 bf_lo4(const u32x4& w) { return (f32x4){__builtin_bit_cast(float, w.x << 16), __builtin_bit_cast(float, w.x & 0xffff0000u), __builtin_bit_cast(float, w.y << 16), __builtin_bit_cast(float, w.y & 0xffff0000u)}; }
__device__ __forceinline__ f32x4 bf_hi4(const u32x4& w) { return (f32x4){__builtin_bit_cast(float, w.z << 16), __builtin_bit_cast(float, w.z & 0xffff0000u), __builtin_bit_cast(float, w.w << 16), __builtin_bit_cast(float, w.w & 0xffff0000u)}; }
struct EpiRes {
    static constexpr bool PERM = true, NEEDS_RSTD = false;
    const PG8_GAS bf16_t* Rb; PG8_GAS bf16_t* Xb; const PG8_GAS float* gate; const PG8_GAS float* cscale; PG8_GAS float* SS;
    __device__ __forceinline__ void operator()(f32x4 (&acc)[2][2][4][2], const Unit& u, int wr, int wc, int fr, int fq) const {
        const int b = u.pm >> 5, colb = u.pn * BM + wc * 32 + 8 * fq, row0 = u.pm * BM + wr * 64 + fr;
        float ssq[2][4];
#pragma unroll
        for (int bj = 0; bj < 2; ++bj) {
            f32x4 gt[2];
#pragma unroll
            for (int n = 0; n < 2; ++n) { const int col = colb + bj * HALF + 4 * n;
                f32x4 gv = *(const PG8_GAS f32x4*)(gate + b * 6144 + col); if (cscale) gv = gv * *(const PG8_GAS f32x4*)(cscale + col); gt[n] = gv; }
#pragma unroll
            for (int ai = 0; ai < 2; ++ai)
#pragma unroll
                for (int m = 0; m < 4; ++m) { const size_t off = ((size_t)(u.pm * 4 + u.pn) * 256 + (wr * 64 + fr + ai * HALF + m * 16)) * 256 + (wc * 32 + 8 * fq + bj * HALF);
                    const u32x4 rw = *(const PG8_GAS u32x4*)(Rb + off); const f32x4 r0 = bf_lo4(rw), r1 = bf_hi4(rw);
                    const f32x4 y0 = r0 + gt[0] * acc[ai][bj][m][0], y1 = r1 + gt[1] * acc[ai][bj][m][1];
                    u32x4 xw; xw.x = cvt_pk_bf16(y0[0], y0[1]); xw.y = cvt_pk_bf16(y0[2], y0[3]); xw.z = cvt_pk_bf16(y1[0], y1[1]); xw.w = cvt_pk_bf16(y1[2], y1[3]);
                    *(PG8_GAS u32x4*)(Xb + off) = xw;
                    const f32x4 x0 = bf_lo4(xw), x1 = bf_hi4(xw);
                    const float q = (x0[0] * x0[0] + x0[1] * x0[1]) + (x0[2] * x0[2] + x0[3] * x0[3]) + (x1[0] * x1[0] + x1[1] * x1[1]) + (x1[2] * x1[2] + x1[3] * x1[3]);
                    ssq[ai][m] = (bj == 0) ? q : ssq[ai][m] + q;
                }
        }
#pragma unroll
        for (int ai = 0; ai < 2; ++ai)
#pragma unroll
            for (int m = 0; m < 4; ++m) { float q = ssq[ai][m]; q += shx(q, 16, fq * 16 + fr); q += shx(q, 32, fq * 16 + fr); if (fq == 0) SS[(size_t)(row0 + ai * HALF + m * 16) * 16 + u.pn * 4 + wc] = q; }
    }
};

struct EpiFinal {
    static constexpr bool PERM = true, NEEDS_RSTD = false;
    const PG8_GAS bf16_t* R; PG8_GAS float* OUT; const PG8_GAS float* gate; const PG8_GAS float* gfin; PG8_GAS float* SS; PG8_GAS unsigned* cnt;
    __device__ __forceinline__ void operator()(f32x4 (&acc)[2][2][4][2], const Unit& u, int wr, int wc, int fr_, int fq_) const {
        int fr = fr_, fq = fq_; asm volatile("" : "+v"(fr), "+v"(fq));
        const int b = u.pm >> 5, colb = u.pn * BM + wc * 32 + 8 * fq, row0 = u.pm * BM + wr * 64 + fr, ln = fq * 16 + fr;
        float ssq[2][4];
#pragma unroll
        for (int bj = 0; bj < 2; ++bj) {
            const f32x4 gt0 = *(const PG8_GAS f32x4*)(gate + b * 6144 + colb + bj * HALF), gt1 = *(const PG8_GAS f32x4*)(gate + b * 6144 + colb + bj * HALF + 4);
#pragma unroll
            for (int ai = 0; ai < 2; ++ai)
#pragma unroll
                for (int m = 0; m < 4; ++m) { const size_t off = (size_t)(row0 + ai * HALF + m * 16) * 1024 + colb + bj * HALF;
                    const u32x4 rw = *(const PG8_GAS u32x4*)(R + ((size_t)(u.pm * 4 + u.pn) * 256 + (wr * 64 + fr + ai * HALF + m * 16)) * 256 + (wc * 32 + 8 * fq + bj * HALF));
                    const f32x4 x0 = bf_lo4(rw) + gt0 * acc[ai][bj][m][0], x1 = bf_hi4(rw) + gt1 * acc[ai][bj][m][1];
                    acc[ai][bj][m][0] = x0; acc[ai][bj][m][1] = x1;
                    const float q = (x0[0] * x0[0] + x0[1] * x0[1]) + (x0[2] * x0[2] + x0[3] * x0[3]) + (x1[0] * x1[0] + x1[1] * x1[1]) + (x1[2] * x1[2] + x1[3] * x1[3]);
                    ssq[ai][m] = (bj == 0) ? q : ssq[ai][m] + q;
                    asm volatile("" : "+v"(acc[ai][bj][m][0]), "+v"(acc[ai][bj][m][1]), "+v"(ssq[ai][m]));
                    if (m & 1) asm volatile("" ::: "memory"); }
        }
#pragma unroll
        for (int ai = 0; ai < 2; ++ai)
#pragma unroll
            for (int m = 0; m < 4; ++m) { float q = ssq[ai][m]; q += shx(q, 16, ln); q += shx(q, 32, ln);
                if (fq == 0) __hip_atomic_store(SS + (size_t)(row0 + ai * HALF + m * 16) * 16 + u.pn * 4 + wc, q, __ATOMIC_RELAXED, __HIP_MEMORY_SCOPE_AGENT); }
        asm volatile("s_waitcnt vmcnt(0)" ::: "memory");
        PG8_GAS unsigned* c = cnt + 64 * u.pm;
        if (ln == 0) (void)__hip_atomic_fetch_add(c, 1u, __ATOMIC_RELAXED, __HIP_MEMORY_SCOPE_AGENT);
        for (unsigned sp = 0; sp < (1u << 22); ++sp) { if ((unsigned)__builtin_amdgcn_readfirstlane((int)__hip_atomic_load(c, __ATOMIC_RELAXED, __HIP_MEMORY_SCOPE_AGENT)) >= 32u) break; __builtin_amdgcn_s_sleep(2); }
        int row1 = row0, colc = colb; asm volatile("" : "+v"(row1), "+v"(colc));
        float rs[2][4];
#pragma unroll
        for (int ai = 0; ai < 2; ++ai)
#pragma unroll
            for (int m = 0; m < 4; ++m) { const PG8_GAS float* sp4 = SS + (size_t)(row1 + ai * HALF + m * 16) * 16 + 4 * fq;
                float t = (__hip_atomic_load(sp4, __ATOMIC_RELAXED, __HIP_MEMORY_SCOPE_AGENT) + __hip_atomic_load(sp4 + 1, __ATOMIC_RELAXED, __HIP_MEMORY_SCOPE_AGENT))
                        + (__hip_atomic_load(sp4 + 2, __ATOMIC_RELAXED, __HIP_MEMORY_SCOPE_AGENT) + __hip_atomic_load(sp4 + 3, __ATOMIC_RELAXED, __HIP_MEMORY_SCOPE_AGENT));
                t += shx(t, 16, ln); t += shx(t, 32, ln); rs[ai][m] = rsqrtf(t * (1.0f / 1024.0f) + EPS_); }
#pragma unroll
        for (int bj = 0; bj < 2; ++bj) {
            const f32x4 g0 = *(const PG8_GAS f32x4*)(gfin + colc + bj * HALF), g1 = *(const PG8_GAS f32x4*)(gfin + colc + bj * HALF + 4);
#pragma unroll
            for (int ai = 0; ai < 2; ++ai)
#pragma unroll
                for (int m = 0; m < 4; ++m) { const size_t off = (size_t)(row1 + ai * HALF + m * 16) * 1024 + colc + bj * HALF;
                    *(PG8_GAS f32x4*)(OUT + off) = acc[ai][bj][m][0] * rs[ai][m] * g0; *(PG8_GAS f32x4*)(OUT + off + 4) = acc[ai][bj][m][1] * rs[ai][m] * g1; }
        }
    }
};

struct EpiUp {
    static constexpr bool PERM = true;
    static constexpr bool NEEDS_RSTD = true;
    const PG8_GAS float* SS; const PG8_GAS float* bias; PG8_GAS bf16_t* O; int ldc; PG8_LAS unsigned char* ldsb; int par;
    __device__ __forceinline__ void operator()(f32x4 (&acc)[2][2][4][2], const Unit& u, int wr, int wc, int fr, int fq) const {
        const int b = u.pm >> 5, colb = u.pn * BM + wc * 32 + 8 * fq, row0 = u.pm * BM + wr * 64 + fr;
        float rs[2][4];
#pragma unroll
        for (int ai = 0; ai < 2; ++ai)
#pragma unroll
            for (int m = 0; m < 4; ++m) rs[ai][m] = ((const PG8_LAS float*)(ldsb + RSTD_TAB_OFF + par * 1024))[wr * 64 + fr + ai * HALF + m * 16];
#pragma unroll
        for (int bj = 0; bj < 2; ++bj) {
            const f32x4 bv0 = *(const PG8_GAS f32x4*)(bias + (size_t)b * ldc + colb + bj * HALF), bv1 = *(const PG8_GAS f32x4*)(bias + (size_t)b * ldc + colb + bj * HALF + 4);
#pragma unroll
            for (int ai = 0; ai < 2; ++ai)
#pragma unroll
                for (int m = 0; m < 4; ++m) { f32x4 v0 = acc[ai][bj][m][0] * rs[ai][m] + bv0, v1 = acc[ai][bj][m][1] * rs[ai][m] + bv1;
#pragma unroll
                    for (int j = 0; j < 4; ++j) { v0[j] = fmaxf(v0[j], 0.f); v1[j] = fmaxf(v1[j], 0.f); }
                    v0 = v0 * v0; v1 = v1 * v1;
                    u32x4 w; w.x = cvt_pk_bf16(v0[0], v0[1]); w.y = cvt_pk_bf16(v0[2], v0[3]); w.z = cvt_pk_bf16(v1[0], v1[1]); w.w = cvt_pk_bf16(v1[2], v1[3]);
                    __builtin_nontemporal_store(w, (PG8_GAS u32x4*)(O + ((size_t)(u.pm * 16 + u.pn) * 256 + (wr * 64 + fr + ai * HALF + m * 16)) * 256 + (wc * 32 + 8 * fq + bj * HALF))); }
        }
    }
};

struct EpiQKV {
    static constexpr bool PERM = true;
    static constexpr bool NEEDS_RSTD = true;
    const PG8_GAS float* SS; const PG8_GAS float* bias; PG8_GAS bf16_t* Q; size_t split_stride; PG8_GAS float* KMP; PG8_LAS unsigned char* ldsb; int par; PG8_GAS unsigned* KBH;
    __device__ __forceinline__ void operator()(f32x4 (&acc)[2][2][4][2], const Unit& u, int wr, int wc, int fr, int fq) const {
        const int b = u.pm >> 5, t = u.pn >> 2, colt = (u.pn & 3) * BM + wc * 32 + 8 * fq, colb = u.pn * BM + wc * 32 + 8 * fq, row0 = u.pm * BM + wr * 64 + fr;
        PG8_GAS bf16_t* base = Q + (size_t)t * split_stride; const float sc = (t == 0) ? C2_ : 1.0f;
        float rs[2][4];
#pragma unroll
        for (int ai = 0; ai < 2; ++ai)
#pragma unroll
            for (int m = 0; m < 4; ++m) rs[ai][m] = ((const PG8_LAS float*)(ldsb + RSTD_TAB_OFF + par * 1024))[wr * 64 + fr + ai * HALF + m * 16];
#pragma unroll
        for (int bj = 0; bj < 2; ++bj) {
            const f32x4 bv0 = *(const PG8_GAS f32x4*)(bias + (size_t)b * 3072 + colb + bj * HALF), bv1 = *(const PG8_GAS f32x4*)(bias + (size_t)b * 3072 + colb + bj * HALF + 4);
            f32x4 cs0 = {0.f, 0.f, 0.f, 0.f}, cs1 = cs0; float rmx = 0.f;
#pragma unroll
            for (int ai = 0; ai < 2; ++ai)
#pragma unroll
                for (int m = 0; m < 4; ++m) { f32x4 v0 = acc[ai][bj][m][0] * rs[ai][m] + bv0, v1 = acc[ai][bj][m][1] * rs[ai][m] + bv1;
                    if (t == 1) { const float r2 = (v0[0] * v0[0] + v0[1] * v0[1]) + (v0[2] * v0[2] + v0[3] * v0[3]) + (v1[0] * v1[0] + v1[1] * v1[1]) + (v1[2] * v1[2] + v1[3] * v1[3]);
                        rmx = fmaxf(rmx, r2); }
                    cs0 += v0; cs1 += v1; v0 = v0 * sc; v1 = v1 * sc;
                    u32x4 w; w.x = cvt_pk_bf16(v0[0], v0[1]); w.y = cvt_pk_bf16(v0[2], v0[3]); w.z = cvt_pk_bf16(v1[0], v1[1]); w.w = cvt_pk_bf16(v1[2], v1[3]);
                    *(PG8_GAS u32x4*)(base + hm_off((size_t)(row0 + ai * HALF + m * 16), b, (colt + bj * HALF) >> 6) + ((colt + bj * HALF) & 63)) = w; }
            if (t == 1) {
#pragma unroll
                for (int o = 1; o < 16; o <<= 1) {
#pragma unroll
                    for (int j = 0; j < 4; ++j) { cs0[j] += shx(cs0[j], o, fq * 16 + fr); cs1[j] += shx(cs1[j], o, fq * 16 + fr); } }
                if (fr == 0) { PG8_GAS float* kp = KMP + ((size_t)u.pm * 2 + wr) * 1024 + colt + bj * HALF; *(f32x4*)kp = cs0; *(PG8_GAS f32x4*)(kp + 4) = cs1; }
#pragma unroll
                for (int o = 1; o < 16; o <<= 1) rmx = fmaxf(rmx, shx(rmx, o, fq * 16 + fr));
                if (fr == 0) { const int head = ((u.pn & 3) * BM + wc * 32 + bj * HALF) >> 6;
                    (void)__hip_atomic_fetch_max(KBH + ((size_t)((b * 16 + head) * 32 + (u.pm & 31)) * 8 + (wc & 1) * 4 + fq), __builtin_bit_cast(unsigned, rmx), __ATOMIC_RELAXED, __HIP_MEMORY_SCOPE_AGENT); }
            }
        }
    }
};

template <class Epi, class Sched, bool ALIGN_EPI>
__device__ __forceinline__ void gemm_phase(PG8_LAS unsigned char* lds, const Gemm g, const Sched& S, const Epi& E_, int wave_id) {
    Epi E = E_;
    int tid = wave_id * 64 + lane_id(); asm volatile("" : "+v"(tid));
    const int wid = __builtin_amdgcn_readfirstlane(tid >> 6), lane = tid & 63, wr = wid >> 2, wc = wid & 3, fr = lane & 15, fq = lane >> 4;
    const int K = g.K, nt = K / BK, lda = g.lda;
    unsigned voffA[2], voffB[2];
#pragma unroll
    for (int i = 0; i < 2; ++i) { int R, C; stage_rc(tid * 16 + i * 8192, R, C); const int Rb = Epi::PERM ? ((R & ~31) + perm32(R & 31)) : R;
        voffA[i] = (unsigned)(R * lda + C) * 2u; voffB[i] = (unsigned)(Rb * K + C) * 2u; }
    const size_t kstep = (size_t)(BK * 2);
    const size_t hstepA = (size_t)HALF * lda * 2, tstepA = (g.a_tileb == 512) ? 2 * hstepA : (size_t)(K / 256) * g.a_tileb, hstepB = (size_t)HALF * K * 2, tstepB = 2 * hstepB;
    const size_t tileb = (size_t)g.a_tileb;
#define PG8_KOFF(t) ((size_t)((t) >> 2) * tileb + (size_t)((t) & 3) * 128)
    const unsigned ldsw = (unsigned)wid * 1024u;
    const int aoff = lds_byte(wr * 64 + fr, fq * 8), boff = lds_byte(wc * 32 + fr, fq * 8);
#define PG8_SA(b, h) (((b) * 2 + (h)) * HTB)
#define PG8_SB(b, h) ((4 + (b) * 2 + (h)) * HTB)
#define PG8_STAGE(bufoff, gbase, voff) do { _Pragma("unroll") for (int _i = 0; _i < 2; ++_i) \
        __builtin_amdgcn_global_load_lds((const PG8_GAS unsigned*)((const PG8_GAS char*)(gbase) + (voff)[_i]), (PG8_LAS unsigned*)(lds + (bufoff) + ldsw + _i * 8192), 16, 0, 0); } while (0)
#define PG8_LDA(dst, b, h) do { _Pragma("unroll") for (int m = 0; m < 4; ++m) _Pragma("unroll") for (int k = 0; k < 2; ++k) dst[m][k] = *(const PG8_LAS bf16x8*)(lds + PG8_SA(b, h) + aoff + m * 2048 + k * 1024); } while (0)
#define PG8_LDB(dst, b, h) do { _Pragma("unroll") for (int n = 0; n < 2; ++n) _Pragma("unroll") for (int k = 0; k < 2; ++k) dst[n][k] = *(const PG8_LAS bf16x8*)(lds + PG8_SB(b, h) + boff + n * 2048 + k * 1024); } while (0)
#define PG8_MMA(ai, bj, At, Bt) do { __builtin_amdgcn_s_setprio(1); _Pragma("unroll") for (int m = 0; m < 4; ++m) _Pragma("unroll") for (int n = 0; n < 2; ++n) _Pragma("unroll") for (int k = 0; k < 2; ++k) \
        acc[ai][bj][m][n] = __builtin_amdgcn_mfma_f32_16x16x32_bf16(Bt[n][k], At[m][k], acc[ai][bj][m][n], 0, 0, 0); __builtin_amdgcn_s_setprio(0); } while (0)
#define PG8_WAIT_V(n) asm volatile("s_waitcnt vmcnt(" #n ")" ::: "memory")
#define PG8_WAIT_L(n) asm volatile("s_waitcnt lgkmcnt(" #n ")" ::: "memory")
#define PG8_BAR __builtin_amdgcn_s_barrier()
#define PG8_SCHED __builtin_amdgcn_sched_barrier(0)
    Unit cur, nxt; int ui = 0;
    if (!S.next(0, cur)) return;
    int rpar = 0;
    if constexpr (Epi::NEEDS_RSTD) { fill_rstd_tab(lds, 0, E.SS, cur.pm, wid, lane); E.par = 0; }
    f32x4 acc[2][2][4][2];
#pragma unroll
    for (int a = 0; a < 2; ++a)
#pragma unroll
        for (int b = 0; b < 2; ++b)
#pragma unroll
            for (int m = 0; m < 4; ++m)
#pragma unroll
                for (int n = 0; n < 2; ++n) acc[a][b][m][n] = (f32x4){0.f, 0.f, 0.f, 0.f};
    bf16x8 At[4][2], B0[2][2], B1[2][2];
    const PG8_GAS char* cA = (const PG8_GAS char*)g.A + (size_t)cur.pm * tstepA + (size_t)cur.pn * g.a_pn_off * 2; const PG8_GAS char* cB = (const PG8_GAS char*)g.Bt + (size_t)cur.pn * tstepB + (size_t)(cur.pm >> 5) * g.b_bstride;
    PG8_STAGE(PG8_SB(0, 0), cB, voffB); PG8_STAGE(PG8_SB(0, 1), cB + hstepB, voffB); PG8_STAGE(PG8_SA(0, 0), cA, voffA); PG8_STAGE(PG8_SA(0, 1), cA + hstepA, voffA);
    if (wr == 1) PG8_BAR;
    PG8_WAIT_V(2); PG8_BAR;
    PG8_STAGE(PG8_SB(1, 0), cB + kstep, voffB); PG8_STAGE(PG8_SA(1, 0), cA + kstep, voffA); PG8_STAGE(PG8_SB(1, 1), cB + hstepB + kstep, voffB);
    PG8_WAIT_V(6); PG8_BAR;
    for (;;) {
        const bool has_next = S.next(ui + 1, nxt);
        const PG8_GAS char* nA = has_next ? (const PG8_GAS char*)g.A + (size_t)nxt.pm * tstepA + (size_t)nxt.pn * g.a_pn_off * 2 : cA; const PG8_GAS char* nB = has_next ? (const PG8_GAS char*)g.Bt + (size_t)nxt.pn * tstepB + (size_t)(nxt.pm >> 5) * g.b_bstride : cB;
        for (int t = 0; t < nt; t += 2) {
            const bool last = (t == nt - 2);
            const PG8_GAS char* a1 = cA + PG8_KOFF(t + 1);
            const PG8_GAS char* a2 = last ? nA : cA + PG8_KOFF(t + 2); const PG8_GAS char* b2 = last ? nB : cB + (size_t)(t + 2) * kstep;
            const PG8_GAS char* a3 = a2 + kstep; const PG8_GAS char* b3 = b2 + kstep;
            PG8_LDB(B0, 0, 0); PG8_LDB(B1, 0, 1); PG8_SCHED; PG8_LDA(At, 0, 0); PG8_STAGE(PG8_SA(1, 1), a1 + hstepA, voffA);
            PG8_WAIT_V(8); PG8_WAIT_L(0); PG8_BAR; PG8_MMA(0, 0, At, B0); PG8_MMA(0, 1, At, B1); PG8_BAR; PG8_SCHED;
            PG8_LDA(At, 0, 1); PG8_STAGE(PG8_SB(0, 0), b2, voffB); PG8_STAGE(PG8_SB(0, 1), b2 + hstepB, voffB); PG8_STAGE(PG8_SA(0, 0), a2, voffA);
            PG8_WAIT_V(8); PG8_WAIT_L(0); PG8_BAR; PG8_MMA(1, 0, At, B0); PG8_MMA(1, 1, At, B1); PG8_BAR; PG8_SCHED;
            PG8_LDB(B0, 1, 0); PG8_LDB(B1, 1, 1); PG8_SCHED; PG8_LDA(At, 1, 0); PG8_STAGE(PG8_SA(0, 1), a2 + hstepA, voffA);
            PG8_WAIT_V(8); PG8_WAIT_L(0); PG8_BAR; PG8_MMA(0, 0, At, B0); PG8_MMA(0, 1, At, B1); PG8_BAR; PG8_SCHED;
            PG8_LDA(At, 1, 1); PG8_STAGE(PG8_SB(1, 0), b3, voffB); PG8_STAGE(PG8_SB(1, 1), b3 + hstepB, voffB); PG8_STAGE(PG8_SA(1, 0), a3, voffA);
            PG8_WAIT_V(8); PG8_WAIT_L(0); PG8_BAR; PG8_MMA(1, 0, At, B0); PG8_MMA(1, 1, At, B1); PG8_BAR; PG8_SCHED;
        }
        if constexpr (ALIGN_EPI) { if (wr == 0) PG8_BAR; }
        if constexpr (Epi::NEEDS_RSTD) E.par = rpar;
        E(acc, cur, wr, wc, fr, fq);
        if constexpr (Epi::NEEDS_RSTD) { if (has_next && nxt.pm != cur.pm) { rpar ^= 1; fill_rstd_tab(lds, rpar, E.SS, nxt.pm, wid, lane); } }
        if (!has_next) break;
#pragma unroll
        for (int a = 0; a < 2; ++a)
#pragma unroll
            for (int b = 0; b < 2; ++b)
#pragma unroll
                for (int m = 0; m < 4; ++m)
#pragma unroll
                    for (int n = 0; n < 2; ++n) acc[a][b][m][n] = (f32x4){0.f, 0.f, 0.f, 0.f};
        cur = nxt; cA = nA; cB = nB; ++ui;
        if constexpr (ALIGN_EPI) { if (wr == 1) PG8_BAR; }
    }
    PG8_WAIT_V(0);
    if constexpr (!ALIGN_EPI) { if (wr == 0) PG8_BAR; }
    PG8_BAR;
#undef PG8_KOFF
#undef PG8_SA
#undef PG8_SB
#undef PG8_STAGE
#undef PG8_LDA
#undef PG8_LDB
#undef PG8_MMA
#undef PG8_WAIT_V
#undef PG8_WAIT_L
#undef PG8_BAR
#undef PG8_SCHED
}
}

constexpr int NWAVES = 8;
constexpr int BATCH = 4, SEQ = 8192, D = 1024, NH = 16, HD = 64, FF = 4096, M = BATCH * SEQ, NQKV = 3 * D, NBLK = 32, BLK = 256;
constexpr float EPS = 1e-6f;
constexpr float LOG2E = 1.4426950408889634f;

constexpr size_t MiB = 1u << 20;
constexpr size_t WS_CTL = 0, CTL_ZERO_BYTES = 1 * MiB;
constexpr size_t WS_MOD = 1 * MiB;
constexpr size_t WS_BIAS_UP0 = WS_MOD + 256 * 1024;
constexpr size_t WS_BIAS_QKV = WS_BIAS_UP0 + 64 * 1024;
constexpr size_t WS_BIAS_UP1 = WS_BIAS_QKV + 64 * 1024;
constexpr size_t WS_KMP = 2 * MiB;
constexpr size_t WS_SS = 3 * MiB;
constexpr size_t WS_WPOOL = 6 * MiB, WS_WQKV = 8 * MiB, WS_WO = 14 * MiB, WS_WUP0 = 16 * MiB, WS_WUP1 = 24 * MiB, WS_WDN0 = 32 * MiB, WS_WDN1 = 40 * MiB;
constexpr size_t WS_XNA = 48 * MiB, WS_XNB = 112 * MiB;
constexpr size_t WS_WSUP0 = 112 * MiB, WS_WSUP1 = 144 * MiB;
constexpr size_t OUT_WSQKV = 96 * MiB;
constexpr size_t WS_HB = 176 * MiB;
constexpr size_t WS_Q = 176 * MiB, WS_K = 240 * MiB, WS_V = 304 * MiB;
constexpr size_t WS_PL = 496 * MiB;
constexpr size_t WS_CNT = 503 * MiB;
constexpr size_t WS_KBM = 503 * MiB + 512 * 1024;
constexpr size_t WS_POB = 48 * MiB;
constexpr size_t WS_SEG = 368 * MiB;
constexpr size_t WS_XR = 432 * MiB;
constexpr size_t WS_O = 368 * MiB;
constexpr size_t WS_DUMP = 504 * MiB;
constexpr size_t WS_END = 506 * MiB;
constexpr int CW_BAR = 4096;
constexpr int CW_KBH = 49152;
constexpr int CW_FIN = 24576;
constexpr int CW_TOT = 16384;

constexpr int RING_OFF = 0, RING_BYTES = 131072;
constexpr int LDSCTL_OFF = RING_BYTES, MISC_OFF = LDSCTL_OFF + 320;
constexpr int LDS_BYTES = 151552;

#define GAS __attribute__((address_space(1)))
#define LAS __attribute__((address_space(3)))
typedef unsigned short bf16;
typedef unsigned v4u __attribute__((ext_vector_type(4)));
typedef unsigned v2u __attribute__((ext_vector_type(2)));
typedef float f32x4 __attribute__((ext_vector_type(4)));
typedef GAS unsigned gu32;
#define RLX_AGENT __ATOMIC_RELAXED, __HIP_MEMORY_SCOPE_AGENT
#define LDS_WAIT() asm volatile("s_waitcnt lgkmcnt(0)" ::: "memory")
__device__ __forceinline__ unsigned f2bf(float f) { unsigned u = __builtin_bit_cast(unsigned, f); return (u + 0x7fffu + ((u >> 16) & 1u)) >> 16; }
__device__ __forceinline__ unsigned pk2(float lo, float hi) { return f2bf(lo) | (f2bf(hi) << 16); }
__device__ __forceinline__ float bf2f(unsigned short v) { return __builtin_bit_cast(float, (unsigned)v << 16); }

#define XB_TMO      128
#define XB_XCNT(j)  (256  + 64 * (j))
#define XB_XSUB(j)  (1280 + 64 * (j))
#define XB_XGEN(j)  (2304 + 64 * (j))
#define XB_TOP      3328
#define XB_TOPGEN   3392
#define XCD_BAR_WORDS 3456
#define XB_SPIN_CAP (1u << 18)
__device__ __forceinline__ unsigned xb_ld(GAS unsigned* p)              { return __hip_atomic_load(p, __ATOMIC_RELAXED, __HIP_MEMORY_SCOPE_AGENT); }
__device__ __forceinline__ unsigned xb_add(GAS unsigned* p, unsigned v) { return __hip_atomic_fetch_add(p, v, __ATOMIC_RELAXED, __HIP_MEMORY_SCOPE_AGENT); }
__device__ __forceinline__ unsigned xb_xcc_id() { return (unsigned)__builtin_amdgcn_s_getreg((3 << 11) | 20) & 0xFu; }
#define XB_SPIN(cond, bar) do { unsigned _sp = 0; while (cond) { __builtin_amdgcn_s_sleep(1); \
    if ((++_sp & 255u) == 0u) { if (xb_ld(&(bar)[XB_TMO])) break; if (_sp > XB_SPIN_CAP) { (void)xb_add(&(bar)[XB_TMO], 1u); break; } } } } while (0)
struct XcdBarrier { GAS unsigned* bar; unsigned x; volatile LAS unsigned* st; int wave; };
__device__ __forceinline__ XcdBarrier xcd_barrier_post(GAS unsigned* bar, volatile LAS unsigned* st) {
    XcdBarrier b; b.bar = bar; b.x = xb_xcc_id(); b.st = st;
    if (threadIdx.x == 0) (void)xb_add(&bar[XB_XCNT(b.x)], 1u);
    return b;
}
__device__ __forceinline__ void xcd_barrier_complete(GAS unsigned* bar, unsigned x, unsigned& nloc, unsigned& nx) {
    const unsigned G = gridDim.x * gridDim.y * gridDim.z;
    unsigned sum, cnt, mine, sp = 0u;
    for (;;) {
        sum = 0u; cnt = 0u; mine = 0u;
#pragma unroll
        for (unsigned j = 0; j < 16; ++j) { const unsigned c = xb_ld(&bar[XB_XCNT(j)]); sum += c; cnt += (c > 0u) ? 1u : 0u; mine = (j == x) ? c : mine; }
        if (sum == G) break;
        __builtin_amdgcn_s_sleep(1);
        if ((++sp & 255u) == 0u) { if (xb_ld(&bar[XB_TMO])) break; if (sp > XB_SPIN_CAP) { (void)xb_add(&bar[XB_TMO], 1u); break; } }
    }
    nloc = mine > 0u ? mine : 1u; nx = cnt > 0u ? cnt : 1u;
}
__device__ __forceinline__ void xcd_barrier(const XcdBarrier& b) {
    asm volatile("s_waitcnt vmcnt(0)" ::: "memory");
    __syncthreads();
    if (b.wave == 0 && lane_id() == 0) {
        GAS unsigned* bar = b.bar; asm volatile("" : "+s"(bar));
        const unsigned bx = xb_xcc_id();
        __builtin_amdgcn_s_waitcnt(0);
        unsigned nloc = b.st[0], nx = b.st[1];
        if (nloc == 0u) { xcd_barrier_complete(bar, bx, nloc, nx); b.st[0] = nloc; b.st[1] = nx; }
        const unsigned old = xb_add(&bar[XB_XSUB(bx)], 1u);
        const unsigned gen = old / nloc;
        if (old + 1u == (gen + 1u) * nloc) {
            __builtin_amdgcn_fence(__ATOMIC_RELEASE, "agent");
            asm volatile("s_waitcnt vmcnt(0)" ::: "memory");
            const unsigned og = xb_add(&bar[XB_TOP], 1u);
            const unsigned tg = og / nx;
            if (og + 1u == (tg + 1u) * nx) xb_add(&bar[XB_TOPGEN], 1u);
            else XB_SPIN(xb_ld(&bar[XB_TOPGEN]) == tg, bar);
            __builtin_amdgcn_fence(__ATOMIC_ACQUIRE, "agent");
            xb_add(&bar[XB_XGEN(bx)], 1u);
            asm volatile("s_waitcnt vmcnt(0)" ::: "memory");
        } else {
            XB_SPIN(xb_ld(&bar[XB_XGEN(bx)]) == gen, bar);
            __builtin_amdgcn_fence(__ATOMIC_ACQUIRE, "agent");
            asm volatile("s_waitcnt vmcnt(0)" ::: "memory");
        }
    }
    __syncthreads();
}

struct Args { const GAS float* in[14]; GAS float* out; GAS unsigned char* ws; };
struct Frame {
    LAS unsigned char* lds; int tid, lane, wave, vcu, G;
    const GAS float *x, *c, *rel_bias, *w_mod, *b_mod, *norm_mix, *norm_mlp, *w_pool, *pool_scale, *w_qkv, *w_o, *w_up, *w_down, *norm_final;
    GAS float* out; GAS unsigned char* ws;
};
__device__ __forceinline__ float wave_sum(float v) {
#pragma unroll
    for (int o = 1; o < 64; o <<= 1) v += __shfl_xor(v, o);
    return v;
}

struct TItem { const GAS float* W; GAS bf16* WT; int K, N, row_off, item; };
__device__ __forceinline__ void tload(const TItem& I, f32x4 (&t)[8], int lane) {
    const int nblk = I.N / 32, kb = I.item / nblk, nb = I.item % nblk, k0 = 64 * kb, n0 = 32 * nb;
#pragma unroll
    for (int i = 0; i < 8; ++i) t[i] = __builtin_nontemporal_load((const GAS f32x4*)(I.W + (size_t)(k0 + 8 * i + (lane >> 3)) * I.N + n0 + 4 * (lane & 7)));
}
__device__ __forceinline__ void tstore(const TItem& I, const f32x4 (&t)[8], LAS float* scr, int lane) {
    const int nblk = I.N / 32, kb = I.item / nblk, nb = I.item % nblk, k0 = 64 * kb, n0 = 32 * nb;
#pragma unroll
    for (int i = 0; i < 8; ++i) { LAS float* d = scr + (8 * i + (lane >> 3)) * 33 + 4 * (lane & 7); d[0] = t[i][0]; d[1] = t[i][1]; d[2] = t[i][2]; d[3] = t[i][3]; }
    LDS_WAIT(); asm volatile("" ::: "memory");
    const int c = lane & 7;
#pragma unroll
    for (int j = 0; j < 4; ++j) { const int n = (lane >> 3) + 8 * j; const LAS float* s = scr + (8 * c) * 33 + n;
        v4u o; o.x = pk2(s[0 * 33], s[1 * 33]); o.y = pk2(s[2 * 33], s[3 * 33]); o.z = pk2(s[4 * 33], s[5 * 33]); o.w = pk2(s[6 * 33], s[7 * 33]);
        *(GAS v4u*)(I.WT + (size_t)(I.row_off + n0 + n) * I.K + k0 + 8 * c) = o; }
    LDS_WAIT(); asm volatile("" ::: "memory");
}
__device__ __forceinline__ void p0_prologue(Frame& F) {
    if (F.vcu < 192) {
        LAS float* cact = (LAS float*)(F.lds + 67584);
        LAS float* red = (LAS float*)(F.lds + 67584 + 16384);
        const int l = F.vcu / 96, j0 = (F.vcu % 96) * 64;
        for (int i = F.tid; i < 4096; i += NWAVES * 64) { const float v = F.c[i]; cact[i] = v / (1.f + __expf(-v)); }
        __syncthreads();
        const int sub = F.lane >> 4, c4 = F.lane & 15;
        f32x4 a0 = {0.f, 0.f, 0.f, 0.f}, a1 = a0, a2 = a0, a3 = a0;
        const GAS float* wb = F.w_mod + (size_t)l * 1024 * 6144 + j0 + 4 * c4;
#pragma unroll
        for (int it = 0; it < 32; ++it) { const int k = 32 * it + 4 * F.wave + sub; const f32x4 wv = __builtin_nontemporal_load((const GAS f32x4*)(wb + (size_t)k * 6144));
            a0 += wv * cact[k]; a1 += wv * cact[1024 + k]; a2 += wv * cact[2048 + k]; a3 += wv * cact[3072 + k]; }
#pragma unroll
        for (int j = 0; j < 4; ++j) { a0[j] += __shfl_xor(a0[j], 16); a0[j] += __shfl_xor(a0[j], 32); a1[j] += __shfl_xor(a1[j], 16); a1[j] += __shfl_xor(a1[j], 32);
            a2[j] += __shfl_xor(a2[j], 16); a2[j] += __shfl_xor(a2[j], 32); a3[j] += __shfl_xor(a3[j], 16); a3[j] += __shfl_xor(a3[j], 32); }
        if (sub == 0) { LAS f32x4* r4 = (LAS f32x4*)(red + F.wave * 256); r4[0 * 16 + c4] = a0; r4[1 * 16 + c4] = a1; r4[2 * 16 + c4] = a2; r4[3 * 16 + c4] = a3; }
        __syncthreads();
        if (F.tid < 256) { const int b = F.tid >> 6, col = F.tid & 63; float s = 0.f;
#pragma unroll
            for (int w = 0; w < 8; ++w) s += red[w * 256 + b * 64 + col];
            ((GAS float*)(F.ws + WS_MOD))[(l * 4 + b) * 6144 + j0 + col] = s + F.b_mod[l * 6144 + j0 + col]; }
    }
    LAS float* scr = (LAS float*)(F.lds + RING_OFF + F.wave * 8448);
    const int gw = F.vcu * NWAVES + F.wave, NGW = F.G * NWAVES;
    constexpr int I_POOL = 4 * 32, I_QKV = 16 * 96, I_O = 16 * 32, I_UP = 16 * 128, I_DN = 64 * 32;
    constexpr int NITEMS = I_POOL + I_QKV + I_O + 2 * I_UP + 2 * I_DN;
    auto desc = [&](int it) -> TItem {
        int r = it;
        if (r < I_POOL) { const int g = r / 32; return TItem{F.w_pool + (size_t)g * 65536, (GAS bf16*)(F.ws + WS_WPOOL), 256, 256, g * 256, r % 32}; } r -= I_POOL;
        if (r < I_QKV) return TItem{F.w_qkv, (GAS bf16*)(F.ws + WS_WQKV), D, NQKV, 0, r}; r -= I_QKV;
        if (r < I_O) return TItem{F.w_o, (GAS bf16*)(F.ws + WS_WO), D, D, 0, r}; r -= I_O;
        if (r < 2 * I_UP) { const int l = r / I_UP; return TItem{F.w_up + (size_t)l * D * FF, (GAS bf16*)(F.ws + (l ? WS_WUP1 : WS_WUP0)), D, FF, 0, r % I_UP}; } r -= 2 * I_UP;
        const int l = r / I_DN; return TItem{F.w_down + (size_t)l * FF * D, (GAS bf16*)(F.ws + (l ? WS_WDN1 : WS_WDN0)), FF, D, 0, r % I_DN};
    };
    f32x4 ta[8], tb[8], tc[8], td[8];
    int it = gw;
    if (it < NITEMS) { TItem c0 = desc(it), c1 = c0; bool h1 = it + NGW < NITEMS; tload(c0, ta, F.lane); if (h1) { c1 = desc(it + NGW); tload(c1, tb, F.lane); }
        for (;;) {
            const int i2 = it + 2 * NGW, i3 = it + 3 * NGW; const bool h2 = i2 < NITEMS, h3 = i3 < NITEMS; TItem n0 = c0, n1 = c1;
            if (h2) { n0 = desc(i2); tload(n0, tc, F.lane); }
            if (h3) { n1 = desc(i3); tload(n1, td, F.lane); }
            tstore(c0, ta, scr, F.lane);
            if (h1) tstore(c1, tb, scr, F.lane);
            if (!h2) break;
#pragma unroll
            for (int i = 0; i < 8; ++i) { ta[i] = tc[i]; tb[i] = td[i]; }
            c0 = n0; c1 = n1; h1 = h3; it = i2;
        } }
}

__device__ __forceinline__ void p1_bias(Frame& F, int seg_lo, int seg_hi) {
    int lane = lane_id(); asm volatile("" : "+v"(lane));
    const int gw = F.vcu * NWAVES + F.wave, NGW = F.G * NWAVES;
    const GAS float* MOD = (const GAS float*)(F.ws + WS_MOD);
#pragma unroll 1
    for (int seg = seg_lo; seg < seg_hi; ++seg) {
        const GAS bf16* wt; const GAS float* sh; GAS float* dst; int N; GAS bf16* wsc; const GAS float* gam;
        if (seg == 0) { N = 4096; wt = (const GAS bf16*)(F.ws + WS_WUP0); sh = MOD + 3072; dst = (GAS float*)(F.ws + WS_BIAS_UP0); wsc = (GAS bf16*)(F.ws + WS_WSUP0); gam = F.norm_mlp; }
        else if (seg == 1) { N = 3072; wt = (const GAS bf16*)(F.ws + WS_WQKV); sh = MOD + 4 * 6144; dst = (GAS float*)(F.ws + WS_BIAS_QKV); wsc = (GAS bf16*)((GAS unsigned char*)F.out + OUT_WSQKV); gam = F.norm_mix + D; }
        else { N = 4096; wt = (const GAS bf16*)(F.ws + WS_WUP1); sh = MOD + 4 * 6144 + 3072; dst = (GAS float*)(F.ws + WS_BIAS_UP1); wsc = (GAS bf16*)(F.ws + WS_WSUP1); gam = F.norm_mlp + D; }
        int n = gw; if (n >= N) continue;
        float shv[4][16], gv[4][16];
#pragma unroll
        for (int b = 0; b < 4; ++b) { const GAS f32x4* sp = (const GAS f32x4*)(sh + b * 6144 + lane * 16); const GAS f32x4* cp = (const GAS f32x4*)(sh + 1024 + b * 6144 + lane * 16); const GAS f32x4* gp = (const GAS f32x4*)(gam + lane * 16);
#pragma unroll
            for (int j = 0; j < 4; ++j) { const f32x4 sv = sp[j], cv = cp[j], g4 = gp[j];
#pragma unroll
                for (int i = 0; i < 4; ++i) { shv[b][4 * j + i] = sv[i]; gv[b][4 * j + i] = g4[i] * (1.0f + cv[i]); } } }
        v4u w0 = *(const GAS v4u*)(wt + (size_t)n * 1024 + lane * 16), w1 = *(const GAS v4u*)(wt + (size_t)n * 1024 + lane * 16 + 8);
        for (;;) {
            const int nn = n + NGW; const bool hn = nn < N; v4u x0 = w0, x1 = w1;
            if (hn) { x0 = *(const GAS v4u*)(wt + (size_t)nn * 1024 + lane * 16); x1 = *(const GAS v4u*)(wt + (size_t)nn * 1024 + lane * 16 + 8); }
            float wf[16];
#pragma unroll
            for (int j = 0; j < 4; ++j) { wf[2 * j] = __builtin_bit_cast(float, w0[j] << 16); wf[2 * j + 1] = __builtin_bit_cast(float, w0[j] & 0xffff0000u);
                wf[8 + 2 * j] = __builtin_bit_cast(float, w1[j] << 16); wf[8 + 2 * j + 1] = __builtin_bit_cast(float, w1[j] & 0xffff0000u); }
#pragma unroll
            for (int b = 0; b < 4; ++b) { float s = 0.f;
#pragma unroll
                for (int i = 0; i < 16; ++i) s += wf[i] * shv[b][i];
                s = wave_sum(s); if (lane == 0) dst[b * N + n] = s;
                unsigned pk[8];
#pragma unroll
                for (int i = 0; i < 8; ++i) pk[i] = pg8::cvt_pk_bf16(wf[2 * i] * gv[b][2 * i], wf[2 * i + 1] * gv[b][2 * i + 1]);
                GAS v4u* wp = (GAS v4u*)(wsc + ((size_t)b * N + n) * 1024 + lane * 16);
                wp[0] = (v4u){pk[0], pk[1], pk[2], pk[3]}; wp[1] = (v4u){pk[4], pk[5], pk[6], pk[7]}; }
            if (!hn) break;
            w0 = x0; w1 = x1; n = nn;
        }
    }
}
__device__ __forceinline__ void p1_pool(Frame& F) {
    LAS float* ring = (LAS float*)(F.lds + RING_OFF);
    const GAS float* MOD = (const GAS float*)(F.ws + WS_MOD); GAS bf16* XN = (GAS bf16*)(F.ws + WS_XNA); GAS bf16* XR = (GAS bf16*)(F.ws + WS_XR);
    for (int run = F.vcu; run < M / 128; run += F.G) {
        const int t0 = run * 128, s0 = t0 % SEQ, b = t0 / SEQ;
        f32x4 gam[4];
#pragma unroll
        for (int j = 0; j < 4; ++j) gam[j] = *(const GAS f32x4*)(F.norm_mix + 4 * (F.lane + 64 * j));
        const int c4 = F.tid & 255, rh = F.tid >> 8, gi = c4 >> 6, w = 2 << gi;
        const f32x4 sc1 = *(const GAS f32x4*)(MOD + b * 6144 + 1024 + 4 * c4) + 1.0f;
        f32x4 v[2][4];
        const GAS float* xb = F.x + (size_t)b * SEQ * D + 4 * F.lane;
        int st = (s0 > 0 ? -1 : 0);
#pragma unroll
        for (int rr = 0; rr < 2; ++rr)
#pragma unroll
            for (int j = 0; j < 4; ++j) v[rr][j] = __builtin_nontemporal_load((const GAS f32x4*)(xb + (size_t)(s0 + 16 * st + 2 * F.wave + rr) * D + 256 * j));
        for (; st < 8; ++st) {
            if (st >= 0) {
#pragma unroll
                for (int rr = 0; rr < 2; ++rr)
#pragma unroll
                    for (int j = 0; j < 4; ++j) { v2u o2; o2.x = pk2(v[rr][j][0], v[rr][j][1]); o2.y = pk2(v[rr][j][2], v[rr][j][3]);
                        { const size_t trow = (size_t)b * SEQ + s0 + 16 * st + 2 * F.wave + rr; *(GAS v2u*)(XR + (((trow >> 8) * 4 + j) * 256 + (trow & 255)) * 256 + 4 * F.lane) = o2; } } }
            float ss0 = 0.f, ss1 = 0.f;
#pragma unroll
            for (int j = 0; j < 4; ++j) { ss0 += (v[0][j][0] * v[0][j][0] + v[0][j][1] * v[0][j][1]) + (v[0][j][2] * v[0][j][2] + v[0][j][3] * v[0][j][3]);
                ss1 += (v[1][j][0] * v[1][j][0] + v[1][j][1] * v[1][j][1]) + (v[1][j][2] * v[1][j][2] + v[1][j][3] * v[1][j][3]); }
#pragma unroll
            for (int o = 1; o < 64; o <<= 1) { ss0 += __shfl_xor(ss0, o); ss1 += __shfl_xor(ss1, o); }
            const float rs0 = rsqrtf(ss0 * (1.0f / D) + EPS), rs1 = rsqrtf(ss1 * (1.0f / D) + EPS);
            { const int sr = s0 + 16 * st + 2 * F.wave;
#pragma unroll
              for (int j = 0; j < 4; ++j) { *(LAS f32x4*)(ring + (sr & 31) * 1024 + 4 * (F.lane + 64 * j)) = v[0][j] * rs0 * gam[j]; *(LAS f32x4*)(ring + ((sr + 1) & 31) * 1024 + 4 * (F.lane + 64 * j)) = v[1][j] * rs1 * gam[j]; } }
            if (st + 1 < 8) {
#pragma unroll
                for (int rr = 0; rr < 2; ++rr)
#pragma unroll
                    for (int j = 0; j < 4; ++j) v[rr][j] = __builtin_nontemporal_load((const GAS f32x4*)(xb + (size_t)(s0 + 16 * (st + 1) + 2 * F.wave + rr) * D + 256 * j)); }
            __syncthreads();
            if (st >= 0) {
                const int sA = s0 + 16 * st + 8 * rh;
                f32x4 sum = {0.f, 0.f, 0.f, 0.f};
                { const int cnt0 = (sA < w) ? sA : w; for (int i = 1; i <= cnt0; ++i) sum += *(const LAS f32x4*)(ring + ((sA - i) & 31) * 1024 + 4 * c4); }
#pragma unroll
                for (int r = 0; r < 8; ++r) { const int s = sA + r; const f32x4 cur = *(const LAS f32x4*)(ring + (s & 31) * 1024 + 4 * c4);
                    sum += cur; if (s >= w) sum -= *(const LAS f32x4*)(ring + ((s - w) & 31) * 1024 + 4 * c4);
                    const float inv = 1.0f / (float)((s + 1 < w) ? s + 1 : w);
                    const f32x4 p = (sum * inv - cur) * sc1;
                    v2u o; o.x = pk2(p[0], p[1]); o.y = pk2(p[2], p[3]);
                    *(GAS v2u*)(XN + ((size_t)b * SEQ + s) * D + 4 * c4) = o; }
            }
            __syncthreads();
        }
    }
}

__device__ __forceinline__ int t5_bucket(int dist) {
    if (dist < 16) return dist;
    int b = 16;
    b += (dist >= 21); b += (dist >= 27); b += (dist >= 35); b += (dist >= 46); b += (dist >= 59); b += (dist >= 77); b += (dist >= 99); b += (dist >= 128);
    b += (dist >= 166); b += (dist >= 216); b += (dist >= 280); b += (dist >= 363); b += (dist >= 470); b += (dist >= 609); b += (dist >= 790);
    return b;
}
namespace att {
typedef short bf16x8 __attribute__((ext_vector_type(8)));
typedef short s16x4 __attribute__((ext_vector_type(4)));
typedef short v4i16_t __attribute__((ext_vector_type(4)));
typedef float f32x16 __attribute__((ext_vector_type(16)));
typedef float f32x2_t __attribute__((ext_vector_type(2)));
typedef __bf16 bf16x2_t __attribute__((ext_vector_type(2)));
typedef LAS const char* lds_cptr;
constexpr int L_K = 0, L_V = 32768, L_LUT = 132096, L_QI = 141312, L_CUM = 142336, L_PRE = 142592;
constexpr int LUTN = 2304;
__device__ __forceinline__ int crow(int r, int hi) { return (r & 3) + 8 * (r >> 2) + 4 * hi; }
__device__ __forceinline__ unsigned cvtpk(float lo, float hi) { f32x2_t v = {lo, hi}; bf16x2_t b = __builtin_convertvector(v, bf16x2_t); return __builtin_bit_cast(unsigned, b); }
__device__ __forceinline__ s16x4 vtr(lds_cptr p) { return __builtin_bit_cast(s16x4, __builtin_amdgcn_ds_read_tr16_b64_v4i16((LAS v4i16_t*)p)); }
__device__ __forceinline__ float swap_add(float v) { auto rr = __builtin_amdgcn_permlane32_swap(__float_as_uint(v), __float_as_uint(v), false, false); return __uint_as_float(rr[0]) + __uint_as_float(rr[1]); }

__device__ __forceinline__ void load_kv(LAS unsigned char* lds, const GAS bf16* Kb, const GAS bf16* Vb, int b, int h, int n, int w, int lane) {
#pragma unroll
    for (int t = 0; t < 4; ++t) {
        const size_t kr = (size_t)b * SEQ + n * BLK + 64 * t + lane, vr = (size_t)b * SEQ + n * BLK + 64 * t + 16 * (w & 3) + (lane >> 2);
        const v4u kv = *(const GAS v4u*)(Kb + hm_off(kr, b, h) + w * 8);
        const v4u vv = *(const GAS v4u*)(Vb + hm_off(vr, b, h) + (w >> 2) * 32 + (lane & 3) * 8);
        *(LAS v4u*)(lds + L_K + t * 8192 + w * 1024 + lane * 16) = kv;
        *(LAS v4u*)(lds + L_V + t * 8192 + w * 1024 + lane * 16) = vv;
    }
}
__device__ __forceinline__ void build_lut(LAS unsigned char* lds, const GAS float* rel_bias, int h, int tid) {
    for (int i = tid; i < LUTN; i += NWAVES * 64) ((LAS float*)(lds + L_LUT))[i] = (i <= 2047) ? rel_bias[t5_bucket(2047 - i) * NH + h] * LOG2E : 0.f;
}
__device__ __forceinline__ void qk_tile(f32x16& p0, f32x16& p1, lds_cptr Kt, const bf16x8* qr, const f32x16& cinit, int r32, int hi) {
    const unsigned kb0 = (unsigned)(r32 * 128 + ((hi ^ ((r32 >> 1) & 7)) * 16));
#pragma unroll
    for (int d0 = 0; d0 < 4; ++d0) {
        const bf16x8 b0 = *(LAS const bf16x8*)(Kt + (kb0 ^ (unsigned)(d0 * 32))), b1 = *(LAS const bf16x8*)(Kt + (kb0 ^ (unsigned)(d0 * 32)) + 4096);
        if (d0 == 0) { p0 = __builtin_amdgcn_mfma_f32_32x32x16_bf16(b0, qr[0], cinit, 0, 0, 0); p1 = __builtin_amdgcn_mfma_f32_32x32x16_bf16(b1, qr[0], cinit, 0, 0, 0); }
        else { p0 = __builtin_amdgcn_mfma_f32_32x32x16_bf16(b0, qr[d0], p0, 0, 0, 0); p1 = __builtin_amdgcn_mfma_f32_32x32x16_bf16(b1, qr[d0], p1, 0, 0, 0); }
    }
}
template <bool BIAS, bool MASK>
__device__ __forceinline__ void softmax_tile(f32x16& p0, f32x16& p1, LAS const float* lutp, int jt, int qrel, int hi, float& l, v4u* pa) {
#pragma unroll
    for (int r = 0; r < 16; ++r) { const int ko = 64 * jt + (r & 3) + 8 * (r >> 2);
        if (BIAS) { p0[r] += lutp[ko]; p1[r] += lutp[ko + 32]; }
        if (MASK) { const int kv = ko + 4 * hi; if (kv > qrel) p0[r] = -INFINITY; if (kv + 32 > qrel) p1[r] = -INFINITY; }
        p0[r] = __builtin_amdgcn_exp2f(p0[r]); p1[r] = __builtin_amdgcn_exp2f(p1[r]); }
    float s = 0.f;
#pragma unroll
    for (int r = 0; r < 16; ++r) s += p0[r] + p1[r];
    l += s;
    pa[0] = (v4u){cvtpk(p0[0], p0[1]), cvtpk(p0[2], p0[3]), cvtpk(p0[4], p0[5]), cvtpk(p0[6], p0[7])};
    pa[1] = (v4u){cvtpk(p0[8], p0[9]), cvtpk(p0[10], p0[11]), cvtpk(p0[12], p0[13]), cvtpk(p0[14], p0[15])};
    pa[2] = (v4u){cvtpk(p1[0], p1[1]), cvtpk(p1[2], p1[3]), cvtpk(p1[4], p1[5]), cvtpk(p1[6], p1[7])};
    pa[3] = (v4u){cvtpk(p1[8], p1[9]), cvtpk(p1[10], p1[11]), cvtpk(p1[12], p1[13]), cvtpk(p1[14], p1[15])};
}
__device__ __forceinline__ void pv_tile(f32x16* o, lds_cptr Vt, unsigned vo0, const v4u* pa) {
#pragma unroll
    for (int d0 = 0; d0 < 2; ++d0)
#pragma unroll
        for (int ks = 0; ks < 4; ++ks) { const s16x4 lo = vtr(Vt + (vo0 ^ (unsigned)(d0 * 64)) + ks * 2048), hi = vtr(Vt + (vo0 ^ (unsigned)(d0 * 64)) + ks * 2048 + 1024);
            const bf16x8 vf = (bf16x8){lo[0], lo[1], lo[2], lo[3], hi[0], hi[1], hi[2], hi[3]};
            o[d0] = __builtin_amdgcn_mfma_f32_32x32x16_bf16(vf, __builtin_bit_cast(bf16x8, pa[ks]), o[d0], 0, 0, 0); }
}
__device__ __forceinline__ void qk_half(f32x16& p, lds_cptr Kt, int s, const bf16x8* qr, const f32x16& cinit, int r32, int hi) {
    lds_cptr kb = Kt + hi * 1024 + r32 * 16 + s * 512;
#pragma unroll
    for (int d0 = 0; d0 < 4; ++d0) { const bf16x8 b0 = *(LAS const bf16x8*)(kb + d0 * 2048);
        if (d0 == 0) p = __builtin_amdgcn_mfma_f32_32x32x16_bf16(b0, qr[0], cinit, 0, 0, 0); else p = __builtin_amdgcn_mfma_f32_32x32x16_bf16(b0, qr[d0], p, 0, 0, 0); }
}
template <bool BIAS>
__device__ __forceinline__ void softmax_half(f32x16& p, LAS const float* lutp, int jt, int s, float& l, v4u& pa0, v4u& pa1) {
#pragma unroll
    for (int r = 0; r < 16; ++r) { const int ko = 64 * jt + 32 * s + (r & 3) + 8 * (r >> 2);
        if (BIAS) p[r] += lutp[ko];
        p[r] = __builtin_amdgcn_exp2f(p[r]); }
    float sm = 0.f;
#pragma unroll
    for (int r = 0; r < 16; ++r) sm += p[r];
    l += sm;
    pa0 = (v4u){cvtpk(p[0], p[1]), cvtpk(p[2], p[3]), cvtpk(p[4], p[5]), cvtpk(p[6], p[7])};
    pa1 = (v4u){cvtpk(p[8], p[9]), cvtpk(p[10], p[11]), cvtpk(p[12], p[13]), cvtpk(p[14], p[15])};
}
__device__ __forceinline__ void pv_half(f32x16* o, lds_cptr vp, int s, const v4u& pa0, const v4u& pa1) {
#pragma unroll
    for (int d0 = 0; d0 < 2; ++d0)
#pragma unroll
        for (int kk = 0; kk < 2; ++kk) { const int ks = 2 * s + kk; const s16x4 lo = vtr(vp + d0 * 4096 + ks * 1024), hi = vtr(vp + d0 * 4096 + ks * 1024 + 512);
            const bf16x8 vf = (bf16x8){lo[0], lo[1], lo[2], lo[3], hi[0], hi[1], hi[2], hi[3]};
            o[d0] = __builtin_amdgcn_mfma_f32_32x32x16_bf16(vf, __builtin_bit_cast(bf16x8, kk ? pa1 : pa0), o[d0], 0, 0, 0); }
}
struct SlotD { int kind, t, idx; };
__device__ __forceinline__ constexpr SlotD slot_desc(int g) {
    if (g < 4) return SlotD{0, 0, g};
    if (g < 8) return SlotD{0, 1, g - 4};
    if (g < 56) { const int tt = (g - 8) / 8 + 1, i = (g - 8) % 8; return (i & 1) ? SlotD{1, tt - 1, i >> 1} : SlotD{0, tt + 1, i >> 1}; }
    if (g < 60) return SlotD{1, 6, g - 56};
    return SlotD{1, 7, g - 60};
}
template <bool BIAS>
struct TileMath {
    f32x16 P[2]; unsigned pk[2][8]; v4u fr[3]; f32x2_t lv[4]; float e0, e1, l0, l1;
    f32x16* o; lds_cptr Kl, Vl; unsigned kb0, vo0; const bf16x8* qr; const f32x16* cinit; LAS const float* lutp;
    template <int G> __device__ __forceinline__ v4u load_frag() { constexpr SlotD d = slot_desc(G);
        if (d.kind == 0) return *(LAS const v4u*)(Kl + (kb0 ^ (unsigned)(d.idx * 32)) + (d.t >> 1) * 8192 + (d.t & 1) * 4096);
        constexpr int d0 = d.idx >> 1, ks = 2 * (d.t & 1) + (d.idx & 1); lds_cptr vp = Vl + (vo0 ^ (unsigned)(d0 * 64)) + (d.t >> 1) * 8192 + ks * 2048;
        const s16x4 a = vtr(vp), c = vtr(vp + 1024); return __builtin_bit_cast(v4u, (bf16x8){a[0], a[1], a[2], a[3], c[0], c[1], c[2], c[3]}); }
    template <int Q> __device__ __forceinline__ f32x2_t lut_pair() { constexpr int t = Q >> 3, r0 = 2 * (Q & 7), ko = 64 * (t >> 1) + 32 * (t & 1) + (r0 & 3) + 8 * (r0 >> 2); return (f32x2_t){lutp[ko], lutp[ko + 1]}; }
    template <int Q> __device__ __forceinline__ void chunk() { constexpr int t = Q >> 3, c = Q & 7;
        if constexpr (Q > 0) { l0 += e0; l1 += e1; pk[((Q - 1) >> 3) & 1][(Q - 1) & 7] = cvtpk(e0, e1); }
        float x0 = P[t & 1][2 * c], x1 = P[t & 1][2 * c + 1];
        if constexpr (BIAS) { x0 += lv[Q & 3][0]; x1 += lv[Q & 3][1]; if constexpr (Q + 3 < 64) lv[(Q + 3) & 3] = lut_pair<Q + 3>(); }
        e0 = __builtin_amdgcn_exp2f(x0); e1 = __builtin_amdgcn_exp2f(x1); }
    template <int G> __device__ __forceinline__ void slot() {
        if constexpr (G + 2 < 64) fr[(G + 2) % 3] = load_frag<G + 2>();
        { constexpr SlotD d = slot_desc(G); const bf16x8 a = __builtin_bit_cast(bf16x8, fr[G % 3]);
          if constexpr (d.kind == 0) { if constexpr (d.idx == 0) P[d.t & 1] = __builtin_amdgcn_mfma_f32_32x32x16_bf16(a, qr[0], *cinit, 0, 0, 0); else P[d.t & 1] = __builtin_amdgcn_mfma_f32_32x32x16_bf16(a, qr[d.idx], P[d.t & 1], 0, 0, 0); }
          else { constexpr int d0 = d.idx >> 1, kk = d.idx & 1;
              o[d0] = __builtin_amdgcn_mfma_f32_32x32x16_bf16(a, __builtin_bit_cast(bf16x8, (v4u){pk[d.t & 1][4 * kk], pk[d.t & 1][4 * kk + 1], pk[d.t & 1][4 * kk + 2], pk[d.t & 1][4 * kk + 3]}), o[d0], 0, 0, 0); } }
        if constexpr (G >= 4 && G < 8) { chunk<2 * (G - 4)>(); chunk<2 * (G - 4) + 1>(); }
        else if constexpr (G >= 8 && G < 56) chunk<G>();
        else if constexpr (G >= 56 && G < 60) { chunk<56 + 2 * (G - 56)>(); chunk<56 + 2 * (G - 56) + 1>(); if constexpr (G == 59) { l0 += e0; l1 += e1; pk[1][7] = cvtpk(e0, e1); } }
        __builtin_amdgcn_sched_barrier(0);
    }
    template <int... G> __device__ __forceinline__ void run(std::integer_sequence<int, G...>) { (slot<G>(), ...); }
};
template <bool BIAS>
__device__ __forceinline__ void tile_math(f32x16* o, float& l, lds_cptr Kl, lds_cptr Vl, unsigned vo0, const bf16x8* qr, const f32x16& cinit, LAS const float* lutp, int r32, int hi) {
    TileMath<BIAS> T; T.o = o; T.Kl = Kl; T.kb0 = (unsigned)(r32 * 128 + ((hi ^ ((r32 >> 1) & 7)) * 16)); T.Vl = Vl; T.vo0 = vo0; T.qr = qr; T.cinit = &cinit; T.lutp = lutp; T.e0 = T.e1 = T.l0 = T.l1 = 0.f;
    if constexpr (BIAS) { T.lv[0] = T.template lut_pair<0>(); T.lv[1] = T.template lut_pair<1>(); T.lv[2] = T.template lut_pair<2>(); }
    T.fr[0] = T.template load_frag<0>(); T.fr[1] = T.template load_frag<1>();
    __builtin_amdgcn_sched_barrier(0);
    T.run(std::make_integer_sequence<int, 64>{});
    l += T.l0 + T.l1;
}
__device__ __forceinline__ void load_q_raw(bf16x8* qr, const GAS bf16* Qb, size_t qrow, int b, int h, int hi) {
#pragma unroll
    for (int d0 = 0; d0 < 4; ++d0) { const v4u v = *(const GAS v4u*)(Qb + hm_off(qrow, b, h) + d0 * 16 + hi * 8); qr[d0] = __builtin_bit_cast(bf16x8, v); }
}
__device__ __forceinline__ float q_norm2(const bf16x8* qr) {
    float q2 = 0.f;
#pragma unroll
    for (int d0 = 0; d0 < 4; ++d0) { const v4u v = __builtin_bit_cast(v4u, qr[d0]);
#pragma unroll
        for (int j = 0; j < 4; ++j) { const float a = __builtin_bit_cast(float, v[j] << 16), c = __builtin_bit_cast(float, v[j] & 0xffff0000u); q2 += a * a + c * c; } }
    return swap_add(q2);
}

__device__ __forceinline__ float ref_exponent(float q2, float kmax2, float bmax) { return __builtin_sqrtf(q2 * kmax2) * 1.002f + bmax + 0.01f; }
__device__ __forceinline__ void head_bounds(const GAS float* KBM, const GAS float* rel_bias, int bh, int h, int lane, float& kmax2, float& bmax) {
    const GAS f32x4* kq = (const GAS f32x4*)(KBM + (bh * 32 + (lane & 31)) * 8); const f32x4 ka = kq[0], kc = kq[1];
    float k = (((ka[0] + ka[1]) + (ka[2] + ka[3])) + ((kc[0] + kc[1]) + (kc[2] + kc[3]))) * 1.008f, bb = rel_bias[(lane & 31) * NH + h] * LOG2E;
#pragma unroll
    for (int o = 1; o < 32; o <<= 1) { k = fmaxf(k, shx(k, o, lane)); bb = fmaxf(bb, shx(bb, o, lane)); }
    kmax2 = k; bmax = bb;
}
template <int CTRL> __device__ __forceinline__ unsigned dpp_q(unsigned v) { return (unsigned)__builtin_amdgcn_update_dpp(0, (int)v, CTRL, 0xf, 0xf, true); }
__device__ __forceinline__ void quad_transpose(v4u* p, int j) {
    const bool jh = (j >> 1) & 1, jl = j & 1;
    v4u a[4];
#pragma unroll
    for (int k = 0; k < 4; ++k)
#pragma unroll
        for (int e = 0; e < 4; ++e) { const unsigned t = dpp_q<0x4E>(p[k ^ 2][e]); a[k][e] = (jh == (bool)((k >> 1) & 1)) ? p[k][e] : t; }
#pragma unroll
    for (int k = 0; k < 4; ++k)
#pragma unroll
        for (int e = 0; e < 4; ++e) { const unsigned t = dpp_q<0xB1>(a[k ^ 1][e]); p[k][e] = (jl == (bool)(k & 1)) ? a[k][e] : t; }
}
template <int K> __device__ __forceinline__ GAS bf16* quad_ptr(const GAS bf16* rowp) {
    const unsigned long long a = (unsigned long long)(size_t)rowp;
    const unsigned lo = dpp_q<85 * K>((unsigned)a), hi = dpp_q<85 * K>((unsigned)(a >> 32));
    return (GAS bf16*)(size_t)(((unsigned long long)hi << 32) | lo);
}
template <bool NT = false>
__device__ __forceinline__ void store_row(GAS bf16* rowp, const f32x16* o, float scale, int hi, int lane) {
    unsigned w0[8], w1[8];
#pragma unroll
    for (int k = 0; k < 4; ++k) { w0[2 * k] = cvtpk(o[0][4 * k] * scale, o[0][4 * k + 1] * scale); w0[2 * k + 1] = cvtpk(o[0][4 * k + 2] * scale, o[0][4 * k + 3] * scale);
        w1[2 * k] = cvtpk(o[1][4 * k] * scale, o[1][4 * k + 1] * scale); w1[2 * k + 1] = cvtpk(o[1][4 * k + 2] * scale, o[1][4 * k + 3] * scale); }
#pragma unroll
    for (int i = 0; i < 8; ++i) { auto r = __builtin_amdgcn_permlane32_swap(w0[i], w1[i], false, false); w0[i] = r[0]; w1[i] = r[1]; }
    v4u p[4];
#pragma unroll
    for (int k = 0; k < 4; ++k) p[k] = (v4u){w0[2 * k], w0[2 * k + 1], w1[2 * k], w1[2 * k + 1]};
    const int j = lane & 3;
    quad_transpose(p, j);
    GAS v4u* d0 = (GAS v4u*)(quad_ptr<0>(rowp) + 32 * hi + 8 * j); GAS v4u* d1 = (GAS v4u*)(quad_ptr<1>(rowp) + 32 * hi + 8 * j);
    GAS v4u* d2 = (GAS v4u*)(quad_ptr<2>(rowp) + 32 * hi + 8 * j); GAS v4u* d3 = (GAS v4u*)(quad_ptr<3>(rowp) + 32 * hi + 8 * j);
    if (NT) { __builtin_nontemporal_store(p[0], d0); __builtin_nontemporal_store(p[1], d1); __builtin_nontemporal_store(p[2], d2); __builtin_nontemporal_store(p[3], d3); }
    else { *d0 = p[0]; *d1 = p[1]; *d2 = p[2]; *d3 = p[3]; }
}
template <bool NT = false>
__device__ __forceinline__ void add_row(f32x16* o, const GAS bf16* rowp, int hi, int lane) {
    v4u v[4]; const int j = lane & 3;
    const GAS v4u* s0 = (const GAS v4u*)(quad_ptr<0>(rowp) + 32 * hi + 8 * j); const GAS v4u* s1 = (const GAS v4u*)(quad_ptr<1>(rowp) + 32 * hi + 8 * j);
    const GAS v4u* s2 = (const GAS v4u*)(quad_ptr<2>(rowp) + 32 * hi + 8 * j); const GAS v4u* s3 = (const GAS v4u*)(quad_ptr<3>(rowp) + 32 * hi + 8 * j);
    if (NT) { v[0] = __builtin_nontemporal_load(s0); v[1] = __builtin_nontemporal_load(s1); v[2] = __builtin_nontemporal_load(s2); v[3] = __builtin_nontemporal_load(s3); }
    else { v[0] = *s0; v[1] = *s1; v[2] = *s2; v[3] = *s3; }
    quad_transpose(v, j);
#pragma unroll
    for (int k = 0; k < 4; ++k) { auto r0 = __builtin_amdgcn_permlane32_swap(v[k][0], v[k][2], false, false); auto r1 = __builtin_amdgcn_permlane32_swap(v[k][1], v[k][3], false, false);
        o[0][4 * k] += __builtin_bit_cast(float, r0[0] << 16); o[0][4 * k + 1] += __builtin_bit_cast(float, r0[0] & 0xffff0000u);
        o[0][4 * k + 2] += __builtin_bit_cast(float, r1[0] << 16); o[0][4 * k + 3] += __builtin_bit_cast(float, r1[0] & 0xffff0000u);
        o[1][4 * k] += __builtin_bit_cast(float, r0[1] << 16); o[1][4 * k + 1] += __builtin_bit_cast(float, r0[1] & 0xffff0000u);
        o[1][4 * k + 2] += __builtin_bit_cast(float, r1[1] << 16); o[1][4 * k + 3] += __builtin_bit_cast(float, r1[1] & 0xffff0000u); }
}
__device__ __forceinline__ GAS bf16* po_row(GAS unsigned char* ws, GAS float* outbuf, int b, int h, int t, int slot) {
    return (b < 2 ? (GAS bf16*)outbuf : (GAS bf16*)(ws + WS_POB)) + ((((size_t)((b & 1) * 16 + h) * SEQ + t) * 3 + slot) * 64);
}

__device__ __forceinline__ void glds16(const GAS void* gsrc, unsigned lds_dst) {
    unsigned keep;
    asm volatile("s_mov_b32 %0, m0\n\ts_mov_b32 m0, %2\n\ts_nop 0\n\tglobal_load_lds_dwordx4 %1, off\n\ts_mov_b32 m0, %0" : "=&s"(keep) : "v"(gsrc), "s"(lds_dst) : "memory");
}
struct Top3 { float g1, g2, g3; int i1, i2, i3; };
__device__ __forceinline__ void top3_insert(Top3& T, float g, int n) {
    const bool c1 = g > T.g1, c2 = g > T.g2, c3 = g > T.g3;
    T.g3 = c2 ? T.g2 : (c3 ? g : T.g3); T.i3 = c2 ? T.i2 : (c3 ? n : T.i3);
    T.g2 = c1 ? T.g1 : (c2 ? g : T.g2); T.i2 = c1 ? T.i1 : (c2 ? n : T.i2);
    T.g1 = c1 ? g : T.g1;               T.i1 = c1 ? n : T.i1;
}
__device__ __forceinline__ void top3_insert_tie(Top3& T, float g, int n) {
    const bool ok = n >= 0;
    const bool c1 = ok && (g > T.g1 || (g == T.g1 && n < T.i1) || T.i1 < 0), c2 = ok && (g > T.g2 || (g == T.g2 && n < T.i2) || T.i2 < 0), c3 = ok && (g > T.g3 || (g == T.g3 && n < T.i3) || T.i3 < 0);
    T.g3 = c2 ? T.g2 : (c3 ? g : T.g3); T.i3 = c2 ? T.i2 : (c3 ? n : T.i3);
    T.g2 = c1 ? T.g1 : (c2 ? g : T.g2); T.i2 = c1 ? T.i1 : (c2 ? n : T.i2);
    T.g1 = c1 ? g : T.g1;               T.i1 = c1 ? n : T.i1;
}
__device__ __forceinline__ void route(Frame& F) {
    GAS unsigned char* ws = F.ws;
    const GAS bf16* Qb = (const GAS bf16*)(ws + WS_Q); const GAS bf16* Kb = (const GAS bf16*)(ws + WS_K);
    const GAS float* KMP = (const GAS float*)(ws + WS_KMP);
    GAS unsigned short* SEG = (GAS unsigned short*)(ws + WS_SEG); GAS unsigned* CNT = (GAS unsigned*)(ws + WS_CNT); GAS unsigned* TOT = (GAS unsigned*)(ws + WS_CTL) + CW_TOT;
    int tid = F.wave * 64 + lane_id(); asm volatile("" : "+v"(tid));
    const int hf = tid >> 8, t = tid & 255, lane = tid & 63, w4 = __builtin_amdgcn_readfirstlane((tid >> 6) & 3), r32 = lane & 31, hi = lane >> 5;
    constexpr int HS = 20480;
    LAS unsigned char* hb = F.lds + __builtin_amdgcn_readfirstlane(hf) * HS;
    LAS unsigned* cntw = (LAS unsigned*)(hb + 16384);
    LAS float* kbw = (LAS float*)(hb + 16384 + 512);
    const int ua = (F.vcu * 2 + hf) >> 6, bh = (F.vcu * 2 + hf) & 63, b = bh >> 4, h = bh & 15;
    auto own_of = [&](int it) -> int { return it == 0 ? ua : it == 1 ? 31 - ua : it == 2 ? 8 + ua : 23 - ua; };
    float kmreg[8]; bf16x8 qf[2][4];
    auto prefetch = [&](int own) {
        const size_t row0 = (size_t)b * SEQ + own * BLK + 64 * w4;
#pragma unroll
        for (int tq = 0; tq < 2; ++tq)
#pragma unroll
            for (int d0 = 0; d0 < 4; ++d0) qf[tq][d0] = __builtin_bit_cast(bf16x8, *(const GAS v4u*)(Qb + hm_off(row0 + 32 * tq + r32, b, h) + d0 * 16 + hi * 8));
#pragma unroll
        for (int j = 0; j < 8; ++j) { const int i = t + 256 * j, n = i >> 6, d = i & 63; const size_t o = ((size_t)(b * 32 + n) * 2) * 1024 + h * 64 + d; kmreg[j] = (KMP[o] + KMP[o + 1024]) * (1.0f / 256.0f); }
    };
    prefetch(own_of(0));
    const unsigned fro = (unsigned)(r32 * 128), swz = (unsigned)((r32 >> 1) & 7);
#pragma unroll 1
    for (int it = 0; it < 4; ++it) {
        const int own = own_of(it);
        LAS unsigned char* kmh = hb + (it & 1) * 8192; LAS unsigned char* kml = kmh + 4096;
#pragma unroll
        for (int j = 0; j < 8; ++j) { const int i = t + 256 * j, n = i >> 6, d = i & 63; const float x = kmreg[j];
            const unsigned xb = __builtin_bit_cast(unsigned, x), hb16 = (xb + 0x7fffu + ((xb >> 16) & 1u)) >> 16; const float xh = __builtin_bit_cast(float, hb16 << 16), xl = x - xh;
            const unsigned lb = __builtin_bit_cast(unsigned, xl), lb16 = (lb + 0x7fffu + ((lb >> 16) & 1u)) >> 16;
            const int pos = n * 128 + (((d >> 3) ^ ((n >> 1) & 7)) * 16) + (d & 7) * 2;
            *(LAS unsigned short*)(kmh + pos) = (unsigned short)hb16; *(LAS unsigned short*)(kml + pos) = (unsigned short)lb16; }
        bf16x8 qc[2][4];
#pragma unroll
        for (int tq = 0; tq < 2; ++tq)
#pragma unroll
            for (int d0 = 0; d0 < 4; ++d0) qc[tq][d0] = qf[tq][d0];
        __syncthreads();
        if (it < 3) prefetch(own_of(it + 1));
        f32x16 acc[2]; acc[0] = f32x16{}; acc[1] = f32x16{};
#pragma unroll
        for (int d0 = 0; d0 < 4; ++d0) { const unsigned co = ((unsigned)(2 * d0 + hi) ^ swz) * 16;
            const bf16x8 ah = *(const LAS bf16x8*)(kmh + fro + co), al = *(const LAS bf16x8*)(kml + fro + co);
#pragma unroll
            for (int tq = 0; tq < 2; ++tq) { acc[tq] = __builtin_amdgcn_mfma_f32_32x32x16_bf16(ah, qc[tq][d0], acc[tq], 0, 0, 0); acc[tq] = __builtin_amdgcn_mfma_f32_32x32x16_bf16(al, qc[tq][d0], acc[tq], 0, 0, 0); } }
        Top3 R;
#pragma unroll
        for (int tq = 0; tq < 2; ++tq) { Top3 T{-INFINITY, -INFINITY, -INFINITY, -1, -1, -1};
#pragma unroll
            for (int r = 0; r < 16; ++r) { const int n = crow(r, hi); const float g = acc[tq][r]; top3_insert(T, n < own ? g : -INFINITY, n < own ? n : -1); }
            Top3 P; { auto x1 = __builtin_amdgcn_permlane32_swap(__float_as_uint(T.g1), __float_as_uint(T.g1), false, false); P.g1 = __uint_as_float(hi ? x1[0] : x1[1]);
                      auto x2 = __builtin_amdgcn_permlane32_swap(__float_as_uint(T.g2), __float_as_uint(T.g2), false, false); P.g2 = __uint_as_float(hi ? x2[0] : x2[1]);
                      auto x3 = __builtin_amdgcn_permlane32_swap(__float_as_uint(T.g3), __float_as_uint(T.g3), false, false); P.g3 = __uint_as_float(hi ? x3[0] : x3[1]);
                      auto y1 = __builtin_amdgcn_permlane32_swap((unsigned)T.i1, (unsigned)T.i1, false, false); P.i1 = (int)(hi ? y1[0] : y1[1]);
                      auto y2 = __builtin_amdgcn_permlane32_swap((unsigned)T.i2, (unsigned)T.i2, false, false); P.i2 = (int)(hi ? y2[0] : y2[1]);
                      auto y3 = __builtin_amdgcn_permlane32_swap((unsigned)T.i3, (unsigned)T.i3, false, false); P.i3 = (int)(hi ? y3[0] : y3[1]); }
            top3_insert_tie(T, P.g1, P.i1); top3_insert_tie(T, P.g2, P.i2); top3_insert_tie(T, P.g3, P.i3);
            if (tq == hi) R = T; }
        const int i1 = R.i1, i2 = R.i2, i3 = R.i3;
        unsigned rk1 = 0, rk2 = 0, rk3 = 0;
        for (int n = 0; n < own; ++n) { const bool h1 = i1 == n, h2 = i2 == n, h3 = i3 == n; const unsigned long long mm = __ballot(h1 || h2 || h3);
            const unsigned rank = __builtin_amdgcn_mbcnt_hi((unsigned)(mm >> 32), __builtin_amdgcn_mbcnt_lo((unsigned)mm, 0u));
            rk1 = h1 ? rank : rk1; rk2 = h2 ? rank : rk2; rk3 = h3 ? rank : rk3;
            if (lane == 0) cntw[w4 * 32 + n] = (unsigned)__popcll(mm); }
        __syncthreads();
#pragma unroll
        for (int sl = 0; sl < 3; ++sl) { const int n = sl == 0 ? i1 : sl == 1 ? i2 : i3; const unsigned rk = sl == 0 ? rk1 : sl == 1 ? rk2 : rk3;
            const int nn = n & 31; unsigned base = 0;
#pragma unroll
            for (int w = 0; w < 3; ++w) { const unsigned v = cntw[w * 32 + nn]; base += (w < w4) ? v : 0u; }
            if (n >= 0) SEG[(((size_t)bh * 32 + own) * 32 + n) * 256 + base + rk] = (unsigned short)(t | (sl << 8)); }
        if (t < own) { const unsigned c = cntw[t] + cntw[32 + t] + cntw[64 + t] + cntw[96 + t]; CNT[((size_t)bh * 32 + own) * 32 + t] = c; (void)__hip_atomic_fetch_add(TOT + bh * 31 + t, c, RLX_AGENT); }
    }
    asm volatile("s_waitcnt vmcnt(0)" ::: "memory");
    __syncthreads();
}

struct GTile { unsigned info; bf16x8 qr[4]; };
struct GRun { int e, c0, c1; };
template <int AUX = 0>
__device__ __forceinline__ void dma_kv(LAS unsigned char* kv, const GAS bf16* Kb, const GAS bf16* Vb, int b, int h, int n, int w, int lane) {
#pragma unroll
    for (int t = 0; t < 4; ++t) {
        const size_t kr = (size_t)b * SEQ + n * BLK + 64 * t + 8 * w + (lane >> 3), vr = (size_t)b * SEQ + n * BLK + 64 * t + 16 * (w & 3) + (lane >> 2);
        __builtin_amdgcn_global_load_lds((const GAS unsigned*)(Kb + hm_off(kr, b, h) + (((lane & 7) ^ ((4 * w + (lane >> 4)) & 7)) * 8)), (LAS unsigned*)(kv + L_K + t * 8192 + w * 1024), 16, 0, AUX);
        __builtin_amdgcn_global_load_lds((const GAS unsigned*)(Vb + hm_off(kr, b, h) + ((((lane >> 2) & 1) ^ ((lane >> 4) & 1)) * 32) + (lane & 3) * 8), (LAS unsigned*)(kv + L_V + t * 8192 + w * 1024), 16, 0, AUX);
    }
}
__device__ __forceinline__ void gather(Frame& F) {
    GAS unsigned char* ws = F.ws;
    const GAS bf16* Qb = (const GAS bf16*)(ws + WS_Q); const GAS bf16* Kb = (const GAS bf16*)(ws + WS_K); const GAS bf16* Vb = (const GAS bf16*)(ws + WS_V);
    const GAS unsigned short* SEG = (const GAS unsigned short*)(ws + WS_SEG); const GAS unsigned* CNT = (const GAS unsigned*)(ws + WS_CNT); const GAS unsigned* TOT = (const GAS unsigned*)(ws + WS_CTL) + CW_TOT;
    const GAS float* KBM = (const GAS float*)(ws + WS_CTL) + CW_KBH; GAS float* PL = (GAS float*)(ws + WS_PL);
    int tid = F.wave * 64 + lane_id(); asm volatile("" : "+v"(tid));
    const int lane = tid & 63, w = __builtin_amdgcn_readfirstlane(tid >> 6), r32 = lane & 31, hi = lane >> 5;
    LAS unsigned* pre = (LAS unsigned*)(F.lds + L_PRE);
    __syncthreads();
    if (w == 0) { unsigned loc = 0;
        for (int i = 0; i < 31; ++i) { const unsigned nc = (TOT[31 * lane + i] + 255u) >> 8; loc += nc + (nc ? 1u : 0u); }
        unsigned inc = loc;
#pragma unroll
        for (int o = 1; o < 64; o <<= 1) { const unsigned v = shup(inc, o, lane); if (lane >= o) inc += v; }
        unsigned run = inc - loc;
        for (int i = 0; i < 31; ++i) { pre[31 * lane + i] = run; const unsigned nc = (TOT[31 * lane + i] + 255u) >> 8; run += nc + (nc ? 1u : 0u); }
        if (lane == 63) pre[1984] = run; }
    __syncthreads();
    const int U = (int)pre[1984];
    int p = (int)(((long)F.vcu * U) / F.G); const int phi = (int)(((long)(F.vcu + 1) * U) / F.G);
    int e = 0; { int lo = 0, hi2 = 1984; while (hi2 - lo > 1) { const int mid = (lo + hi2) >> 1; if ((int)pre[mid] <= p) lo = mid; else hi2 = mid; } e = lo; }
    auto next_run = [&](GRun& R) -> bool {
        while (p < phi) {
            while (p >= (int)pre[e + 1]) ++e;
            const int k = p - (int)pre[e], nch = (int)pre[e + 1] - (int)pre[e] - 1;
            const int c0 = k > 0 ? k - 1 : 0; int c1 = phi - (int)pre[e] - 1; c1 = c1 < nch ? c1 : nch;
            p = (int)pre[e] + 1 + c1;
            if (c1 > c0) { R.e = e; R.c0 = c0; R.c1 = c1; return true; }
        }
        return false;
    };
    auto scan_cnt = [&](unsigned v) -> unsigned { unsigned inc = v;
#pragma unroll
        for (int o = 1; o < 32; o <<= 1) { const unsigned t2 = shup(inc, o, lane); if ((lane & 31) >= o) inc += t2; }
        return inc; };
    int cur_h = -1, cur_bh = -1, rb = 0; float kmax2 = 0.f, bmax = 0.f, rb31 = 0.f;
    GRun cur, nxt; bool hc = next_run(cur);
    unsigned cntN = 0, totN = 0, cumv = 0, tot = 0;
    if (hc) { const int bh = cur.e / 31, n = cur.e - bh * 31; dma_kv(F.lds, Kb, Vb, bh >> 4, bh & 15, n, w, lane);
        cntN = ((lane & 31) > n) ? CNT[((size_t)bh * 32 + (lane & 31)) * 32 + n] : 0u; totN = TOT[cur.e]; }
    GTile tcur, tnxt; unsigned ownB = 0, entB = 0xffffffffu; bool mine = false;
    auto fetch_ent = [&](int c, bool valid, int n, const GAS unsigned short* segb, unsigned cv, unsigned tt, unsigned& own_o) -> unsigned {
        const unsigned g0 = 256u * c + 32u * w, g = g0 + r32;
        const bool tile_ok = valid && g0 < tt;
        unsigned own = (unsigned)(n + 1), base = 0u;
        if (tile_ok) {
            int lo = n + 1, hi2 = 32;
            while (hi2 - lo > 1) { const int mid = (lo + hi2) >> 1; if (__builtin_amdgcn_readlane(cv, mid - 1) <= g0) lo = mid; else hi2 = mid; }
            own = (unsigned)lo; base = (lo == n + 1) ? 0u : __builtin_amdgcn_readlane(cv, lo - 1);
            for (int o = lo + 1; o < 32; ++o) { const unsigned s2 = __builtin_amdgcn_readlane(cv, o - 1); if (s2 > g0 + 31u) break; if (s2 <= g) { own = (unsigned)o; base = s2; } }
        }
        const bool lane_ok = tile_ok && g < tt;
        const unsigned idx = lane_ok ? (g - base) : 0u;
        const unsigned v = (unsigned)segb[(size_t)own * 32 * 256 + idx];
        own_o = own;
        return lane_ok ? v : 0xffffffffu;
    };
    auto make_tile = [&](unsigned ent, unsigned own, int b, int h, int n, GTile& T) {
        const bool act = ent != 0xffffffffu;
        const int tq = act ? (int)(own * BLK + (ent & 255u)) : SEQ - 1;
        T.info = (unsigned)tq | (act ? (((ent >> 8) & 3u) << 16) | (1u << 18) | ((own - n <= 4) ? (1u << 19) : 0u) : 0u);
        load_q_raw(T.qr, Qb, (size_t)b * SEQ + tq, b, h, hi);
    };
    auto start_run = [&](const GRun& R) {
        const int bh = R.e / 31, n = R.e - bh * 31; const GAS unsigned short* segb = SEG + ((size_t)bh * 32 * 32 + n) * 256;
        cumv = scan_cnt(cntN); tot = totN;
        mine = (unsigned)(256 * R.c0 + 32 * w) < tot;
        entB = 0xffffffffu; ownB = 0;
        if (mine) { unsigned ownA; const unsigned entA = fetch_ent(R.c0, true, n, segb, cumv, tot, ownA); make_tile(entA, ownA, bh >> 4, bh & 15, n, tcur);
            entB = fetch_ent(R.c0 + 1, R.c0 + 1 < R.c1, n, segb, cumv, tot, ownB); }
    };
    if (hc) start_run(cur);
    while (hc) {
        const bool hn = next_run(nxt);
        const int c0 = cur.c0, c1 = cur.c1, bh = cur.e / 31, n = cur.e - bh * 31, b = bh >> 4, h = bh & 15;
        const GAS unsigned short* segb = SEG + ((size_t)bh * 32 * 32 + n) * 256;
        LAS unsigned char* kv = F.lds + rb * 65536;
        __builtin_amdgcn_s_waitcnt(0x0F70);
        __syncthreads();
        if (hn) { const int bh2 = nxt.e / 31, n2 = nxt.e - bh2 * 31;
            cntN = ((lane & 31) > n2) ? CNT[((size_t)bh2 * 32 + (lane & 31)) * 32 + n2] : 0u; totN = TOT[nxt.e]; }
        if (bh != cur_bh) { head_bounds(KBM, F.rel_bias, bh, h, lane, kmax2, bmax); rb31 = F.rel_bias[31 * NH + h] * LOG2E; cur_bh = bh;
            if (h != cur_h) { build_lut(F.lds, F.rel_bias, h, tid); cur_h = h; __syncthreads(); } }
        const lds_cptr Kl = (lds_cptr)(kv + L_K), Vl = (lds_cptr)(kv + L_V); const int vrl = 4 * hi + ((lane & 15) >> 2); const unsigned vo0 = (unsigned)(vrl * 128 + ((vrl >> 1) & 1) * 64 + ((lane >> 4) & 1) * 32 + (lane & 3) * 8);
        if (mine) for (int c = c0; c < c1; ++c) {
            if ((unsigned)(256 * c + 32 * w) >= tot) break;
            make_tile(entB, ownB, b, h, n, tnxt);
            entB = fetch_ent(c + 2, c + 2 < c1, n, segb, cumv, tot, ownB);
            const unsigned info = tcur.info; const int tq = (int)(info & 0xffffu); const bool near = (info >> 19) & 1u;
            const float mref = ref_exponent(q_norm2(tcur.qr), kmax2, bmax);
            const bool anynear = __any(near);
            const int tqrel = near ? (tq - n * BLK) : 1755;
            LAS const float* lutp = (LAS const float*)(F.lds + L_LUT) + (2047 - tqrel + 4 * hi);
            f32x16 cinit; { const float cc = anynear ? -mref : (rb31 - mref);
#pragma unroll
                for (int r = 0; r < 16; ++r) cinit[r] = cc; }
            f32x16 o[2]; o[0] = f32x16{}; o[1] = f32x16{}; float l = 0.f;
            if (anynear) tile_math<true>(o, l, Kl, Vl, vo0, tcur.qr, cinit, lutp, r32, hi); else tile_math<false>(o, l, Kl, Vl, vo0, tcur.qr, cinit, lutp, r32, hi);
            l = swap_add(l);
            { const bool act = (info >> 18) & 1u; const int slot = (int)((info >> 16) & 3u);
              GAS bf16* dump = (GAS bf16*)(ws + WS_DUMP) + (size_t)F.vcu * 4096 + lane * 64;
              store_row<true>(act ? po_row(ws, F.out, b, h, tq, slot) : dump - 32 * hi, o, 1.0f, hi, lane);
              GAS float* plp = act ? PL + ((size_t)(bh * 3 + slot) * SEQ + tq) : (GAS float*)dump;
              *plp = l; }
            tcur = tnxt;
        }
        if (hn) { start_run(nxt);
            const int bh2 = nxt.e / 31, n2 = nxt.e - bh2 * 31; dma_kv(F.lds + (rb ^ 1) * 65536, Kb, Vb, bh2 >> 4, bh2 & 15, n2, w, lane); }
        cur = nxt; hc = hn; rb ^= 1;
    }
    asm volatile("s_waitcnt vmcnt(0)" ::: "memory");
    __syncthreads();
}

__device__ __forceinline__ void own_block(Frame& F) {
    GAS unsigned char* ws = F.ws;
    const GAS bf16* Qb = (const GAS bf16*)(ws + WS_Q); const GAS bf16* Kb = (const GAS bf16*)(ws + WS_K); const GAS bf16* Vb = (const GAS bf16*)(ws + WS_V); GAS bf16* Ob = (GAS bf16*)(ws + WS_O);
    const GAS float* KBM = (const GAS float*)(ws + WS_CTL) + CW_KBH; const GAS float* PL = (const GAS float*)(ws + WS_PL);
    int tid = F.wave * 64 + lane_id(); asm volatile("" : "+v"(tid));
    const int lane = tid & 63, w = __builtin_amdgcn_readfirstlane(tid >> 6), r32 = lane & 31, hi = lane >> 5;
    const int bh = F.vcu & 63, b = bh >> 4, h = bh & 15, own0 = F.vcu >> 6, nun = (NBLK - own0 + 3) / 4;
    __syncthreads();
    build_lut(F.lds, F.rel_bias, h, tid);
    float kmax2, bmax; head_bounds(KBM, F.rel_bias, bh, h, lane, kmax2, bmax);
    const int qrel = 32 * w + r32;
    LAS const float* lutp = (LAS const float*)(F.lds + L_LUT) + (2047 - qrel + 4 * hi);
    const int jd = w >> 1;
    bf16x8 qn[4];
    dma_kv<2>(F.lds, Kb, Vb, b, h, own0, w, lane);
    load_q_raw(qn, Qb, (size_t)b * SEQ + own0 * BLK + qrel, b, h, hi);
    for (int i = 0; i < nun; ++i) {
        const int own = own0 + 4 * i; const size_t qrow = (size_t)b * SEQ + own * BLK + qrel;
        LAS unsigned char* kv = F.lds + (i & 1) * 65536;
        bf16x8 qr[4];
#pragma unroll
        for (int d0 = 0; d0 < 4; ++d0) qr[d0] = qn[d0];
        asm volatile("s_waitcnt vmcnt(0)" ::: "memory");
        __syncthreads();
        if (i + 1 < nun) { dma_kv<2>(F.lds + ((i + 1) & 1) * 65536, Kb, Vb, b, h, own + 4, w, lane); load_q_raw(qn, Qb, qrow + 4 * BLK, b, h, hi); }
        const float mref = ref_exponent(q_norm2(qr), kmax2, bmax);
        f32x16 cinit;
#pragma unroll
        for (int r = 0; r < 16; ++r) cinit[r] = -mref;
        f32x16 o[2]; o[0] = f32x16{}; o[1] = f32x16{}; float l = 0.f;
        const lds_cptr Kl = (lds_cptr)(kv + L_K), Vl = (lds_cptr)(kv + L_V); const int vrl = 4 * hi + ((lane & 15) >> 2); const unsigned vo0 = (unsigned)(vrl * 128 + ((vrl >> 1) & 1) * 64 + ((lane >> 4) & 1) * 32 + (lane & 3) * 8);
        for (int j = 0; j <= jd; ++j) { f32x16 p0, p1; v4u pa[4];
            qk_tile(p0, p1, Kl + j * 8192, qr, cinit, r32, hi);
            if (j == jd) softmax_tile<true, true>(p0, p1, lutp, j, qrel, hi, l, pa); else softmax_tile<true, false>(p0, p1, lutp, j, qrel, hi, l, pa);
            pv_tile(o, Vl + j * 8192, vo0, pa); }
        l = swap_add(l);
        const int nsl = own < 3 ? own : 3; const int tq = own * BLK + qrel;
        for (int sl = 0; sl < nsl; ++sl) { add_row<true>(o, po_row(ws, F.out, b, h, tq, sl), hi, lane); l += PL[(size_t)(bh * 3 + sl) * SEQ + tq]; }
        store_row<false>(Ob + qrow * D + h * 64, o, 1.0f / l, hi, lane);
    }
    asm volatile("s_waitcnt vmcnt(0)" ::: "memory");
    __syncthreads();
}
}

__device__ __forceinline__ void final_norm(Frame& Fr) {
    struct { int lane, vcu, wave, G; const GAS float* norm_final; GAS float* out; } F{Fr.wave * 64 + lane_id(), Fr.vcu, Fr.wave, Fr.G, Fr.norm_final, Fr.out};
    asm volatile("" : "+v"(F.lane)); F.lane &= 63;
    const int gw = F.vcu * NWAVES + F.wave, NGW = F.G * NWAVES;
    f32x4 gam[4];
#pragma unroll
    for (int j = 0; j < 4; ++j) gam[j] = *(const GAS f32x4*)(F.norm_final + 4 * (F.lane + 64 * j));
    for (int row = gw; row < M; row += NGW) { GAS float* xr = F.out + (size_t)row * D; f32x4 v[4]; float ss = 0.f;
#pragma unroll
        for (int j = 0; j < 4; ++j) { v[j] = *(const GAS f32x4*)(xr + 4 * (F.lane + 64 * j)); ss += (v[j][0] * v[j][0] + v[j][1] * v[j][1]) + (v[j][2] * v[j][2] + v[j][3] * v[j][3]); }
#pragma unroll
        for (int o = 1; o < 64; o <<= 1) ss += shx(ss, o, F.lane);
        const float rstd = rsqrtf(ss * (1.0f / D) + EPS);
#pragma unroll
        for (int j = 0; j < 4; ++j) *(GAS f32x4*)(xr + 4 * (F.lane + 64 * j)) = v[j] * rstd * gam[j]; }
}

__global__ void __launch_bounds__(NWAVES * 64, 2) fwd_megakernel(Args args) {
    __shared__ __attribute__((aligned(16))) unsigned char lds[LDS_BYTES];
    Frame F;
    F.lds = (LAS unsigned char*)lds;
    F.tid = threadIdx.x; F.lane = F.tid & 63; F.wave = __builtin_amdgcn_readfirstlane(F.tid >> 6);
    F.G = gridDim.x; { const int bx = blockIdx.x; F.vcu = (F.G % 8 == 0) ? (bx % 8) * (F.G / 8) + bx / 8 : bx; }
    F.x = args.in[0]; F.c = args.in[1]; F.rel_bias = args.in[2]; F.w_mod = args.in[3]; F.b_mod = args.in[4]; F.norm_mix = args.in[5]; F.norm_mlp = args.in[6];
    F.w_pool = args.in[7]; F.pool_scale = args.in[8]; F.w_qkv = args.in[9]; F.w_o = args.in[10]; F.w_up = args.in[11]; F.w_down = args.in[12]; F.norm_final = args.in[13];
    F.out = args.out; F.ws = args.ws;
    volatile LAS unsigned* MISC = (volatile LAS unsigned*)(F.lds + MISC_OFF);
    for (int u = F.tid; u < (LDS_BYTES - LDSCTL_OFF) / 4; u += NWAVES * 64) ((LAS unsigned*)(F.lds + LDSCTL_OFF))[u] = 0u;
    __syncthreads();
    gu32* ctl = (gu32*)(F.ws + WS_CTL);
    XcdBarrier bar = xcd_barrier_post((GAS unsigned*)(ctl + CW_BAR), MISC + 8); bar.wave = F.wave;
    GAS unsigned char* ws = F.ws;
#define WSB(off) ((GAS bf16*)(ws + (off)))
#define WSF(off) ((GAS float*)(ws + (off)))

    p0_prologue(F);
    xcd_barrier(bar);
    p1_pool(F); p1_bias(F, 0, 1);
    xcd_barrier(bar);

    for (int ph = 0; ph < 10; ++ph) {
        asm volatile("" : "+s"(ws));
        const GAS float* MOD = WSF(WS_MOD); GAS float* SS = WSF(WS_SS);
        const int kind = (ph == 0 || ph == 2 || ph == 7) ? 0 : (ph == 1 || ph == 8) ? 1 : (ph == 3) ? 2 : (ph == 4) ? 3 : (ph == 5) ? 4 : (ph == 6) ? 5 : 7;
        if (kind == 0) {
            pg8::Gemm g; pg8::EpiRes E;
            if (ph == 0) { g = pg8::Gemm{WSB(WS_XNA), WSB(WS_WPOOL), M, D, 256, D, 256, 512};
                E = pg8::EpiRes{WSB(WS_XR), WSB(WS_XR), MOD + 2048, F.pool_scale, SS}; }
            else if (ph == 2) { g = pg8::Gemm{WSB(WS_HB), WSB(WS_WDN0), M, D, FF, 256, 0, 131072};
                E = pg8::EpiRes{WSB(WS_XR), WSB(WS_XR), MOD + 5120, nullptr, SS}; }
            else { g = pg8::Gemm{WSB(WS_O), WSB(WS_WO), M, D, D, D, 0, 512};
                E = pg8::EpiRes{WSB(WS_XR), WSB(WS_XR), MOD + 4 * 6144 + 2048, nullptr, SS}; }
            pg8::StaticOrder S; S.init(M, D, F.G, (int)blockIdx.x);
            pg8::gemm_phase<pg8::EpiRes, pg8::StaticOrder, true>(F.lds + RING_OFF, g, S, E, F.wave);
            if (ph == 2) { F.ws = ws; p1_bias(F, 1, 2); } else if (ph == 7) { F.ws = ws; p1_bias(F, 2, 3); }
        } else if (kind == 1) {
            const pg8::Gemm g{WSB(WS_XR), WSB(ph == 1 ? WS_WSUP0 : WS_WSUP1), M, FF, D, 256, 0, 131072, (size_t)FF * D * 2};
            const pg8::EpiUp E{SS, WSF(ph == 1 ? WS_BIAS_UP0 : WS_BIAS_UP1), WSB(WS_HB), FF, F.lds, 0};
            pg8::StaticOrder S; S.init(M, FF, F.G, (int)blockIdx.x);
            pg8::gemm_phase<pg8::EpiUp, pg8::StaticOrder, true>(F.lds + RING_OFF, g, S, E, F.wave);
        } else if (kind == 2) {
            const pg8::Gemm g{WSB(WS_XR), (const GAS bf16*)((GAS unsigned char*)F.out + OUT_WSQKV), M, NQKV, D, 256, 0, 131072, (size_t)NQKV * D * 2};
            const pg8::EpiQKV E{SS, WSF(WS_BIAS_QKV), WSB(WS_Q), (size_t)(WS_K - WS_Q) / 2, WSF(WS_KMP), F.lds, 0, (GAS unsigned*)(ws + WS_CTL) + CW_KBH};
            pg8::StaticOrder S; S.init(M, NQKV, F.G, (int)blockIdx.x);
            pg8::gemm_phase<pg8::EpiQKV, pg8::StaticOrder, true>(F.lds + RING_OFF, g, S, E, F.wave);
        } else if (kind == 3) { F.ws = ws; att::route(F);
        } else if (kind == 4) { F.ws = ws; att::gather(F);
        } else if (kind == 5) { F.ws = ws; att::own_block(F);
        } else {
            const pg8::Gemm g{WSB(WS_HB), WSB(WS_WDN1), M, D, FF, 256, 0, 131072};
            const pg8::EpiFinal E{WSB(WS_XR), F.out, MOD + 4 * 6144 + 5120, F.norm_final, SS, (GAS unsigned*)(ws + WS_CTL) + CW_FIN};
            pg8::StaticOrder S; S.init(M, D, F.G, (int)blockIdx.x);
            pg8::gemm_phase<pg8::EpiFinal, pg8::StaticOrder, true>(F.lds + RING_OFF, g, S, E, F.wave);
            break;
        }
        xcd_barrier(bar);
    }
}

extern "C" void kernel_launch(void* const* d_in, const int* in_sizes, int n_in, void* d_out, int out_size, void* d_ws, size_t ws_size, hipStream_t stream) {
    static int grid = 0;
    if (grid == 0) {
        if (n_in != 14 || in_sizes[0] != M * D || out_size != M * D || ws_size < WS_END) { fprintf(stderr, "kernel_launch: unexpected shapes / workspace (n_in %d, in0 %d, out %d, ws %zu)\n", n_in, n_in > 0 ? in_sizes[0] : -1, out_size, ws_size); grid = -1; return; }
        int dev = 0, cus = 0, per_cu = 0;
        if (hipGetDevice(&dev) != hipSuccess || hipDeviceGetAttribute(&cus, hipDeviceAttributeMultiprocessorCount, dev) != hipSuccess) { grid = -1; return; }
        if (hipOccupancyMaxActiveBlocksPerMultiprocessor(&per_cu, (const void*)fwd_megakernel, NWAVES * 64, 0) != hipSuccess || per_cu < 1) { fprintf(stderr, "kernel_launch: occupancy query says %d blocks per CU\n", per_cu); }
        (void)hipGetLastError();
        grid = cus;
    }
    if (grid < 0) return;
    if (hipMemsetAsync((char*)d_ws + WS_CTL, 0, CTL_ZERO_BYTES, stream) != hipSuccess) return;
    Args a{};
    for (int i = 0; i < 14; ++i) a.in[i] = (const GAS float*)d_in[i];
    a.out = (GAS float*)d_out; a.ws = (GAS unsigned char*)d_ws;
    hipLaunchKernelGGL(fwd_megakernel, dim3(grid), dim3(NWAVES * 64), 0, stream, a);
}
```
